# Optimizing an MI355X kernel written in HIP

```python
import math
import jax, jax.numpy as jnp
from jax import lax
import numpy as np

D_MODEL = 1024
BATCH = 32
SEQ = 2048
DEPTH = 1

EPS = 1e-6
A_WIDTH = 768
A_GROUPS = 4
A_GROUP_DIM = A_WIDTH // A_GROUPS
CHUNK = 128
B_PATTERNS = ((128, 1), (512, 4), (2048, 16))
B_GROUPS = len(B_PATTERNS)
B_HEADS_PER_GROUP = 4
B_HEADS = B_GROUPS * B_HEADS_PER_GROUP
B_HEAD_DIM = 64
B_QKV_WIDTH = B_HEADS * B_HEAD_DIM
B_OUT_WIDTH = B_HEADS_PER_GROUP * B_HEAD_DIM
BLOCK = 128
MEM_LEN = 256
M_HEADS = 4
M_HEAD_DIM = 128
M_WIDTH = M_HEADS * M_HEAD_DIM
N_BRANCHES = 3
REL_BUCKETS = 32
REL_MAX_DISTANCE = 2048
IN_SIZES = (A_WIDTH, A_WIDTH, A_WIDTH,
            B_QKV_WIDTH, B_QKV_WIDTH, B_QKV_WIDTH, B_OUT_WIDTH,
            M_WIDTH, M_WIDTH,
            N_BRANCHES * D_MODEL)
IN_TOTAL = sum(IN_SIZES)

kernel_name = "hybrid_sgu_dilated_memory_block"


def rms_norm(x, w):
    xf = x.astype(jnp.float32)
    y = xf * lax.rsqrt(jnp.mean(xf * xf, axis=-1, keepdims=True) + EPS)
    return (y * w.astype(jnp.float32)).astype(x.dtype)


def layer_norm(x, w, b):
    xf = x.astype(jnp.float32)
    mu = jnp.mean(xf, axis=-1, keepdims=True)
    xc = xf - mu
    y = xc * lax.rsqrt(jnp.mean(xc * xc, axis=-1, keepdims=True) + EPS)
    return (y * w.astype(jnp.float32) + b.astype(jnp.float32)).astype(x.dtype)


def t5_causal_bucket(dist):
    max_exact = REL_BUCKETS // 2
    is_small = dist < max_exact
    df = jnp.maximum(dist, 1).astype(jnp.float32)
    large = max_exact + (jnp.log(df / max_exact) / math.log(REL_MAX_DISTANCE / max_exact)
                         * (REL_BUCKETS - max_exact)).astype(jnp.int32)
    large = jnp.minimum(large, REL_BUCKETS - 1)
    return jnp.where(is_small, dist, large)


def chunked_spatial_gating(u, v, w_s, b_s):
    bn, s, _ = u.shape
    nc = s // CHUNK
    causal = jnp.tril(jnp.ones((CHUNK, CHUNK), dtype=bool))
    w = jnp.where(causal[None], w_s, 0).astype(v.dtype)
    vc = v.reshape(bn, nc, CHUNK, A_GROUPS, A_GROUP_DIM)
    mixed = jnp.einsum('gts,bcsgd->bctgd', w, vc) + b_s.T.astype(v.dtype)[None, None, :, :, None]
    return u * mixed.reshape(bn, s, A_WIDTH)


def dilated_window_attention(q, k, v, bias_table, dilation, win_steps):
    bn, s, h, hd = q.shape
    L = s // dilation
    bd = bn * dilation

    def to_residue(t):
        return jnp.moveaxis(t.reshape((bn, L, dilation) + t.shape[2:]), 2, 1).reshape((bd, L) + t.shape[2:])

    def from_residue(t):
        t = t.reshape((bn, dilation, L) + t.shape[2:])
        return jnp.moveaxis(t, 1, 2).reshape((bn, s) + t.shape[3:])

    qs, ks, vs = to_residue(q), to_residue(k), to_residue(v)
    nb = -(-L // BLOCK)
    lp = nb * BLOCK
    pad = lp - L
    qb = jnp.pad(qs, ((0, 0), (0, pad), (0, 0), (0, 0))).reshape(bd, nb, BLOCK, h, hd)

    def kv_blocks(t):
        tp = jnp.pad(t, ((0, 0), (BLOCK, pad), (0, 0), (0, 0))).reshape(bd, nb + 1, BLOCK, h, hd)
        return jnp.concatenate([tp[:, :-1], tp[:, 1:]], axis=2)

    kb, vb = kv_blocks(ks), kv_blocks(vs)
    qi = jnp.arange(BLOCK)[:, None]
    kj = jnp.arange(2 * BLOCK)[None, :]
    step = qi + BLOCK - kj
    in_window = (step >= 0) & (step <= win_steps)
    key_pos = jnp.arange(nb)[:, None, None] * BLOCK - BLOCK + kj[None]
    valid = in_window[None] & (key_pos >= 0)
    bucket = t5_causal_bucket(jnp.maximum(step, 0) * dilation)
    bias = jnp.transpose(bias_table[bucket], (2, 0, 1)).astype(jnp.float32)

    scores = jnp.einsum('bnqhd,bnkhd->bnhqk', qb.astype(jnp.float32), kb.astype(jnp.float32)) * (hd ** -0.5)
    scores = jnp.where(valid[None, :, None], scores + bias[None, None], -1e30)
    m = jnp.max(scores, axis=-1, keepdims=True)
    p = jnp.exp(scores - m)
    l = jnp.sum(p, axis=-1)
    o = jnp.einsum('bnhqk,bnkhd->bnqhd', p, vb.astype(jnp.float32))
    o = o / jnp.transpose(l, (0, 1, 3, 2))[..., None]
    lse = jnp.transpose(m[..., 0] + jnp.log(l), (0, 1, 3, 2))
    o = o.reshape(bd, lp, h, hd)[:, :L]
    lse = lse.reshape(bd, lp, h)[:, :L]
    return from_residue(o), from_residue(lse)


def setup_inputs(seed: int = 0) -> dict:
    key = jax.random.key(seed)
    ks = jax.random.split(key, 22)
    f32 = jnp.float32
    n = lambda k, shape: jax.random.normal(k, shape, f32)
    return {
        "x": n(ks[0], (BATCH, SEQ, D_MODEL)),
        "mem": n(ks[1], (BATCH, MEM_LEN, D_MODEL)),
        "norm_w": 1.0 + 0.02 * n(ks[2], (D_MODEL,)),
        "w_in": n(ks[3], (D_MODEL, IN_TOTAL)) * D_MODEL ** -0.5,
        "gate_b": 0.01 * n(ks[4], (N_BRANCHES, D_MODEL)),
        "a_v_norm_w": 1.0 + 0.02 * n(ks[5], (A_WIDTH,)),
        "a_v_norm_b": 0.02 * n(ks[6], (A_WIDTH,)),
        "a_spatial_w": n(ks[7], (A_GROUPS, CHUNK, CHUNK)) * CHUNK ** -0.5,
        "a_spatial_b": 1.0 + 0.02 * n(ks[8], (A_GROUPS, CHUNK)),
        "b_q_norm_w": 1.0 + 0.02 * n(ks[9], (B_HEAD_DIM,)),
        "b_k_norm_w": 1.0 + 0.02 * n(ks[10], (B_HEAD_DIM,)),
        "rel_bias": 0.2 * n(ks[11], (REL_BUCKETS, B_HEADS)),
        "mem_norm_w": 1.0 + 0.02 * n(ks[12], (D_MODEL,)),
        "m_w_kv": n(ks[13], (D_MODEL, 2 * M_WIDTH)) * D_MODEL ** -0.5,
        "m_q_norm_w": 1.0 + 0.02 * n(ks[14], (M_HEAD_DIM,)),
        "m_k_norm_w": 1.0 + 0.02 * n(ks[15], (M_HEAD_DIM,)),
        "proj_a": n(ks[16], (A_WIDTH, D_MODEL)) * A_WIDTH ** -0.5,
        "proj_b": n(ks[17], (B_OUT_WIDTH, D_MODEL)) * B_OUT_WIDTH ** -0.5,
        "proj_m": n(ks[18], (M_WIDTH, D_MODEL)) * M_WIDTH ** -0.5,
        "w_out": n(ks[19], (D_MODEL, D_MODEL)) * D_MODEL ** -0.5,
    }


def reference(x, mem, norm_w, w_in, gate_b, a_v_norm_w, a_v_norm_b, a_spatial_w, a_spatial_b,
              b_q_norm_w, b_k_norm_w, rel_bias, mem_norm_w, m_w_kv, m_q_norm_w, m_k_norm_w,
              proj_a, proj_b, proj_m, w_out):
    bn, s, _ = x.shape
    split_at = np.cumsum(IN_SIZES)[:-1].tolist()
    for _layer in range(DEPTH):
        h = rms_norm(x, norm_w)
        proj = h @ w_in
        a_u, a_v, a_z, b_q, b_k, b_v, b_z, m_q, m_z, g = jnp.split(proj, split_at, axis=-1)

        u = jax.nn.gelu(a_u, approximate=False)
        vv = layer_norm(jax.nn.gelu(a_v, approximate=False), a_v_norm_w, a_v_norm_b)
        y_a = chunked_spatial_gating(u, vv, a_spatial_w, a_spatial_b) * jax.nn.silu(a_z)

        q = rms_norm(b_q.reshape(bn, s, B_HEADS, B_HEAD_DIM), b_q_norm_w)
        k = rms_norm(b_k.reshape(bn, s, B_HEADS, B_HEAD_DIM), b_k_norm_w)
        v = b_v.reshape(bn, s, B_HEADS, B_HEAD_DIM)
        outs, lses = [], []
        for gi, (window, dilation) in enumerate(B_PATTERNS):
            hs = slice(gi * B_HEADS_PER_GROUP, (gi + 1) * B_HEADS_PER_GROUP)
            o_g, lse_g = dilated_window_attention(q[:, :, hs], k[:, :, hs], v[:, :, hs],
                                                  rel_bias[:, hs], dilation, window // dilation)
            outs.append(o_g)
            lses.append(lse_g)
        o_all = jnp.stack(outs, axis=0)
        wts = jax.nn.softmax(jnp.stack(lses, axis=0), axis=0)
        y_b = jnp.sum(wts[..., None] * o_all, axis=0).reshape(bn, s, B_OUT_WIDTH).astype(x.dtype)
        y_b = y_b * jax.nn.silu(b_z)

        kv = rms_norm(mem, mem_norm_w) @ m_w_kv
        mk, mv = jnp.split(kv, 2, axis=-1)
        mq = rms_norm(m_q.reshape(bn, s, M_HEADS, M_HEAD_DIM), m_q_norm_w)
        mk = rms_norm(mk.reshape(bn, MEM_LEN, M_HEADS, M_HEAD_DIM), m_k_norm_w)
        mv = mv.reshape(bn, MEM_LEN, M_HEADS, M_HEAD_DIM)
        sc = jnp.einsum('bshd,bmhd->bhsm', mq.astype(jnp.float32), mk.astype(jnp.float32)) * (M_HEAD_DIM ** -0.5)
        pm = jax.nn.softmax(sc, axis=-1)
        y_m = jnp.einsum('bhsm,bmhd->bshd', pm, mv.astype(jnp.float32)).reshape(bn, s, M_WIDTH).astype(x.dtype)
        y_m = y_m * jax.nn.silu(m_z)

        gates = jax.nn.sigmoid((g.reshape(bn, s, N_BRANCHES, D_MODEL) + gate_b).astype(jnp.float32)).astype(x.dtype)
        merged = (gates[:, :, 0] * (y_a @ proj_a)
                  + gates[:, :, 1] * (y_b @ proj_b)
                  + gates[:, :, 2] * (y_m @ proj_m))
        x = x + merged @ w_out
    return x
```

```cpp
#include <hip/hip_runtime.h>
#include <cstdint>
#include <cstdio>

constexpr int DM = 1024, NB = 32, SEQ = 2048, MTOT = NB * SEQ;
constexpr int NIN = 8960, MEML = 256, MMEM = NB * MEML;
constexpr int HB_ROWS = MTOT / 2;
constexpr int C_AU = 0, C_AV = 768, C_AZ = 1536, C_BQ = 2304, C_BK = 3072, C_BV = 3840, C_BZ = 4608, C_MQ = 4864, C_MZ = 5376, C_G = 5888;
constexpr float EPS = 1e-6f;
constexpr int SS_W = 112;
constexpr int KC = 1536;

typedef unsigned short bf16_t;
constexpr size_t MiB = 1u << 20;
constexpr size_t WS_CTL = 0, WS_WIN = 2 * MiB, WS_PCAT = 22 * MiB, WS_WOUT = 25 * MiB, WS_WSP = 27 * MiB, WS_BIAS = 27 * MiB + 512 * 1024;
constexpr size_t WS_XN = 32 * MiB, WS_PA = 176 * MiB, WS_KVM = 736 * MiB, WS_SS = 752 * MiB, WS_MKSS = 766 * MiB, WS_OG = 768 * MiB, WS_LSE = 816 * MiB, WS_LNST = 818 * MiB;
constexpr size_t WS_YC = 820 * MiB, WS_MRG = 916 * MiB, WS_END = 980 * MiB;

__device__ __forceinline__ unsigned f2bf(float f) { unsigned u = __builtin_bit_cast(unsigned, f); return (u + 0x7fffu + ((u >> 16) & 1u)) >> 16; }
__device__ __forceinline__ float bf2f(bf16_t h) { return __builtin_bit_cast(float, (unsigned)h << 16); }
__device__ __forceinline__ float gelu_f(float x) { return 0.5f * x * (1.f + erff(x * 0.70710678118654752f)); }
__device__ __forceinline__ float sigm_f(float x) { return 1.f / (1.f + __expf(-x)); }
__device__ __forceinline__ float silu_f(float x) { return x * sigm_f(x); }
__device__ __forceinline__ float wave_sum(float v) {
#pragma unroll
    for (int o = 1; o < 64; o <<= 1) v += __shfl_xor(v, o);
    return v;
}
__device__ __forceinline__ int t5_bucket(int d) {
    if (d < 16) return d;
    const int thr[15] = {22, 30, 40, 54, 73, 99, 134, 182, 246, 332, 450, 609, 825, 1117, 1513};
    int b = 16;
#pragma unroll
    for (int i = 0; i < 15; ++i) b += (d >= thr[i]) ? 1 : 0;
    return b;
}

__global__ void k_prep_w(const float* w_in, const float* m_w_kv, const float* proj_a, const float* proj_b, const float* proj_m, const float* w_out,
                         const float* a_sp_w, const float* rel_bias, bf16_t* WIN, bf16_t* PCAT, bf16_t* WOUT, bf16_t* WSP, float* BIAS) {
    const size_t gid = (size_t)blockIdx.x * blockDim.x + threadIdx.x, gsz = (size_t)gridDim.x * blockDim.x;
    for (size_t i = gid; i < (size_t)(NIN + 1024) * DM; i += gsz) { const int n = (int)(i / DM), k = (int)(i % DM);
        WIN[i] = (bf16_t)f2bf(n < NIN ? w_in[(size_t)k * NIN + n] : m_w_kv[(size_t)k * 1024 + (n - NIN)]); }
    for (size_t i = gid; i < (size_t)DM * KC; i += gsz) { const int n = (int)(i / KC), k = (int)(i % KC);
        const float v = k < 768 ? proj_a[(size_t)k * DM + n] : (k < 1024 ? proj_b[(size_t)(k - 768) * DM + n] : proj_m[(size_t)(k - 1024) * DM + n]);
        PCAT[i] = (bf16_t)f2bf(v); }
    for (size_t i = gid; i < (size_t)DM * DM; i += gsz) { const int n = (int)(i / DM), k = (int)(i % DM); WOUT[i] = (bf16_t)f2bf(w_out[(size_t)k * DM + n]); }
    for (size_t i = gid; i < (size_t)4 * 128 * 128; i += gsz) { const int t = (int)((i / 128) % 128), s = (int)(i % 128); WSP[i] = (bf16_t)(s <= t ? f2bf(a_sp_w[i]) : 0u); }
    for (size_t i = gid; i < (size_t)3 * 4 * 132; i += gsz) { const int g = (int)(i / (4 * 132)), h = (int)((i / 132) % 4), j = (int)(i % 132);
        const int dil = g == 0 ? 1 : (g == 1 ? 4 : 16);
        BIAS[i] = j <= 128 ? rel_bias[t5_bucket(j * dil) * 12 + 4 * g + h] : 0.f; }
}
__global__ void k_rmsnorm(const float* x, const float* mem, const float* norm_w, const float* mem_norm_w, bf16_t* XN) {
    const int wave = (blockIdx.x * blockDim.x + threadIdx.x) >> 6, lane = threadIdx.x & 63, nw = (gridDim.x * blockDim.x) >> 6;
    for (int r = wave; r < MTOT + MMEM; r += nw) {
        const float* src = r < MTOT ? x + (size_t)r * DM : mem + (size_t)(r - MTOT) * DM; const float* w = r < MTOT ? norm_w : mem_norm_w;
        float v[16]; float s = 0.f;
#pragma unroll
        for (int j = 0; j < 16; ++j) { v[j] = src[lane + 64 * j]; s += v[j] * v[j]; }
        const float rs = rsqrtf(wave_sum(s) * (1.f / DM) + EPS);
#pragma unroll
        for (int j = 0; j < 16; ++j) XN[(size_t)r * DM + lane + 64 * j] = (bf16_t)f2bf(v[j] * rs * w[lane + 64 * j]);
    }
}

struct EpiG1 { bf16_t* PA; const float* gate_b;
    __device__ void operator()(int r, int c, float v) const {
        float o;
        if (c < C_AZ) o = gelu_f(v); else if (c < C_BQ) o = silu_f(v); else if (c < C_BZ) o = v; else if (c < C_MQ) o = silu_f(v); else if (c < C_MZ) o = v; else if (c < C_G) o = silu_f(v);
        else o = sigm_f(v + gate_b[c - C_G]);
        PA[(size_t)r * NIN + c] = (bf16_t)f2bf(o); } };
struct EpiKV { bf16_t* KVM; __device__ void operator()(int r, int c, float v) const { KVM[(size_t)r * 1024 + c] = (bf16_t)f2bf(v); } };
struct EpiG2 { float* tmp; const bf16_t* PA; bf16_t* MRG; int br; int pad;
    __device__ void operator()(int r, int c, float v) const {
        const float g = bf2f(PA[(size_t)r * NIN + C_G + br * DM + c]); float* t = tmp + (size_t)r * DM + c;
        if (br == 0) *t = g * v; else if (br == 1) *t += g * v; else MRG[(size_t)r * DM + c] = (bf16_t)f2bf(*t + g * v); } };
struct EpiG3 { const float* x; float* out; __device__ void operator()(int r, int c, float v) const { out[(size_t)r * DM + c] = x[(size_t)r * DM + c] + v; } };

template <class Epi> __global__ void __launch_bounds__(256) k_gemm_naive(const bf16_t* A, const bf16_t* Bt, int lda, int ldb, int K, int pad, Epi epi) {
    __shared__ float As[32][65], Bs[32][65];
    const int tid = threadIdx.x, tx = tid & 15, ty = tid >> 4, m0 = blockIdx.y * 64, n0 = blockIdx.x * 64;
    float acc[4][4];
#pragma unroll
    for (int i = 0; i < 4; ++i)
#pragma unroll
        for (int j = 0; j < 4; ++j) acc[i][j] = 0.f;
    for (int k0 = 0; k0 < K; k0 += 32) {
#pragma unroll
        for (int i = 0; i < 8; ++i) { const int e = tid + 256 * i, r = e >> 5, kk = e & 31;
            As[kk][r] = bf2f(A[(size_t)(m0 + r) * lda + k0 + kk]); Bs[kk][r] = bf2f(Bt[(size_t)(n0 + r) * ldb + k0 + kk]); }
        __syncthreads();
#pragma unroll 8
        for (int kk = 0; kk < 32; ++kk) { float a[4], b[4];
#pragma unroll
            for (int i = 0; i < 4; ++i) { a[i] = As[kk][ty * 4 + i]; b[i] = Bs[kk][tx * 4 + i]; }
#pragma unroll
            for (int i = 0; i < 4; ++i)
#pragma unroll
                for (int j = 0; j < 4; ++j) acc[i][j] += a[i] * b[j]; }
        __syncthreads();
    }
#pragma unroll
    for (int i = 0; i < 4; ++i)
#pragma unroll
        for (int j = 0; j < 4; ++j) epi(m0 + ty * 4 + i, n0 + tx * 4 + j, acc[i][j]);
}

__global__ void k_stats(const bf16_t* PA, float* SS, float* LNST) {
    const size_t gid = (size_t)blockIdx.x * blockDim.x + threadIdx.x; if (gid >= (size_t)HB_ROWS * 88) return;
    const int r = (int)(gid / 88), b = (int)(gid % 88);
    int c0, o; bool two = false;
    if (b < 24) { c0 = C_AV + 32 * b; o = 2 * b; two = true; } else if (b < 48) { c0 = C_BQ + 32 * (b - 24); o = 48 + (b - 24); } else if (b < 72) { c0 = C_BK + 32 * (b - 48); o = 72 + (b - 48); } else { c0 = C_MQ + 32 * (b - 72); o = 96 + (b - 72); }
    float s = 0.f, q = 0.f;
    for (int j = 0; j < 32; ++j) { const float v = bf2f(PA[(size_t)r * NIN + c0 + j]); s += v; q += v * v; }
    if (two) { SS[(size_t)r * SS_W + o] = s; SS[(size_t)r * SS_W + o + 1] = q; } else SS[(size_t)r * SS_W + o] = q;
}
__global__ void k_lnstat(const float* SS, float* LNST) {
    const int r = blockIdx.x * blockDim.x + threadIdx.x; if (r >= HB_ROWS) return;
    float s = 0.f, q = 0.f; for (int b = 0; b < 24; ++b) { s += SS[(size_t)r * SS_W + 2 * b]; q += SS[(size_t)r * SS_W + 2 * b + 1]; }
    const float mu = s * (1.f / 768.f), var = q * (1.f / 768.f) - mu * mu;
    LNST[2 * r] = mu; LNST[2 * r + 1] = rsqrtf(fmaxf(var, 0.f) + EPS);
}
__global__ void k_mkss(const bf16_t* KVM, float* MKSS) {
    const int gid = blockIdx.x * blockDim.x + threadIdx.x; if (gid >= MMEM * 16) return;
    const int r = gid / 16, b = gid % 16; float q = 0.f;
    for (int j = 0; j < 32; ++j) { const float v = bf2f(KVM[(size_t)r * 1024 + 32 * b + j]); q += v * v; }
    MKSS[gid] = q;
}

__global__ void k_mixA(const bf16_t* PA, const float* LNST, const bf16_t* WSP, const float* lnw, const float* lnb, const float* sp_b, bf16_t* YC) {
    const size_t gid = (size_t)blockIdx.x * blockDim.x + threadIdx.x; if (gid >= (size_t)HB_ROWS * 768) return;
    const int r = (int)(gid / 768), c = (int)(gid % 768), g = c / 192, t = r & 127, r0 = r - t;
    float acc = 0.f;
    for (int s = 0; s <= t; ++s) { const float gv = bf2f(PA[(size_t)(r0 + s) * NIN + C_AV + c]);
        const float vv = (gv - LNST[2 * (r0 + s)]) * LNST[2 * (r0 + s) + 1] * lnw[c] + lnb[c];
        acc += bf2f(WSP[(g * 128 + t) * 128 + s]) * vv; }
    acc += sp_b[g * 128 + t];
    const float u = bf2f(PA[(size_t)r * NIN + C_AU + c]), z = bf2f(PA[(size_t)r * NIN + C_AZ + c]);
    YC[(size_t)r * KC + c] = (bf16_t)f2bf(u * acc * z);
}
__global__ void k_attnB(const bf16_t* PA, const float* SS, const float* BIAS, const float* qw, const float* kw, bf16_t* OG, float* LSE) {
    const int wave = (int)(((size_t)blockIdx.x * blockDim.x + threadIdx.x) >> 6), lane = threadIdx.x & 63;
    if (wave >= 3 * HB_ROWS * 4) return;
    const int g = wave / (HB_ROWS * 4), r = (wave / 4) % HB_ROWS, h = wave % 4, hh = 4 * g + h, dil = g == 0 ? 1 : (g == 1 ? 4 : 16), t = r % SEQ;
    const float qs = rsqrtf((SS[(size_t)r * SS_W + 48 + 2 * hh] + SS[(size_t)r * SS_W + 48 + 2 * hh + 1]) * (1.f / 64.f) + EPS);
    const float q = bf2f(PA[(size_t)r * NIN + C_BQ + hh * 64 + lane]) * qs * qw[lane] * kw[lane] * 0.125f;
    float m = -1e30f, l = 0.f, o = 0.f;
    for (int j = 0; j <= 128; ++j) { if (t - j * dil < 0) break; const int kr = r - j * dil;
        const float ks = rsqrtf((SS[(size_t)kr * SS_W + 72 + 2 * hh] + SS[(size_t)kr * SS_W + 72 + 2 * hh + 1]) * (1.f / 64.f) + EPS);
        const float s = wave_sum(q * bf2f(PA[(size_t)kr * NIN + C_BK + hh * 64 + lane])) * ks + BIAS[(g * 4 + h) * 132 + j];
        const float mn = fmaxf(m, s), a = __expf(m - mn), p = __expf(s - mn);
        l = l * a + p; o = o * a + p * bf2f(PA[(size_t)kr * NIN + C_BV + hh * 64 + lane]); m = mn; }
    OG[((size_t)g * HB_ROWS + r) * 256 + h * 64 + lane] = (bf16_t)f2bf(o / l);
    if (lane == 0) LSE[((size_t)g * HB_ROWS + r) * 4 + h] = m + __logf(l);
}
__global__ void k_mergeB(const bf16_t* PA, const bf16_t* OG, const float* LSE, bf16_t* YC) {
    const size_t gid = (size_t)blockIdx.x * blockDim.x + threadIdx.x; if (gid >= (size_t)HB_ROWS * 256) return;
    const int r = (int)(gid / 256), c = (int)(gid % 256), h = c / 64;
    const float l0 = LSE[((size_t)0 * HB_ROWS + r) * 4 + h], l1 = LSE[((size_t)1 * HB_ROWS + r) * 4 + h], l2 = LSE[((size_t)2 * HB_ROWS + r) * 4 + h];
    const float mx = fmaxf(l0, fmaxf(l1, l2)), e0 = __expf(l0 - mx), e1 = __expf(l1 - mx), e2 = __expf(l2 - mx), inv = 1.f / (e0 + e1 + e2);
    const float y = (e0 * bf2f(OG[((size_t)0 * HB_ROWS + r) * 256 + c]) + e1 * bf2f(OG[((size_t)1 * HB_ROWS + r) * 256 + c]) + e2 * bf2f(OG[((size_t)2 * HB_ROWS + r) * 256 + c])) * inv;
    YC[(size_t)r * KC + 768 + c] = (bf16_t)f2bf(y * bf2f(PA[(size_t)r * NIN + C_BZ + c]));
}
__global__ void k_attnM(const bf16_t* PA, const float* SS, const bf16_t* KVM, const float* MKSS, const float* qw, const float* kw, bf16_t* YC, int row_base, int pad) {
    const int wave = (int)(((size_t)blockIdx.x * blockDim.x + threadIdx.x) >> 6), lane = threadIdx.x & 63;
    if (wave >= HB_ROWS * 4) return;
    const int r = wave / 4, h = wave % 4, b = (row_base + r) / SEQ;
    float qq = 0.f; for (int i = 0; i < 4; ++i) qq += SS[(size_t)r * SS_W + 96 + 4 * h + i];
    const float qs = rsqrtf(qq * (1.f / 128.f) + EPS) * 0.08838834764831845f;
    const float q0 = bf2f(PA[(size_t)r * NIN + C_MQ + h * 128 + lane]) * qs * qw[lane] * kw[lane], q1 = bf2f(PA[(size_t)r * NIN + C_MQ + h * 128 + 64 + lane]) * qs * qw[64 + lane] * kw[64 + lane];
    float m = -1e30f, l = 0.f, o0 = 0.f, o1 = 0.f;
    for (int j = 0; j < MEML; ++j) { const size_t kr = (size_t)b * MEML + j;
        float kk = 0.f; for (int i = 0; i < 4; ++i) kk += MKSS[kr * 16 + 4 * h + i];
        const float ks = rsqrtf(kk * (1.f / 128.f) + EPS);
        const float s = wave_sum(q0 * bf2f(KVM[kr * 1024 + h * 128 + lane]) + q1 * bf2f(KVM[kr * 1024 + h * 128 + 64 + lane])) * ks;
        const float mn = fmaxf(m, s), a = __expf(m - mn), p = __expf(s - mn);
        l = l * a + p; o0 = o0 * a + p * bf2f(KVM[kr * 1024 + 512 + h * 128 + lane]); o1 = o1 * a + p * bf2f(KVM[kr * 1024 + 512 + h * 128 + 64 + lane]); m = mn; }
    YC[(size_t)r * KC + 1024 + h * 128 + lane] = (bf16_t)f2bf(o0 / l * bf2f(PA[(size_t)r * NIN + C_MZ + h * 128 + lane]));
    YC[(size_t)r * KC + 1024 + h * 128 + 64 + lane] = (bf16_t)f2bf(o1 / l * bf2f(PA[(size_t)r * NIN + C_MZ + h * 128 + 64 + lane]));
}

extern "C" void kernel_launch(void* const* d_in, const int* in_sizes, int n_in, void* d_out, int out_size, void* d_ws, size_t ws_size, hipStream_t stream) {
    if (n_in != 20 || ws_size < WS_END) { fprintf(stderr, "kernel_launch: unexpected n_in %d / ws %zu\n", n_in, ws_size); return; }
    const float* x = (const float*)d_in[0]; const float* mem = (const float*)d_in[1]; const float* norm_w = (const float*)d_in[2]; const float* w_in = (const float*)d_in[3];
    const float* gate_b = (const float*)d_in[4]; const float* lnw = (const float*)d_in[5]; const float* lnb = (const float*)d_in[6]; const float* sp_w = (const float*)d_in[7];
    const float* sp_b = (const float*)d_in[8]; const float* bqw = (const float*)d_in[9]; const float* bkw = (const float*)d_in[10]; const float* rel_bias = (const float*)d_in[11];
    const float* mem_norm_w = (const float*)d_in[12]; const float* m_w_kv = (const float*)d_in[13]; const float* mqw = (const float*)d_in[14]; const float* mkw = (const float*)d_in[15];
    const float* proj_a = (const float*)d_in[16]; const float* proj_b = (const float*)d_in[17]; const float* proj_m = (const float*)d_in[18]; const float* w_out = (const float*)d_in[19];
    float* out = (float*)d_out; unsigned char* ws = (unsigned char*)d_ws;
    bf16_t* WIN = (bf16_t*)(ws + WS_WIN); bf16_t* PCAT = (bf16_t*)(ws + WS_PCAT); bf16_t* WOUT = (bf16_t*)(ws + WS_WOUT); bf16_t* WSP = (bf16_t*)(ws + WS_WSP); float* BIAS = (float*)(ws + WS_BIAS);
    bf16_t* XN = (bf16_t*)(ws + WS_XN); bf16_t* PA = (bf16_t*)(ws + WS_PA); bf16_t* KVM = (bf16_t*)(ws + WS_KVM); float* SS = (float*)(ws + WS_SS); float* MKSS = (float*)(ws + WS_MKSS);
    bf16_t* OG = (bf16_t*)(ws + WS_OG); float* LSE = (float*)(ws + WS_LSE); float* LNST = (float*)(ws + WS_LNST); bf16_t* YC = (bf16_t*)(ws + WS_YC); bf16_t* MRG = (bf16_t*)(ws + WS_MRG);

    k_prep_w<<<2048, 256, 0, stream>>>(w_in, m_w_kv, proj_a, proj_b, proj_m, w_out, sp_w, rel_bias, WIN, PCAT, WOUT, WSP, BIAS);
    k_rmsnorm<<<2048, 256, 0, stream>>>(x, mem, norm_w, mem_norm_w, XN);
    k_gemm_naive<EpiKV><<<dim3(1024 / 64, MMEM / 64), 256, 0, stream>>>(XN + (size_t)MTOT * DM, WIN + (size_t)NIN * DM, DM, DM, DM, 0, EpiKV{KVM});
    k_mkss<<<(MMEM * 16 + 255) / 256, 256, 0, stream>>>(KVM, MKSS);
    for (int hb = 0; hb < 2; ++hb) {
        const int row0 = hb * HB_ROWS;
        k_gemm_naive<EpiG1><<<dim3(NIN / 64, HB_ROWS / 64), 256, 0, stream>>>(XN + (size_t)row0 * DM, WIN, DM, DM, DM, 0, EpiG1{PA, gate_b});
        k_stats<<<(unsigned)(((size_t)HB_ROWS * 88 + 255) / 256), 256, 0, stream>>>(PA, SS, LNST);
        k_lnstat<<<HB_ROWS / 256, 256, 0, stream>>>(SS, LNST);
        k_mixA<<<(unsigned)(((size_t)HB_ROWS * 768 + 255) / 256), 256, 0, stream>>>(PA, LNST, WSP, lnw, lnb, sp_b, YC);
        k_attnB<<<(unsigned)(((size_t)3 * HB_ROWS * 4 * 64 + 255) / 256), 256, 0, stream>>>(PA, SS, BIAS, bqw, bkw, OG, LSE);
        k_mergeB<<<(unsigned)(((size_t)HB_ROWS * 256 + 255) / 256), 256, 0, stream>>>(PA, OG, LSE, YC);
        k_attnM<<<(unsigned)(((size_t)HB_ROWS * 4 * 64 + 255) / 256), 256, 0, stream>>>(PA, SS, KVM, MKSS, mqw, mkw, YC, row0, 0);
        float* tmp = out + (size_t)row0 * DM;
        k_gemm_naive<EpiG2><<<dim3(DM / 64, HB_ROWS / 64), 256, 0, stream>>>(YC, PCAT, KC, KC, 768, 0, EpiG2{tmp, PA, MRG, 0, 0});
        k_gemm_naive<EpiG2><<<dim3(DM / 64, HB_ROWS / 64), 256, 0, stream>>>(YC + 768, PCAT + 768, KC, KC, 256, 0, EpiG2{tmp, PA, MRG, 1, 0});
        k_gemm_naive<EpiG2><<<dim3(DM / 64, HB_ROWS / 64), 256, 0, stream>>>(YC + 1024, PCAT + 1024, KC, KC, 512, 0, EpiG2{tmp, PA, MRG, 2, 0});
        k_gemm_naive<EpiG3><<<dim3(DM / 64, HB_ROWS / 64), 256, 0, stream>>>(MRG, WOUT, DM, DM, DM, 0, EpiG3{x + (size_t)row0 * DM, out + (size_t)row0 * DM});
    }
}
```

```cpp
#include <hip/hip_runtime.h>
#include <cstdint>
#include <cstdio>

constexpr int DM = 1024, NB = 32, SEQ = 2048, MTOT = NB * SEQ;
constexpr int NIN = 8960, MEML = 256, MMEM = NB * MEML;
constexpr int HB_ROWS = MTOT / 2;
constexpr int C_AU = 0, C_AV = 768, C_AZ = 1536, C_BQ = 2304, C_BK = 3072, C_BV = 3840, C_BZ = 4608, C_MQ = 4864, C_MZ = 5376, C_G = 5888;
constexpr float EPS = 1e-6f;
constexpr int SS_W = 112;
constexpr int KC = 1536;

constexpr size_t MiB = 1u << 20;
constexpr size_t WS_CTL = 0, CTL_ZERO_BYTES = 256 * 1024, WS_WIN = 2 * MiB, WS_PCAT = 22 * MiB, WS_WOUT = 25 * MiB, WS_WSP = 27 * MiB, WS_BIAS = 27 * MiB + 512 * 1024;
constexpr size_t WS_XN = 32 * MiB, WS_PA = 176 * MiB, WS_KVM = 736 * MiB, WS_SS = 752 * MiB, WS_MKSS = 766 * MiB, WS_OG = 768 * MiB, WS_LSE = 816 * MiB, WS_LNST = 818 * MiB;
constexpr size_t WS_YC = 820 * MiB, WS_MRG = 916 * MiB, WS_END = 980 * MiB;
constexpr int CW_BAR = 4096;

namespace pg8 {
#define PG8_LAS __attribute__((address_space(3)))
typedef unsigned short bf16_t;
typedef short bf16x8 __attribute__((ext_vector_type(8)));
typedef float f32x4 __attribute__((ext_vector_type(4)));
typedef unsigned u32x4 __attribute__((ext_vector_type(4)));
constexpr int BM = 256, BK = 64, HALF = 128, HTB = HALF * BK * 2  , STAGE_BYTES = 8 * HTB, NXCD = 8, WGM = 8;

__host__ __device__ __forceinline__ int lds_byte(int r, int c) { const int st = (r >> 4) * 2 + (c >> 5), rr = r & 15, cc = c & 31, ob = rr * 64 + cc * 2; return st * 1024 + (ob ^ (((ob >> 9) & 1) << 5)); }
__host__ __device__ __forceinline__ void stage_rc(int b, int& R, int& C) { const int st = b / 1024, sb = b % 1024, swz = sb ^ (((sb >> 9) & 1) << 5); R = (st >> 1) * 16 + swz / 64; C = (st & 1) * 32 + (swz % 64) / 2; }
__host__ __device__ __forceinline__ int perm32(int rho) { const int n = rho >> 4, i = rho & 15; return 8 * (i >> 2) + 4 * n + (i & 3); }

struct Unit { int pm, pn; };
struct Gemm { const bf16_t* A; const bf16_t* Bt; int M, N, K, lda, ldb; };

struct StaticOrder {
    int nM, nN, nwg, G, c;
    __host__ __device__ void init(int M, int N, int G_, int c_) { nM = M / BM; nN = N / BM; nwg = nM * nN; G = G_; c = c_; }
    __host__ __device__ bool next(int i, Unit& u) const {
        const long L = (long)i * G + c; if (L >= nwg) return false;
        int wgid = (int)L; { const int q = nwg / NXCD, r = nwg % NXCD, xcd = wgid % NXCD, off = wgid / NXCD; wgid = (xcd < r ? xcd * (q + 1) : r * (q + 1) + (xcd - r) * q) + off; }
        const int nig = WGM * nN, gid = wgid / nig, fm = gid * WGM, gsz = (nM - fm) < WGM ? (nM - fm) : WGM;
        u.pm = fm + ((wgid % nig) % gsz); u.pn = (wgid % nig) / gsz; return true;
    }
    __device__ __forceinline__ void a_ready(const Unit&) const {}
    __device__ __forceinline__ void done(const Unit&) const {}
};


__device__ __forceinline__ unsigned cvt_pk_bf16(float lo, float hi) { unsigned r; asm volatile("v_cvt_pk_bf16_f32 %0, %1, %2" : "=v"(r) : "v"(lo), "v"(hi)); return r; }
typedef float f32x2 __attribute__((ext_vector_type(2)));
__device__ __forceinline__ f32x2 gelu_pk(f32x2 v) {
    const f32x2 av = __builtin_elementwise_abs(v), d = av * 0.2316418882f + 1.0f;
    f32x2 t; t.x = __builtin_amdgcn_rcpf(d.x); t.y = __builtin_amdgcn_rcpf(d.y);
    f32x2 q = t * 0.5307027145f + (-0.7265760135f); q = q * t + 0.7107068705f; q = q * t + (-0.142248368f); q = q * t + 0.127414796f; q = q * t;
    const f32x2 s = (v * v) * (-0.72134752044f);
    f32x2 e; e.x = __builtin_amdgcn_exp2f(s.x); e.y = __builtin_amdgcn_exp2f(s.y);
    const f32x2 m = v * (q * e), r = v - m;
    f32x2 o; o.x = v.x < 0.f ? m.x : r.x; o.y = v.y < 0.f ? m.y : r.y; return o;
}

template <class Epi, class Sched, bool ALIGN_EPI = false, bool SP2 = false>
__device__ __forceinline__ void gemm_phase(PG8_LAS unsigned char* lds, const Gemm g, const Sched& S, const Epi& E) {
    int tid = threadIdx.x; asm volatile("" : "+v"(tid));
    const int wid = __builtin_amdgcn_readfirstlane(tid >> 6), lane = tid & 63, wr = wid >> 2, wc = wid & 3, fr = lane & 15, fq = lane >> 4;
    int K = g.K; asm volatile("" : "+s"(K)); const int nt = K / BK;
    unsigned voffA[2], voffB[2];
#pragma unroll
    for (int i = 0; i < 2; ++i) { int R, C; stage_rc(tid * 16 + i * 8192, R, C); const int Rb = Epi::PERM ? ((R & ~31) + perm32(R & 31)) : R;
        voffA[i] = (unsigned)(R * g.lda + C) * 2u; voffB[i] = (unsigned)(Rb * g.ldb + C) * 2u; }
    const size_t kstep = (size_t)(BK * 2);
    const size_t hstepA = (size_t)HALF * g.lda * 2, hstepB = (size_t)HALF * g.ldb * 2;
    const size_t tstepA = 2 * hstepA, tstepB = 2 * hstepB;
    const unsigned ldsw = (unsigned)wid * 1024u;
    const int aoff = lds_byte(wr * 64 + fr, fq * 8), boff = lds_byte(wc * 32 + fr, fq * 8);
#define PG8_SA(b, h) (((b) * 2 + (h)) * HTB)
#define PG8_SB(b, h) ((4 + (b) * 2 + (h)) * HTB)
#define PG8_STAGE(bufoff, gbase, voff) do { _Pragma("unroll") for (int _i = 0; _i < 2; ++_i) \
        __builtin_amdgcn_global_load_lds((const unsigned*)((const char*)(gbase) + (voff)[_i]), (PG8_LAS unsigned*)(lds + (bufoff) + ldsw + _i * 8192), 16, 0, 0); } while (0)
#define PG8_LDA(dst, b, h) do { _Pragma("unroll") for (int m = 0; m < 4; ++m) _Pragma("unroll") for (int k = 0; k < 2; ++k) dst[m][k] = *(const PG8_LAS bf16x8*)(lds + PG8_SA(b, h) + aoff + m * 2048 + k * 1024); } while (0)
#define PG8_LDB(dst, b, h) do { _Pragma("unroll") for (int n = 0; n < 2; ++n) _Pragma("unroll") for (int k = 0; k < 2; ++k) dst[n][k] = *(const PG8_LAS bf16x8*)(lds + PG8_SB(b, h) + boff + n * 2048 + k * 1024); } while (0)
#define PG8_MMA(ai, bj, At, Bt) do { __builtin_amdgcn_s_setprio(1); _Pragma("unroll") for (int m = 0; m < 4; ++m) _Pragma("unroll") for (int n = 0; n < 2; ++n) _Pragma("unroll") for (int k = 0; k < 2; ++k) \
        acc[ai][bj][m][n] = __builtin_amdgcn_mfma_f32_16x16x32_bf16(Bt[n][k], At[m][k], acc[ai][bj][m][n], 0, 0, 0); __builtin_amdgcn_s_setprio(0); } while (0)
#define PG8_WAIT_V(n) asm volatile("s_waitcnt vmcnt(" #n ")" ::: "memory")
#define PG8_WAIT_L(n) asm volatile("s_waitcnt lgkmcnt(" #n ")" ::: "memory")
#define PG8_BAR __builtin_amdgcn_s_barrier()
#define PG8_SCHED __builtin_amdgcn_sched_barrier(0)
    Unit cur, nxt; int ui = 0;
    if (!S.next(0, cur)) return;
    f32x4 acc[2][2][4][2];
#pragma unroll
    for (int a = 0; a < 2; ++a)
#pragma unroll
        for (int b = 0; b < 2; ++b)
#pragma unroll
            for (int m = 0; m < 4; ++m)
#pragma unroll
                for (int n = 0; n < 2; ++n) acc[a][b][m][n] = (f32x4){0.f, 0.f, 0.f, 0.f};
    bf16x8 At[4][2], B0[2][2], B1[2][2];
    const char* cA = (const char*)g.A + (size_t)cur.pm * tstepA; const char* cB = (const char*)g.Bt + (size_t)cur.pn * tstepB;
    S.a_ready(cur);
    if constexpr (SP2) {
        PG8_STAGE(PG8_SB(0, 0), cB, voffB); PG8_STAGE(PG8_SB(0, 1), cB + hstepB, voffB); PG8_STAGE(PG8_SA(0, 0), cA, voffA); PG8_STAGE(PG8_SA(0, 1), cA + hstepA, voffA);
        if (wr == 1) PG8_BAR;
        PG8_WAIT_V(2); PG8_BAR;
        PG8_STAGE(PG8_SB(1, 0), cB + kstep, voffB); PG8_STAGE(PG8_SA(1, 0), cA + kstep, voffA); PG8_STAGE(PG8_SB(1, 1), cB + hstepB + kstep, voffB);
        PG8_WAIT_V(6); PG8_BAR;
    } else {
        PG8_STAGE(PG8_SB(0, 0), cB, voffB); PG8_STAGE(PG8_SA(0, 0), cA, voffA); PG8_STAGE(PG8_SB(0, 1), cB + hstepB, voffB); PG8_STAGE(PG8_SA(0, 1), cA + hstepA, voffA);
        if (wr == 1) PG8_BAR;
        PG8_WAIT_V(4); PG8_BAR;
        PG8_STAGE(PG8_SB(1, 0), cB + kstep, voffB); PG8_STAGE(PG8_SA(1, 0), cA + kstep, voffA); PG8_STAGE(PG8_SB(1, 1), cB + hstepB + kstep, voffB);
        PG8_WAIT_V(6); PG8_BAR;
    }
    for (;;) {
        const bool has_next = S.next(ui + 1, nxt);
        const char* nA = has_next ? (const char*)g.A + (size_t)nxt.pm * tstepA : cA; const char* nB = has_next ? (const char*)g.Bt + (size_t)nxt.pn * tstepB : cB;
        for (int t = 0; t < nt; t += 2) {
            const bool last = (t == nt - 2);
            const char* a1 = cA + (size_t)(t + 1) * kstep;
            const char* a2 = last ? nA : cA + (size_t)(t + 2) * kstep; const char* b2 = last ? nB : cB + (size_t)(t + 2) * kstep;
            const char* a3 = a2 + kstep; const char* b3 = b2 + kstep;
            if (last && has_next) S.a_ready(nxt);
            if constexpr (SP2) {
            PG8_LDB(B0, 0, 0); PG8_LDB(B1, 0, 1); PG8_SCHED; PG8_LDA(At, 0, 0); PG8_STAGE(PG8_SA(1, 1), a1 + hstepA, voffA);
            PG8_WAIT_V(8); PG8_WAIT_L(0); PG8_BAR; PG8_MMA(0, 0, At, B0); PG8_MMA(0, 1, At, B1); PG8_BAR; PG8_SCHED;
            PG8_LDA(At, 0, 1); PG8_STAGE(PG8_SB(0, 0), b2, voffB); PG8_STAGE(PG8_SB(0, 1), b2 + hstepB, voffB); PG8_STAGE(PG8_SA(0, 0), a2, voffA);
            PG8_WAIT_V(8); PG8_WAIT_L(0); PG8_BAR; PG8_MMA(1, 0, At, B0); PG8_MMA(1, 1, At, B1); PG8_BAR; PG8_SCHED;
            PG8_LDB(B0, 1, 0); PG8_LDB(B1, 1, 1); PG8_SCHED; PG8_LDA(At, 1, 0); PG8_STAGE(PG8_SA(0, 1), a2 + hstepA, voffA);
            PG8_WAIT_V(8); PG8_WAIT_L(0); PG8_BAR; PG8_MMA(0, 0, At, B0); PG8_MMA(0, 1, At, B1); PG8_BAR; PG8_SCHED;
            PG8_LDA(At, 1, 1); PG8_STAGE(PG8_SB(1, 0), b3, voffB); PG8_STAGE(PG8_SB(1, 1), b3 + hstepB, voffB); PG8_STAGE(PG8_SA(1, 0), a3, voffA);
            PG8_WAIT_V(8); PG8_WAIT_L(0); PG8_BAR; PG8_MMA(1, 0, At, B0); PG8_MMA(1, 1, At, B1); PG8_BAR; PG8_SCHED;
            } else {
            PG8_LDB(B0, 0, 0); PG8_SCHED; PG8_LDA(At, 0, 0); PG8_STAGE(PG8_SA(1, 1), a1 + hstepA, voffA);
            PG8_WAIT_L(8); PG8_BAR; PG8_WAIT_L(0); PG8_MMA(0, 0, At, B0); PG8_BAR; PG8_SCHED;
            PG8_LDB(B1, 0, 1); PG8_STAGE(PG8_SB(0, 0), b2, voffB);
            PG8_BAR; PG8_WAIT_L(0); PG8_MMA(0, 1, At, B1); PG8_BAR;
            PG8_LDA(At, 0, 1); PG8_STAGE(PG8_SA(0, 0), a2, voffA);
            PG8_BAR; PG8_WAIT_L(0); PG8_MMA(1, 0, At, B0); PG8_BAR; PG8_SCHED;
            PG8_STAGE(PG8_SB(0, 1), b2 + hstepB, voffB);
            PG8_WAIT_V(6); PG8_BAR; PG8_MMA(1, 1, At, B1); PG8_BAR;
            PG8_LDB(B0, 1, 0); PG8_SCHED; PG8_LDA(At, 1, 0); PG8_STAGE(PG8_SA(0, 1), a2 + hstepA, voffA);
            PG8_WAIT_L(8); PG8_BAR; PG8_WAIT_L(0); PG8_MMA(0, 0, At, B0); PG8_BAR; PG8_SCHED;
            PG8_LDB(B1, 1, 1); PG8_STAGE(PG8_SB(1, 0), b3, voffB);
            PG8_BAR; PG8_WAIT_L(0); PG8_MMA(0, 1, At, B1); PG8_BAR;
            PG8_LDA(At, 1, 1); PG8_STAGE(PG8_SA(1, 0), a3, voffA);
            PG8_BAR; PG8_WAIT_L(0); PG8_MMA(1, 0, At, B0); PG8_BAR; PG8_SCHED;
            PG8_STAGE(PG8_SB(1, 1), b3 + hstepB, voffB);
            PG8_WAIT_V(6); PG8_BAR; PG8_MMA(1, 1, At, B1); PG8_BAR;
            }
        }
        if constexpr (ALIGN_EPI) { if (wr == 0) PG8_BAR; }
        if constexpr (!Epi::AFTER_DRAIN) { E(acc, cur, wr, wc, fr, fq); S.done(cur); }
        if (!has_next) break;
#pragma unroll
        for (int a = 0; a < 2; ++a)
#pragma unroll
            for (int b = 0; b < 2; ++b)
#pragma unroll
                for (int m = 0; m < 4; ++m)
#pragma unroll
                    for (int n = 0; n < 2; ++n) acc[a][b][m][n] = (f32x4){0.f, 0.f, 0.f, 0.f};
        cur = nxt; cA = nA; cB = nB; ++ui;
        if constexpr (ALIGN_EPI) { if (wr == 1) PG8_BAR; }
    }
    PG8_WAIT_V(0);
    if constexpr (!ALIGN_EPI) { if (wr == 0) PG8_BAR; }
    PG8_BAR;
    if constexpr (Epi::AFTER_DRAIN) { E.fused(acc, cur, wr, wc, fr, fq, lds, wid, lane); S.done(cur); }
#undef PG8_SA
#undef PG8_SB
#undef PG8_STAGE
#undef PG8_LDA
#undef PG8_LDB
#undef PG8_MMA
#undef PG8_WAIT_V
#undef PG8_WAIT_L
#undef PG8_BAR
#undef PG8_SCHED
}
}

namespace pg8 {
__device__ __forceinline__ float ex2(float x) { return __builtin_amdgcn_exp2f(x); }
__device__ __forceinline__ float sigm_fast(float x) { return __builtin_amdgcn_rcpf(1.0f + ex2(x * -1.4426950408889634f)); }
struct EpiProj {
    static constexpr bool PERM = true, AFTER_DRAIN = false;
    bf16_t* PA; bf16_t* KVM; float* SS; float* MKSS; const float* gate_b; int pm0; int pad;
    __device__ __forceinline__ void operator()(const f32x4 (&acc)[2][2][4][2], const Unit& u, int wr, int wc, int fr, int fq) const {
        const bool kv = u.pn >= 35; const int pn = kv ? u.pn - 35 : u.pn;
        const int rowt = kv ? (u.pm - 256) * BM : (u.pm - pm0) * BM;
        bf16_t* base = kv ? KVM : PA; const int ldc = kv ? 1024 : NIN;
        int kind = 0, stat = 0, so = 0; float* sb = SS; int sld = SS_W;
        if (kv) { sb = MKSS; sld = 16; if (pn < 2) { stat = 1; so = 8 * pn; } }
        else if (pn < 3) kind = 1;
        else if (pn < 6) { kind = 1; stat = 2; so = 16 * (pn - 3); }
        else if (pn < 9) kind = 2;
        else if (pn < 12) { stat = 1; so = 48 + 8 * (pn - 9); }
        else if (pn < 15) { stat = 1; so = 72 + 8 * (pn - 12); }
        else if (pn < 18) kind = 0;
        else if (pn < 19) kind = 2;
        else if (pn < 21) { stat = 1; so = 96 + 8 * (pn - 19); }
        else if (pn < 23) kind = 2;
        else kind = 3;
        const int row0 = rowt + wr * 64 + fr, col0 = pn * BM + wc * 32 + 8 * fq;
        f32x4 bv[2][2];
#pragma unroll
        for (int bj = 0; bj < 2; ++bj)
#pragma unroll
            for (int n = 0; n < 2; ++n) bv[bj][n] = (kind == 3) ? *(const f32x4*)(gate_b + (col0 - 23 * BM) + bj * HALF + 4 * n) : (f32x4){0.f, 0.f, 0.f, 0.f};
#pragma unroll
        for (int ai = 0; ai < 2; ++ai)
#pragma unroll
            for (int m = 0; m < 4; ++m) { const int row = row0 + ai * HALF + m * 16; bf16_t* rowp = base + (size_t)row * ldc + col0;
#pragma unroll
                for (int bj = 0; bj < 2; ++bj) { f32x4 v0 = acc[ai][bj][m][0], v1 = acc[ai][bj][m][1];
                    if (kind == 1) { f32x2 a = gelu_pk((f32x2){v0[0], v0[1]}), b = gelu_pk((f32x2){v0[2], v0[3]}), c = gelu_pk((f32x2){v1[0], v1[1]}), d = gelu_pk((f32x2){v1[2], v1[3]});
                        v0 = (f32x4){a.x, a.y, b.x, b.y}; v1 = (f32x4){c.x, c.y, d.x, d.y}; }
                    else if (kind == 2) {
#pragma unroll
                        for (int j = 0; j < 4; ++j) { v0[j] = v0[j] * sigm_fast(v0[j]); v1[j] = v1[j] * sigm_fast(v1[j]); } }
                    else if (kind == 3) { v0 = v0 + bv[bj][0]; v1 = v1 + bv[bj][1];
#pragma unroll
                        for (int j = 0; j < 4; ++j) { v0[j] = sigm_fast(v0[j]); v1[j] = sigm_fast(v1[j]); } }
                    if (stat) {
                        float s = ((v0[0] + v0[1]) + (v0[2] + v0[3])) + ((v1[0] + v1[1]) + (v1[2] + v1[3]));
                        float q = ((v0[0] * v0[0] + v0[1] * v0[1]) + (v0[2] * v0[2] + v0[3] * v0[3])) + ((v1[0] * v1[0] + v1[1] * v1[1]) + (v1[2] * v1[2] + v1[3] * v1[3]));
                        s += __shfl_xor(s, 16); s += __shfl_xor(s, 32); q += __shfl_xor(q, 16); q += __shfl_xor(q, 32);
                        if (fq == 0) { float* sp = sb + (size_t)row * sld + so; const int blk = 4 * bj + wc;
                            if (stat == 2) { sp[2 * blk] = s; sp[2 * blk + 1] = q; } else sp[blk] = q; }
                    }
                    u32x4 w; w.x = cvt_pk_bf16(v0[0], v0[1]); w.y = cvt_pk_bf16(v0[2], v0[3]); w.z = cvt_pk_bf16(v1[0], v1[1]); w.w = cvt_pk_bf16(v1[2], v1[3]);
                    *(u32x4*)(rowp + bj * HALF) = w; } }
    }
};
template <int BR> struct EpiG2 {
    static constexpr bool PERM = false, AFTER_DRAIN = false;
    float* tmp; const bf16_t* PA; bf16_t* MRG;
    __device__ __forceinline__ void operator()(const f32x4 (&acc)[2][2][4][2], const Unit& u, int wr, int wc, int fr, int fq) const {
        typedef unsigned u32x2v __attribute__((ext_vector_type(2)));
        const int row0 = u.pm * BM + wr * 64 + fr, col0 = u.pn * BM + wc * 32 + 4 * fq;
#pragma unroll
        for (int ai = 0; ai < 2; ++ai)
#pragma unroll
            for (int m = 0; m < 4; ++m) { const size_t row = (size_t)(row0 + ai * HALF + m * 16);
                const bf16_t* gp = PA + row * NIN + C_G + BR * DM + col0; float* tp = tmp + row * DM + col0; bf16_t* mp = MRG + row * DM + col0;
#pragma unroll
                for (int bj = 0; bj < 2; ++bj)
#pragma unroll
                    for (int n = 0; n < 2; ++n) { const int co = bj * HALF + n * 16;
                        const u32x2v gw = *(const u32x2v*)(gp + co);
                        f32x4 g; g[0] = __uint_as_float(gw.x << 16); g[1] = __uint_as_float(gw.x & 0xffff0000u); g[2] = __uint_as_float(gw.y << 16); g[3] = __uint_as_float(gw.y & 0xffff0000u);
                        f32x4 v = g * acc[ai][bj][m][n];
                        if (BR == 0) *(f32x4*)(tp + co) = v;
                        else if (BR == 1) *(f32x4*)(tp + co) = *(const f32x4*)(tp + co) + v;
                        else { v = *(const f32x4*)(tp + co) + v; u32x2v w; w.x = cvt_pk_bf16(v[0], v[1]); w.y = cvt_pk_bf16(v[2], v[3]); *(u32x2v*)(mp + co) = w; } }
                asm volatile("" ::: "memory"); }
    }
};
struct EpiG3 {
    static constexpr bool PERM = false, AFTER_DRAIN = false;
    const float* x; float* out;
    __device__ __forceinline__ void operator()(const f32x4 (&acc)[2][2][4][2], const Unit& u, int wr, int wc, int fr, int fq) const {
        const int row0 = u.pm * BM + wr * 64 + fr, col0 = u.pn * BM + wc * 32 + 4 * fq;
#pragma unroll
        for (int ai = 0; ai < 2; ++ai)
#pragma unroll
            for (int m = 0; m < 4; ++m) { const size_t off = (size_t)(row0 + ai * HALF + m * 16) * DM + col0;
#pragma unroll
                for (int bj = 0; bj < 2; ++bj)
#pragma unroll
                    for (int n = 0; n < 2; ++n) *(f32x4*)(out + off + bj * HALF + n * 16) = *(const f32x4*)(x + off + bj * HALF + n * 16) + acc[ai][bj][m][n];
                asm volatile("" ::: "memory"); }
    }
};
struct OrderG1 {
    StaticOrder so; int pm0, nkv;
    __device__ void init(int hb, int G, int c) { so.init(HB_ROWS, NIN, G, c); pm0 = hb * (HB_ROWS / BM); nkv = hb == 0 ? (MMEM / BM) * 4 : 0; }
    __device__ bool next(int i, Unit& u) const {
        if (so.next(i, u)) { u.pm += pm0; return true; }
        const long j = (long)i * so.G + so.c - so.nwg; if (j < 0 || j >= nkv) return false;
        u.pm = 256 + (int)(j >> 2); u.pn = 35 + (int)(j & 3); return true;
    }
    __device__ __forceinline__ void a_ready(const Unit&) const {}
    __device__ __forceinline__ void done(const Unit&) const {}
};
}

#define GAS __attribute__((address_space(1)))
#define LAS __attribute__((address_space(3)))
typedef unsigned short bf16;
typedef unsigned v4u __attribute__((ext_vector_type(4)));
typedef float f32x4 __attribute__((ext_vector_type(4)));
typedef short bf16x8 __attribute__((ext_vector_type(8)));
typedef GAS unsigned gu32;
typedef GAS unsigned long long gu64;
#define RLX_AGENT __ATOMIC_RELAXED, __HIP_MEMORY_SCOPE_AGENT
#define LDS_WAIT() asm volatile("s_waitcnt lgkmcnt(0)" ::: "memory")
#define VM_WAIT() asm volatile("s_waitcnt vmcnt(0)" ::: "memory")
__device__ __forceinline__ unsigned long long rt() { return __builtin_amdgcn_s_memrealtime(); }
__device__ __forceinline__ unsigned f2bf(float f) { unsigned u = __builtin_bit_cast(unsigned, f); return (u + 0x7fffu + ((u >> 16) & 1u)) >> 16; }
__device__ __forceinline__ unsigned pk2(float lo, float hi) { return f2bf(lo) | (f2bf(hi) << 16); }

#define XB_TMO      128
#define XB_XCNT(j)  (256  + 64 * (j))
#define XB_XSUB(j)  (1280 + 64 * (j))
#define XB_XGEN(j)  (2304 + 64 * (j))
#define XB_TOP      3328
#define XB_TOPGEN   3392
#define XCD_BAR_WORDS 3456
#define XB_SPIN_CAP (1u << 18)

__device__ __forceinline__ unsigned xb_ld(unsigned* p)              { return __hip_atomic_load(p, __ATOMIC_RELAXED, __HIP_MEMORY_SCOPE_AGENT); }
__device__ __forceinline__ unsigned xb_add(unsigned* p, unsigned v) { return __hip_atomic_fetch_add(p, v, __ATOMIC_RELAXED, __HIP_MEMORY_SCOPE_AGENT); }
__device__ __forceinline__ unsigned xb_xcc_id() { return (unsigned)__builtin_amdgcn_s_getreg((3 << 11) | 20) & 0xFu; }
#define XB_SPIN(cond, bar) do { unsigned _sp = 0; while (cond) { __builtin_amdgcn_s_sleep(1); \
    if ((++_sp & 255u) == 0u) { if (xb_ld(&(bar)[XB_TMO])) break; if (_sp > XB_SPIN_CAP) { atomicAdd(&(bar)[XB_TMO], 1u); break; } } } } while (0)

struct XcdBarrier {
    unsigned* bar; unsigned x;
    volatile LAS unsigned* st;
};

__device__ __forceinline__ XcdBarrier xcd_barrier_post(unsigned* bar, volatile LAS unsigned* st) {
    XcdBarrier b; b.bar = bar; b.x = xb_xcc_id(); b.st = st;
    if (threadIdx.x == 0) (void)xb_add(&bar[XB_XCNT(b.x)], 1u);
    return b;
}
__device__ __forceinline__ void xcd_barrier_complete(unsigned* bar, unsigned x, unsigned& nloc, unsigned& nx) {
    const unsigned G = gridDim.x * gridDim.y * gridDim.z;
    unsigned sum, cnt, mine, sp = 0u;
    for (;;) {
        sum = 0u; cnt = 0u; mine = 0u;
#pragma unroll
        for (unsigned j = 0; j < 16; ++j) { const unsigned c = xb_ld(&bar[XB_XCNT(j)]); sum += c; cnt += (c > 0u) ? 1u : 0u; mine = (j == x) ? c : mine; }
        if (sum == G) break;
        __builtin_amdgcn_s_sleep(1);
        if ((++sp & 255u) == 0u) { if (xb_ld(&bar[XB_TMO])) break; if (sp > XB_SPIN_CAP) { atomicAdd(&bar[XB_TMO], 1u); break; } }
    }
    nloc = mine > 0u ? mine : 1u; nx = cnt > 0u ? cnt : 1u;
}

__device__ __forceinline__ void xcd_barrier(const XcdBarrier& b) {
    asm volatile("s_waitcnt vmcnt(0)" ::: "memory");
    __syncthreads();
    if (threadIdx.x == 0) {
        unsigned* bar = b.bar;
        __builtin_amdgcn_s_waitcnt(0);
        unsigned nloc = b.st[0], nx = b.st[1];
        if (nloc == 0u) { xcd_barrier_complete(bar, b.x, nloc, nx); b.st[0] = nloc; b.st[1] = nx; }
        const unsigned old = xb_add(&bar[XB_XSUB(b.x)], 1u);
        const unsigned gen = old / nloc;
        if (old + 1u == (gen + 1u) * nloc) {
            __builtin_amdgcn_fence(__ATOMIC_RELEASE, "agent");
            asm volatile("s_waitcnt vmcnt(0)" ::: "memory");
            const unsigned og = xb_add(&bar[XB_TOP], 1u);
            const unsigned tg = og / nx;
            if (og + 1u == (tg + 1u) * nx) xb_add(&bar[XB_TOPGEN], 1u);
            else XB_SPIN(xb_ld(&bar[XB_TOPGEN]) == tg, bar);
            __builtin_amdgcn_fence(__ATOMIC_ACQUIRE, "agent");
            xb_add(&bar[XB_XGEN(b.x)], 1u);
            asm volatile("s_waitcnt vmcnt(0)" ::: "memory");
        } else {
            XB_SPIN(xb_ld(&bar[XB_XGEN(b.x)]) == gen, bar);
            __builtin_amdgcn_fence(__ATOMIC_ACQUIRE, "agent");
            asm volatile("s_waitcnt vmcnt(0)" ::: "memory");
        }
    }
    __syncthreads();
}

__device__ __forceinline__ float wave_sum(float v) {
#pragma unroll
    for (int o = 1; o < 64; o <<= 1) v += __shfl_xor(v, o);
    return v;
}

constexpr int RING_OFF = 0, RING_BYTES = 131072;
constexpr int LDSCTL_OFF = RING_BYTES, MISC_OFF = LDSCTL_OFF + 320;
constexpr int LDS_BYTES = 147456;
constexpr int NWAVES = 8, NTHR = NWAVES * 64;

__device__ __forceinline__ float bf2f(bf16 h) { return __builtin_bit_cast(float, (unsigned)h << 16); }
__device__ __forceinline__ float sigm_f(float x) { return 1.f / (1.f + __expf(-x)); }
__device__ __forceinline__ int t5_bucket(int d) {
    if (d < 16) return d;
    int b = 16;
    b += d >= 22; b += d >= 30; b += d >= 40; b += d >= 54; b += d >= 73; b += d >= 99; b += d >= 134; b += d >= 182; b += d >= 246; b += d >= 332; b += d >= 450; b += d >= 609; b += d >= 825; b += d >= 1117; b += d >= 1513;
    return b;
}

struct Ctx {
    const float *x, *mem, *norm_w, *w_in, *gate_b, *lnw, *lnb, *sp_w, *sp_b, *bqw, *bkw, *rel_bias, *mem_norm_w, *m_w_kv, *mqw, *mkw, *proj_a, *proj_b, *proj_m, *w_out;
    float* out;
    bf16 *WIN, *PCAT, *WOUT, *WSP, *XN, *PA, *KVM, *OG, *YC, *MRG; float *BIAS, *SS, *MKSS, *LSE, *LNST;
    LAS unsigned char* lds; int tid, lane, wave, G, gtid, T, gwave, NW;
};

__device__ __forceinline__ void p0_transpose_item(const float* W, int N, bf16* WT, int ldt, int row_off, int koff, LAS float* scr, int item, int lane) {
    const int nblk = N / 32, kb = item / nblk, nb = item % nblk, k0 = 64 * kb, n0 = 32 * nb;
#pragma unroll 8
    for (int i = 0; i < 32; ++i) { const int kk = 2 * i + (lane >> 5); scr[kk * 33 + (lane & 31)] = W[(size_t)(k0 + kk) * N + n0 + (lane & 31)]; }
    LDS_WAIT(); asm volatile("" ::: "memory");
    const int c = lane & 7;
#pragma unroll
    for (int j = 0; j < 4; ++j) { const int n = (lane >> 3) + 8 * j; const LAS float* s = scr + (8 * c) * 33 + n;
        v4u o; o.x = pk2(s[0 * 33], s[1 * 33]); o.y = pk2(s[2 * 33], s[3 * 33]); o.z = pk2(s[4 * 33], s[5 * 33]); o.w = pk2(s[6 * 33], s[7 * 33]);
        *(GAS v4u*)(WT + (size_t)(row_off + n0 + n) * ldt + koff + k0 + 8 * c) = o; }
    LDS_WAIT(); asm volatile("" ::: "memory");
}
__device__ __forceinline__ void rms_row_to_bf16(const float* xrow, const float* w, bf16* orow, int lane) {
    const GAS f32x4* xr = (const GAS f32x4*)xrow + lane; const GAS f32x4* wr = (const GAS f32x4*)w + lane;
    f32x4 v[4]; float s = 0.f;
#pragma unroll
    for (int j = 0; j < 4; ++j) { v[j] = xr[64 * j]; s += (v[j].x * v[j].x + v[j].y * v[j].y) + (v[j].z * v[j].z + v[j].w * v[j].w); }
    const float rs = rsqrtf(wave_sum(s) * (1.f / DM) + EPS);
    GAS unsigned long long* o8 = (GAS unsigned long long*)orow + lane;
#pragma unroll
    for (int j = 0; j < 4; ++j) { const f32x4 ww = wr[64 * j]; o8[64 * j] = (unsigned long long)pk2(v[j].x * rs * ww.x, v[j].y * rs * ww.y) | ((unsigned long long)pk2(v[j].z * rs * ww.z, v[j].w * rs * ww.w) << 32); }
}
__device__ __forceinline__ void p0_prologue(Ctx& F) {
    LAS float* scr = (LAS float*)(F.lds + RING_OFF + F.wave * 16384);
    constexpr int I_IN = 16 * (NIN / 32), I_KV = 16 * 32, I_PA = 12 * 32, I_PB = 4 * 32, I_PM = 8 * 32, I_WO = 16 * 32;
    constexpr int NITEMS = I_IN + I_KV + I_PA + I_PB + I_PM + I_WO;
    for (int it = F.gwave; it < NITEMS; it += F.NW) {
        int r = it;
        if (r < I_IN) { p0_transpose_item(F.w_in, NIN, F.WIN, DM, 0, 0, scr, r, F.lane); continue; } r -= I_IN;
        if (r < I_KV) { p0_transpose_item(F.m_w_kv, 1024, F.WIN, DM, NIN, 0, scr, r, F.lane); continue; } r -= I_KV;
        if (r < I_PA) { p0_transpose_item(F.proj_a, DM, F.PCAT, KC, 0, 0, scr, r, F.lane); continue; } r -= I_PA;
        if (r < I_PB) { p0_transpose_item(F.proj_b, DM, F.PCAT, KC, 0, 768, scr, r, F.lane); continue; } r -= I_PB;
        if (r < I_PM) { p0_transpose_item(F.proj_m, DM, F.PCAT, KC, 0, 1024, scr, r, F.lane); continue; } r -= I_PM;
        p0_transpose_item(F.w_out, DM, F.WOUT, DM, 0, 0, scr, r, F.lane);
    }
    for (int i = F.gtid; i < 4 * 128 * 128; i += F.T) { const int t = (i >> 7) & 127, s = i & 127; F.WSP[i] = (bf16)(s <= t ? f2bf(F.sp_w[i]) : 0u); }
    for (int i = F.gtid; i < 3 * 4 * 132; i += F.T) { const int g = i / (4 * 132), h = (i / 132) % 4, j = i % 132; const int dil = g == 0 ? 1 : (g == 1 ? 4 : 16);
        F.BIAS[i] = j <= 128 ? F.rel_bias[t5_bucket(j * dil) * 12 + 4 * g + h] : 0.f; }
    for (int m = F.gwave; m < MTOT + MMEM; m += F.NW) {
        if (m < MTOT) rms_row_to_bf16(F.x + (size_t)m * DM, F.norm_w, F.XN + (size_t)m * DM, F.lane);
        else rms_row_to_bf16(F.mem + (size_t)(m - MTOT) * DM, F.mem_norm_w, F.XN + (size_t)m * DM, F.lane);
    }
}

__device__ __forceinline__ void st_lnstat(Ctx& F) {
    for (int r = F.gtid; r < HB_ROWS; r += F.T) {
        float s = 0.f, q = 0.f; for (int b = 0; b < 24; ++b) { s += F.SS[(size_t)r * SS_W + 2 * b]; q += F.SS[(size_t)r * SS_W + 2 * b + 1]; }
        const float mu = s * (1.f / 768.f), var = q * (1.f / 768.f) - mu * mu;
        F.LNST[2 * r] = mu; F.LNST[2 * r + 1] = rsqrtf(fmaxf(var, 0.f) + EPS); }
}
__device__ __forceinline__ void st_mixA(Ctx& F) {
    for (size_t gid = F.gtid; gid < (size_t)HB_ROWS * 768; gid += F.T) {
        const int r = (int)(gid / 768), c = (int)(gid % 768), g = c / 192, t = r & 127, r0 = r - t;
        float acc = 0.f;
        for (int s = 0; s <= t; ++s) { const float gv = bf2f(F.PA[(size_t)(r0 + s) * NIN + C_AV + c]);
            const float vv = (gv - F.LNST[2 * (r0 + s)]) * F.LNST[2 * (r0 + s) + 1] * F.lnw[c] + F.lnb[c];
            acc += bf2f(F.WSP[(g * 128 + t) * 128 + s]) * vv; }
        acc += F.sp_b[g * 128 + t];
        const float u = bf2f(F.PA[(size_t)r * NIN + C_AU + c]), z = bf2f(F.PA[(size_t)r * NIN + C_AZ + c]);
        F.YC[(size_t)r * KC + c] = (bf16)f2bf(u * acc * z); }
}
__device__ __forceinline__ void st_attnB(Ctx& F) {
    const int lane = F.lane;
    for (int w = F.gwave; w < 3 * HB_ROWS * 4; w += F.NW) {
        const int g = w / (HB_ROWS * 4), r = (w / 4) % HB_ROWS, h = w % 4, hh = 4 * g + h, dil = g == 0 ? 1 : (g == 1 ? 4 : 16), t = r % SEQ;
        const float qs = rsqrtf((F.SS[(size_t)r * SS_W + 48 + 2 * hh] + F.SS[(size_t)r * SS_W + 48 + 2 * hh + 1]) * (1.f / 64.f) + EPS);
        const float q = bf2f(F.PA[(size_t)r * NIN + C_BQ + hh * 64 + lane]) * qs * F.bqw[lane] * F.bkw[lane] * 0.125f;
        float m = -1e30f, l = 0.f, o = 0.f;
        for (int j = 0; j <= 128; ++j) { if (t - j * dil < 0) break; const int kr = r - j * dil;
            const float ks = rsqrtf((F.SS[(size_t)kr * SS_W + 72 + 2 * hh] + F.SS[(size_t)kr * SS_W + 72 + 2 * hh + 1]) * (1.f / 64.f) + EPS);
            const float s = wave_sum(q * bf2f(F.PA[(size_t)kr * NIN + C_BK + hh * 64 + lane])) * ks + F.BIAS[(g * 4 + h) * 132 + j];
            const float mn = fmaxf(m, s), a = __expf(m - mn), p = __expf(s - mn);
            l = l * a + p; o = o * a + p * bf2f(F.PA[(size_t)kr * NIN + C_BV + hh * 64 + lane]); m = mn; }
        F.OG[((size_t)g * HB_ROWS + r) * 256 + h * 64 + lane] = (bf16)f2bf(o / l);
        if (lane == 0) F.LSE[((size_t)g * HB_ROWS + r) * 4 + h] = m + __logf(l); }
}
__device__ __forceinline__ void st_mergeB(Ctx& F) {
    for (size_t gid = F.gtid; gid < (size_t)HB_ROWS * 256; gid += F.T) {
        const int r = (int)(gid / 256), c = (int)(gid % 256), h = c / 64;
        const float l0 = F.LSE[((size_t)0 * HB_ROWS + r) * 4 + h], l1 = F.LSE[((size_t)1 * HB_ROWS + r) * 4 + h], l2 = F.LSE[((size_t)2 * HB_ROWS + r) * 4 + h];
        const float mx = fmaxf(l0, fmaxf(l1, l2)), e0 = __expf(l0 - mx), e1 = __expf(l1 - mx), e2 = __expf(l2 - mx), inv = 1.f / (e0 + e1 + e2);
        const float y = (e0 * bf2f(F.OG[((size_t)0 * HB_ROWS + r) * 256 + c]) + e1 * bf2f(F.OG[((size_t)1 * HB_ROWS + r) * 256 + c]) + e2 * bf2f(F.OG[((size_t)2 * HB_ROWS + r) * 256 + c])) * inv;
        F.YC[(size_t)r * KC + 768 + c] = (bf16)f2bf(y * bf2f(F.PA[(size_t)r * NIN + C_BZ + c])); }
}
__device__ __forceinline__ void st_attnM(Ctx& F, int row_base) {
    const int lane = F.lane;
    for (int w = F.gwave; w < HB_ROWS * 4; w += F.NW) {
        const int r = w / 4, h = w % 4, b = (row_base + r) / SEQ;
        float qq = 0.f; for (int i = 0; i < 4; ++i) qq += F.SS[(size_t)r * SS_W + 96 + 4 * h + i];
        const float qs = rsqrtf(qq * (1.f / 128.f) + EPS) * 0.08838834764831845f;
        const float q0 = bf2f(F.PA[(size_t)r * NIN + C_MQ + h * 128 + lane]) * qs * F.mqw[lane] * F.mkw[lane], q1 = bf2f(F.PA[(size_t)r * NIN + C_MQ + h * 128 + 64 + lane]) * qs * F.mqw[64 + lane] * F.mkw[64 + lane];
        float m = -1e30f, l = 0.f, o0 = 0.f, o1 = 0.f;
        for (int j = 0; j < MEML; ++j) { const size_t kr = (size_t)b * MEML + j;
            float kk = 0.f; for (int i = 0; i < 4; ++i) kk += F.MKSS[kr * 16 + 4 * h + i];
            const float ks = rsqrtf(kk * (1.f / 128.f) + EPS);
            const float s = wave_sum(q0 * bf2f(F.KVM[kr * 1024 + h * 128 + lane]) + q1 * bf2f(F.KVM[kr * 1024 + h * 128 + 64 + lane])) * ks;
            const float mn = fmaxf(m, s), a = __expf(m - mn), p = __expf(s - mn);
            l = l * a + p; o0 = o0 * a + p * bf2f(F.KVM[kr * 1024 + 512 + h * 128 + lane]); o1 = o1 * a + p * bf2f(F.KVM[kr * 1024 + 512 + h * 128 + 64 + lane]); m = mn; }
        F.YC[(size_t)r * KC + 1024 + h * 128 + lane] = (bf16)f2bf(o0 / l * bf2f(F.PA[(size_t)r * NIN + C_MZ + h * 128 + lane]));
        F.YC[(size_t)r * KC + 1024 + h * 128 + 64 + lane] = (bf16)f2bf(o1 / l * bf2f(F.PA[(size_t)r * NIN + C_MZ + h * 128 + 64 + lane])); }
}

#ifndef MK_PER_PHASE
#define MK_PER_PHASE 0
#endif
constexpr int NPH_HALF = 6, NPHASES = 1 + 2 * NPH_HALF;
struct Args { const float* in[20]; float* out; unsigned char* ws; int ph_lo, ph_hi; };
__global__ void __launch_bounds__(NTHR, 2) mega_fwd(Args args) {
    extern __shared__ __attribute__((aligned(16))) unsigned char lds_raw[];
    Ctx F;
    F.lds = (LAS unsigned char*)lds_raw;
    F.tid = threadIdx.x; F.lane = F.tid & 63; F.wave = __builtin_amdgcn_readfirstlane(F.tid >> 6);
    F.G = gridDim.x; F.gtid = blockIdx.x * NTHR + F.tid; F.T = F.G * NTHR; F.gwave = blockIdx.x * NWAVES + F.wave; F.NW = F.G * NWAVES;
    unsigned char* ws = args.ws;
    F.x = args.in[0]; F.mem = args.in[1]; F.norm_w = args.in[2]; F.w_in = args.in[3]; F.gate_b = args.in[4]; F.lnw = args.in[5]; F.lnb = args.in[6]; F.sp_w = args.in[7];
    F.sp_b = args.in[8]; F.bqw = args.in[9]; F.bkw = args.in[10]; F.rel_bias = args.in[11]; F.mem_norm_w = args.in[12]; F.m_w_kv = args.in[13]; F.mqw = args.in[14]; F.mkw = args.in[15];
    F.proj_a = args.in[16]; F.proj_b = args.in[17]; F.proj_m = args.in[18]; F.w_out = args.in[19]; F.out = args.out;
    F.WIN = (bf16*)(ws + WS_WIN); F.PCAT = (bf16*)(ws + WS_PCAT); F.WOUT = (bf16*)(ws + WS_WOUT); F.WSP = (bf16*)(ws + WS_WSP); F.BIAS = (float*)(ws + WS_BIAS);
    F.XN = (bf16*)(ws + WS_XN); F.PA = (bf16*)(ws + WS_PA); F.KVM = (bf16*)(ws + WS_KVM); F.SS = (float*)(ws + WS_SS); F.MKSS = (float*)(ws + WS_MKSS);
    F.OG = (bf16*)(ws + WS_OG); F.LSE = (float*)(ws + WS_LSE); F.LNST = (float*)(ws + WS_LNST); F.YC = (bf16*)(ws + WS_YC); F.MRG = (bf16*)(ws + WS_MRG);
    for (int u = F.tid; u < (LDS_BYTES - LDSCTL_OFF) / 4; u += NTHR) ((LAS unsigned*)(F.lds + LDSCTL_OFF))[u] = 0u;
    __syncthreads();
    XcdBarrier bar; bar.bar = (unsigned*)(ws + WS_CTL) + CW_BAR; bar.x = 0; bar.st = nullptr;
    if (!MK_PER_PHASE) bar = xcd_barrier_post((unsigned*)(ws + WS_CTL) + CW_BAR, (volatile LAS unsigned*)(F.lds + MISC_OFF) + 8);
    const int lo = args.ph_lo, hi = args.ph_hi;
#define IN(k) (lo <= (k) && (k) < hi)
#define SEAM(k) do { if (IN(k) && IN((k) + 1)) xcd_barrier(bar); } while (0)

    if (IN(0)) { p0_prologue(F); } SEAM(0);
#pragma unroll 1
    for (int hb = 0; hb < 2; ++hb) {
        const int pb = 1 + hb * NPH_HALF, row0 = hb * HB_ROWS;
        asm volatile("" : "+v"(F.gtid), "+v"(F.tid), "+v"(F.lane));
        if (IN(pb + 0)) {
            pg8::Gemm g{F.XN, F.WIN, MTOT + MMEM, NIN + 1024, DM, DM, DM}; pg8::OrderG1 S; S.init(hb, F.G, (int)blockIdx.x);
            pg8::EpiProj E{F.PA, F.KVM, F.SS, F.MKSS, F.gate_b, hb * (HB_ROWS / 256), 0};
            pg8::gemm_phase<pg8::EpiProj, pg8::OrderG1, true, true>(F.lds + RING_OFF, g, S, E);
        } SEAM(pb + 0);
        if (IN(pb + 1)) { st_lnstat(F); } SEAM(pb + 1);
        if (IN(pb + 2)) { st_mixA(F); st_attnB(F); st_attnM(F, row0); } SEAM(pb + 2);
        if (IN(pb + 3)) { st_mergeB(F); } SEAM(pb + 3);
        if (IN(pb + 4)) {
            pg8::StaticOrder S; S.init(HB_ROWS, DM, F.G, (int)blockIdx.x);
            float* tmp = F.out + (size_t)row0 * DM;
            { pg8::Gemm g{F.YC, F.PCAT, HB_ROWS, DM, 768, KC, KC}; pg8::EpiG2<0> E{tmp, F.PA, F.MRG}; pg8::gemm_phase<pg8::EpiG2<0>, pg8::StaticOrder, true, true>(F.lds + RING_OFF, g, S, E); }
            { pg8::Gemm g{F.YC + 768, F.PCAT + 768, HB_ROWS, DM, 256, KC, KC}; pg8::EpiG2<1> E{tmp, F.PA, F.MRG}; pg8::gemm_phase<pg8::EpiG2<1>, pg8::StaticOrder, true, true>(F.lds + RING_OFF, g, S, E); }
            { pg8::Gemm g{F.YC + 1024, F.PCAT + 1024, HB_ROWS, DM, 512, KC, KC}; pg8::EpiG2<2> E{tmp, F.PA, F.MRG}; pg8::gemm_phase<pg8::EpiG2<2>, pg8::StaticOrder, true, true>(F.lds + RING_OFF, g, S, E); }
        } SEAM(pb + 4);
        if (IN(pb + 5)) {
            pg8::Gemm g{F.MRG, F.WOUT, HB_ROWS, DM, DM, DM, DM}; pg8::StaticOrder S; S.init(HB_ROWS, DM, F.G, (int)blockIdx.x);
            pg8::EpiG3 E{F.x + (size_t)row0 * DM, F.out + (size_t)row0 * DM};
            pg8::gemm_phase<pg8::EpiG3, pg8::StaticOrder, true, true>(F.lds + RING_OFF, g, S, E);
        } SEAM(pb + 5);
    }
#undef IN
#undef SEAM
}

extern "C" void kernel_launch(void* const* d_in, const int* in_sizes, int n_in, void* d_out, int out_size, void* d_ws, size_t ws_size, hipStream_t stream) {
    static int grid = 0;
    if (grid == 0) {
        if (n_in != 20 || in_sizes[0] != MTOT * DM || out_size != MTOT * DM || ws_size < WS_END) { fprintf(stderr, "kernel_launch: unexpected shapes (n_in %d, ws %zu); nothing launched\n", n_in, ws_size); grid = -1; return; }
        int dev = 0, cus = 0, per_cu = 0;
        if (hipGetDevice(&dev) != hipSuccess || hipDeviceGetAttribute(&cus, hipDeviceAttributeMultiprocessorCount, dev) != hipSuccess) { grid = -1; return; }
        if (hipFuncSetAttribute((const void*)mega_fwd, hipFuncAttributeMaxDynamicSharedMemorySize, LDS_BYTES) != hipSuccess) { fprintf(stderr, "kernel_launch: hipFuncSetAttribute failed\n"); grid = -1; return; }
        if (hipOccupancyMaxActiveBlocksPerMultiprocessor(&per_cu, (const void*)mega_fwd, NTHR, LDS_BYTES) != hipSuccess || per_cu < 1) { fprintf(stderr, "kernel_launch: occupancy query says %d blocks per CU\n", per_cu); (void)hipGetLastError(); grid = -1; return; }
        grid = cus;
    }
    if (grid < 0) return;
    if (hipMemsetAsync((char*)d_ws + WS_CTL, 0, CTL_ZERO_BYTES, stream) != hipSuccess) return;
    Args a{};
    for (int i = 0; i < 20; ++i) a.in[i] = (const float*)d_in[i];
    a.out = (float*)d_out; a.ws = (unsigned char*)d_ws;
#if MK_PER_PHASE
    for (int p = 0; p < NPHASES; ++p) { a.ph_lo = p; a.ph_hi = p + 1; hipLaunchKernelGGL(mega_fwd, dim3(grid), dim3(NTHR), LDS_BYTES, stream, a); }
#else
    a.ph_lo = 0; a.ph_hi = NPHASES; hipLaunchKernelGGL(mega_fwd, dim3(grid), dim3(NTHR), LDS_BYTES, stream, a);
#endif
}
```

```cpp
#include <hip/hip_runtime.h>
#include <cstdint>
#include <cstdio>

constexpr int DM = 1024, NB = 32, SEQ = 2048, MTOT = NB * SEQ;
constexpr int NIN = 8960, MEML = 256, MMEM = NB * MEML;
constexpr int HB_ROWS = MTOT / 2;
constexpr int C_AU = 0, C_AV = 768, C_AZ = 1536, C_BQ = 2304, C_BK = 3072, C_BV = 3840, C_BZ = 4608, C_MQ = 4864, C_MZ = 5376, C_G = 5888;
constexpr float EPS = 1e-6f;
constexpr int SS_W = 112;
constexpr int KC = 1536;

constexpr size_t MiB = 1u << 20;
constexpr size_t WS_CTL = 0, CTL_ZERO_BYTES = 256 * 1024, WS_WIN = 2 * MiB, WS_PCAT = 22 * MiB, WS_WOUT = 25 * MiB, WS_WSP = 27 * MiB, WS_BIAS = 27 * MiB + 512 * 1024;
constexpr size_t WS_XN = 32 * MiB, WS_PA = 176 * MiB, WS_KVM = 736 * MiB, WS_SS = 752 * MiB, WS_MKSS = 766 * MiB, WS_OG = 768 * MiB, WS_LSE = 816 * MiB, WS_LNST = 818 * MiB;
constexpr size_t WS_YC = 820 * MiB, WS_MRG = 916 * MiB, WS_END = 980 * MiB;
constexpr int CW_BAR = 4096;

namespace pg8 {
#define PG8_LAS __attribute__((address_space(3)))
typedef unsigned short bf16_t;
typedef short bf16x8 __attribute__((ext_vector_type(8)));
typedef float f32x4 __attribute__((ext_vector_type(4)));
typedef unsigned u32x4 __attribute__((ext_vector_type(4)));
constexpr int BM = 256, BK = 64, HALF = 128, HTB = HALF * BK * 2  , STAGE_BYTES = 8 * HTB, NXCD = 8, WGM = 8;

__host__ __device__ __forceinline__ int lds_byte(int r, int c) { const int st = (r >> 4) * 2 + (c >> 5), rr = r & 15, cc = c & 31, ob = rr * 64 + cc * 2; return st * 1024 + (ob ^ (((ob >> 9) & 1) << 5)); }
__host__ __device__ __forceinline__ void stage_rc(int b, int& R, int& C) { const int st = b / 1024, sb = b % 1024, swz = sb ^ (((sb >> 9) & 1) << 5); R = (st >> 1) * 16 + swz / 64; C = (st & 1) * 32 + (swz % 64) / 2; }
__host__ __device__ __forceinline__ int perm32(int rho) { const int n = rho >> 4, i = rho & 15; return 8 * (i >> 2) + 4 * n + (i & 3); }

struct Unit { int pm, pn; };
struct Gemm { const bf16_t* A; const bf16_t* Bt; int M, N, K, lda, ldb; };

struct StaticOrder {
    int nM, nN, nwg, G, c;
    __host__ __device__ void init(int M, int N, int G_, int c_) { nM = M / BM; nN = N / BM; nwg = nM * nN; G = G_; c = c_; }
    __host__ __device__ bool next(int i, Unit& u) const {
        const long L = (long)i * G + c; if (L >= nwg) return false;
        int wgid = (int)L; { const int q = nwg / NXCD, r = nwg % NXCD, xcd = wgid % NXCD, off = wgid / NXCD; wgid = (xcd < r ? xcd * (q + 1) : r * (q + 1) + (xcd - r) * q) + off; }
        const int nig = WGM * nN, gid = wgid / nig, fm = gid * WGM, gsz = (nM - fm) < WGM ? (nM - fm) : WGM;
        u.pm = fm + ((wgid % nig) % gsz); u.pn = (wgid % nig) / gsz; return true;
    }
    __device__ __forceinline__ void a_ready(const Unit&) const {}
    __device__ __forceinline__ void done(const Unit&) const {}
};


__device__ __forceinline__ unsigned cvt_pk_bf16(float lo, float hi) { unsigned r; asm volatile("v_cvt_pk_bf16_f32 %0, %1, %2" : "=v"(r) : "v"(lo), "v"(hi)); return r; }
typedef float f32x2 __attribute__((ext_vector_type(2)));
__device__ __forceinline__ f32x2 gelu_pk(f32x2 v) {
    const f32x2 av = __builtin_elementwise_abs(v), d = av * 0.2316418882f + 1.0f;
    f32x2 t; t.x = __builtin_amdgcn_rcpf(d.x); t.y = __builtin_amdgcn_rcpf(d.y);
    f32x2 q = t * 0.5307027145f + (-0.7265760135f); q = q * t + 0.7107068705f; q = q * t + (-0.142248368f); q = q * t + 0.127414796f; q = q * t;
    const f32x2 s = (v * v) * (-0.72134752044f);
    f32x2 e; e.x = __builtin_amdgcn_exp2f(s.x); e.y = __builtin_amdgcn_exp2f(s.y);
    const f32x2 m = v * (q * e), r = v - m;
    f32x2 o; o.x = v.x < 0.f ? m.x : r.x; o.y = v.y < 0.f ? m.y : r.y; return o;
}

template <class Epi, class Sched, bool ALIGN_EPI = false, bool SP2 = false>
__device__ __forceinline__ void gemm_phase(PG8_LAS unsigned char* lds, const Gemm g, const Sched& S, const Epi& E) {
    int tid = threadIdx.x; asm volatile("" : "+v"(tid));
    const int wid = __builtin_amdgcn_readfirstlane(tid >> 6), lane = tid & 63, wr = wid >> 2, wc = wid & 3, fr = lane & 15, fq = lane >> 4;
    int K = g.K; asm volatile("" : "+s"(K)); const int nt = K / BK;
    unsigned voffA[2], voffB[2];
#pragma unroll
    for (int i = 0; i < 2; ++i) { int R, C; stage_rc(tid * 16 + i * 8192, R, C); const int Rb = Epi::PERM ? ((R & ~31) + perm32(R & 31)) : R;
        voffA[i] = (unsigned)(R * g.lda + C) * 2u; voffB[i] = (unsigned)(Rb * g.ldb + C) * 2u; }
    const size_t kstep = (size_t)(BK * 2);
    const size_t hstepA = (size_t)HALF * g.lda * 2, hstepB = (size_t)HALF * g.ldb * 2;
    const size_t tstepA = 2 * hstepA, tstepB = 2 * hstepB;
    const unsigned ldsw = (unsigned)wid * 1024u;
    const int aoff = lds_byte(wr * 64 + fr, fq * 8), boff = lds_byte(wc * 32 + fr, fq * 8);
#define PG8_SA(b, h) (((b) * 2 + (h)) * HTB)
#define PG8_SB(b, h) ((4 + (b) * 2 + (h)) * HTB)
#define PG8_STAGE(bufoff, gbase, voff) do { _Pragma("unroll") for (int _i = 0; _i < 2; ++_i) \
        __builtin_amdgcn_global_load_lds((const unsigned*)((const char*)(gbase) + (voff)[_i]), (PG8_LAS unsigned*)(lds + (bufoff) + ldsw + _i * 8192), 16, 0, 0); } while (0)
#define PG8_LDA(dst, b, h) do { _Pragma("unroll") for (int m = 0; m < 4; ++m) _Pragma("unroll") for (int k = 0; k < 2; ++k) dst[m][k] = *(const PG8_LAS bf16x8*)(lds + PG8_SA(b, h) + aoff + m * 2048 + k * 1024); } while (0)
#define PG8_LDB(dst, b, h) do { _Pragma("unroll") for (int n = 0; n < 2; ++n) _Pragma("unroll") for (int k = 0; k < 2; ++k) dst[n][k] = *(const PG8_LAS bf16x8*)(lds + PG8_SB(b, h) + boff + n * 2048 + k * 1024); } while (0)
#define PG8_MMA(ai, bj, At, Bt) do { __builtin_amdgcn_s_setprio(1); _Pragma("unroll") for (int m = 0; m < 4; ++m) _Pragma("unroll") for (int n = 0; n < 2; ++n) _Pragma("unroll") for (int k = 0; k < 2; ++k) \
        acc[ai][bj][m][n] = __builtin_amdgcn_mfma_f32_16x16x32_bf16(Bt[n][k], At[m][k], acc[ai][bj][m][n], 0, 0, 0); __builtin_amdgcn_s_setprio(0); } while (0)
#define PG8_WAIT_V(n) asm volatile("s_waitcnt vmcnt(" #n ")" ::: "memory")
#define PG8_WAIT_L(n) asm volatile("s_waitcnt lgkmcnt(" #n ")" ::: "memory")
#define PG8_BAR __builtin_amdgcn_s_barrier()
#define PG8_SCHED __builtin_amdgcn_sched_barrier(0)
    Unit cur, nxt; int ui = 0;
    if (!S.next(0, cur)) return;
    f32x4 acc[2][2][4][2];
#pragma unroll
    for (int a = 0; a < 2; ++a)
#pragma unroll
        for (int b = 0; b < 2; ++b)
#pragma unroll
            for (int m = 0; m < 4; ++m)
#pragma unroll
                for (int n = 0; n < 2; ++n) acc[a][b][m][n] = (f32x4){0.f, 0.f, 0.f, 0.f};
    bf16x8 At[4][2], B0[2][2], B1[2][2];
    const char* cA = (const char*)g.A + (size_t)cur.pm * tstepA; const char* cB = (const char*)g.Bt + (size_t)cur.pn * tstepB;
    S.a_ready(cur);
    if constexpr (SP2) {
        PG8_STAGE(PG8_SB(0, 0), cB, voffB); PG8_STAGE(PG8_SB(0, 1), cB + hstepB, voffB); PG8_STAGE(PG8_SA(0, 0), cA, voffA); PG8_STAGE(PG8_SA(0, 1), cA + hstepA, voffA);
        if (wr == 1) PG8_BAR;
        PG8_WAIT_V(2); PG8_BAR;
        PG8_STAGE(PG8_SB(1, 0), cB + kstep, voffB); PG8_STAGE(PG8_SA(1, 0), cA + kstep, voffA); PG8_STAGE(PG8_SB(1, 1), cB + hstepB + kstep, voffB);
        PG8_WAIT_V(6); PG8_BAR;
    } else {
        PG8_STAGE(PG8_SB(0, 0), cB, voffB); PG8_STAGE(PG8_SA(0, 0), cA, voffA); PG8_STAGE(PG8_SB(0, 1), cB + hstepB, voffB); PG8_STAGE(PG8_SA(0, 1), cA + hstepA, voffA);
        if (wr == 1) PG8_BAR;
        PG8_WAIT_V(4); PG8_BAR;
        PG8_STAGE(PG8_SB(1, 0), cB + kstep, voffB); PG8_STAGE(PG8_SA(1, 0), cA + kstep, voffA); PG8_STAGE(PG8_SB(1, 1), cB + hstepB + kstep, voffB);
        PG8_WAIT_V(6); PG8_BAR;
    }
    for (;;) {
        const bool has_next = S.next(ui + 1, nxt);
        const char* nA = has_next ? (const char*)g.A + (size_t)nxt.pm * tstepA : cA; const char* nB = has_next ? (const char*)g.Bt + (size_t)nxt.pn * tstepB : cB;
        for (int t = 0; t < nt; t += 2) {
            const bool last = (t == nt - 2);
            const char* a1 = cA + (size_t)(t + 1) * kstep;
            const char* a2 = last ? nA : cA + (size_t)(t + 2) * kstep; const char* b2 = last ? nB : cB + (size_t)(t + 2) * kstep;
            const char* a3 = a2 + kstep; const char* b3 = b2 + kstep;
            if (last && has_next) S.a_ready(nxt);
            if constexpr (SP2) {
            PG8_LDB(B0, 0, 0); PG8_LDB(B1, 0, 1); PG8_SCHED; PG8_LDA(At, 0, 0); PG8_STAGE(PG8_SA(1, 1), a1 + hstepA, voffA);
            PG8_WAIT_V(8); PG8_WAIT_L(0); PG8_BAR; PG8_MMA(0, 0, At, B0); PG8_MMA(0, 1, At, B1); PG8_BAR; PG8_SCHED;
            PG8_LDA(At, 0, 1); PG8_STAGE(PG8_SB(0, 0), b2, voffB); PG8_STAGE(PG8_SB(0, 1), b2 + hstepB, voffB); PG8_STAGE(PG8_SA(0, 0), a2, voffA);
            PG8_WAIT_V(8); PG8_WAIT_L(0); PG8_BAR; PG8_MMA(1, 0, At, B0); PG8_MMA(1, 1, At, B1); PG8_BAR; PG8_SCHED;
            PG8_LDB(B0, 1, 0); PG8_LDB(B1, 1, 1); PG8_SCHED; PG8_LDA(At, 1, 0); PG8_STAGE(PG8_SA(0, 1), a2 + hstepA, voffA);
            PG8_WAIT_V(8); PG8_WAIT_L(0); PG8_BAR; PG8_MMA(0, 0, At, B0); PG8_MMA(0, 1, At, B1); PG8_BAR; PG8_SCHED;
            PG8_LDA(At, 1, 1); PG8_STAGE(PG8_SB(1, 0), b3, voffB); PG8_STAGE(PG8_SB(1, 1), b3 + hstepB, voffB); PG8_STAGE(PG8_SA(1, 0), a3, voffA);
            PG8_WAIT_V(8); PG8_WAIT_L(0); PG8_BAR; PG8_MMA(1, 0, At, B0); PG8_MMA(1, 1, At, B1); PG8_BAR; PG8_SCHED;
            } else {
            PG8_LDB(B0, 0, 0); PG8_SCHED; PG8_LDA(At, 0, 0); PG8_STAGE(PG8_SA(1, 1), a1 + hstepA, voffA);
            PG8_WAIT_L(8); PG8_BAR; PG8_WAIT_L(0); PG8_MMA(0, 0, At, B0); PG8_BAR; PG8_SCHED;
            PG8_LDB(B1, 0, 1); PG8_STAGE(PG8_SB(0, 0), b2, voffB);
            PG8_BAR; PG8_WAIT_L(0); PG8_MMA(0, 1, At, B1); PG8_BAR;
            PG8_LDA(At, 0, 1); PG8_STAGE(PG8_SA(0, 0), a2, voffA);
            PG8_BAR; PG8_WAIT_L(0); PG8_MMA(1, 0, At, B0); PG8_BAR; PG8_SCHED;
            PG8_STAGE(PG8_SB(0, 1), b2 + hstepB, voffB);
            PG8_WAIT_V(6); PG8_BAR; PG8_MMA(1, 1, At, B1); PG8_BAR;
            PG8_LDB(B0, 1, 0); PG8_SCHED; PG8_LDA(At, 1, 0); PG8_STAGE(PG8_SA(0, 1), a2 + hstepA, voffA);
            PG8_WAIT_L(8); PG8_BAR; PG8_WAIT_L(0); PG8_MMA(0, 0, At, B0); PG8_BAR; PG8_SCHED;
            PG8_LDB(B1, 1, 1); PG8_STAGE(PG8_SB(1, 0), b3, voffB);
            PG8_BAR; PG8_WAIT_L(0); PG8_MMA(0, 1, At, B1); PG8_BAR;
            PG8_LDA(At, 1, 1); PG8_STAGE(PG8_SA(1, 0), a3, voffA);
            PG8_BAR; PG8_WAIT_L(0); PG8_MMA(1, 0, At, B0); PG8_BAR; PG8_SCHED;
            PG8_STAGE(PG8_SB(1, 1), b3 + hstepB, voffB);
            PG8_WAIT_V(6); PG8_BAR; PG8_MMA(1, 1, At, B1); PG8_BAR;
            }
        }
        if constexpr (ALIGN_EPI) { if (wr == 0) PG8_BAR; }
        if constexpr (!Epi::AFTER_DRAIN) { E(acc, cur, wr, wc, fr, fq); S.done(cur); }
        if (!has_next) break;
#pragma unroll
        for (int a = 0; a < 2; ++a)
#pragma unroll
            for (int b = 0; b < 2; ++b)
#pragma unroll
                for (int m = 0; m < 4; ++m)
#pragma unroll
                    for (int n = 0; n < 2; ++n) acc[a][b][m][n] = (f32x4){0.f, 0.f, 0.f, 0.f};
        cur = nxt; cA = nA; cB = nB; ++ui;
        if constexpr (ALIGN_EPI) { if (wr == 1) PG8_BAR; }
    }
    PG8_WAIT_V(0);
    if constexpr (!ALIGN_EPI) { if (wr == 0) PG8_BAR; }
    PG8_BAR;
    if constexpr (Epi::AFTER_DRAIN) { E.fused(acc, cur, wr, wc, fr, fq, lds, wid, lane); S.done(cur); }
#undef PG8_SA
#undef PG8_SB
#undef PG8_STAGE
#undef PG8_LDA
#undef PG8_LDB
#undef PG8_MMA
#undef PG8_WAIT_V
#undef PG8_WAIT_L
#undef PG8_BAR
#undef PG8_SCHED
}
}

namespace pg8 {
__device__ __forceinline__ float ex2(float x) { return __builtin_amdgcn_exp2f(x); }
__device__ __forceinline__ float sigm_fast(float x) { return __builtin_amdgcn_rcpf(1.0f + ex2(x * -1.4426950408889634f)); }
struct EpiProj {
    static constexpr bool PERM = true, AFTER_DRAIN = false;
    bf16_t* PA; bf16_t* KVM; float* SS; float* MKSS; const float* gate_b; int pm0; int pad;
    __device__ __forceinline__ void operator()(const f32x4 (&acc)[2][2][4][2], const Unit& u, int wr, int wc, int fr, int fq) const {
        const bool kv = u.pn >= 35; const int pn = kv ? u.pn - 35 : u.pn;
        const int rowt = kv ? (u.pm - 256) * BM : (u.pm - pm0) * BM;
        bf16_t* base = kv ? KVM : PA; const int ldc = kv ? 1024 : NIN;
        int kind = 0, stat = 0, so = 0; float* sb = SS; int sld = SS_W;
        if (kv) { sb = MKSS; sld = 16; if (pn < 2) { stat = 1; so = 8 * pn; } }
        else if (pn < 3) kind = 1;
        else if (pn < 6) { kind = 1; stat = 2; so = 16 * (pn - 3); }
        else if (pn < 9) kind = 2;
        else if (pn < 12) { stat = 1; so = 48 + 8 * (pn - 9); }
        else if (pn < 15) { stat = 1; so = 72 + 8 * (pn - 12); }
        else if (pn < 18) kind = 0;
        else if (pn < 19) kind = 2;
        else if (pn < 21) { stat = 1; so = 96 + 8 * (pn - 19); }
        else if (pn < 23) kind = 2;
        else kind = 3;
        const int row0 = rowt + wr * 64 + fr, col0 = pn * BM + wc * 32 + 8 * fq;
        f32x4 bv[2][2];
#pragma unroll
        for (int bj = 0; bj < 2; ++bj)
#pragma unroll
            for (int n = 0; n < 2; ++n) bv[bj][n] = (kind == 3) ? *(const f32x4*)(gate_b + (col0 - 23 * BM) + bj * HALF + 4 * n) : (f32x4){0.f, 0.f, 0.f, 0.f};
#pragma unroll
        for (int ai = 0; ai < 2; ++ai)
#pragma unroll
            for (int m = 0; m < 4; ++m) { const int row = row0 + ai * HALF + m * 16; bf16_t* rowp = base + (size_t)row * ldc + col0;
#pragma unroll
                for (int bj = 0; bj < 2; ++bj) { f32x4 v0 = acc[ai][bj][m][0], v1 = acc[ai][bj][m][1];
                    if (kind == 1) { f32x2 a = gelu_pk((f32x2){v0[0], v0[1]}), b = gelu_pk((f32x2){v0[2], v0[3]}), c = gelu_pk((f32x2){v1[0], v1[1]}), d = gelu_pk((f32x2){v1[2], v1[3]});
                        v0 = (f32x4){a.x, a.y, b.x, b.y}; v1 = (f32x4){c.x, c.y, d.x, d.y}; }
                    else if (kind == 2) {
#pragma unroll
                        for (int j = 0; j < 4; ++j) { v0[j] = v0[j] * sigm_fast(v0[j]); v1[j] = v1[j] * sigm_fast(v1[j]); } }
                    else if (kind == 3) { v0 = v0 + bv[bj][0]; v1 = v1 + bv[bj][1];
#pragma unroll
                        for (int j = 0; j < 4; ++j) { v0[j] = sigm_fast(v0[j]); v1[j] = sigm_fast(v1[j]); } }
                    if (stat) {
                        float s = ((v0[0] + v0[1]) + (v0[2] + v0[3])) + ((v1[0] + v1[1]) + (v1[2] + v1[3]));
                        float q = ((v0[0] * v0[0] + v0[1] * v0[1]) + (v0[2] * v0[2] + v0[3] * v0[3])) + ((v1[0] * v1[0] + v1[1] * v1[1]) + (v1[2] * v1[2] + v1[3] * v1[3]));
                        s += __shfl_xor(s, 16); s += __shfl_xor(s, 32); q += __shfl_xor(q, 16); q += __shfl_xor(q, 32);
                        if (fq == 0) { float* sp = sb + (size_t)row * sld + so; const int blk = 4 * bj + wc;
                            if (stat == 2) { sp[2 * blk] = s; sp[2 * blk + 1] = q; } else sp[blk] = q; }
                    }
                    u32x4 w; w.x = cvt_pk_bf16(v0[0], v0[1]); w.y = cvt_pk_bf16(v0[2], v0[3]); w.z = cvt_pk_bf16(v1[0], v1[1]); w.w = cvt_pk_bf16(v1[2], v1[3]);
                    *(u32x4*)(rowp + bj * HALF) = w; } }
    }
};
template <int BR> struct EpiG2 {
    static constexpr bool PERM = false, AFTER_DRAIN = false;
    float* tmp; const bf16_t* PA; bf16_t* MRG;
    __device__ __forceinline__ void operator()(const f32x4 (&acc)[2][2][4][2], const Unit& u, int wr, int wc, int fr, int fq) const {
        typedef unsigned u32x2v __attribute__((ext_vector_type(2)));
        const int row0 = u.pm * BM + wr * 64 + fr, col0 = u.pn * BM + wc * 32 + 4 * fq;
#pragma unroll
        for (int ai = 0; ai < 2; ++ai)
#pragma unroll
            for (int m = 0; m < 4; ++m) { const size_t row = (size_t)(row0 + ai * HALF + m * 16);
                const bf16_t* gp = PA + row * NIN + C_G + BR * DM + col0; float* tp = tmp + row * DM + col0; bf16_t* mp = MRG + row * DM + col0;
#pragma unroll
                for (int bj = 0; bj < 2; ++bj)
#pragma unroll
                    for (int n = 0; n < 2; ++n) { const int co = bj * HALF + n * 16;
                        const u32x2v gw = *(const u32x2v*)(gp + co);
                        f32x4 g; g[0] = __uint_as_float(gw.x << 16); g[1] = __uint_as_float(gw.x & 0xffff0000u); g[2] = __uint_as_float(gw.y << 16); g[3] = __uint_as_float(gw.y & 0xffff0000u);
                        f32x4 v = g * acc[ai][bj][m][n];
                        if (BR == 0) *(f32x4*)(tp + co) = v;
                        else if (BR == 1) *(f32x4*)(tp + co) = *(const f32x4*)(tp + co) + v;
                        else { v = *(const f32x4*)(tp + co) + v; u32x2v w; w.x = cvt_pk_bf16(v[0], v[1]); w.y = cvt_pk_bf16(v[2], v[3]); *(u32x2v*)(mp + co) = w; } }
                asm volatile("" ::: "memory"); }
    }
};
struct EpiG3 {
    static constexpr bool PERM = false, AFTER_DRAIN = false;
    const float* x; float* out;
    __device__ __forceinline__ void operator()(const f32x4 (&acc)[2][2][4][2], const Unit& u, int wr, int wc, int fr, int fq) const {
        const int row0 = u.pm * BM + wr * 64 + fr, col0 = u.pn * BM + wc * 32 + 4 * fq;
#pragma unroll
        for (int ai = 0; ai < 2; ++ai)
#pragma unroll
            for (int m = 0; m < 4; ++m) { const size_t off = (size_t)(row0 + ai * HALF + m * 16) * DM + col0;
#pragma unroll
                for (int bj = 0; bj < 2; ++bj)
#pragma unroll
                    for (int n = 0; n < 2; ++n) *(f32x4*)(out + off + bj * HALF + n * 16) = *(const f32x4*)(x + off + bj * HALF + n * 16) + acc[ai][bj][m][n];
                asm volatile("" ::: "memory"); }
    }
};
struct OrderG1 {
    StaticOrder so; int pm0, nkv;
    __device__ void init(int hb, int G, int c) { so.init(HB_ROWS, NIN, G, c); pm0 = hb * (HB_ROWS / BM); nkv = hb == 0 ? (MMEM / BM) * 4 : 0; }
    __device__ bool next(int i, Unit& u) const {
        if (so.next(i, u)) { u.pm += pm0; return true; }
        const long j = (long)i * so.G + so.c - so.nwg; if (j < 0 || j >= nkv) return false;
        u.pm = 256 + (int)(j >> 2); u.pn = 35 + (int)(j & 3); return true;
    }
    __device__ __forceinline__ void a_ready(const Unit&) const {}
    __device__ __forceinline__ void done(const Unit&) const {}
};
}

#define GAS __attribute__((address_space(1)))
#define LAS __attribute__((address_space(3)))
typedef unsigned short bf16;
typedef unsigned v4u __attribute__((ext_vector_type(4)));
typedef float f32x4 __attribute__((ext_vector_type(4)));
typedef short bf16x8 __attribute__((ext_vector_type(8)));
typedef GAS unsigned gu32;
typedef GAS unsigned long long gu64;
#define RLX_AGENT __ATOMIC_RELAXED, __HIP_MEMORY_SCOPE_AGENT
#define LDS_WAIT() asm volatile("s_waitcnt lgkmcnt(0)" ::: "memory")
#define VM_WAIT() asm volatile("s_waitcnt vmcnt(0)" ::: "memory")
__device__ __forceinline__ unsigned long long rt() { return __builtin_amdgcn_s_memrealtime(); }
__device__ __forceinline__ unsigned f2bf(float f) { unsigned u = __builtin_bit_cast(unsigned, f); return (u + 0x7fffu + ((u >> 16) & 1u)) >> 16; }
__device__ __forceinline__ unsigned pk2(float lo, float hi) { return f2bf(lo) | (f2bf(hi) << 16); }

#define XB_TMO      128
#define XB_XCNT(j)  (256  + 64 * (j))
#define XB_XSUB(j)  (1280 + 64 * (j))
#define XB_XGEN(j)  (2304 + 64 * (j))
#define XB_TOP      3328
#define XB_TOPGEN   3392
#define XCD_BAR_WORDS 3456
#define XB_SPIN_CAP (1u << 18)

__device__ __forceinline__ unsigned xb_ld(unsigned* p)              { return __hip_atomic_load(p, __ATOMIC_RELAXED, __HIP_MEMORY_SCOPE_AGENT); }
__device__ __forceinline__ unsigned xb_add(unsigned* p, unsigned v) { return __hip_atomic_fetch_add(p, v, __ATOMIC_RELAXED, __HIP_MEMORY_SCOPE_AGENT); }
__device__ __forceinline__ unsigned xb_xcc_id() { return (unsigned)__builtin_amdgcn_s_getreg((3 << 11) | 20) & 0xFu; }
#define XB_SPIN(cond, bar) do { unsigned _sp = 0; while (cond) { __builtin_amdgcn_s_sleep(1); \
    if ((++_sp & 255u) == 0u) { if (xb_ld(&(bar)[XB_TMO])) break; if (_sp > XB_SPIN_CAP) { atomicAdd(&(bar)[XB_TMO], 1u); break; } } } } while (0)

struct XcdBarrier {
    unsigned* bar; unsigned x;
    volatile LAS unsigned* st;
};

__device__ __forceinline__ XcdBarrier xcd_barrier_post(unsigned* bar, volatile LAS unsigned* st) {
    XcdBarrier b; b.bar = bar; b.x = xb_xcc_id(); b.st = st;
    if (threadIdx.x == 0) (void)xb_add(&bar[XB_XCNT(b.x)], 1u);
    return b;
}
__device__ __forceinline__ void xcd_barrier_complete(unsigned* bar, unsigned x, unsigned& nloc, unsigned& nx) {
    const unsigned G = gridDim.x * gridDim.y * gridDim.z;
    unsigned sum, cnt, mine, sp = 0u;
    for (;;) {
        sum = 0u; cnt = 0u; mine = 0u;
#pragma unroll
        for (unsigned j = 0; j < 16; ++j) { const unsigned c = xb_ld(&bar[XB_XCNT(j)]); sum += c; cnt += (c > 0u) ? 1u : 0u; mine = (j == x) ? c : mine; }
        if (sum == G) break;
        __builtin_amdgcn_s_sleep(1);
        if ((++sp & 255u) == 0u) { if (xb_ld(&bar[XB_TMO])) break; if (sp > XB_SPIN_CAP) { atomicAdd(&bar[XB_TMO], 1u); break; } }
    }
    nloc = mine > 0u ? mine : 1u; nx = cnt > 0u ? cnt : 1u;
}

__device__ __forceinline__ void xcd_barrier(const XcdBarrier& b) {
    asm volatile("s_waitcnt vmcnt(0)" ::: "memory");
    __syncthreads();
    if (threadIdx.x == 0) {
        unsigned* bar = b.bar;
        __builtin_amdgcn_s_waitcnt(0);
        unsigned nloc = b.st[0], nx = b.st[1];
        if (nloc == 0u) { xcd_barrier_complete(bar, b.x, nloc, nx); b.st[0] = nloc; b.st[1] = nx; }
        const unsigned old = xb_add(&bar[XB_XSUB(b.x)], 1u);
        const unsigned gen = old / nloc;
        if (old + 1u == (gen + 1u) * nloc) {
            __builtin_amdgcn_fence(__ATOMIC_RELEASE, "agent");
            asm volatile("s_waitcnt vmcnt(0)" ::: "memory");
            const unsigned og = xb_add(&bar[XB_TOP], 1u);
            const unsigned tg = og / nx;
            if (og + 1u == (tg + 1u) * nx) xb_add(&bar[XB_TOPGEN], 1u);
            else XB_SPIN(xb_ld(&bar[XB_TOPGEN]) == tg, bar);
            __builtin_amdgcn_fence(__ATOMIC_ACQUIRE, "agent");
            xb_add(&bar[XB_XGEN(b.x)], 1u);
            asm volatile("s_waitcnt vmcnt(0)" ::: "memory");
        } else {
            XB_SPIN(xb_ld(&bar[XB_XGEN(b.x)]) == gen, bar);
            __builtin_amdgcn_fence(__ATOMIC_ACQUIRE, "agent");
            asm volatile("s_waitcnt vmcnt(0)" ::: "memory");
        }
    }
    __syncthreads();
}

__device__ __forceinline__ float wave_sum(float v) {
#pragma unroll
    for (int o = 1; o < 64; o <<= 1) v += __shfl_xor(v, o);
    return v;
}

constexpr int RING_OFF = 0, RING_BYTES = 131072;
constexpr int LDSCTL_OFF = RING_BYTES, MISC_OFF = LDSCTL_OFF + 320;
constexpr int LDS_BYTES = 147456;
constexpr int NWAVES = 8, NTHR = NWAVES * 64;

__device__ __forceinline__ float bf2f(bf16 h) { return __builtin_bit_cast(float, (unsigned)h << 16); }
__device__ __forceinline__ float sigm_f(float x) { return 1.f / (1.f + __expf(-x)); }
__device__ __forceinline__ int t5_bucket(int d) {
    if (d < 16) return d;
    int b = 16;
    b += d >= 22; b += d >= 30; b += d >= 40; b += d >= 54; b += d >= 73; b += d >= 99; b += d >= 134; b += d >= 182; b += d >= 246; b += d >= 332; b += d >= 450; b += d >= 609; b += d >= 825; b += d >= 1117; b += d >= 1513;
    return b;
}

struct Ctx {
    const float *x, *mem, *norm_w, *w_in, *gate_b, *lnw, *lnb, *sp_w, *sp_b, *bqw, *bkw, *rel_bias, *mem_norm_w, *m_w_kv, *mqw, *mkw, *proj_a, *proj_b, *proj_m, *w_out;
    float* out;
    bf16 *WIN, *PCAT, *WOUT, *WSP, *XN, *PA, *KVM, *OG, *YC, *MRG; float *BIAS, *BIASX, *SS, *MKSS, *LSE, *LNST;
    LAS unsigned char* lds; int tid, lane, wave, G, gtid, T, gwave, NW;
};

__device__ __forceinline__ void p0_transpose_item(const float* W, int N, bf16* WT, int ldt, int row_off, int koff, LAS float* scr, int item, int lane) {
    const int nblk = N / 32, kb = item / nblk, nb = item % nblk, k0 = 64 * kb, n0 = 32 * nb;
#pragma unroll 8
    for (int i = 0; i < 32; ++i) { const int kk = 2 * i + (lane >> 5); scr[kk * 33 + (lane & 31)] = W[(size_t)(k0 + kk) * N + n0 + (lane & 31)]; }
    LDS_WAIT(); asm volatile("" ::: "memory");
    const int c = lane & 7;
#pragma unroll
    for (int j = 0; j < 4; ++j) { const int n = (lane >> 3) + 8 * j; const LAS float* s = scr + (8 * c) * 33 + n;
        v4u o; o.x = pk2(s[0 * 33], s[1 * 33]); o.y = pk2(s[2 * 33], s[3 * 33]); o.z = pk2(s[4 * 33], s[5 * 33]); o.w = pk2(s[6 * 33], s[7 * 33]);
        *(GAS v4u*)(WT + (size_t)(row_off + n0 + n) * ldt + koff + k0 + 8 * c) = o; }
    LDS_WAIT(); asm volatile("" ::: "memory");
}
__device__ __forceinline__ void rms_row_to_bf16(const float* xrow, const float* w, bf16* orow, int lane) {
    const GAS f32x4* xr = (const GAS f32x4*)xrow + lane; const GAS f32x4* wr = (const GAS f32x4*)w + lane;
    f32x4 v[4]; float s = 0.f;
#pragma unroll
    for (int j = 0; j < 4; ++j) { v[j] = xr[64 * j]; s += (v[j].x * v[j].x + v[j].y * v[j].y) + (v[j].z * v[j].z + v[j].w * v[j].w); }
    const float rs = rsqrtf(wave_sum(s) * (1.f / DM) + EPS);
    GAS unsigned long long* o8 = (GAS unsigned long long*)orow + lane;
#pragma unroll
    for (int j = 0; j < 4; ++j) { const f32x4 ww = wr[64 * j]; o8[64 * j] = (unsigned long long)pk2(v[j].x * rs * ww.x, v[j].y * rs * ww.y) | ((unsigned long long)pk2(v[j].z * rs * ww.z, v[j].w * rs * ww.w) << 32); }
}
__device__ __forceinline__ void p0_prologue(Ctx& F) {
    LAS float* scr = (LAS float*)(F.lds + RING_OFF + F.wave * 16384);
    constexpr int I_IN = 16 * (NIN / 32), I_KV = 16 * 32, I_PA = 12 * 32, I_PB = 4 * 32, I_PM = 8 * 32, I_WO = 16 * 32;
    constexpr int NITEMS = I_IN + I_KV + I_PA + I_PB + I_PM + I_WO;
    for (int it = F.gwave; it < NITEMS; it += F.NW) {
        int r = it;
        if (r < I_IN) { p0_transpose_item(F.w_in, NIN, F.WIN, DM, 0, 0, scr, r, F.lane); continue; } r -= I_IN;
        if (r < I_KV) { p0_transpose_item(F.m_w_kv, 1024, F.WIN, DM, NIN, 0, scr, r, F.lane); continue; } r -= I_KV;
        if (r < I_PA) { p0_transpose_item(F.proj_a, DM, F.PCAT, KC, 0, 0, scr, r, F.lane); continue; } r -= I_PA;
        if (r < I_PB) { p0_transpose_item(F.proj_b, DM, F.PCAT, KC, 0, 768, scr, r, F.lane); continue; } r -= I_PB;
        if (r < I_PM) { p0_transpose_item(F.proj_m, DM, F.PCAT, KC, 0, 1024, scr, r, F.lane); continue; } r -= I_PM;
        p0_transpose_item(F.w_out, DM, F.WOUT, DM, 0, 0, scr, r, F.lane);
    }
    for (int i = F.gtid; i < 4 * 128 * 128; i += F.T) { const int t = (i >> 7) & 127, s = i & 127; F.WSP[i] = (bf16)(s <= t ? f2bf(F.sp_w[i]) : 0u); }
    for (int i = F.gtid; i < 3 * 4 * 132; i += F.T) { const int g = i / (4 * 132), h = (i / 132) % 4, j = i % 132; const int dil = g == 0 ? 1 : (g == 1 ? 4 : 16);
        F.BIAS[i] = j <= 128 ? F.rel_bias[t5_bucket(j * dil) * 12 + 4 * g + h] : 0.f; }
    for (int i = F.gtid; i < 3 * 4 * 192; i += F.T) { const int g = i / (4 * 192), h = (i / 192) % 4, step = i % 192 - 31; const int dil = g == 0 ? 1 : (g == 1 ? 4 : 16);
        F.BIASX[i] = (step >= 0 && step <= 128) ? F.rel_bias[t5_bucket(step * dil) * 12 + 4 * g + h] * 1.4426950408889634f : -1e30f; }
    for (int m = F.gwave; m < MTOT + MMEM; m += F.NW) {
        if (m < MTOT) rms_row_to_bf16(F.x + (size_t)m * DM, F.norm_w, F.XN + (size_t)m * DM, F.lane);
        else rms_row_to_bf16(F.mem + (size_t)(m - MTOT) * DM, F.mem_norm_w, F.XN + (size_t)m * DM, F.lane);
    }
}

__device__ __forceinline__ void st_lnstat(Ctx& F) {
    for (int r = F.gtid; r < HB_ROWS; r += F.T) {
        float s = 0.f, q = 0.f; for (int b = 0; b < 24; ++b) { s += F.SS[(size_t)r * SS_W + 2 * b]; q += F.SS[(size_t)r * SS_W + 2 * b + 1]; }
        const float mu = s * (1.f / 768.f), var = q * (1.f / 768.f) - mu * mu;
        F.LNST[2 * r] = mu; F.LNST[2 * r + 1] = rsqrtf(fmaxf(var, 0.f) + EPS); }
}
__device__ __forceinline__ void st_mixA(Ctx& F) {
    for (size_t gid = F.gtid; gid < (size_t)HB_ROWS * 768; gid += F.T) {
        const int r = (int)(gid / 768), c = (int)(gid % 768), g = c / 192, t = r & 127, r0 = r - t;
        float acc = 0.f;
        for (int s = 0; s <= t; ++s) { const float gv = bf2f(F.PA[(size_t)(r0 + s) * NIN + C_AV + c]);
            const float vv = (gv - F.LNST[2 * (r0 + s)]) * F.LNST[2 * (r0 + s) + 1] * F.lnw[c] + F.lnb[c];
            acc += bf2f(F.WSP[(g * 128 + t) * 128 + s]) * vv; }
        acc += F.sp_b[g * 128 + t];
        const float u = bf2f(F.PA[(size_t)r * NIN + C_AU + c]), z = bf2f(F.PA[(size_t)r * NIN + C_AZ + c]);
        F.YC[(size_t)r * KC + c] = (bf16)f2bf(u * acc * z); }
}
__device__ __forceinline__ void st_attnB(Ctx& F) {
    const int lane = F.lane;
    for (int w = F.gwave; w < 3 * HB_ROWS * 4; w += F.NW) {
        const int g = w / (HB_ROWS * 4), r = (w / 4) % HB_ROWS, h = w % 4, hh = 4 * g + h, dil = g == 0 ? 1 : (g == 1 ? 4 : 16), t = r % SEQ;
        const float qs = rsqrtf((F.SS[(size_t)r * SS_W + 48 + 2 * hh] + F.SS[(size_t)r * SS_W + 48 + 2 * hh + 1]) * (1.f / 64.f) + EPS);
        const float q = bf2f(F.PA[(size_t)r * NIN + C_BQ + hh * 64 + lane]) * qs * F.bqw[lane] * F.bkw[lane] * 0.125f;
        float m = -1e30f, l = 0.f, o = 0.f;
        for (int j = 0; j <= 128; ++j) { if (t - j * dil < 0) break; const int kr = r - j * dil;
            const float ks = rsqrtf((F.SS[(size_t)kr * SS_W + 72 + 2 * hh] + F.SS[(size_t)kr * SS_W + 72 + 2 * hh + 1]) * (1.f / 64.f) + EPS);
            const float s = wave_sum(q * bf2f(F.PA[(size_t)kr * NIN + C_BK + hh * 64 + lane])) * ks + F.BIAS[(g * 4 + h) * 132 + j];
            const float mn = fmaxf(m, s), a = __expf(m - mn), p = __expf(s - mn);
            l = l * a + p; o = o * a + p * bf2f(F.PA[(size_t)kr * NIN + C_BV + hh * 64 + lane]); m = mn; }
        F.OG[((size_t)g * HB_ROWS + r) * 256 + h * 64 + lane] = (bf16)f2bf(o / l);
        if (lane == 0) F.LSE[((size_t)g * HB_ROWS + r) * 4 + h] = m + __logf(l); }
}
__device__ __forceinline__ void st_mergeB(Ctx& F) {
    for (size_t gid = F.gtid; gid < (size_t)HB_ROWS * 256; gid += F.T) {
        const int r = (int)(gid / 256), c = (int)(gid % 256), h = c / 64;
        const float l0 = F.LSE[((size_t)0 * HB_ROWS + r) * 4 + h], l1 = F.LSE[((size_t)1 * HB_ROWS + r) * 4 + h], l2 = F.LSE[((size_t)2 * HB_ROWS + r) * 4 + h];
        const float mx = fmaxf(l0, fmaxf(l1, l2)), e0 = __expf(l0 - mx), e1 = __expf(l1 - mx), e2 = __expf(l2 - mx), inv = 1.f / (e0 + e1 + e2);
        const float y = (e0 * bf2f(F.OG[((size_t)0 * HB_ROWS + r) * 256 + c]) + e1 * bf2f(F.OG[((size_t)1 * HB_ROWS + r) * 256 + c]) + e2 * bf2f(F.OG[((size_t)2 * HB_ROWS + r) * 256 + c])) * inv;
        F.YC[(size_t)r * KC + 768 + c] = (bf16)f2bf(y * bf2f(F.PA[(size_t)r * NIN + C_BZ + c])); }
}
__device__ __forceinline__ void st_attnM(Ctx& F, int row_base) {
    const int lane = F.lane;
    for (int w = F.gwave; w < HB_ROWS * 4; w += F.NW) {
        const int r = w / 4, h = w % 4, b = (row_base + r) / SEQ;
        float qq = 0.f; for (int i = 0; i < 4; ++i) qq += F.SS[(size_t)r * SS_W + 96 + 4 * h + i];
        const float qs = rsqrtf(qq * (1.f / 128.f) + EPS) * 0.08838834764831845f;
        const float q0 = bf2f(F.PA[(size_t)r * NIN + C_MQ + h * 128 + lane]) * qs * F.mqw[lane] * F.mkw[lane], q1 = bf2f(F.PA[(size_t)r * NIN + C_MQ + h * 128 + 64 + lane]) * qs * F.mqw[64 + lane] * F.mkw[64 + lane];
        float m = -1e30f, l = 0.f, o0 = 0.f, o1 = 0.f;
        for (int j = 0; j < MEML; ++j) { const size_t kr = (size_t)b * MEML + j;
            float kk = 0.f; for (int i = 0; i < 4; ++i) kk += F.MKSS[kr * 16 + 4 * h + i];
            const float ks = rsqrtf(kk * (1.f / 128.f) + EPS);
            const float s = wave_sum(q0 * bf2f(F.KVM[kr * 1024 + h * 128 + lane]) + q1 * bf2f(F.KVM[kr * 1024 + h * 128 + 64 + lane])) * ks;
            const float mn = fmaxf(m, s), a = __expf(m - mn), p = __expf(s - mn);
            l = l * a + p; o0 = o0 * a + p * bf2f(F.KVM[kr * 1024 + 512 + h * 128 + lane]); o1 = o1 * a + p * bf2f(F.KVM[kr * 1024 + 512 + h * 128 + 64 + lane]); m = mn; }
        F.YC[(size_t)r * KC + 1024 + h * 128 + lane] = (bf16)f2bf(o0 / l * bf2f(F.PA[(size_t)r * NIN + C_MZ + h * 128 + lane]));
        F.YC[(size_t)r * KC + 1024 + h * 128 + 64 + lane] = (bf16)f2bf(o1 / l * bf2f(F.PA[(size_t)r * NIN + C_MZ + h * 128 + 64 + lane])); }
}

typedef float f32x16 __attribute__((ext_vector_type(16)));
typedef short s16x4 __attribute__((ext_vector_type(4)));
__device__ __forceinline__ int crow(int r, int hi) { return (r & 3) + 8 * (r >> 2) + 4 * hi; }
__device__ __forceinline__ unsigned cvtpk(float lo, float hi) { unsigned r; asm volatile("v_cvt_pk_bf16_f32 %0, %1, %2" : "=v"(r) : "v"(lo), "v"(hi)); return r; }
__device__ __forceinline__ s16x4 vtr(const LAS unsigned char* p) { typedef short v4i16_t __attribute__((ext_vector_type(4))); return __builtin_bit_cast(s16x4, __builtin_amdgcn_ds_read_tr16_b64_v4i16((LAS v4i16_t*)p)); }
__device__ __forceinline__ float bflo(unsigned w) { return __uint_as_float(w << 16); }
__device__ __forceinline__ float bfhi(unsigned w) { return __uint_as_float(w & 0xffff0000u); }
constexpr float LOG2E = 1.4426950408889634f, LN2 = 0.6931471805599453f;
constexpr int NBX = 192;

__device__ __forceinline__ void st_attnB_mfma(Ctx& F) {
    const int lane = F.lane, r32 = lane & 31, hi = lane >> 5;
    LAS unsigned char* wl = F.lds + RING_OFF + F.wave * 16384;
    LAS float* btab = (LAS float*)(wl + 8192); LAS float* kst = (LAS float*)(wl + 9216);
    for (int it = F.gwave; it < 3 * 16 * 4 * 64; it += F.NW) {
        const int blk = it & 63, h = (it >> 6) & 3, gb = it >> 8, b = gb & 15, g = gb >> 4, hh = 4 * g + h;
        const int dil = g == 0 ? 1 : (g == 1 ? 4 : 16), nqb = 64 / dil, res = blk / nqb, q0 = (blk % nqb) * 32;
        const int rbase = b * SEQ + res;
        for (int i = lane; i < NBX; i += 64) btab[i] = F.BIASX[(g * 4 + h) * NBX + i];
        const size_t qrow = (size_t)(rbase + (q0 + r32) * dil);
        const float qs = rsqrtf((F.SS[qrow * SS_W + 48 + 2 * hh] + F.SS[qrow * SS_W + 48 + 2 * hh + 1]) * (1.f / 64.f) + EPS) * (0.125f * LOG2E);
        bf16x8 qf[4];
#pragma unroll
        for (int d0 = 0; d0 < 4; ++d0) { const int dd = 16 * d0 + 8 * hi;
            const v4u raw = *(const v4u*)(F.PA + qrow * NIN + C_BQ + hh * 64 + dd);
            const f32x4 wa = *(const f32x4*)(F.bqw + dd), wb = *(const f32x4*)(F.bqw + dd + 4), ka = *(const f32x4*)(F.bkw + dd), kb = *(const f32x4*)(F.bkw + dd + 4);
            v4u o;
            o.x = cvtpk(bflo(raw.x) * qs * wa.x * ka.x, bfhi(raw.x) * qs * wa.y * ka.y); o.y = cvtpk(bflo(raw.y) * qs * wa.z * ka.z, bfhi(raw.y) * qs * wa.w * ka.w);
            o.z = cvtpk(bflo(raw.z) * qs * wb.x * kb.x, bfhi(raw.z) * qs * wb.y * kb.y); o.w = cvtpk(bflo(raw.w) * qs * wb.z * kb.z, bfhi(raw.w) * qs * wb.w * kb.w);
            qf[d0] = __builtin_bit_cast(bf16x8, o); }
        float mrun = -1e30f, lrun = 0.f; f32x16 o0 = {}, o1 = {};
        for (int k0 = (q0 >= 128 ? q0 - 128 : 0); k0 <= q0; k0 += 32) {
            const size_t krow = (size_t)(rbase + (k0 + r32) * dil);
            bf16x8 kf[4];
#pragma unroll
            for (int d0 = 0; d0 < 4; ++d0) kf[d0] = *(const bf16x8*)(F.PA + krow * NIN + C_BK + hh * 64 + 16 * d0 + 8 * hi);
            const float ksv = rsqrtf((F.SS[krow * SS_W + 72 + 2 * hh] + F.SS[krow * SS_W + 72 + 2 * hh + 1]) * (1.f / 64.f) + EPS);
            v4u vr[4];
#pragma unroll
            for (int i = 0; i < 4; ++i) vr[i] = *(const v4u*)(F.PA + (size_t)(rbase + (k0 + 8 * i + (lane >> 3)) * dil) * NIN + C_BV + hh * 64 + 8 * (lane & 7));
#pragma unroll
            for (int i = 0; i < 4; ++i) *(LAS v4u*)(wl + (2 * i + ((lane & 7) >> 2)) * 512 + (lane >> 3) * 64 + (lane & 3) * 16) = vr[i];
            if (lane < 32) kst[r32] = ksv;
            f32x16 st = {};
#pragma unroll
            for (int d0 = 0; d0 < 4; ++d0) st = __builtin_amdgcn_mfma_f32_32x32x16_bf16(kf[d0], qf[d0], st, 0, 0, 0);
            const int bidx = (q0 + r32) - k0 + 31 - 4 * hi;
            float tmax = -1e30f;
#pragma unroll
            for (int i = 0; i < 4; ++i) { const f32x4 kk = *(const LAS f32x4*)(kst + 8 * i + 4 * hi);
#pragma unroll
                for (int j = 0; j < 4; ++j) { const float s = st[4 * i + j] * kk[j] + btab[bidx - 8 * i - j]; st[4 * i + j] = s; tmax = fmaxf(tmax, s); } }
            tmax = fmaxf(tmax, __shfl_xor(tmax, 32));
            const float mnew = fmaxf(mrun, tmax), alpha = __builtin_amdgcn_exp2f(mrun - mnew); mrun = mnew;
            float psum = 0.f;
#pragma unroll
            for (int r = 0; r < 16; ++r) { st[r] = __builtin_amdgcn_exp2f(st[r] - mnew); psum += st[r]; }
            lrun = lrun * alpha + psum;
#pragma unroll
            for (int r = 0; r < 16; ++r) { o0[r] *= alpha; o1[r] *= alpha; }
            v4u p0, p1;
            p0.x = cvtpk(st[0], st[1]); p0.y = cvtpk(st[2], st[3]); p0.z = cvtpk(st[4], st[5]); p0.w = cvtpk(st[6], st[7]);
            p1.x = cvtpk(st[8], st[9]); p1.y = cvtpk(st[10], st[11]); p1.z = cvtpk(st[12], st[13]); p1.w = cvtpk(st[14], st[15]);
            const LAS unsigned char* vb = wl + (4 * hi + ((lane & 15) >> 2)) * 64 + ((lane >> 4) & 1) * 32 + (lane & 3) * 8;
#pragma unroll
            for (int s = 0; s < 2; ++s) { const bf16x8 pf = __builtin_bit_cast(bf16x8, s == 0 ? p0 : p1);
                { const s16x4 a = vtr(vb + (2 * s) * 1024), c = vtr(vb + (2 * s + 1) * 1024); const bf16x8 vf = {a[0], a[1], a[2], a[3], c[0], c[1], c[2], c[3]};
                  o0 = __builtin_amdgcn_mfma_f32_32x32x16_bf16(vf, pf, o0, 0, 0, 0); }
                { const s16x4 a = vtr(vb + (2 * s) * 1024 + 512), c = vtr(vb + (2 * s + 1) * 1024 + 512); const bf16x8 vf = {a[0], a[1], a[2], a[3], c[0], c[1], c[2], c[3]};
                  o1 = __builtin_amdgcn_mfma_f32_32x32x16_bf16(vf, pf, o1, 0, 0, 0); } }
        }
        const float ltot = lrun + __shfl_xor(lrun, 32), inv = 1.f / ltot;
        bf16* orow = F.OG + ((size_t)g * HB_ROWS + qrow) * 256 + h * 64 + 4 * hi;
        typedef unsigned u32x2v __attribute__((ext_vector_type(2)));
#pragma unroll
        for (int i = 0; i < 4; ++i) { u32x2v w0, w1; w0.x = cvtpk(o0[4 * i] * inv, o0[4 * i + 1] * inv); w0.y = cvtpk(o0[4 * i + 2] * inv, o0[4 * i + 3] * inv);
            w1.x = cvtpk(o1[4 * i] * inv, o1[4 * i + 1] * inv); w1.y = cvtpk(o1[4 * i + 2] * inv, o1[4 * i + 3] * inv);
            *(u32x2v*)(orow + 8 * i) = w0; *(u32x2v*)(orow + 32 + 8 * i) = w1; }
        if (hi == 0) F.LSE[((size_t)g * HB_ROWS + qrow) * 4 + h] = (mrun + __log2f(ltot)) * LN2;
    }
}

__device__ __forceinline__ void st_attnM_mfma(Ctx& F, int hb) {
    const int lane = F.lane, r32 = lane & 31, hi = lane >> 5;
    LAS unsigned char* wl = F.lds + RING_OFF + F.wave * 16384;
    LAS float* kst = (LAS float*)(wl + 9216);
    typedef unsigned u32x2v __attribute__((ext_vector_type(2)));
    for (int it = F.gwave; it < 16 * 64 * 4; it += F.NW) {
        const int h = it & 3, qb = (it >> 2) & 63, b = it >> 8;
        const size_t qrow = (size_t)(b * SEQ + qb * 32 + r32); const size_t kbase = (size_t)(hb * 16 + b) * MEML;
        const float qs = rsqrtf(((F.SS[qrow * SS_W + 96 + 4 * h] + F.SS[qrow * SS_W + 96 + 4 * h + 1]) + (F.SS[qrow * SS_W + 96 + 4 * h + 2] + F.SS[qrow * SS_W + 96 + 4 * h + 3])) * (1.f / 128.f) + EPS) * (0.08838834764831845f * LOG2E);
        bf16x8 qf[8];
#pragma unroll
        for (int d0 = 0; d0 < 8; ++d0) { const int dd = 16 * d0 + 8 * hi;
            const v4u raw = *(const v4u*)(F.PA + qrow * NIN + C_MQ + h * 128 + dd);
            const f32x4 wa = *(const f32x4*)(F.mqw + dd), wb = *(const f32x4*)(F.mqw + dd + 4), ka = *(const f32x4*)(F.mkw + dd), kb = *(const f32x4*)(F.mkw + dd + 4);
            v4u o;
            o.x = cvtpk(bflo(raw.x) * qs * wa.x * ka.x, bfhi(raw.x) * qs * wa.y * ka.y); o.y = cvtpk(bflo(raw.y) * qs * wa.z * ka.z, bfhi(raw.y) * qs * wa.w * ka.w);
            o.z = cvtpk(bflo(raw.z) * qs * wb.x * kb.x, bfhi(raw.z) * qs * wb.y * kb.y); o.w = cvtpk(bflo(raw.w) * qs * wb.z * kb.z, bfhi(raw.w) * qs * wb.w * kb.w);
            qf[d0] = __builtin_bit_cast(bf16x8, o); }
        float mrun = -1e30f, lrun = 0.f; f32x16 o0 = {}, o1 = {}, o2 = {}, o3 = {};
        for (int k0 = 0; k0 < MEML; k0 += 32) {
            const size_t krow = kbase + k0 + r32;
            bf16x8 kf[8];
#pragma unroll
            for (int d0 = 0; d0 < 8; ++d0) kf[d0] = *(const bf16x8*)(F.KVM + krow * 1024 + h * 128 + 16 * d0 + 8 * hi);
            const float ksv = rsqrtf(((F.MKSS[krow * 16 + 4 * h] + F.MKSS[krow * 16 + 4 * h + 1]) + (F.MKSS[krow * 16 + 4 * h + 2] + F.MKSS[krow * 16 + 4 * h + 3])) * (1.f / 128.f) + EPS);
#pragma unroll
            for (int i = 0; i < 8; ++i) { const v4u vr = *(const v4u*)(F.KVM + (kbase + k0 + 4 * i + (lane >> 4)) * 1024 + 512 + h * 128 + 8 * (lane & 15));
                *(LAS v4u*)(wl + ((i >> 1) * 4 + ((lane & 15) >> 2)) * 512 + (4 * (i & 1) + (lane >> 4)) * 64 + (lane & 3) * 16) = vr; }
            if (lane < 32) kst[r32] = ksv;
            f32x16 st = {};
#pragma unroll
            for (int d0 = 0; d0 < 8; ++d0) st = __builtin_amdgcn_mfma_f32_32x32x16_bf16(kf[d0], qf[d0], st, 0, 0, 0);
            float tmax = -1e30f;
#pragma unroll
            for (int i = 0; i < 4; ++i) { const f32x4 kk = *(const LAS f32x4*)(kst + 8 * i + 4 * hi);
#pragma unroll
                for (int j = 0; j < 4; ++j) { const float s = st[4 * i + j] * kk[j]; st[4 * i + j] = s; tmax = fmaxf(tmax, s); } }
            tmax = fmaxf(tmax, __shfl_xor(tmax, 32));
            const float mnew = fmaxf(mrun, tmax), alpha = __builtin_amdgcn_exp2f(mrun - mnew); mrun = mnew;
            float psum = 0.f;
#pragma unroll
            for (int r = 0; r < 16; ++r) { st[r] = __builtin_amdgcn_exp2f(st[r] - mnew); psum += st[r]; }
            lrun = lrun * alpha + psum;
#pragma unroll
            for (int r = 0; r < 16; ++r) { o0[r] *= alpha; o1[r] *= alpha; o2[r] *= alpha; o3[r] *= alpha; }
            v4u p0, p1;
            p0.x = cvtpk(st[0], st[1]); p0.y = cvtpk(st[2], st[3]); p0.z = cvtpk(st[4], st[5]); p0.w = cvtpk(st[6], st[7]);
            p1.x = cvtpk(st[8], st[9]); p1.y = cvtpk(st[10], st[11]); p1.z = cvtpk(st[12], st[13]); p1.w = cvtpk(st[14], st[15]);
            const LAS unsigned char* vb = wl + (4 * hi + ((lane & 15) >> 2)) * 64 + ((lane >> 4) & 1) * 32 + (lane & 3) * 8;
#define AM_PV(OX, DB) do { _Pragma("unroll") for (int s = 0; s < 2; ++s) { const bf16x8 pf = __builtin_bit_cast(bf16x8, s == 0 ? p0 : p1); \
                const s16x4 a = vtr(vb + (2 * s) * 2048 + (DB) * 512), c = vtr(vb + (2 * s + 1) * 2048 + (DB) * 512); const bf16x8 vf = {a[0], a[1], a[2], a[3], c[0], c[1], c[2], c[3]}; \
                OX = __builtin_amdgcn_mfma_f32_32x32x16_bf16(vf, pf, OX, 0, 0, 0); } } while (0)
            AM_PV(o0, 0); AM_PV(o1, 1); AM_PV(o2, 2); AM_PV(o3, 3);
#undef AM_PV
        }
        const float ltot = lrun + __shfl_xor(lrun, 32), inv = 1.f / ltot;
        const bf16* zrow = F.PA + qrow * NIN + C_MZ + h * 128 + 4 * hi; bf16* yrow = F.YC + qrow * KC + 1024 + h * 128 + 4 * hi;
#define AM_ST(OX, DB) do { _Pragma("unroll") for (int i = 0; i < 4; ++i) { const u32x2v z = *(const u32x2v*)(zrow + (DB) * 32 + 8 * i); u32x2v w; \
            w.x = cvtpk(OX[4 * i] * inv * bflo(z.x), OX[4 * i + 1] * inv * bfhi(z.x)); w.y = cvtpk(OX[4 * i + 2] * inv * bflo(z.y), OX[4 * i + 3] * inv * bfhi(z.y)); \
            *(u32x2v*)(yrow + (DB) * 32 + 8 * i) = w; } } while (0)
        AM_ST(o0, 0); AM_ST(o1, 1); AM_ST(o2, 2); AM_ST(o3, 3);
#undef AM_ST
    }
}

__device__ __forceinline__ void st_mixA_mfma(Ctx& F) {
    const int lane = F.lane, r32 = lane & 31, hi = lane >> 5, tid = F.tid;
    LAS unsigned char* wl = F.lds + RING_OFF + F.wave * 16384;
    typedef float f32x2v __attribute__((ext_vector_type(2))); typedef unsigned u32x2v __attribute__((ext_vector_type(2)));
    LAS f32x2v* tab = (LAS f32x2v*)(F.lds + RING_OFF + 12288);
    for (int unit = blockIdx.x; unit < HB_ROWS / 128; unit += F.G) {
        const int rowbase = unit * 128;
        { const int row = tid >> 2, part = tid & 3; const float* sp = F.SS + (size_t)(rowbase + row) * SS_W + 12 * part; float s = 0.f, q = 0.f;
#pragma unroll
          for (int k = 0; k < 6; ++k) { s += sp[2 * k]; q += sp[2 * k + 1]; }
          s += __shfl_xor(s, 1); s += __shfl_xor(s, 2); q += __shfl_xor(q, 1); q += __shfl_xor(q, 2);
          const float mu = s * (1.f / 768.f), var = q * (1.f / 768.f) - mu * mu;
          if (part == 0) tab[row] = (f32x2v){mu, rsqrtf(fmaxf(var, 0.f) + EPS)}; }
        __syncthreads();
        const int g = F.wave >> 1;
        for (int cbi = 0; cbi < 3; ++cbi) {
            const int c0 = g * 192 + ((F.wave & 1) * 3 + cbi) * 32, ch = lane & 3;
            const f32x4 w0 = *(const f32x4*)(F.lnw + c0 + 8 * ch), w1 = *(const f32x4*)(F.lnw + c0 + 8 * ch + 4), b0 = *(const f32x4*)(F.lnb + c0 + 8 * ch), b1 = *(const f32x4*)(F.lnb + c0 + 8 * ch + 4);
#pragma unroll
            for (int i = 0; i < 8; ++i) { const int s = (lane >> 2) + 16 * i;
                const v4u raw = *(const v4u*)(F.PA + (size_t)(rowbase + s) * NIN + C_AV + c0 + 8 * ch); const f32x2v st = tab[s]; v4u o;
                o.x = cvtpk((bflo(raw.x) - st.x) * st.y * w0.x + b0.x, (bfhi(raw.x) - st.x) * st.y * w0.y + b0.y); o.y = cvtpk((bflo(raw.y) - st.x) * st.y * w0.z + b0.z, (bfhi(raw.y) - st.x) * st.y * w0.w + b0.w);
                o.z = cvtpk((bflo(raw.z) - st.x) * st.y * w1.x + b1.x, (bfhi(raw.z) - st.x) * st.y * w1.y + b1.y); o.w = cvtpk((bflo(raw.w) - st.x) * st.y * w1.z + b1.z, (bfhi(raw.w) - st.x) * st.y * w1.w + b1.w);
                *(LAS v4u*)(wl + (s >> 3) * 512 + (s & 7) * 64 + ch * 16) = o; }
            const LAS unsigned char* vb = wl + hi * 512 + ((lane & 15) >> 2) * 64 + ((lane >> 4) & 1) * 32 + (lane & 3) * 8;
#pragma unroll
            for (int tb = 0; tb < 4; ++tb) { f32x16 acc = {};
                const bf16* wrow = F.WSP + (size_t)(g * 128 + 32 * tb + r32) * 128 + 8 * hi;
#pragma unroll
                for (int ks = 0; ks < 2 * (tb + 1); ++ks) { const s16x4 a = vtr(vb + ks * 1024), c = vtr(vb + ks * 1024 + 256); const bf16x8 af = {a[0], a[1], a[2], a[3], c[0], c[1], c[2], c[3]};
                    const bf16x8 bfr = *(const bf16x8*)(wrow + 16 * ks); acc = __builtin_amdgcn_mfma_f32_32x32x16_bf16(af, bfr, acc, 0, 0, 0); }
                const int t = 32 * tb + r32; const size_t row = (size_t)(rowbase + t); const float sb = F.sp_b[g * 128 + t];
                const bf16* up = F.PA + row * NIN + C_AU + c0 + 4 * hi; const bf16* zp = F.PA + row * NIN + C_AZ + c0 + 4 * hi; bf16* yp = F.YC + row * KC + c0 + 4 * hi;
#pragma unroll
                for (int i = 0; i < 4; ++i) { const u32x2v u = *(const u32x2v*)(up + 8 * i), z = *(const u32x2v*)(zp + 8 * i); u32x2v w;
                    w.x = cvtpk(bflo(u.x) * (acc[4 * i] + sb) * bflo(z.x), bfhi(u.x) * (acc[4 * i + 1] + sb) * bfhi(z.x)); w.y = cvtpk(bflo(u.y) * (acc[4 * i + 2] + sb) * bflo(z.y), bfhi(u.y) * (acc[4 * i + 3] + sb) * bfhi(z.y));
                    *(u32x2v*)(yp + 8 * i) = w; } }
        }
        __syncthreads();
    }
}

#ifndef MK_PER_PHASE
#define MK_PER_PHASE 0
#endif
constexpr int NPH_HALF = 6, NPHASES = 1 + 2 * NPH_HALF;
struct Args { const float* in[20]; float* out; unsigned char* ws; int ph_lo, ph_hi; };
__global__ void __launch_bounds__(NTHR, 2) mega_fwd(Args args) {
    extern __shared__ __attribute__((aligned(16))) unsigned char lds_raw[];
    Ctx F;
    F.lds = (LAS unsigned char*)lds_raw;
    F.tid = threadIdx.x; F.lane = F.tid & 63; F.wave = __builtin_amdgcn_readfirstlane(F.tid >> 6);
    F.G = gridDim.x; F.gtid = blockIdx.x * NTHR + F.tid; F.T = F.G * NTHR; F.gwave = blockIdx.x * NWAVES + F.wave; F.NW = F.G * NWAVES;
    unsigned char* ws = args.ws;
    F.x = args.in[0]; F.mem = args.in[1]; F.norm_w = args.in[2]; F.w_in = args.in[3]; F.gate_b = args.in[4]; F.lnw = args.in[5]; F.lnb = args.in[6]; F.sp_w = args.in[7];
    F.sp_b = args.in[8]; F.bqw = args.in[9]; F.bkw = args.in[10]; F.rel_bias = args.in[11]; F.mem_norm_w = args.in[12]; F.m_w_kv = args.in[13]; F.mqw = args.in[14]; F.mkw = args.in[15];
    F.proj_a = args.in[16]; F.proj_b = args.in[17]; F.proj_m = args.in[18]; F.w_out = args.in[19]; F.out = args.out;
    F.WIN = (bf16*)(ws + WS_WIN); F.PCAT = (bf16*)(ws + WS_PCAT); F.WOUT = (bf16*)(ws + WS_WOUT); F.WSP = (bf16*)(ws + WS_WSP); F.BIAS = (float*)(ws + WS_BIAS); F.BIASX = (float*)(ws + WS_BIAS + 65536);
    F.XN = (bf16*)(ws + WS_XN); F.PA = (bf16*)(ws + WS_PA); F.KVM = (bf16*)(ws + WS_KVM); F.SS = (float*)(ws + WS_SS); F.MKSS = (float*)(ws + WS_MKSS);
    F.OG = (bf16*)(ws + WS_OG); F.LSE = (float*)(ws + WS_LSE); F.LNST = (float*)(ws + WS_LNST); F.YC = (bf16*)(ws + WS_YC); F.MRG = (bf16*)(ws + WS_MRG);
    for (int u = F.tid; u < (LDS_BYTES - LDSCTL_OFF) / 4; u += NTHR) ((LAS unsigned*)(F.lds + LDSCTL_OFF))[u] = 0u;
    __syncthreads();
    XcdBarrier bar; bar.bar = (unsigned*)(ws + WS_CTL) + CW_BAR; bar.x = 0; bar.st = nullptr;
    if (!MK_PER_PHASE) bar = xcd_barrier_post((unsigned*)(ws + WS_CTL) + CW_BAR, (volatile LAS unsigned*)(F.lds + MISC_OFF) + 8);
    const int lo = args.ph_lo, hi = args.ph_hi;
#define IN(k) (lo <= (k) && (k) < hi)
#define SEAM(k) do { if (IN(k) && IN((k) + 1)) xcd_barrier(bar); } while (0)

    if (IN(0)) { p0_prologue(F); } SEAM(0);
#pragma unroll 1
    for (int hb = 0; hb < 2; ++hb) {
        const int pb = 1 + hb * NPH_HALF, row0 = hb * HB_ROWS;
        asm volatile("" : "+v"(F.gtid), "+v"(F.tid), "+v"(F.lane));
        if (IN(pb + 0)) {
            pg8::Gemm g{F.XN, F.WIN, MTOT + MMEM, NIN + 1024, DM, DM, DM}; pg8::OrderG1 S; S.init(hb, F.G, (int)blockIdx.x);
            pg8::EpiProj E{F.PA, F.KVM, F.SS, F.MKSS, F.gate_b, hb * (HB_ROWS / 256), 0};
            pg8::gemm_phase<pg8::EpiProj, pg8::OrderG1, true, true>(F.lds + RING_OFF, g, S, E);
        } SEAM(pb + 0);
        SEAM(pb + 1);
        if (IN(pb + 2)) { st_mixA_mfma(F); st_attnB_mfma(F); st_attnM_mfma(F, hb); } SEAM(pb + 2);
        if (IN(pb + 3)) { st_mergeB(F); } SEAM(pb + 3);
        if (IN(pb + 4)) {
            pg8::StaticOrder S; S.init(HB_ROWS, DM, F.G, (int)blockIdx.x);
            float* tmp = F.out + (size_t)row0 * DM;
            { pg8::Gemm g{F.YC, F.PCAT, HB_ROWS, DM, 768, KC, KC}; pg8::EpiG2<0> E{tmp, F.PA, F.MRG}; pg8::gemm_phase<pg8::EpiG2<0>, pg8::StaticOrder, true, true>(F.lds + RING_OFF, g, S, E); }
            { pg8::Gemm g{F.YC + 768, F.PCAT + 768, HB_ROWS, DM, 256, KC, KC}; pg8::EpiG2<1> E{tmp, F.PA, F.MRG}; pg8::gemm_phase<pg8::EpiG2<1>, pg8::StaticOrder, true, true>(F.lds + RING_OFF, g, S, E); }
            { pg8::Gemm g{F.YC + 1024, F.PCAT + 1024, HB_ROWS, DM, 512, KC, KC}; pg8::EpiG2<2> E{tmp, F.PA, F.MRG}; pg8::gemm_phase<pg8::EpiG2<2>, pg8::StaticOrder, true, true>(F.lds + RING_OFF, g, S, E); }
        } SEAM(pb + 4);
        if (IN(pb + 5)) {
            pg8::Gemm g{F.MRG, F.WOUT, HB_ROWS, DM, DM, DM, DM}; pg8::StaticOrder S; S.init(HB_ROWS, DM, F.G, (int)blockIdx.x);
            pg8::EpiG3 E{F.x + (size_t)row0 * DM, F.out + (size_t)row0 * DM};
            pg8::gemm_phase<pg8::EpiG3, pg8::StaticOrder, true, true>(F.lds + RING_OFF, g, S, E);
        } SEAM(pb + 5);
    }
#undef IN
#undef SEAM
}

extern "C" void kernel_launch(void* const* d_in, const int* in_sizes, int n_in, void* d_out, int out_size, void* d_ws, size_t ws_size, hipStream_t stream) {
    static int grid = 0;
    if (grid == 0) {
        if (n_in != 20 || in_sizes[0] != MTOT * DM || out_size != MTOT * DM || ws_size < WS_END) { fprintf(stderr, "kernel_launch: unexpected shapes (n_in %d, ws %zu); nothing launched\n", n_in, ws_size); grid = -1; return; }
        int dev = 0, cus = 0, per_cu = 0;
        if (hipGetDevice(&dev) != hipSuccess || hipDeviceGetAttribute(&cus, hipDeviceAttributeMultiprocessorCount, dev) != hipSuccess) { grid = -1; return; }
        if (hipFuncSetAttribute((const void*)mega_fwd, hipFuncAttributeMaxDynamicSharedMemorySize, LDS_BYTES) != hipSuccess) { fprintf(stderr, "kernel_launch: hipFuncSetAttribute failed\n"); grid = -1; return; }
        if (hipOccupancyMaxActiveBlocksPerMultiprocessor(&per_cu, (const void*)mega_fwd, NTHR, LDS_BYTES) != hipSuccess || per_cu < 1) { fprintf(stderr, "kernel_launch: occupancy query says %d blocks per CU\n", per_cu); (void)hipGetLastError(); grid = -1; return; }
        grid = cus;
    }
    if (grid < 0) return;
    if (hipMemsetAsync((char*)d_ws + WS_CTL, 0, CTL_ZERO_BYTES, stream) != hipSuccess) return;
    Args a{};
    for (int i = 0; i < 20; ++i) a.in[i] = (const float*)d_in[i];
    a.out = (float*)d_out; a.ws = (unsigned char*)d_ws;
#if MK_PER_PHASE
    for (int p = 0; p < NPHASES; ++p) { a.ph_lo = p; a.ph_hi = p + 1; hipLaunchKernelGGL(mega_fwd, dim3(grid), dim3(NTHR), LDS_BYTES, stream, a); }
#else
    a.ph_lo = 0; a.ph_hi = NPHASES; hipLaunchKernelGGL(mega_fwd, dim3(grid), dim3(NTHR), LDS_BYTES, stream, a);
#endif
}
```

```cpp
#include <hip/hip_runtime.h>
#include <cstdint>
#include <cstdio>

constexpr int DM = 1024, NB = 32, SEQ = 2048, MTOT = NB * SEQ;
constexpr int NIN = 8960, MEML = 256, MMEM = NB * MEML;
constexpr int HB_ROWS = MTOT / 2;
constexpr int C_AU = 0, C_AV = 768, C_AZ = 1536, C_BQ = 2304, C_BK = 3072, C_BV = 3840, C_BZ = 4608, C_MQ = 4864, C_MZ = 5376, C_G = 5888;
constexpr float EPS = 1e-6f;
constexpr int SS_W = 112;
constexpr int KC = 1536;

constexpr size_t MiB = 1u << 20;
constexpr size_t WS_CTL = 0, CTL_ZERO_BYTES = 256 * 1024, WS_WIN = 2 * MiB, WS_PCAT = 22 * MiB, WS_WOUT = 25 * MiB, WS_WSP = 27 * MiB, WS_BIAS = 27 * MiB + 512 * 1024;
constexpr size_t WS_XN = 32 * MiB, WS_PA = 176 * MiB, WS_KVM = 736 * MiB, WS_SS = 752 * MiB, WS_MKSS = 766 * MiB, WS_OG = 768 * MiB, WS_LSE = 816 * MiB, WS_LNST = 818 * MiB;
constexpr size_t WS_YC = 820 * MiB, WS_MRG = 916 * MiB, WS_END = 980 * MiB;
constexpr int CW_BAR = 4096;

namespace pg8 {
#define PG8_LAS __attribute__((address_space(3)))
typedef unsigned short bf16_t;
typedef short bf16x8 __attribute__((ext_vector_type(8)));
typedef float f32x4 __attribute__((ext_vector_type(4)));
typedef unsigned u32x4 __attribute__((ext_vector_type(4)));
constexpr int BM = 256, BK = 64, HALF = 128, HTB = HALF * BK * 2  , STAGE_BYTES = 8 * HTB, NXCD = 8, WGM = 8;

__host__ __device__ __forceinline__ int lds_byte(int r, int c) { const int st = (r >> 4) * 2 + (c >> 5), rr = r & 15, cc = c & 31, ob = rr * 64 + cc * 2; return st * 1024 + (ob ^ (((ob >> 9) & 1) << 5)); }
__host__ __device__ __forceinline__ void stage_rc(int b, int& R, int& C) { const int st = b / 1024, sb = b % 1024, swz = sb ^ (((sb >> 9) & 1) << 5); R = (st >> 1) * 16 + swz / 64; C = (st & 1) * 32 + (swz % 64) / 2; }
__host__ __device__ __forceinline__ int perm32(int rho) { const int n = rho >> 4, i = rho & 15; return 8 * (i >> 2) + 4 * n + (i & 3); }

struct Unit { int pm, pn; };
struct Gemm { const bf16_t* A; const bf16_t* Bt; int M, N, K, lda, ldb; };

struct StaticOrder {
    int nM, nN, nwg, G, c;
    __host__ __device__ void init(int M, int N, int G_, int c_) { nM = M / BM; nN = N / BM; nwg = nM * nN; G = G_; c = c_; }
    __host__ __device__ bool next(int i, Unit& u) const {
        const long L = (long)i * G + c; if (L >= nwg) return false;
        int wgid = (int)L; { const int q = nwg / NXCD, r = nwg % NXCD, xcd = wgid % NXCD, off = wgid / NXCD; wgid = (xcd < r ? xcd * (q + 1) : r * (q + 1) + (xcd - r) * q) + off; }
        const int nig = WGM * nN, gid = wgid / nig, fm = gid * WGM, gsz = (nM - fm) < WGM ? (nM - fm) : WGM;
        u.pm = fm + ((wgid % nig) % gsz); u.pn = (wgid % nig) / gsz; return true;
    }
    __device__ __forceinline__ void a_ready(const Unit&) const {}
    __device__ __forceinline__ void done(const Unit&) const {}
};


__device__ __forceinline__ unsigned cvt_pk_bf16(float lo, float hi) { unsigned r; asm volatile("v_cvt_pk_bf16_f32 %0, %1, %2" : "=v"(r) : "v"(lo), "v"(hi)); return r; }
typedef float f32x2 __attribute__((ext_vector_type(2)));
__device__ __forceinline__ f32x2 gelu_pk(f32x2 v) {
    const f32x2 av = __builtin_elementwise_abs(v), d = av * 0.2316418882f + 1.0f;
    f32x2 t; t.x = __builtin_amdgcn_rcpf(d.x); t.y = __builtin_amdgcn_rcpf(d.y);
    f32x2 q = t * 0.5307027145f + (-0.7265760135f); q = q * t + 0.7107068705f; q = q * t + (-0.142248368f); q = q * t + 0.127414796f; q = q * t;
    const f32x2 s = (v * v) * (-0.72134752044f);
    f32x2 e; e.x = __builtin_amdgcn_exp2f(s.x); e.y = __builtin_amdgcn_exp2f(s.y);
    const f32x2 m = v * (q * e), r = v - m;
    f32x2 o; o.x = v.x < 0.f ? m.x : r.x; o.y = v.y < 0.f ? m.y : r.y; return o;
}

template <class Epi, class Sched, bool ALIGN_EPI = false, bool SP2 = false>
__device__ __forceinline__ void gemm_phase(PG8_LAS unsigned char* lds, const Gemm g, const Sched& S, const Epi& E, const int wave_id) {
    int tid; asm volatile("v_mbcnt_lo_u32_b32 %0, -1, 0\n\tv_mbcnt_hi_u32_b32 %0, -1, %0" : "=v"(tid)); tid += wave_id * 64;
    const int wid = __builtin_amdgcn_readfirstlane(tid >> 6), lane = tid & 63, wr = wid >> 2, wc = wid & 3, fr = lane & 15, fq = lane >> 4;
    int K = g.K; asm volatile("" : "+s"(K)); const int nt = K / BK;
    unsigned voffA[2], voffB[2];
#pragma unroll
    for (int i = 0; i < 2; ++i) { int R, C; stage_rc(tid * 16 + i * 8192, R, C); const int Rb = Epi::PERM ? ((R & ~31) + perm32(R & 31)) : R;
        voffA[i] = (unsigned)(R * g.lda + C) * 2u; voffB[i] = (unsigned)(Rb * g.ldb + C) * 2u; }
    const size_t kstep = (size_t)(BK * 2);
    const size_t hstepA = (size_t)HALF * g.lda * 2, hstepB = (size_t)HALF * g.ldb * 2;
    const size_t tstepA = 2 * hstepA, tstepB = 2 * hstepB;
    const unsigned ldsw = (unsigned)wid * 1024u;
    const int aoff = lds_byte(wr * 64 + fr, fq * 8), boff = lds_byte(wc * 32 + fr, fq * 8);
#define PG8_SA(b, h) (((b) * 2 + (h)) * HTB)
#define PG8_SB(b, h) ((4 + (b) * 2 + (h)) * HTB)
#define PG8_STAGE(bufoff, gbase, voff) do { _Pragma("unroll") for (int _i = 0; _i < 2; ++_i) \
        __builtin_amdgcn_global_load_lds((const unsigned*)((const char*)(gbase) + (voff)[_i]), (PG8_LAS unsigned*)(lds + (bufoff) + ldsw + _i * 8192), 16, 0, 0); } while (0)
#define PG8_LDA(dst, b, h) do { _Pragma("unroll") for (int m = 0; m < 4; ++m) _Pragma("unroll") for (int k = 0; k < 2; ++k) dst[m][k] = *(const PG8_LAS bf16x8*)(lds + PG8_SA(b, h) + aoff + m * 2048 + k * 1024); } while (0)
#define PG8_LDB(dst, b, h) do { _Pragma("unroll") for (int n = 0; n < 2; ++n) _Pragma("unroll") for (int k = 0; k < 2; ++k) dst[n][k] = *(const PG8_LAS bf16x8*)(lds + PG8_SB(b, h) + boff + n * 2048 + k * 1024); } while (0)
#define PG8_MMA(ai, bj, At, Bt) do { __builtin_amdgcn_s_setprio(1); _Pragma("unroll") for (int m = 0; m < 4; ++m) _Pragma("unroll") for (int n = 0; n < 2; ++n) _Pragma("unroll") for (int k = 0; k < 2; ++k) \
        acc[ai][bj][m][n] = __builtin_amdgcn_mfma_f32_16x16x32_bf16(Bt[n][k], At[m][k], acc[ai][bj][m][n], 0, 0, 0); __builtin_amdgcn_s_setprio(0); } while (0)
#define PG8_WAIT_V(n) asm volatile("s_waitcnt vmcnt(" #n ")" ::: "memory")
#define PG8_WAIT_L(n) asm volatile("s_waitcnt lgkmcnt(" #n ")" ::: "memory")
#define PG8_BAR __builtin_amdgcn_s_barrier()
#define PG8_SCHED __builtin_amdgcn_sched_barrier(0)
    Unit cur, nxt; int ui = 0;
    if (!S.next(0, cur)) return;
    f32x4 acc[2][2][4][2];
#pragma unroll
    for (int a = 0; a < 2; ++a)
#pragma unroll
        for (int b = 0; b < 2; ++b)
#pragma unroll
            for (int m = 0; m < 4; ++m)
#pragma unroll
                for (int n = 0; n < 2; ++n) acc[a][b][m][n] = (f32x4){0.f, 0.f, 0.f, 0.f};
    bf16x8 At[4][2], B0[2][2], B1[2][2];
    const char* cA = (const char*)g.A + (size_t)cur.pm * tstepA; const char* cB = (const char*)g.Bt + (size_t)cur.pn * tstepB;
    S.a_ready(cur);
    if constexpr (SP2) {
        PG8_STAGE(PG8_SB(0, 0), cB, voffB); PG8_STAGE(PG8_SB(0, 1), cB + hstepB, voffB); PG8_STAGE(PG8_SA(0, 0), cA, voffA); PG8_STAGE(PG8_SA(0, 1), cA + hstepA, voffA);
        if (wr == 1) PG8_BAR;
        PG8_WAIT_V(2); PG8_BAR;
        PG8_STAGE(PG8_SB(1, 0), cB + kstep, voffB); PG8_STAGE(PG8_SA(1, 0), cA + kstep, voffA); PG8_STAGE(PG8_SB(1, 1), cB + hstepB + kstep, voffB);
        PG8_WAIT_V(6); PG8_BAR;
    } else {
        PG8_STAGE(PG8_SB(0, 0), cB, voffB); PG8_STAGE(PG8_SA(0, 0), cA, voffA); PG8_STAGE(PG8_SB(0, 1), cB + hstepB, voffB); PG8_STAGE(PG8_SA(0, 1), cA + hstepA, voffA);
        if (wr == 1) PG8_BAR;
        PG8_WAIT_V(4); PG8_BAR;
        PG8_STAGE(PG8_SB(1, 0), cB + kstep, voffB); PG8_STAGE(PG8_SA(1, 0), cA + kstep, voffA); PG8_STAGE(PG8_SB(1, 1), cB + hstepB + kstep, voffB);
        PG8_WAIT_V(6); PG8_BAR;
    }
    for (;;) {
        const bool has_next = S.next(ui + 1, nxt);
        const char* nA = has_next ? (const char*)g.A + (size_t)nxt.pm * tstepA : cA; const char* nB = has_next ? (const char*)g.Bt + (size_t)nxt.pn * tstepB : cB;
        for (int t = 0; t < nt; t += 2) {
            if constexpr (Epi::KHOOK) { if (t == Epi::KH1 || t == Epi::KH2) E.khook(acc, cur, t, wr, wc, fr, fq); }
            const bool last = (t == nt - 2);
            const char* a1 = cA + (size_t)(t + 1) * kstep;
            const char* a2 = last ? nA : cA + (size_t)(t + 2) * kstep; const char* b2 = last ? nB : cB + (size_t)(t + 2) * kstep;
            const char* a3 = a2 + kstep; const char* b3 = b2 + kstep;
            if (last && has_next) S.a_ready(nxt);
            if constexpr (SP2) {
            PG8_LDB(B0, 0, 0); PG8_LDB(B1, 0, 1); PG8_SCHED; PG8_LDA(At, 0, 0); PG8_STAGE(PG8_SA(1, 1), a1 + hstepA, voffA);
            PG8_WAIT_V(8); PG8_WAIT_L(0); PG8_BAR; PG8_MMA(0, 0, At, B0); PG8_MMA(0, 1, At, B1); PG8_BAR; PG8_SCHED;
            PG8_LDA(At, 0, 1); PG8_STAGE(PG8_SB(0, 0), b2, voffB); PG8_STAGE(PG8_SB(0, 1), b2 + hstepB, voffB); PG8_STAGE(PG8_SA(0, 0), a2, voffA);
            PG8_WAIT_V(8); PG8_WAIT_L(0); PG8_BAR; PG8_MMA(1, 0, At, B0); PG8_MMA(1, 1, At, B1); PG8_BAR; PG8_SCHED;
            PG8_LDB(B0, 1, 0); PG8_LDB(B1, 1, 1); PG8_SCHED; PG8_LDA(At, 1, 0); PG8_STAGE(PG8_SA(0, 1), a2 + hstepA, voffA);
            PG8_WAIT_V(8); PG8_WAIT_L(0); PG8_BAR; PG8_MMA(0, 0, At, B0); PG8_MMA(0, 1, At, B1); PG8_BAR; PG8_SCHED;
            PG8_LDA(At, 1, 1); PG8_STAGE(PG8_SB(1, 0), b3, voffB); PG8_STAGE(PG8_SB(1, 1), b3 + hstepB, voffB); PG8_STAGE(PG8_SA(1, 0), a3, voffA);
            PG8_WAIT_V(8); PG8_WAIT_L(0); PG8_BAR; PG8_MMA(1, 0, At, B0); PG8_MMA(1, 1, At, B1); PG8_BAR; PG8_SCHED;
            } else {
            PG8_LDB(B0, 0, 0); PG8_SCHED; PG8_LDA(At, 0, 0); PG8_STAGE(PG8_SA(1, 1), a1 + hstepA, voffA);
            PG8_WAIT_L(8); PG8_BAR; PG8_WAIT_L(0); PG8_MMA(0, 0, At, B0); PG8_BAR; PG8_SCHED;
            PG8_LDB(B1, 0, 1); PG8_STAGE(PG8_SB(0, 0), b2, voffB);
            PG8_BAR; PG8_WAIT_L(0); PG8_MMA(0, 1, At, B1); PG8_BAR;
            PG8_LDA(At, 0, 1); PG8_STAGE(PG8_SA(0, 0), a2, voffA);
            PG8_BAR; PG8_WAIT_L(0); PG8_MMA(1, 0, At, B0); PG8_BAR; PG8_SCHED;
            PG8_STAGE(PG8_SB(0, 1), b2 + hstepB, voffB);
            PG8_WAIT_V(6); PG8_BAR; PG8_MMA(1, 1, At, B1); PG8_BAR;
            PG8_LDB(B0, 1, 0); PG8_SCHED; PG8_LDA(At, 1, 0); PG8_STAGE(PG8_SA(0, 1), a2 + hstepA, voffA);
            PG8_WAIT_L(8); PG8_BAR; PG8_WAIT_L(0); PG8_MMA(0, 0, At, B0); PG8_BAR; PG8_SCHED;
            PG8_LDB(B1, 1, 1); PG8_STAGE(PG8_SB(1, 0), b3, voffB);
            PG8_BAR; PG8_WAIT_L(0); PG8_MMA(0, 1, At, B1); PG8_BAR;
            PG8_LDA(At, 1, 1); PG8_STAGE(PG8_SA(1, 0), a3, voffA);
            PG8_BAR; PG8_WAIT_L(0); PG8_MMA(1, 0, At, B0); PG8_BAR; PG8_SCHED;
            PG8_STAGE(PG8_SB(1, 1), b3 + hstepB, voffB);
            PG8_WAIT_V(6); PG8_BAR; PG8_MMA(1, 1, At, B1); PG8_BAR;
            }
        }
        if constexpr (ALIGN_EPI) { if (wr == 0) PG8_BAR; }
        if constexpr (!Epi::AFTER_DRAIN) { E(acc, cur, wr, wc, fr, fq); S.done(cur); }
        if (!has_next) break;
#pragma unroll
        for (int a = 0; a < 2; ++a)
#pragma unroll
            for (int b = 0; b < 2; ++b)
#pragma unroll
                for (int m = 0; m < 4; ++m)
#pragma unroll
                    for (int n = 0; n < 2; ++n) acc[a][b][m][n] = (f32x4){0.f, 0.f, 0.f, 0.f};
        cur = nxt; cA = nA; cB = nB; ++ui;
        if constexpr (ALIGN_EPI) { if (wr == 1) PG8_BAR; }
    }
    PG8_WAIT_V(0);
    if constexpr (!ALIGN_EPI) { if (wr == 0) PG8_BAR; }
    PG8_BAR;
    if constexpr (Epi::AFTER_DRAIN) { E.fused(acc, cur, wr, wc, fr, fq, lds, wid, lane); S.done(cur); }
#undef PG8_SA
#undef PG8_SB
#undef PG8_STAGE
#undef PG8_LDA
#undef PG8_LDB
#undef PG8_MMA
#undef PG8_WAIT_V
#undef PG8_WAIT_L
#undef PG8_BAR
#undef PG8_SCHED
}
}

namespace pg8 {
__device__ __forceinline__ float ex2(float x) { return __builtin_amdgcn_exp2f(x); }
__device__ __forceinline__ float sigm_fast(float x) { return __builtin_amdgcn_rcpf(1.0f + ex2(x * -1.4426950408889634f)); }
struct EpiProj {
    static constexpr bool PERM = true, AFTER_DRAIN = false, KHOOK = false;
    bf16_t* PA; bf16_t* KVM; float* SS; float* MKSS; const float* gate_b; int pm0; int pad;
    __device__ __forceinline__ void operator()(const f32x4 (&acc)[2][2][4][2], const Unit& u, int wr, int wc, int fr, int fq) const {
        const bool kv = u.pn >= 35; const int pn = kv ? u.pn - 35 : u.pn;
        const int rowt = kv ? (u.pm - 256) * BM : (u.pm - pm0) * BM;
        bf16_t* base = kv ? KVM : PA; const int ldc = kv ? 1024 : NIN;
        int kind = 0, stat = 0, so = 0; float* sb = SS; int sld = SS_W;
        if (kv) { sb = MKSS; sld = 16; if (pn < 2) { stat = 1; so = 8 * pn; } }
        else if (pn < 3) kind = 1;
        else if (pn < 6) { kind = 1; stat = 2; so = 16 * (pn - 3); }
        else if (pn < 9) kind = 2;
        else if (pn < 12) { stat = 1; so = 48 + 8 * (pn - 9); }
        else if (pn < 15) { stat = 1; so = 72 + 8 * (pn - 12); }
        else if (pn < 18) kind = 0;
        else if (pn < 19) kind = 2;
        else if (pn < 21) { stat = 1; so = 96 + 8 * (pn - 19); }
        else if (pn < 23) kind = 2;
        else kind = 3;
        const int row0 = rowt + wr * 64 + fr, col0 = pn * BM + wc * 32 + 8 * fq;
        f32x4 bv[2][2];
#pragma unroll
        for (int bj = 0; bj < 2; ++bj)
#pragma unroll
            for (int n = 0; n < 2; ++n) bv[bj][n] = (kind == 3) ? *(const f32x4*)(gate_b + (col0 - 23 * BM) + bj * HALF + 4 * n) : (f32x4){0.f, 0.f, 0.f, 0.f};
#pragma unroll
        for (int ai = 0; ai < 2; ++ai)
#pragma unroll
            for (int m = 0; m < 4; ++m) { const int row = row0 + ai * HALF + m * 16; bf16_t* rowp = base + (size_t)row * ldc + col0;
#pragma unroll
                for (int bj = 0; bj < 2; ++bj) { f32x4 v0 = acc[ai][bj][m][0], v1 = acc[ai][bj][m][1];
                    if (kind == 1) { f32x2 a = gelu_pk((f32x2){v0[0], v0[1]}), b = gelu_pk((f32x2){v0[2], v0[3]}), c = gelu_pk((f32x2){v1[0], v1[1]}), d = gelu_pk((f32x2){v1[2], v1[3]});
                        v0 = (f32x4){a.x, a.y, b.x, b.y}; v1 = (f32x4){c.x, c.y, d.x, d.y}; }
                    else if (kind == 2) {
#pragma unroll
                        for (int j = 0; j < 4; ++j) { v0[j] = v0[j] * sigm_fast(v0[j]); v1[j] = v1[j] * sigm_fast(v1[j]); } }
                    else if (kind == 3) { v0 = v0 + bv[bj][0]; v1 = v1 + bv[bj][1];
#pragma unroll
                        for (int j = 0; j < 4; ++j) { v0[j] = sigm_fast(v0[j]); v1[j] = sigm_fast(v1[j]); } }
                    if (stat) {
                        float s = ((v0[0] + v0[1]) + (v0[2] + v0[3])) + ((v1[0] + v1[1]) + (v1[2] + v1[3]));
                        float q = ((v0[0] * v0[0] + v0[1] * v0[1]) + (v0[2] * v0[2] + v0[3] * v0[3])) + ((v1[0] * v1[0] + v1[1] * v1[1]) + (v1[2] * v1[2] + v1[3] * v1[3]));
                        s += __shfl_xor(s, 16); s += __shfl_xor(s, 32); q += __shfl_xor(q, 16); q += __shfl_xor(q, 32);
                        if (fq == 0) { float* sp = sb + (size_t)row * sld + so; const int blk = 4 * bj + wc;
                            if (stat == 2) { sp[2 * blk] = s; sp[2 * blk + 1] = q; } else sp[blk] = q; }
                    }
                    u32x4 w; w.x = cvt_pk_bf16(v0[0], v0[1]); w.y = cvt_pk_bf16(v0[2], v0[3]); w.z = cvt_pk_bf16(v1[0], v1[1]); w.w = cvt_pk_bf16(v1[2], v1[3]);
                    *(u32x4*)(rowp + bj * HALF) = w; } }
    }
};
struct EpiG2cat {
    static constexpr bool PERM = true, AFTER_DRAIN = false, KHOOK = true; static constexpr int KH1 = 12, KH2 = 16;
    const bf16_t* PA; bf16_t* MRG;
    __device__ __forceinline__ void khook(f32x4 (&acc)[2][2][4][2], const Unit& u, int t, int wr, int wc, int fr, int fq) const {
        const int ga = t == KH1 ? 0 : 1;
        const int row0 = u.pm * BM + wr * 64 + fr, col0 = u.pn * BM + wc * 32 + 8 * fq;
#pragma unroll
        for (int ai = 0; ai < 2; ++ai)
#pragma unroll
            for (int m = 0; m < 4; ++m) { const bf16_t* gp = PA + (size_t)(row0 + ai * HALF + m * 16) * NIN + C_G + ga * DM + col0;
#pragma unroll
                for (int bj = 0; bj < 2; ++bj) { const u32x4 a = *(const u32x4*)(gp + bj * HALF), b = *(const u32x4*)(gp + DM + bj * HALF);
                    f32x4 r0, r1;
                    r0[0] = __uint_as_float(a.x << 16) * __builtin_amdgcn_rcpf(__uint_as_float(b.x << 16)); r0[1] = __uint_as_float(a.x & 0xffff0000u) * __builtin_amdgcn_rcpf(__uint_as_float(b.x & 0xffff0000u));
                    r0[2] = __uint_as_float(a.y << 16) * __builtin_amdgcn_rcpf(__uint_as_float(b.y << 16)); r0[3] = __uint_as_float(a.y & 0xffff0000u) * __builtin_amdgcn_rcpf(__uint_as_float(b.y & 0xffff0000u));
                    r1[0] = __uint_as_float(a.z << 16) * __builtin_amdgcn_rcpf(__uint_as_float(b.z << 16)); r1[1] = __uint_as_float(a.z & 0xffff0000u) * __builtin_amdgcn_rcpf(__uint_as_float(b.z & 0xffff0000u));
                    r1[2] = __uint_as_float(a.w << 16) * __builtin_amdgcn_rcpf(__uint_as_float(b.w << 16)); r1[3] = __uint_as_float(a.w & 0xffff0000u) * __builtin_amdgcn_rcpf(__uint_as_float(b.w & 0xffff0000u));
                    acc[ai][bj][m][0] *= r0; acc[ai][bj][m][1] *= r1; }
                asm volatile("" ::: "memory"); }
    }
    __device__ __forceinline__ void operator()(const f32x4 (&acc)[2][2][4][2], const Unit& u, int wr, int wc, int fr, int fq) const {
        const int row0 = u.pm * BM + wr * 64 + fr, col0 = u.pn * BM + wc * 32 + 8 * fq;
#pragma unroll
        for (int ai = 0; ai < 2; ++ai)
#pragma unroll
            for (int m = 0; m < 4; ++m) { const size_t row = (size_t)(row0 + ai * HALF + m * 16); const bf16_t* gp = PA + row * NIN + C_G + 2 * DM + col0; bf16_t* mp = MRG + row * DM + col0;
#pragma unroll
                for (int bj = 0; bj < 2; ++bj) { const u32x4 g = *(const u32x4*)(gp + bj * HALF); const f32x4 v0 = acc[ai][bj][m][0], v1 = acc[ai][bj][m][1]; u32x4 w;
                    w.x = cvt_pk_bf16(v0[0] * __uint_as_float(g.x << 16), v0[1] * __uint_as_float(g.x & 0xffff0000u)); w.y = cvt_pk_bf16(v0[2] * __uint_as_float(g.y << 16), v0[3] * __uint_as_float(g.y & 0xffff0000u));
                    w.z = cvt_pk_bf16(v1[0] * __uint_as_float(g.z << 16), v1[1] * __uint_as_float(g.z & 0xffff0000u)); w.w = cvt_pk_bf16(v1[2] * __uint_as_float(g.w << 16), v1[3] * __uint_as_float(g.w & 0xffff0000u));
                    *(u32x4*)(mp + bj * HALF) = w; }
                asm volatile("" ::: "memory"); }
    }
};
struct EpiG3 {
    static constexpr bool PERM = false, AFTER_DRAIN = false, KHOOK = false;
    const float* x; float* out;
    __device__ __forceinline__ void operator()(const f32x4 (&acc)[2][2][4][2], const Unit& u, int wr, int wc, int fr, int fq) const {
        const int row0 = u.pm * BM + wr * 64 + fr, col0 = u.pn * BM + wc * 32 + 4 * fq;
#pragma unroll
        for (int ai = 0; ai < 2; ++ai)
#pragma unroll
            for (int m = 0; m < 4; ++m) { const size_t off = (size_t)(row0 + ai * HALF + m * 16) * DM + col0;
#pragma unroll
                for (int bj = 0; bj < 2; ++bj)
#pragma unroll
                    for (int n = 0; n < 2; ++n) *(f32x4*)(out + off + bj * HALF + n * 16) = *(const f32x4*)(x + off + bj * HALF + n * 16) + acc[ai][bj][m][n];
                asm volatile("" ::: "memory"); }
    }
};
struct OrderG1 {
    StaticOrder so; int pm0, nkv;
    __device__ void init(int hb, int G, int c) { so.init(HB_ROWS, NIN, G, c); pm0 = hb * (HB_ROWS / BM); nkv = hb == 0 ? (MMEM / BM) * 4 : 0; }
    __device__ bool next(int i, Unit& u) const {
        if (so.next(i, u)) { u.pm += pm0; return true; }
        const long j = (long)i * so.G + so.c - so.nwg; if (j < 0 || j >= nkv) return false;
        u.pm = 256 + (int)(j >> 2); u.pn = 35 + (int)(j & 3); return true;
    }
    __device__ __forceinline__ void a_ready(const Unit&) const {}
    __device__ __forceinline__ void done(const Unit&) const {}
};
}

#define GAS __attribute__((address_space(1)))
#define LAS __attribute__((address_space(3)))
typedef unsigned short bf16;
typedef unsigned v4u __attribute__((ext_vector_type(4)));
typedef float f32x4 __attribute__((ext_vector_type(4)));
typedef short bf16x8 __attribute__((ext_vector_type(8)));
typedef GAS unsigned gu32;
typedef GAS unsigned long long gu64;
#define RLX_AGENT __ATOMIC_RELAXED, __HIP_MEMORY_SCOPE_AGENT
#define LDS_WAIT() asm volatile("s_waitcnt lgkmcnt(0)" ::: "memory")
#define VM_WAIT() asm volatile("s_waitcnt vmcnt(0)" ::: "memory")
__device__ __forceinline__ unsigned long long rt() { return __builtin_amdgcn_s_memrealtime(); }
__device__ __forceinline__ unsigned f2bf(float f) { unsigned u = __builtin_bit_cast(unsigned, f); return (u + 0x7fffu + ((u >> 16) & 1u)) >> 16; }
__device__ __forceinline__ unsigned pk2(float lo, float hi) { return f2bf(lo) | (f2bf(hi) << 16); }

__device__ __forceinline__ int hw_lane() { int l; asm volatile("v_mbcnt_lo_u32_b32 %0, -1, 0\n\tv_mbcnt_hi_u32_b32 %0, -1, %0" : "=v"(l)); return l; }
__device__ __forceinline__ bool hw_thread0(int wave) { return wave == 0 && hw_lane() == 0; }
#define XB_TMO      128
#define XB_XCNT(j)  (256  + 64 * (j))
#define XB_XSUB(j)  (1280 + 64 * (j))
#define XB_XGEN(j)  (2304 + 64 * (j))
#define XB_TOP      3328
#define XB_TOPGEN   3392
#define XCD_BAR_WORDS 3456
#define XB_SPIN_CAP (1u << 18)

__device__ __forceinline__ unsigned xb_ld(unsigned* p)              { return __hip_atomic_load(p, __ATOMIC_RELAXED, __HIP_MEMORY_SCOPE_AGENT); }
__device__ __forceinline__ unsigned xb_add(unsigned* p, unsigned v) { return __hip_atomic_fetch_add(p, v, __ATOMIC_RELAXED, __HIP_MEMORY_SCOPE_AGENT); }
__device__ __forceinline__ unsigned xb_xcc_id() { return (unsigned)__builtin_amdgcn_s_getreg((3 << 11) | 20) & 0xFu; }
#define XB_SPIN(cond, bar) do { unsigned _sp = 0; while (cond) { __builtin_amdgcn_s_sleep(1); \
    if ((++_sp & 255u) == 0u) { if (xb_ld(&(bar)[XB_TMO])) break; if (_sp > XB_SPIN_CAP) { atomicAdd(&(bar)[XB_TMO], 1u); break; } } } } while (0)

struct XcdBarrier {
    unsigned* bar; unsigned x; int wave;
    volatile LAS unsigned* st;
};

__device__ __forceinline__ XcdBarrier xcd_barrier_post(unsigned* bar, volatile LAS unsigned* st, int wave) {
    XcdBarrier b; b.bar = bar; b.x = xb_xcc_id(); b.st = st; b.wave = wave;
    if (hw_thread0(wave)) (void)xb_add(&bar[XB_XCNT(b.x)], 1u);
    return b;
}
__device__ __forceinline__ void xcd_barrier_complete(unsigned* bar, unsigned x, unsigned& nloc, unsigned& nx) {
    const unsigned G = gridDim.x * gridDim.y * gridDim.z;
    unsigned sum, cnt, mine, sp = 0u;
    for (;;) {
        sum = 0u; cnt = 0u; mine = 0u;
#pragma unroll
        for (unsigned j = 0; j < 16; ++j) { const unsigned c = xb_ld(&bar[XB_XCNT(j)]); sum += c; cnt += (c > 0u) ? 1u : 0u; mine = (j == x) ? c : mine; }
        if (sum == G) break;
        __builtin_amdgcn_s_sleep(1);
        if ((++sp & 255u) == 0u) { if (xb_ld(&bar[XB_TMO])) break; if (sp > XB_SPIN_CAP) { atomicAdd(&bar[XB_TMO], 1u); break; } }
    }
    nloc = mine > 0u ? mine : 1u; nx = cnt > 0u ? cnt : 1u;
}

__device__ __forceinline__ void xcd_barrier(const XcdBarrier& b) {
    asm volatile("s_waitcnt vmcnt(0)" ::: "memory");
    __syncthreads();
    if (hw_thread0(b.wave)) {
        unsigned* bar = b.bar;
        __builtin_amdgcn_s_waitcnt(0);
        unsigned nloc = b.st[0], nx = b.st[1];
        if (nloc == 0u) { xcd_barrier_complete(bar, b.x, nloc, nx); b.st[0] = nloc; b.st[1] = nx; }
        const unsigned old = xb_add(&bar[XB_XSUB(b.x)], 1u);
        const unsigned gen = old / nloc;
        if (old + 1u == (gen + 1u) * nloc) {
            __builtin_amdgcn_fence(__ATOMIC_RELEASE, "agent");
            asm volatile("s_waitcnt vmcnt(0)" ::: "memory");
            const unsigned og = xb_add(&bar[XB_TOP], 1u);
            const unsigned tg = og / nx;
            if (og + 1u == (tg + 1u) * nx) xb_add(&bar[XB_TOPGEN], 1u);
            else XB_SPIN(xb_ld(&bar[XB_TOPGEN]) == tg, bar);
            __builtin_amdgcn_fence(__ATOMIC_ACQUIRE, "agent");
            xb_add(&bar[XB_XGEN(b.x)], 1u);
            asm volatile("s_waitcnt vmcnt(0)" ::: "memory");
        } else {
            XB_SPIN(xb_ld(&bar[XB_XGEN(b.x)]) == gen, bar);
            __builtin_amdgcn_fence(__ATOMIC_ACQUIRE, "agent");
            asm volatile("s_waitcnt vmcnt(0)" ::: "memory");
        }
    }
    __syncthreads();
}

__device__ __forceinline__ float wave_sum(float v) {
#pragma unroll
    for (int o = 1; o < 64; o <<= 1) v += __shfl_xor(v, o);
    return v;
}

constexpr int RING_OFF = 0, RING_BYTES = 131072;
constexpr int LDSCTL_OFF = RING_BYTES, MISC_OFF = LDSCTL_OFF + 320;
constexpr int LDS_BYTES = 147456;
constexpr int NWAVES = 8, NTHR = NWAVES * 64;

__device__ __forceinline__ float bf2f(bf16 h) { return __builtin_bit_cast(float, (unsigned)h << 16); }
__device__ __forceinline__ float sigm_f(float x) { return 1.f / (1.f + __expf(-x)); }
__device__ __forceinline__ int t5_bucket(int d) {
    if (d < 16) return d;
    int b = 16;
    b += d >= 22; b += d >= 30; b += d >= 40; b += d >= 54; b += d >= 73; b += d >= 99; b += d >= 134; b += d >= 182; b += d >= 246; b += d >= 332; b += d >= 450; b += d >= 609; b += d >= 825; b += d >= 1117; b += d >= 1513;
    return b;
}

struct Ctx {
    const float *x, *mem, *norm_w, *w_in, *gate_b, *lnw, *lnb, *sp_w, *sp_b, *bqw, *bkw, *rel_bias, *mem_norm_w, *m_w_kv, *mqw, *mkw, *proj_a, *proj_b, *proj_m, *w_out;
    float* out;
    bf16 *WIN, *PCAT, *WOUT, *WSP, *XN, *PA, *KVM, *OG, *YC, *MRG; float *BIAS, *BIASX, *SS, *MKSS, *LSE, *LNST;
    LAS unsigned char* lds; int tid, lane, wave, G, gtid, T, gwave, NW;
};

__device__ __forceinline__ void p0_transpose_item(const float* W, int N, bf16* WT, int ldt, int row_off, int koff, LAS float* scr, int item, int lane) {
    const int nblk = N / 32, kb = item / nblk, nb = item % nblk, k0 = 64 * kb, n0 = 32 * nb;
#pragma unroll 8
    for (int i = 0; i < 32; ++i) { const int kk = 2 * i + (lane >> 5); scr[kk * 33 + (lane & 31)] = W[(size_t)(k0 + kk) * N + n0 + (lane & 31)]; }
    LDS_WAIT(); asm volatile("" ::: "memory");
    const int c = lane & 7;
#pragma unroll
    for (int j = 0; j < 4; ++j) { const int n = (lane >> 3) + 8 * j; const LAS float* s = scr + (8 * c) * 33 + n;
        v4u o; o.x = pk2(s[0 * 33], s[1 * 33]); o.y = pk2(s[2 * 33], s[3 * 33]); o.z = pk2(s[4 * 33], s[5 * 33]); o.w = pk2(s[6 * 33], s[7 * 33]);
        *(GAS v4u*)(WT + (size_t)(row_off + n0 + n) * ldt + koff + k0 + 8 * c) = o; }
    LDS_WAIT(); asm volatile("" ::: "memory");
}
__device__ __forceinline__ void rms_row_to_bf16(const float* xrow, const float* w, bf16* orow, int lane) {
    const GAS f32x4* xr = (const GAS f32x4*)xrow + lane; const GAS f32x4* wr = (const GAS f32x4*)w + lane;
    f32x4 v[4]; float s = 0.f;
#pragma unroll
    for (int j = 0; j < 4; ++j) { v[j] = xr[64 * j]; s += (v[j].x * v[j].x + v[j].y * v[j].y) + (v[j].z * v[j].z + v[j].w * v[j].w); }
    const float rs = rsqrtf(wave_sum(s) * (1.f / DM) + EPS);
    GAS unsigned long long* o8 = (GAS unsigned long long*)orow + lane;
#pragma unroll
    for (int j = 0; j < 4; ++j) { const f32x4 ww = wr[64 * j]; o8[64 * j] = (unsigned long long)pk2(v[j].x * rs * ww.x, v[j].y * rs * ww.y) | ((unsigned long long)pk2(v[j].z * rs * ww.z, v[j].w * rs * ww.w) << 32); }
}
__device__ __forceinline__ void p0_prologue(Ctx& F) {
    LAS float* scr = (LAS float*)(F.lds + RING_OFF + F.wave * 16384);
    constexpr int I_IN = 16 * (NIN / 32), I_KV = 16 * 32, I_PA = 12 * 32, I_PB = 4 * 32, I_PM = 8 * 32, I_WO = 16 * 32;
    constexpr int NITEMS = I_IN + I_KV + I_PA + I_PB + I_PM + I_WO;
    for (int it = F.gwave; it < NITEMS; it += F.NW) {
        int r = it;
        if (r < I_IN) { p0_transpose_item(F.w_in, NIN, F.WIN, DM, 0, 0, scr, r, F.lane); continue; } r -= I_IN;
        if (r < I_KV) { p0_transpose_item(F.m_w_kv, 1024, F.WIN, DM, NIN, 0, scr, r, F.lane); continue; } r -= I_KV;
        if (r < I_PA) { p0_transpose_item(F.proj_a, DM, F.PCAT, KC, 0, 0, scr, r, F.lane); continue; } r -= I_PA;
        if (r < I_PB) { p0_transpose_item(F.proj_b, DM, F.PCAT, KC, 0, 768, scr, r, F.lane); continue; } r -= I_PB;
        if (r < I_PM) { p0_transpose_item(F.proj_m, DM, F.PCAT, KC, 0, 1024, scr, r, F.lane); continue; } r -= I_PM;
        p0_transpose_item(F.w_out, DM, F.WOUT, DM, 0, 0, scr, r, F.lane);
    }
    for (int i = F.gtid; i < 4 * 128 * 128; i += F.T) { const int t = (i >> 7) & 127, s = i & 127; F.WSP[i] = (bf16)(s <= t ? f2bf(F.sp_w[i]) : 0u); }
    for (int i = F.gtid; i < 3 * 4 * 132; i += F.T) { const int g = i / (4 * 132), h = (i / 132) % 4, j = i % 132; const int dil = g == 0 ? 1 : (g == 1 ? 4 : 16);
        F.BIAS[i] = j <= 128 ? F.rel_bias[t5_bucket(j * dil) * 12 + 4 * g + h] : 0.f; }
    for (int i = F.gtid; i < 3 * 4 * 192; i += F.T) { const int g = i / (4 * 192), h = (i / 192) % 4, step = i % 192 - 31; const int dil = g == 0 ? 1 : (g == 1 ? 4 : 16);
        F.BIASX[i] = (step >= 0 && step <= 128) ? F.rel_bias[t5_bucket(step * dil) * 12 + 4 * g + h] * 1.4426950408889634f : -1e30f; }
    for (int m = F.gwave; m < MTOT + MMEM; m += F.NW) {
        if (m < MTOT) rms_row_to_bf16(F.x + (size_t)m * DM, F.norm_w, F.XN + (size_t)m * DM, F.lane);
        else rms_row_to_bf16(F.mem + (size_t)(m - MTOT) * DM, F.mem_norm_w, F.XN + (size_t)m * DM, F.lane);
    }
}

__device__ __forceinline__ void st_lnstat(Ctx& F) {
    for (int r = F.gtid; r < HB_ROWS; r += F.T) {
        float s = 0.f, q = 0.f; for (int b = 0; b < 24; ++b) { s += F.SS[(size_t)r * SS_W + 2 * b]; q += F.SS[(size_t)r * SS_W + 2 * b + 1]; }
        const float mu = s * (1.f / 768.f), var = q * (1.f / 768.f) - mu * mu;
        F.LNST[2 * r] = mu; F.LNST[2 * r + 1] = rsqrtf(fmaxf(var, 0.f) + EPS); }
}
__device__ __forceinline__ void st_mixA(Ctx& F) {
    for (size_t gid = F.gtid; gid < (size_t)HB_ROWS * 768; gid += F.T) {
        const int r = (int)(gid / 768), c = (int)(gid % 768), g = c / 192, t = r & 127, r0 = r - t;
        float acc = 0.f;
        for (int s = 0; s <= t; ++s) { const float gv = bf2f(F.PA[(size_t)(r0 + s) * NIN + C_AV + c]);
            const float vv = (gv - F.LNST[2 * (r0 + s)]) * F.LNST[2 * (r0 + s) + 1] * F.lnw[c] + F.lnb[c];
            acc += bf2f(F.WSP[(g * 128 + t) * 128 + s]) * vv; }
        acc += F.sp_b[g * 128 + t];
        const float u = bf2f(F.PA[(size_t)r * NIN + C_AU + c]), z = bf2f(F.PA[(size_t)r * NIN + C_AZ + c]);
        F.YC[(size_t)r * KC + c] = (bf16)f2bf(u * acc * z); }
}
__device__ __forceinline__ void st_attnB(Ctx& F) {
    const int lane = F.lane;
    for (int w = F.gwave; w < 3 * HB_ROWS * 4; w += F.NW) {
        const int g = w / (HB_ROWS * 4), r = (w / 4) % HB_ROWS, h = w % 4, hh = 4 * g + h, dil = g == 0 ? 1 : (g == 1 ? 4 : 16), t = r % SEQ;
        const float qs = rsqrtf((F.SS[(size_t)r * SS_W + 48 + 2 * hh] + F.SS[(size_t)r * SS_W + 48 + 2 * hh + 1]) * (1.f / 64.f) + EPS);
        const float q = bf2f(F.PA[(size_t)r * NIN + C_BQ + hh * 64 + lane]) * qs * F.bqw[lane] * F.bkw[lane] * 0.125f;
        float m = -1e30f, l = 0.f, o = 0.f;
        for (int j = 0; j <= 128; ++j) { if (t - j * dil < 0) break; const int kr = r - j * dil;
            const float ks = rsqrtf((F.SS[(size_t)kr * SS_W + 72 + 2 * hh] + F.SS[(size_t)kr * SS_W + 72 + 2 * hh + 1]) * (1.f / 64.f) + EPS);
            const float s = wave_sum(q * bf2f(F.PA[(size_t)kr * NIN + C_BK + hh * 64 + lane])) * ks + F.BIAS[(g * 4 + h) * 132 + j];
            const float mn = fmaxf(m, s), a = __expf(m - mn), p = __expf(s - mn);
            l = l * a + p; o = o * a + p * bf2f(F.PA[(size_t)kr * NIN + C_BV + hh * 64 + lane]); m = mn; }
        F.OG[((size_t)g * HB_ROWS + r) * 256 + h * 64 + lane] = (bf16)f2bf(o / l);
        if (lane == 0) F.LSE[((size_t)g * HB_ROWS + r) * 4 + h] = m + __logf(l); }
}
__device__ __forceinline__ void st_mergeB(Ctx& F) {
    for (size_t gid = F.gtid; gid < (size_t)HB_ROWS * 256; gid += F.T) {
        const int r = (int)(gid / 256), c = (int)(gid % 256), h = c / 64;
        const float l0 = F.LSE[((size_t)0 * HB_ROWS + r) * 4 + h], l1 = F.LSE[((size_t)1 * HB_ROWS + r) * 4 + h], l2 = F.LSE[((size_t)2 * HB_ROWS + r) * 4 + h];
        const float mx = fmaxf(l0, fmaxf(l1, l2)), e0 = __expf(l0 - mx), e1 = __expf(l1 - mx), e2 = __expf(l2 - mx), inv = 1.f / (e0 + e1 + e2);
        const float y = (e0 * bf2f(F.OG[((size_t)0 * HB_ROWS + r) * 256 + c]) + e1 * bf2f(F.OG[((size_t)1 * HB_ROWS + r) * 256 + c]) + e2 * bf2f(F.OG[((size_t)2 * HB_ROWS + r) * 256 + c])) * inv;
        F.YC[(size_t)r * KC + 768 + c] = (bf16)f2bf(y * bf2f(F.PA[(size_t)r * NIN + C_BZ + c])); }
}
__device__ __forceinline__ void st_attnM(Ctx& F, int row_base) {
    const int lane = F.lane;
    for (int w = F.gwave; w < HB_ROWS * 4; w += F.NW) {
        const int r = w / 4, h = w % 4, b = (row_base + r) / SEQ;
        float qq = 0.f; for (int i = 0; i < 4; ++i) qq += F.SS[(size_t)r * SS_W + 96 + 4 * h + i];
        const float qs = rsqrtf(qq * (1.f / 128.f) + EPS) * 0.08838834764831845f;
        const float q0 = bf2f(F.PA[(size_t)r * NIN + C_MQ + h * 128 + lane]) * qs * F.mqw[lane] * F.mkw[lane], q1 = bf2f(F.PA[(size_t)r * NIN + C_MQ + h * 128 + 64 + lane]) * qs * F.mqw[64 + lane] * F.mkw[64 + lane];
        float m = -1e30f, l = 0.f, o0 = 0.f, o1 = 0.f;
        for (int j = 0; j < MEML; ++j) { const size_t kr = (size_t)b * MEML + j;
            float kk = 0.f; for (int i = 0; i < 4; ++i) kk += F.MKSS[kr * 16 + 4 * h + i];
            const float ks = rsqrtf(kk * (1.f / 128.f) + EPS);
            const float s = wave_sum(q0 * bf2f(F.KVM[kr * 1024 + h * 128 + lane]) + q1 * bf2f(F.KVM[kr * 1024 + h * 128 + 64 + lane])) * ks;
            const float mn = fmaxf(m, s), a = __expf(m - mn), p = __expf(s - mn);
            l = l * a + p; o0 = o0 * a + p * bf2f(F.KVM[kr * 1024 + 512 + h * 128 + lane]); o1 = o1 * a + p * bf2f(F.KVM[kr * 1024 + 512 + h * 128 + 64 + lane]); m = mn; }
        F.YC[(size_t)r * KC + 1024 + h * 128 + lane] = (bf16)f2bf(o0 / l * bf2f(F.PA[(size_t)r * NIN + C_MZ + h * 128 + lane]));
        F.YC[(size_t)r * KC + 1024 + h * 128 + 64 + lane] = (bf16)f2bf(o1 / l * bf2f(F.PA[(size_t)r * NIN + C_MZ + h * 128 + 64 + lane])); }
}

typedef float f32x16 __attribute__((ext_vector_type(16)));
typedef short s16x4 __attribute__((ext_vector_type(4)));
__device__ __forceinline__ int crow(int r, int hi) { return (r & 3) + 8 * (r >> 2) + 4 * hi; }
__device__ __forceinline__ unsigned cvtpk(float lo, float hi) { unsigned r; asm volatile("v_cvt_pk_bf16_f32 %0, %1, %2" : "=v"(r) : "v"(lo), "v"(hi)); return r; }
__device__ __forceinline__ s16x4 vtr(const LAS unsigned char* p) { typedef short v4i16_t __attribute__((ext_vector_type(4))); return __builtin_bit_cast(s16x4, __builtin_amdgcn_ds_read_tr16_b64_v4i16((LAS v4i16_t*)p)); }
__device__ __forceinline__ float bflo(unsigned w) { return __uint_as_float(w << 16); }
__device__ __forceinline__ float bfhi(unsigned w) { return __uint_as_float(w & 0xffff0000u); }
constexpr float LOG2E = 1.4426950408889634f, LN2 = 0.6931471805599453f;
constexpr int NBX = 192;

__device__ __forceinline__ void st_attnB_mfma(Ctx& F) {
    const int lane = F.lane, r32 = lane & 31, hi = lane >> 5;
    LAS unsigned char* wl = F.lds + RING_OFF + F.wave * 16384;
    LAS float* btab = (LAS float*)(wl + 8192); LAS float* kst = (LAS float*)(wl + 9216);
    for (int it = F.gwave; it < 3 * 16 * 4 * 64; it += F.NW) {
        const int blk = it & 63, h = (it >> 6) & 3, gb = it >> 8, b = gb & 15, g = gb >> 4, hh = 4 * g + h;
        const int dil = g == 0 ? 1 : (g == 1 ? 4 : 16), nqb = 64 / dil, res = blk / nqb, q0 = (blk % nqb) * 32;
        const int rbase = b * SEQ + res;
        for (int i = lane; i < NBX; i += 64) btab[i] = F.BIASX[(g * 4 + h) * NBX + i];
        const size_t qrow = (size_t)(rbase + (q0 + r32) * dil);
        const float qs = rsqrtf((F.SS[qrow * SS_W + 48 + 2 * hh] + F.SS[qrow * SS_W + 48 + 2 * hh + 1]) * (1.f / 64.f) + EPS) * (0.125f * LOG2E);
        bf16x8 qf[4];
#pragma unroll
        for (int d0 = 0; d0 < 4; ++d0) { const int dd = 16 * d0 + 8 * hi;
            const v4u raw = *(const v4u*)(F.PA + qrow * NIN + C_BQ + hh * 64 + dd);
            const f32x4 wa = *(const f32x4*)(F.bqw + dd), wb = *(const f32x4*)(F.bqw + dd + 4), ka = *(const f32x4*)(F.bkw + dd), kb = *(const f32x4*)(F.bkw + dd + 4);
            v4u o;
            o.x = cvtpk(bflo(raw.x) * qs * wa.x * ka.x, bfhi(raw.x) * qs * wa.y * ka.y); o.y = cvtpk(bflo(raw.y) * qs * wa.z * ka.z, bfhi(raw.y) * qs * wa.w * ka.w);
            o.z = cvtpk(bflo(raw.z) * qs * wb.x * kb.x, bfhi(raw.z) * qs * wb.y * kb.y); o.w = cvtpk(bflo(raw.w) * qs * wb.z * kb.z, bfhi(raw.w) * qs * wb.w * kb.w);
            qf[d0] = __builtin_bit_cast(bf16x8, o); }
        float mrun = -1e30f, lrun = 0.f; f32x16 o0 = {}, o1 = {};
        for (int k0 = (q0 >= 128 ? q0 - 128 : 0); k0 <= q0; k0 += 32) {
            const size_t krow = (size_t)(rbase + (k0 + r32) * dil);
            bf16x8 kf[4];
#pragma unroll
            for (int d0 = 0; d0 < 4; ++d0) kf[d0] = *(const bf16x8*)(F.PA + krow * NIN + C_BK + hh * 64 + 16 * d0 + 8 * hi);
            const float ksv = rsqrtf((F.SS[krow * SS_W + 72 + 2 * hh] + F.SS[krow * SS_W + 72 + 2 * hh + 1]) * (1.f / 64.f) + EPS);
            v4u vr[4];
#pragma unroll
            for (int i = 0; i < 4; ++i) vr[i] = *(const v4u*)(F.PA + (size_t)(rbase + (k0 + 8 * i + (lane >> 3)) * dil) * NIN + C_BV + hh * 64 + 8 * (lane & 7));
#pragma unroll
            for (int i = 0; i < 4; ++i) *(LAS v4u*)(wl + (2 * i + ((lane & 7) >> 2)) * 512 + (lane >> 3) * 64 + (lane & 3) * 16) = vr[i];
            if (lane < 32) kst[r32] = ksv;
            f32x16 st = {};
#pragma unroll
            for (int d0 = 0; d0 < 4; ++d0) st = __builtin_amdgcn_mfma_f32_32x32x16_bf16(kf[d0], qf[d0], st, 0, 0, 0);
            const int bidx = (q0 + r32) - k0 + 31 - 4 * hi;
            float tmax = -1e30f;
#pragma unroll
            for (int i = 0; i < 4; ++i) { const f32x4 kk = *(const LAS f32x4*)(kst + 8 * i + 4 * hi);
#pragma unroll
                for (int j = 0; j < 4; ++j) { const float s = st[4 * i + j] * kk[j] + btab[bidx - 8 * i - j]; st[4 * i + j] = s; tmax = fmaxf(tmax, s); } }
            tmax = fmaxf(tmax, __shfl_xor(tmax, 32));
            const float mnew = fmaxf(mrun, tmax), alpha = __builtin_amdgcn_exp2f(mrun - mnew); mrun = mnew;
            float psum = 0.f;
#pragma unroll
            for (int r = 0; r < 16; ++r) { st[r] = __builtin_amdgcn_exp2f(st[r] - mnew); psum += st[r]; }
            lrun = lrun * alpha + psum;
#pragma unroll
            for (int r = 0; r < 16; ++r) { o0[r] *= alpha; o1[r] *= alpha; }
            v4u p0, p1;
            p0.x = cvtpk(st[0], st[1]); p0.y = cvtpk(st[2], st[3]); p0.z = cvtpk(st[4], st[5]); p0.w = cvtpk(st[6], st[7]);
            p1.x = cvtpk(st[8], st[9]); p1.y = cvtpk(st[10], st[11]); p1.z = cvtpk(st[12], st[13]); p1.w = cvtpk(st[14], st[15]);
            const LAS unsigned char* vb = wl + (4 * hi + ((lane & 15) >> 2)) * 64 + ((lane >> 4) & 1) * 32 + (lane & 3) * 8;
#pragma unroll
            for (int s = 0; s < 2; ++s) { const bf16x8 pf = __builtin_bit_cast(bf16x8, s == 0 ? p0 : p1);
                { const s16x4 a = vtr(vb + (2 * s) * 1024), c = vtr(vb + (2 * s + 1) * 1024); const bf16x8 vf = {a[0], a[1], a[2], a[3], c[0], c[1], c[2], c[3]};
                  o0 = __builtin_amdgcn_mfma_f32_32x32x16_bf16(vf, pf, o0, 0, 0, 0); }
                { const s16x4 a = vtr(vb + (2 * s) * 1024 + 512), c = vtr(vb + (2 * s + 1) * 1024 + 512); const bf16x8 vf = {a[0], a[1], a[2], a[3], c[0], c[1], c[2], c[3]};
                  o1 = __builtin_amdgcn_mfma_f32_32x32x16_bf16(vf, pf, o1, 0, 0, 0); } }
        }
        const float ltot = lrun + __shfl_xor(lrun, 32), inv = 1.f / ltot;
        bf16* orow = F.OG + ((size_t)g * HB_ROWS + qrow) * 256 + h * 64 + 4 * hi;
        typedef unsigned u32x2v __attribute__((ext_vector_type(2)));
#pragma unroll
        for (int i = 0; i < 4; ++i) { u32x2v w0, w1; w0.x = cvtpk(o0[4 * i] * inv, o0[4 * i + 1] * inv); w0.y = cvtpk(o0[4 * i + 2] * inv, o0[4 * i + 3] * inv);
            w1.x = cvtpk(o1[4 * i] * inv, o1[4 * i + 1] * inv); w1.y = cvtpk(o1[4 * i + 2] * inv, o1[4 * i + 3] * inv);
            *(u32x2v*)(orow + 8 * i) = w0; *(u32x2v*)(orow + 32 + 8 * i) = w1; }
        if (hi == 0) F.LSE[((size_t)g * HB_ROWS + qrow) * 4 + h] = (mrun + __log2f(ltot)) * LN2;
    }
}

__device__ __forceinline__ void st_attnM_mfma(Ctx& F, int hb) {
    const int lane = F.lane, r32 = lane & 31, hi = lane >> 5;
    LAS unsigned char* wl = F.lds + RING_OFF + F.wave * 16384;
    LAS float* kst = (LAS float*)(wl + 9216);
    typedef unsigned u32x2v __attribute__((ext_vector_type(2)));
    for (int it = F.gwave; it < 16 * 64 * 4; it += F.NW) {
        const int h = it & 3, qb = (it >> 2) & 63, b = it >> 8;
        const size_t qrow = (size_t)(b * SEQ + qb * 32 + r32); const size_t kbase = (size_t)(hb * 16 + b) * MEML;
        const float qs = rsqrtf(((F.SS[qrow * SS_W + 96 + 4 * h] + F.SS[qrow * SS_W + 96 + 4 * h + 1]) + (F.SS[qrow * SS_W + 96 + 4 * h + 2] + F.SS[qrow * SS_W + 96 + 4 * h + 3])) * (1.f / 128.f) + EPS) * (0.08838834764831845f * LOG2E);
        bf16x8 qf[8];
#pragma unroll
        for (int d0 = 0; d0 < 8; ++d0) { const int dd = 16 * d0 + 8 * hi;
            const v4u raw = *(const v4u*)(F.PA + qrow * NIN + C_MQ + h * 128 + dd);
            const f32x4 wa = *(const f32x4*)(F.mqw + dd), wb = *(const f32x4*)(F.mqw + dd + 4), ka = *(const f32x4*)(F.mkw + dd), kb = *(const f32x4*)(F.mkw + dd + 4);
            v4u o;
            o.x = cvtpk(bflo(raw.x) * qs * wa.x * ka.x, bfhi(raw.x) * qs * wa.y * ka.y); o.y = cvtpk(bflo(raw.y) * qs * wa.z * ka.z, bfhi(raw.y) * qs * wa.w * ka.w);
            o.z = cvtpk(bflo(raw.z) * qs * wb.x * kb.x, bfhi(raw.z) * qs * wb.y * kb.y); o.w = cvtpk(bflo(raw.w) * qs * wb.z * kb.z, bfhi(raw.w) * qs * wb.w * kb.w);
            qf[d0] = __builtin_bit_cast(bf16x8, o); }
        float mrun = -1e30f, lrun = 0.f; f32x16 o0 = {}, o1 = {}, o2 = {}, o3 = {};
        for (int k0 = 0; k0 < MEML; k0 += 32) {
            const size_t krow = kbase + k0 + r32;
            bf16x8 kf[8];
#pragma unroll
            for (int d0 = 0; d0 < 8; ++d0) kf[d0] = *(const bf16x8*)(F.KVM + krow * 1024 + h * 128 + 16 * d0 + 8 * hi);
            const float ksv = rsqrtf(((F.MKSS[krow * 16 + 4 * h] + F.MKSS[krow * 16 + 4 * h + 1]) + (F.MKSS[krow * 16 + 4 * h + 2] + F.MKSS[krow * 16 + 4 * h + 3])) * (1.f / 128.f) + EPS);
#pragma unroll
            for (int i = 0; i < 8; ++i) { const v4u vr = *(const v4u*)(F.KVM + (kbase + k0 + 4 * i + (lane >> 4)) * 1024 + 512 + h * 128 + 8 * (lane & 15));
                *(LAS v4u*)(wl + ((i >> 1) * 4 + ((lane & 15) >> 2)) * 512 + (4 * (i & 1) + (lane >> 4)) * 64 + (lane & 3) * 16) = vr; }
            if (lane < 32) kst[r32] = ksv;
            f32x16 st = {};
#pragma unroll
            for (int d0 = 0; d0 < 8; ++d0) st = __builtin_amdgcn_mfma_f32_32x32x16_bf16(kf[d0], qf[d0], st, 0, 0, 0);
            float tmax = -1e30f;
#pragma unroll
            for (int i = 0; i < 4; ++i) { const f32x4 kk = *(const LAS f32x4*)(kst + 8 * i + 4 * hi);
#pragma unroll
                for (int j = 0; j < 4; ++j) { const float s = st[4 * i + j] * kk[j]; st[4 * i + j] = s; tmax = fmaxf(tmax, s); } }
            tmax = fmaxf(tmax, __shfl_xor(tmax, 32));
            const float mnew = fmaxf(mrun, tmax), alpha = __builtin_amdgcn_exp2f(mrun - mnew); mrun = mnew;
            float psum = 0.f;
#pragma unroll
            for (int r = 0; r < 16; ++r) { st[r] = __builtin_amdgcn_exp2f(st[r] - mnew); psum += st[r]; }
            lrun = lrun * alpha + psum;
#pragma unroll
            for (int r = 0; r < 16; ++r) { o0[r] *= alpha; o1[r] *= alpha; o2[r] *= alpha; o3[r] *= alpha; }
            v4u p0, p1;
            p0.x = cvtpk(st[0], st[1]); p0.y = cvtpk(st[2], st[3]); p0.z = cvtpk(st[4], st[5]); p0.w = cvtpk(st[6], st[7]);
            p1.x = cvtpk(st[8], st[9]); p1.y = cvtpk(st[10], st[11]); p1.z = cvtpk(st[12], st[13]); p1.w = cvtpk(st[14], st[15]);
            const LAS unsigned char* vb = wl + (4 * hi + ((lane & 15) >> 2)) * 64 + ((lane >> 4) & 1) * 32 + (lane & 3) * 8;
#define AM_PV(OX, DB) do { _Pragma("unroll") for (int s = 0; s < 2; ++s) { const bf16x8 pf = __builtin_bit_cast(bf16x8, s == 0 ? p0 : p1); \
                const s16x4 a = vtr(vb + (2 * s) * 2048 + (DB) * 512), c = vtr(vb + (2 * s + 1) * 2048 + (DB) * 512); const bf16x8 vf = {a[0], a[1], a[2], a[3], c[0], c[1], c[2], c[3]}; \
                OX = __builtin_amdgcn_mfma_f32_32x32x16_bf16(vf, pf, OX, 0, 0, 0); } } while (0)
            AM_PV(o0, 0); AM_PV(o1, 1); AM_PV(o2, 2); AM_PV(o3, 3);
#undef AM_PV
        }
        const float ltot = lrun + __shfl_xor(lrun, 32), inv = 1.f / ltot;
        const bf16* zrow = F.PA + qrow * NIN + C_MZ + h * 128 + 4 * hi; bf16* yrow = F.YC + qrow * KC + 1024 + h * 128 + 4 * hi;
#define AM_ST(OX, DB) do { _Pragma("unroll") for (int i = 0; i < 4; ++i) { const u32x2v z = *(const u32x2v*)(zrow + (DB) * 32 + 8 * i); u32x2v w; \
            w.x = cvtpk(OX[4 * i] * inv * bflo(z.x), OX[4 * i + 1] * inv * bfhi(z.x)); w.y = cvtpk(OX[4 * i + 2] * inv * bflo(z.y), OX[4 * i + 3] * inv * bfhi(z.y)); \
            *(u32x2v*)(yrow + (DB) * 32 + 8 * i) = w; } } while (0)
        AM_ST(o0, 0); AM_ST(o1, 1); AM_ST(o2, 2); AM_ST(o3, 3);
#undef AM_ST
    }
}

__device__ __forceinline__ void st_mixA_mfma(Ctx& F) {
    const int lane = F.lane, r32 = lane & 31, hi = lane >> 5, tid = F.tid;
    LAS unsigned char* wl = F.lds + RING_OFF + F.wave * 16384;
    typedef float f32x2v __attribute__((ext_vector_type(2))); typedef unsigned u32x2v __attribute__((ext_vector_type(2)));
    LAS f32x2v* tab = (LAS f32x2v*)(F.lds + RING_OFF + 12288);
    for (int unit = blockIdx.x; unit < HB_ROWS / 128; unit += F.G) {
        const int rowbase = unit * 128;
        { const int row = tid >> 2, part = tid & 3; const float* sp = F.SS + (size_t)(rowbase + row) * SS_W + 12 * part; float s = 0.f, q = 0.f;
#pragma unroll
          for (int k = 0; k < 6; ++k) { s += sp[2 * k]; q += sp[2 * k + 1]; }
          s += __shfl_xor(s, 1); s += __shfl_xor(s, 2); q += __shfl_xor(q, 1); q += __shfl_xor(q, 2);
          const float mu = s * (1.f / 768.f), var = q * (1.f / 768.f) - mu * mu;
          if (part == 0) tab[row] = (f32x2v){mu, rsqrtf(fmaxf(var, 0.f) + EPS)}; }
        __syncthreads();
        const int g = F.wave >> 1;
        for (int cbi = 0; cbi < 3; ++cbi) {
            const int c0 = g * 192 + ((F.wave & 1) * 3 + cbi) * 32, ch = lane & 3;
            const f32x4 w0 = *(const f32x4*)(F.lnw + c0 + 8 * ch), w1 = *(const f32x4*)(F.lnw + c0 + 8 * ch + 4), b0 = *(const f32x4*)(F.lnb + c0 + 8 * ch), b1 = *(const f32x4*)(F.lnb + c0 + 8 * ch + 4);
#pragma unroll
            for (int i = 0; i < 8; ++i) { const int s = (lane >> 2) + 16 * i;
                const v4u raw = *(const v4u*)(F.PA + (size_t)(rowbase + s) * NIN + C_AV + c0 + 8 * ch); const f32x2v st = tab[s]; v4u o;
                o.x = cvtpk((bflo(raw.x) - st.x) * st.y * w0.x + b0.x, (bfhi(raw.x) - st.x) * st.y * w0.y + b0.y); o.y = cvtpk((bflo(raw.y) - st.x) * st.y * w0.z + b0.z, (bfhi(raw.y) - st.x) * st.y * w0.w + b0.w);
                o.z = cvtpk((bflo(raw.z) - st.x) * st.y * w1.x + b1.x, (bfhi(raw.z) - st.x) * st.y * w1.y + b1.y); o.w = cvtpk((bflo(raw.w) - st.x) * st.y * w1.z + b1.z, (bfhi(raw.w) - st.x) * st.y * w1.w + b1.w);
                *(LAS v4u*)(wl + (s >> 3) * 512 + (s & 7) * 64 + ch * 16) = o; }
            const LAS unsigned char* vb = wl + hi * 512 + ((lane & 15) >> 2) * 64 + ((lane >> 4) & 1) * 32 + (lane & 3) * 8;
#pragma unroll
            for (int tb = 0; tb < 4; ++tb) { f32x16 acc = {};
                const bf16* wrow = F.WSP + (size_t)(g * 128 + 32 * tb + r32) * 128 + 8 * hi;
#pragma unroll
                for (int ks = 0; ks < 2 * (tb + 1); ++ks) { const s16x4 a = vtr(vb + ks * 1024), c = vtr(vb + ks * 1024 + 256); const bf16x8 af = {a[0], a[1], a[2], a[3], c[0], c[1], c[2], c[3]};
                    const bf16x8 bfr = *(const bf16x8*)(wrow + 16 * ks); acc = __builtin_amdgcn_mfma_f32_32x32x16_bf16(af, bfr, acc, 0, 0, 0); }
                const int t = 32 * tb + r32; const size_t row = (size_t)(rowbase + t); const float sb = F.sp_b[g * 128 + t];
                const bf16* up = F.PA + row * NIN + C_AU + c0 + 4 * hi; const bf16* zp = F.PA + row * NIN + C_AZ + c0 + 4 * hi; bf16* yp = F.YC + row * KC + c0 + 4 * hi;
#pragma unroll
                for (int i = 0; i < 4; ++i) { const u32x2v u = *(const u32x2v*)(up + 8 * i), z = *(const u32x2v*)(zp + 8 * i); u32x2v w;
                    w.x = cvtpk(bflo(u.x) * (acc[4 * i] + sb) * bflo(z.x), bfhi(u.x) * (acc[4 * i + 1] + sb) * bfhi(z.x)); w.y = cvtpk(bflo(u.y) * (acc[4 * i + 2] + sb) * bflo(z.y), bfhi(u.y) * (acc[4 * i + 3] + sb) * bfhi(z.y));
                    *(u32x2v*)(yp + 8 * i) = w; } }
        }
        __syncthreads();
    }
}

__device__ __forceinline__ void st_mergeB_vec(Ctx& F) {
    for (int gid = F.gtid; gid < HB_ROWS * 32; gid += F.T) {
        const int r = gid >> 5, c8 = (gid & 31) * 8, h = c8 >> 6;
        const float l0 = F.LSE[((size_t)0 * HB_ROWS + r) * 4 + h], l1 = F.LSE[((size_t)1 * HB_ROWS + r) * 4 + h], l2 = F.LSE[((size_t)2 * HB_ROWS + r) * 4 + h];
        const float mx = fmaxf(l0, fmaxf(l1, l2)); float e0 = __expf(l0 - mx), e1 = __expf(l1 - mx), e2 = __expf(l2 - mx); const float inv = 1.f / (e0 + e1 + e2); e0 *= inv; e1 *= inv; e2 *= inv;
        const v4u a = *(const v4u*)(F.OG + ((size_t)0 * HB_ROWS + r) * 256 + c8), b = *(const v4u*)(F.OG + ((size_t)1 * HB_ROWS + r) * 256 + c8), c = *(const v4u*)(F.OG + ((size_t)2 * HB_ROWS + r) * 256 + c8);
        const v4u z = *(const v4u*)(F.PA + (size_t)r * NIN + C_BZ + c8); v4u o;
#define MB_1(X) X = pk2((e0 * bflo(a.X) + e1 * bflo(b.X) + e2 * bflo(c.X)) * bflo(z.X), (e0 * bfhi(a.X) + e1 * bfhi(b.X) + e2 * bfhi(c.X)) * bfhi(z.X))
        o.MB_1(x); o.MB_1(y); o.MB_1(z); o.MB_1(w);
#undef MB_1
        *(v4u*)(F.YC + (size_t)r * KC + 768 + c8) = o; }
}

#ifndef PROBE_REP
#define PROBE_REP -1
#endif
#define REPS(id) for (int rep_ = 0; rep_ < ((PROBE_REP) == (id) ? 2 : 1); ++rep_)
#ifndef MK_PER_PHASE
#define MK_PER_PHASE 0
#endif
constexpr int NPH_HALF = 5, NPHASES = 1 + 2 * NPH_HALF;
struct Args { const float* in[20]; float* out; unsigned char* ws; int ph_lo, ph_hi; };
__global__ void __launch_bounds__(NTHR, 2) mega_fwd(Args args) {
    extern __shared__ __attribute__((aligned(16))) unsigned char lds_raw[];
    Ctx F;
    F.lds = (LAS unsigned char*)lds_raw;
    F.tid = threadIdx.x; F.lane = F.tid & 63; F.wave = __builtin_amdgcn_readfirstlane(F.tid >> 6);
    F.G = gridDim.x; F.gtid = blockIdx.x * NTHR + F.tid; F.T = F.G * NTHR; F.gwave = blockIdx.x * NWAVES + F.wave; F.NW = F.G * NWAVES;
    unsigned char* ws = args.ws;
    F.x = args.in[0]; F.mem = args.in[1]; F.norm_w = args.in[2]; F.w_in = args.in[3]; F.gate_b = args.in[4]; F.lnw = args.in[5]; F.lnb = args.in[6]; F.sp_w = args.in[7];
    F.sp_b = args.in[8]; F.bqw = args.in[9]; F.bkw = args.in[10]; F.rel_bias = args.in[11]; F.mem_norm_w = args.in[12]; F.m_w_kv = args.in[13]; F.mqw = args.in[14]; F.mkw = args.in[15];
    F.proj_a = args.in[16]; F.proj_b = args.in[17]; F.proj_m = args.in[18]; F.w_out = args.in[19]; F.out = args.out;
    F.WIN = (bf16*)(ws + WS_WIN); F.PCAT = (bf16*)(ws + WS_PCAT); F.WOUT = (bf16*)(ws + WS_WOUT); F.WSP = (bf16*)(ws + WS_WSP); F.BIAS = (float*)(ws + WS_BIAS); F.BIASX = (float*)(ws + WS_BIAS + 65536);
    F.XN = (bf16*)(ws + WS_XN); F.PA = (bf16*)(ws + WS_PA); F.KVM = (bf16*)(ws + WS_KVM); F.SS = (float*)(ws + WS_SS); F.MKSS = (float*)(ws + WS_MKSS);
    F.OG = (bf16*)(ws + WS_OG); F.LSE = (float*)(ws + WS_LSE); F.LNST = (float*)(ws + WS_LNST); F.YC = (bf16*)(ws + WS_YC); F.MRG = (bf16*)(ws + WS_MRG);
    for (int u = F.tid; u < (LDS_BYTES - LDSCTL_OFF) / 4; u += NTHR) ((LAS unsigned*)(F.lds + LDSCTL_OFF))[u] = 0u;
    __syncthreads();
    XcdBarrier bar; bar.bar = (unsigned*)(ws + WS_CTL) + CW_BAR; bar.x = 0; bar.st = nullptr; bar.wave = 0;
    if (!MK_PER_PHASE) bar = xcd_barrier_post((unsigned*)(ws + WS_CTL) + CW_BAR, (volatile LAS unsigned*)(F.lds + MISC_OFF) + 8, F.wave);
    const int lo = args.ph_lo, hi = args.ph_hi;
#define IN(k) (lo <= (k) && (k) < hi)
#define SEAM(k) do { if (IN(k) && IN((k) + 1)) xcd_barrier(bar); } while (0)

    if (IN(0)) { REPS(0) p0_prologue(F); } SEAM(0);
#pragma unroll 1
    for (int hb = 0; hb < 2; ++hb) {
        const int pb = 1 + hb * NPH_HALF, row0 = hb * HB_ROWS;
        asm volatile("v_mbcnt_lo_u32_b32 %0, -1, 0\n\tv_mbcnt_hi_u32_b32 %0, -1, %0" : "=v"(F.lane)); F.tid = F.wave * 64 + F.lane; F.gtid = blockIdx.x * NTHR + F.tid;
        if (IN(pb + 0)) REPS(1) {
            pg8::Gemm g{F.XN, F.WIN, MTOT + MMEM, NIN + 1024, DM, DM, DM}; pg8::OrderG1 S; S.init(hb, F.G, (int)blockIdx.x);
            pg8::EpiProj E{F.PA, F.KVM, F.SS, F.MKSS, F.gate_b, hb * (HB_ROWS / 256), 0};
            pg8::gemm_phase<pg8::EpiProj, pg8::OrderG1, true, true>(F.lds + RING_OFF, g, S, E, F.wave);
        } SEAM(pb + 0);
        if (IN(pb + 1)) { REPS(2) st_mixA_mfma(F); REPS(3) st_attnB_mfma(F); REPS(4) st_attnM_mfma(F, hb); } SEAM(pb + 1);
        if (IN(pb + 2)) { REPS(5) st_mergeB_vec(F); } SEAM(pb + 2);
        if (IN(pb + 3)) REPS(6) {
            pg8::Gemm g{F.YC, F.PCAT, HB_ROWS, DM, KC, KC, KC}; pg8::StaticOrder S; S.init(HB_ROWS, DM, F.G, (int)blockIdx.x);
            pg8::EpiG2cat E{F.PA, F.MRG};
            pg8::gemm_phase<pg8::EpiG2cat, pg8::StaticOrder, true, true>(F.lds + RING_OFF, g, S, E, F.wave);
        } SEAM(pb + 3);
        if (IN(pb + 4)) REPS(7) {
            pg8::Gemm g{F.MRG, F.WOUT, HB_ROWS, DM, DM, DM, DM}; pg8::StaticOrder S; S.init(HB_ROWS, DM, F.G, (int)blockIdx.x);
            pg8::EpiG3 E{F.x + (size_t)row0 * DM, F.out + (size_t)row0 * DM};
            pg8::gemm_phase<pg8::EpiG3, pg8::StaticOrder, true, true>(F.lds + RING_OFF, g, S, E, F.wave);
        } SEAM(pb + 4);
    }
#undef IN
#undef SEAM
}

extern "C" void kernel_launch(void* const* d_in, const int* in_sizes, int n_in, void* d_out, int out_size, void* d_ws, size_t ws_size, hipStream_t stream) {
    static int grid = 0;
    if (grid == 0) {
        if (n_in != 20 || in_sizes[0] != MTOT * DM || out_size != MTOT * DM || ws_size < WS_END) { fprintf(stderr, "kernel_launch: unexpected shapes (n_in %d, ws %zu); nothing launched\n", n_in, ws_size); grid = -1; return; }
        int dev = 0, cus = 0, per_cu = 0;
        if (hipGetDevice(&dev) != hipSuccess || hipDeviceGetAttribute(&cus, hipDeviceAttributeMultiprocessorCount, dev) != hipSuccess) { grid = -1; return; }
        if (hipFuncSetAttribute((const void*)mega_fwd, hipFuncAttributeMaxDynamicSharedMemorySize, LDS_BYTES) != hipSuccess) { fprintf(stderr, "kernel_launch: hipFuncSetAttribute failed\n"); grid = -1; return; }
        if (hipOccupancyMaxActiveBlocksPerMultiprocessor(&per_cu, (const void*)mega_fwd, NTHR, LDS_BYTES) != hipSuccess || per_cu < 1) { fprintf(stderr, "kernel_launch: occupancy query says %d blocks per CU\n", per_cu); (void)hipGetLastError(); grid = -1; return; }
        grid = cus;
    }
    if (grid < 0) return;
    if (hipMemsetAsync((char*)d_ws + WS_CTL, 0, CTL_ZERO_BYTES, stream) != hipSuccess) return;
    Args a{};
    for (int i = 0; i < 20; ++i) a.in[i] = (const float*)d_in[i];
    a.out = (float*)d_out; a.ws = (unsigned char*)d_ws;
#if MK_PER_PHASE
    for (int p = 0; p < NPHASES; ++p) { a.ph_lo = p; a.ph_hi = p + 1; hipLaunchKernelGGL(mega_fwd, dim3(grid), dim3(NTHR), LDS_BYTES, stream, a); }
#else
    a.ph_lo = 0; a.ph_hi = NPHASES; hipLaunchKernelGGL(mega_fwd, dim3(grid), dim3(NTHR), LDS_BYTES, stream, a);
#endif
}
```

```cpp
#include <hip/hip_runtime.h>
#include <cstdint>
#include <cstdio>

constexpr int DM = 1024, NB = 32, SEQ = 2048, MTOT = NB * SEQ;
constexpr int NIN = 8960, MEML = 256, MMEM = NB * MEML;
constexpr int HB_ROWS = MTOT / 2;
constexpr int C_AU = 0, C_AV = 768, C_AZ = 1536, C_BQ = 2304, C_BK = 3072, C_BV = 3840, C_BZ = 4608, C_MQ = 4864, C_MZ = 5376, C_G = 5888;
constexpr float EPS = 1e-6f;
constexpr int SS_W = 112;
constexpr int KC = 1536;

constexpr size_t MiB = 1u << 20;
constexpr size_t WS_CTL = 0, CTL_ZERO_BYTES = 256 * 1024, WS_WIN = 2 * MiB, WS_PCAT = 22 * MiB, WS_WOUT = 25 * MiB, WS_WSP = 27 * MiB, WS_BIAS = 27 * MiB + 512 * 1024;
constexpr size_t WS_XN = 32 * MiB, WS_PA = 176 * MiB, WS_KVM = 736 * MiB, WS_SS = 752 * MiB, WS_MKSS = 766 * MiB, WS_OG = 768 * MiB, WS_LSE = 816 * MiB, WS_LNST = 818 * MiB;
constexpr size_t WS_YC = 820 * MiB, WS_MRG = 916 * MiB, WS_END = 980 * MiB;
constexpr int CW_BAR = 4096;

namespace pg8 {
#define PG8_LAS __attribute__((address_space(3)))
typedef unsigned short bf16_t;
typedef short bf16x8 __attribute__((ext_vector_type(8)));
typedef float f32x4 __attribute__((ext_vector_type(4)));
typedef unsigned u32x4 __attribute__((ext_vector_type(4)));
constexpr int BM = 256, BK = 64, HALF = 128, HTB = HALF * BK * 2  , STAGE_BYTES = 8 * HTB, NXCD = 8, WGM = 8;

__host__ __device__ __forceinline__ int lds_byte(int r, int c) { const int st = (r >> 4) * 2 + (c >> 5), rr = r & 15, cc = c & 31, ob = rr * 64 + cc * 2; return st * 1024 + (ob ^ (((ob >> 9) & 1) << 5)); }
__host__ __device__ __forceinline__ void stage_rc(int b, int& R, int& C) { const int st = b / 1024, sb = b % 1024, swz = sb ^ (((sb >> 9) & 1) << 5); R = (st >> 1) * 16 + swz / 64; C = (st & 1) * 32 + (swz % 64) / 2; }
__host__ __device__ __forceinline__ int perm32(int rho) { const int n = rho >> 4, i = rho & 15; return 8 * (i >> 2) + 4 * n + (i & 3); }

struct Unit { int pm, pn; };
struct Gemm { const bf16_t* A; const bf16_t* Bt; int M, N, K, lda, ldb; };

struct StaticOrder {
    int nM, nN, nwg, G, c;
    __host__ __device__ void init(int M, int N, int G_, int c_) { nM = M / BM; nN = N / BM; nwg = nM * nN; G = G_; c = c_; }
    __host__ __device__ bool next(int i, Unit& u) const {
        const long L = (long)i * G + c; if (L >= nwg) return false;
        int wgid = (int)L; { const int q = nwg / NXCD, r = nwg % NXCD, xcd = wgid % NXCD, off = wgid / NXCD; wgid = (xcd < r ? xcd * (q + 1) : r * (q + 1) + (xcd - r) * q) + off; }
        const int nig = WGM * nN, gid = wgid / nig, fm = gid * WGM, gsz = (nM - fm) < WGM ? (nM - fm) : WGM;
        u.pm = fm + ((wgid % nig) % gsz); u.pn = (wgid % nig) / gsz; return true;
    }
    __device__ __forceinline__ void a_ready(const Unit&) const {}
    __device__ __forceinline__ void done(const Unit&) const {}
};


__device__ __forceinline__ unsigned cvt_pk_bf16(float lo, float hi) { unsigned r; asm volatile("v_cvt_pk_bf16_f32 %0, %1, %2" : "=v"(r) : "v"(lo), "v"(hi)); return r; }
typedef float f32x2 __attribute__((ext_vector_type(2)));
__device__ __forceinline__ f32x2 gelu_pk(f32x2 v) {
    const f32x2 av = __builtin_elementwise_abs(v), d = av * 0.2316418882f + 1.0f;
    f32x2 t; t.x = __builtin_amdgcn_rcpf(d.x); t.y = __builtin_amdgcn_rcpf(d.y);
    f32x2 q = t * 0.5307027145f + (-0.7265760135f); q = q * t + 0.7107068705f; q = q * t + (-0.142248368f); q = q * t + 0.127414796f; q = q * t;
    const f32x2 s = (v * v) * (-0.72134752044f);
    f32x2 e; e.x = __builtin_amdgcn_exp2f(s.x); e.y = __builtin_amdgcn_exp2f(s.y);
    const f32x2 m = v * (q * e), r = v - m;
    f32x2 o; o.x = v.x < 0.f ? m.x : r.x; o.y = v.y < 0.f ? m.y : r.y; return o;
}

template <class Epi, class Sched, bool ALIGN_EPI = false, bool SP2 = false>
__device__ __forceinline__ void gemm_phase(PG8_LAS unsigned char* lds, const Gemm g, const Sched& S, const Epi& E, const int wave_id) {
    int tid; asm volatile("v_mbcnt_lo_u32_b32 %0, -1, 0\n\tv_mbcnt_hi_u32_b32 %0, -1, %0" : "=v"(tid)); tid += wave_id * 64;
    const int wid = __builtin_amdgcn_readfirstlane(tid >> 6), lane = tid & 63, wr = wid >> 2, wc = wid & 3, fr = lane & 15, fq = lane >> 4;
    int K = g.K; asm volatile("" : "+s"(K)); const int nt = K / BK;
    unsigned voffA[2], voffB[2];
#pragma unroll
    for (int i = 0; i < 2; ++i) { int R, C; stage_rc(tid * 16 + i * 8192, R, C); const int Rb = Epi::PERM ? ((R & ~31) + perm32(R & 31)) : R;
        voffA[i] = (unsigned)(R * g.lda + C) * 2u; voffB[i] = (unsigned)(Rb * g.ldb + C) * 2u; }
    const size_t kstep = (size_t)(BK * 2);
    const size_t hstepA = (size_t)HALF * g.lda * 2, hstepB = (size_t)HALF * g.ldb * 2;
    const size_t tstepA = 2 * hstepA, tstepB = 2 * hstepB;
    const unsigned ldsw = (unsigned)wid * 1024u;
    const int aoff = lds_byte(wr * 64 + fr, fq * 8), boff = lds_byte(wc * 32 + fr, fq * 8);
#define PG8_SA(b, h) (((b) * 2 + (h)) * HTB)
#define PG8_SB(b, h) ((4 + (b) * 2 + (h)) * HTB)
#define PG8_STAGE(bufoff, gbase, voff) do { _Pragma("unroll") for (int _i = 0; _i < 2; ++_i) \
        __builtin_amdgcn_global_load_lds((const unsigned*)((const char*)(gbase) + (voff)[_i]), (PG8_LAS unsigned*)(lds + (bufoff) + ldsw + _i * 8192), 16, 0, 0); } while (0)
#define PG8_LDA(dst, b, h) do { _Pragma("unroll") for (int m = 0; m < 4; ++m) _Pragma("unroll") for (int k = 0; k < 2; ++k) dst[m][k] = *(const PG8_LAS bf16x8*)(lds + PG8_SA(b, h) + aoff + m * 2048 + k * 1024); } while (0)
#define PG8_LDB(dst, b, h) do { _Pragma("unroll") for (int n = 0; n < 2; ++n) _Pragma("unroll") for (int k = 0; k < 2; ++k) dst[n][k] = *(const PG8_LAS bf16x8*)(lds + PG8_SB(b, h) + boff + n * 2048 + k * 1024); } while (0)
#define PG8_MMA(ai, bj, At, Bt) do { __builtin_amdgcn_s_setprio(1); _Pragma("unroll") for (int m = 0; m < 4; ++m) _Pragma("unroll") for (int n = 0; n < 2; ++n) _Pragma("unroll") for (int k = 0; k < 2; ++k) \
        acc[ai][bj][m][n] = __builtin_amdgcn_mfma_f32_16x16x32_bf16(Bt[n][k], At[m][k], acc[ai][bj][m][n], 0, 0, 0); __builtin_amdgcn_s_setprio(0); } while (0)
#define PG8_WAIT_V(n) asm volatile("s_waitcnt vmcnt(" #n ")" ::: "memory")
#define PG8_WAIT_L(n) asm volatile("s_waitcnt lgkmcnt(" #n ")" ::: "memory")
#define PG8_BAR __builtin_amdgcn_s_barrier()
#define PG8_SCHED __builtin_amdgcn_sched_barrier(0)
    Unit cur, nxt; int ui = 0;
    if (!S.next(0, cur)) return;
    f32x4 acc[2][2][4][2];
#pragma unroll
    for (int a = 0; a < 2; ++a)
#pragma unroll
        for (int b = 0; b < 2; ++b)
#pragma unroll
            for (int m = 0; m < 4; ++m)
#pragma unroll
                for (int n = 0; n < 2; ++n) acc[a][b][m][n] = (f32x4){0.f, 0.f, 0.f, 0.f};
    bf16x8 At[4][2], B0[2][2], B1[2][2];
    const char* cA = (const char*)g.A + (size_t)cur.pm * tstepA; const char* cB = (const char*)g.Bt + (size_t)cur.pn * tstepB;
    S.a_ready(cur);
    if constexpr (SP2) {
        PG8_STAGE(PG8_SB(0, 0), cB, voffB); PG8_STAGE(PG8_SB(0, 1), cB + hstepB, voffB); PG8_STAGE(PG8_SA(0, 0), cA, voffA); PG8_STAGE(PG8_SA(0, 1), cA + hstepA, voffA);
        if (wr == 1) PG8_BAR;
        PG8_WAIT_V(2); PG8_BAR;
        PG8_STAGE(PG8_SB(1, 0), cB + kstep, voffB); PG8_STAGE(PG8_SA(1, 0), cA + kstep, voffA); PG8_STAGE(PG8_SB(1, 1), cB + hstepB + kstep, voffB);
        PG8_WAIT_V(6); PG8_BAR;
    } else {
        PG8_STAGE(PG8_SB(0, 0), cB, voffB); PG8_STAGE(PG8_SA(0, 0), cA, voffA); PG8_STAGE(PG8_SB(0, 1), cB + hstepB, voffB); PG8_STAGE(PG8_SA(0, 1), cA + hstepA, voffA);
        if (wr == 1) PG8_BAR;
        PG8_WAIT_V(4); PG8_BAR;
        PG8_STAGE(PG8_SB(1, 0), cB + kstep, voffB); PG8_STAGE(PG8_SA(1, 0), cA + kstep, voffA); PG8_STAGE(PG8_SB(1, 1), cB + hstepB + kstep, voffB);
        PG8_WAIT_V(6); PG8_BAR;
    }
    for (;;) {
        const bool has_next = S.next(ui + 1, nxt);
        const char* nA = has_next ? (const char*)g.A + (size_t)nxt.pm * tstepA : cA; const char* nB = has_next ? (const char*)g.Bt + (size_t)nxt.pn * tstepB : cB;
        for (int t = 0; t < nt; t += 2) {
            if constexpr (Epi::KHOOK) { if (t == Epi::KH1 || t == Epi::KH2) E.khook(acc, cur, t, wr, wc, fr, fq); }
            const bool last = (t == nt - 2);
            const char* a1 = cA + (size_t)(t + 1) * kstep;
            const char* a2 = last ? nA : cA + (size_t)(t + 2) * kstep; const char* b2 = last ? nB : cB + (size_t)(t + 2) * kstep;
            const char* a3 = a2 + kstep; const char* b3 = b2 + kstep;
            if (last && has_next) S.a_ready(nxt);
            if constexpr (SP2) {
            PG8_LDB(B0, 0, 0); PG8_LDB(B1, 0, 1); PG8_SCHED; PG8_LDA(At, 0, 0); PG8_STAGE(PG8_SA(1, 1), a1 + hstepA, voffA);
            PG8_WAIT_V(8); PG8_WAIT_L(0); PG8_BAR; PG8_MMA(0, 0, At, B0); PG8_MMA(0, 1, At, B1); PG8_BAR; PG8_SCHED;
            PG8_LDA(At, 0, 1); PG8_STAGE(PG8_SB(0, 0), b2, voffB); PG8_STAGE(PG8_SB(0, 1), b2 + hstepB, voffB); PG8_STAGE(PG8_SA(0, 0), a2, voffA);
            PG8_WAIT_V(8); PG8_WAIT_L(0); PG8_BAR; PG8_MMA(1, 0, At, B0); PG8_MMA(1, 1, At, B1); PG8_BAR; PG8_SCHED;
            PG8_LDB(B0, 1, 0); PG8_LDB(B1, 1, 1); PG8_SCHED; PG8_LDA(At, 1, 0); PG8_STAGE(PG8_SA(0, 1), a2 + hstepA, voffA);
            PG8_WAIT_V(8); PG8_WAIT_L(0); PG8_BAR; PG8_MMA(0, 0, At, B0); PG8_MMA(0, 1, At, B1); PG8_BAR; PG8_SCHED;
            PG8_LDA(At, 1, 1); PG8_STAGE(PG8_SB(1, 0), b3, voffB); PG8_STAGE(PG8_SB(1, 1), b3 + hstepB, voffB); PG8_STAGE(PG8_SA(1, 0), a3, voffA);
            PG8_WAIT_V(8); PG8_WAIT_L(0); PG8_BAR; PG8_MMA(1, 0, At, B0); PG8_MMA(1, 1, At, B1); PG8_BAR; PG8_SCHED;
            } else {
            PG8_LDB(B0, 0, 0); PG8_SCHED; PG8_LDA(At, 0, 0); PG8_STAGE(PG8_SA(1, 1), a1 + hstepA, voffA);
            PG8_WAIT_L(8); PG8_BAR; PG8_WAIT_L(0); PG8_MMA(0, 0, At, B0); PG8_BAR; PG8_SCHED;
            PG8_LDB(B1, 0, 1); PG8_STAGE(PG8_SB(0, 0), b2, voffB);
            PG8_BAR; PG8_WAIT_L(0); PG8_MMA(0, 1, At, B1); PG8_BAR;
            PG8_LDA(At, 0, 1); PG8_STAGE(PG8_SA(0, 0), a2, voffA);
            PG8_BAR; PG8_WAIT_L(0); PG8_MMA(1, 0, At, B0); PG8_BAR; PG8_SCHED;
            PG8_STAGE(PG8_SB(0, 1), b2 + hstepB, voffB);
            PG8_WAIT_V(6); PG8_BAR; PG8_MMA(1, 1, At, B1); PG8_BAR;
            PG8_LDB(B0, 1, 0); PG8_SCHED; PG8_LDA(At, 1, 0); PG8_STAGE(PG8_SA(0, 1), a2 + hstepA, voffA);
            PG8_WAIT_L(8); PG8_BAR; PG8_WAIT_L(0); PG8_MMA(0, 0, At, B0); PG8_BAR; PG8_SCHED;
            PG8_LDB(B1, 1, 1); PG8_STAGE(PG8_SB(1, 0), b3, voffB);
            PG8_BAR; PG8_WAIT_L(0); PG8_MMA(0, 1, At, B1); PG8_BAR;
            PG8_LDA(At, 1, 1); PG8_STAGE(PG8_SA(1, 0), a3, voffA);
            PG8_BAR; PG8_WAIT_L(0); PG8_MMA(1, 0, At, B0); PG8_BAR; PG8_SCHED;
            PG8_STAGE(PG8_SB(1, 1), b3 + hstepB, voffB);
            PG8_WAIT_V(6); PG8_BAR; PG8_MMA(1, 1, At, B1); PG8_BAR;
            }
        }
        if constexpr (ALIGN_EPI) { if (wr == 0) PG8_BAR; }
        if constexpr (!Epi::AFTER_DRAIN) { E(acc, cur, wr, wc, fr, fq); S.done(cur); }
        if (!has_next) break;
#pragma unroll
        for (int a = 0; a < 2; ++a)
#pragma unroll
            for (int b = 0; b < 2; ++b)
#pragma unroll
                for (int m = 0; m < 4; ++m)
#pragma unroll
                    for (int n = 0; n < 2; ++n) acc[a][b][m][n] = (f32x4){0.f, 0.f, 0.f, 0.f};
        cur = nxt; cA = nA; cB = nB; ++ui;
        if constexpr (ALIGN_EPI) { if (wr == 1) PG8_BAR; }
    }
    PG8_WAIT_V(0);
    if constexpr (!ALIGN_EPI) { if (wr == 0) PG8_BAR; }
    PG8_BAR;
    if constexpr (Epi::AFTER_DRAIN) { E.fused(acc, cur, wr, wc, fr, fq, lds, wid, lane); S.done(cur); }
#undef PG8_SA
#undef PG8_SB
#undef PG8_STAGE
#undef PG8_LDA
#undef PG8_LDB
#undef PG8_MMA
#undef PG8_WAIT_V
#undef PG8_WAIT_L
#undef PG8_BAR
#undef PG8_SCHED
}
}

#ifndef G1_STORE_AUX
#define G1_STORE_AUX 2
#endif
namespace pg8 {
__device__ __forceinline__ float ex2(float x) { return __builtin_amdgcn_exp2f(x); }
__device__ __forceinline__ float sigm_fast(float x) { return __builtin_amdgcn_rcpf(1.0f + ex2(x * -1.4426950408889634f)); }
template <int MODE = 0  > struct EpiProjT {
    static constexpr bool PERM = true, AFTER_DRAIN = false, KHOOK = false;
    bf16_t* PA; bf16_t* KVM; float* SS; float* MKSS; const float* gate_b; int pm0; int pad;
    __device__ __forceinline__ void operator()(const f32x4 (&acc)[2][2][4][2], const Unit& u, int wr, int wc, int fr, int fq) const {
        const bool kv = u.pn >= 35; const int pn = kv ? u.pn - 35 : u.pn;
        const int rowt = kv ? (u.pm - 256) * BM : (u.pm - pm0) * BM;
        bf16_t* base = kv ? KVM : PA; const int ldc = kv ? 1024 : NIN;
        const __amdgpu_buffer_rsrc_t rsrc = __builtin_amdgcn_make_buffer_rsrc(base, 0, kv ? (int)((size_t)MMEM * 1024 * 2) : (int)((size_t)HB_ROWS * NIN * 2), 0x00020000);
        int kind = 0, stat = 0, so = 0; float* sb = SS; int sld = SS_W;
        if (kv) { sb = MKSS; sld = 16; if (pn < 2) { stat = 1; so = 8 * pn; } }
        else if (pn < 3) kind = 1;
        else if (pn < 6) { kind = 1; stat = 2; so = 16 * (pn - 3); }
        else if (pn < 9) kind = 2;
        else if (pn < 12) { stat = 1; so = 48 + 8 * (pn - 9); }
        else if (pn < 15) { stat = 1; so = 72 + 8 * (pn - 12); }
        else if (pn < 18) kind = 0;
        else if (pn < 19) kind = 2;
        else if (pn < 21) { stat = 1; so = 96 + 8 * (pn - 19); }
        else if (pn < 23) kind = 2;
        else kind = 3;
        if (MODE == 1) { kind = 0; stat = 0; }
        const int row0 = rowt + wr * 64 + fr, col0 = pn * BM + wc * 32 + 8 * fq;
        f32x4 bv[2][2];
#pragma unroll
        for (int bj = 0; bj < 2; ++bj)
#pragma unroll
            for (int n = 0; n < 2; ++n) bv[bj][n] = (kind == 3) ? *(const f32x4*)(gate_b + (col0 - 23 * BM) + bj * HALF + 4 * n) : (f32x4){0.f, 0.f, 0.f, 0.f};
#pragma unroll
        for (int ai = 0; ai < 2; ++ai)
#pragma unroll
            for (int m = 0; m < 4; ++m) { const int row = row0 + ai * HALF + m * 16; const unsigned rowoff = ((unsigned)row * (unsigned)ldc + (unsigned)col0) * 2u;
#pragma unroll
                for (int bj = 0; bj < 2; ++bj) { f32x4 v0 = acc[ai][bj][m][0], v1 = acc[ai][bj][m][1];
                    if (kind == 1) { f32x2 a = gelu_pk((f32x2){v0[0], v0[1]}), b = gelu_pk((f32x2){v0[2], v0[3]}), c = gelu_pk((f32x2){v1[0], v1[1]}), d = gelu_pk((f32x2){v1[2], v1[3]});
                        v0 = (f32x4){a.x, a.y, b.x, b.y}; v1 = (f32x4){c.x, c.y, d.x, d.y}; }
                    else if (kind == 2) {
#pragma unroll
                        for (int j = 0; j < 4; ++j) { v0[j] = v0[j] * sigm_fast(v0[j]); v1[j] = v1[j] * sigm_fast(v1[j]); } }
                    else if (kind == 3) { v0 = v0 + bv[bj][0]; v1 = v1 + bv[bj][1];
#pragma unroll
                        for (int j = 0; j < 4; ++j) { v0[j] = sigm_fast(v0[j]); v1[j] = sigm_fast(v1[j]); } }
                    if (stat) {
                        float s = ((v0[0] + v0[1]) + (v0[2] + v0[3])) + ((v1[0] + v1[1]) + (v1[2] + v1[3]));
                        float q = ((v0[0] * v0[0] + v0[1] * v0[1]) + (v0[2] * v0[2] + v0[3] * v0[3])) + ((v1[0] * v1[0] + v1[1] * v1[1]) + (v1[2] * v1[2] + v1[3] * v1[3]));
                        s += __shfl_xor(s, 16); s += __shfl_xor(s, 32); q += __shfl_xor(q, 16); q += __shfl_xor(q, 32);
                        if (fq == 0) { float* sp = sb + (size_t)row * sld + so; const int blk = 4 * bj + wc;
                            if (stat == 2) { sp[2 * blk] = s; sp[2 * blk + 1] = q; } else sp[blk] = q; }
                    }
                    u32x4 w; w.x = cvt_pk_bf16(v0[0], v0[1]); w.y = cvt_pk_bf16(v0[2], v0[3]); w.z = cvt_pk_bf16(v1[0], v1[1]); w.w = cvt_pk_bf16(v1[2], v1[3]);
                    if (MODE == 2) asm volatile("" :: "v"(w)); else __builtin_amdgcn_raw_buffer_store_b128(w, rsrc, (int)(rowoff + bj * HALF * 2), 0, G1_STORE_AUX); } }
    }
};
typedef EpiProjT<0> EpiProj;
struct EpiG2cat {
    static constexpr bool PERM = true, AFTER_DRAIN = false, KHOOK = true; static constexpr int KH1 = 12, KH2 = 16;
    const bf16_t* PA; bf16_t* MRG;
    __device__ __forceinline__ void khook(f32x4 (&acc)[2][2][4][2], const Unit& u, int t, int wr, int wc, int fr, int fq) const {
        const int ga = t == KH1 ? 0 : 1;
        const int row0 = u.pm * BM + wr * 64 + fr, col0 = u.pn * BM + wc * 32 + 8 * fq;
#pragma unroll
        for (int ai = 0; ai < 2; ++ai)
#pragma unroll
            for (int m = 0; m < 4; ++m) { const bf16_t* gp = PA + (size_t)(row0 + ai * HALF + m * 16) * NIN + C_G + ga * DM + col0;
#pragma unroll
                for (int bj = 0; bj < 2; ++bj) { const u32x4 a = *(const u32x4*)(gp + bj * HALF), b = *(const u32x4*)(gp + DM + bj * HALF);
                    f32x4 r0, r1;
                    r0[0] = __uint_as_float(a.x << 16) * __builtin_amdgcn_rcpf(__uint_as_float(b.x << 16)); r0[1] = __uint_as_float(a.x & 0xffff0000u) * __builtin_amdgcn_rcpf(__uint_as_float(b.x & 0xffff0000u));
                    r0[2] = __uint_as_float(a.y << 16) * __builtin_amdgcn_rcpf(__uint_as_float(b.y << 16)); r0[3] = __uint_as_float(a.y & 0xffff0000u) * __builtin_amdgcn_rcpf(__uint_as_float(b.y & 0xffff0000u));
                    r1[0] = __uint_as_float(a.z << 16) * __builtin_amdgcn_rcpf(__uint_as_float(b.z << 16)); r1[1] = __uint_as_float(a.z & 0xffff0000u) * __builtin_amdgcn_rcpf(__uint_as_float(b.z & 0xffff0000u));
                    r1[2] = __uint_as_float(a.w << 16) * __builtin_amdgcn_rcpf(__uint_as_float(b.w << 16)); r1[3] = __uint_as_float(a.w & 0xffff0000u) * __builtin_amdgcn_rcpf(__uint_as_float(b.w & 0xffff0000u));
                    acc[ai][bj][m][0] *= r0; acc[ai][bj][m][1] *= r1; }
                asm volatile("" ::: "memory"); }
    }
    __device__ __forceinline__ void operator()(const f32x4 (&acc)[2][2][4][2], const Unit& u, int wr, int wc, int fr, int fq) const {
        const int row0 = u.pm * BM + wr * 64 + fr, col0 = u.pn * BM + wc * 32 + 8 * fq;
#pragma unroll
        for (int ai = 0; ai < 2; ++ai)
#pragma unroll
            for (int m = 0; m < 4; ++m) { const size_t row = (size_t)(row0 + ai * HALF + m * 16); const bf16_t* gp = PA + row * NIN + C_G + 2 * DM + col0; bf16_t* mp = MRG + row * DM + col0;
#pragma unroll
                for (int bj = 0; bj < 2; ++bj) { const u32x4 g = *(const u32x4*)(gp + bj * HALF); const f32x4 v0 = acc[ai][bj][m][0], v1 = acc[ai][bj][m][1]; u32x4 w;
                    w.x = cvt_pk_bf16(v0[0] * __uint_as_float(g.x << 16), v0[1] * __uint_as_float(g.x & 0xffff0000u)); w.y = cvt_pk_bf16(v0[2] * __uint_as_float(g.y << 16), v0[3] * __uint_as_float(g.y & 0xffff0000u));
                    w.z = cvt_pk_bf16(v1[0] * __uint_as_float(g.z << 16), v1[1] * __uint_as_float(g.z & 0xffff0000u)); w.w = cvt_pk_bf16(v1[2] * __uint_as_float(g.w << 16), v1[3] * __uint_as_float(g.w & 0xffff0000u));
                    *(u32x4*)(mp + bj * HALF) = w; }
                asm volatile("" ::: "memory"); }
    }
};
struct EpiG3 {
    static constexpr bool PERM = false, AFTER_DRAIN = false, KHOOK = false;
    const float* x; float* out;
    __device__ __forceinline__ void operator()(const f32x4 (&acc)[2][2][4][2], const Unit& u, int wr, int wc, int fr, int fq) const {
        const int row0 = u.pm * BM + wr * 64 + fr, col0 = u.pn * BM + wc * 32 + 4 * fq;
#pragma unroll
        for (int ai = 0; ai < 2; ++ai)
#pragma unroll
            for (int m = 0; m < 4; ++m) { const size_t off = (size_t)(row0 + ai * HALF + m * 16) * DM + col0;
#pragma unroll
                for (int bj = 0; bj < 2; ++bj)
#pragma unroll
                    for (int n = 0; n < 2; ++n) *(f32x4*)(out + off + bj * HALF + n * 16) = *(const f32x4*)(x + off + bj * HALF + n * 16) + acc[ai][bj][m][n];
                asm volatile("" ::: "memory"); }
    }
};
struct EpiNull {
    static constexpr bool PERM = true, AFTER_DRAIN = false, KHOOK = false;
    __device__ __forceinline__ void operator()(const f32x4 (&acc)[2][2][4][2], const Unit& u, int wr, int wc, int fr, int fq) const {
#pragma unroll
        for (int ai = 0; ai < 2; ++ai)
#pragma unroll
            for (int bj = 0; bj < 2; ++bj)
#pragma unroll
                for (int m = 0; m < 4; ++m) asm volatile("" :: "v"(acc[ai][bj][m][0]), "v"(acc[ai][bj][m][1]));
    }
};
struct OrderG1 {
    StaticOrder so; int pm0, nkv;
    __device__ void init(int hb, int G, int c) { so.init(HB_ROWS, NIN, G, c); pm0 = hb * (HB_ROWS / BM); nkv = hb == 0 ? (MMEM / BM) * 4 : 0; }
    __device__ bool next(int i, Unit& u) const {
        if (so.next(i, u)) { u.pm += pm0; return true; }
        const long j = (long)i * so.G + so.c - so.nwg; if (j < 0 || j >= nkv) return false;
        u.pm = 256 + (int)(j >> 2); u.pn = 35 + (int)(j & 3); return true;
    }
    __device__ __forceinline__ void a_ready(const Unit&) const {}
    __device__ __forceinline__ void done(const Unit&) const {}
};
}

#define GAS __attribute__((address_space(1)))
#define LAS __attribute__((address_space(3)))
typedef unsigned short bf16;
typedef unsigned v4u __attribute__((ext_vector_type(4)));
typedef float f32x4 __attribute__((ext_vector_type(4)));
typedef short bf16x8 __attribute__((ext_vector_type(8)));
typedef GAS unsigned gu32;
typedef GAS unsigned long long gu64;
#define RLX_AGENT __ATOMIC_RELAXED, __HIP_MEMORY_SCOPE_AGENT
#define LDS_WAIT() asm volatile("s_waitcnt lgkmcnt(0)" ::: "memory")
#define VM_WAIT() asm volatile("s_waitcnt vmcnt(0)" ::: "memory")
__device__ __forceinline__ unsigned long long rt() { return __builtin_amdgcn_s_memrealtime(); }
__device__ __forceinline__ unsigned f2bf(float f) { unsigned u = __builtin_bit_cast(unsigned, f); return (u + 0x7fffu + ((u >> 16) & 1u)) >> 16; }
__device__ __forceinline__ unsigned pk2(float lo, float hi) { return f2bf(lo) | (f2bf(hi) << 16); }

__device__ __forceinline__ int hw_lane() { int l; asm volatile("v_mbcnt_lo_u32_b32 %0, -1, 0\n\tv_mbcnt_hi_u32_b32 %0, -1, %0" : "=v"(l)); return l; }
__device__ __forceinline__ bool hw_thread0(int wave) { return wave == 0 && hw_lane() == 0; }
#define XB_TMO      128
#define XB_XCNT(j)  (256  + 64 * (j))
#define XB_XSUB(j)  (1280 + 64 * (j))
#define XB_XGEN(j)  (2304 + 64 * (j))
#define XB_TOP      3328
#define XB_TOPGEN   3392
#define XCD_BAR_WORDS 3456
#define XB_SPIN_CAP (1u << 18)

__device__ __forceinline__ unsigned xb_ld(unsigned* p)              { return __hip_atomic_load(p, __ATOMIC_RELAXED, __HIP_MEMORY_SCOPE_AGENT); }
__device__ __forceinline__ unsigned xb_add(unsigned* p, unsigned v) { return __hip_atomic_fetch_add(p, v, __ATOMIC_RELAXED, __HIP_MEMORY_SCOPE_AGENT); }
__device__ __forceinline__ unsigned xb_xcc_id() { return (unsigned)__builtin_amdgcn_s_getreg((3 << 11) | 20) & 0xFu; }
#define XB_SPIN(cond, bar) do { unsigned _sp = 0; while (cond) { __builtin_amdgcn_s_sleep(1); \
    if ((++_sp & 255u) == 0u) { if (xb_ld(&(bar)[XB_TMO])) break; if (_sp > XB_SPIN_CAP) { atomicAdd(&(bar)[XB_TMO], 1u); break; } } } } while (0)

struct XcdBarrier {
    unsigned* bar; unsigned x; int wave;
    volatile LAS unsigned* st;
};

__device__ __forceinline__ XcdBarrier xcd_barrier_post(unsigned* bar, volatile LAS unsigned* st, int wave) {
    XcdBarrier b; b.bar = bar; b.x = xb_xcc_id(); b.st = st; b.wave = wave;
    if (hw_thread0(wave)) (void)xb_add(&bar[XB_XCNT(b.x)], 1u);
    return b;
}
__device__ __forceinline__ void xcd_barrier_complete(unsigned* bar, unsigned x, unsigned& nloc, unsigned& nx) {
    const unsigned G = gridDim.x * gridDim.y * gridDim.z;
    unsigned sum, cnt, mine, sp = 0u;
    for (;;) {
        sum = 0u; cnt = 0u; mine = 0u;
#pragma unroll
        for (unsigned j = 0; j < 16; ++j) { const unsigned c = xb_ld(&bar[XB_XCNT(j)]); sum += c; cnt += (c > 0u) ? 1u : 0u; mine = (j == x) ? c : mine; }
        if (sum == G) break;
        __builtin_amdgcn_s_sleep(1);
        if ((++sp & 255u) == 0u) { if (xb_ld(&bar[XB_TMO])) break; if (sp > XB_SPIN_CAP) { atomicAdd(&bar[XB_TMO], 1u); break; } }
    }
    nloc = mine > 0u ? mine : 1u; nx = cnt > 0u ? cnt : 1u;
}

__device__ __forceinline__ void xcd_barrier(const XcdBarrier& b) {
    asm volatile("s_waitcnt vmcnt(0)" ::: "memory");
    __syncthreads();
    if (hw_thread0(b.wave)) {
        unsigned* bar = b.bar;
        __builtin_amdgcn_s_waitcnt(0);
        unsigned nloc = b.st[0], nx = b.st[1];
        if (nloc == 0u) { xcd_barrier_complete(bar, b.x, nloc, nx); b.st[0] = nloc; b.st[1] = nx; }
        const unsigned old = xb_add(&bar[XB_XSUB(b.x)], 1u);
        const unsigned gen = old / nloc;
        if (old + 1u == (gen + 1u) * nloc) {
            __builtin_amdgcn_fence(__ATOMIC_RELEASE, "agent");
            asm volatile("s_waitcnt vmcnt(0)" ::: "memory");
            const unsigned og = xb_add(&bar[XB_TOP], 1u);
            const unsigned tg = og / nx;
            if (og + 1u == (tg + 1u) * nx) xb_add(&bar[XB_TOPGEN], 1u);
            else XB_SPIN(xb_ld(&bar[XB_TOPGEN]) == tg, bar);
            __builtin_amdgcn_fence(__ATOMIC_ACQUIRE, "agent");
            xb_add(&bar[XB_XGEN(b.x)], 1u);
            asm volatile("s_waitcnt vmcnt(0)" ::: "memory");
        } else {
            XB_SPIN(xb_ld(&bar[XB_XGEN(b.x)]) == gen, bar);
            __builtin_amdgcn_fence(__ATOMIC_ACQUIRE, "agent");
            asm volatile("s_waitcnt vmcnt(0)" ::: "memory");
        }
    }
    __syncthreads();
}

__device__ __forceinline__ float wave_sum(float v) {
#pragma unroll
    for (int o = 1; o < 64; o <<= 1) v += __shfl_xor(v, o);
    return v;
}

constexpr int RING_OFF = 0, RING_BYTES = 131072;
constexpr int LDSCTL_OFF = RING_BYTES, MISC_OFF = LDSCTL_OFF + 320;
constexpr int LDS_BYTES = 147456;
constexpr int NWAVES = 8, NTHR = NWAVES * 64;
constexpr int WSCR_OFF = 132096;

__device__ __forceinline__ float bf2f(bf16 h) { return __builtin_bit_cast(float, (unsigned)h << 16); }
__device__ __forceinline__ float sigm_f(float x) { return 1.f / (1.f + __expf(-x)); }
__device__ __forceinline__ int t5_bucket(int d) {
    if (d < 16) return d;
    int b = 16;
    b += d >= 22; b += d >= 30; b += d >= 40; b += d >= 54; b += d >= 73; b += d >= 99; b += d >= 134; b += d >= 182; b += d >= 246; b += d >= 332; b += d >= 450; b += d >= 609; b += d >= 825; b += d >= 1117; b += d >= 1513;
    return b;
}

struct Ctx {
    const float *x, *mem, *norm_w, *w_in, *gate_b, *lnw, *lnb, *sp_w, *sp_b, *bqw, *bkw, *rel_bias, *mem_norm_w, *m_w_kv, *mqw, *mkw, *proj_a, *proj_b, *proj_m, *w_out;
    float* out;
    bf16 *WIN, *PCAT, *WOUT, *WSP, *XN, *PA, *KVM, *OG, *YC, *MRG; float *BIAS, *BIASX, *SS, *MKSS, *LSE, *LNST;
    LAS unsigned char* lds; int tid, lane, wave, G, gtid, T, gwave, NW, xgwave;
};

__device__ __forceinline__ void p0_transpose_item(const float* W, int N, bf16* WT, int ldt, int row_off, int koff, LAS float* scr, int item, int lane) {
    const int nblk = N / 32, kb = item / nblk, nb = item % nblk, k0 = 64 * kb, n0 = 32 * nb;
#pragma unroll 8
    for (int i = 0; i < 32; ++i) { const int kk = 2 * i + (lane >> 5); scr[kk * 33 + (lane & 31)] = W[(size_t)(k0 + kk) * N + n0 + (lane & 31)]; }
    LDS_WAIT(); asm volatile("" ::: "memory");
    const int c = lane & 7;
#pragma unroll
    for (int j = 0; j < 4; ++j) { const int n = (lane >> 3) + 8 * j; const LAS float* s = scr + (8 * c) * 33 + n;
        v4u o; o.x = pk2(s[0 * 33], s[1 * 33]); o.y = pk2(s[2 * 33], s[3 * 33]); o.z = pk2(s[4 * 33], s[5 * 33]); o.w = pk2(s[6 * 33], s[7 * 33]);
        *(GAS v4u*)(WT + (size_t)(row_off + n0 + n) * ldt + koff + k0 + 8 * c) = o; }
    LDS_WAIT(); asm volatile("" ::: "memory");
}
__device__ __forceinline__ void rms_row_to_bf16(const float* xrow, const float* w, bf16* orow, int lane) {
    const GAS f32x4* xr = (const GAS f32x4*)xrow + lane; const GAS f32x4* wr = (const GAS f32x4*)w + lane;
    f32x4 v[4]; float s = 0.f;
#pragma unroll
    for (int j = 0; j < 4; ++j) { v[j] = xr[64 * j]; s += (v[j].x * v[j].x + v[j].y * v[j].y) + (v[j].z * v[j].z + v[j].w * v[j].w); }
    const float rs = rsqrtf(wave_sum(s) * (1.f / DM) + EPS);
    GAS unsigned long long* o8 = (GAS unsigned long long*)orow + lane;
#pragma unroll
    for (int j = 0; j < 4; ++j) { const f32x4 ww = wr[64 * j]; o8[64 * j] = (unsigned long long)pk2(v[j].x * rs * ww.x, v[j].y * rs * ww.y) | ((unsigned long long)pk2(v[j].z * rs * ww.z, v[j].w * rs * ww.w) << 32); }
}
__device__ __forceinline__ void p0_prologue(Ctx& F) {
    LAS float* scr = (LAS float*)(F.lds + RING_OFF + F.wave * 16384);
    constexpr int I_IN = 16 * (NIN / 32), I_KV = 16 * 32, I_PA = 12 * 32, I_PB = 4 * 32, I_PM = 8 * 32, I_WO = 16 * 32;
    constexpr int NITEMS = I_IN + I_KV + I_PA + I_PB + I_PM + I_WO;
    for (int it = F.gwave; it < NITEMS; it += F.NW) {
        int r = it;
        if (r < I_IN) { p0_transpose_item(F.w_in, NIN, F.WIN, DM, 0, 0, scr, r, F.lane); continue; } r -= I_IN;
        if (r < I_KV) { p0_transpose_item(F.m_w_kv, 1024, F.WIN, DM, NIN, 0, scr, r, F.lane); continue; } r -= I_KV;
        if (r < I_PA) { p0_transpose_item(F.proj_a, DM, F.PCAT, KC, 0, 0, scr, r, F.lane); continue; } r -= I_PA;
        if (r < I_PB) { p0_transpose_item(F.proj_b, DM, F.PCAT, KC, 0, 768, scr, r, F.lane); continue; } r -= I_PB;
        if (r < I_PM) { p0_transpose_item(F.proj_m, DM, F.PCAT, KC, 0, 1024, scr, r, F.lane); continue; } r -= I_PM;
        p0_transpose_item(F.w_out, DM, F.WOUT, DM, 0, 0, scr, r, F.lane);
    }
    for (int i = F.gtid; i < 4 * 128 * 128; i += F.T) { const int t = (i >> 7) & 127, s = i & 127; F.WSP[i] = (bf16)(s <= t ? f2bf(F.sp_w[i]) : 0u); }
    for (int i = F.gtid; i < 3 * 4 * 132; i += F.T) { const int g = i / (4 * 132), h = (i / 132) % 4, j = i % 132; const int dil = g == 0 ? 1 : (g == 1 ? 4 : 16);
        F.BIAS[i] = j <= 128 ? F.rel_bias[t5_bucket(j * dil) * 12 + 4 * g + h] : 0.f; }
    for (int i = F.gtid; i < 3 * 4 * 192; i += F.T) { const int g = i / (4 * 192), h = (i / 192) % 4, step = i % 192 - 31; const int dil = g == 0 ? 1 : (g == 1 ? 4 : 16);
        F.BIASX[i] = (step >= 0 && step <= 128) ? F.rel_bias[t5_bucket(step * dil) * 12 + 4 * g + h] * 1.4426950408889634f : -1e30f; }
    for (int m = F.gwave; m < MTOT + MMEM; m += F.NW) {
        if (m < MTOT) rms_row_to_bf16(F.x + (size_t)m * DM, F.norm_w, F.XN + (size_t)m * DM, F.lane);
        else rms_row_to_bf16(F.mem + (size_t)(m - MTOT) * DM, F.mem_norm_w, F.XN + (size_t)m * DM, F.lane);
    }
}

__device__ __forceinline__ void st_lnstat(Ctx& F) {
    for (int r = F.gtid; r < HB_ROWS; r += F.T) {
        float s = 0.f, q = 0.f; for (int b = 0; b < 24; ++b) { s += F.SS[(size_t)r * SS_W + 2 * b]; q += F.SS[(size_t)r * SS_W + 2 * b + 1]; }
        const float mu = s * (1.f / 768.f), var = q * (1.f / 768.f) - mu * mu;
        F.LNST[2 * r] = mu; F.LNST[2 * r + 1] = rsqrtf(fmaxf(var, 0.f) + EPS); }
}
__device__ __forceinline__ void st_mixA(Ctx& F) {
    for (size_t gid = F.gtid; gid < (size_t)HB_ROWS * 768; gid += F.T) {
        const int r = (int)(gid / 768), c = (int)(gid % 768), g = c / 192, t = r & 127, r0 = r - t;
        float acc = 0.f;
        for (int s = 0; s <= t; ++s) { const float gv = bf2f(F.PA[(size_t)(r0 + s) * NIN + C_AV + c]);
            const float vv = (gv - F.LNST[2 * (r0 + s)]) * F.LNST[2 * (r0 + s) + 1] * F.lnw[c] + F.lnb[c];
            acc += bf2f(F.WSP[(g * 128 + t) * 128 + s]) * vv; }
        acc += F.sp_b[g * 128 + t];
        const float u = bf2f(F.PA[(size_t)r * NIN + C_AU + c]), z = bf2f(F.PA[(size_t)r * NIN + C_AZ + c]);
        F.YC[(size_t)r * KC + c] = (bf16)f2bf(u * acc * z); }
}
__device__ __forceinline__ void st_attnB(Ctx& F) {
    const int lane = F.lane;
    for (int w = F.gwave; w < 3 * HB_ROWS * 4; w += F.NW) {
        const int g = w / (HB_ROWS * 4), r = (w / 4) % HB_ROWS, h = w % 4, hh = 4 * g + h, dil = g == 0 ? 1 : (g == 1 ? 4 : 16), t = r % SEQ;
        const float qs = rsqrtf((F.SS[(size_t)r * SS_W + 48 + 2 * hh] + F.SS[(size_t)r * SS_W + 48 + 2 * hh + 1]) * (1.f / 64.f) + EPS);
        const float q = bf2f(F.PA[(size_t)r * NIN + C_BQ + hh * 64 + lane]) * qs * F.bqw[lane] * F.bkw[lane] * 0.125f;
        float m = -1e30f, l = 0.f, o = 0.f;
        for (int j = 0; j <= 128; ++j) { if (t - j * dil < 0) break; const int kr = r - j * dil;
            const float ks = rsqrtf((F.SS[(size_t)kr * SS_W + 72 + 2 * hh] + F.SS[(size_t)kr * SS_W + 72 + 2 * hh + 1]) * (1.f / 64.f) + EPS);
            const float s = wave_sum(q * bf2f(F.PA[(size_t)kr * NIN + C_BK + hh * 64 + lane])) * ks + F.BIAS[(g * 4 + h) * 132 + j];
            const float mn = fmaxf(m, s), a = __expf(m - mn), p = __expf(s - mn);
            l = l * a + p; o = o * a + p * bf2f(F.PA[(size_t)kr * NIN + C_BV + hh * 64 + lane]); m = mn; }
        F.OG[((size_t)g * HB_ROWS + r) * 256 + h * 64 + lane] = (bf16)f2bf(o / l);
        if (lane == 0) F.LSE[((size_t)g * HB_ROWS + r) * 4 + h] = m + __logf(l); }
}
__device__ __forceinline__ void st_mergeB(Ctx& F) {
    for (size_t gid = F.gtid; gid < (size_t)HB_ROWS * 256; gid += F.T) {
        const int r = (int)(gid / 256), c = (int)(gid % 256), h = c / 64;
        const float l0 = F.LSE[((size_t)0 * HB_ROWS + r) * 4 + h], l1 = F.LSE[((size_t)1 * HB_ROWS + r) * 4 + h], l2 = F.LSE[((size_t)2 * HB_ROWS + r) * 4 + h];
        const float mx = fmaxf(l0, fmaxf(l1, l2)), e0 = __expf(l0 - mx), e1 = __expf(l1 - mx), e2 = __expf(l2 - mx), inv = 1.f / (e0 + e1 + e2);
        const float y = (e0 * bf2f(F.OG[((size_t)0 * HB_ROWS + r) * 256 + c]) + e1 * bf2f(F.OG[((size_t)1 * HB_ROWS + r) * 256 + c]) + e2 * bf2f(F.OG[((size_t)2 * HB_ROWS + r) * 256 + c])) * inv;
        F.YC[(size_t)r * KC + 768 + c] = (bf16)f2bf(y * bf2f(F.PA[(size_t)r * NIN + C_BZ + c])); }
}
__device__ __forceinline__ void st_attnM(Ctx& F, int row_base) {
    const int lane = F.lane;
    for (int w = F.gwave; w < HB_ROWS * 4; w += F.NW) {
        const int r = w / 4, h = w % 4, b = (row_base + r) / SEQ;
        float qq = 0.f; for (int i = 0; i < 4; ++i) qq += F.SS[(size_t)r * SS_W + 96 + 4 * h + i];
        const float qs = rsqrtf(qq * (1.f / 128.f) + EPS) * 0.08838834764831845f;
        const float q0 = bf2f(F.PA[(size_t)r * NIN + C_MQ + h * 128 + lane]) * qs * F.mqw[lane] * F.mkw[lane], q1 = bf2f(F.PA[(size_t)r * NIN + C_MQ + h * 128 + 64 + lane]) * qs * F.mqw[64 + lane] * F.mkw[64 + lane];
        float m = -1e30f, l = 0.f, o0 = 0.f, o1 = 0.f;
        for (int j = 0; j < MEML; ++j) { const size_t kr = (size_t)b * MEML + j;
            float kk = 0.f; for (int i = 0; i < 4; ++i) kk += F.MKSS[kr * 16 + 4 * h + i];
            const float ks = rsqrtf(kk * (1.f / 128.f) + EPS);
            const float s = wave_sum(q0 * bf2f(F.KVM[kr * 1024 + h * 128 + lane]) + q1 * bf2f(F.KVM[kr * 1024 + h * 128 + 64 + lane])) * ks;
            const float mn = fmaxf(m, s), a = __expf(m - mn), p = __expf(s - mn);
            l = l * a + p; o0 = o0 * a + p * bf2f(F.KVM[kr * 1024 + 512 + h * 128 + lane]); o1 = o1 * a + p * bf2f(F.KVM[kr * 1024 + 512 + h * 128 + 64 + lane]); m = mn; }
        F.YC[(size_t)r * KC + 1024 + h * 128 + lane] = (bf16)f2bf(o0 / l * bf2f(F.PA[(size_t)r * NIN + C_MZ + h * 128 + lane]));
        F.YC[(size_t)r * KC + 1024 + h * 128 + 64 + lane] = (bf16)f2bf(o1 / l * bf2f(F.PA[(size_t)r * NIN + C_MZ + h * 128 + 64 + lane])); }
}

typedef float f32x16 __attribute__((ext_vector_type(16)));
typedef short s16x4 __attribute__((ext_vector_type(4)));
__device__ __forceinline__ int crow(int r, int hi) { return (r & 3) + 8 * (r >> 2) + 4 * hi; }
__device__ __forceinline__ unsigned cvtpk(float lo, float hi) { unsigned r; asm volatile("v_cvt_pk_bf16_f32 %0, %1, %2" : "=v"(r) : "v"(lo), "v"(hi)); return r; }
__device__ __forceinline__ s16x4 vtr(const LAS unsigned char* p) { typedef short v4i16_t __attribute__((ext_vector_type(4))); return __builtin_bit_cast(s16x4, __builtin_amdgcn_ds_read_tr16_b64_v4i16((LAS v4i16_t*)p)); }
__device__ __forceinline__ float bflo(unsigned w) { return __uint_as_float(w << 16); }
__device__ __forceinline__ float bfhi(unsigned w) { return __uint_as_float(w & 0xffff0000u); }
constexpr float LOG2E = 1.4426950408889634f, LN2 = 0.6931471805599453f;
constexpr int NBX = 192;

__device__ __forceinline__ void st_attnB_mfma(Ctx& F) {
    const int lane = hw_lane(), r32 = lane & 31, hi = lane >> 5;
    LAS unsigned char* wl = F.lds + RING_OFF + F.wave * 16384;
    LAS float* btab = (LAS float*)(wl + 8192); LAS float* kst = (LAS float*)(wl + 9216);
    for (int it = F.xgwave; it < 3 * 16 * 4 * 64; it += F.NW) {
        const int blk = it & 63, h = (it >> 6) & 3, gb = it >> 8, b = gb & 15, g = gb >> 4, hh = 4 * g + h;
        const int dil = g == 0 ? 1 : (g == 1 ? 4 : 16), nqb = 64 / dil, res = blk / nqb, q0 = (blk % nqb) * 32;
        const int rbase = b * SEQ + res;
        for (int i = lane; i < NBX; i += 64) btab[i] = F.BIASX[(g * 4 + h) * NBX + i];
        const size_t qrow = (size_t)(rbase + (q0 + r32) * dil);
        const float qs = rsqrtf((F.SS[qrow * SS_W + 48 + 2 * hh] + F.SS[qrow * SS_W + 48 + 2 * hh + 1]) * (1.f / 64.f) + EPS) * (0.125f * LOG2E);
        bf16x8 qf[4];
#pragma unroll
        for (int d0 = 0; d0 < 4; ++d0) { const int dd = 16 * d0 + 8 * hi;
            const v4u raw = *(const v4u*)(F.PA + qrow * NIN + C_BQ + hh * 64 + dd);
            const f32x4 wa = *(const f32x4*)(F.bqw + dd), wb = *(const f32x4*)(F.bqw + dd + 4), ka = *(const f32x4*)(F.bkw + dd), kb = *(const f32x4*)(F.bkw + dd + 4);
            v4u o;
            o.x = cvtpk(bflo(raw.x) * qs * wa.x * ka.x, bfhi(raw.x) * qs * wa.y * ka.y); o.y = cvtpk(bflo(raw.y) * qs * wa.z * ka.z, bfhi(raw.y) * qs * wa.w * ka.w);
            o.z = cvtpk(bflo(raw.z) * qs * wb.x * kb.x, bfhi(raw.z) * qs * wb.y * kb.y); o.w = cvtpk(bflo(raw.w) * qs * wb.z * kb.z, bfhi(raw.w) * qs * wb.w * kb.w);
            qf[d0] = __builtin_bit_cast(bf16x8, o); }
        float mrun = -1e30f, lrun = 0.f; f32x16 o0 = {}, o1 = {};
        for (int k0 = (q0 >= 128 ? q0 - 128 : 0); k0 <= q0; k0 += 32) {
            const size_t krow = (size_t)(rbase + (k0 + r32) * dil);
            bf16x8 kf[4];
#pragma unroll
            for (int d0 = 0; d0 < 4; ++d0) kf[d0] = *(const bf16x8*)(F.PA + krow * NIN + C_BK + hh * 64 + 16 * d0 + 8 * hi);
            const float ksv = rsqrtf((F.SS[krow * SS_W + 72 + 2 * hh] + F.SS[krow * SS_W + 72 + 2 * hh + 1]) * (1.f / 64.f) + EPS);
            v4u vr[4];
#pragma unroll
            for (int i = 0; i < 4; ++i) vr[i] = *(const v4u*)(F.PA + (size_t)(rbase + (k0 + 8 * i + (lane >> 3)) * dil) * NIN + C_BV + hh * 64 + 8 * (lane & 7));
#pragma unroll
            for (int i = 0; i < 4; ++i) *(LAS v4u*)(wl + (2 * i + ((lane & 7) >> 2)) * 512 + (lane >> 3) * 64 + (lane & 3) * 16) = vr[i];
            if (lane < 32) kst[r32] = ksv;
            f32x16 st = {};
#pragma unroll
            for (int d0 = 0; d0 < 4; ++d0) st = __builtin_amdgcn_mfma_f32_32x32x16_bf16(kf[d0], qf[d0], st, 0, 0, 0);
            const int bidx = (q0 + r32) - k0 + 31 - 4 * hi;
            float tmax = -1e30f;
#pragma unroll
            for (int i = 0; i < 4; ++i) { const f32x4 kk = *(const LAS f32x4*)(kst + 8 * i + 4 * hi);
#pragma unroll
                for (int j = 0; j < 4; ++j) { const float s = st[4 * i + j] * kk[j] + btab[bidx - 8 * i - j]; st[4 * i + j] = s; tmax = fmaxf(tmax, s); } }
            tmax = fmaxf(tmax, __shfl_xor(tmax, 32));
            const float mnew = fmaxf(mrun, tmax), alpha = __builtin_amdgcn_exp2f(mrun - mnew); mrun = mnew;
            float psum = 0.f;
#pragma unroll
            for (int r = 0; r < 16; ++r) { st[r] = __builtin_amdgcn_exp2f(st[r] - mnew); psum += st[r]; }
            lrun = lrun * alpha + psum;
#pragma unroll
            for (int r = 0; r < 16; ++r) { o0[r] *= alpha; o1[r] *= alpha; }
            v4u p0, p1;
            p0.x = cvtpk(st[0], st[1]); p0.y = cvtpk(st[2], st[3]); p0.z = cvtpk(st[4], st[5]); p0.w = cvtpk(st[6], st[7]);
            p1.x = cvtpk(st[8], st[9]); p1.y = cvtpk(st[10], st[11]); p1.z = cvtpk(st[12], st[13]); p1.w = cvtpk(st[14], st[15]);
            const LAS unsigned char* vb = wl + (4 * hi + ((lane & 15) >> 2)) * 64 + ((lane >> 4) & 1) * 32 + (lane & 3) * 8;
#pragma unroll
            for (int s = 0; s < 2; ++s) { const bf16x8 pf = __builtin_bit_cast(bf16x8, s == 0 ? p0 : p1);
                { const s16x4 a = vtr(vb + (2 * s) * 1024), c = vtr(vb + (2 * s + 1) * 1024); const bf16x8 vf = {a[0], a[1], a[2], a[3], c[0], c[1], c[2], c[3]};
                  o0 = __builtin_amdgcn_mfma_f32_32x32x16_bf16(vf, pf, o0, 0, 0, 0); }
                { const s16x4 a = vtr(vb + (2 * s) * 1024 + 512), c = vtr(vb + (2 * s + 1) * 1024 + 512); const bf16x8 vf = {a[0], a[1], a[2], a[3], c[0], c[1], c[2], c[3]};
                  o1 = __builtin_amdgcn_mfma_f32_32x32x16_bf16(vf, pf, o1, 0, 0, 0); } }
        }
        const float ltot = lrun + __shfl_xor(lrun, 32), inv = 1.f / ltot;
        bf16* orow = F.OG + ((size_t)g * HB_ROWS + qrow) * 256 + h * 64 + 4 * hi;
        typedef unsigned u32x2v __attribute__((ext_vector_type(2)));
#pragma unroll
        for (int i = 0; i < 4; ++i) { u32x2v w0, w1; w0.x = cvtpk(o0[4 * i] * inv, o0[4 * i + 1] * inv); w0.y = cvtpk(o0[4 * i + 2] * inv, o0[4 * i + 3] * inv);
            w1.x = cvtpk(o1[4 * i] * inv, o1[4 * i + 1] * inv); w1.y = cvtpk(o1[4 * i + 2] * inv, o1[4 * i + 3] * inv);
            *(u32x2v*)(orow + 8 * i) = w0; *(u32x2v*)(orow + 32 + 8 * i) = w1; }
        if (hi == 0) F.LSE[((size_t)g * HB_ROWS + qrow) * 4 + h] = (mrun + __log2f(ltot)) * LN2;
    }
}

__device__ __forceinline__ void st_attnM_mfma(Ctx& F, int hb) {
    const int lane = hw_lane(), r32 = lane & 31, hi = lane >> 5;
    LAS unsigned char* wl = F.lds + RING_OFF + F.wave * 16384;
    LAS float* kst = (LAS float*)(wl + 9216);
    typedef unsigned u32x2v __attribute__((ext_vector_type(2)));
    for (int it = F.xgwave; it < 16 * 64 * 4; it += F.NW) {
        const int h = it & 3, qb = (it >> 2) & 63, b = it >> 8;
        const size_t qrow = (size_t)(b * SEQ + qb * 32 + r32); const size_t kbase = (size_t)(hb * 16 + b) * MEML;
        const float qs = rsqrtf(((F.SS[qrow * SS_W + 96 + 4 * h] + F.SS[qrow * SS_W + 96 + 4 * h + 1]) + (F.SS[qrow * SS_W + 96 + 4 * h + 2] + F.SS[qrow * SS_W + 96 + 4 * h + 3])) * (1.f / 128.f) + EPS) * (0.08838834764831845f * LOG2E);
        bf16x8 qf[8];
#pragma unroll
        for (int d0 = 0; d0 < 8; ++d0) { const int dd = 16 * d0 + 8 * hi;
            const v4u raw = *(const v4u*)(F.PA + qrow * NIN + C_MQ + h * 128 + dd);
            const f32x4 wa = *(const f32x4*)(F.mqw + dd), wb = *(const f32x4*)(F.mqw + dd + 4), ka = *(const f32x4*)(F.mkw + dd), kb = *(const f32x4*)(F.mkw + dd + 4);
            v4u o;
            o.x = cvtpk(bflo(raw.x) * qs * wa.x * ka.x, bfhi(raw.x) * qs * wa.y * ka.y); o.y = cvtpk(bflo(raw.y) * qs * wa.z * ka.z, bfhi(raw.y) * qs * wa.w * ka.w);
            o.z = cvtpk(bflo(raw.z) * qs * wb.x * kb.x, bfhi(raw.z) * qs * wb.y * kb.y); o.w = cvtpk(bflo(raw.w) * qs * wb.z * kb.z, bfhi(raw.w) * qs * wb.w * kb.w);
            qf[d0] = __builtin_bit_cast(bf16x8, o); }
        float mrun = -1e30f, lrun = 0.f; f32x16 o0 = {}, o1 = {}, o2 = {}, o3 = {};
        for (int k0 = 0; k0 < MEML; k0 += 32) {
            const size_t krow = kbase + k0 + r32;
            bf16x8 kf[8];
#pragma unroll
            for (int d0 = 0; d0 < 8; ++d0) kf[d0] = *(const bf16x8*)(F.KVM + krow * 1024 + h * 128 + 16 * d0 + 8 * hi);
            const float ksv = rsqrtf(((F.MKSS[krow * 16 + 4 * h] + F.MKSS[krow * 16 + 4 * h + 1]) + (F.MKSS[krow * 16 + 4 * h + 2] + F.MKSS[krow * 16 + 4 * h + 3])) * (1.f / 128.f) + EPS);
#pragma unroll
            for (int i = 0; i < 8; ++i) { const v4u vr = *(const v4u*)(F.KVM + (kbase + k0 + 4 * i + (lane >> 4)) * 1024 + 512 + h * 128 + 8 * (lane & 15));
                *(LAS v4u*)(wl + ((i >> 1) * 4 + ((lane & 15) >> 2)) * 512 + (4 * (i & 1) + (lane >> 4)) * 64 + (lane & 3) * 16) = vr; }
            if (lane < 32) kst[r32] = ksv;
            f32x16 st = {};
#pragma unroll
            for (int d0 = 0; d0 < 8; ++d0) st = __builtin_amdgcn_mfma_f32_32x32x16_bf16(kf[d0], qf[d0], st, 0, 0, 0);
            float tmax = -1e30f;
#pragma unroll
            for (int i = 0; i < 4; ++i) { const f32x4 kk = *(const LAS f32x4*)(kst + 8 * i + 4 * hi);
#pragma unroll
                for (int j = 0; j < 4; ++j) { const float s = st[4 * i + j] * kk[j]; st[4 * i + j] = s; tmax = fmaxf(tmax, s); } }
            tmax = fmaxf(tmax, __shfl_xor(tmax, 32));
            const float mnew = fmaxf(mrun, tmax), alpha = __builtin_amdgcn_exp2f(mrun - mnew); mrun = mnew;
            float psum = 0.f;
#pragma unroll
            for (int r = 0; r < 16; ++r) { st[r] = __builtin_amdgcn_exp2f(st[r] - mnew); psum += st[r]; }
            lrun = lrun * alpha + psum;
#pragma unroll
            for (int r = 0; r < 16; ++r) { o0[r] *= alpha; o1[r] *= alpha; o2[r] *= alpha; o3[r] *= alpha; }
            v4u p0, p1;
            p0.x = cvtpk(st[0], st[1]); p0.y = cvtpk(st[2], st[3]); p0.z = cvtpk(st[4], st[5]); p0.w = cvtpk(st[6], st[7]);
            p1.x = cvtpk(st[8], st[9]); p1.y = cvtpk(st[10], st[11]); p1.z = cvtpk(st[12], st[13]); p1.w = cvtpk(st[14], st[15]);
            const LAS unsigned char* vb = wl + (4 * hi + ((lane & 15) >> 2)) * 64 + ((lane >> 4) & 1) * 32 + (lane & 3) * 8;
#define AM_PV(OX, DB) do { _Pragma("unroll") for (int s = 0; s < 2; ++s) { const bf16x8 pf = __builtin_bit_cast(bf16x8, s == 0 ? p0 : p1); \
                const s16x4 a = vtr(vb + (2 * s) * 2048 + (DB) * 512), c = vtr(vb + (2 * s + 1) * 2048 + (DB) * 512); const bf16x8 vf = {a[0], a[1], a[2], a[3], c[0], c[1], c[2], c[3]}; \
                OX = __builtin_amdgcn_mfma_f32_32x32x16_bf16(vf, pf, OX, 0, 0, 0); } } while (0)
            AM_PV(o0, 0); AM_PV(o1, 1); AM_PV(o2, 2); AM_PV(o3, 3);
#undef AM_PV
        }
        const float ltot = lrun + __shfl_xor(lrun, 32), inv = 1.f / ltot;
        const bf16* zrow = F.PA + qrow * NIN + C_MZ + h * 128 + 4 * hi; bf16* yrow = F.YC + qrow * KC + 1024 + h * 128 + 4 * hi;
#define AM_ST(OX, DB) do { _Pragma("unroll") for (int i = 0; i < 4; ++i) { const u32x2v z = *(const u32x2v*)(zrow + (DB) * 32 + 8 * i); u32x2v w; \
            w.x = cvtpk(OX[4 * i] * inv * bflo(z.x), OX[4 * i + 1] * inv * bfhi(z.x)); w.y = cvtpk(OX[4 * i + 2] * inv * bflo(z.y), OX[4 * i + 3] * inv * bfhi(z.y)); \
            *(u32x2v*)(yrow + (DB) * 32 + 8 * i) = w; } } while (0)
        AM_ST(o0, 0); AM_ST(o1, 1); AM_ST(o2, 2); AM_ST(o3, 3);
#undef AM_ST
    }
}

__device__ __forceinline__ void st_mixA_mfma(Ctx& F) {
    const int lane = hw_lane(), r32 = lane & 31, hi = lane >> 5, tid = F.wave * 64 + lane;
    LAS unsigned char* wl = F.lds + RING_OFF + F.wave * 16384;
    typedef float f32x2v __attribute__((ext_vector_type(2))); typedef unsigned u32x2v __attribute__((ext_vector_type(2)));
    LAS f32x2v* tab = (LAS f32x2v*)(F.lds + WSCR_OFF + 8192);
    const int g = F.wave >> 1, ch = lane & 3;
    bf16x8 wf[20];
    { const bf16* wrow = F.WSP + (size_t)(g * 128 + r32) * 128 + 8 * hi; int n = 0;
#pragma unroll
      for (int tb = 0; tb < 4; ++tb)
#pragma unroll
          for (int ks = 0; ks < 2 * (tb + 1); ++ks) wf[n++] = *(const bf16x8*)(wrow + (size_t)tb * 32 * 128 + 16 * ks); }
    for (int unit = blockIdx.x; unit < HB_ROWS / 128; unit += F.G) {
        const int rowbase = unit * 128;
        v4u raw[8];
        { const int c0 = g * 192 + (F.wave & 1) * 96;
#pragma unroll
          for (int i = 0; i < 8; ++i) raw[i] = *(const v4u*)(F.PA + (size_t)(rowbase + (lane >> 2) + 16 * i) * NIN + C_AV + c0 + 8 * ch); }
        { const int row = tid >> 2, part = tid & 3; const float* sp = F.SS + (size_t)(rowbase + row) * SS_W + 12 * part; float s = 0.f, q = 0.f;
#pragma unroll
          for (int k = 0; k < 6; ++k) { s += sp[2 * k]; q += sp[2 * k + 1]; }
          s += __shfl_xor(s, 1); s += __shfl_xor(s, 2); q += __shfl_xor(q, 1); q += __shfl_xor(q, 2);
          const float mu = s * (1.f / 768.f), var = q * (1.f / 768.f) - mu * mu;
          if (part == 0) tab[row] = (f32x2v){mu, rsqrtf(fmaxf(var, 0.f) + EPS)}; }
        __syncthreads();
#pragma unroll 1
        for (int cbi = 0; cbi < 3; ++cbi) {
            const int c0 = g * 192 + ((F.wave & 1) * 3 + cbi) * 32;
            const f32x4 w0 = *(const f32x4*)(F.lnw + c0 + 8 * ch), w1 = *(const f32x4*)(F.lnw + c0 + 8 * ch + 4), b0 = *(const f32x4*)(F.lnb + c0 + 8 * ch), b1 = *(const f32x4*)(F.lnb + c0 + 8 * ch + 4);
#pragma unroll
            for (int i = 0; i < 8; ++i) { const int s = (lane >> 2) + 16 * i; const f32x2v st = tab[s]; const v4u rw = raw[i]; v4u o;
                o.x = cvtpk((bflo(rw.x) - st.x) * st.y * w0.x + b0.x, (bfhi(rw.x) - st.x) * st.y * w0.y + b0.y); o.y = cvtpk((bflo(rw.y) - st.x) * st.y * w0.z + b0.z, (bfhi(rw.y) - st.x) * st.y * w0.w + b0.w);
                o.z = cvtpk((bflo(rw.z) - st.x) * st.y * w1.x + b1.x, (bfhi(rw.z) - st.x) * st.y * w1.y + b1.y); o.w = cvtpk((bflo(rw.w) - st.x) * st.y * w1.z + b1.z, (bfhi(rw.w) - st.x) * st.y * w1.w + b1.w);
                *(LAS v4u*)(wl + (s >> 3) * 512 + (s & 7) * 64 + ch * 16) = o; }
            if (cbi < 2) {
#pragma unroll
                for (int i = 0; i < 8; ++i) raw[i] = *(const v4u*)(F.PA + (size_t)(rowbase + (lane >> 2) + 16 * i) * NIN + C_AV + c0 + 32 + 8 * ch); }
            u32x2v uu[2][4], zz[2][4];
#define MA_LDUZ(TB) do { const size_t row_ = (size_t)(rowbase + 32 * (TB) + r32); _Pragma("unroll") for (int i = 0; i < 4; ++i) { \
                uu[(TB) & 1][i] = *(const u32x2v*)(F.PA + row_ * NIN + C_AU + c0 + 4 * hi + 8 * i); zz[(TB) & 1][i] = *(const u32x2v*)(F.PA + row_ * NIN + C_AZ + c0 + 4 * hi + 8 * i); } } while (0)
            MA_LDUZ(0);
            const LAS unsigned char* vb = wl + hi * 512 + ((lane & 15) >> 2) * 64 + ((lane >> 4) & 1) * 32 + (lane & 3) * 8;
            int n = 0;
#pragma unroll
            for (int tb = 0; tb < 4; ++tb) { f32x16 acc = {};
                if (tb < 3) MA_LDUZ(tb + 1);
#pragma unroll
                for (int ks = 0; ks < 2 * (tb + 1); ++ks) { const s16x4 a = vtr(vb + ks * 1024), c = vtr(vb + ks * 1024 + 256); const bf16x8 af = {a[0], a[1], a[2], a[3], c[0], c[1], c[2], c[3]};
                    acc = __builtin_amdgcn_mfma_f32_32x32x16_bf16(af, wf[n++], acc, 0, 0, 0); }
                const int t = 32 * tb + r32; const size_t row = (size_t)(rowbase + t); const float sb = F.sp_b[g * 128 + t];
                bf16* yp = F.YC + row * KC + c0 + 4 * hi;
#pragma unroll
                for (int i = 0; i < 4; ++i) { const u32x2v u = uu[tb & 1][i], z = zz[tb & 1][i]; u32x2v w;
                    w.x = cvtpk(bflo(u.x) * (acc[4 * i] + sb) * bflo(z.x), bfhi(u.x) * (acc[4 * i + 1] + sb) * bfhi(z.x)); w.y = cvtpk(bflo(u.y) * (acc[4 * i + 2] + sb) * bflo(z.y), bfhi(u.y) * (acc[4 * i + 3] + sb) * bfhi(z.y));
                    *(u32x2v*)(yp + 8 * i) = w; } }
#undef MA_LDUZ
        }
        __syncthreads();
    }
}

__device__ __forceinline__ void st_mergeB_vec(Ctx& F) {
    for (int gid = F.gtid; gid < HB_ROWS * 32; gid += F.T) {
        const int r = gid >> 5, c8 = (gid & 31) * 8, h = c8 >> 6;
        const float l0 = F.LSE[((size_t)0 * HB_ROWS + r) * 4 + h], l1 = F.LSE[((size_t)1 * HB_ROWS + r) * 4 + h], l2 = F.LSE[((size_t)2 * HB_ROWS + r) * 4 + h];
        const float mx = fmaxf(l0, fmaxf(l1, l2)); float e0 = __expf(l0 - mx), e1 = __expf(l1 - mx), e2 = __expf(l2 - mx); const float inv = 1.f / (e0 + e1 + e2); e0 *= inv; e1 *= inv; e2 *= inv;
        const v4u a = *(const v4u*)(F.OG + ((size_t)0 * HB_ROWS + r) * 256 + c8), b = *(const v4u*)(F.OG + ((size_t)1 * HB_ROWS + r) * 256 + c8), c = *(const v4u*)(F.OG + ((size_t)2 * HB_ROWS + r) * 256 + c8);
        const v4u z = *(const v4u*)(F.PA + (size_t)r * NIN + C_BZ + c8); v4u o;
#define MB_1(X) X = pk2((e0 * bflo(a.X) + e1 * bflo(b.X) + e2 * bflo(c.X)) * bflo(z.X), (e0 * bfhi(a.X) + e1 * bfhi(b.X) + e2 * bfhi(c.X)) * bfhi(z.X))
        o.MB_1(x); o.MB_1(y); o.MB_1(z); o.MB_1(w);
#undef MB_1
        *(v4u*)(F.YC + (size_t)r * KC + 768 + c8) = o; }
}

__device__ __forceinline__ void dma16(const void* gsrc, LAS unsigned char* ldst) { __builtin_amdgcn_global_load_lds((const unsigned*)gsrc, (LAS unsigned*)ldst, 16, 0, 0); }
#define VM_WAIT0() asm volatile("s_waitcnt vmcnt(0)" ::: "memory")

__device__ __forceinline__ void st_attnM_v2(Ctx& F, int hb) {
    const int lane = hw_lane(), r32 = lane & 31, hi = lane >> 5;
    LAS unsigned char* wl = F.lds + RING_OFF + F.wave * 16384;
    LAS float* kst = (LAS float*)(F.lds + WSCR_OFF + F.wave * 1024);
    typedef unsigned u32x2v __attribute__((ext_vector_type(2)));
    const int vkey = (lane & 31) >> 2, vd = (lane >> 5) * 32 + (lane & 3) * 8;
    for (int it = F.xgwave; it < 16 * 64 * 4; it += F.NW) {
        const int h = it & 3, qb = (it >> 2) & 63, b = it >> 8;
        const size_t qrow = (size_t)(b * SEQ + qb * 32 + r32); const size_t kbase = (size_t)(hb * 16 + b) * MEML;
        const bf16* kp = F.KVM + (kbase + r32) * 1024 + h * 128 + 8 * hi;
        const float* ksp = F.MKSS + (kbase + r32) * 16 + 4 * h;
        const bf16* vp = F.KVM + (kbase + vkey) * 1024 + 512 + h * 128 + vd;
        bf16x8 kfn[8]; f32x4 ksn;
#define AM_ISSUE(T, STG) do { _Pragma("unroll") for (int d0 = 0; d0 < 8; ++d0) kfn[d0] = *(const bf16x8*)(kp + (size_t)(T) * 32 * 1024 + 16 * d0); ksn = *(const f32x4*)(ksp + (size_t)(T) * 32 * 16); \
        _Pragma("unroll") for (int j = 0; j < 8; ++j) dma16(vp + ((size_t)(T) * 32 + 8 * (j >> 1)) * 1024 + 64 * (j & 1), wl + (STG) * 8192 + j * 1024); } while (0)
        AM_ISSUE(0, 0);
        const float qs = rsqrtf(((F.SS[qrow * SS_W + 96 + 4 * h] + F.SS[qrow * SS_W + 96 + 4 * h + 1]) + (F.SS[qrow * SS_W + 96 + 4 * h + 2] + F.SS[qrow * SS_W + 96 + 4 * h + 3])) * (1.f / 128.f) + EPS) * (0.08838834764831845f * LOG2E);
        bf16x8 qf[8];
#pragma unroll
        for (int d0 = 0; d0 < 8; ++d0) { const int dd = 16 * d0 + 8 * hi;
            const v4u raw = *(const v4u*)(F.PA + qrow * NIN + C_MQ + h * 128 + dd);
            const f32x4 wa = *(const f32x4*)(F.mqw + dd), wb = *(const f32x4*)(F.mqw + dd + 4), ka = *(const f32x4*)(F.mkw + dd), kb = *(const f32x4*)(F.mkw + dd + 4);
            v4u o;
            o.x = cvtpk(bflo(raw.x) * qs * wa.x * ka.x, bfhi(raw.x) * qs * wa.y * ka.y); o.y = cvtpk(bflo(raw.y) * qs * wa.z * ka.z, bfhi(raw.y) * qs * wa.w * ka.w);
            o.z = cvtpk(bflo(raw.z) * qs * wb.x * kb.x, bfhi(raw.z) * qs * wb.y * kb.y); o.w = cvtpk(bflo(raw.w) * qs * wb.z * kb.z, bfhi(raw.w) * qs * wb.w * kb.w);
            qf[d0] = __builtin_bit_cast(bf16x8, o); }
        float mrun = -1e30f, lrun = 0.f; f32x16 o0 = {}, o1 = {}, o2 = {}, o3 = {};
        for (int t = 0; t < MEML / 32; ++t) {
            VM_WAIT0();
            bf16x8 kf[8];
#pragma unroll
            for (int d0 = 0; d0 < 8; ++d0) kf[d0] = kfn[d0];
            const float ksv = rsqrtf(((ksn[0] + ksn[1]) + (ksn[2] + ksn[3])) * (1.f / 128.f) + EPS);
            if (t + 1 < MEML / 32) AM_ISSUE(t + 1, (t + 1) & 1);
            if (lane < 32) kst[r32] = ksv;
            f32x16 st = {};
#pragma unroll
            for (int d0 = 0; d0 < 8; ++d0) st = __builtin_amdgcn_mfma_f32_32x32x16_bf16(kf[d0], qf[d0], st, 0, 0, 0);
            float tmax = -1e30f;
#pragma unroll
            for (int i = 0; i < 4; ++i) { const f32x4 kk = *(const LAS f32x4*)(kst + 8 * i + 4 * hi);
#pragma unroll
                for (int j = 0; j < 4; ++j) { const float s = st[4 * i + j] * kk[j]; st[4 * i + j] = s; tmax = fmaxf(tmax, s); } }
            tmax = fmaxf(tmax, __shfl_xor(tmax, 32));
            const float mnew = fmaxf(mrun, tmax), alpha = __builtin_amdgcn_exp2f(mrun - mnew); mrun = mnew;
            float psum = 0.f;
#pragma unroll
            for (int r = 0; r < 16; ++r) { st[r] = __builtin_amdgcn_exp2f(st[r] - mnew); psum += st[r]; }
            lrun = lrun * alpha + psum;
#pragma unroll
            for (int r = 0; r < 16; ++r) { o0[r] *= alpha; o1[r] *= alpha; o2[r] *= alpha; o3[r] *= alpha; }
            v4u p0, p1;
            p0.x = cvtpk(st[0], st[1]); p0.y = cvtpk(st[2], st[3]); p0.z = cvtpk(st[4], st[5]); p0.w = cvtpk(st[6], st[7]);
            p1.x = cvtpk(st[8], st[9]); p1.y = cvtpk(st[10], st[11]); p1.z = cvtpk(st[12], st[13]); p1.w = cvtpk(st[14], st[15]);
            const LAS unsigned char* vb = wl + (t & 1) * 8192 + (4 * hi + ((lane & 15) >> 2)) * 64 + ((lane >> 4) & 1) * 32 + (lane & 3) * 8;
#define AM_PV(OX, DB) do { _Pragma("unroll") for (int s = 0; s < 2; ++s) { const bf16x8 pf = __builtin_bit_cast(bf16x8, s == 0 ? p0 : p1); \
                const s16x4 a = vtr(vb + (2 * s) * 2048 + (DB) * 512), c = vtr(vb + (2 * s + 1) * 2048 + (DB) * 512); const bf16x8 vf = {a[0], a[1], a[2], a[3], c[0], c[1], c[2], c[3]}; \
                OX = __builtin_amdgcn_mfma_f32_32x32x16_bf16(vf, pf, OX, 0, 0, 0); } } while (0)
            AM_PV(o0, 0); AM_PV(o1, 1); AM_PV(o2, 2); AM_PV(o3, 3);
#undef AM_PV
        }
#undef AM_ISSUE
        const float ltot = lrun + __shfl_xor(lrun, 32), inv = 1.f / ltot;
        const bf16* zrow = F.PA + qrow * NIN + C_MZ + h * 128 + 4 * hi; bf16* yrow = F.YC + qrow * KC + 1024 + h * 128 + 4 * hi;
#define AM_ST(OX, DB) do { _Pragma("unroll") for (int i = 0; i < 4; ++i) { const u32x2v z = *(const u32x2v*)(zrow + (DB) * 32 + 8 * i); u32x2v w; \
            w.x = cvtpk(OX[4 * i] * inv * bflo(z.x), OX[4 * i + 1] * inv * bfhi(z.x)); w.y = cvtpk(OX[4 * i + 2] * inv * bflo(z.y), OX[4 * i + 3] * inv * bfhi(z.y)); \
            *(u32x2v*)(yrow + (DB) * 32 + 8 * i) = w; } } while (0)
        AM_ST(o0, 0); AM_ST(o1, 1); AM_ST(o2, 2); AM_ST(o3, 3);
#undef AM_ST
    }
}

#ifndef G1_STAGGER_TICKS
#define G1_STAGGER_TICKS 0
#endif
#ifndef PROBE_REP
#define PROBE_REP -1
#endif
#define REPS(id) for (int rep_ = 0; rep_ < ((PROBE_REP) == (id) ? 2 : 1); ++rep_)
#ifndef MK_PER_PHASE
#define MK_PER_PHASE 0
#endif
constexpr int NPH_HALF = 5, NPHASES = 1 + 2 * NPH_HALF;
struct Args { const float* in[20]; float* out; unsigned char* ws; int ph_lo, ph_hi; };
__global__ void __launch_bounds__(NTHR, 2) mega_fwd(Args args) {
    extern __shared__ __attribute__((aligned(16))) unsigned char lds_raw[];
    Ctx F;
    F.lds = (LAS unsigned char*)lds_raw;
    F.tid = threadIdx.x; F.lane = F.tid & 63; F.wave = __builtin_amdgcn_readfirstlane(F.tid >> 6);
    F.G = gridDim.x; F.gtid = blockIdx.x * NTHR + F.tid; F.T = F.G * NTHR; F.gwave = blockIdx.x * NWAVES + F.wave; F.NW = F.G * NWAVES;
    { const int bx = blockIdx.x; const int vcu = (F.G % 8 == 0) ? (bx % 8) * (F.G / 8) + bx / 8 : bx; F.xgwave = vcu * NWAVES + F.wave; }
    unsigned char* ws = args.ws;
    F.x = args.in[0]; F.mem = args.in[1]; F.norm_w = args.in[2]; F.w_in = args.in[3]; F.gate_b = args.in[4]; F.lnw = args.in[5]; F.lnb = args.in[6]; F.sp_w = args.in[7];
    F.sp_b = args.in[8]; F.bqw = args.in[9]; F.bkw = args.in[10]; F.rel_bias = args.in[11]; F.mem_norm_w = args.in[12]; F.m_w_kv = args.in[13]; F.mqw = args.in[14]; F.mkw = args.in[15];
    F.proj_a = args.in[16]; F.proj_b = args.in[17]; F.proj_m = args.in[18]; F.w_out = args.in[19]; F.out = args.out;
    F.WIN = (bf16*)(ws + WS_WIN); F.PCAT = (bf16*)(ws + WS_PCAT); F.WOUT = (bf16*)(ws + WS_WOUT); F.WSP = (bf16*)(ws + WS_WSP); F.BIAS = (float*)(ws + WS_BIAS); F.BIASX = (float*)(ws + WS_BIAS + 65536);
    F.XN = (bf16*)(ws + WS_XN); F.PA = (bf16*)(ws + WS_PA); F.KVM = (bf16*)(ws + WS_KVM); F.SS = (float*)(ws + WS_SS); F.MKSS = (float*)(ws + WS_MKSS);
    F.OG = (bf16*)(ws + WS_OG); F.LSE = (float*)(ws + WS_LSE); F.LNST = (float*)(ws + WS_LNST); F.YC = (bf16*)(ws + WS_YC); F.MRG = (bf16*)(ws + WS_MRG);
    for (int u = F.tid; u < (LDS_BYTES - LDSCTL_OFF) / 4; u += NTHR) ((LAS unsigned*)(F.lds + LDSCTL_OFF))[u] = 0u;
    __syncthreads();
    XcdBarrier bar; bar.bar = (unsigned*)(ws + WS_CTL) + CW_BAR; bar.x = 0; bar.st = nullptr; bar.wave = 0;
    if (!MK_PER_PHASE) bar = xcd_barrier_post((unsigned*)(ws + WS_CTL) + CW_BAR, (volatile LAS unsigned*)(F.lds + MISC_OFF) + 8, F.wave);
    const int lo = args.ph_lo, hi = args.ph_hi;
#define IN(k) (lo <= (k) && (k) < hi)
#define SEAM(k) do { if (IN(k) && IN((k) + 1)) xcd_barrier(bar); } while (0)

    if (IN(0)) { REPS(0) p0_prologue(F); } SEAM(0);
#pragma unroll 1
    for (int hb = 0; hb < 2; ++hb) {
        const int pb = 1 + hb * NPH_HALF, row0 = hb * HB_ROWS;
        asm volatile("v_mbcnt_lo_u32_b32 %0, -1, 0\n\tv_mbcnt_hi_u32_b32 %0, -1, %0" : "=v"(F.lane)); F.tid = F.wave * 64 + F.lane; F.gtid = blockIdx.x * NTHR + F.tid;
#if PROBE_REP == 9 || PROBE_REP == 10
        if (IN(pb + 0)) { pg8::Gemm g{F.XN, F.WIN, MTOT + MMEM, NIN + 1024, DM, DM, DM}; pg8::OrderG1 S; S.init(hb, F.G, (int)blockIdx.x);
            typedef pg8::EpiProjT<PROBE_REP - 8> EP; EP E{F.PA, F.KVM, F.SS, F.MKSS, F.gate_b, hb * (HB_ROWS / 256), 0};
            pg8::gemm_phase<EP, pg8::OrderG1, true, true>(F.lds + RING_OFF, g, S, E, F.wave); }
#endif
        if (IN(pb + 0)) REPS(1) {
            pg8::Gemm g{F.XN, F.WIN, MTOT + MMEM, NIN + 1024, DM, DM, DM}; pg8::OrderG1 S; S.init(hb, F.G, (int)blockIdx.x);
#if G1_STAGGER_TICKS
            { const unsigned long long t0 = __builtin_amdgcn_s_memrealtime(), dl = (unsigned long long)((blockIdx.x >> 3) & 31) * G1_STAGGER_TICKS;
              while (__builtin_amdgcn_s_memrealtime() - t0 < dl) __builtin_amdgcn_s_sleep(8); }
#endif
            pg8::EpiProj E{F.PA, F.KVM, F.SS, F.MKSS, F.gate_b, hb * (HB_ROWS / 256), 0};
            pg8::gemm_phase<pg8::EpiProj, pg8::OrderG1, true, true>(F.lds + RING_OFF, g, S, E, F.wave);
        }
#if PROBE_REP == 8
        if (IN(pb + 0)) { pg8::Gemm g{F.XN, F.WIN, MTOT + MMEM, NIN + 1024, DM, DM, DM}; pg8::OrderG1 S; S.init(hb, F.G, (int)blockIdx.x); pg8::EpiNull E{};
            pg8::gemm_phase<pg8::EpiNull, pg8::OrderG1, true, true>(F.lds + RING_OFF, g, S, E, F.wave); }
#endif
        SEAM(pb + 0);
        if (IN(pb + 1)) { REPS(2) st_mixA_mfma(F); REPS(3) st_attnB_mfma(F); REPS(4) st_attnM_v2(F, hb); } SEAM(pb + 1);
        if (IN(pb + 2)) { REPS(5) st_mergeB_vec(F); } SEAM(pb + 2);
        if (IN(pb + 3)) REPS(6) {
            pg8::Gemm g{F.YC, F.PCAT, HB_ROWS, DM, KC, KC, KC}; pg8::StaticOrder S; S.init(HB_ROWS, DM, F.G, (int)blockIdx.x);
            pg8::EpiG2cat E{F.PA, F.MRG};
            pg8::gemm_phase<pg8::EpiG2cat, pg8::StaticOrder, true, true>(F.lds + RING_OFF, g, S, E, F.wave);
        } SEAM(pb + 3);
        if (IN(pb + 4)) REPS(7) {
            pg8::Gemm g{F.MRG, F.WOUT, HB_ROWS, DM, DM, DM, DM}; pg8::StaticOrder S; S.init(HB_ROWS, DM, F.G, (int)blockIdx.x);
            pg8::EpiG3 E{F.x + (size_t)row0 * DM, F.out + (size_t)row0 * DM};
            pg8::gemm_phase<pg8::EpiG3, pg8::StaticOrder, true, true>(F.lds + RING_OFF, g, S, E, F.wave);
        } SEAM(pb + 4);
    }
#undef IN
#undef SEAM
}

extern "C" void kernel_launch(void* const* d_in, const int* in_sizes, int n_in, void* d_out, int out_size, void* d_ws, size_t ws_size, hipStream_t stream) {
    static int grid = 0;
    if (grid == 0) {
        if (n_in != 20 || in_sizes[0] != MTOT * DM || out_size != MTOT * DM || ws_size < WS_END) { fprintf(stderr, "kernel_launch: unexpected shapes (n_in %d, ws %zu); nothing launched\n", n_in, ws_size); grid = -1; return; }
        int dev = 0, cus = 0, per_cu = 0;
        if (hipGetDevice(&dev) != hipSuccess || hipDeviceGetAttribute(&cus, hipDeviceAttributeMultiprocessorCount, dev) != hipSuccess) { grid = -1; return; }
        if (hipFuncSetAttribute((const void*)mega_fwd, hipFuncAttributeMaxDynamicSharedMemorySize, LDS_BYTES) != hipSuccess) { fprintf(stderr, "kernel_launch: hipFuncSetAttribute failed\n"); grid = -1; return; }
        if (hipOccupancyMaxActiveBlocksPerMultiprocessor(&per_cu, (const void*)mega_fwd, NTHR, LDS_BYTES) != hipSuccess || per_cu < 1) { fprintf(stderr, "kernel_launch: occupancy query says %d blocks per CU\n", per_cu); (void)hipGetLastError(); grid = -1; return; }
        grid = cus;
    }
    if (grid < 0) return;
    if (hipMemsetAsync((char*)d_ws + WS_CTL, 0, CTL_ZERO_BYTES, stream) != hipSuccess) return;
    Args a{};
    for (int i = 0; i < 20; ++i) a.in[i] = (const float*)d_in[i];
    a.out = (float*)d_out; a.ws = (unsigned char*)d_ws;
#if MK_PER_PHASE
    for (int p = 0; p < NPHASES; ++p) { a.ph_lo = p; a.ph_hi = p + 1; hipLaunchKernelGGL(mega_fwd, dim3(grid), dim3(NTHR), LDS_BYTES, stream, a); }
#else
    a.ph_lo = 0; a.ph_hi = NPHASES; hipLaunchKernelGGL(mega_fwd, dim3(grid), dim3(NTHR), LDS_BYTES, stream, a);
#endif
}
```

```cpp
#include <hip/hip_runtime.h>
#include <cstdint>
#include <cstdio>

constexpr int DM = 1024, NB = 32, SEQ = 2048, MTOT = NB * SEQ;
constexpr int NIN = 8960, MEML = 256, MMEM = NB * MEML;
constexpr int HB_ROWS = MTOT / 2;
constexpr int C_AU = 0, C_AV = 768, C_AZ = 1536, C_BQ = 2304, C_BK = 3072, C_BV = 3840, C_BZ = 4608, C_MQ = 4864, C_MZ = 5376, C_G = 5888;
constexpr float EPS = 1e-6f;
constexpr int SS_W = 112;
constexpr int KC = 1536;

constexpr size_t MiB = 1u << 20;
constexpr size_t WS_CTL = 0, CTL_ZERO_BYTES = 256 * 1024, WS_WIN = 2 * MiB, WS_PCAT = 22 * MiB, WS_WOUT = 25 * MiB, WS_WSP = 27 * MiB, WS_BIAS = 27 * MiB + 512 * 1024;
constexpr size_t WS_XN = 32 * MiB, WS_PA = 176 * MiB, WS_KVM = 736 * MiB, WS_SS = 752 * MiB, WS_MKSS = 766 * MiB, WS_OG = 768 * MiB, WS_LSE = 816 * MiB, WS_LNST = 818 * MiB;
constexpr size_t WS_YC = 820 * MiB, WS_MRG = 916 * MiB, WS_END = 980 * MiB;
constexpr int CW_BAR = 4096;

namespace pg8 {
#define PG8_LAS __attribute__((address_space(3)))
typedef unsigned short bf16_t;
typedef short bf16x8 __attribute__((ext_vector_type(8)));
typedef float f32x4 __attribute__((ext_vector_type(4)));
typedef unsigned u32x4 __attribute__((ext_vector_type(4)));
constexpr int BM = 256, BK = 64, HALF = 128, HTB = HALF * BK * 2  , STAGE_BYTES = 8 * HTB, NXCD = 8, WGM = 8;

__host__ __device__ __forceinline__ int lds_byte(int r, int c) { const int st = (r >> 4) * 2 + (c >> 5), rr = r & 15, cc = c & 31, ob = rr * 64 + cc * 2; return st * 1024 + (ob ^ (((ob >> 9) & 1) << 5)); }
__host__ __device__ __forceinline__ void stage_rc(int b, int& R, int& C) { const int st = b / 1024, sb = b % 1024, swz = sb ^ (((sb >> 9) & 1) << 5); R = (st >> 1) * 16 + swz / 64; C = (st & 1) * 32 + (swz % 64) / 2; }
__host__ __device__ __forceinline__ int perm32(int rho) { const int n = rho >> 4, i = rho & 15; return 8 * (i >> 2) + 4 * n + (i & 3); }

struct Unit { int pm, pn; };
struct Gemm { const bf16_t* A; const bf16_t* Bt; int M, N, K, lda, ldb; };

struct StaticOrder {
    int nM, nN, nwg, G, c;
    __host__ __device__ void init(int M, int N, int G_, int c_) { nM = M / BM; nN = N / BM; nwg = nM * nN; G = G_; c = c_; }
    __host__ __device__ bool next(int i, Unit& u) const {
        const long L = (long)i * G + c; if (L >= nwg) return false;
        int wgid = (int)L; { const int q = nwg / NXCD, r = nwg % NXCD, xcd = wgid % NXCD, off = wgid / NXCD; wgid = (xcd < r ? xcd * (q + 1) : r * (q + 1) + (xcd - r) * q) + off; }
        const int nig = WGM * nN, gid = wgid / nig, fm = gid * WGM, gsz = (nM - fm) < WGM ? (nM - fm) : WGM;
        u.pm = fm + ((wgid % nig) % gsz); u.pn = (wgid % nig) / gsz; return true;
    }
    __device__ __forceinline__ void a_ready(const Unit&) const {}
    __device__ __forceinline__ void done(const Unit&) const {}
};


typedef float f32x2c_t __attribute__((ext_vector_type(2))); typedef __bf16 bf16x2c_t __attribute__((ext_vector_type(2)));
__device__ __forceinline__ unsigned cvt_pk_bf16(float lo, float hi) { const f32x2c_t v = {lo, hi}; const bf16x2c_t b = __builtin_convertvector(v, bf16x2c_t); return __builtin_bit_cast(unsigned, b); }
typedef float f32x2 __attribute__((ext_vector_type(2)));
__device__ __forceinline__ f32x2 gelu_pk(f32x2 v) {
    const f32x2 av = __builtin_elementwise_abs(v), d = av * 0.2316418882f + 1.0f;
    f32x2 t; t.x = __builtin_amdgcn_rcpf(d.x); t.y = __builtin_amdgcn_rcpf(d.y);
    f32x2 q = t * 0.5307027145f + (-0.7265760135f); q = q * t + 0.7107068705f; q = q * t + (-0.142248368f); q = q * t + 0.127414796f; q = q * t;
    const f32x2 s = (v * v) * (-0.72134752044f);
    f32x2 e; e.x = __builtin_amdgcn_exp2f(s.x); e.y = __builtin_amdgcn_exp2f(s.y);
    const f32x2 m = v * (q * e), r = v - m;
    f32x2 o; o.x = v.x < 0.f ? m.x : r.x; o.y = v.y < 0.f ? m.y : r.y; return o;
}

template <class Epi, class Sched, bool ALIGN_EPI = false, bool SP2 = false>
__device__ __forceinline__ void gemm_phase(PG8_LAS unsigned char* lds, const Gemm g, const Sched& S, const Epi& E, const int wave_id) {
    int tid; asm volatile("v_mbcnt_lo_u32_b32 %0, -1, 0\n\tv_mbcnt_hi_u32_b32 %0, -1, %0" : "=v"(tid)); tid += wave_id * 64;
    const int wid = __builtin_amdgcn_readfirstlane(tid >> 6), lane = tid & 63, wr = wid >> 2, wc = wid & 3, fr = lane & 15, fq = lane >> 4;
    int K = g.K; asm volatile("" : "+s"(K)); const int nt = K / BK;
    unsigned voffA[2], voffB[2];
#pragma unroll
    for (int i = 0; i < 2; ++i) { int R, C; stage_rc(tid * 16 + i * 8192, R, C); const int Rb = Epi::PERM ? ((R & ~31) + perm32(R & 31)) : R;
        voffA[i] = (unsigned)(R * g.lda + C) * 2u; voffB[i] = (unsigned)(Rb * g.ldb + C) * 2u; }
    const size_t kstep = (size_t)(BK * 2);
    const size_t hstepA = (size_t)HALF * g.lda * 2, hstepB = (size_t)HALF * g.ldb * 2;
    const size_t tstepA = 2 * hstepA, tstepB = 2 * hstepB;
    const unsigned ldsw = (unsigned)wid * 1024u;
    const int aoff = lds_byte(wr * 64 + fr, fq * 8), boff = lds_byte(wc * 32 + fr, fq * 8);
#define PG8_SA(b, h) (((b) * 2 + (h)) * HTB)
#define PG8_SB(b, h) ((4 + (b) * 2 + (h)) * HTB)
#define PG8_STAGE(bufoff, gbase, voff) do { _Pragma("unroll") for (int _i = 0; _i < 2; ++_i) \
        __builtin_amdgcn_global_load_lds((const unsigned*)((const char*)(gbase) + (voff)[_i]), (PG8_LAS unsigned*)(lds + (bufoff) + ldsw + _i * 8192), 16, 0, 0); } while (0)
#define PG8_LDA(dst, b, h) do { _Pragma("unroll") for (int m = 0; m < 4; ++m) _Pragma("unroll") for (int k = 0; k < 2; ++k) dst[m][k] = *(const PG8_LAS bf16x8*)(lds + PG8_SA(b, h) + aoff + m * 2048 + k * 1024); } while (0)
#define PG8_LDB(dst, b, h) do { _Pragma("unroll") for (int n = 0; n < 2; ++n) _Pragma("unroll") for (int k = 0; k < 2; ++k) dst[n][k] = *(const PG8_LAS bf16x8*)(lds + PG8_SB(b, h) + boff + n * 2048 + k * 1024); } while (0)
#define PG8_MMA(ai, bj, At, Bt) do { __builtin_amdgcn_s_setprio(1); _Pragma("unroll") for (int m = 0; m < 4; ++m) _Pragma("unroll") for (int n = 0; n < 2; ++n) _Pragma("unroll") for (int k = 0; k < 2; ++k) \
        acc[ai][bj][m][n] = __builtin_amdgcn_mfma_f32_16x16x32_bf16(Bt[n][k], At[m][k], acc[ai][bj][m][n], 0, 0, 0); __builtin_amdgcn_s_setprio(0); } while (0)
#define PG8_WAIT_V(n) asm volatile("s_waitcnt vmcnt(" #n ")" ::: "memory")
#define PG8_WAIT_L(n) asm volatile("s_waitcnt lgkmcnt(" #n ")" ::: "memory")
#define PG8_BAR __builtin_amdgcn_s_barrier()
#define PG8_SCHED __builtin_amdgcn_sched_barrier(0)
    Unit cur, nxt; int ui = 0;
    if (!S.next(0, cur)) return;
    f32x4 acc[2][2][4][2];
#pragma unroll
    for (int a = 0; a < 2; ++a)
#pragma unroll
        for (int b = 0; b < 2; ++b)
#pragma unroll
            for (int m = 0; m < 4; ++m)
#pragma unroll
                for (int n = 0; n < 2; ++n) acc[a][b][m][n] = (f32x4){0.f, 0.f, 0.f, 0.f};
    bf16x8 At[4][2], B0[2][2], B1[2][2];
    const char* cA = (const char*)g.A + (size_t)cur.pm * tstepA; const char* cB = (const char*)g.Bt + (size_t)cur.pn * tstepB;
    S.a_ready(cur);
    if constexpr (SP2) {
        PG8_STAGE(PG8_SB(0, 0), cB, voffB); PG8_STAGE(PG8_SB(0, 1), cB + hstepB, voffB); PG8_STAGE(PG8_SA(0, 0), cA, voffA); PG8_STAGE(PG8_SA(0, 1), cA + hstepA, voffA);
        if (wr == 1) PG8_BAR;
        PG8_WAIT_V(2); PG8_BAR;
        PG8_STAGE(PG8_SB(1, 0), cB + kstep, voffB); PG8_STAGE(PG8_SA(1, 0), cA + kstep, voffA); PG8_STAGE(PG8_SB(1, 1), cB + hstepB + kstep, voffB);
        PG8_WAIT_V(6); PG8_BAR;
    } else {
        PG8_STAGE(PG8_SB(0, 0), cB, voffB); PG8_STAGE(PG8_SA(0, 0), cA, voffA); PG8_STAGE(PG8_SB(0, 1), cB + hstepB, voffB); PG8_STAGE(PG8_SA(0, 1), cA + hstepA, voffA);
        if (wr == 1) PG8_BAR;
        PG8_WAIT_V(4); PG8_BAR;
        PG8_STAGE(PG8_SB(1, 0), cB + kstep, voffB); PG8_STAGE(PG8_SA(1, 0), cA + kstep, voffA); PG8_STAGE(PG8_SB(1, 1), cB + hstepB + kstep, voffB);
        PG8_WAIT_V(6); PG8_BAR;
    }
    for (;;) {
        const bool has_next = S.next(ui + 1, nxt);
        const char* nA = has_next ? (const char*)g.A + (size_t)nxt.pm * tstepA : cA; const char* nB = has_next ? (const char*)g.Bt + (size_t)nxt.pn * tstepB : cB;
        for (int t = 0; t < nt; t += 2) {
            if constexpr (Epi::KHOOK) { if (t == Epi::KH1 || t == Epi::KH2) E.khook(acc, cur, t, wr, wc, fr, fq); }
            const bool last = (t == nt - 2);
            const char* a1 = cA + (size_t)(t + 1) * kstep;
            const char* a2 = last ? nA : cA + (size_t)(t + 2) * kstep; const char* b2 = last ? nB : cB + (size_t)(t + 2) * kstep;
            const char* a3 = a2 + kstep; const char* b3 = b2 + kstep;
            if (last && has_next) S.a_ready(nxt);
            if constexpr (SP2) {
            PG8_LDB(B0, 0, 0); PG8_LDB(B1, 0, 1); PG8_SCHED; PG8_LDA(At, 0, 0); PG8_STAGE(PG8_SA(1, 1), a1 + hstepA, voffA);
            PG8_WAIT_V(8); PG8_WAIT_L(0); PG8_BAR; PG8_MMA(0, 0, At, B0); PG8_MMA(0, 1, At, B1); PG8_BAR; PG8_SCHED;
            PG8_LDA(At, 0, 1); PG8_STAGE(PG8_SB(0, 0), b2, voffB); PG8_STAGE(PG8_SB(0, 1), b2 + hstepB, voffB); PG8_STAGE(PG8_SA(0, 0), a2, voffA);
            PG8_WAIT_V(8); PG8_WAIT_L(0); PG8_BAR; PG8_MMA(1, 0, At, B0); PG8_MMA(1, 1, At, B1); PG8_BAR; PG8_SCHED;
            PG8_LDB(B0, 1, 0); PG8_LDB(B1, 1, 1); PG8_SCHED; PG8_LDA(At, 1, 0); PG8_STAGE(PG8_SA(0, 1), a2 + hstepA, voffA);
            PG8_WAIT_V(8); PG8_WAIT_L(0); PG8_BAR; PG8_MMA(0, 0, At, B0); PG8_MMA(0, 1, At, B1); PG8_BAR; PG8_SCHED;
            PG8_LDA(At, 1, 1); PG8_STAGE(PG8_SB(1, 0), b3, voffB); PG8_STAGE(PG8_SB(1, 1), b3 + hstepB, voffB); PG8_STAGE(PG8_SA(1, 0), a3, voffA);
            PG8_WAIT_V(8); PG8_WAIT_L(0); PG8_BAR; PG8_MMA(1, 0, At, B0); PG8_MMA(1, 1, At, B1); PG8_BAR; PG8_SCHED;
            } else {
            PG8_LDB(B0, 0, 0); PG8_SCHED; PG8_LDA(At, 0, 0); PG8_STAGE(PG8_SA(1, 1), a1 + hstepA, voffA);
            PG8_WAIT_L(8); PG8_BAR; PG8_WAIT_L(0); PG8_MMA(0, 0, At, B0); PG8_BAR; PG8_SCHED;
            PG8_LDB(B1, 0, 1); PG8_STAGE(PG8_SB(0, 0), b2, voffB);
            PG8_BAR; PG8_WAIT_L(0); PG8_MMA(0, 1, At, B1); PG8_BAR;
            PG8_LDA(At, 0, 1); PG8_STAGE(PG8_SA(0, 0), a2, voffA);
            PG8_BAR; PG8_WAIT_L(0); PG8_MMA(1, 0, At, B0); PG8_BAR; PG8_SCHED;
            PG8_STAGE(PG8_SB(0, 1), b2 + hstepB, voffB);
            PG8_WAIT_V(6); PG8_BAR; PG8_MMA(1, 1, At, B1); PG8_BAR;
            PG8_LDB(B0, 1, 0); PG8_SCHED; PG8_LDA(At, 1, 0); PG8_STAGE(PG8_SA(0, 1), a2 + hstepA, voffA);
            PG8_WAIT_L(8); PG8_BAR; PG8_WAIT_L(0); PG8_MMA(0, 0, At, B0); PG8_BAR; PG8_SCHED;
            PG8_LDB(B1, 1, 1); PG8_STAGE(PG8_SB(1, 0), b3, voffB);
            PG8_BAR; PG8_WAIT_L(0); PG8_MMA(0, 1, At, B1); PG8_BAR;
            PG8_LDA(At, 1, 1); PG8_STAGE(PG8_SA(1, 0), a3, voffA);
            PG8_BAR; PG8_WAIT_L(0); PG8_MMA(1, 0, At, B0); PG8_BAR; PG8_SCHED;
            PG8_STAGE(PG8_SB(1, 1), b3 + hstepB, voffB);
            PG8_WAIT_V(6); PG8_BAR; PG8_MMA(1, 1, At, B1); PG8_BAR;
            }
        }
        if constexpr (ALIGN_EPI) { if (wr == 0) PG8_BAR; }
        if constexpr (!Epi::AFTER_DRAIN) { E(acc, cur, wr, wc, fr, fq); S.done(cur); }
        if (!has_next) break;
#pragma unroll
        for (int a = 0; a < 2; ++a)
#pragma unroll
            for (int b = 0; b < 2; ++b)
#pragma unroll
                for (int m = 0; m < 4; ++m)
#pragma unroll
                    for (int n = 0; n < 2; ++n) acc[a][b][m][n] = (f32x4){0.f, 0.f, 0.f, 0.f};
        cur = nxt; cA = nA; cB = nB; ++ui;
        if constexpr (ALIGN_EPI) { if (wr == 1) PG8_BAR; }
    }
    PG8_WAIT_V(0);
    if constexpr (!ALIGN_EPI) { if (wr == 0) PG8_BAR; }
    PG8_BAR;
    if constexpr (Epi::AFTER_DRAIN) { E.fused(acc, cur, wr, wc, fr, fq, lds, wid, lane); S.done(cur); }
#undef PG8_SA
#undef PG8_SB
#undef PG8_STAGE
#undef PG8_LDA
#undef PG8_LDB
#undef PG8_MMA
#undef PG8_WAIT_V
#undef PG8_WAIT_L
#undef PG8_BAR
#undef PG8_SCHED
}
}

#ifndef G1_EPI_DRAIN
#define G1_EPI_DRAIN 0
#endif
#ifndef G1_STORE_AUX
#define G1_STORE_AUX 2
#endif
namespace pg8 {
__device__ __forceinline__ float ex2(float x) { return __builtin_amdgcn_exp2f(x); }
__device__ __forceinline__ float sigm_fast(float x) { return __builtin_amdgcn_rcpf(1.0f + ex2(x * -1.4426950408889634f)); }
template <int MODE = 0  > struct EpiProjT {
    static constexpr bool PERM = true, AFTER_DRAIN = false, KHOOK = false;
    bf16_t* PA; bf16_t* KVM; float* SS; float* MKSS; const float* gate_b; int pm0; int pad;
    template <int KIND, int STAT> __device__ __forceinline__ void body(const f32x4 (&acc)[2][2][4][2], const __amdgpu_buffer_rsrc_t rsrc, int row0, int col0, int ldc, float* sb, int sld, int so, const float* bias, int wc, int fq) const {
        f32x4 bv[2][2];
        if (KIND == 3) {
#pragma unroll
            for (int bj = 0; bj < 2; ++bj)
#pragma unroll
                for (int n = 0; n < 2; ++n) bv[bj][n] = *(const f32x4*)(bias + bj * HALF + 4 * n);
        }
#pragma unroll
        for (int ai = 0; ai < 2; ++ai)
#pragma unroll
            for (int m = 0; m < 4; ++m) { const int row = row0 + ai * HALF + m * 16; const unsigned rowoff = ((unsigned)row * (unsigned)ldc + (unsigned)col0) * 2u;
#pragma unroll
                for (int bj = 0; bj < 2; ++bj) { f32x4 v0 = acc[ai][bj][m][0], v1 = acc[ai][bj][m][1];
                    if (KIND == 1) { f32x2 a = gelu_pk((f32x2){v0[0], v0[1]}), b = gelu_pk((f32x2){v0[2], v0[3]}), c = gelu_pk((f32x2){v1[0], v1[1]}), d = gelu_pk((f32x2){v1[2], v1[3]});
                        v0 = (f32x4){a.x, a.y, b.x, b.y}; v1 = (f32x4){c.x, c.y, d.x, d.y}; }
                    else if (KIND == 2) {
#pragma unroll
                        for (int j = 0; j < 4; ++j) { v0[j] = v0[j] * sigm_fast(v0[j]); v1[j] = v1[j] * sigm_fast(v1[j]); } }
                    else if (KIND == 3) { v0 = v0 + bv[bj][0]; v1 = v1 + bv[bj][1];
#pragma unroll
                        for (int j = 0; j < 4; ++j) { v0[j] = sigm_fast(v0[j]); v1[j] = sigm_fast(v1[j]); } }
                    if (STAT) {
                        float s = ((v0[0] + v0[1]) + (v0[2] + v0[3])) + ((v1[0] + v1[1]) + (v1[2] + v1[3]));
                        float q = ((v0[0] * v0[0] + v0[1] * v0[1]) + (v0[2] * v0[2] + v0[3] * v0[3])) + ((v1[0] * v1[0] + v1[1] * v1[1]) + (v1[2] * v1[2] + v1[3] * v1[3]));
                        if (STAT == 2) { s += __shfl_xor(s, 16); s += __shfl_xor(s, 32); }
                        q += __shfl_xor(q, 16); q += __shfl_xor(q, 32);
                        if (fq == 0) { float* sp = sb + (size_t)row * sld + so; const int blk = 4 * bj + wc;
                            if (STAT == 2) { sp[2 * blk] = s; sp[2 * blk + 1] = q; } else sp[blk] = q; }
                    }
                    u32x4 w; w.x = cvt_pk_bf16(v0[0], v0[1]); w.y = cvt_pk_bf16(v0[2], v0[3]); w.z = cvt_pk_bf16(v1[0], v1[1]); w.w = cvt_pk_bf16(v1[2], v1[3]);
                    if (MODE == 2) asm volatile("" :: "v"(w)); else __builtin_amdgcn_raw_buffer_store_b128(w, rsrc, (int)(rowoff + bj * HALF * 2), 0, G1_STORE_AUX); } }
    }
    __device__ __forceinline__ void operator()(const f32x4 (&acc)[2][2][4][2], const Unit& u, int wr, int wc, int fr, int fq) const {
        const bool kv = u.pn >= 35; const int pn = kv ? u.pn - 35 : u.pn;
        const int rowt = kv ? (u.pm - 256) * BM : (u.pm - pm0) * BM;
        bf16_t* base = kv ? KVM : PA; const int ldc = kv ? 1024 : NIN;
        const __amdgpu_buffer_rsrc_t rsrc = __builtin_amdgcn_make_buffer_rsrc(base, 0, kv ? (int)((size_t)MMEM * 1024 * 2) : (int)((size_t)HB_ROWS * NIN * 2), 0x00020000);
        const int row0 = rowt + wr * 64 + fr, col0 = pn * BM + wc * 32 + 8 * fq;
        if (MODE == 1) { body<0, 0>(acc, rsrc, row0, col0, ldc, SS, SS_W, 0, gate_b, wc, fq); return; }
        if (kv) { if (pn < 2) body<0, 1>(acc, rsrc, row0, col0, ldc, MKSS, 16, 8 * pn, gate_b, wc, fq); else body<0, 0>(acc, rsrc, row0, col0, ldc, SS, SS_W, 0, gate_b, wc, fq); }
        else if (pn < 3) body<1, 0>(acc, rsrc, row0, col0, ldc, SS, SS_W, 0, gate_b, wc, fq);
        else if (pn < 6) body<1, 2>(acc, rsrc, row0, col0, ldc, SS, SS_W, 16 * (pn - 3), gate_b, wc, fq);
        else if (pn < 9) body<2, 0>(acc, rsrc, row0, col0, ldc, SS, SS_W, 0, gate_b, wc, fq);
        else if (pn < 12) body<0, 1>(acc, rsrc, row0, col0, ldc, SS, SS_W, 48 + 8 * (pn - 9), gate_b, wc, fq);
        else if (pn < 15) body<0, 1>(acc, rsrc, row0, col0, ldc, SS, SS_W, 72 + 8 * (pn - 12), gate_b, wc, fq);
        else if (pn < 18) body<0, 0>(acc, rsrc, row0, col0, ldc, SS, SS_W, 0, gate_b, wc, fq);
        else if (pn < 19) body<2, 0>(acc, rsrc, row0, col0, ldc, SS, SS_W, 0, gate_b, wc, fq);
        else if (pn < 21) body<0, 1>(acc, rsrc, row0, col0, ldc, SS, SS_W, 96 + 8 * (pn - 19), gate_b, wc, fq);
        else if (pn < 23) body<2, 0>(acc, rsrc, row0, col0, ldc, SS, SS_W, 0, gate_b, wc, fq);
        else body<3, 0>(acc, rsrc, row0, col0, ldc, SS, SS_W, 0, gate_b + (col0 - 23 * BM), wc, fq);
#if G1_EPI_DRAIN
        asm volatile("s_waitcnt vmcnt(0)" ::: "memory");
#endif
    }
};
typedef EpiProjT<0> EpiProj;
struct EpiG2cat {
    static constexpr bool PERM = true, AFTER_DRAIN = false, KHOOK = true; static constexpr int KH1 = 12, KH2 = 16;
    const bf16_t* PA; bf16_t* MRG;
    __device__ __forceinline__ void khook(f32x4 (&acc)[2][2][4][2], const Unit& u, int t, int wr, int wc, int fr, int fq) const {
        const int ga = t == KH1 ? 0 : 1;
        const int row0 = u.pm * BM + wr * 64 + fr, col0 = u.pn * BM + wc * 32 + 8 * fq;
#pragma unroll
        for (int ai = 0; ai < 2; ++ai)
#pragma unroll
            for (int m = 0; m < 4; ++m) { const bf16_t* gp = PA + (size_t)(row0 + ai * HALF + m * 16) * NIN + C_G + ga * DM + col0;
#pragma unroll
                for (int bj = 0; bj < 2; ++bj) { const u32x4 a = *(const u32x4*)(gp + bj * HALF), b = *(const u32x4*)(gp + DM + bj * HALF);
                    f32x4 r0, r1;
                    r0[0] = __uint_as_float(a.x << 16) * __builtin_amdgcn_rcpf(__uint_as_float(b.x << 16)); r0[1] = __uint_as_float(a.x & 0xffff0000u) * __builtin_amdgcn_rcpf(__uint_as_float(b.x & 0xffff0000u));
                    r0[2] = __uint_as_float(a.y << 16) * __builtin_amdgcn_rcpf(__uint_as_float(b.y << 16)); r0[3] = __uint_as_float(a.y & 0xffff0000u) * __builtin_amdgcn_rcpf(__uint_as_float(b.y & 0xffff0000u));
                    r1[0] = __uint_as_float(a.z << 16) * __builtin_amdgcn_rcpf(__uint_as_float(b.z << 16)); r1[1] = __uint_as_float(a.z & 0xffff0000u) * __builtin_amdgcn_rcpf(__uint_as_float(b.z & 0xffff0000u));
                    r1[2] = __uint_as_float(a.w << 16) * __builtin_amdgcn_rcpf(__uint_as_float(b.w << 16)); r1[3] = __uint_as_float(a.w & 0xffff0000u) * __builtin_amdgcn_rcpf(__uint_as_float(b.w & 0xffff0000u));
                    acc[ai][bj][m][0] *= r0; acc[ai][bj][m][1] *= r1; }
                asm volatile("" ::: "memory"); }
    }
    __device__ __forceinline__ void operator()(const f32x4 (&acc)[2][2][4][2], const Unit& u, int wr, int wc, int fr, int fq) const {
        const int row0 = u.pm * BM + wr * 64 + fr, col0 = u.pn * BM + wc * 32 + 8 * fq;
#pragma unroll
        for (int ai = 0; ai < 2; ++ai)
#pragma unroll
            for (int m = 0; m < 4; ++m) { const size_t row = (size_t)(row0 + ai * HALF + m * 16); const bf16_t* gp = PA + row * NIN + C_G + 2 * DM + col0; bf16_t* mp = MRG + row * DM + col0;
#pragma unroll
                for (int bj = 0; bj < 2; ++bj) { const u32x4 g = *(const u32x4*)(gp + bj * HALF); const f32x4 v0 = acc[ai][bj][m][0], v1 = acc[ai][bj][m][1]; u32x4 w;
                    w.x = cvt_pk_bf16(v0[0] * __uint_as_float(g.x << 16), v0[1] * __uint_as_float(g.x & 0xffff0000u)); w.y = cvt_pk_bf16(v0[2] * __uint_as_float(g.y << 16), v0[3] * __uint_as_float(g.y & 0xffff0000u));
                    w.z = cvt_pk_bf16(v1[0] * __uint_as_float(g.z << 16), v1[1] * __uint_as_float(g.z & 0xffff0000u)); w.w = cvt_pk_bf16(v1[2] * __uint_as_float(g.w << 16), v1[3] * __uint_as_float(g.w & 0xffff0000u));
                    *(u32x4*)(mp + bj * HALF) = w; }
                asm volatile("" ::: "memory"); }
    }
};
struct EpiG3 {
    static constexpr bool PERM = false, AFTER_DRAIN = false, KHOOK = false;
    const float* x; float* out;
    __device__ __forceinline__ void operator()(const f32x4 (&acc)[2][2][4][2], const Unit& u, int wr, int wc, int fr, int fq) const {
        const int row0 = u.pm * BM + wr * 64 + fr, col0 = u.pn * BM + wc * 32 + 4 * fq;
#pragma unroll
        for (int ai = 0; ai < 2; ++ai)
#pragma unroll
            for (int m = 0; m < 4; ++m) { const size_t off = (size_t)(row0 + ai * HALF + m * 16) * DM + col0;
#pragma unroll
                for (int bj = 0; bj < 2; ++bj)
#pragma unroll
                    for (int n = 0; n < 2; ++n) *(f32x4*)(out + off + bj * HALF + n * 16) = *(const f32x4*)(x + off + bj * HALF + n * 16) + acc[ai][bj][m][n];
                asm volatile("" ::: "memory"); }
    }
};
struct EpiNull {
    static constexpr bool PERM = true, AFTER_DRAIN = false, KHOOK = false;
    __device__ __forceinline__ void operator()(const f32x4 (&acc)[2][2][4][2], const Unit& u, int wr, int wc, int fr, int fq) const {
#pragma unroll
        for (int ai = 0; ai < 2; ++ai)
#pragma unroll
            for (int bj = 0; bj < 2; ++bj)
#pragma unroll
                for (int m = 0; m < 4; ++m) asm volatile("" :: "v"(acc[ai][bj][m][0]), "v"(acc[ai][bj][m][1]));
    }
};
struct OrderG1 {
    StaticOrder so; int pm0, nkv;
    __device__ void init(int hb, int G, int c) { so.init(HB_ROWS, NIN, G, c); pm0 = hb * (HB_ROWS / BM); nkv = hb == 0 ? (MMEM / BM) * 4 : 0; }
    __device__ bool next(int i, Unit& u) const {
        if (so.next(i, u)) { u.pm += pm0; return true; }
        const long j = (long)i * so.G + so.c - so.nwg; if (j < 0 || j >= nkv) return false;
        u.pm = 256 + (int)(j >> 2); u.pn = 35 + (int)(j & 3); return true;
    }
    __device__ __forceinline__ void a_ready(const Unit&) const {}
    __device__ __forceinline__ void done(const Unit&) const {}
};
}

#define GAS __attribute__((address_space(1)))
#define LAS __attribute__((address_space(3)))
typedef unsigned short bf16;
typedef unsigned v4u __attribute__((ext_vector_type(4)));
typedef float f32x4 __attribute__((ext_vector_type(4)));
typedef short bf16x8 __attribute__((ext_vector_type(8)));
typedef GAS unsigned gu32;
typedef GAS unsigned long long gu64;
#define RLX_AGENT __ATOMIC_RELAXED, __HIP_MEMORY_SCOPE_AGENT
#define LDS_WAIT() asm volatile("s_waitcnt lgkmcnt(0)" ::: "memory")
#define VM_WAIT() asm volatile("s_waitcnt vmcnt(0)" ::: "memory")
__device__ __forceinline__ unsigned long long rt() { return __builtin_amdgcn_s_memrealtime(); }
__device__ __forceinline__ unsigned f2bf(float f) { unsigned u = __builtin_bit_cast(unsigned, f); return (u + 0x7fffu + ((u >> 16) & 1u)) >> 16; }
__device__ __forceinline__ unsigned pk2(float lo, float hi) { return f2bf(lo) | (f2bf(hi) << 16); }

__device__ __forceinline__ int hw_lane() { int l; asm volatile("v_mbcnt_lo_u32_b32 %0, -1, 0\n\tv_mbcnt_hi_u32_b32 %0, -1, %0" : "=v"(l)); return l; }
__device__ __forceinline__ bool hw_thread0(int wave) { return wave == 0 && hw_lane() == 0; }
#define XB_TMO      128
#define XB_XCNT(j)  (256  + 64 * (j))
#define XB_XSUB(j)  (1280 + 64 * (j))
#define XB_XGEN(j)  (2304 + 64 * (j))
#define XB_TOP      3328
#define XB_TOPGEN   3392
#define XCD_BAR_WORDS 3456
#define XB_SPIN_CAP (1u << 18)

__device__ __forceinline__ unsigned xb_ld(unsigned* p)              { return __hip_atomic_load(p, __ATOMIC_RELAXED, __HIP_MEMORY_SCOPE_AGENT); }
__device__ __forceinline__ unsigned xb_add(unsigned* p, unsigned v) { return __hip_atomic_fetch_add(p, v, __ATOMIC_RELAXED, __HIP_MEMORY_SCOPE_AGENT); }
__device__ __forceinline__ unsigned xb_xcc_id() { return (unsigned)__builtin_amdgcn_s_getreg((3 << 11) | 20) & 0xFu; }
#define XB_SPIN(cond, bar) do { unsigned _sp = 0; while (cond) { __builtin_amdgcn_s_sleep(1); \
    if ((++_sp & 255u) == 0u) { if (xb_ld(&(bar)[XB_TMO])) break; if (_sp > XB_SPIN_CAP) { atomicAdd(&(bar)[XB_TMO], 1u); break; } } } } while (0)

struct XcdBarrier {
    unsigned* bar; unsigned x; int wave;
    volatile LAS unsigned* st;
};

__device__ __forceinline__ XcdBarrier xcd_barrier_post(unsigned* bar, volatile LAS unsigned* st, int wave) {
    XcdBarrier b; b.bar = bar; b.x = xb_xcc_id(); b.st = st; b.wave = wave;
    if (hw_thread0(wave)) (void)xb_add(&bar[XB_XCNT(b.x)], 1u);
    return b;
}
__device__ __forceinline__ void xcd_barrier_complete(unsigned* bar, unsigned x, unsigned& nloc, unsigned& nx) {
    const unsigned G = gridDim.x * gridDim.y * gridDim.z;
    unsigned sum, cnt, mine, sp = 0u;
    for (;;) {
        sum = 0u; cnt = 0u; mine = 0u;
#pragma unroll
        for (unsigned j = 0; j < 16; ++j) { const unsigned c = xb_ld(&bar[XB_XCNT(j)]); sum += c; cnt += (c > 0u) ? 1u : 0u; mine = (j == x) ? c : mine; }
        if (sum == G) break;
        __builtin_amdgcn_s_sleep(1);
        if ((++sp & 255u) == 0u) { if (xb_ld(&bar[XB_TMO])) break; if (sp > XB_SPIN_CAP) { atomicAdd(&bar[XB_TMO], 1u); break; } }
    }
    nloc = mine > 0u ? mine : 1u; nx = cnt > 0u ? cnt : 1u;
}

__device__ __forceinline__ void xcd_barrier(const XcdBarrier& b) {
    asm volatile("s_waitcnt vmcnt(0)" ::: "memory");
    __syncthreads();
    if (hw_thread0(b.wave)) {
        unsigned* bar = b.bar;
        __builtin_amdgcn_s_waitcnt(0);
        unsigned nloc = b.st[0], nx = b.st[1];
        if (nloc == 0u) { xcd_barrier_complete(bar, b.x, nloc, nx); b.st[0] = nloc; b.st[1] = nx; }
        const unsigned old = xb_add(&bar[XB_XSUB(b.x)], 1u);
        const unsigned gen = old / nloc;
        if (old + 1u == (gen + 1u) * nloc) {
            __builtin_amdgcn_fence(__ATOMIC_RELEASE, "agent");
            asm volatile("s_waitcnt vmcnt(0)" ::: "memory");
            const unsigned og = xb_add(&bar[XB_TOP], 1u);
            const unsigned tg = og / nx;
            if (og + 1u == (tg + 1u) * nx) xb_add(&bar[XB_TOPGEN], 1u);
            else XB_SPIN(xb_ld(&bar[XB_TOPGEN]) == tg, bar);
            __builtin_amdgcn_fence(__ATOMIC_ACQUIRE, "agent");
            xb_add(&bar[XB_XGEN(b.x)], 1u);
            asm volatile("s_waitcnt vmcnt(0)" ::: "memory");
        } else {
            XB_SPIN(xb_ld(&bar[XB_XGEN(b.x)]) == gen, bar);
            __builtin_amdgcn_fence(__ATOMIC_ACQUIRE, "agent");
            asm volatile("s_waitcnt vmcnt(0)" ::: "memory");
        }
    }
    __syncthreads();
}

__device__ __forceinline__ float wave_sum(float v) {
#pragma unroll
    for (int o = 1; o < 64; o <<= 1) v += __shfl_xor(v, o);
    return v;
}

constexpr int RING_OFF = 0, RING_BYTES = 131072;
constexpr int LDSCTL_OFF = RING_BYTES, MISC_OFF = LDSCTL_OFF + 320;
constexpr int LDS_BYTES = 147456;
constexpr int NWAVES = 8, NTHR = NWAVES * 64;
constexpr int WSCR_OFF = 132096;

__device__ __forceinline__ float bf2f(bf16 h) { return __builtin_bit_cast(float, (unsigned)h << 16); }
__device__ __forceinline__ float sigm_f(float x) { return 1.f / (1.f + __expf(-x)); }
__device__ __forceinline__ int t5_bucket(int d) {
    if (d < 16) return d;
    int b = 16;
    b += d >= 22; b += d >= 30; b += d >= 40; b += d >= 54; b += d >= 73; b += d >= 99; b += d >= 134; b += d >= 182; b += d >= 246; b += d >= 332; b += d >= 450; b += d >= 609; b += d >= 825; b += d >= 1117; b += d >= 1513;
    return b;
}

struct Ctx {
    const float *x, *mem, *norm_w, *w_in, *gate_b, *lnw, *lnb, *sp_w, *sp_b, *bqw, *bkw, *rel_bias, *mem_norm_w, *m_w_kv, *mqw, *mkw, *proj_a, *proj_b, *proj_m, *w_out;
    float* out;
    bf16 *WIN, *PCAT, *WOUT, *WSP, *XN, *PA, *KVM, *OG, *YC, *MRG; float *BIAS, *BIASX, *SS, *MKSS, *LSE, *LNST;
    LAS unsigned char* lds; int tid, lane, wave, G, gtid, T, gwave, NW, xgwave;
};

__device__ __forceinline__ void p0_transpose_item(const float* W, int N, bf16* WT, int ldt, int row_off, int koff, LAS float* scr, int item, int lane) {
    const int nblk = N / 32, kb = item / nblk, nb = item % nblk, k0 = 64 * kb, n0 = 32 * nb;
#pragma unroll 8
    for (int i = 0; i < 32; ++i) { const int kk = 2 * i + (lane >> 5); scr[kk * 33 + (lane & 31)] = W[(size_t)(k0 + kk) * N + n0 + (lane & 31)]; }
    LDS_WAIT(); asm volatile("" ::: "memory");
    const int c = lane & 7;
#pragma unroll
    for (int j = 0; j < 4; ++j) { const int n = (lane >> 3) + 8 * j; const LAS float* s = scr + (8 * c) * 33 + n;
        v4u o; o.x = pk2(s[0 * 33], s[1 * 33]); o.y = pk2(s[2 * 33], s[3 * 33]); o.z = pk2(s[4 * 33], s[5 * 33]); o.w = pk2(s[6 * 33], s[7 * 33]);
        *(GAS v4u*)(WT + (size_t)(row_off + n0 + n) * ldt + koff + k0 + 8 * c) = o; }
    LDS_WAIT(); asm volatile("" ::: "memory");
}
__device__ __forceinline__ void rms_row_to_bf16(const float* xrow, const float* w, bf16* orow, int lane) {
    const GAS f32x4* xr = (const GAS f32x4*)xrow + lane; const GAS f32x4* wr = (const GAS f32x4*)w + lane;
    f32x4 v[4]; float s = 0.f;
#pragma unroll
    for (int j = 0; j < 4; ++j) { v[j] = xr[64 * j]; s += (v[j].x * v[j].x + v[j].y * v[j].y) + (v[j].z * v[j].z + v[j].w * v[j].w); }
    const float rs = rsqrtf(wave_sum(s) * (1.f / DM) + EPS);
    GAS unsigned long long* o8 = (GAS unsigned long long*)orow + lane;
#pragma unroll
    for (int j = 0; j < 4; ++j) { const f32x4 ww = wr[64 * j]; o8[64 * j] = (unsigned long long)pk2(v[j].x * rs * ww.x, v[j].y * rs * ww.y) | ((unsigned long long)pk2(v[j].z * rs * ww.z, v[j].w * rs * ww.w) << 32); }
}
__device__ __forceinline__ void p0_prologue(Ctx& F) {
    LAS float* scr = (LAS float*)(F.lds + RING_OFF + F.wave * 16384);
    constexpr int I_IN = 16 * (NIN / 32), I_KV = 16 * 32, I_PA = 12 * 32, I_PB = 4 * 32, I_PM = 8 * 32, I_WO = 16 * 32;
    constexpr int NITEMS = I_IN + I_KV + I_PA + I_PB + I_PM + I_WO;
    for (int it = F.gwave; it < NITEMS; it += F.NW) {
        int r = it;
        if (r < I_IN) { p0_transpose_item(F.w_in, NIN, F.WIN, DM, 0, 0, scr, r, F.lane); continue; } r -= I_IN;
        if (r < I_KV) { p0_transpose_item(F.m_w_kv, 1024, F.WIN, DM, NIN, 0, scr, r, F.lane); continue; } r -= I_KV;
        if (r < I_PA) { p0_transpose_item(F.proj_a, DM, F.PCAT, KC, 0, 0, scr, r, F.lane); continue; } r -= I_PA;
        if (r < I_PB) { p0_transpose_item(F.proj_b, DM, F.PCAT, KC, 0, 768, scr, r, F.lane); continue; } r -= I_PB;
        if (r < I_PM) { p0_transpose_item(F.proj_m, DM, F.PCAT, KC, 0, 1024, scr, r, F.lane); continue; } r -= I_PM;
        p0_transpose_item(F.w_out, DM, F.WOUT, DM, 0, 0, scr, r, F.lane);
    }
    for (int i = F.gtid; i < 4 * 128 * 128; i += F.T) { const int t = (i >> 7) & 127, s = i & 127; F.WSP[i] = (bf16)(s <= t ? f2bf(F.sp_w[i]) : 0u); }
    for (int i = F.gtid; i < 3 * 4 * 132; i += F.T) { const int g = i / (4 * 132), h = (i / 132) % 4, j = i % 132; const int dil = g == 0 ? 1 : (g == 1 ? 4 : 16);
        F.BIAS[i] = j <= 128 ? F.rel_bias[t5_bucket(j * dil) * 12 + 4 * g + h] : 0.f; }
    for (int i = F.gtid; i < 3 * 4 * 192; i += F.T) { const int g = i / (4 * 192), h = (i / 192) % 4, step = i % 192 - 31; const int dil = g == 0 ? 1 : (g == 1 ? 4 : 16);
        F.BIASX[i] = (step >= 0 && step <= 128) ? F.rel_bias[t5_bucket(step * dil) * 12 + 4 * g + h] * 1.4426950408889634f : -1e30f; }
    for (int m = F.gwave; m < MTOT + MMEM; m += F.NW) {
        if (m < MTOT) rms_row_to_bf16(F.x + (size_t)m * DM, F.norm_w, F.XN + (size_t)m * DM, F.lane);
        else rms_row_to_bf16(F.mem + (size_t)(m - MTOT) * DM, F.mem_norm_w, F.XN + (size_t)m * DM, F.lane);
    }
}

__device__ __forceinline__ void st_lnstat(Ctx& F) {
    for (int r = F.gtid; r < HB_ROWS; r += F.T) {
        float s = 0.f, q = 0.f; for (int b = 0; b < 24; ++b) { s += F.SS[(size_t)r * SS_W + 2 * b]; q += F.SS[(size_t)r * SS_W + 2 * b + 1]; }
        const float mu = s * (1.f / 768.f), var = q * (1.f / 768.f) - mu * mu;
        F.LNST[2 * r] = mu; F.LNST[2 * r + 1] = rsqrtf(fmaxf(var, 0.f) + EPS); }
}
__device__ __forceinline__ void st_mixA(Ctx& F) {
    for (size_t gid = F.gtid; gid < (size_t)HB_ROWS * 768; gid += F.T) {
        const int r = (int)(gid / 768), c = (int)(gid % 768), g = c / 192, t = r & 127, r0 = r - t;
        float acc = 0.f;
        for (int s = 0; s <= t; ++s) { const float gv = bf2f(F.PA[(size_t)(r0 + s) * NIN + C_AV + c]);
            const float vv = (gv - F.LNST[2 * (r0 + s)]) * F.LNST[2 * (r0 + s) + 1] * F.lnw[c] + F.lnb[c];
            acc += bf2f(F.WSP[(g * 128 + t) * 128 + s]) * vv; }
        acc += F.sp_b[g * 128 + t];
        const float u = bf2f(F.PA[(size_t)r * NIN + C_AU + c]), z = bf2f(F.PA[(size_t)r * NIN + C_AZ + c]);
        F.YC[(size_t)r * KC + c] = (bf16)f2bf(u * acc * z); }
}
__device__ __forceinline__ void st_attnB(Ctx& F) {
    const int lane = F.lane;
    for (int w = F.gwave; w < 3 * HB_ROWS * 4; w += F.NW) {
        const int g = w / (HB_ROWS * 4), r = (w / 4) % HB_ROWS, h = w % 4, hh = 4 * g + h, dil = g == 0 ? 1 : (g == 1 ? 4 : 16), t = r % SEQ;
        const float qs = rsqrtf((F.SS[(size_t)r * SS_W + 48 + 2 * hh] + F.SS[(size_t)r * SS_W + 48 + 2 * hh + 1]) * (1.f / 64.f) + EPS);
        const float q = bf2f(F.PA[(size_t)r * NIN + C_BQ + hh * 64 + lane]) * qs * F.bqw[lane] * F.bkw[lane] * 0.125f;
        float m = -1e30f, l = 0.f, o = 0.f;
        for (int j = 0; j <= 128; ++j) { if (t - j * dil < 0) break; const int kr = r - j * dil;
            const float ks = rsqrtf((F.SS[(size_t)kr * SS_W + 72 + 2 * hh] + F.SS[(size_t)kr * SS_W + 72 + 2 * hh + 1]) * (1.f / 64.f) + EPS);
            const float s = wave_sum(q * bf2f(F.PA[(size_t)kr * NIN + C_BK + hh * 64 + lane])) * ks + F.BIAS[(g * 4 + h) * 132 + j];
            const float mn = fmaxf(m, s), a = __expf(m - mn), p = __expf(s - mn);
            l = l * a + p; o = o * a + p * bf2f(F.PA[(size_t)kr * NIN + C_BV + hh * 64 + lane]); m = mn; }
        F.OG[((size_t)g * HB_ROWS + r) * 256 + h * 64 + lane] = (bf16)f2bf(o / l);
        if (lane == 0) F.LSE[((size_t)g * HB_ROWS + r) * 4 + h] = m + __logf(l); }
}
__device__ __forceinline__ void st_mergeB(Ctx& F) {
    for (size_t gid = F.gtid; gid < (size_t)HB_ROWS * 256; gid += F.T) {
        const int r = (int)(gid / 256), c = (int)(gid % 256), h = c / 64;
        const float l0 = F.LSE[((size_t)0 * HB_ROWS + r) * 4 + h], l1 = F.LSE[((size_t)1 * HB_ROWS + r) * 4 + h], l2 = F.LSE[((size_t)2 * HB_ROWS + r) * 4 + h];
        const float mx = fmaxf(l0, fmaxf(l1, l2)), e0 = __expf(l0 - mx), e1 = __expf(l1 - mx), e2 = __expf(l2 - mx), inv = 1.f / (e0 + e1 + e2);
        const float y = (e0 * bf2f(F.OG[((size_t)0 * HB_ROWS + r) * 256 + c]) + e1 * bf2f(F.OG[((size_t)1 * HB_ROWS + r) * 256 + c]) + e2 * bf2f(F.OG[((size_t)2 * HB_ROWS + r) * 256 + c])) * inv;
        F.YC[(size_t)r * KC + 768 + c] = (bf16)f2bf(y * bf2f(F.PA[(size_t)r * NIN + C_BZ + c])); }
}
__device__ __forceinline__ void st_attnM(Ctx& F, int row_base) {
    const int lane = F.lane;
    for (int w = F.gwave; w < HB_ROWS * 4; w += F.NW) {
        const int r = w / 4, h = w % 4, b = (row_base + r) / SEQ;
        float qq = 0.f; for (int i = 0; i < 4; ++i) qq += F.SS[(size_t)r * SS_W + 96 + 4 * h + i];
        const float qs = rsqrtf(qq * (1.f / 128.f) + EPS) * 0.08838834764831845f;
        const float q0 = bf2f(F.PA[(size_t)r * NIN + C_MQ + h * 128 + lane]) * qs * F.mqw[lane] * F.mkw[lane], q1 = bf2f(F.PA[(size_t)r * NIN + C_MQ + h * 128 + 64 + lane]) * qs * F.mqw[64 + lane] * F.mkw[64 + lane];
        float m = -1e30f, l = 0.f, o0 = 0.f, o1 = 0.f;
        for (int j = 0; j < MEML; ++j) { const size_t kr = (size_t)b * MEML + j;
            float kk = 0.f; for (int i = 0; i < 4; ++i) kk += F.MKSS[kr * 16 + 4 * h + i];
            const float ks = rsqrtf(kk * (1.f / 128.f) + EPS);
            const float s = wave_sum(q0 * bf2f(F.KVM[kr * 1024 + h * 128 + lane]) + q1 * bf2f(F.KVM[kr * 1024 + h * 128 + 64 + lane])) * ks;
            const float mn = fmaxf(m, s), a = __expf(m - mn), p = __expf(s - mn);
            l = l * a + p; o0 = o0 * a + p * bf2f(F.KVM[kr * 1024 + 512 + h * 128 + lane]); o1 = o1 * a + p * bf2f(F.KVM[kr * 1024 + 512 + h * 128 + 64 + lane]); m = mn; }
        F.YC[(size_t)r * KC + 1024 + h * 128 + lane] = (bf16)f2bf(o0 / l * bf2f(F.PA[(size_t)r * NIN + C_MZ + h * 128 + lane]));
        F.YC[(size_t)r * KC + 1024 + h * 128 + 64 + lane] = (bf16)f2bf(o1 / l * bf2f(F.PA[(size_t)r * NIN + C_MZ + h * 128 + 64 + lane])); }
}

typedef float f32x16 __attribute__((ext_vector_type(16)));
typedef short s16x4 __attribute__((ext_vector_type(4)));
__device__ __forceinline__ int crow(int r, int hi) { return (r & 3) + 8 * (r >> 2) + 4 * hi; }
__device__ __forceinline__ unsigned cvtpk(float lo, float hi) { return pg8::cvt_pk_bf16(lo, hi); }
__device__ __forceinline__ s16x4 vtr(const LAS unsigned char* p) { typedef short v4i16_t __attribute__((ext_vector_type(4))); return __builtin_bit_cast(s16x4, __builtin_amdgcn_ds_read_tr16_b64_v4i16((LAS v4i16_t*)p)); }
__device__ __forceinline__ float bflo(unsigned w) { return __uint_as_float(w << 16); }
__device__ __forceinline__ float bfhi(unsigned w) { return __uint_as_float(w & 0xffff0000u); }
constexpr float LOG2E = 1.4426950408889634f, LN2 = 0.6931471805599453f;
constexpr int NBX = 192;

__device__ __forceinline__ void st_attnB_mfma(Ctx& F) {
    const int lane = hw_lane(), r32 = lane & 31, hi = lane >> 5;
    LAS unsigned char* wl = F.lds + RING_OFF + F.wave * 16384;
    LAS float* btab = (LAS float*)(wl + 8192); LAS float* kst = (LAS float*)(wl + 9216);
    for (int it = F.xgwave; it < 3 * 16 * 4 * 64; it += F.NW) {
        const int blk = it & 63, h = (it >> 6) & 3, gb = it >> 8, b = gb & 15, g = gb >> 4, hh = 4 * g + h;
        const int dil = g == 0 ? 1 : (g == 1 ? 4 : 16), nqb = 64 / dil, res = blk / nqb, q0 = (blk % nqb) * 32;
        const int rbase = b * SEQ + res;
        for (int i = lane; i < NBX; i += 64) btab[i] = F.BIASX[(g * 4 + h) * NBX + i];
        const size_t qrow = (size_t)(rbase + (q0 + r32) * dil);
        const float qs = rsqrtf((F.SS[qrow * SS_W + 48 + 2 * hh] + F.SS[qrow * SS_W + 48 + 2 * hh + 1]) * (1.f / 64.f) + EPS) * (0.125f * LOG2E);
        bf16x8 qf[4];
#pragma unroll
        for (int d0 = 0; d0 < 4; ++d0) { const int dd = 16 * d0 + 8 * hi;
            const v4u raw = *(const v4u*)(F.PA + qrow * NIN + C_BQ + hh * 64 + dd);
            const f32x4 wa = *(const f32x4*)(F.bqw + dd), wb = *(const f32x4*)(F.bqw + dd + 4), ka = *(const f32x4*)(F.bkw + dd), kb = *(const f32x4*)(F.bkw + dd + 4);
            v4u o;
            o.x = cvtpk(bflo(raw.x) * qs * wa.x * ka.x, bfhi(raw.x) * qs * wa.y * ka.y); o.y = cvtpk(bflo(raw.y) * qs * wa.z * ka.z, bfhi(raw.y) * qs * wa.w * ka.w);
            o.z = cvtpk(bflo(raw.z) * qs * wb.x * kb.x, bfhi(raw.z) * qs * wb.y * kb.y); o.w = cvtpk(bflo(raw.w) * qs * wb.z * kb.z, bfhi(raw.w) * qs * wb.w * kb.w);
            qf[d0] = __builtin_bit_cast(bf16x8, o); }
        float mrun = -1e30f, lrun = 0.f; f32x16 o0 = {}, o1 = {};
        for (int k0 = (q0 >= 128 ? q0 - 128 : 0); k0 <= q0; k0 += 32) {
            const size_t krow = (size_t)(rbase + (k0 + r32) * dil);
            bf16x8 kf[4];
#pragma unroll
            for (int d0 = 0; d0 < 4; ++d0) kf[d0] = *(const bf16x8*)(F.PA + krow * NIN + C_BK + hh * 64 + 16 * d0 + 8 * hi);
            const float ksv = rsqrtf((F.SS[krow * SS_W + 72 + 2 * hh] + F.SS[krow * SS_W + 72 + 2 * hh + 1]) * (1.f / 64.f) + EPS);
            v4u vr[4];
#pragma unroll
            for (int i = 0; i < 4; ++i) vr[i] = *(const v4u*)(F.PA + (size_t)(rbase + (k0 + 8 * i + (lane >> 3)) * dil) * NIN + C_BV + hh * 64 + 8 * (lane & 7));
#pragma unroll
            for (int i = 0; i < 4; ++i) *(LAS v4u*)(wl + (2 * i + ((lane & 7) >> 2)) * 512 + (lane >> 3) * 64 + (lane & 3) * 16) = vr[i];
            if (lane < 32) kst[r32] = ksv;
            f32x16 st = {};
#pragma unroll
            for (int d0 = 0; d0 < 4; ++d0) st = __builtin_amdgcn_mfma_f32_32x32x16_bf16(kf[d0], qf[d0], st, 0, 0, 0);
            const int bidx = (q0 + r32) - k0 + 31 - 4 * hi;
            float tmax = -1e30f;
#pragma unroll
            for (int i = 0; i < 4; ++i) { const f32x4 kk = *(const LAS f32x4*)(kst + 8 * i + 4 * hi);
#pragma unroll
                for (int j = 0; j < 4; ++j) { const float s = st[4 * i + j] * kk[j] + btab[bidx - 8 * i - j]; st[4 * i + j] = s; tmax = fmaxf(tmax, s); } }
            tmax = fmaxf(tmax, __shfl_xor(tmax, 32));
            const float mnew = fmaxf(mrun, tmax), alpha = __builtin_amdgcn_exp2f(mrun - mnew); mrun = mnew;
            float psum = 0.f;
#pragma unroll
            for (int r = 0; r < 16; ++r) { st[r] = __builtin_amdgcn_exp2f(st[r] - mnew); psum += st[r]; }
            lrun = lrun * alpha + psum;
#pragma unroll
            for (int r = 0; r < 16; ++r) { o0[r] *= alpha; o1[r] *= alpha; }
            v4u p0, p1;
            p0.x = cvtpk(st[0], st[1]); p0.y = cvtpk(st[2], st[3]); p0.z = cvtpk(st[4], st[5]); p0.w = cvtpk(st[6], st[7]);
            p1.x = cvtpk(st[8], st[9]); p1.y = cvtpk(st[10], st[11]); p1.z = cvtpk(st[12], st[13]); p1.w = cvtpk(st[14], st[15]);
            const LAS unsigned char* vb = wl + (4 * hi + ((lane & 15) >> 2)) * 64 + ((lane >> 4) & 1) * 32 + (lane & 3) * 8;
#pragma unroll
            for (int s = 0; s < 2; ++s) { const bf16x8 pf = __builtin_bit_cast(bf16x8, s == 0 ? p0 : p1);
                { const s16x4 a = vtr(vb + (2 * s) * 1024), c = vtr(vb + (2 * s + 1) * 1024); const bf16x8 vf = {a[0], a[1], a[2], a[3], c[0], c[1], c[2], c[3]};
                  o0 = __builtin_amdgcn_mfma_f32_32x32x16_bf16(vf, pf, o0, 0, 0, 0); }
                { const s16x4 a = vtr(vb + (2 * s) * 1024 + 512), c = vtr(vb + (2 * s + 1) * 1024 + 512); const bf16x8 vf = {a[0], a[1], a[2], a[3], c[0], c[1], c[2], c[3]};
                  o1 = __builtin_amdgcn_mfma_f32_32x32x16_bf16(vf, pf, o1, 0, 0, 0); } }
        }
        const float ltot = lrun + __shfl_xor(lrun, 32), inv = 1.f / ltot;
        bf16* orow = F.OG + ((size_t)g * HB_ROWS + qrow) * 256 + h * 64 + 4 * hi;
        typedef unsigned u32x2v __attribute__((ext_vector_type(2)));
#pragma unroll
        for (int i = 0; i < 4; ++i) { u32x2v w0, w1; w0.x = cvtpk(o0[4 * i] * inv, o0[4 * i + 1] * inv); w0.y = cvtpk(o0[4 * i + 2] * inv, o0[4 * i + 3] * inv);
            w1.x = cvtpk(o1[4 * i] * inv, o1[4 * i + 1] * inv); w1.y = cvtpk(o1[4 * i + 2] * inv, o1[4 * i + 3] * inv);
            *(u32x2v*)(orow + 8 * i) = w0; *(u32x2v*)(orow + 32 + 8 * i) = w1; }
        if (hi == 0) F.LSE[((size_t)g * HB_ROWS + qrow) * 4 + h] = (mrun + __log2f(ltot)) * LN2;
    }
}

__device__ __forceinline__ void st_attnM_mfma(Ctx& F, int hb) {
    const int lane = hw_lane(), r32 = lane & 31, hi = lane >> 5;
    LAS unsigned char* wl = F.lds + RING_OFF + F.wave * 16384;
    LAS float* kst = (LAS float*)(wl + 9216);
    typedef unsigned u32x2v __attribute__((ext_vector_type(2)));
    for (int it = F.xgwave; it < 16 * 64 * 4; it += F.NW) {
        const int h = it & 3, qb = (it >> 2) & 63, b = it >> 8;
        const size_t qrow = (size_t)(b * SEQ + qb * 32 + r32); const size_t kbase = (size_t)(hb * 16 + b) * MEML;
        const float qs = rsqrtf(((F.SS[qrow * SS_W + 96 + 4 * h] + F.SS[qrow * SS_W + 96 + 4 * h + 1]) + (F.SS[qrow * SS_W + 96 + 4 * h + 2] + F.SS[qrow * SS_W + 96 + 4 * h + 3])) * (1.f / 128.f) + EPS) * (0.08838834764831845f * LOG2E);
        bf16x8 qf[8];
#pragma unroll
        for (int d0 = 0; d0 < 8; ++d0) { const int dd = 16 * d0 + 8 * hi;
            const v4u raw = *(const v4u*)(F.PA + qrow * NIN + C_MQ + h * 128 + dd);
            const f32x4 wa = *(const f32x4*)(F.mqw + dd), wb = *(const f32x4*)(F.mqw + dd + 4), ka = *(const f32x4*)(F.mkw + dd), kb = *(const f32x4*)(F.mkw + dd + 4);
            v4u o;
            o.x = cvtpk(bflo(raw.x) * qs * wa.x * ka.x, bfhi(raw.x) * qs * wa.y * ka.y); o.y = cvtpk(bflo(raw.y) * qs * wa.z * ka.z, bfhi(raw.y) * qs * wa.w * ka.w);
            o.z = cvtpk(bflo(raw.z) * qs * wb.x * kb.x, bfhi(raw.z) * qs * wb.y * kb.y); o.w = cvtpk(bflo(raw.w) * qs * wb.z * kb.z, bfhi(raw.w) * qs * wb.w * kb.w);
            qf[d0] = __builtin_bit_cast(bf16x8, o); }
        float mrun = -1e30f, lrun = 0.f; f32x16 o0 = {}, o1 = {}, o2 = {}, o3 = {};
        for (int k0 = 0; k0 < MEML; k0 += 32) {
            const size_t krow = kbase + k0 + r32;
            bf16x8 kf[8];
#pragma unroll
            for (int d0 = 0; d0 < 8; ++d0) kf[d0] = *(const bf16x8*)(F.KVM + krow * 1024 + h * 128 + 16 * d0 + 8 * hi);
            const float ksv = rsqrtf(((F.MKSS[krow * 16 + 4 * h] + F.MKSS[krow * 16 + 4 * h + 1]) + (F.MKSS[krow * 16 + 4 * h + 2] + F.MKSS[krow * 16 + 4 * h + 3])) * (1.f / 128.f) + EPS);
#pragma unroll
            for (int i = 0; i < 8; ++i) { const v4u vr = *(const v4u*)(F.KVM + (kbase + k0 + 4 * i + (lane >> 4)) * 1024 + 512 + h * 128 + 8 * (lane & 15));
                *(LAS v4u*)(wl + ((i >> 1) * 4 + ((lane & 15) >> 2)) * 512 + (4 * (i & 1) + (lane >> 4)) * 64 + (lane & 3) * 16) = vr; }
            if (lane < 32) kst[r32] = ksv;
            f32x16 st = {};
#pragma unroll
            for (int d0 = 0; d0 < 8; ++d0) st = __builtin_amdgcn_mfma_f32_32x32x16_bf16(kf[d0], qf[d0], st, 0, 0, 0);
            float tmax = -1e30f;
#pragma unroll
            for (int i = 0; i < 4; ++i) { const f32x4 kk = *(const LAS f32x4*)(kst + 8 * i + 4 * hi);
#pragma unroll
                for (int j = 0; j < 4; ++j) { const float s = st[4 * i + j] * kk[j]; st[4 * i + j] = s; tmax = fmaxf(tmax, s); } }
            tmax = fmaxf(tmax, __shfl_xor(tmax, 32));
            const float mnew = fmaxf(mrun, tmax), alpha = __builtin_amdgcn_exp2f(mrun - mnew); mrun = mnew;
            float psum = 0.f;
#pragma unroll
            for (int r = 0; r < 16; ++r) { st[r] = __builtin_amdgcn_exp2f(st[r] - mnew); psum += st[r]; }
            lrun = lrun * alpha + psum;
#pragma unroll
            for (int r = 0; r < 16; ++r) { o0[r] *= alpha; o1[r] *= alpha; o2[r] *= alpha; o3[r] *= alpha; }
            v4u p0, p1;
            p0.x = cvtpk(st[0], st[1]); p0.y = cvtpk(st[2], st[3]); p0.z = cvtpk(st[4], st[5]); p0.w = cvtpk(st[6], st[7]);
            p1.x = cvtpk(st[8], st[9]); p1.y = cvtpk(st[10], st[11]); p1.z = cvtpk(st[12], st[13]); p1.w = cvtpk(st[14], st[15]);
            const LAS unsigned char* vb = wl + (4 * hi + ((lane & 15) >> 2)) * 64 + ((lane >> 4) & 1) * 32 + (lane & 3) * 8;
#define AM_PV(OX, DB) do { _Pragma("unroll") for (int s = 0; s < 2; ++s) { const bf16x8 pf = __builtin_bit_cast(bf16x8, s == 0 ? p0 : p1); \
                const s16x4 a = vtr(vb + (2 * s) * 2048 + (DB) * 512), c = vtr(vb + (2 * s + 1) * 2048 + (DB) * 512); const bf16x8 vf = {a[0], a[1], a[2], a[3], c[0], c[1], c[2], c[3]}; \
                OX = __builtin_amdgcn_mfma_f32_32x32x16_bf16(vf, pf, OX, 0, 0, 0); } } while (0)
            AM_PV(o0, 0); AM_PV(o1, 1); AM_PV(o2, 2); AM_PV(o3, 3);
#undef AM_PV
        }
        const float ltot = lrun + __shfl_xor(lrun, 32), inv = 1.f / ltot;
        const bf16* zrow = F.PA + qrow * NIN + C_MZ + h * 128 + 4 * hi; bf16* yrow = F.YC + qrow * KC + 1024 + h * 128 + 4 * hi;
#define AM_ST(OX, DB) do { _Pragma("unroll") for (int i = 0; i < 4; ++i) { const u32x2v z = *(const u32x2v*)(zrow + (DB) * 32 + 8 * i); u32x2v w; \
            w.x = cvtpk(OX[4 * i] * inv * bflo(z.x), OX[4 * i + 1] * inv * bfhi(z.x)); w.y = cvtpk(OX[4 * i + 2] * inv * bflo(z.y), OX[4 * i + 3] * inv * bfhi(z.y)); \
            *(u32x2v*)(yrow + (DB) * 32 + 8 * i) = w; } } while (0)
        AM_ST(o0, 0); AM_ST(o1, 1); AM_ST(o2, 2); AM_ST(o3, 3);
#undef AM_ST
    }
}

__device__ __forceinline__ void st_mixA_mfma(Ctx& F) {
    const int lane = hw_lane(), r32 = lane & 31, hi = lane >> 5, tid = F.wave * 64 + lane;
    LAS unsigned char* wl = F.lds + RING_OFF + F.wave * 16384;
    typedef float f32x2v __attribute__((ext_vector_type(2))); typedef unsigned u32x2v __attribute__((ext_vector_type(2)));
    LAS f32x2v* tab = (LAS f32x2v*)(F.lds + WSCR_OFF + 8192);
    const int g = F.wave >> 1, ch = lane & 3;
    bf16x8 wf[20];
    { const bf16* wrow = F.WSP + (size_t)(g * 128 + r32) * 128 + 8 * hi; int n = 0;
#pragma unroll
      for (int tb = 0; tb < 4; ++tb)
#pragma unroll
          for (int ks = 0; ks < 2 * (tb + 1); ++ks) wf[n++] = *(const bf16x8*)(wrow + (size_t)tb * 32 * 128 + 16 * ks); }
    for (int unit = blockIdx.x; unit < HB_ROWS / 128; unit += F.G) {
        const int rowbase = unit * 128;
        { const int row = tid >> 2, part = tid & 3; const float* sp = F.SS + (size_t)(rowbase + row) * SS_W + 12 * part; float s = 0.f, q = 0.f;
#pragma unroll
          for (int k = 0; k < 6; ++k) { s += sp[2 * k]; q += sp[2 * k + 1]; }
          s += __shfl_xor(s, 1); s += __shfl_xor(s, 2); q += __shfl_xor(q, 1); q += __shfl_xor(q, 2);
          const float mu = s * (1.f / 768.f), var = q * (1.f / 768.f) - mu * mu;
          if (part == 0) tab[row] = (f32x2v){mu, rsqrtf(fmaxf(var, 0.f) + EPS)}; }
        __syncthreads();
#pragma unroll 1
        for (int cbi = 0; cbi < 3; ++cbi) {
            const int c0 = g * 192 + ((F.wave & 1) * 3 + cbi) * 32;
            v4u raw[8];
#pragma unroll
            for (int i = 0; i < 8; ++i) raw[i] = *(const v4u*)(F.PA + (size_t)(rowbase + (lane >> 2) + 16 * i) * NIN + C_AV + c0 + 8 * ch);
            const f32x4 w0 = *(const f32x4*)(F.lnw + c0 + 8 * ch), w1 = *(const f32x4*)(F.lnw + c0 + 8 * ch + 4), b0 = *(const f32x4*)(F.lnb + c0 + 8 * ch), b1 = *(const f32x4*)(F.lnb + c0 + 8 * ch + 4);
#pragma unroll
            for (int i = 0; i < 8; ++i) { const int s = (lane >> 2) + 16 * i; const f32x2v st = tab[s]; const v4u rw = raw[i]; v4u o;
                o.x = cvtpk((bflo(rw.x) - st.x) * st.y * w0.x + b0.x, (bfhi(rw.x) - st.x) * st.y * w0.y + b0.y); o.y = cvtpk((bflo(rw.y) - st.x) * st.y * w0.z + b0.z, (bfhi(rw.y) - st.x) * st.y * w0.w + b0.w);
                o.z = cvtpk((bflo(rw.z) - st.x) * st.y * w1.x + b1.x, (bfhi(rw.z) - st.x) * st.y * w1.y + b1.y); o.w = cvtpk((bflo(rw.w) - st.x) * st.y * w1.z + b1.z, (bfhi(rw.w) - st.x) * st.y * w1.w + b1.w);
                *(LAS v4u*)(wl + (s >> 3) * 512 + (s & 7) * 64 + ch * 16) = o; }
            u32x2v uu[1][4], zz[1][4];
#define MA_LDUZ(TB) do { const size_t row_ = (size_t)(rowbase + 32 * (TB) + r32); _Pragma("unroll") for (int i = 0; i < 4; ++i) { \
                uu[0][i] = *(const u32x2v*)(F.PA + row_ * NIN + C_AU + c0 + 4 * hi + 8 * i); zz[0][i] = *(const u32x2v*)(F.PA + row_ * NIN + C_AZ + c0 + 4 * hi + 8 * i); } } while (0)
            const LAS unsigned char* vb = wl + hi * 512 + ((lane & 15) >> 2) * 64 + ((lane >> 4) & 1) * 32 + (lane & 3) * 8;
            int n = 0;
#pragma unroll
            for (int tb = 0; tb < 4; ++tb) { f32x16 acc = {};
                MA_LDUZ(tb);
#pragma unroll
                for (int ks = 0; ks < 2 * (tb + 1); ++ks) { const s16x4 a = vtr(vb + ks * 1024), c = vtr(vb + ks * 1024 + 256); const bf16x8 af = {a[0], a[1], a[2], a[3], c[0], c[1], c[2], c[3]};
                    acc = __builtin_amdgcn_mfma_f32_32x32x16_bf16(af, wf[n++], acc, 0, 0, 0); }
                const int t = 32 * tb + r32; const size_t row = (size_t)(rowbase + t); const float sb = F.sp_b[g * 128 + t];
                bf16* yp = F.YC + row * KC + c0 + 4 * hi;
#pragma unroll
                for (int i = 0; i < 4; ++i) { const u32x2v u = uu[0][i], z = zz[0][i]; u32x2v w;
                    w.x = cvtpk(bflo(u.x) * (acc[4 * i] + sb) * bflo(z.x), bfhi(u.x) * (acc[4 * i + 1] + sb) * bfhi(z.x)); w.y = cvtpk(bflo(u.y) * (acc[4 * i + 2] + sb) * bflo(z.y), bfhi(u.y) * (acc[4 * i + 3] + sb) * bfhi(z.y));
                    *(u32x2v*)(yp + 8 * i) = w; } }
#undef MA_LDUZ
        }
        __syncthreads();
    }
}

__device__ __forceinline__ void st_mergeB_vec(Ctx& F) {
    for (int gid = F.gtid; gid < HB_ROWS * 32; gid += F.T) {
        const int r = gid >> 5, c8 = (gid & 31) * 8, h = c8 >> 6;
        const float l0 = F.LSE[((size_t)0 * HB_ROWS + r) * 4 + h], l1 = F.LSE[((size_t)1 * HB_ROWS + r) * 4 + h], l2 = F.LSE[((size_t)2 * HB_ROWS + r) * 4 + h];
        const float mx = fmaxf(l0, fmaxf(l1, l2)); float e0 = __expf(l0 - mx), e1 = __expf(l1 - mx), e2 = __expf(l2 - mx); const float inv = 1.f / (e0 + e1 + e2); e0 *= inv; e1 *= inv; e2 *= inv;
        const v4u a = *(const v4u*)(F.OG + ((size_t)0 * HB_ROWS + r) * 256 + c8), b = *(const v4u*)(F.OG + ((size_t)1 * HB_ROWS + r) * 256 + c8), c = *(const v4u*)(F.OG + ((size_t)2 * HB_ROWS + r) * 256 + c8);
        const v4u z = *(const v4u*)(F.PA + (size_t)r * NIN + C_BZ + c8); v4u o;
#define MB_1(X) X = pk2((e0 * bflo(a.X) + e1 * bflo(b.X) + e2 * bflo(c.X)) * bflo(z.X), (e0 * bfhi(a.X) + e1 * bfhi(b.X) + e2 * bfhi(c.X)) * bfhi(z.X))
        o.MB_1(x); o.MB_1(y); o.MB_1(z); o.MB_1(w);
#undef MB_1
        *(v4u*)(F.YC + (size_t)r * KC + 768 + c8) = o; }
}

__device__ __forceinline__ void dma16(const void* gsrc, LAS unsigned char* ldst) { __builtin_amdgcn_global_load_lds((const unsigned*)gsrc, (LAS unsigned*)ldst, 16, 0, 0); }
#define VM_WAIT0() asm volatile("s_waitcnt vmcnt(0)" ::: "memory")

__device__ __forceinline__ void st_attnM_v2(Ctx& F, int hb) {
    const int lane = hw_lane(), r32 = lane & 31, hi = lane >> 5;
    LAS unsigned char* wl = F.lds + RING_OFF + F.wave * 16384;
    LAS float* kst = (LAS float*)(F.lds + WSCR_OFF + F.wave * 1024);
    typedef unsigned u32x2v __attribute__((ext_vector_type(2)));
    const int vkey = (lane & 31) >> 2, vd = (lane >> 5) * 32 + (lane & 3) * 8;
    for (int it = F.xgwave; it < 16 * 64 * 4; it += F.NW) {
        const int h = it & 3, qb = (it >> 2) & 63, b = it >> 8;
        const size_t qrow = (size_t)(b * SEQ + qb * 32 + r32); const size_t kbase = (size_t)(hb * 16 + b) * MEML;
        const bf16* kp = F.KVM + (kbase + r32) * 1024 + h * 128 + 8 * hi;
        const float* ksp = F.MKSS + (kbase + r32) * 16 + 4 * h;
        const bf16* vp = F.KVM + (kbase + vkey) * 1024 + 512 + h * 128 + vd;
        bf16x8 kfn[8]; f32x4 ksn;
#define AM_ISSUE(T, STG) do { _Pragma("unroll") for (int d0 = 0; d0 < 8; ++d0) kfn[d0] = *(const bf16x8*)(kp + (size_t)(T) * 32 * 1024 + 16 * d0); ksn = *(const f32x4*)(ksp + (size_t)(T) * 32 * 16); \
        _Pragma("unroll") for (int j = 0; j < 8; ++j) dma16(vp + ((size_t)(T) * 32 + 8 * (j >> 1)) * 1024 + 64 * (j & 1), wl + (STG) * 8192 + j * 1024); } while (0)
        AM_ISSUE(0, 0);
        const float qs = rsqrtf(((F.SS[qrow * SS_W + 96 + 4 * h] + F.SS[qrow * SS_W + 96 + 4 * h + 1]) + (F.SS[qrow * SS_W + 96 + 4 * h + 2] + F.SS[qrow * SS_W + 96 + 4 * h + 3])) * (1.f / 128.f) + EPS) * (0.08838834764831845f * LOG2E);
        bf16x8 qf[8];
#pragma unroll
        for (int d0 = 0; d0 < 8; ++d0) { const int dd = 16 * d0 + 8 * hi;
            const v4u raw = *(const v4u*)(F.PA + qrow * NIN + C_MQ + h * 128 + dd);
            const f32x4 wa = *(const f32x4*)(F.mqw + dd), wb = *(const f32x4*)(F.mqw + dd + 4), ka = *(const f32x4*)(F.mkw + dd), kb = *(const f32x4*)(F.mkw + dd + 4);
            v4u o;
            o.x = cvtpk(bflo(raw.x) * qs * wa.x * ka.x, bfhi(raw.x) * qs * wa.y * ka.y); o.y = cvtpk(bflo(raw.y) * qs * wa.z * ka.z, bfhi(raw.y) * qs * wa.w * ka.w);
            o.z = cvtpk(bflo(raw.z) * qs * wb.x * kb.x, bfhi(raw.z) * qs * wb.y * kb.y); o.w = cvtpk(bflo(raw.w) * qs * wb.z * kb.z, bfhi(raw.w) * qs * wb.w * kb.w);
            qf[d0] = __builtin_bit_cast(bf16x8, o); }
        float mrun = -1e30f, lrun = 0.f; f32x16 o0 = {}, o1 = {}, o2 = {}, o3 = {};
        for (int t = 0; t < MEML / 32; ++t) {
            VM_WAIT0();
            bf16x8 kf[8];
#pragma unroll
            for (int d0 = 0; d0 < 8; ++d0) kf[d0] = kfn[d0];
            const float ksv = rsqrtf(((ksn[0] + ksn[1]) + (ksn[2] + ksn[3])) * (1.f / 128.f) + EPS);
            if (t + 1 < MEML / 32) AM_ISSUE(t + 1, (t + 1) & 1);
            if (lane < 32) kst[r32] = ksv;
            f32x16 st = {};
#pragma unroll
            for (int d0 = 0; d0 < 8; ++d0) st = __builtin_amdgcn_mfma_f32_32x32x16_bf16(kf[d0], qf[d0], st, 0, 0, 0);
            float tmax = -1e30f;
#pragma unroll
            for (int i = 0; i < 4; ++i) { const f32x4 kk = *(const LAS f32x4*)(kst + 8 * i + 4 * hi);
#pragma unroll
                for (int j = 0; j < 4; ++j) { const float s = st[4 * i + j] * kk[j]; st[4 * i + j] = s; tmax = fmaxf(tmax, s); } }
            tmax = fmaxf(tmax, __shfl_xor(tmax, 32));
            const float mnew = fmaxf(mrun, tmax), alpha = __builtin_amdgcn_exp2f(mrun - mnew); mrun = mnew;
            float psum = 0.f;
#pragma unroll
            for (int r = 0; r < 16; ++r) { st[r] = __builtin_amdgcn_exp2f(st[r] - mnew); psum += st[r]; }
            lrun = lrun * alpha + psum;
#pragma unroll
            for (int r = 0; r < 16; ++r) { o0[r] *= alpha; o1[r] *= alpha; o2[r] *= alpha; o3[r] *= alpha; }
            v4u p0, p1;
            p0.x = cvtpk(st[0], st[1]); p0.y = cvtpk(st[2], st[3]); p0.z = cvtpk(st[4], st[5]); p0.w = cvtpk(st[6], st[7]);
            p1.x = cvtpk(st[8], st[9]); p1.y = cvtpk(st[10], st[11]); p1.z = cvtpk(st[12], st[13]); p1.w = cvtpk(st[14], st[15]);
            const LAS unsigned char* vb = wl + (t & 1) * 8192 + (4 * hi + ((lane & 15) >> 2)) * 64 + ((lane >> 4) & 1) * 32 + (lane & 3) * 8;
#define AM_PV(OX, DB) do { _Pragma("unroll") for (int s = 0; s < 2; ++s) { const bf16x8 pf = __builtin_bit_cast(bf16x8, s == 0 ? p0 : p1); \
                const s16x4 a = vtr(vb + (2 * s) * 2048 + (DB) * 512), c = vtr(vb + (2 * s + 1) * 2048 + (DB) * 512); const bf16x8 vf = {a[0], a[1], a[2], a[3], c[0], c[1], c[2], c[3]}; \
                OX = __builtin_amdgcn_mfma_f32_32x32x16_bf16(vf, pf, OX, 0, 0, 0); } } while (0)
            AM_PV(o0, 0); AM_PV(o1, 1); AM_PV(o2, 2); AM_PV(o3, 3);
#undef AM_PV
        }
#undef AM_ISSUE
        const float ltot = lrun + __shfl_xor(lrun, 32), inv = 1.f / ltot;
        const bf16* zrow = F.PA + qrow * NIN + C_MZ + h * 128 + 4 * hi; bf16* yrow = F.YC + qrow * KC + 1024 + h * 128 + 4 * hi;
#define AM_ST(OX, DB) do { _Pragma("unroll") for (int i = 0; i < 4; ++i) { const u32x2v z = *(const u32x2v*)(zrow + (DB) * 32 + 8 * i); u32x2v w; \
            w.x = cvtpk(OX[4 * i] * inv * bflo(z.x), OX[4 * i + 1] * inv * bfhi(z.x)); w.y = cvtpk(OX[4 * i + 2] * inv * bflo(z.y), OX[4 * i + 3] * inv * bfhi(z.y)); \
            *(u32x2v*)(yrow + (DB) * 32 + 8 * i) = w; } } while (0)
        AM_ST(o0, 0); AM_ST(o1, 1); AM_ST(o2, 2); AM_ST(o3, 3);
#undef AM_ST
    }
}

__device__ __forceinline__ void st_attnM_v3(Ctx& F, int hb) {
    const int lane = hw_lane(), r32 = lane & 31, hi = lane >> 5;
    LAS unsigned char* kimg = F.lds + RING_OFF; LAS unsigned char* vimg = F.lds + RING_OFF + 65536;
    LAS float* kstab = (LAS float*)(F.lds + WSCR_OFF + 8192);
    typedef unsigned u32x2v __attribute__((ext_vector_type(2)));
    const int vcu = F.xgwave >> 3;
    __syncthreads();
    for (int task = vcu; task < 256; task += F.G) {
        const int bh = task >> 2, b = bh >> 2, h = bh & 3; const size_t kbase = (size_t)(hb * 16 + b) * MEML;
#pragma unroll
        for (int j = 0; j < 8; ++j) { const int p = F.wave * 8 + j, row = 4 * p + (lane >> 4);
            dma16(F.KVM + (kbase + row) * 1024 + h * 128 + 8 * ((lane & 15) ^ (row & 15)), kimg + p * 1024);
            dma16(F.KVM + (kbase + 8 * (p >> 1) + ((lane & 31) >> 2)) * 1024 + 512 + h * 128 + (2 * (p & 1) + (lane >> 5)) * 32 + (lane & 3) * 8, vimg + p * 1024); }
        { const int key = F.wave * 32 + r32; const float* sp = F.MKSS + (kbase + key) * 16 + 4 * h;
          const float ksv = rsqrtf(((sp[0] + sp[1]) + (sp[2] + sp[3])) * (1.f / 128.f) + EPS); if (lane < 32) kstab[key] = ksv; }
        VM_WAIT0(); __syncthreads();
#pragma unroll 1
        for (int qi = 0; qi < 2; ++qi) {
            const int qb = (task & 3) * 16 + F.wave * 2 + qi;
            const size_t qrow = (size_t)(b * SEQ + qb * 32 + r32);
            const float qs = rsqrtf(((F.SS[qrow * SS_W + 96 + 4 * h] + F.SS[qrow * SS_W + 96 + 4 * h + 1]) + (F.SS[qrow * SS_W + 96 + 4 * h + 2] + F.SS[qrow * SS_W + 96 + 4 * h + 3])) * (1.f / 128.f) + EPS) * (0.08838834764831845f * LOG2E);
            bf16x8 qf[8];
#pragma unroll
            for (int d0 = 0; d0 < 8; ++d0) { const int dd = 16 * d0 + 8 * hi;
                const v4u raw = *(const v4u*)(F.PA + qrow * NIN + C_MQ + h * 128 + dd);
                const f32x4 wa = *(const f32x4*)(F.mqw + dd), wb = *(const f32x4*)(F.mqw + dd + 4), ka = *(const f32x4*)(F.mkw + dd), kb = *(const f32x4*)(F.mkw + dd + 4);
                v4u o;
                o.x = cvtpk(bflo(raw.x) * qs * wa.x * ka.x, bfhi(raw.x) * qs * wa.y * ka.y); o.y = cvtpk(bflo(raw.y) * qs * wa.z * ka.z, bfhi(raw.y) * qs * wa.w * ka.w);
                o.z = cvtpk(bflo(raw.z) * qs * wb.x * kb.x, bfhi(raw.z) * qs * wb.y * kb.y); o.w = cvtpk(bflo(raw.w) * qs * wb.z * kb.z, bfhi(raw.w) * qs * wb.w * kb.w);
                qf[d0] = __builtin_bit_cast(bf16x8, o); }
            u32x2v zz[4][4];
#pragma unroll
            for (int db = 0; db < 4; ++db)
#pragma unroll
                for (int i = 0; i < 4; ++i) zz[db][i] = *(const u32x2v*)(F.PA + qrow * NIN + C_MZ + h * 128 + 4 * hi + db * 32 + 8 * i);
            float mrun = -1e30f, lrun = 0.f; f32x16 o0 = {}, o1 = {}, o2 = {}, o3 = {};
            const LAS unsigned char* kb0 = kimg + r32 * 256; const int ksw = r32 & 15;
            const LAS unsigned char* vb0 = vimg + (4 * hi + ((lane & 15) >> 2)) * 64 + ((lane >> 4) & 1) * 32 + (lane & 3) * 8;
#pragma unroll 2
            for (int t = 0; t < MEML / 32; ++t) {
                f32x16 st = {};
#pragma unroll
                for (int d0 = 0; d0 < 8; ++d0) { const bf16x8 kf = *(const LAS bf16x8*)(kb0 + t * 8192 + (((2 * d0 + hi) ^ ksw) * 16)); st = __builtin_amdgcn_mfma_f32_32x32x16_bf16(kf, qf[d0], st, 0, 0, 0); }
                float tmax = -1e30f;
#pragma unroll
                for (int i = 0; i < 4; ++i) { const f32x4 kk = *(const LAS f32x4*)(kstab + 32 * t + 8 * i + 4 * hi);
#pragma unroll
                    for (int j = 0; j < 4; ++j) { const float s = st[4 * i + j] * kk[j]; st[4 * i + j] = s; tmax = fmaxf(tmax, s); } }
                tmax = fmaxf(tmax, __shfl_xor(tmax, 32));
                const float mnew = fmaxf(mrun, tmax), alpha = __builtin_amdgcn_exp2f(mrun - mnew); mrun = mnew;
                float psum = 0.f;
#pragma unroll
                for (int r = 0; r < 16; ++r) { st[r] = __builtin_amdgcn_exp2f(st[r] - mnew); psum += st[r]; }
                lrun = lrun * alpha + psum;
#pragma unroll
                for (int r = 0; r < 16; ++r) { o0[r] *= alpha; o1[r] *= alpha; o2[r] *= alpha; o3[r] *= alpha; }
                v4u p0, p1;
                p0.x = cvtpk(st[0], st[1]); p0.y = cvtpk(st[2], st[3]); p0.z = cvtpk(st[4], st[5]); p0.w = cvtpk(st[6], st[7]);
                p1.x = cvtpk(st[8], st[9]); p1.y = cvtpk(st[10], st[11]); p1.z = cvtpk(st[12], st[13]); p1.w = cvtpk(st[14], st[15]);
                const LAS unsigned char* vb = vb0 + t * 8192;
#define AM_PV(OX, DB) do { _Pragma("unroll") for (int s = 0; s < 2; ++s) { const bf16x8 pf = __builtin_bit_cast(bf16x8, s == 0 ? p0 : p1); \
                    const s16x4 a = vtr(vb + (2 * s) * 2048 + (DB) * 512), c = vtr(vb + (2 * s + 1) * 2048 + (DB) * 512); const bf16x8 vf = {a[0], a[1], a[2], a[3], c[0], c[1], c[2], c[3]}; \
                    OX = __builtin_amdgcn_mfma_f32_32x32x16_bf16(vf, pf, OX, 0, 0, 0); } } while (0)
                AM_PV(o0, 0); AM_PV(o1, 1); AM_PV(o2, 2); AM_PV(o3, 3);
#undef AM_PV
            }
            const float ltot = lrun + __shfl_xor(lrun, 32), inv = 1.f / ltot;
            bf16* yrow = F.YC + qrow * KC + 1024 + h * 128 + 4 * hi;
#define AM_ST(OX, DB) do { _Pragma("unroll") for (int i = 0; i < 4; ++i) { const u32x2v z = zz[DB][i]; u32x2v w; \
                w.x = cvtpk(OX[4 * i] * inv * bflo(z.x), OX[4 * i + 1] * inv * bfhi(z.x)); w.y = cvtpk(OX[4 * i + 2] * inv * bflo(z.y), OX[4 * i + 3] * inv * bfhi(z.y)); \
                *(u32x2v*)(yrow + (DB) * 32 + 8 * i) = w; } } while (0)
            AM_ST(o0, 0); AM_ST(o1, 1); AM_ST(o2, 2); AM_ST(o3, 3);
#undef AM_ST
        }
        __syncthreads();
    }
}

#ifndef G1_STAGGER_TICKS
#define G1_STAGGER_TICKS 0
#endif
#ifndef PROBE_REP
#define PROBE_REP -1
#endif
#define REPS(id) for (int rep_ = 0; rep_ < ((PROBE_REP) == (id) ? 2 : 1); ++rep_)
#ifndef MK_PER_PHASE
#define MK_PER_PHASE 0
#endif
constexpr int NPH_HALF = 5, NPHASES = 1 + 2 * NPH_HALF;
struct Args { const float* in[20]; float* out; unsigned char* ws; int ph_lo, ph_hi; };
__global__ void __launch_bounds__(NTHR, 2) mega_fwd(Args args) {
    extern __shared__ __attribute__((aligned(16))) unsigned char lds_raw[];
    Ctx F;
    F.lds = (LAS unsigned char*)lds_raw;
    F.tid = threadIdx.x; F.lane = F.tid & 63; F.wave = __builtin_amdgcn_readfirstlane(F.tid >> 6);
    F.G = gridDim.x; F.gtid = blockIdx.x * NTHR + F.tid; F.T = F.G * NTHR; F.gwave = blockIdx.x * NWAVES + F.wave; F.NW = F.G * NWAVES;
    { const int bx = blockIdx.x; const int vcu = (F.G % 8 == 0) ? (bx % 8) * (F.G / 8) + bx / 8 : bx; F.xgwave = vcu * NWAVES + F.wave; }
    unsigned char* ws = args.ws;
    F.x = args.in[0]; F.mem = args.in[1]; F.norm_w = args.in[2]; F.w_in = args.in[3]; F.gate_b = args.in[4]; F.lnw = args.in[5]; F.lnb = args.in[6]; F.sp_w = args.in[7];
    F.sp_b = args.in[8]; F.bqw = args.in[9]; F.bkw = args.in[10]; F.rel_bias = args.in[11]; F.mem_norm_w = args.in[12]; F.m_w_kv = args.in[13]; F.mqw = args.in[14]; F.mkw = args.in[15];
    F.proj_a = args.in[16]; F.proj_b = args.in[17]; F.proj_m = args.in[18]; F.w_out = args.in[19]; F.out = args.out;
    F.WIN = (bf16*)(ws + WS_WIN); F.PCAT = (bf16*)(ws + WS_PCAT); F.WOUT = (bf16*)(ws + WS_WOUT); F.WSP = (bf16*)(ws + WS_WSP); F.BIAS = (float*)(ws + WS_BIAS); F.BIASX = (float*)(ws + WS_BIAS + 65536);
    F.XN = (bf16*)(ws + WS_XN); F.PA = (bf16*)(ws + WS_PA); F.KVM = (bf16*)(ws + WS_KVM); F.SS = (float*)(ws + WS_SS); F.MKSS = (float*)(ws + WS_MKSS);
    F.OG = (bf16*)(ws + WS_OG); F.LSE = (float*)(ws + WS_LSE); F.LNST = (float*)(ws + WS_LNST); F.YC = (bf16*)(ws + WS_YC); F.MRG = (bf16*)(ws + WS_MRG);
    for (int u = F.tid; u < (LDS_BYTES - LDSCTL_OFF) / 4; u += NTHR) ((LAS unsigned*)(F.lds + LDSCTL_OFF))[u] = 0u;
    __syncthreads();
    XcdBarrier bar; bar.bar = (unsigned*)(ws + WS_CTL) + CW_BAR; bar.x = 0; bar.st = nullptr; bar.wave = 0;
    if (!MK_PER_PHASE) bar = xcd_barrier_post((unsigned*)(ws + WS_CTL) + CW_BAR, (volatile LAS unsigned*)(F.lds + MISC_OFF) + 8, F.wave);
    const int lo = args.ph_lo, hi = args.ph_hi;
#define IN(k) (lo <= (k) && (k) < hi)
#define SEAM(k) do { if (IN(k) && IN((k) + 1)) xcd_barrier(bar); } while (0)

    if (IN(0)) { REPS(0) p0_prologue(F); } SEAM(0);
#pragma unroll 1
    for (int hb = 0; hb < 2; ++hb) {
        const int pb = 1 + hb * NPH_HALF, row0 = hb * HB_ROWS;
        asm volatile("v_mbcnt_lo_u32_b32 %0, -1, 0\n\tv_mbcnt_hi_u32_b32 %0, -1, %0" : "=v"(F.lane)); F.tid = F.wave * 64 + F.lane; F.gtid = blockIdx.x * NTHR + F.tid;
#if PROBE_REP == 9 || PROBE_REP == 10
        if (IN(pb + 0)) { pg8::Gemm g{F.XN, F.WIN, MTOT + MMEM, NIN + 1024, DM, DM, DM}; pg8::OrderG1 S; S.init(hb, F.G, (int)blockIdx.x);
            typedef pg8::EpiProjT<PROBE_REP - 8> EP; EP E{F.PA, F.KVM, F.SS, F.MKSS, F.gate_b, hb * (HB_ROWS / 256), 0};
            pg8::gemm_phase<EP, pg8::OrderG1, true, true>(F.lds + RING_OFF, g, S, E, F.wave); }
#endif
        if (IN(pb + 0)) REPS(1) {
            pg8::Gemm g{F.XN, F.WIN, MTOT + MMEM, NIN + 1024, DM, DM, DM}; pg8::OrderG1 S; S.init(hb, F.G, (int)blockIdx.x);
#if G1_STAGGER_TICKS
            { const unsigned long long t0 = __builtin_amdgcn_s_memrealtime(), dl = (unsigned long long)((blockIdx.x >> 3) & 31) * G1_STAGGER_TICKS;
              while (__builtin_amdgcn_s_memrealtime() - t0 < dl) __builtin_amdgcn_s_sleep(8); }
#endif
            pg8::EpiProj E{F.PA, F.KVM, F.SS, F.MKSS, F.gate_b, hb * (HB_ROWS / 256), 0};
            pg8::gemm_phase<pg8::EpiProj, pg8::OrderG1, true, true>(F.lds + RING_OFF, g, S, E, F.wave);
        }
#if PROBE_REP == 8
        if (IN(pb + 0)) { pg8::Gemm g{F.XN, F.WIN, MTOT + MMEM, NIN + 1024, DM, DM, DM}; pg8::OrderG1 S; S.init(hb, F.G, (int)blockIdx.x); pg8::EpiNull E{};
            pg8::gemm_phase<pg8::EpiNull, pg8::OrderG1, true, true>(F.lds + RING_OFF, g, S, E, F.wave); }
#endif
        SEAM(pb + 0);
        if (IN(pb + 1)) { REPS(2) st_mixA_mfma(F); REPS(3) st_attnB_mfma(F); REPS(4) st_attnM_v3(F, hb); } SEAM(pb + 1);
        if (IN(pb + 2)) { REPS(5) st_mergeB_vec(F); } SEAM(pb + 2);
        if (IN(pb + 3)) REPS(6) {
            pg8::Gemm g{F.YC, F.PCAT, HB_ROWS, DM, KC, KC, KC}; pg8::StaticOrder S; S.init(HB_ROWS, DM, F.G, (int)blockIdx.x);
            pg8::EpiG2cat E{F.PA, F.MRG};
            pg8::gemm_phase<pg8::EpiG2cat, pg8::StaticOrder, true, true>(F.lds + RING_OFF, g, S, E, F.wave);
        } SEAM(pb + 3);
        if (IN(pb + 4)) REPS(7) {
            pg8::Gemm g{F.MRG, F.WOUT, HB_ROWS, DM, DM, DM, DM}; pg8::StaticOrder S; S.init(HB_ROWS, DM, F.G, (int)blockIdx.x);
            pg8::EpiG3 E{F.x + (size_t)row0 * DM, F.out + (size_t)row0 * DM};
            pg8::gemm_phase<pg8::EpiG3, pg8::StaticOrder, true, true>(F.lds + RING_OFF, g, S, E, F.wave);
        } SEAM(pb + 4);
    }
#undef IN
#undef SEAM
}

extern "C" void kernel_launch(void* const* d_in, const int* in_sizes, int n_in, void* d_out, int out_size, void* d_ws, size_t ws_size, hipStream_t stream) {
    static int grid = 0;
    if (grid == 0) {
        if (n_in != 20 || in_sizes[0] != MTOT * DM || out_size != MTOT * DM || ws_size < WS_END) { fprintf(stderr, "kernel_launch: unexpected shapes (n_in %d, ws %zu); nothing launched\n", n_in, ws_size); grid = -1; return; }
        int dev = 0, cus = 0, per_cu = 0;
        if (hipGetDevice(&dev) != hipSuccess || hipDeviceGetAttribute(&cus, hipDeviceAttributeMultiprocessorCount, dev) != hipSuccess) { grid = -1; return; }
        if (hipFuncSetAttribute((const void*)mega_fwd, hipFuncAttributeMaxDynamicSharedMemorySize, LDS_BYTES) != hipSuccess) { fprintf(stderr, "kernel_launch: hipFuncSetAttribute failed\n"); grid = -1; return; }
        if (hipOccupancyMaxActiveBlocksPerMultiprocessor(&per_cu, (const void*)mega_fwd, NTHR, LDS_BYTES) != hipSuccess || per_cu < 1) { fprintf(stderr, "kernel_launch: occupancy query says %d blocks per CU\n", per_cu); (void)hipGetLastError(); grid = -1; return; }
        grid = cus;
    }
    if (grid < 0) return;
    if (hipMemsetAsync((char*)d_ws + WS_CTL, 0, CTL_ZERO_BYTES, stream) != hipSuccess) return;
    Args a{};
    for (int i = 0; i < 20; ++i) a.in[i] = (const float*)d_in[i];
    a.out = (float*)d_out; a.ws = (unsigned char*)d_ws;
#if MK_PER_PHASE
    for (int p = 0; p < NPHASES; ++p) { a.ph_lo = p; a.ph_hi = p + 1; hipLaunchKernelGGL(mega_fwd, dim3(grid), dim3(NTHR), LDS_BYTES, stream, a); }
#else
    a.ph_lo = 0; a.ph_hi = NPHASES; hipLaunchKernelGGL(mega_fwd, dim3(grid), dim3(NTHR), LDS_BYTES, stream, a);
#endif
}
```

```cpp
#include <hip/hip_runtime.h>
#include <cstdint>
#include <cstdio>

constexpr int DM = 1024, NB = 32, SEQ = 2048, MTOT = NB * SEQ;
constexpr int NIN = 8960, MEML = 256, MMEM = NB * MEML;
constexpr int HB_ROWS = MTOT / 2;
constexpr int C_AU = 0, C_AV = 768, C_AZ = 1536, C_BQ = 2304, C_BK = 3072, C_BV = 3840, C_BZ = 4608, C_MQ = 4864, C_MZ = 5376, C_G = 5888;
constexpr float EPS = 1e-6f;
constexpr int SS_W = 112;
constexpr int KC = 1536;

constexpr size_t MiB = 1u << 20;
constexpr size_t WS_CTL = 0, CTL_ZERO_BYTES = 256 * 1024, WS_WIN = 2 * MiB, WS_PCAT = 22 * MiB, WS_WOUT = 25 * MiB, WS_WSP = 27 * MiB, WS_BIAS = 27 * MiB + 512 * 1024;
constexpr size_t WS_XN = 32 * MiB, WS_PA = 176 * MiB, WS_KVM = 736 * MiB, WS_SS = 752 * MiB, WS_MKSS = 766 * MiB, WS_OG = 768 * MiB, WS_LSE = 816 * MiB, WS_LNST = 818 * MiB;
constexpr size_t WS_YC = 820 * MiB, WS_MRG = 916 * MiB, WS_END = 980 * MiB;
constexpr int CW_BAR = 4096;

namespace pg8 {
#define PG8_LAS __attribute__((address_space(3)))
typedef unsigned short bf16_t;
typedef short bf16x8 __attribute__((ext_vector_type(8)));
typedef float f32x4 __attribute__((ext_vector_type(4)));
typedef unsigned u32x4 __attribute__((ext_vector_type(4)));
constexpr int BM = 256, BK = 64, HALF = 128, HTB = HALF * BK * 2  , STAGE_BYTES = 8 * HTB, NXCD = 8, WGM = 8;

__host__ __device__ __forceinline__ int lds_byte(int r, int c) { const int st = (r >> 4) * 2 + (c >> 5), rr = r & 15, cc = c & 31, ob = rr * 64 + cc * 2; return st * 1024 + (ob ^ (((ob >> 9) & 1) << 5)); }
__host__ __device__ __forceinline__ void stage_rc(int b, int& R, int& C) { const int st = b / 1024, sb = b % 1024, swz = sb ^ (((sb >> 9) & 1) << 5); R = (st >> 1) * 16 + swz / 64; C = (st & 1) * 32 + (swz % 64) / 2; }
__host__ __device__ __forceinline__ int perm32(int rho) { const int n = rho >> 4, i = rho & 15; return 8 * (i >> 2) + 4 * n + (i & 3); }

struct Unit { int pm, pn; };
struct Gemm { const bf16_t* A; const bf16_t* Bt; int M, N, K, lda, ldb; };

struct StaticOrder {
    int nM, nN, nwg, G, c;
    __host__ __device__ void init(int M, int N, int G_, int c_) { nM = M / BM; nN = N / BM; nwg = nM * nN; G = G_; c = c_; }
    __host__ __device__ bool next(int i, Unit& u) const {
        const long L = (long)i * G + c; if (L >= nwg) return false;
        int wgid = (int)L; { const int q = nwg / NXCD, r = nwg % NXCD, xcd = wgid % NXCD, off = wgid / NXCD; wgid = (xcd < r ? xcd * (q + 1) : r * (q + 1) + (xcd - r) * q) + off; }
        const int nig = WGM * nN, gid = wgid / nig, fm = gid * WGM, gsz = (nM - fm) < WGM ? (nM - fm) : WGM;
        u.pm = fm + ((wgid % nig) % gsz); u.pn = (wgid % nig) / gsz; return true;
    }
    __device__ __forceinline__ void a_ready(const Unit&) const {}
    __device__ __forceinline__ void done(const Unit&) const {}
};


typedef float f32x2c_t __attribute__((ext_vector_type(2))); typedef __bf16 bf16x2c_t __attribute__((ext_vector_type(2)));
__device__ __forceinline__ unsigned cvt_pk_bf16(float lo, float hi) { const f32x2c_t v = {lo, hi}; const bf16x2c_t b = __builtin_convertvector(v, bf16x2c_t); return __builtin_bit_cast(unsigned, b); }
typedef float f32x2 __attribute__((ext_vector_type(2)));
__device__ __forceinline__ f32x2 gelu_pk(f32x2 v) {
    const f32x2 av = __builtin_elementwise_abs(v), d = av * 0.2316418882f + 1.0f;
    f32x2 t; t.x = __builtin_amdgcn_rcpf(d.x); t.y = __builtin_amdgcn_rcpf(d.y);
    f32x2 q = t * 0.5307027145f + (-0.7265760135f); q = q * t + 0.7107068705f; q = q * t + (-0.142248368f); q = q * t + 0.127414796f; q = q * t;
    const f32x2 s = (v * v) * (-0.72134752044f);
    f32x2 e; e.x = __builtin_amdgcn_exp2f(s.x); e.y = __builtin_amdgcn_exp2f(s.y);
    const f32x2 m = v * (q * e), r = v - m;
    f32x2 o; o.x = v.x < 0.f ? m.x : r.x; o.y = v.y < 0.f ? m.y : r.y; return o;
}

template <class Epi, class Sched, bool ALIGN_EPI = false, bool SP2 = false>
__device__ __forceinline__ void gemm_phase(PG8_LAS unsigned char* lds, const Gemm g, const Sched& S, const Epi& E, const int wave_id) {
    int tid; asm volatile("v_mbcnt_lo_u32_b32 %0, -1, 0\n\tv_mbcnt_hi_u32_b32 %0, -1, %0" : "=v"(tid)); tid += wave_id * 64;
    const int wid = __builtin_amdgcn_readfirstlane(tid >> 6), lane = tid & 63, wr = wid >> 2, wc = wid & 3, fr = lane & 15, fq = lane >> 4;
    int K = g.K; asm volatile("" : "+s"(K)); const int nt = K / BK;
    unsigned voffA[2], voffB[2];
#pragma unroll
    for (int i = 0; i < 2; ++i) { int R, C; stage_rc(tid * 16 + i * 8192, R, C); const int Rb = Epi::PERM ? ((R & ~31) + perm32(R & 31)) : R;
        voffA[i] = (unsigned)(R * g.lda + C) * 2u; voffB[i] = (unsigned)(Rb * g.ldb + C) * 2u; }
    const size_t kstep = (size_t)(BK * 2);
    const size_t hstepA = (size_t)HALF * g.lda * 2, hstepB = (size_t)HALF * g.ldb * 2;
    const size_t tstepA = 2 * hstepA, tstepB = 2 * hstepB;
    const unsigned ldsw = (unsigned)wid * 1024u;
    const int aoff = lds_byte(wr * 64 + fr, fq * 8), boff = lds_byte(wc * 32 + fr, fq * 8);
#define PG8_SA(b, h) (((b) * 2 + (h)) * HTB)
#define PG8_SB(b, h) ((4 + (b) * 2 + (h)) * HTB)
#define PG8_STAGE(bufoff, gbase, voff) do { _Pragma("unroll") for (int _i = 0; _i < 2; ++_i) \
        __builtin_amdgcn_global_load_lds((const unsigned*)((const char*)(gbase) + (voff)[_i]), (PG8_LAS unsigned*)(lds + (bufoff) + ldsw + _i * 8192), 16, 0, 0); } while (0)
#define PG8_LDA(dst, b, h) do { _Pragma("unroll") for (int m = 0; m < 4; ++m) _Pragma("unroll") for (int k = 0; k < 2; ++k) dst[m][k] = *(const PG8_LAS bf16x8*)(lds + PG8_SA(b, h) + aoff + m * 2048 + k * 1024); } while (0)
#define PG8_LDB(dst, b, h) do { _Pragma("unroll") for (int n = 0; n < 2; ++n) _Pragma("unroll") for (int k = 0; k < 2; ++k) dst[n][k] = *(const PG8_LAS bf16x8*)(lds + PG8_SB(b, h) + boff + n * 2048 + k * 1024); } while (0)
#define PG8_MMA(ai, bj, At, Bt) do { __builtin_amdgcn_s_setprio(1); _Pragma("unroll") for (int m = 0; m < 4; ++m) _Pragma("unroll") for (int n = 0; n < 2; ++n) _Pragma("unroll") for (int k = 0; k < 2; ++k) \
        acc[ai][bj][m][n] = __builtin_amdgcn_mfma_f32_16x16x32_bf16(Bt[n][k], At[m][k], acc[ai][bj][m][n], 0, 0, 0); __builtin_amdgcn_s_setprio(0); } while (0)
#define PG8_WAIT_V(n) asm volatile("s_waitcnt vmcnt(" #n ")" ::: "memory")
#define PG8_WAIT_L(n) asm volatile("s_waitcnt lgkmcnt(" #n ")" ::: "memory")
#define PG8_BAR __builtin_amdgcn_s_barrier()
#define PG8_SCHED __builtin_amdgcn_sched_barrier(0)
    Unit cur, nxt; int ui = 0;
    if (!S.next(0, cur)) return;
    f32x4 acc[2][2][4][2];
#pragma unroll
    for (int a = 0; a < 2; ++a)
#pragma unroll
        for (int b = 0; b < 2; ++b)
#pragma unroll
            for (int m = 0; m < 4; ++m)
#pragma unroll
                for (int n = 0; n < 2; ++n) acc[a][b][m][n] = (f32x4){0.f, 0.f, 0.f, 0.f};
    bf16x8 At[4][2], B0[2][2], B1[2][2];
    const char* cA = (const char*)g.A + (size_t)cur.pm * tstepA; const char* cB = (const char*)g.Bt + (size_t)cur.pn * tstepB;
    S.a_ready(cur);
    if constexpr (SP2) {
        PG8_STAGE(PG8_SB(0, 0), cB, voffB); PG8_STAGE(PG8_SB(0, 1), cB + hstepB, voffB); PG8_STAGE(PG8_SA(0, 0), cA, voffA); PG8_STAGE(PG8_SA(0, 1), cA + hstepA, voffA);
        if (wr == 1) PG8_BAR;
        PG8_WAIT_V(2); PG8_BAR;
        PG8_STAGE(PG8_SB(1, 0), cB + kstep, voffB); PG8_STAGE(PG8_SA(1, 0), cA + kstep, voffA); PG8_STAGE(PG8_SB(1, 1), cB + hstepB + kstep, voffB);
        PG8_WAIT_V(6); PG8_BAR;
    } else {
        PG8_STAGE(PG8_SB(0, 0), cB, voffB); PG8_STAGE(PG8_SA(0, 0), cA, voffA); PG8_STAGE(PG8_SB(0, 1), cB + hstepB, voffB); PG8_STAGE(PG8_SA(0, 1), cA + hstepA, voffA);
        if (wr == 1) PG8_BAR;
        PG8_WAIT_V(4); PG8_BAR;
        PG8_STAGE(PG8_SB(1, 0), cB + kstep, voffB); PG8_STAGE(PG8_SA(1, 0), cA + kstep, voffA); PG8_STAGE(PG8_SB(1, 1), cB + hstepB + kstep, voffB);
        PG8_WAIT_V(6); PG8_BAR;
    }
    for (;;) {
        const bool has_next = S.next(ui + 1, nxt);
        const char* nA = has_next ? (const char*)g.A + (size_t)nxt.pm * tstepA : cA; const char* nB = has_next ? (const char*)g.Bt + (size_t)nxt.pn * tstepB : cB;
        for (int t = 0; t < nt; t += 2) {
            if constexpr (Epi::KHOOK) { if (t == Epi::KH1 || t == Epi::KH2) E.khook(acc, cur, t, wr, wc, fr, fq); }
            const bool last = (t == nt - 2);
            const char* a1 = cA + (size_t)(t + 1) * kstep;
            const char* a2 = last ? nA : cA + (size_t)(t + 2) * kstep; const char* b2 = last ? nB : cB + (size_t)(t + 2) * kstep;
            const char* a3 = a2 + kstep; const char* b3 = b2 + kstep;
            if (last && has_next) S.a_ready(nxt);
            if constexpr (SP2) {
            PG8_LDB(B0, 0, 0); PG8_LDB(B1, 0, 1); PG8_SCHED; PG8_LDA(At, 0, 0); PG8_STAGE(PG8_SA(1, 1), a1 + hstepA, voffA);
            PG8_WAIT_V(8); PG8_WAIT_L(0); PG8_BAR; PG8_MMA(0, 0, At, B0); PG8_MMA(0, 1, At, B1); PG8_BAR; PG8_SCHED;
            PG8_LDA(At, 0, 1); PG8_STAGE(PG8_SB(0, 0), b2, voffB); PG8_STAGE(PG8_SB(0, 1), b2 + hstepB, voffB); PG8_STAGE(PG8_SA(0, 0), a2, voffA);
            PG8_WAIT_V(8); PG8_WAIT_L(0); PG8_BAR; PG8_MMA(1, 0, At, B0); PG8_MMA(1, 1, At, B1); PG8_BAR; PG8_SCHED;
            PG8_LDB(B0, 1, 0); PG8_LDB(B1, 1, 1); PG8_SCHED; PG8_LDA(At, 1, 0); PG8_STAGE(PG8_SA(0, 1), a2 + hstepA, voffA);
            PG8_WAIT_V(8); PG8_WAIT_L(0); PG8_BAR; PG8_MMA(0, 0, At, B0); PG8_MMA(0, 1, At, B1); PG8_BAR; PG8_SCHED;
            PG8_LDA(At, 1, 1); PG8_STAGE(PG8_SB(1, 0), b3, voffB); PG8_STAGE(PG8_SB(1, 1), b3 + hstepB, voffB); PG8_STAGE(PG8_SA(1, 0), a3, voffA);
            PG8_WAIT_V(8); PG8_WAIT_L(0); PG8_BAR; PG8_MMA(1, 0, At, B0); PG8_MMA(1, 1, At, B1); PG8_BAR; PG8_SCHED;
            } else {
            PG8_LDB(B0, 0, 0); PG8_SCHED; PG8_LDA(At, 0, 0); PG8_STAGE(PG8_SA(1, 1), a1 + hstepA, voffA);
            PG8_WAIT_L(8); PG8_BAR; PG8_WAIT_L(0); PG8_MMA(0, 0, At, B0); PG8_BAR; PG8_SCHED;
            PG8_LDB(B1, 0, 1); PG8_STAGE(PG8_SB(0, 0), b2, voffB);
            PG8_BAR; PG8_WAIT_L(0); PG8_MMA(0, 1, At, B1); PG8_BAR;
            PG8_LDA(At, 0, 1); PG8_STAGE(PG8_SA(0, 0), a2, voffA);
            PG8_BAR; PG8_WAIT_L(0); PG8_MMA(1, 0, At, B0); PG8_BAR; PG8_SCHED;
            PG8_STAGE(PG8_SB(0, 1), b2 + hstepB, voffB);
            PG8_WAIT_V(6); PG8_BAR; PG8_MMA(1, 1, At, B1); PG8_BAR;
            PG8_LDB(B0, 1, 0); PG8_SCHED; PG8_LDA(At, 1, 0); PG8_STAGE(PG8_SA(0, 1), a2 + hstepA, voffA);
            PG8_WAIT_L(8); PG8_BAR; PG8_WAIT_L(0); PG8_MMA(0, 0, At, B0); PG8_BAR; PG8_SCHED;
            PG8_LDB(B1, 1, 1); PG8_STAGE(PG8_SB(1, 0), b3, voffB);
            PG8_BAR; PG8_WAIT_L(0); PG8_MMA(0, 1, At, B1); PG8_BAR;
            PG8_LDA(At, 1, 1); PG8_STAGE(PG8_SA(1, 0), a3, voffA);
            PG8_BAR; PG8_WAIT_L(0); PG8_MMA(1, 0, At, B0); PG8_BAR; PG8_SCHED;
            PG8_STAGE(PG8_SB(1, 1), b3 + hstepB, voffB);
            PG8_WAIT_V(6); PG8_BAR; PG8_MMA(1, 1, At, B1); PG8_BAR;
            }
        }
        if constexpr (ALIGN_EPI) { if (wr == 0) PG8_BAR; }
        if constexpr (!Epi::AFTER_DRAIN) { E(acc, cur, wr, wc, fr, fq); S.done(cur); }
        if (!has_next) break;
#pragma unroll
        for (int a = 0; a < 2; ++a)
#pragma unroll
            for (int b = 0; b < 2; ++b)
#pragma unroll
                for (int m = 0; m < 4; ++m)
#pragma unroll
                    for (int n = 0; n < 2; ++n) acc[a][b][m][n] = (f32x4){0.f, 0.f, 0.f, 0.f};
        cur = nxt; cA = nA; cB = nB; ++ui;
        if constexpr (ALIGN_EPI) { if (wr == 1) PG8_BAR; }
    }
    PG8_WAIT_V(0);
    if constexpr (!ALIGN_EPI) { if (wr == 0) PG8_BAR; }
    PG8_BAR;
    if constexpr (Epi::AFTER_DRAIN) { E.fused(acc, cur, wr, wc, fr, fq, lds, wid, lane); S.done(cur); }
#undef PG8_SA
#undef PG8_SB
#undef PG8_STAGE
#undef PG8_LDA
#undef PG8_LDB
#undef PG8_MMA
#undef PG8_WAIT_V
#undef PG8_WAIT_L
#undef PG8_BAR
#undef PG8_SCHED
}
}

#ifndef G1_EPI_DRAIN
#define G1_EPI_DRAIN 0
#endif
#ifndef G1_STORE_AUX
#define G1_STORE_AUX 2
#endif
namespace pg8 {
__device__ __forceinline__ float ex2(float x) { return __builtin_amdgcn_exp2f(x); }
__device__ __forceinline__ float sigm_fast(float x) { return __builtin_amdgcn_rcpf(1.0f + ex2(x * -1.4426950408889634f)); }
template <int MODE = 0  > struct EpiProjT {
    static constexpr bool PERM = true, AFTER_DRAIN = false, KHOOK = false;
    bf16_t* PA; bf16_t* KVM; float* SS; float* MKSS; const float* gate_b; int pm0; int pad;
    template <int KIND, int STAT> __device__ __forceinline__ void body(const f32x4 (&acc)[2][2][4][2], const __amdgpu_buffer_rsrc_t rsrc, int row0, int col0, int ldc, float* sb, int sld, int so, const float* bias, int wc, int fq) const {
        f32x4 bv[2][2];
        if (KIND == 3) {
#pragma unroll
            for (int bj = 0; bj < 2; ++bj)
#pragma unroll
                for (int n = 0; n < 2; ++n) bv[bj][n] = *(const f32x4*)(bias + bj * HALF + 4 * n);
        }
#pragma unroll
        for (int ai = 0; ai < 2; ++ai)
#pragma unroll
            for (int m = 0; m < 4; ++m) { const int row = row0 + ai * HALF + m * 16; const unsigned rowoff = ((unsigned)row * (unsigned)ldc + (unsigned)col0) * 2u;
#pragma unroll
                for (int bj = 0; bj < 2; ++bj) { f32x4 v0 = acc[ai][bj][m][0], v1 = acc[ai][bj][m][1];
                    if (KIND == 1) { f32x2 a = gelu_pk((f32x2){v0[0], v0[1]}), b = gelu_pk((f32x2){v0[2], v0[3]}), c = gelu_pk((f32x2){v1[0], v1[1]}), d = gelu_pk((f32x2){v1[2], v1[3]});
                        v0 = (f32x4){a.x, a.y, b.x, b.y}; v1 = (f32x4){c.x, c.y, d.x, d.y}; }
                    else if (KIND == 2) {
#pragma unroll
                        for (int j = 0; j < 4; ++j) { v0[j] = v0[j] * sigm_fast(v0[j]); v1[j] = v1[j] * sigm_fast(v1[j]); } }
                    else if (KIND == 3) { v0 = v0 + bv[bj][0]; v1 = v1 + bv[bj][1];
#pragma unroll
                        for (int j = 0; j < 4; ++j) { v0[j] = sigm_fast(v0[j]); v1[j] = sigm_fast(v1[j]); } }
                    if (STAT) {
                        float s = ((v0[0] + v0[1]) + (v0[2] + v0[3])) + ((v1[0] + v1[1]) + (v1[2] + v1[3]));
                        float q = ((v0[0] * v0[0] + v0[1] * v0[1]) + (v0[2] * v0[2] + v0[3] * v0[3])) + ((v1[0] * v1[0] + v1[1] * v1[1]) + (v1[2] * v1[2] + v1[3] * v1[3]));
                        if (STAT == 2) { s += __shfl_xor(s, 16); s += __shfl_xor(s, 32); }
                        q += __shfl_xor(q, 16); q += __shfl_xor(q, 32);
                        if (fq == 0) { float* sp = sb + (size_t)row * sld + so; const int blk = 4 * bj + wc;
                            if (STAT == 2) { sp[2 * blk] = s; sp[2 * blk + 1] = q; } else sp[blk] = q; }
                    }
                    u32x4 w; w.x = cvt_pk_bf16(v0[0], v0[1]); w.y = cvt_pk_bf16(v0[2], v0[3]); w.z = cvt_pk_bf16(v1[0], v1[1]); w.w = cvt_pk_bf16(v1[2], v1[3]);
                    if (MODE == 2) asm volatile("" :: "v"(w)); else __builtin_amdgcn_raw_buffer_store_b128(w, rsrc, (int)(rowoff + bj * HALF * 2), 0, G1_STORE_AUX); } }
    }
    __device__ __forceinline__ void operator()(const f32x4 (&acc)[2][2][4][2], const Unit& u, int wr, int wc, int fr, int fq) const {
        const bool kv = u.pn >= 35; const int pn = kv ? u.pn - 35 : u.pn;
        const int rowt = kv ? (u.pm - 256) * BM : (u.pm - pm0) * BM;
        bf16_t* base = kv ? KVM : PA; const int ldc = kv ? 1024 : NIN;
        const __amdgpu_buffer_rsrc_t rsrc = __builtin_amdgcn_make_buffer_rsrc(base, 0, kv ? (int)((size_t)MMEM * 1024 * 2) : (int)((size_t)HB_ROWS * NIN * 2), 0x00020000);
        const int row0 = rowt + wr * 64 + fr, col0 = pn * BM + wc * 32 + 8 * fq;
        if (MODE == 1) { body<0, 0>(acc, rsrc, row0, col0, ldc, SS, SS_W, 0, gate_b, wc, fq); return; }
        if (kv) { if (pn < 2) body<0, 1>(acc, rsrc, row0, col0, ldc, MKSS, 16, 8 * pn, gate_b, wc, fq); else body<0, 0>(acc, rsrc, row0, col0, ldc, SS, SS_W, 0, gate_b, wc, fq); }
        else if (pn < 3) body<1, 0>(acc, rsrc, row0, col0, ldc, SS, SS_W, 0, gate_b, wc, fq);
        else if (pn < 6) body<1, 2>(acc, rsrc, row0, col0, ldc, SS, SS_W, 16 * (pn - 3), gate_b, wc, fq);
        else if (pn < 9) body<2, 0>(acc, rsrc, row0, col0, ldc, SS, SS_W, 0, gate_b, wc, fq);
        else if (pn < 12) body<0, 1>(acc, rsrc, row0, col0, ldc, SS, SS_W, 48 + 8 * (pn - 9), gate_b, wc, fq);
        else if (pn < 15) body<0, 1>(acc, rsrc, row0, col0, ldc, SS, SS_W, 72 + 8 * (pn - 12), gate_b, wc, fq);
        else if (pn < 18) body<0, 0>(acc, rsrc, row0, col0, ldc, SS, SS_W, 0, gate_b, wc, fq);
        else if (pn < 19) body<2, 0>(acc, rsrc, row0, col0, ldc, SS, SS_W, 0, gate_b, wc, fq);
        else if (pn < 21) body<0, 1>(acc, rsrc, row0, col0, ldc, SS, SS_W, 96 + 8 * (pn - 19), gate_b, wc, fq);
        else if (pn < 23) body<2, 0>(acc, rsrc, row0, col0, ldc, SS, SS_W, 0, gate_b, wc, fq);
        else body<3, 0>(acc, rsrc, row0, col0, ldc, SS, SS_W, 0, gate_b + (col0 - 23 * BM), wc, fq);
#if G1_EPI_DRAIN
        asm volatile("s_waitcnt vmcnt(0)" ::: "memory");
#endif
    }
};
typedef EpiProjT<0> EpiProj;
struct EpiG2cat {
    static constexpr bool PERM = true, AFTER_DRAIN = false, KHOOK = true; static constexpr int KH1 = 12, KH2 = 16;
    const bf16_t* PA; bf16_t* MRG;
    __device__ __forceinline__ void khook(f32x4 (&acc)[2][2][4][2], const Unit& u, int t, int wr, int wc, int fr, int fq) const {
        const int ga = t == KH1 ? 0 : 1;
        const int row0 = u.pm * BM + wr * 64 + fr, col0 = u.pn * BM + wc * 32 + 8 * fq;
        const bf16_t* gbase = PA + (size_t)row0 * NIN + C_G + ga * DM + col0;
        u32x4 ag[2][2][2], bg[2][2][2];
#define G2_LOAD(B) do { _Pragma("unroll") for (int mm = 0; mm < 2; ++mm) { const bf16_t* gp_ = gbase + (size_t)(((B) >> 1) * HALF + (2 * ((B) & 1) + mm) * 16) * NIN; \
            _Pragma("unroll") for (int bj = 0; bj < 2; ++bj) { ag[(B) & 1][mm][bj] = *(const u32x4*)(gp_ + bj * HALF); bg[(B) & 1][mm][bj] = *(const u32x4*)(gp_ + DM + bj * HALF); } } } while (0)
#define G2_RATIO(A, Bv, SH) (__uint_as_float(SH(A)) * __builtin_amdgcn_rcpf(__uint_as_float(SH(Bv))))
#define G2_LO(w) ((w) << 16)
#define G2_HI(w) ((w) & 0xffff0000u)
#define G2_SCALE(B) do { _Pragma("unroll") for (int mm = 0; mm < 2; ++mm) _Pragma("unroll") for (int bj = 0; bj < 2; ++bj) { const u32x4 a = ag[(B) & 1][mm][bj], b = bg[(B) & 1][mm][bj]; f32x4 r0, r1; \
            r0[0] = G2_RATIO(a.x, b.x, G2_LO); r0[1] = G2_RATIO(a.x, b.x, G2_HI); r0[2] = G2_RATIO(a.y, b.y, G2_LO); r0[3] = G2_RATIO(a.y, b.y, G2_HI); \
            r1[0] = G2_RATIO(a.z, b.z, G2_LO); r1[1] = G2_RATIO(a.z, b.z, G2_HI); r1[2] = G2_RATIO(a.w, b.w, G2_LO); r1[3] = G2_RATIO(a.w, b.w, G2_HI); \
            acc[(B) >> 1][bj][2 * ((B) & 1) + mm][0] *= r0; acc[(B) >> 1][bj][2 * ((B) & 1) + mm][1] *= r1; } } while (0)
        G2_LOAD(0); G2_LOAD(1); G2_SCALE(0); G2_LOAD(2); G2_SCALE(1); G2_LOAD(3); G2_SCALE(2); G2_SCALE(3);
#undef G2_LOAD
#undef G2_RATIO
#undef G2_LO
#undef G2_HI
#undef G2_SCALE
    }
    __device__ __forceinline__ void operator()(const f32x4 (&acc)[2][2][4][2], const Unit& u, int wr, int wc, int fr, int fq) const {
        const int row0 = u.pm * BM + wr * 64 + fr, col0 = u.pn * BM + wc * 32 + 8 * fq;
        u32x4 gv[2][4][2];
#pragma unroll
        for (int ai = 0; ai < 2; ++ai)
#pragma unroll
            for (int m = 0; m < 4; ++m) { const bf16_t* gp = PA + (size_t)(row0 + ai * HALF + m * 16) * NIN + C_G + 2 * DM + col0;
#pragma unroll
                for (int bj = 0; bj < 2; ++bj) gv[ai][m][bj] = *(const u32x4*)(gp + bj * HALF); }
#pragma unroll
        for (int ai = 0; ai < 2; ++ai)
#pragma unroll
            for (int m = 0; m < 4; ++m) { bf16_t* mp = MRG + (size_t)(row0 + ai * HALF + m * 16) * DM + col0;
#pragma unroll
                for (int bj = 0; bj < 2; ++bj) { const u32x4 g = gv[ai][m][bj]; const f32x4 v0 = acc[ai][bj][m][0], v1 = acc[ai][bj][m][1]; u32x4 w;
                    w.x = cvt_pk_bf16(v0[0] * __uint_as_float(g.x << 16), v0[1] * __uint_as_float(g.x & 0xffff0000u)); w.y = cvt_pk_bf16(v0[2] * __uint_as_float(g.y << 16), v0[3] * __uint_as_float(g.y & 0xffff0000u));
                    w.z = cvt_pk_bf16(v1[0] * __uint_as_float(g.z << 16), v1[1] * __uint_as_float(g.z & 0xffff0000u)); w.w = cvt_pk_bf16(v1[2] * __uint_as_float(g.w << 16), v1[3] * __uint_as_float(g.w & 0xffff0000u));
                    *(u32x4*)(mp + bj * HALF) = w; } }
    }
};
struct EpiG3 {
    static constexpr bool PERM = false, AFTER_DRAIN = false, KHOOK = false;
    const float* x; float* out;
    __device__ __forceinline__ void operator()(const f32x4 (&acc)[2][2][4][2], const Unit& u, int wr, int wc, int fr, int fq) const {
        const int row0 = u.pm * BM + wr * 64 + fr, col0 = u.pn * BM + wc * 32 + 4 * fq;
        f32x4 xv[2][2][2][2];
#define G3_LOAD(B) do { _Pragma("unroll") for (int mm = 0; mm < 2; ++mm) { const size_t off_ = (size_t)(row0 + ((B) >> 1) * HALF + (2 * ((B) & 1) + mm) * 16) * DM + col0; \
            _Pragma("unroll") for (int bj = 0; bj < 2; ++bj) _Pragma("unroll") for (int n = 0; n < 2; ++n) xv[(B) & 1][mm][bj][n] = __builtin_nontemporal_load((const f32x4*)(x + off_ + bj * HALF + n * 16)); } } while (0)
#define G3_STORE(B) do { _Pragma("unroll") for (int mm = 0; mm < 2; ++mm) { const size_t off_ = (size_t)(row0 + ((B) >> 1) * HALF + (2 * ((B) & 1) + mm) * 16) * DM + col0; \
            _Pragma("unroll") for (int bj = 0; bj < 2; ++bj) _Pragma("unroll") for (int n = 0; n < 2; ++n) \
                __builtin_nontemporal_store(xv[(B) & 1][mm][bj][n] + acc[(B) >> 1][bj][2 * ((B) & 1) + mm][n], (f32x4*)(out + off_ + bj * HALF + n * 16)); } } while (0)
        G3_LOAD(0); G3_LOAD(1); G3_STORE(0); G3_LOAD(2); G3_STORE(1); G3_LOAD(3); G3_STORE(2); G3_STORE(3);
#undef G3_LOAD
#undef G3_STORE
    }
};
struct EpiNull {
    static constexpr bool PERM = true, AFTER_DRAIN = false, KHOOK = false;
    __device__ __forceinline__ void operator()(const f32x4 (&acc)[2][2][4][2], const Unit& u, int wr, int wc, int fr, int fq) const {
#pragma unroll
        for (int ai = 0; ai < 2; ++ai)
#pragma unroll
            for (int bj = 0; bj < 2; ++bj)
#pragma unroll
                for (int m = 0; m < 4; ++m) asm volatile("" :: "v"(acc[ai][bj][m][0]), "v"(acc[ai][bj][m][1]));
    }
};
struct OrderG1 {
    StaticOrder so; int pm0, nkv;
    __device__ void init(int hb, int G, int c) { so.init(HB_ROWS, NIN, G, c); pm0 = hb * (HB_ROWS / BM); nkv = hb == 0 ? (MMEM / BM) * 4 : 0; }
    __device__ bool next(int i, Unit& u) const {
        if (so.next(i, u)) { u.pm += pm0; return true; }
        const long j = (long)i * so.G + so.c - so.nwg; if (j < 0 || j >= nkv) return false;
        u.pm = 256 + (int)(j >> 2); u.pn = 35 + (int)(j & 3); return true;
    }
    __device__ __forceinline__ void a_ready(const Unit&) const {}
    __device__ __forceinline__ void done(const Unit&) const {}
};
}

#define GAS __attribute__((address_space(1)))
#define LAS __attribute__((address_space(3)))
typedef unsigned short bf16;
typedef unsigned v4u __attribute__((ext_vector_type(4)));
typedef float f32x4 __attribute__((ext_vector_type(4)));
typedef short bf16x8 __attribute__((ext_vector_type(8)));
typedef GAS unsigned gu32;
typedef GAS unsigned long long gu64;
#define RLX_AGENT __ATOMIC_RELAXED, __HIP_MEMORY_SCOPE_AGENT
#define LDS_WAIT() asm volatile("s_waitcnt lgkmcnt(0)" ::: "memory")
#define VM_WAIT() asm volatile("s_waitcnt vmcnt(0)" ::: "memory")
__device__ __forceinline__ unsigned long long rt() { return __builtin_amdgcn_s_memrealtime(); }
__device__ __forceinline__ unsigned f2bf(float f) { unsigned u = __builtin_bit_cast(unsigned, f); return (u + 0x7fffu + ((u >> 16) & 1u)) >> 16; }
__device__ __forceinline__ unsigned pk2(float lo, float hi) { return f2bf(lo) | (f2bf(hi) << 16); }

__device__ __forceinline__ int hw_lane() { int l; asm volatile("v_mbcnt_lo_u32_b32 %0, -1, 0\n\tv_mbcnt_hi_u32_b32 %0, -1, %0" : "=v"(l)); return l; }
__device__ __forceinline__ bool hw_thread0(int wave) { return wave == 0 && hw_lane() == 0; }
#define XB_TMO      128
#define XB_XCNT(j)  (256  + 64 * (j))
#define XB_XSUB(j)  (1280 + 64 * (j))
#define XB_XGEN(j)  (2304 + 64 * (j))
#define XB_TOP      3328
#define XB_TOPGEN   3392
#define XCD_BAR_WORDS 3456
#define XB_SPIN_CAP (1u << 18)

__device__ __forceinline__ unsigned xb_ld(unsigned* p)              { return __hip_atomic_load(p, __ATOMIC_RELAXED, __HIP_MEMORY_SCOPE_AGENT); }
__device__ __forceinline__ unsigned xb_add(unsigned* p, unsigned v) { return __hip_atomic_fetch_add(p, v, __ATOMIC_RELAXED, __HIP_MEMORY_SCOPE_AGENT); }
__device__ __forceinline__ unsigned xb_xcc_id() { return (unsigned)__builtin_amdgcn_s_getreg((3 << 11) | 20) & 0xFu; }
#define XB_SPIN(cond, bar) do { unsigned _sp = 0; while (cond) { __builtin_amdgcn_s_sleep(1); \
    if ((++_sp & 255u) == 0u) { if (xb_ld(&(bar)[XB_TMO])) break; if (_sp > XB_SPIN_CAP) { atomicAdd(&(bar)[XB_TMO], 1u); break; } } } } while (0)

struct XcdBarrier {
    unsigned* bar; unsigned x; int wave;
    volatile LAS unsigned* st;
};

__device__ __forceinline__ XcdBarrier xcd_barrier_post(unsigned* bar, volatile LAS unsigned* st, int wave) {
    XcdBarrier b; b.bar = bar; b.x = xb_xcc_id(); b.st = st; b.wave = wave;
    if (hw_thread0(wave)) (void)xb_add(&bar[XB_XCNT(b.x)], 1u);
    return b;
}
__device__ __forceinline__ void xcd_barrier_complete(unsigned* bar, unsigned x, unsigned& nloc, unsigned& nx) {
    const unsigned G = gridDim.x * gridDim.y * gridDim.z;
    unsigned sum, cnt, mine, sp = 0u;
    for (;;) {
        sum = 0u; cnt = 0u; mine = 0u;
#pragma unroll
        for (unsigned j = 0; j < 16; ++j) { const unsigned c = xb_ld(&bar[XB_XCNT(j)]); sum += c; cnt += (c > 0u) ? 1u : 0u; mine = (j == x) ? c : mine; }
        if (sum == G) break;
        __builtin_amdgcn_s_sleep(1);
        if ((++sp & 255u) == 0u) { if (xb_ld(&bar[XB_TMO])) break; if (sp > XB_SPIN_CAP) { atomicAdd(&bar[XB_TMO], 1u); break; } }
    }
    nloc = mine > 0u ? mine : 1u; nx = cnt > 0u ? cnt : 1u;
}

__device__ __forceinline__ void xcd_barrier(const XcdBarrier& b) {
    asm volatile("s_waitcnt vmcnt(0)" ::: "memory");
    __syncthreads();
    if (hw_thread0(b.wave)) {
        unsigned* bar = b.bar;
        __builtin_amdgcn_s_waitcnt(0);
        unsigned nloc = b.st[0], nx = b.st[1];
        if (nloc == 0u) { xcd_barrier_complete(bar, b.x, nloc, nx); b.st[0] = nloc; b.st[1] = nx; }
        const unsigned old = xb_add(&bar[XB_XSUB(b.x)], 1u);
        const unsigned gen = old / nloc;
        if (old + 1u == (gen + 1u) * nloc) {
            __builtin_amdgcn_fence(__ATOMIC_RELEASE, "agent");
            asm volatile("s_waitcnt vmcnt(0)" ::: "memory");
            const unsigned og = xb_add(&bar[XB_TOP], 1u);
            const unsigned tg = og / nx;
            if (og + 1u == (tg + 1u) * nx) xb_add(&bar[XB_TOPGEN], 1u);
            else XB_SPIN(xb_ld(&bar[XB_TOPGEN]) == tg, bar);
            __builtin_amdgcn_fence(__ATOMIC_ACQUIRE, "agent");
            xb_add(&bar[XB_XGEN(b.x)], 1u);
            asm volatile("s_waitcnt vmcnt(0)" ::: "memory");
        } else {
            XB_SPIN(xb_ld(&bar[XB_XGEN(b.x)]) == gen, bar);
            __builtin_amdgcn_fence(__ATOMIC_ACQUIRE, "agent");
            asm volatile("s_waitcnt vmcnt(0)" ::: "memory");
        }
    }
    __syncthreads();
}

__device__ __forceinline__ float wave_sum(float v) {
#pragma unroll
    for (int o = 1; o < 64; o <<= 1) v += __shfl_xor(v, o);
    return v;
}

constexpr int RING_OFF = 0, RING_BYTES = 131072;
constexpr int LDSCTL_OFF = RING_BYTES, MISC_OFF = LDSCTL_OFF + 320;
constexpr int LDS_BYTES = 147456;
constexpr int NWAVES = 8, NTHR = NWAVES * 64;
constexpr int WSCR_OFF = 132096;

__device__ __forceinline__ float bf2f(bf16 h) { return __builtin_bit_cast(float, (unsigned)h << 16); }
__device__ __forceinline__ float sigm_f(float x) { return 1.f / (1.f + __expf(-x)); }
__device__ __forceinline__ int t5_bucket(int d) {
    if (d < 16) return d;
    int b = 16;
    b += d >= 22; b += d >= 30; b += d >= 40; b += d >= 54; b += d >= 73; b += d >= 99; b += d >= 134; b += d >= 182; b += d >= 246; b += d >= 332; b += d >= 450; b += d >= 609; b += d >= 825; b += d >= 1117; b += d >= 1513;
    return b;
}

struct Ctx {
    const float *x, *mem, *norm_w, *w_in, *gate_b, *lnw, *lnb, *sp_w, *sp_b, *bqw, *bkw, *rel_bias, *mem_norm_w, *m_w_kv, *mqw, *mkw, *proj_a, *proj_b, *proj_m, *w_out;
    float* out;
    bf16 *WIN, *PCAT, *WOUT, *WSP, *XN, *PA, *KVM, *OG, *YC, *MRG; float *BIAS, *BIASX, *SS, *MKSS, *LSE, *LNST;
    LAS unsigned char* lds; int tid, lane, wave, G, gtid, T, gwave, NW, xgwave;
};

__device__ __forceinline__ void p0_transpose_item(const float* W, int N, bf16* WT, int ldt, int row_off, int koff, LAS float* scr, int item, int lane) {
    const int nblk = N / 32, kb = item / nblk, nb = item % nblk, k0 = 64 * kb, n0 = 32 * nb;
#pragma unroll 8
    for (int i = 0; i < 32; ++i) { const int kk = 2 * i + (lane >> 5); scr[kk * 33 + (lane & 31)] = W[(size_t)(k0 + kk) * N + n0 + (lane & 31)]; }
    LDS_WAIT(); asm volatile("" ::: "memory");
    const int c = lane & 7;
#pragma unroll
    for (int j = 0; j < 4; ++j) { const int n = (lane >> 3) + 8 * j; const LAS float* s = scr + (8 * c) * 33 + n;
        v4u o; o.x = pk2(s[0 * 33], s[1 * 33]); o.y = pk2(s[2 * 33], s[3 * 33]); o.z = pk2(s[4 * 33], s[5 * 33]); o.w = pk2(s[6 * 33], s[7 * 33]);
        *(GAS v4u*)(WT + (size_t)(row_off + n0 + n) * ldt + koff + k0 + 8 * c) = o; }
    LDS_WAIT(); asm volatile("" ::: "memory");
}
__device__ __forceinline__ void rms_row_to_bf16(const float* xrow, const float* w, bf16* orow, int lane) {
    const GAS f32x4* xr = (const GAS f32x4*)xrow + lane; const GAS f32x4* wr = (const GAS f32x4*)w + lane;
    f32x4 v[4]; float s = 0.f;
#pragma unroll
    for (int j = 0; j < 4; ++j) { v[j] = xr[64 * j]; s += (v[j].x * v[j].x + v[j].y * v[j].y) + (v[j].z * v[j].z + v[j].w * v[j].w); }
    const float rs = rsqrtf(wave_sum(s) * (1.f / DM) + EPS);
    GAS unsigned long long* o8 = (GAS unsigned long long*)orow + lane;
#pragma unroll
    for (int j = 0; j < 4; ++j) { const f32x4 ww = wr[64 * j]; o8[64 * j] = (unsigned long long)pk2(v[j].x * rs * ww.x, v[j].y * rs * ww.y) | ((unsigned long long)pk2(v[j].z * rs * ww.z, v[j].w * rs * ww.w) << 32); }
}
__device__ __forceinline__ void p0_prologue(Ctx& F) {
    LAS float* scr = (LAS float*)(F.lds + RING_OFF + F.wave * 16384);
    constexpr int I_IN = 16 * (NIN / 32), I_KV = 16 * 32, I_PA = 12 * 32, I_PB = 4 * 32, I_PM = 8 * 32, I_WO = 16 * 32;
    constexpr int NITEMS = I_IN + I_KV + I_PA + I_PB + I_PM + I_WO;
    for (int it = F.gwave; it < NITEMS; it += F.NW) {
        int r = it;
        if (r < I_IN) { p0_transpose_item(F.w_in, NIN, F.WIN, DM, 0, 0, scr, r, F.lane); continue; } r -= I_IN;
        if (r < I_KV) { p0_transpose_item(F.m_w_kv, 1024, F.WIN, DM, NIN, 0, scr, r, F.lane); continue; } r -= I_KV;
        if (r < I_PA) { p0_transpose_item(F.proj_a, DM, F.PCAT, KC, 0, 0, scr, r, F.lane); continue; } r -= I_PA;
        if (r < I_PB) { p0_transpose_item(F.proj_b, DM, F.PCAT, KC, 0, 768, scr, r, F.lane); continue; } r -= I_PB;
        if (r < I_PM) { p0_transpose_item(F.proj_m, DM, F.PCAT, KC, 0, 1024, scr, r, F.lane); continue; } r -= I_PM;
        p0_transpose_item(F.w_out, DM, F.WOUT, DM, 0, 0, scr, r, F.lane);
    }
    for (int i = F.gtid; i < 4 * 128 * 128; i += F.T) { const int t = (i >> 7) & 127, s = i & 127; F.WSP[i] = (bf16)(s <= t ? f2bf(F.sp_w[i]) : 0u); }
    for (int i = F.gtid; i < 3 * 4 * 132; i += F.T) { const int g = i / (4 * 132), h = (i / 132) % 4, j = i % 132; const int dil = g == 0 ? 1 : (g == 1 ? 4 : 16);
        F.BIAS[i] = j <= 128 ? F.rel_bias[t5_bucket(j * dil) * 12 + 4 * g + h] : 0.f; }
    for (int i = F.gtid; i < 3 * 4 * 192; i += F.T) { const int g = i / (4 * 192), h = (i / 192) % 4, step = i % 192 - 31; const int dil = g == 0 ? 1 : (g == 1 ? 4 : 16);
        F.BIASX[i] = (step >= 0 && step <= 128) ? F.rel_bias[t5_bucket(step * dil) * 12 + 4 * g + h] * 1.4426950408889634f : -1e30f; }
    for (int m = F.gwave; m < MTOT + MMEM; m += F.NW) {
        if (m < MTOT) rms_row_to_bf16(F.x + (size_t)m * DM, F.norm_w, F.XN + (size_t)m * DM, F.lane);
        else rms_row_to_bf16(F.mem + (size_t)(m - MTOT) * DM, F.mem_norm_w, F.XN + (size_t)m * DM, F.lane);
    }
}

__device__ __forceinline__ void st_lnstat(Ctx& F) {
    for (int r = F.gtid; r < HB_ROWS; r += F.T) {
        float s = 0.f, q = 0.f; for (int b = 0; b < 24; ++b) { s += F.SS[(size_t)r * SS_W + 2 * b]; q += F.SS[(size_t)r * SS_W + 2 * b + 1]; }
        const float mu = s * (1.f / 768.f), var = q * (1.f / 768.f) - mu * mu;
        F.LNST[2 * r] = mu; F.LNST[2 * r + 1] = rsqrtf(fmaxf(var, 0.f) + EPS); }
}
__device__ __forceinline__ void st_mixA(Ctx& F) {
    for (size_t gid = F.gtid; gid < (size_t)HB_ROWS * 768; gid += F.T) {
        const int r = (int)(gid / 768), c = (int)(gid % 768), g = c / 192, t = r & 127, r0 = r - t;
        float acc = 0.f;
        for (int s = 0; s <= t; ++s) { const float gv = bf2f(F.PA[(size_t)(r0 + s) * NIN + C_AV + c]);
            const float vv = (gv - F.LNST[2 * (r0 + s)]) * F.LNST[2 * (r0 + s) + 1] * F.lnw[c] + F.lnb[c];
            acc += bf2f(F.WSP[(g * 128 + t) * 128 + s]) * vv; }
        acc += F.sp_b[g * 128 + t];
        const float u = bf2f(F.PA[(size_t)r * NIN + C_AU + c]), z = bf2f(F.PA[(size_t)r * NIN + C_AZ + c]);
        F.YC[(size_t)r * KC + c] = (bf16)f2bf(u * acc * z); }
}
__device__ __forceinline__ void st_attnB(Ctx& F) {
    const int lane = F.lane;
    for (int w = F.gwave; w < 3 * HB_ROWS * 4; w += F.NW) {
        const int g = w / (HB_ROWS * 4), r = (w / 4) % HB_ROWS, h = w % 4, hh = 4 * g + h, dil = g == 0 ? 1 : (g == 1 ? 4 : 16), t = r % SEQ;
        const float qs = rsqrtf((F.SS[(size_t)r * SS_W + 48 + 2 * hh] + F.SS[(size_t)r * SS_W + 48 + 2 * hh + 1]) * (1.f / 64.f) + EPS);
        const float q = bf2f(F.PA[(size_t)r * NIN + C_BQ + hh * 64 + lane]) * qs * F.bqw[lane] * F.bkw[lane] * 0.125f;
        float m = -1e30f, l = 0.f, o = 0.f;
        for (int j = 0; j <= 128; ++j) { if (t - j * dil < 0) break; const int kr = r - j * dil;
            const float ks = rsqrtf((F.SS[(size_t)kr * SS_W + 72 + 2 * hh] + F.SS[(size_t)kr * SS_W + 72 + 2 * hh + 1]) * (1.f / 64.f) + EPS);
            const float s = wave_sum(q * bf2f(F.PA[(size_t)kr * NIN + C_BK + hh * 64 + lane])) * ks + F.BIAS[(g * 4 + h) * 132 + j];
            const float mn = fmaxf(m, s), a = __expf(m - mn), p = __expf(s - mn);
            l = l * a + p; o = o * a + p * bf2f(F.PA[(size_t)kr * NIN + C_BV + hh * 64 + lane]); m = mn; }
        F.OG[((size_t)g * HB_ROWS + r) * 256 + h * 64 + lane] = (bf16)f2bf(o / l);
        if (lane == 0) F.LSE[((size_t)g * HB_ROWS + r) * 4 + h] = m + __logf(l); }
}
__device__ __forceinline__ void st_mergeB(Ctx& F) {
    for (size_t gid = F.gtid; gid < (size_t)HB_ROWS * 256; gid += F.T) {
        const int r = (int)(gid / 256), c = (int)(gid % 256), h = c / 64;
        const float l0 = F.LSE[((size_t)0 * HB_ROWS + r) * 4 + h], l1 = F.LSE[((size_t)1 * HB_ROWS + r) * 4 + h], l2 = F.LSE[((size_t)2 * HB_ROWS + r) * 4 + h];
        const float mx = fmaxf(l0, fmaxf(l1, l2)), e0 = __expf(l0 - mx), e1 = __expf(l1 - mx), e2 = __expf(l2 - mx), inv = 1.f / (e0 + e1 + e2);
        const float y = (e0 * bf2f(F.OG[((size_t)0 * HB_ROWS + r) * 256 + c]) + e1 * bf2f(F.OG[((size_t)1 * HB_ROWS + r) * 256 + c]) + e2 * bf2f(F.OG[((size_t)2 * HB_ROWS + r) * 256 + c])) * inv;
        F.YC[(size_t)r * KC + 768 + c] = (bf16)f2bf(y * bf2f(F.PA[(size_t)r * NIN + C_BZ + c])); }
}
__device__ __forceinline__ void st_attnM(Ctx& F, int row_base) {
    const int lane = F.lane;
    for (int w = F.gwave; w < HB_ROWS * 4; w += F.NW) {
        const int r = w / 4, h = w % 4, b = (row_base + r) / SEQ;
        float qq = 0.f; for (int i = 0; i < 4; ++i) qq += F.SS[(size_t)r * SS_W + 96 + 4 * h + i];
        const float qs = rsqrtf(qq * (1.f / 128.f) + EPS) * 0.08838834764831845f;
        const float q0 = bf2f(F.PA[(size_t)r * NIN + C_MQ + h * 128 + lane]) * qs * F.mqw[lane] * F.mkw[lane], q1 = bf2f(F.PA[(size_t)r * NIN + C_MQ + h * 128 + 64 + lane]) * qs * F.mqw[64 + lane] * F.mkw[64 + lane];
        float m = -1e30f, l = 0.f, o0 = 0.f, o1 = 0.f;
        for (int j = 0; j < MEML; ++j) { const size_t kr = (size_t)b * MEML + j;
            float kk = 0.f; for (int i = 0; i < 4; ++i) kk += F.MKSS[kr * 16 + 4 * h + i];
            const float ks = rsqrtf(kk * (1.f / 128.f) + EPS);
            const float s = wave_sum(q0 * bf2f(F.KVM[kr * 1024 + h * 128 + lane]) + q1 * bf2f(F.KVM[kr * 1024 + h * 128 + 64 + lane])) * ks;
            const float mn = fmaxf(m, s), a = __expf(m - mn), p = __expf(s - mn);
            l = l * a + p; o0 = o0 * a + p * bf2f(F.KVM[kr * 1024 + 512 + h * 128 + lane]); o1 = o1 * a + p * bf2f(F.KVM[kr * 1024 + 512 + h * 128 + 64 + lane]); m = mn; }
        F.YC[(size_t)r * KC + 1024 + h * 128 + lane] = (bf16)f2bf(o0 / l * bf2f(F.PA[(size_t)r * NIN + C_MZ + h * 128 + lane]));
        F.YC[(size_t)r * KC + 1024 + h * 128 + 64 + lane] = (bf16)f2bf(o1 / l * bf2f(F.PA[(size_t)r * NIN + C_MZ + h * 128 + 64 + lane])); }
}

typedef float f32x16 __attribute__((ext_vector_type(16)));
typedef short s16x4 __attribute__((ext_vector_type(4)));
__device__ __forceinline__ int crow(int r, int hi) { return (r & 3) + 8 * (r >> 2) + 4 * hi; }
__device__ __forceinline__ unsigned cvtpk(float lo, float hi) { return pg8::cvt_pk_bf16(lo, hi); }
__device__ __forceinline__ s16x4 vtr(const LAS unsigned char* p) { typedef short v4i16_t __attribute__((ext_vector_type(4))); return __builtin_bit_cast(s16x4, __builtin_amdgcn_ds_read_tr16_b64_v4i16((LAS v4i16_t*)p)); }
__device__ __forceinline__ float bflo(unsigned w) { return __uint_as_float(w << 16); }
__device__ __forceinline__ float bfhi(unsigned w) { return __uint_as_float(w & 0xffff0000u); }
constexpr float LOG2E = 1.4426950408889634f, LN2 = 0.6931471805599453f;
constexpr int NBX = 192;

__device__ __forceinline__ void st_attnB_mfma(Ctx& F) {
    const int lane = hw_lane(), r32 = lane & 31, hi = lane >> 5;
    LAS unsigned char* wl = F.lds + RING_OFF + F.wave * 16384;
    LAS float* btab = (LAS float*)(wl + 8192); LAS float* kst = (LAS float*)(wl + 9216);
    for (int it = F.xgwave; it < 3 * 16 * 4 * 64; it += F.NW) {
        const int blk = it & 63, h = (it >> 6) & 3, gb = it >> 8, b = gb & 15, g = gb >> 4, hh = 4 * g + h;
        const int dil = g == 0 ? 1 : (g == 1 ? 4 : 16), nqb = 64 / dil, res = blk / nqb, q0 = (blk % nqb) * 32;
        const int rbase = b * SEQ + res;
        for (int i = lane; i < NBX; i += 64) btab[i] = F.BIASX[(g * 4 + h) * NBX + i];
        const size_t qrow = (size_t)(rbase + (q0 + r32) * dil);
        const float qs = rsqrtf((F.SS[qrow * SS_W + 48 + 2 * hh] + F.SS[qrow * SS_W + 48 + 2 * hh + 1]) * (1.f / 64.f) + EPS) * (0.125f * LOG2E);
        bf16x8 qf[4];
#pragma unroll
        for (int d0 = 0; d0 < 4; ++d0) { const int dd = 16 * d0 + 8 * hi;
            const v4u raw = *(const v4u*)(F.PA + qrow * NIN + C_BQ + hh * 64 + dd);
            const f32x4 wa = *(const f32x4*)(F.bqw + dd), wb = *(const f32x4*)(F.bqw + dd + 4), ka = *(const f32x4*)(F.bkw + dd), kb = *(const f32x4*)(F.bkw + dd + 4);
            v4u o;
            o.x = cvtpk(bflo(raw.x) * qs * wa.x * ka.x, bfhi(raw.x) * qs * wa.y * ka.y); o.y = cvtpk(bflo(raw.y) * qs * wa.z * ka.z, bfhi(raw.y) * qs * wa.w * ka.w);
            o.z = cvtpk(bflo(raw.z) * qs * wb.x * kb.x, bfhi(raw.z) * qs * wb.y * kb.y); o.w = cvtpk(bflo(raw.w) * qs * wb.z * kb.z, bfhi(raw.w) * qs * wb.w * kb.w);
            qf[d0] = __builtin_bit_cast(bf16x8, o); }
        float mrun = -1e30f, lrun = 0.f; f32x16 o0 = {}, o1 = {};
        for (int k0 = (q0 >= 128 ? q0 - 128 : 0); k0 <= q0; k0 += 32) {
            const size_t krow = (size_t)(rbase + (k0 + r32) * dil);
            bf16x8 kf[4];
#pragma unroll
            for (int d0 = 0; d0 < 4; ++d0) kf[d0] = *(const bf16x8*)(F.PA + krow * NIN + C_BK + hh * 64 + 16 * d0 + 8 * hi);
            const float ksv = rsqrtf((F.SS[krow * SS_W + 72 + 2 * hh] + F.SS[krow * SS_W + 72 + 2 * hh + 1]) * (1.f / 64.f) + EPS);
            v4u vr[4];
#pragma unroll
            for (int i = 0; i < 4; ++i) vr[i] = *(const v4u*)(F.PA + (size_t)(rbase + (k0 + 8 * i + (lane >> 3)) * dil) * NIN + C_BV + hh * 64 + 8 * (lane & 7));
#pragma unroll
            for (int i = 0; i < 4; ++i) *(LAS v4u*)(wl + (2 * i + ((lane & 7) >> 2)) * 512 + (lane >> 3) * 64 + (lane & 3) * 16) = vr[i];
            if (lane < 32) kst[r32] = ksv;
            f32x16 st = {};
#pragma unroll
            for (int d0 = 0; d0 < 4; ++d0) st = __builtin_amdgcn_mfma_f32_32x32x16_bf16(kf[d0], qf[d0], st, 0, 0, 0);
            const int bidx = (q0 + r32) - k0 + 31 - 4 * hi;
            float tmax = -1e30f;
#pragma unroll
            for (int i = 0; i < 4; ++i) { const f32x4 kk = *(const LAS f32x4*)(kst + 8 * i + 4 * hi);
#pragma unroll
                for (int j = 0; j < 4; ++j) { const float s = st[4 * i + j] * kk[j] + btab[bidx - 8 * i - j]; st[4 * i + j] = s; tmax = fmaxf(tmax, s); } }
            tmax = fmaxf(tmax, __shfl_xor(tmax, 32));
            const float mnew = fmaxf(mrun, tmax), alpha = __builtin_amdgcn_exp2f(mrun - mnew); mrun = mnew;
            float psum = 0.f;
#pragma unroll
            for (int r = 0; r < 16; ++r) { st[r] = __builtin_amdgcn_exp2f(st[r] - mnew); psum += st[r]; }
            lrun = lrun * alpha + psum;
#pragma unroll
            for (int r = 0; r < 16; ++r) { o0[r] *= alpha; o1[r] *= alpha; }
            v4u p0, p1;
            p0.x = cvtpk(st[0], st[1]); p0.y = cvtpk(st[2], st[3]); p0.z = cvtpk(st[4], st[5]); p0.w = cvtpk(st[6], st[7]);
            p1.x = cvtpk(st[8], st[9]); p1.y = cvtpk(st[10], st[11]); p1.z = cvtpk(st[12], st[13]); p1.w = cvtpk(st[14], st[15]);
            const LAS unsigned char* vb = wl + (4 * hi + ((lane & 15) >> 2)) * 64 + ((lane >> 4) & 1) * 32 + (lane & 3) * 8;
#pragma unroll
            for (int s = 0; s < 2; ++s) { const bf16x8 pf = __builtin_bit_cast(bf16x8, s == 0 ? p0 : p1);
                { const s16x4 a = vtr(vb + (2 * s) * 1024), c = vtr(vb + (2 * s + 1) * 1024); const bf16x8 vf = {a[0], a[1], a[2], a[3], c[0], c[1], c[2], c[3]};
                  o0 = __builtin_amdgcn_mfma_f32_32x32x16_bf16(vf, pf, o0, 0, 0, 0); }
                { const s16x4 a = vtr(vb + (2 * s) * 1024 + 512), c = vtr(vb + (2 * s + 1) * 1024 + 512); const bf16x8 vf = {a[0], a[1], a[2], a[3], c[0], c[1], c[2], c[3]};
                  o1 = __builtin_amdgcn_mfma_f32_32x32x16_bf16(vf, pf, o1, 0, 0, 0); } }
        }
        const float ltot = lrun + __shfl_xor(lrun, 32), inv = 1.f / ltot;
        bf16* orow = F.OG + ((size_t)g * HB_ROWS + qrow) * 256 + h * 64 + 4 * hi;
        typedef unsigned u32x2v __attribute__((ext_vector_type(2)));
#pragma unroll
        for (int i = 0; i < 4; ++i) { u32x2v w0, w1; w0.x = cvtpk(o0[4 * i] * inv, o0[4 * i + 1] * inv); w0.y = cvtpk(o0[4 * i + 2] * inv, o0[4 * i + 3] * inv);
            w1.x = cvtpk(o1[4 * i] * inv, o1[4 * i + 1] * inv); w1.y = cvtpk(o1[4 * i + 2] * inv, o1[4 * i + 3] * inv);
            *(u32x2v*)(orow + 8 * i) = w0; *(u32x2v*)(orow + 32 + 8 * i) = w1; }
        if (hi == 0) F.LSE[((size_t)g * HB_ROWS + qrow) * 4 + h] = (mrun + __log2f(ltot)) * LN2;
    }
}

__device__ __forceinline__ void st_attnM_mfma(Ctx& F, int hb) {
    const int lane = hw_lane(), r32 = lane & 31, hi = lane >> 5;
    LAS unsigned char* wl = F.lds + RING_OFF + F.wave * 16384;
    LAS float* kst = (LAS float*)(wl + 9216);
    typedef unsigned u32x2v __attribute__((ext_vector_type(2)));
    for (int it = F.xgwave; it < 16 * 64 * 4; it += F.NW) {
        const int h = it & 3, qb = (it >> 2) & 63, b = it >> 8;
        const size_t qrow = (size_t)(b * SEQ + qb * 32 + r32); const size_t kbase = (size_t)(hb * 16 + b) * MEML;
        const float qs = rsqrtf(((F.SS[qrow * SS_W + 96 + 4 * h] + F.SS[qrow * SS_W + 96 + 4 * h + 1]) + (F.SS[qrow * SS_W + 96 + 4 * h + 2] + F.SS[qrow * SS_W + 96 + 4 * h + 3])) * (1.f / 128.f) + EPS) * (0.08838834764831845f * LOG2E);
        bf16x8 qf[8];
#pragma unroll
        for (int d0 = 0; d0 < 8; ++d0) { const int dd = 16 * d0 + 8 * hi;
            const v4u raw = *(const v4u*)(F.PA + qrow * NIN + C_MQ + h * 128 + dd);
            const f32x4 wa = *(const f32x4*)(F.mqw + dd), wb = *(const f32x4*)(F.mqw + dd + 4), ka = *(const f32x4*)(F.mkw + dd), kb = *(const f32x4*)(F.mkw + dd + 4);
            v4u o;
            o.x = cvtpk(bflo(raw.x) * qs * wa.x * ka.x, bfhi(raw.x) * qs * wa.y * ka.y); o.y = cvtpk(bflo(raw.y) * qs * wa.z * ka.z, bfhi(raw.y) * qs * wa.w * ka.w);
            o.z = cvtpk(bflo(raw.z) * qs * wb.x * kb.x, bfhi(raw.z) * qs * wb.y * kb.y); o.w = cvtpk(bflo(raw.w) * qs * wb.z * kb.z, bfhi(raw.w) * qs * wb.w * kb.w);
            qf[d0] = __builtin_bit_cast(bf16x8, o); }
        float mrun = -1e30f, lrun = 0.f; f32x16 o0 = {}, o1 = {}, o2 = {}, o3 = {};
        for (int k0 = 0; k0 < MEML; k0 += 32) {
            const size_t krow = kbase + k0 + r32;
            bf16x8 kf[8];
#pragma unroll
            for (int d0 = 0; d0 < 8; ++d0) kf[d0] = *(const bf16x8*)(F.KVM + krow * 1024 + h * 128 + 16 * d0 + 8 * hi);
            const float ksv = rsqrtf(((F.MKSS[krow * 16 + 4 * h] + F.MKSS[krow * 16 + 4 * h + 1]) + (F.MKSS[krow * 16 + 4 * h + 2] + F.MKSS[krow * 16 + 4 * h + 3])) * (1.f / 128.f) + EPS);
#pragma unroll
            for (int i = 0; i < 8; ++i) { const v4u vr = *(const v4u*)(F.KVM + (kbase + k0 + 4 * i + (lane >> 4)) * 1024 + 512 + h * 128 + 8 * (lane & 15));
                *(LAS v4u*)(wl + ((i >> 1) * 4 + ((lane & 15) >> 2)) * 512 + (4 * (i & 1) + (lane >> 4)) * 64 + (lane & 3) * 16) = vr; }
            if (lane < 32) kst[r32] = ksv;
            f32x16 st = {};
#pragma unroll
            for (int d0 = 0; d0 < 8; ++d0) st = __builtin_amdgcn_mfma_f32_32x32x16_bf16(kf[d0], qf[d0], st, 0, 0, 0);
            float tmax = -1e30f;
#pragma unroll
            for (int i = 0; i < 4; ++i) { const f32x4 kk = *(const LAS f32x4*)(kst + 8 * i + 4 * hi);
#pragma unroll
                for (int j = 0; j < 4; ++j) { const float s = st[4 * i + j] * kk[j]; st[4 * i + j] = s; tmax = fmaxf(tmax, s); } }
            tmax = fmaxf(tmax, __shfl_xor(tmax, 32));
            const float mnew = fmaxf(mrun, tmax), alpha = __builtin_amdgcn_exp2f(mrun - mnew); mrun = mnew;
            float psum = 0.f;
#pragma unroll
            for (int r = 0; r < 16; ++r) { st[r] = __builtin_amdgcn_exp2f(st[r] - mnew); psum += st[r]; }
            lrun = lrun * alpha + psum;
#pragma unroll
            for (int r = 0; r < 16; ++r) { o0[r] *= alpha; o1[r] *= alpha; o2[r] *= alpha; o3[r] *= alpha; }
            v4u p0, p1;
            p0.x = cvtpk(st[0], st[1]); p0.y = cvtpk(st[2], st[3]); p0.z = cvtpk(st[4], st[5]); p0.w = cvtpk(st[6], st[7]);
            p1.x = cvtpk(st[8], st[9]); p1.y = cvtpk(st[10], st[11]); p1.z = cvtpk(st[12], st[13]); p1.w = cvtpk(st[14], st[15]);
            const LAS unsigned char* vb = wl + (4 * hi + ((lane & 15) >> 2)) * 64 + ((lane >> 4) & 1) * 32 + (lane & 3) * 8;
#define AM_PV(OX, DB) do { _Pragma("unroll") for (int s = 0; s < 2; ++s) { const bf16x8 pf = __builtin_bit_cast(bf16x8, s == 0 ? p0 : p1); \
                const s16x4 a = vtr(vb + (2 * s) * 2048 + (DB) * 512), c = vtr(vb + (2 * s + 1) * 2048 + (DB) * 512); const bf16x8 vf = {a[0], a[1], a[2], a[3], c[0], c[1], c[2], c[3]}; \
                OX = __builtin_amdgcn_mfma_f32_32x32x16_bf16(vf, pf, OX, 0, 0, 0); } } while (0)
            AM_PV(o0, 0); AM_PV(o1, 1); AM_PV(o2, 2); AM_PV(o3, 3);
#undef AM_PV
        }
        const float ltot = lrun + __shfl_xor(lrun, 32), inv = 1.f / ltot;
        const bf16* zrow = F.PA + qrow * NIN + C_MZ + h * 128 + 4 * hi; bf16* yrow = F.YC + qrow * KC + 1024 + h * 128 + 4 * hi;
#define AM_ST(OX, DB) do { _Pragma("unroll") for (int i = 0; i < 4; ++i) { const u32x2v z = *(const u32x2v*)(zrow + (DB) * 32 + 8 * i); u32x2v w; \
            w.x = cvtpk(OX[4 * i] * inv * bflo(z.x), OX[4 * i + 1] * inv * bfhi(z.x)); w.y = cvtpk(OX[4 * i + 2] * inv * bflo(z.y), OX[4 * i + 3] * inv * bfhi(z.y)); \
            *(u32x2v*)(yrow + (DB) * 32 + 8 * i) = w; } } while (0)
        AM_ST(o0, 0); AM_ST(o1, 1); AM_ST(o2, 2); AM_ST(o3, 3);
#undef AM_ST
    }
}

__device__ __forceinline__ void st_mixA_mfma(Ctx& F) {
    const int lane = hw_lane(), r32 = lane & 31, hi = lane >> 5, tid = F.wave * 64 + lane;
    LAS unsigned char* wl = F.lds + RING_OFF + F.wave * 16384;
    typedef float f32x2v __attribute__((ext_vector_type(2))); typedef unsigned u32x2v __attribute__((ext_vector_type(2)));
    LAS f32x2v* tab = (LAS f32x2v*)(F.lds + WSCR_OFF + 8192);
    const int g = F.wave >> 1, ch = lane & 3;
    bf16x8 wf[20];
    { const bf16* wrow = F.WSP + (size_t)(g * 128 + r32) * 128 + 8 * hi; int n = 0;
#pragma unroll
      for (int tb = 0; tb < 4; ++tb)
#pragma unroll
          for (int ks = 0; ks < 2 * (tb + 1); ++ks) wf[n++] = *(const bf16x8*)(wrow + (size_t)tb * 32 * 128 + 16 * ks); }
    for (int unit = blockIdx.x; unit < HB_ROWS / 128; unit += F.G) {
        const int rowbase = unit * 128;
        { const int row = tid >> 2, part = tid & 3; const float* sp = F.SS + (size_t)(rowbase + row) * SS_W + 12 * part; float s = 0.f, q = 0.f;
#pragma unroll
          for (int k = 0; k < 6; ++k) { s += sp[2 * k]; q += sp[2 * k + 1]; }
          s += __shfl_xor(s, 1); s += __shfl_xor(s, 2); q += __shfl_xor(q, 1); q += __shfl_xor(q, 2);
          const float mu = s * (1.f / 768.f), var = q * (1.f / 768.f) - mu * mu;
          if (part == 0) tab[row] = (f32x2v){mu, rsqrtf(fmaxf(var, 0.f) + EPS)}; }
        __syncthreads();
#pragma unroll 1
        for (int cbi = 0; cbi < 3; ++cbi) {
            const int c0 = g * 192 + ((F.wave & 1) * 3 + cbi) * 32;
            v4u raw[8];
#pragma unroll
            for (int i = 0; i < 8; ++i) raw[i] = *(const v4u*)(F.PA + (size_t)(rowbase + (lane >> 2) + 16 * i) * NIN + C_AV + c0 + 8 * ch);
            const f32x4 w0 = *(const f32x4*)(F.lnw + c0 + 8 * ch), w1 = *(const f32x4*)(F.lnw + c0 + 8 * ch + 4), b0 = *(const f32x4*)(F.lnb + c0 + 8 * ch), b1 = *(const f32x4*)(F.lnb + c0 + 8 * ch + 4);
#pragma unroll
            for (int i = 0; i < 8; ++i) { const int s = (lane >> 2) + 16 * i; const f32x2v st = tab[s]; const v4u rw = raw[i]; v4u o;
                o.x = cvtpk((bflo(rw.x) - st.x) * st.y * w0.x + b0.x, (bfhi(rw.x) - st.x) * st.y * w0.y + b0.y); o.y = cvtpk((bflo(rw.y) - st.x) * st.y * w0.z + b0.z, (bfhi(rw.y) - st.x) * st.y * w0.w + b0.w);
                o.z = cvtpk((bflo(rw.z) - st.x) * st.y * w1.x + b1.x, (bfhi(rw.z) - st.x) * st.y * w1.y + b1.y); o.w = cvtpk((bflo(rw.w) - st.x) * st.y * w1.z + b1.z, (bfhi(rw.w) - st.x) * st.y * w1.w + b1.w);
                *(LAS v4u*)(wl + (s >> 3) * 512 + (s & 7) * 64 + ch * 16) = o; }
            u32x2v uu[1][4], zz[1][4];
#define MA_LDUZ(TB) do { const size_t row_ = (size_t)(rowbase + 32 * (TB) + r32); _Pragma("unroll") for (int i = 0; i < 4; ++i) { \
                uu[0][i] = *(const u32x2v*)(F.PA + row_ * NIN + C_AU + c0 + 4 * hi + 8 * i); zz[0][i] = *(const u32x2v*)(F.PA + row_ * NIN + C_AZ + c0 + 4 * hi + 8 * i); } } while (0)
            const LAS unsigned char* vb = wl + hi * 512 + ((lane & 15) >> 2) * 64 + ((lane >> 4) & 1) * 32 + (lane & 3) * 8;
            int n = 0;
#pragma unroll
            for (int tb = 0; tb < 4; ++tb) { f32x16 acc = {};
                MA_LDUZ(tb);
#pragma unroll
                for (int ks = 0; ks < 2 * (tb + 1); ++ks) { const s16x4 a = vtr(vb + ks * 1024), c = vtr(vb + ks * 1024 + 256); const bf16x8 af = {a[0], a[1], a[2], a[3], c[0], c[1], c[2], c[3]};
                    acc = __builtin_amdgcn_mfma_f32_32x32x16_bf16(af, wf[n++], acc, 0, 0, 0); }
                const int t = 32 * tb + r32; const size_t row = (size_t)(rowbase + t); const float sb = F.sp_b[g * 128 + t];
                bf16* yp = F.YC + row * KC + c0 + 4 * hi;
#pragma unroll
                for (int i = 0; i < 4; ++i) { const u32x2v u = uu[0][i], z = zz[0][i]; u32x2v w;
                    w.x = cvtpk(bflo(u.x) * (acc[4 * i] + sb) * bflo(z.x), bfhi(u.x) * (acc[4 * i + 1] + sb) * bfhi(z.x)); w.y = cvtpk(bflo(u.y) * (acc[4 * i + 2] + sb) * bflo(z.y), bfhi(u.y) * (acc[4 * i + 3] + sb) * bfhi(z.y));
                    *(u32x2v*)(yp + 8 * i) = w; } }
#undef MA_LDUZ
        }
        __syncthreads();
    }
}

__device__ __forceinline__ void st_mergeB_vec(Ctx& F) {
    for (int gid = F.gtid; gid < HB_ROWS * 32; gid += F.T) {
        const int r = gid >> 5, c8 = (gid & 31) * 8, h = c8 >> 6;
        const float l0 = F.LSE[((size_t)0 * HB_ROWS + r) * 4 + h], l1 = F.LSE[((size_t)1 * HB_ROWS + r) * 4 + h], l2 = F.LSE[((size_t)2 * HB_ROWS + r) * 4 + h];
        const float mx = fmaxf(l0, fmaxf(l1, l2)); float e0 = __expf(l0 - mx), e1 = __expf(l1 - mx), e2 = __expf(l2 - mx); const float inv = 1.f / (e0 + e1 + e2); e0 *= inv; e1 *= inv; e2 *= inv;
        const v4u a = *(const v4u*)(F.OG + ((size_t)0 * HB_ROWS + r) * 256 + c8), b = *(const v4u*)(F.OG + ((size_t)1 * HB_ROWS + r) * 256 + c8), c = *(const v4u*)(F.OG + ((size_t)2 * HB_ROWS + r) * 256 + c8);
        const v4u z = *(const v4u*)(F.PA + (size_t)r * NIN + C_BZ + c8); v4u o;
#define MB_1(X) X = pk2((e0 * bflo(a.X) + e1 * bflo(b.X) + e2 * bflo(c.X)) * bflo(z.X), (e0 * bfhi(a.X) + e1 * bfhi(b.X) + e2 * bfhi(c.X)) * bfhi(z.X))
        o.MB_1(x); o.MB_1(y); o.MB_1(z); o.MB_1(w);
#undef MB_1
        *(v4u*)(F.YC + (size_t)r * KC + 768 + c8) = o; }
}

__device__ __forceinline__ void dma16(const void* gsrc, LAS unsigned char* ldst) { __builtin_amdgcn_global_load_lds((const unsigned*)gsrc, (LAS unsigned*)ldst, 16, 0, 0); }
#define VM_WAIT0() asm volatile("s_waitcnt vmcnt(0)" ::: "memory")

__device__ __forceinline__ void st_attnM_v2(Ctx& F, int hb) {
    const int lane = hw_lane(), r32 = lane & 31, hi = lane >> 5;
    LAS unsigned char* wl = F.lds + RING_OFF + F.wave * 16384;
    LAS float* kst = (LAS float*)(F.lds + WSCR_OFF + F.wave * 1024);
    typedef unsigned u32x2v __attribute__((ext_vector_type(2)));
    const int vkey = (lane & 31) >> 2, vd = (lane >> 5) * 32 + (lane & 3) * 8;
    for (int it = F.xgwave; it < 16 * 64 * 4; it += F.NW) {
        const int h = it & 3, qb = (it >> 2) & 63, b = it >> 8;
        const size_t qrow = (size_t)(b * SEQ + qb * 32 + r32); const size_t kbase = (size_t)(hb * 16 + b) * MEML;
        const bf16* kp = F.KVM + (kbase + r32) * 1024 + h * 128 + 8 * hi;
        const float* ksp = F.MKSS + (kbase + r32) * 16 + 4 * h;
        const bf16* vp = F.KVM + (kbase + vkey) * 1024 + 512 + h * 128 + vd;
        bf16x8 kfn[8]; f32x4 ksn;
#define AM_ISSUE(T, STG) do { _Pragma("unroll") for (int d0 = 0; d0 < 8; ++d0) kfn[d0] = *(const bf16x8*)(kp + (size_t)(T) * 32 * 1024 + 16 * d0); ksn = *(const f32x4*)(ksp + (size_t)(T) * 32 * 16); \
        _Pragma("unroll") for (int j = 0; j < 8; ++j) dma16(vp + ((size_t)(T) * 32 + 8 * (j >> 1)) * 1024 + 64 * (j & 1), wl + (STG) * 8192 + j * 1024); } while (0)
        AM_ISSUE(0, 0);
        const float qs = rsqrtf(((F.SS[qrow * SS_W + 96 + 4 * h] + F.SS[qrow * SS_W + 96 + 4 * h + 1]) + (F.SS[qrow * SS_W + 96 + 4 * h + 2] + F.SS[qrow * SS_W + 96 + 4 * h + 3])) * (1.f / 128.f) + EPS) * (0.08838834764831845f * LOG2E);
        bf16x8 qf[8];
#pragma unroll
        for (int d0 = 0; d0 < 8; ++d0) { const int dd = 16 * d0 + 8 * hi;
            const v4u raw = *(const v4u*)(F.PA + qrow * NIN + C_MQ + h * 128 + dd);
            const f32x4 wa = *(const f32x4*)(F.mqw + dd), wb = *(const f32x4*)(F.mqw + dd + 4), ka = *(const f32x4*)(F.mkw + dd), kb = *(const f32x4*)(F.mkw + dd + 4);
            v4u o;
            o.x = cvtpk(bflo(raw.x) * qs * wa.x * ka.x, bfhi(raw.x) * qs * wa.y * ka.y); o.y = cvtpk(bflo(raw.y) * qs * wa.z * ka.z, bfhi(raw.y) * qs * wa.w * ka.w);
            o.z = cvtpk(bflo(raw.z) * qs * wb.x * kb.x, bfhi(raw.z) * qs * wb.y * kb.y); o.w = cvtpk(bflo(raw.w) * qs * wb.z * kb.z, bfhi(raw.w) * qs * wb.w * kb.w);
            qf[d0] = __builtin_bit_cast(bf16x8, o); }
        float mrun = -1e30f, lrun = 0.f; f32x16 o0 = {}, o1 = {}, o2 = {}, o3 = {};
        for (int t = 0; t < MEML / 32; ++t) {
            VM_WAIT0();
            bf16x8 kf[8];
#pragma unroll
            for (int d0 = 0; d0 < 8; ++d0) kf[d0] = kfn[d0];
            const float ksv = rsqrtf(((ksn[0] + ksn[1]) + (ksn[2] + ksn[3])) * (1.f / 128.f) + EPS);
            if (t + 1 < MEML / 32) AM_ISSUE(t + 1, (t + 1) & 1);
            if (lane < 32) kst[r32] = ksv;
            f32x16 st = {};
#pragma unroll
            for (int d0 = 0; d0 < 8; ++d0) st = __builtin_amdgcn_mfma_f32_32x32x16_bf16(kf[d0], qf[d0], st, 0, 0, 0);
            float tmax = -1e30f;
#pragma unroll
            for (int i = 0; i < 4; ++i) { const f32x4 kk = *(const LAS f32x4*)(kst + 8 * i + 4 * hi);
#pragma unroll
                for (int j = 0; j < 4; ++j) { const float s = st[4 * i + j] * kk[j]; st[4 * i + j] = s; tmax = fmaxf(tmax, s); } }
            tmax = fmaxf(tmax, __shfl_xor(tmax, 32));
            const float mnew = fmaxf(mrun, tmax), alpha = __builtin_amdgcn_exp2f(mrun - mnew); mrun = mnew;
            float psum = 0.f;
#pragma unroll
            for (int r = 0; r < 16; ++r) { st[r] = __builtin_amdgcn_exp2f(st[r] - mnew); psum += st[r]; }
            lrun = lrun * alpha + psum;
#pragma unroll
            for (int r = 0; r < 16; ++r) { o0[r] *= alpha; o1[r] *= alpha; o2[r] *= alpha; o3[r] *= alpha; }
            v4u p0, p1;
            p0.x = cvtpk(st[0], st[1]); p0.y = cvtpk(st[2], st[3]); p0.z = cvtpk(st[4], st[5]); p0.w = cvtpk(st[6], st[7]);
            p1.x = cvtpk(st[8], st[9]); p1.y = cvtpk(st[10], st[11]); p1.z = cvtpk(st[12], st[13]); p1.w = cvtpk(st[14], st[15]);
            const LAS unsigned char* vb = wl + (t & 1) * 8192 + (4 * hi + ((lane & 15) >> 2)) * 64 + ((lane >> 4) & 1) * 32 + (lane & 3) * 8;
#define AM_PV(OX, DB) do { _Pragma("unroll") for (int s = 0; s < 2; ++s) { const bf16x8 pf = __builtin_bit_cast(bf16x8, s == 0 ? p0 : p1); \
                const s16x4 a = vtr(vb + (2 * s) * 2048 + (DB) * 512), c = vtr(vb + (2 * s + 1) * 2048 + (DB) * 512); const bf16x8 vf = {a[0], a[1], a[2], a[3], c[0], c[1], c[2], c[3]}; \
                OX = __builtin_amdgcn_mfma_f32_32x32x16_bf16(vf, pf, OX, 0, 0, 0); } } while (0)
            AM_PV(o0, 0); AM_PV(o1, 1); AM_PV(o2, 2); AM_PV(o3, 3);
#undef AM_PV
        }
#undef AM_ISSUE
        const float ltot = lrun + __shfl_xor(lrun, 32), inv = 1.f / ltot;
        const bf16* zrow = F.PA + qrow * NIN + C_MZ + h * 128 + 4 * hi; bf16* yrow = F.YC + qrow * KC + 1024 + h * 128 + 4 * hi;
#define AM_ST(OX, DB) do { _Pragma("unroll") for (int i = 0; i < 4; ++i) { const u32x2v z = *(const u32x2v*)(zrow + (DB) * 32 + 8 * i); u32x2v w; \
            w.x = cvtpk(OX[4 * i] * inv * bflo(z.x), OX[4 * i + 1] * inv * bfhi(z.x)); w.y = cvtpk(OX[4 * i + 2] * inv * bflo(z.y), OX[4 * i + 3] * inv * bfhi(z.y)); \
            *(u32x2v*)(yrow + (DB) * 32 + 8 * i) = w; } } while (0)
        AM_ST(o0, 0); AM_ST(o1, 1); AM_ST(o2, 2); AM_ST(o3, 3);
#undef AM_ST
    }
}

__device__ __forceinline__ void st_attnM_v3(Ctx& F, int hb) {
    const int lane = hw_lane(), r32 = lane & 31, hi = lane >> 5;
    LAS unsigned char* kimg = F.lds + RING_OFF; LAS unsigned char* vimg = F.lds + RING_OFF + 65536;
    LAS float* kstab = (LAS float*)(F.lds + WSCR_OFF + 8192);
    typedef unsigned u32x2v __attribute__((ext_vector_type(2)));
    const int vcu = F.xgwave >> 3;
    __syncthreads();
    for (int task = vcu; task < 256; task += F.G) {
        const int bh = task >> 2, b = bh >> 2, h = bh & 3; const size_t kbase = (size_t)(hb * 16 + b) * MEML;
#pragma unroll
        for (int j = 0; j < 8; ++j) { const int p = F.wave * 8 + j, row = 4 * p + (lane >> 4);
            dma16(F.KVM + (kbase + row) * 1024 + h * 128 + 8 * ((lane & 15) ^ (row & 15)), kimg + p * 1024);
            dma16(F.KVM + (kbase + 8 * (p >> 1) + ((lane & 31) >> 2)) * 1024 + 512 + h * 128 + (2 * (p & 1) + (lane >> 5)) * 32 + (lane & 3) * 8, vimg + p * 1024); }
        { const int key = F.wave * 32 + r32; const float* sp = F.MKSS + (kbase + key) * 16 + 4 * h;
          const float ksv = rsqrtf(((sp[0] + sp[1]) + (sp[2] + sp[3])) * (1.f / 128.f) + EPS); if (lane < 32) kstab[key] = ksv; }
        VM_WAIT0(); __syncthreads();
#pragma unroll 1
        for (int qi = 0; qi < 2; ++qi) {
            const int qb = (task & 3) * 16 + F.wave * 2 + qi;
            const size_t qrow = (size_t)(b * SEQ + qb * 32 + r32);
            const float qs = rsqrtf(((F.SS[qrow * SS_W + 96 + 4 * h] + F.SS[qrow * SS_W + 96 + 4 * h + 1]) + (F.SS[qrow * SS_W + 96 + 4 * h + 2] + F.SS[qrow * SS_W + 96 + 4 * h + 3])) * (1.f / 128.f) + EPS) * (0.08838834764831845f * LOG2E);
            bf16x8 qf[8];
#pragma unroll
            for (int d0 = 0; d0 < 8; ++d0) { const int dd = 16 * d0 + 8 * hi;
                const v4u raw = *(const v4u*)(F.PA + qrow * NIN + C_MQ + h * 128 + dd);
                const f32x4 wa = *(const f32x4*)(F.mqw + dd), wb = *(const f32x4*)(F.mqw + dd + 4), ka = *(const f32x4*)(F.mkw + dd), kb = *(const f32x4*)(F.mkw + dd + 4);
                v4u o;
                o.x = cvtpk(bflo(raw.x) * qs * wa.x * ka.x, bfhi(raw.x) * qs * wa.y * ka.y); o.y = cvtpk(bflo(raw.y) * qs * wa.z * ka.z, bfhi(raw.y) * qs * wa.w * ka.w);
                o.z = cvtpk(bflo(raw.z) * qs * wb.x * kb.x, bfhi(raw.z) * qs * wb.y * kb.y); o.w = cvtpk(bflo(raw.w) * qs * wb.z * kb.z, bfhi(raw.w) * qs * wb.w * kb.w);
                qf[d0] = __builtin_bit_cast(bf16x8, o); }
            u32x2v zz[4][4];
#pragma unroll
            for (int db = 0; db < 4; ++db)
#pragma unroll
                for (int i = 0; i < 4; ++i) zz[db][i] = *(const u32x2v*)(F.PA + qrow * NIN + C_MZ + h * 128 + 4 * hi + db * 32 + 8 * i);
            float mrun = -1e30f, lrun = 0.f; f32x16 o0 = {}, o1 = {}, o2 = {}, o3 = {};
            const LAS unsigned char* kb0 = kimg + r32 * 256; const int ksw = r32 & 15;
            const LAS unsigned char* vb0 = vimg + (4 * hi + ((lane & 15) >> 2)) * 64 + ((lane >> 4) & 1) * 32 + (lane & 3) * 8;
#pragma unroll 2
            for (int t = 0; t < MEML / 32; ++t) {
                f32x16 st = {};
#pragma unroll
                for (int d0 = 0; d0 < 8; ++d0) { const bf16x8 kf = *(const LAS bf16x8*)(kb0 + t * 8192 + (((2 * d0 + hi) ^ ksw) * 16)); st = __builtin_amdgcn_mfma_f32_32x32x16_bf16(kf, qf[d0], st, 0, 0, 0); }
                float tmax = -1e30f;
#pragma unroll
                for (int i = 0; i < 4; ++i) { const f32x4 kk = *(const LAS f32x4*)(kstab + 32 * t + 8 * i + 4 * hi);
#pragma unroll
                    for (int j = 0; j < 4; ++j) { const float s = st[4 * i + j] * kk[j]; st[4 * i + j] = s; tmax = fmaxf(tmax, s); } }
                tmax = fmaxf(tmax, __shfl_xor(tmax, 32));
                const float mnew = fmaxf(mrun, tmax), alpha = __builtin_amdgcn_exp2f(mrun - mnew); mrun = mnew;
                float psum = 0.f;
#pragma unroll
                for (int r = 0; r < 16; ++r) { st[r] = __builtin_amdgcn_exp2f(st[r] - mnew); psum += st[r]; }
                lrun = lrun * alpha + psum;
#pragma unroll
                for (int r = 0; r < 16; ++r) { o0[r] *= alpha; o1[r] *= alpha; o2[r] *= alpha; o3[r] *= alpha; }
                v4u p0, p1;
                p0.x = cvtpk(st[0], st[1]); p0.y = cvtpk(st[2], st[3]); p0.z = cvtpk(st[4], st[5]); p0.w = cvtpk(st[6], st[7]);
                p1.x = cvtpk(st[8], st[9]); p1.y = cvtpk(st[10], st[11]); p1.z = cvtpk(st[12], st[13]); p1.w = cvtpk(st[14], st[15]);
                const LAS unsigned char* vb = vb0 + t * 8192;
#define AM_PV(OX, DB) do { _Pragma("unroll") for (int s = 0; s < 2; ++s) { const bf16x8 pf = __builtin_bit_cast(bf16x8, s == 0 ? p0 : p1); \
                    const s16x4 a = vtr(vb + (2 * s) * 2048 + (DB) * 512), c = vtr(vb + (2 * s + 1) * 2048 + (DB) * 512); const bf16x8 vf = {a[0], a[1], a[2], a[3], c[0], c[1], c[2], c[3]}; \
                    OX = __builtin_amdgcn_mfma_f32_32x32x16_bf16(vf, pf, OX, 0, 0, 0); } } while (0)
                AM_PV(o0, 0); AM_PV(o1, 1); AM_PV(o2, 2); AM_PV(o3, 3);
#undef AM_PV
            }
            const float ltot = lrun + __shfl_xor(lrun, 32), inv = 1.f / ltot;
            bf16* yrow = F.YC + qrow * KC + 1024 + h * 128 + 4 * hi;
#define AM_ST(OX, DB) do { _Pragma("unroll") for (int i = 0; i < 4; ++i) { const u32x2v z = zz[DB][i]; u32x2v w; \
                w.x = cvtpk(OX[4 * i] * inv * bflo(z.x), OX[4 * i + 1] * inv * bfhi(z.x)); w.y = cvtpk(OX[4 * i + 2] * inv * bflo(z.y), OX[4 * i + 3] * inv * bfhi(z.y)); \
                *(u32x2v*)(yrow + (DB) * 32 + 8 * i) = w; } } while (0)
            AM_ST(o0, 0); AM_ST(o1, 1); AM_ST(o2, 2); AM_ST(o3, 3);
#undef AM_ST
        }
        __syncthreads();
    }
}

#ifndef G1_STAGGER_TICKS
#define G1_STAGGER_TICKS 0
#endif
#ifndef PROBE_REP
#define PROBE_REP -1
#endif
#define REPS(id) for (int rep_ = 0; rep_ < ((PROBE_REP) == (id) ? 2 : 1); ++rep_)
#ifndef MK_PER_PHASE
#define MK_PER_PHASE 0
#endif
constexpr int NPH_HALF = 5, NPHASES = 1 + 2 * NPH_HALF;
struct Args { const float* in[20]; float* out; unsigned char* ws; int ph_lo, ph_hi; };
__global__ void __launch_bounds__(NTHR, 2) mega_fwd(Args args) {
    extern __shared__ __attribute__((aligned(16))) unsigned char lds_raw[];
    Ctx F;
    F.lds = (LAS unsigned char*)lds_raw;
    F.tid = threadIdx.x; F.lane = F.tid & 63; F.wave = __builtin_amdgcn_readfirstlane(F.tid >> 6);
    F.G = gridDim.x; F.gtid = blockIdx.x * NTHR + F.tid; F.T = F.G * NTHR; F.gwave = blockIdx.x * NWAVES + F.wave; F.NW = F.G * NWAVES;
    { const int bx = blockIdx.x; const int vcu = (F.G % 8 == 0) ? (bx % 8) * (F.G / 8) + bx / 8 : bx; F.xgwave = vcu * NWAVES + F.wave; }
    unsigned char* ws = args.ws;
    F.x = args.in[0]; F.mem = args.in[1]; F.norm_w = args.in[2]; F.w_in = args.in[3]; F.gate_b = args.in[4]; F.lnw = args.in[5]; F.lnb = args.in[6]; F.sp_w = args.in[7];
    F.sp_b = args.in[8]; F.bqw = args.in[9]; F.bkw = args.in[10]; F.rel_bias = args.in[11]; F.mem_norm_w = args.in[12]; F.m_w_kv = args.in[13]; F.mqw = args.in[14]; F.mkw = args.in[15];
    F.proj_a = args.in[16]; F.proj_b = args.in[17]; F.proj_m = args.in[18]; F.w_out = args.in[19]; F.out = args.out;
    F.WIN = (bf16*)(ws + WS_WIN); F.PCAT = (bf16*)(ws + WS_PCAT); F.WOUT = (bf16*)(ws + WS_WOUT); F.WSP = (bf16*)(ws + WS_WSP); F.BIAS = (float*)(ws + WS_BIAS); F.BIASX = (float*)(ws + WS_BIAS + 65536);
    F.XN = (bf16*)(ws + WS_XN); F.PA = (bf16*)(ws + WS_PA); F.KVM = (bf16*)(ws + WS_KVM); F.SS = (float*)(ws + WS_SS); F.MKSS = (float*)(ws + WS_MKSS);
    F.OG = (bf16*)(ws + WS_OG); F.LSE = (float*)(ws + WS_LSE); F.LNST = (float*)(ws + WS_LNST); F.YC = (bf16*)(ws + WS_YC); F.MRG = (bf16*)(ws + WS_MRG);
    for (int u = F.tid; u < (LDS_BYTES - LDSCTL_OFF) / 4; u += NTHR) ((LAS unsigned*)(F.lds + LDSCTL_OFF))[u] = 0u;
    __syncthreads();
    XcdBarrier bar; bar.bar = (unsigned*)(ws + WS_CTL) + CW_BAR; bar.x = 0; bar.st = nullptr; bar.wave = 0;
    if (!MK_PER_PHASE) bar = xcd_barrier_post((unsigned*)(ws + WS_CTL) + CW_BAR, (volatile LAS unsigned*)(F.lds + MISC_OFF) + 8, F.wave);
    const int lo = args.ph_lo, hi = args.ph_hi;
#define IN(k) (lo <= (k) && (k) < hi)
#define SEAM(k) do { if (IN(k) && IN((k) + 1)) xcd_barrier(bar); } while (0)

    if (IN(0)) { REPS(0) p0_prologue(F); } SEAM(0);
#pragma unroll 1
    for (int hb = 0; hb < 2; ++hb) {
        const int pb = 1 + hb * NPH_HALF, row0 = hb * HB_ROWS;
        asm volatile("v_mbcnt_lo_u32_b32 %0, -1, 0\n\tv_mbcnt_hi_u32_b32 %0, -1, %0" : "=v"(F.lane)); F.tid = F.wave * 64 + F.lane; F.gtid = blockIdx.x * NTHR + F.tid;
#if PROBE_REP == 9 || PROBE_REP == 10
        if (IN(pb + 0)) { pg8::Gemm g{F.XN, F.WIN, MTOT + MMEM, NIN + 1024, DM, DM, DM}; pg8::OrderG1 S; S.init(hb, F.G, (int)blockIdx.x);
            typedef pg8::EpiProjT<PROBE_REP - 8> EP; EP E{F.PA, F.KVM, F.SS, F.MKSS, F.gate_b, hb * (HB_ROWS / 256), 0};
            pg8::gemm_phase<EP, pg8::OrderG1, true, true>(F.lds + RING_OFF, g, S, E, F.wave); }
#endif
        if (IN(pb + 0)) REPS(1) {
            pg8::Gemm g{F.XN, F.WIN, MTOT + MMEM, NIN + 1024, DM, DM, DM}; pg8::OrderG1 S; S.init(hb, F.G, (int)blockIdx.x);
#if G1_STAGGER_TICKS
            { const unsigned long long t0 = __builtin_amdgcn_s_memrealtime(), dl = (unsigned long long)((blockIdx.x >> 3) & 31) * G1_STAGGER_TICKS;
              while (__builtin_amdgcn_s_memrealtime() - t0 < dl) __builtin_amdgcn_s_sleep(8); }
#endif
            pg8::EpiProj E{F.PA, F.KVM, F.SS, F.MKSS, F.gate_b, hb * (HB_ROWS / 256), 0};
            pg8::gemm_phase<pg8::EpiProj, pg8::OrderG1, true, true>(F.lds + RING_OFF, g, S, E, F.wave);
        }
#if PROBE_REP == 8
        if (IN(pb + 0)) { pg8::Gemm g{F.XN, F.WIN, MTOT + MMEM, NIN + 1024, DM, DM, DM}; pg8::OrderG1 S; S.init(hb, F.G, (int)blockIdx.x); pg8::EpiNull E{};
            pg8::gemm_phase<pg8::EpiNull, pg8::OrderG1, true, true>(F.lds + RING_OFF, g, S, E, F.wave); }
#endif
        SEAM(pb + 0);
        if (IN(pb + 1)) { REPS(2) st_mixA_mfma(F); REPS(3) st_attnB_mfma(F); REPS(4) st_attnM_v3(F, hb); } SEAM(pb + 1);
        if (IN(pb + 2)) { REPS(5) st_mergeB_vec(F); } SEAM(pb + 2);
        if (IN(pb + 3)) REPS(6) {
            pg8::Gemm g{F.YC, F.PCAT, HB_ROWS, DM, KC, KC, KC}; pg8::StaticOrder S; S.init(HB_ROWS, DM, F.G, (int)blockIdx.x);
            pg8::EpiG2cat E{F.PA, F.MRG};
            pg8::gemm_phase<pg8::EpiG2cat, pg8::StaticOrder, true, true>(F.lds + RING_OFF, g, S, E, F.wave);
        } SEAM(pb + 3);
        if (IN(pb + 4)) REPS(7) {
            pg8::Gemm g{F.MRG, F.WOUT, HB_ROWS, DM, DM, DM, DM}; pg8::StaticOrder S; S.init(HB_ROWS, DM, F.G, (int)blockIdx.x);
            pg8::EpiG3 E{F.x + (size_t)row0 * DM, F.out + (size_t)row0 * DM};
            pg8::gemm_phase<pg8::EpiG3, pg8::StaticOrder, true, true>(F.lds + RING_OFF, g, S, E, F.wave);
        } SEAM(pb + 4);
    }
#undef IN
#undef SEAM
}

extern "C" void kernel_launch(void* const* d_in, const int* in_sizes, int n_in, void* d_out, int out_size, void* d_ws, size_t ws_size, hipStream_t stream) {
    static int grid = 0;
    if (grid == 0) {
        if (n_in != 20 || in_sizes[0] != MTOT * DM || out_size != MTOT * DM || ws_size < WS_END) { fprintf(stderr, "kernel_launch: unexpected shapes (n_in %d, ws %zu); nothing launched\n", n_in, ws_size); grid = -1; return; }
        int dev = 0, cus = 0, per_cu = 0;
        if (hipGetDevice(&dev) != hipSuccess || hipDeviceGetAttribute(&cus, hipDeviceAttributeMultiprocessorCount, dev) != hipSuccess) { grid = -1; return; }
        if (hipFuncSetAttribute((const void*)mega_fwd, hipFuncAttributeMaxDynamicSharedMemorySize, LDS_BYTES) != hipSuccess) { fprintf(stderr, "kernel_launch: hipFuncSetAttribute failed\n"); grid = -1; return; }
        if (hipOccupancyMaxActiveBlocksPerMultiprocessor(&per_cu, (const void*)mega_fwd, NTHR, LDS_BYTES) != hipSuccess || per_cu < 1) { fprintf(stderr, "kernel_launch: occupancy query says %d blocks per CU\n", per_cu); (void)hipGetLastError(); grid = -1; return; }
        grid = cus;
    }
    if (grid < 0) return;
    if (hipMemsetAsync((char*)d_ws + WS_CTL, 0, CTL_ZERO_BYTES, stream) != hipSuccess) return;
    Args a{};
    for (int i = 0; i < 20; ++i) a.in[i] = (const float*)d_in[i];
    a.out = (float*)d_out; a.ws = (unsigned char*)d_ws;
#if MK_PER_PHASE
    for (int p = 0; p < NPHASES; ++p) { a.ph_lo = p; a.ph_hi = p + 1; hipLaunchKernelGGL(mega_fwd, dim3(grid), dim3(NTHR), LDS_BYTES, stream, a); }
#else
    a.ph_lo = 0; a.ph_hi = NPHASES; hipLaunchKernelGGL(mega_fwd, dim3(grid), dim3(NTHR), LDS_BYTES, stream, a);
#endif
}
```

```cpp
#include <hip/hip_runtime.h>
#include <cstdint>
#include <cstdio>

constexpr int DM = 1024, NB = 32, SEQ = 2048, MTOT = NB * SEQ;
constexpr int NIN = 8960, MEML = 256, MMEM = NB * MEML;
constexpr int HB_ROWS = MTOT / 2;
constexpr int C_AU = 0, C_AV = 768, C_AZ = 1536, C_BQ = 2304, C_BK = 3072, C_BV = 3840, C_BZ = 4608, C_MQ = 4864, C_MZ = 5376, C_G = 5888;
constexpr float EPS = 1e-6f;
constexpr int SS_W = 112;
constexpr int PAP = 7424;
constexpr int PA_ROWB = 2 * PAP, PA_GOFF = 2 * C_G;
constexpr int KC = 1536;

constexpr size_t MiB = 1u << 20;
constexpr size_t WS_CTL = 0, CTL_ZERO_BYTES = 256 * 1024, WS_WIN = 2 * MiB, WS_PCAT = 22 * MiB, WS_WOUT = 25 * MiB, WS_WSP = 27 * MiB, WS_BIAS = 27 * MiB + 512 * 1024;
constexpr size_t WS_XN = 32 * MiB, WS_PA = 176 * MiB, WS_KVM = 736 * MiB, WS_SS = 752 * MiB, WS_MKSS = 766 * MiB, WS_OG = 768 * MiB, WS_LSE = 816 * MiB, WS_LNST = 818 * MiB;
constexpr size_t WS_YC = 820 * MiB, WS_MRG = 916 * MiB, WS_END = 980 * MiB;
constexpr int CW_BAR = 4096;

namespace pg8 {
#define PG8_LAS __attribute__((address_space(3)))
typedef unsigned short bf16_t;
typedef short bf16x8 __attribute__((ext_vector_type(8)));
typedef float f32x4 __attribute__((ext_vector_type(4)));
typedef unsigned u32x4 __attribute__((ext_vector_type(4)));
constexpr int BM = 256, BK = 64, HALF = 128, HTB = HALF * BK * 2  , STAGE_BYTES = 8 * HTB, NXCD = 8, WGM = 8;

__host__ __device__ __forceinline__ int lds_byte(int r, int c) { const int st = (r >> 4) * 2 + (c >> 5), rr = r & 15, cc = c & 31, ob = rr * 64 + cc * 2; return st * 1024 + (ob ^ (((ob >> 9) & 1) << 5)); }
__host__ __device__ __forceinline__ void stage_rc(int b, int& R, int& C) { const int st = b / 1024, sb = b % 1024, swz = sb ^ (((sb >> 9) & 1) << 5); R = (st >> 1) * 16 + swz / 64; C = (st & 1) * 32 + (swz % 64) / 2; }
__host__ __device__ __forceinline__ int perm32(int rho) { const int n = rho >> 4, i = rho & 15; return 8 * (i >> 2) + 4 * n + (i & 3); }

struct Unit { int pm, pn; };
struct Gemm { const bf16_t* A; const bf16_t* Bt; int M, N, K, lda, ldb; };

struct StaticOrder {
    int nM, nN, nwg, G, c;
    __host__ __device__ void init(int M, int N, int G_, int c_) { nM = M / BM; nN = N / BM; nwg = nM * nN; G = G_; c = c_; }
    __host__ __device__ bool next(int i, Unit& u) const {
        const long L = (long)i * G + c; if (L >= nwg) return false;
        int wgid = (int)L; { const int q = nwg / NXCD, r = nwg % NXCD, xcd = wgid % NXCD, off = wgid / NXCD; wgid = (xcd < r ? xcd * (q + 1) : r * (q + 1) + (xcd - r) * q) + off; }
        const int nig = WGM * nN, gid = wgid / nig, fm = gid * WGM, gsz = (nM - fm) < WGM ? (nM - fm) : WGM;
        u.pm = fm + ((wgid % nig) % gsz); u.pn = (wgid % nig) / gsz; return true;
    }
    __device__ __forceinline__ void a_ready(const Unit&) const {}
    __device__ __forceinline__ void done(const Unit&) const {}
};


typedef float f32x2c_t __attribute__((ext_vector_type(2))); typedef __bf16 bf16x2c_t __attribute__((ext_vector_type(2)));
__device__ __forceinline__ unsigned cvt_pk_bf16(float lo, float hi) { const f32x2c_t v = {lo, hi}; const bf16x2c_t b = __builtin_convertvector(v, bf16x2c_t); return __builtin_bit_cast(unsigned, b); }
typedef float f32x2 __attribute__((ext_vector_type(2)));
__device__ __forceinline__ f32x2 gelu_pk(f32x2 v) {
    const f32x2 av = __builtin_elementwise_abs(v), d = av * 0.2316418882f + 1.0f;
    f32x2 t; t.x = __builtin_amdgcn_rcpf(d.x); t.y = __builtin_amdgcn_rcpf(d.y);
    f32x2 q = t * 0.5307027145f + (-0.7265760135f); q = q * t + 0.7107068705f; q = q * t + (-0.142248368f); q = q * t + 0.127414796f; q = q * t;
    const f32x2 s = (v * v) * (-0.72134752044f);
    f32x2 e; e.x = __builtin_amdgcn_exp2f(s.x); e.y = __builtin_amdgcn_exp2f(s.y);
    const f32x2 m = v * (q * e), r = v - m;
    f32x2 o; o.x = v.x < 0.f ? m.x : r.x; o.y = v.y < 0.f ? m.y : r.y; return o;
}

template <class Epi, class Sched, bool ALIGN_EPI = false, bool SP2 = false>
__device__ __forceinline__ void gemm_phase(PG8_LAS unsigned char* lds, const Gemm g, const Sched& S, const Epi& E, const int wave_id) {
    int tid; asm volatile("v_mbcnt_lo_u32_b32 %0, -1, 0\n\tv_mbcnt_hi_u32_b32 %0, -1, %0" : "=v"(tid)); tid += wave_id * 64;
    const int wid = __builtin_amdgcn_readfirstlane(tid >> 6), lane = tid & 63, wr = wid >> 2, wc = wid & 3, fr = lane & 15, fq = lane >> 4;
    int K = g.K; asm volatile("" : "+s"(K)); const int nt = K / BK;
    unsigned voffA[2], voffB[2];
#pragma unroll
    for (int i = 0; i < 2; ++i) { int R, C; stage_rc(tid * 16 + i * 8192, R, C); const int Rb = Epi::PERM ? ((R & ~31) + perm32(R & 31)) : R;
        voffA[i] = (unsigned)(R * g.lda + C) * 2u; voffB[i] = (unsigned)(Rb * g.ldb + C) * 2u; }
    const size_t kstep = (size_t)(BK * 2);
    const size_t hstepA = (size_t)HALF * g.lda * 2, hstepB = (size_t)HALF * g.ldb * 2;
    const size_t tstepA = 2 * hstepA, tstepB = 2 * hstepB;
    const unsigned ldsw = (unsigned)wid * 1024u;
    const int aoff = lds_byte(wr * 64 + fr, fq * 8), boff = lds_byte(wc * 32 + fr, fq * 8);
#define PG8_SA(b, h) (((b) * 2 + (h)) * HTB)
#define PG8_SB(b, h) ((4 + (b) * 2 + (h)) * HTB)
#define PG8_STAGE(bufoff, gbase, voff) do { _Pragma("unroll") for (int _i = 0; _i < 2; ++_i) \
        __builtin_amdgcn_global_load_lds((const unsigned*)((const char*)(gbase) + (voff)[_i]), (PG8_LAS unsigned*)(lds + (bufoff) + ldsw + _i * 8192), 16, 0, 0); } while (0)
#define PG8_LDA(dst, b, h) do { _Pragma("unroll") for (int m = 0; m < 4; ++m) _Pragma("unroll") for (int k = 0; k < 2; ++k) dst[m][k] = *(const PG8_LAS bf16x8*)(lds + PG8_SA(b, h) + aoff + m * 2048 + k * 1024); } while (0)
#define PG8_LDB(dst, b, h) do { _Pragma("unroll") for (int n = 0; n < 2; ++n) _Pragma("unroll") for (int k = 0; k < 2; ++k) dst[n][k] = *(const PG8_LAS bf16x8*)(lds + PG8_SB(b, h) + boff + n * 2048 + k * 1024); } while (0)
#define PG8_MMA(ai, bj, At, Bt) do { __builtin_amdgcn_s_setprio(1); _Pragma("unroll") for (int m = 0; m < 4; ++m) _Pragma("unroll") for (int n = 0; n < 2; ++n) _Pragma("unroll") for (int k = 0; k < 2; ++k) \
        acc[ai][bj][m][n] = __builtin_amdgcn_mfma_f32_16x16x32_bf16(Bt[n][k], At[m][k], acc[ai][bj][m][n], 0, 0, 0); __builtin_amdgcn_s_setprio(0); } while (0)
#define PG8_WAIT_V(n) asm volatile("s_waitcnt vmcnt(" #n ")" ::: "memory")
#define PG8_WAIT_L(n) asm volatile("s_waitcnt lgkmcnt(" #n ")" ::: "memory")
#define PG8_BAR __builtin_amdgcn_s_barrier()
#define PG8_SCHED __builtin_amdgcn_sched_barrier(0)
    Unit cur, nxt; int ui = 0;
    if (!S.next(0, cur)) return;
    f32x4 acc[2][2][4][2];
#pragma unroll
    for (int a = 0; a < 2; ++a)
#pragma unroll
        for (int b = 0; b < 2; ++b)
#pragma unroll
            for (int m = 0; m < 4; ++m)
#pragma unroll
                for (int n = 0; n < 2; ++n) acc[a][b][m][n] = (f32x4){0.f, 0.f, 0.f, 0.f};
    bf16x8 At[4][2], B0[2][2], B1[2][2];
    const char* cA = (const char*)g.A + (size_t)cur.pm * tstepA; const char* cB = (const char*)g.Bt + (size_t)cur.pn * tstepB;
    S.a_ready(cur);
    if constexpr (SP2) {
        PG8_STAGE(PG8_SB(0, 0), cB, voffB); PG8_STAGE(PG8_SB(0, 1), cB + hstepB, voffB); PG8_STAGE(PG8_SA(0, 0), cA, voffA); PG8_STAGE(PG8_SA(0, 1), cA + hstepA, voffA);
        if (wr == 1) PG8_BAR;
        PG8_WAIT_V(2); PG8_BAR;
        PG8_STAGE(PG8_SB(1, 0), cB + kstep, voffB); PG8_STAGE(PG8_SA(1, 0), cA + kstep, voffA); PG8_STAGE(PG8_SB(1, 1), cB + hstepB + kstep, voffB);
        PG8_WAIT_V(6); PG8_BAR;
    } else {
        PG8_STAGE(PG8_SB(0, 0), cB, voffB); PG8_STAGE(PG8_SA(0, 0), cA, voffA); PG8_STAGE(PG8_SB(0, 1), cB + hstepB, voffB); PG8_STAGE(PG8_SA(0, 1), cA + hstepA, voffA);
        if (wr == 1) PG8_BAR;
        PG8_WAIT_V(4); PG8_BAR;
        PG8_STAGE(PG8_SB(1, 0), cB + kstep, voffB); PG8_STAGE(PG8_SA(1, 0), cA + kstep, voffA); PG8_STAGE(PG8_SB(1, 1), cB + hstepB + kstep, voffB);
        PG8_WAIT_V(6); PG8_BAR;
    }
    for (;;) {
        const bool has_next = S.next(ui + 1, nxt);
        const char* nA = has_next ? (const char*)g.A + (size_t)nxt.pm * tstepA : cA; const char* nB = has_next ? (const char*)g.Bt + (size_t)nxt.pn * tstepB : cB;
        for (int t = 0; t < nt; t += 2) {
            if constexpr (Epi::KHOOK) { if (t == Epi::KH1 || t == Epi::KH2) E.khook(acc, cur, t, wr, wc, fr, fq); }
            const bool last = (t == nt - 2);
            const char* a1 = cA + (size_t)(t + 1) * kstep;
            const char* a2 = last ? nA : cA + (size_t)(t + 2) * kstep; const char* b2 = last ? nB : cB + (size_t)(t + 2) * kstep;
            const char* a3 = a2 + kstep; const char* b3 = b2 + kstep;
            if (last && has_next) S.a_ready(nxt);
            if constexpr (SP2) {
            PG8_LDB(B0, 0, 0); PG8_LDB(B1, 0, 1); PG8_SCHED; PG8_LDA(At, 0, 0); PG8_STAGE(PG8_SA(1, 1), a1 + hstepA, voffA);
            PG8_WAIT_V(8); PG8_WAIT_L(0); PG8_BAR; PG8_MMA(0, 0, At, B0); PG8_MMA(0, 1, At, B1); PG8_BAR; PG8_SCHED;
            PG8_LDA(At, 0, 1); PG8_STAGE(PG8_SB(0, 0), b2, voffB); PG8_STAGE(PG8_SB(0, 1), b2 + hstepB, voffB); PG8_STAGE(PG8_SA(0, 0), a2, voffA);
            PG8_WAIT_V(8); PG8_WAIT_L(0); PG8_BAR; PG8_MMA(1, 0, At, B0); PG8_MMA(1, 1, At, B1); PG8_BAR; PG8_SCHED;
            PG8_LDB(B0, 1, 0); PG8_LDB(B1, 1, 1); PG8_SCHED; PG8_LDA(At, 1, 0); PG8_STAGE(PG8_SA(0, 1), a2 + hstepA, voffA);
            PG8_WAIT_V(8); PG8_WAIT_L(0); PG8_BAR; PG8_MMA(0, 0, At, B0); PG8_MMA(0, 1, At, B1); PG8_BAR; PG8_SCHED;
            PG8_LDA(At, 1, 1); PG8_STAGE(PG8_SB(1, 0), b3, voffB); PG8_STAGE(PG8_SB(1, 1), b3 + hstepB, voffB); PG8_STAGE(PG8_SA(1, 0), a3, voffA);
            PG8_WAIT_V(8); PG8_WAIT_L(0); PG8_BAR; PG8_MMA(1, 0, At, B0); PG8_MMA(1, 1, At, B1); PG8_BAR; PG8_SCHED;
            } else {
            PG8_LDB(B0, 0, 0); PG8_SCHED; PG8_LDA(At, 0, 0); PG8_STAGE(PG8_SA(1, 1), a1 + hstepA, voffA);
            PG8_WAIT_L(8); PG8_BAR; PG8_WAIT_L(0); PG8_MMA(0, 0, At, B0); PG8_BAR; PG8_SCHED;
            PG8_LDB(B1, 0, 1); PG8_STAGE(PG8_SB(0, 0), b2, voffB);
            PG8_BAR; PG8_WAIT_L(0); PG8_MMA(0, 1, At, B1); PG8_BAR;
            PG8_LDA(At, 0, 1); PG8_STAGE(PG8_SA(0, 0), a2, voffA);
            PG8_BAR; PG8_WAIT_L(0); PG8_MMA(1, 0, At, B0); PG8_BAR; PG8_SCHED;
            PG8_STAGE(PG8_SB(0, 1), b2 + hstepB, voffB);
            PG8_WAIT_V(6); PG8_BAR; PG8_MMA(1, 1, At, B1); PG8_BAR;
            PG8_LDB(B0, 1, 0); PG8_SCHED; PG8_LDA(At, 1, 0); PG8_STAGE(PG8_SA(0, 1), a2 + hstepA, voffA);
            PG8_WAIT_L(8); PG8_BAR; PG8_WAIT_L(0); PG8_MMA(0, 0, At, B0); PG8_BAR; PG8_SCHED;
            PG8_LDB(B1, 1, 1); PG8_STAGE(PG8_SB(1, 0), b3, voffB);
            PG8_BAR; PG8_WAIT_L(0); PG8_MMA(0, 1, At, B1); PG8_BAR;
            PG8_LDA(At, 1, 1); PG8_STAGE(PG8_SA(1, 0), a3, voffA);
            PG8_BAR; PG8_WAIT_L(0); PG8_MMA(1, 0, At, B0); PG8_BAR; PG8_SCHED;
            PG8_STAGE(PG8_SB(1, 1), b3 + hstepB, voffB);
            PG8_WAIT_V(6); PG8_BAR; PG8_MMA(1, 1, At, B1); PG8_BAR;
            }
        }
        if constexpr (ALIGN_EPI) { if (wr == 0) PG8_BAR; }
        if constexpr (!Epi::AFTER_DRAIN) { E(acc, cur, wr, wc, fr, fq); S.done(cur); }
        if (!has_next) break;
#pragma unroll
        for (int a = 0; a < 2; ++a)
#pragma unroll
            for (int b = 0; b < 2; ++b)
#pragma unroll
                for (int m = 0; m < 4; ++m)
#pragma unroll
                    for (int n = 0; n < 2; ++n) acc[a][b][m][n] = (f32x4){0.f, 0.f, 0.f, 0.f};
        cur = nxt; cA = nA; cB = nB; ++ui;
        if constexpr (ALIGN_EPI) { if (wr == 1) PG8_BAR; }
    }
    PG8_WAIT_V(0);
    if constexpr (!ALIGN_EPI) { if (wr == 0) PG8_BAR; }
    PG8_BAR;
    if constexpr (Epi::AFTER_DRAIN) { E.fused(acc, cur, wr, wc, fr, fq, lds, wid, lane); S.done(cur); }
#undef PG8_SA
#undef PG8_SB
#undef PG8_STAGE
#undef PG8_LDA
#undef PG8_LDB
#undef PG8_MMA
#undef PG8_WAIT_V
#undef PG8_WAIT_L
#undef PG8_BAR
#undef PG8_SCHED
}
}

#ifndef G1_EPI_DRAIN
#define G1_EPI_DRAIN 0
#endif
#ifndef G1_STORE_AUX_MIX
#define G1_STORE_AUX_MIX 2
#endif
#ifndef G1_STORE_AUX
#define G1_STORE_AUX 2
#endif
namespace pg8 {
__device__ __forceinline__ float ubf0(unsigned w) { return (float)(w & 0xffu); }
__device__ __forceinline__ float ubf1(unsigned w) { return (float)((w >> 8) & 0xffu); }
__device__ __forceinline__ float ubf2(unsigned w) { return (float)((w >> 16) & 0xffu); }
__device__ __forceinline__ float ubf3(unsigned w) { return (float)(w >> 24); }
__device__ __forceinline__ float ex2(float x) { return __builtin_amdgcn_exp2f(x); }
__device__ __forceinline__ float sigm_fast(float x) { return __builtin_amdgcn_rcpf(1.0f + ex2(x * -1.4426950408889634f)); }
template <int MODE = 0  > struct EpiProjT {
    static constexpr bool PERM = true, AFTER_DRAIN = false, KHOOK = false;
    bf16_t* PA; bf16_t* KVM; float* SS; float* MKSS; const float* gate_b; int pm0; int pad;
    template <int KIND, int STAT> __device__ __forceinline__ void body(const f32x4 (&acc)[2][2][4][2], const __amdgpu_buffer_rsrc_t rsrc, int row0, int col0, int ldc, float* sb, int sld, int so, const float* bias, int wc, int fq) const {
        f32x4 bv[2][2];
        if (KIND == 3) {
#pragma unroll
            for (int bj = 0; bj < 2; ++bj)
#pragma unroll
                for (int n = 0; n < 2; ++n) bv[bj][n] = *(const f32x4*)(bias + bj * HALF + 4 * n);
        }
#pragma unroll
        for (int ai = 0; ai < 2; ++ai)
#pragma unroll
            for (int m = 0; m < 4; ++m) { const int row = row0 + ai * HALF + m * 16; const unsigned rowoff = ((unsigned)row * (unsigned)ldc + (unsigned)col0) * 2u;
#pragma unroll
                for (int bj = 0; bj < 2; ++bj) { f32x4 v0 = acc[ai][bj][m][0], v1 = acc[ai][bj][m][1];
                    if (KIND == 1) { f32x2 a = gelu_pk((f32x2){v0[0], v0[1]}), b = gelu_pk((f32x2){v0[2], v0[3]}), c = gelu_pk((f32x2){v1[0], v1[1]}), d = gelu_pk((f32x2){v1[2], v1[3]});
                        v0 = (f32x4){a.x, a.y, b.x, b.y}; v1 = (f32x4){c.x, c.y, d.x, d.y}; }
                    else if (KIND == 2) {
#pragma unroll
                        for (int j = 0; j < 4; ++j) { v0[j] = v0[j] * sigm_fast(v0[j]); v1[j] = v1[j] * sigm_fast(v1[j]); } }
                    else if (KIND == 3) { v0 = v0 + bv[bj][0]; v1 = v1 + bv[bj][1];
#pragma unroll
                        for (int j = 0; j < 4; ++j) { v0[j] = sigm_fast(v0[j]); v1[j] = sigm_fast(v1[j]); } }
                    if (STAT) {
                        float s = ((v0[0] + v0[1]) + (v0[2] + v0[3])) + ((v1[0] + v1[1]) + (v1[2] + v1[3]));
                        float q = ((v0[0] * v0[0] + v0[1] * v0[1]) + (v0[2] * v0[2] + v0[3] * v0[3])) + ((v1[0] * v1[0] + v1[1] * v1[1]) + (v1[2] * v1[2] + v1[3] * v1[3]));
                        if (STAT == 2) { s += __shfl_xor(s, 16); s += __shfl_xor(s, 32); }
                        q += __shfl_xor(q, 16); q += __shfl_xor(q, 32);
                        if (fq == 0) { float* sp = sb + (size_t)row * sld + so; const int blk = 4 * bj + wc;
                            if (STAT == 2) { sp[2 * blk] = s; sp[2 * blk + 1] = q; } else sp[blk] = q; }
                    }
                    u32x4 w; w.x = cvt_pk_bf16(v0[0], v0[1]); w.y = cvt_pk_bf16(v0[2], v0[3]); w.z = cvt_pk_bf16(v1[0], v1[1]); w.w = cvt_pk_bf16(v1[2], v1[3]);
                    if (MODE == 2) asm volatile("" :: "v"(w)); else __builtin_amdgcn_raw_buffer_store_b128(w, rsrc, (int)(rowoff + bj * HALF * 2), 0, KIND == 3 ? G1_STORE_AUX : G1_STORE_AUX_MIX); } }
    }
    __device__ __forceinline__ void gate_body(const f32x4 (&acc)[2][2][4][2], const __amdgpu_buffer_rsrc_t rsrc, int row0, int gcol0, const float* bias) const {
        f32x4 bv[2][2];
#pragma unroll
        for (int bj = 0; bj < 2; ++bj)
#pragma unroll
            for (int n = 0; n < 2; ++n) bv[bj][n] = *(const f32x4*)(bias + 8 * bj + 4 * n);
#pragma unroll
        for (int ai = 0; ai < 2; ++ai)
#pragma unroll
            for (int m = 0; m < 4; ++m) { const int row = row0 + ai * HALF + m * 16; u32x4 w;
#pragma unroll
                for (int bj = 0; bj < 2; ++bj)
#pragma unroll
                    for (int n = 0; n < 2; ++n) { const f32x4 v = acc[ai][bj][m][n] + bv[bj][n]; unsigned d = 0u;
#pragma unroll
                        for (int j = 0; j < 4; ++j) d |= (unsigned)(fmaxf(sigm_fast(v[j]) * 255.0f, 1.0f) + 0.5f) << (8 * j);
                        w[2 * bj + n] = d; }
                if (MODE == 2) asm volatile("" :: "v"(w)); else __builtin_amdgcn_raw_buffer_store_b128(w, rsrc, (int)((unsigned)row * (unsigned)PA_ROWB + (unsigned)(PA_GOFF + gcol0)), 0, G1_STORE_AUX); }
    }
    __device__ __forceinline__ void operator()(const f32x4 (&acc)[2][2][4][2], const Unit& u, int wr, int wc, int fr, int fq) const {
        const bool kv = u.pn >= 35; const int pn = kv ? u.pn - 35 : u.pn;
        const int rowt = kv ? (u.pm - 256) * BM : (u.pm - pm0) * BM;
        bf16_t* base = kv ? KVM : PA; const int ldc = kv ? 1024 : PAP;
        const __amdgpu_buffer_rsrc_t rsrc = __builtin_amdgcn_make_buffer_rsrc(base, 0, kv ? (int)((size_t)MMEM * 1024 * 2) : (int)((size_t)HB_ROWS * PA_ROWB), 0x00020000);
        const int row0 = rowt + wr * 64 + fr, col0 = pn * BM + wc * 32 + 8 * fq;
        if (MODE == 1) { body<0, 0>(acc, rsrc, row0, col0, ldc, SS, SS_W, 0, gate_b, wc, fq); return; }
        if (kv) { if (pn < 2) body<0, 1>(acc, rsrc, row0, col0, ldc, MKSS, 16, 8 * pn, gate_b, wc, fq); else body<0, 0>(acc, rsrc, row0, col0, ldc, SS, SS_W, 0, gate_b, wc, fq); }
        else if (pn < 3) body<1, 0>(acc, rsrc, row0, col0, ldc, SS, SS_W, 0, gate_b, wc, fq);
        else if (pn < 6) body<1, 2>(acc, rsrc, row0, col0, ldc, SS, SS_W, 16 * (pn - 3), gate_b, wc, fq);
        else if (pn < 9) body<2, 0>(acc, rsrc, row0, col0, ldc, SS, SS_W, 0, gate_b, wc, fq);
        else if (pn < 12) body<0, 1>(acc, rsrc, row0, col0, ldc, SS, SS_W, 48 + 8 * (pn - 9), gate_b, wc, fq);
        else if (pn < 15) body<0, 1>(acc, rsrc, row0, col0, ldc, SS, SS_W, 72 + 8 * (pn - 12), gate_b, wc, fq);
        else if (pn < 18) body<0, 0>(acc, rsrc, row0, col0, ldc, SS, SS_W, 0, gate_b, wc, fq);
        else if (pn < 19) body<2, 0>(acc, rsrc, row0, col0, ldc, SS, SS_W, 0, gate_b, wc, fq);
        else if (pn < 21) body<0, 1>(acc, rsrc, row0, col0, ldc, SS, SS_W, 96 + 8 * (pn - 19), gate_b, wc, fq);
        else if (pn < 23) body<2, 0>(acc, rsrc, row0, col0, ldc, SS, SS_W, 0, gate_b, wc, fq);
        else { const int gc = (pn - 23) * BM + 64 * wc + 16 * fq; gate_body(acc, rsrc, row0, gc, gate_b + gc); }
#if G1_EPI_DRAIN
        asm volatile("s_waitcnt vmcnt(0)" ::: "memory");
#endif
    }
};
typedef EpiProjT<0> EpiProj;
template <bool HOOKS = true, bool EPI = true> struct EpiG2catT {
    static constexpr bool PERM = true, AFTER_DRAIN = false, KHOOK = HOOKS; static constexpr int KH1 = 12, KH2 = 16;
    const bf16_t* PA; bf16_t* MRG;
    __device__ __forceinline__ void khook(f32x4 (&acc)[2][2][4][2], const Unit& u, int t, int wr, int wc, int fr, int fq) const {
        typedef unsigned u32x2v __attribute__((ext_vector_type(2)));
        const int ga = t == KH1 ? 0 : 1;
        const int row0 = u.pm * BM + wr * 64 + fr, col0 = u.pn * BM + wc * 32 + 8 * fq;
        const unsigned char* gbase = (const unsigned char*)PA + (size_t)row0 * PA_ROWB + PA_GOFF + ga * DM + col0;
        u32x2v ag[2][4][2], bg[2][4][2];
#pragma unroll
        for (int ai = 0; ai < 2; ++ai)
#pragma unroll
            for (int m = 0; m < 4; ++m) { const unsigned char* gp_ = gbase + (size_t)(ai * HALF + m * 16) * PA_ROWB;
#pragma unroll
                for (int bj = 0; bj < 2; ++bj) { ag[ai][m][bj] = *(const u32x2v*)(gp_ + bj * HALF); bg[ai][m][bj] = *(const u32x2v*)(gp_ + DM + bj * HALF); } }
        __builtin_amdgcn_sched_barrier(0);
#define G2_R(A, Bv, K) (ubf##K(A) * __builtin_amdgcn_rcpf(ubf##K(Bv)))
#pragma unroll
        for (int ai = 0; ai < 2; ++ai)
#pragma unroll
            for (int m = 0; m < 4; ++m)
#pragma unroll
                for (int bj = 0; bj < 2; ++bj) { const u32x2v a = ag[ai][m][bj], b = bg[ai][m][bj]; f32x4 r0, r1;
                    r0[0] = G2_R(a.x, b.x, 0); r0[1] = G2_R(a.x, b.x, 1); r0[2] = G2_R(a.x, b.x, 2); r0[3] = G2_R(a.x, b.x, 3);
                    r1[0] = G2_R(a.y, b.y, 0); r1[1] = G2_R(a.y, b.y, 1); r1[2] = G2_R(a.y, b.y, 2); r1[3] = G2_R(a.y, b.y, 3);
                    acc[ai][bj][m][0] *= r0; acc[ai][bj][m][1] *= r1; }
#undef G2_R
    }
    __device__ __forceinline__ void operator()(const f32x4 (&acc)[2][2][4][2], const Unit& u, int wr, int wc, int fr, int fq) const {
        typedef unsigned u32x2v __attribute__((ext_vector_type(2)));
        if (!EPI) { _Pragma("unroll") for (int ai = 0; ai < 2; ++ai) _Pragma("unroll") for (int bj = 0; bj < 2; ++bj) _Pragma("unroll") for (int m = 0; m < 4; ++m) asm volatile("" :: "v"(acc[ai][bj][m][0]), "v"(acc[ai][bj][m][1])); return; }
        const int row0 = u.pm * BM + wr * 64 + fr, col0 = u.pn * BM + wc * 32 + 8 * fq;
        u32x2v gv[2][4][2];
#pragma unroll
        for (int ai = 0; ai < 2; ++ai)
#pragma unroll
            for (int m = 0; m < 4; ++m) { const unsigned char* gp = (const unsigned char*)PA + (size_t)(row0 + ai * HALF + m * 16) * PA_ROWB + PA_GOFF + 2 * DM + col0;
#pragma unroll
                for (int bj = 0; bj < 2; ++bj) gv[ai][m][bj] = *(const u32x2v*)(gp + bj * HALF); }
        __builtin_amdgcn_sched_barrier(0);
        const float q = 1.0f / 255.0f;
#pragma unroll
        for (int ai = 0; ai < 2; ++ai)
#pragma unroll
            for (int m = 0; m < 4; ++m) { bf16_t* mp = MRG + (size_t)(row0 + ai * HALF + m * 16) * DM + col0;
#pragma unroll
                for (int bj = 0; bj < 2; ++bj) { const u32x2v g = gv[ai][m][bj]; const f32x4 v0 = acc[ai][bj][m][0] * q, v1 = acc[ai][bj][m][1] * q; u32x4 w;
                    w.x = cvt_pk_bf16(v0[0] * ubf0(g.x), v0[1] * ubf1(g.x)); w.y = cvt_pk_bf16(v0[2] * ubf2(g.x), v0[3] * ubf3(g.x));
                    w.z = cvt_pk_bf16(v1[0] * ubf0(g.y), v1[1] * ubf1(g.y)); w.w = cvt_pk_bf16(v1[2] * ubf2(g.y), v1[3] * ubf3(g.y));
                    *(u32x4*)(mp + bj * HALF) = w; } }
    }
};
typedef EpiG2catT<true, true> EpiG2cat;
struct EpiG3 {
    static constexpr bool PERM = false, AFTER_DRAIN = false, KHOOK = false;
    const float* x; float* out;
    __device__ __forceinline__ void operator()(const f32x4 (&acc)[2][2][4][2], const Unit& u, int wr, int wc, int fr, int fq) const {
        const int row0 = u.pm * BM + wr * 64 + fr, col0 = u.pn * BM + wc * 32 + 4 * fq;
        f32x4 xv[2][2][2][2];
#define G3_LOAD(B) do { _Pragma("unroll") for (int mm = 0; mm < 2; ++mm) { const size_t off_ = (size_t)(row0 + ((B) >> 1) * HALF + (2 * ((B) & 1) + mm) * 16) * DM + col0; \
            _Pragma("unroll") for (int bj = 0; bj < 2; ++bj) _Pragma("unroll") for (int n = 0; n < 2; ++n) xv[(B) & 1][mm][bj][n] = __builtin_nontemporal_load((const f32x4*)(x + off_ + bj * HALF + n * 16)); } } while (0)
#define G3_STORE(B) do { _Pragma("unroll") for (int mm = 0; mm < 2; ++mm) { const size_t off_ = (size_t)(row0 + ((B) >> 1) * HALF + (2 * ((B) & 1) + mm) * 16) * DM + col0; \
            _Pragma("unroll") for (int bj = 0; bj < 2; ++bj) _Pragma("unroll") for (int n = 0; n < 2; ++n) \
                __builtin_nontemporal_store(xv[(B) & 1][mm][bj][n] + acc[(B) >> 1][bj][2 * ((B) & 1) + mm][n], (f32x4*)(out + off_ + bj * HALF + n * 16)); } } while (0)
        G3_LOAD(0); G3_LOAD(1); __builtin_amdgcn_sched_barrier(0); G3_STORE(0); G3_STORE(1); __builtin_amdgcn_sched_barrier(0); G3_LOAD(2); G3_LOAD(3); __builtin_amdgcn_sched_barrier(0); G3_STORE(2); G3_STORE(3);
#undef G3_LOAD
#undef G3_STORE
    }
};
struct EpiNull {
    static constexpr bool PERM = true, AFTER_DRAIN = false, KHOOK = false;
    __device__ __forceinline__ void operator()(const f32x4 (&acc)[2][2][4][2], const Unit& u, int wr, int wc, int fr, int fq) const {
#pragma unroll
        for (int ai = 0; ai < 2; ++ai)
#pragma unroll
            for (int bj = 0; bj < 2; ++bj)
#pragma unroll
                for (int m = 0; m < 4; ++m) asm volatile("" :: "v"(acc[ai][bj][m][0]), "v"(acc[ai][bj][m][1]));
    }
};
struct OrderG1 {
    StaticOrder so; int pm0, nkv;
    __device__ void init(int hb, int G, int c) { so.init(HB_ROWS, NIN, G, c); pm0 = hb * (HB_ROWS / BM); nkv = hb == 0 ? (MMEM / BM) * 4 : 0; }
    __device__ bool next(int i, Unit& u) const {
        if (so.next(i, u)) { u.pm += pm0; return true; }
        const long j = (long)i * so.G + so.c - so.nwg; if (j < 0 || j >= nkv) return false;
        u.pm = 256 + (int)(j >> 2); u.pn = 35 + (int)(j & 3); return true;
    }
    __device__ __forceinline__ void a_ready(const Unit&) const {}
    __device__ __forceinline__ void done(const Unit&) const {}
};
}

#define GAS __attribute__((address_space(1)))
#define LAS __attribute__((address_space(3)))
typedef unsigned short bf16;
typedef unsigned v4u __attribute__((ext_vector_type(4)));
typedef float f32x4 __attribute__((ext_vector_type(4)));
typedef short bf16x8 __attribute__((ext_vector_type(8)));
typedef GAS unsigned gu32;
typedef GAS unsigned long long gu64;
#define RLX_AGENT __ATOMIC_RELAXED, __HIP_MEMORY_SCOPE_AGENT
#define LDS_WAIT() asm volatile("s_waitcnt lgkmcnt(0)" ::: "memory")
#define VM_WAIT() asm volatile("s_waitcnt vmcnt(0)" ::: "memory")
__device__ __forceinline__ unsigned long long rt() { return __builtin_amdgcn_s_memrealtime(); }
__device__ __forceinline__ unsigned f2bf(float f) { unsigned u = __builtin_bit_cast(unsigned, f); return (u + 0x7fffu + ((u >> 16) & 1u)) >> 16; }
__device__ __forceinline__ unsigned pk2(float lo, float hi) { return f2bf(lo) | (f2bf(hi) << 16); }

__device__ __forceinline__ int hw_lane() { int l; asm volatile("v_mbcnt_lo_u32_b32 %0, -1, 0\n\tv_mbcnt_hi_u32_b32 %0, -1, %0" : "=v"(l)); return l; }
__device__ __forceinline__ bool hw_thread0(int wave) { return wave == 0 && hw_lane() == 0; }
#define XB_TMO      128
#define XB_XCNT(j)  (256  + 64 * (j))
#define XB_XSUB(j)  (1280 + 64 * (j))
#define XB_XGEN(j)  (2304 + 64 * (j))
#define XB_TOP      3328
#define XB_TOPGEN   3392
#define XCD_BAR_WORDS 3456
#define XB_SPIN_CAP (1u << 18)

__device__ __forceinline__ unsigned xb_ld(unsigned* p)              { return __hip_atomic_load(p, __ATOMIC_RELAXED, __HIP_MEMORY_SCOPE_AGENT); }
__device__ __forceinline__ unsigned xb_add(unsigned* p, unsigned v) { return __hip_atomic_fetch_add(p, v, __ATOMIC_RELAXED, __HIP_MEMORY_SCOPE_AGENT); }
__device__ __forceinline__ unsigned xb_xcc_id() { return (unsigned)__builtin_amdgcn_s_getreg((3 << 11) | 20) & 0xFu; }
#define XB_SPIN(cond, bar) do { unsigned _sp = 0; while (cond) { __builtin_amdgcn_s_sleep(1); \
    if ((++_sp & 255u) == 0u) { if (xb_ld(&(bar)[XB_TMO])) break; if (_sp > XB_SPIN_CAP) { atomicAdd(&(bar)[XB_TMO], 1u); break; } } } } while (0)

struct XcdBarrier {
    unsigned* bar; unsigned x; int wave;
    volatile LAS unsigned* st;
};

__device__ __forceinline__ XcdBarrier xcd_barrier_post(unsigned* bar, volatile LAS unsigned* st, int wave) {
    XcdBarrier b; b.bar = bar; b.x = xb_xcc_id(); b.st = st; b.wave = wave;
    if (hw_thread0(wave)) (void)xb_add(&bar[XB_XCNT(b.x)], 1u);
    return b;
}
__device__ __forceinline__ void xcd_barrier_complete(unsigned* bar, unsigned x, unsigned& nloc, unsigned& nx) {
    const unsigned G = gridDim.x * gridDim.y * gridDim.z;
    unsigned sum, cnt, mine, sp = 0u;
    for (;;) {
        sum = 0u; cnt = 0u; mine = 0u;
#pragma unroll
        for (unsigned j = 0; j < 16; ++j) { const unsigned c = xb_ld(&bar[XB_XCNT(j)]); sum += c; cnt += (c > 0u) ? 1u : 0u; mine = (j == x) ? c : mine; }
        if (sum == G) break;
        __builtin_amdgcn_s_sleep(1);
        if ((++sp & 255u) == 0u) { if (xb_ld(&bar[XB_TMO])) break; if (sp > XB_SPIN_CAP) { atomicAdd(&bar[XB_TMO], 1u); break; } }
    }
    nloc = mine > 0u ? mine : 1u; nx = cnt > 0u ? cnt : 1u;
}

__device__ __forceinline__ void xcd_barrier(const XcdBarrier& b) {
    asm volatile("s_waitcnt vmcnt(0)" ::: "memory");
    __syncthreads();
    if (hw_thread0(b.wave)) {
        unsigned* bar = b.bar;
        __builtin_amdgcn_s_waitcnt(0);
        unsigned nloc = b.st[0], nx = b.st[1];
        if (nloc == 0u) { xcd_barrier_complete(bar, b.x, nloc, nx); b.st[0] = nloc; b.st[1] = nx; }
        const unsigned old = xb_add(&bar[XB_XSUB(b.x)], 1u);
        const unsigned gen = old / nloc;
        if (old + 1u == (gen + 1u) * nloc) {
            __builtin_amdgcn_fence(__ATOMIC_RELEASE, "agent");
            asm volatile("s_waitcnt vmcnt(0)" ::: "memory");
            const unsigned og = xb_add(&bar[XB_TOP], 1u);
            const unsigned tg = og / nx;
            if (og + 1u == (tg + 1u) * nx) xb_add(&bar[XB_TOPGEN], 1u);
            else XB_SPIN(xb_ld(&bar[XB_TOPGEN]) == tg, bar);
            __builtin_amdgcn_fence(__ATOMIC_ACQUIRE, "agent");
            xb_add(&bar[XB_XGEN(b.x)], 1u);
            asm volatile("s_waitcnt vmcnt(0)" ::: "memory");
        } else {
            XB_SPIN(xb_ld(&bar[XB_XGEN(b.x)]) == gen, bar);
            __builtin_amdgcn_fence(__ATOMIC_ACQUIRE, "agent");
            asm volatile("s_waitcnt vmcnt(0)" ::: "memory");
        }
    }
    __syncthreads();
}

__device__ __forceinline__ float wave_sum(float v) {
#pragma unroll
    for (int o = 1; o < 64; o <<= 1) v += __shfl_xor(v, o);
    return v;
}

constexpr int RING_OFF = 0, RING_BYTES = 131072;
constexpr int LDSCTL_OFF = RING_BYTES, MISC_OFF = LDSCTL_OFF + 320;
constexpr int LDS_BYTES = 147456;
constexpr int NWAVES = 8, NTHR = NWAVES * 64;
constexpr int WSCR_OFF = 132096;

__device__ __forceinline__ float bf2f(bf16 h) { return __builtin_bit_cast(float, (unsigned)h << 16); }
__device__ __forceinline__ float sigm_f(float x) { return 1.f / (1.f + __expf(-x)); }
__device__ __forceinline__ int t5_bucket(int d) {
    if (d < 16) return d;
    int b = 16;
    b += d >= 22; b += d >= 30; b += d >= 40; b += d >= 54; b += d >= 73; b += d >= 99; b += d >= 134; b += d >= 182; b += d >= 246; b += d >= 332; b += d >= 450; b += d >= 609; b += d >= 825; b += d >= 1117; b += d >= 1513;
    return b;
}

struct Ctx {
    const float *x, *mem, *norm_w, *w_in, *gate_b, *lnw, *lnb, *sp_w, *sp_b, *bqw, *bkw, *rel_bias, *mem_norm_w, *m_w_kv, *mqw, *mkw, *proj_a, *proj_b, *proj_m, *w_out;
    float* out;
    bf16 *WIN, *PCAT, *WOUT, *WSP, *XN, *PA, *KVM, *OG, *YC, *MRG; float *BIAS, *BIASX, *SS, *MKSS, *LSE, *LNST;
    LAS unsigned char* lds; int tid, lane, wave, G, gtid, T, gwave, NW, xgwave;
};

__device__ __forceinline__ void p0_transpose_item(const float* W, int N, bf16* WT, int ldt, int row_off, int koff, LAS float* scr, int item, int lane, bool gperm = false) {
    const int nblk = N / 32, kb = item / nblk, nb = item % nblk, k0 = 64 * kb, n0 = 32 * nb;
#pragma unroll 8
    for (int i = 0; i < 32; ++i) { const int kk = 2 * i + (lane >> 5); scr[kk * 33 + (lane & 31)] = W[(size_t)(k0 + kk) * N + n0 + (lane & 31)]; }
    LDS_WAIT(); asm volatile("" ::: "memory");
    const int c = lane & 7;
#pragma unroll
    for (int j = 0; j < 4; ++j) { const int n = (lane >> 3) + 8 * j; const LAS float* s = scr + (8 * c) * 33 + n;
        v4u o; o.x = pk2(s[0 * 33], s[1 * 33]); o.y = pk2(s[2 * 33], s[3 * 33]); o.z = pk2(s[4 * 33], s[5 * 33]); o.w = pk2(s[6 * 33], s[7 * 33]);
        int nn = n0 + n; if (gperm && nn >= C_G) nn = (nn & ~255) + 128 * ((nn >> 3) & 1) + 32 * ((nn >> 6) & 3) + 8 * ((nn >> 4) & 3) + (nn & 7);
        *(GAS v4u*)(WT + (size_t)(row_off + nn) * ldt + koff + k0 + 8 * c) = o; }
    LDS_WAIT(); asm volatile("" ::: "memory");
}
template <int NR> __device__ __forceinline__ void rms_rows_to_bf16(const float* src, const float* w, bf16* dst, size_t m0, size_t stride, int lane) {
    f32x4 v[NR][4]; float s[NR];
#pragma unroll
    for (int r = 0; r < NR; ++r) { const GAS f32x4* xr = (const GAS f32x4*)(src + (m0 + r * stride) * DM) + lane;
#pragma unroll
        for (int j = 0; j < 4; ++j) v[r][j] = __builtin_nontemporal_load(xr + 64 * j); }
    f32x4 ww[4];
#pragma unroll
    for (int j = 0; j < 4; ++j) ww[j] = ((const GAS f32x4*)w + lane)[64 * j];
#pragma unroll
    for (int r = 0; r < NR; ++r) { float a = 0.f;
#pragma unroll
        for (int j = 0; j < 4; ++j) a += (v[r][j].x * v[r][j].x + v[r][j].y * v[r][j].y) + (v[r][j].z * v[r][j].z + v[r][j].w * v[r][j].w);
        s[r] = rsqrtf(wave_sum(a) * (1.f / DM) + EPS); }
#pragma unroll
    for (int r = 0; r < NR; ++r) { GAS unsigned long long* o8 = (GAS unsigned long long*)(dst + (m0 + r * stride) * DM) + lane;
#pragma unroll
        for (int j = 0; j < 4; ++j) o8[64 * j] = (unsigned long long)pk2(v[r][j].x * s[r] * ww[j].x, v[r][j].y * s[r] * ww[j].y) | ((unsigned long long)pk2(v[r][j].z * s[r] * ww[j].z, v[r][j].w * s[r] * ww[j].w) << 32); }
}
__device__ __forceinline__ void p0_prologue(Ctx& F) {
    LAS float* scr = (LAS float*)(F.lds + RING_OFF + F.wave * 16384);
    constexpr int I_IN = 16 * (NIN / 32), I_KV = 16 * 32, I_PA = 12 * 32, I_PB = 4 * 32, I_PM = 8 * 32, I_WO = 16 * 32;
    constexpr int NITEMS = I_IN + I_KV + I_PA + I_PB + I_PM + I_WO;
    for (int it = F.gwave; it < NITEMS; it += F.NW) {
        int r = it;
        if (r < I_IN) { p0_transpose_item(F.w_in, NIN, F.WIN, DM, 0, 0, scr, r, F.lane, true); continue; } r -= I_IN;
        if (r < I_KV) { p0_transpose_item(F.m_w_kv, 1024, F.WIN, DM, NIN, 0, scr, r, F.lane); continue; } r -= I_KV;
        if (r < I_PA) { p0_transpose_item(F.proj_a, DM, F.PCAT, KC, 0, 0, scr, r, F.lane); continue; } r -= I_PA;
        if (r < I_PB) { p0_transpose_item(F.proj_b, DM, F.PCAT, KC, 0, 768, scr, r, F.lane); continue; } r -= I_PB;
        if (r < I_PM) { p0_transpose_item(F.proj_m, DM, F.PCAT, KC, 0, 1024, scr, r, F.lane); continue; } r -= I_PM;
        p0_transpose_item(F.w_out, DM, F.WOUT, DM, 0, 0, scr, r, F.lane);
    }
    for (int i = F.gtid; i < 4 * 128 * 128; i += F.T) { const int t = (i >> 7) & 127, s = i & 127; F.WSP[i] = (bf16)(s <= t ? f2bf(F.sp_w[i]) : 0u); }
    for (int i = F.gtid; i < 3 * 4 * 132; i += F.T) { const int g = i / (4 * 132), h = (i / 132) % 4, j = i % 132; const int dil = g == 0 ? 1 : (g == 1 ? 4 : 16);
        F.BIAS[i] = j <= 128 ? F.rel_bias[t5_bucket(j * dil) * 12 + 4 * g + h] : 0.f; }
    for (int i = F.gtid; i < 3 * 4 * 192; i += F.T) { const int g = i / (4 * 192), h = (i / 192) % 4, step = i % 192 - 31; const int dil = g == 0 ? 1 : (g == 1 ? 4 : 16);
        F.BIASX[i] = (step >= 0 && step <= 128) ? F.rel_bias[t5_bucket(step * dil) * 12 + 4 * g + h] * 1.4426950408889634f : -1e30f; }
    if ((MTOT % (4 * F.NW)) == 0 && (MMEM % (4 * F.NW)) == 0) {
        for (size_t m = F.gwave; m < (size_t)MTOT; m += 4 * (size_t)F.NW) rms_rows_to_bf16<4>(F.x, F.norm_w, F.XN, m, F.NW, F.lane);
        for (size_t m = F.gwave; m < (size_t)MMEM; m += 4 * (size_t)F.NW) rms_rows_to_bf16<4>(F.mem, F.mem_norm_w, F.XN + (size_t)MTOT * DM, m, F.NW, F.lane);
    } else {
        for (size_t m = F.gwave; m < (size_t)MTOT; m += F.NW) rms_rows_to_bf16<1>(F.x, F.norm_w, F.XN, m, 0, F.lane);
        for (size_t m = F.gwave; m < (size_t)MMEM; m += F.NW) rms_rows_to_bf16<1>(F.mem, F.mem_norm_w, F.XN + (size_t)MTOT * DM, m, 0, F.lane);
    }
}


typedef float f32x16 __attribute__((ext_vector_type(16)));
typedef short s16x4 __attribute__((ext_vector_type(4)));
__device__ __forceinline__ int crow(int r, int hi) { return (r & 3) + 8 * (r >> 2) + 4 * hi; }
__device__ __forceinline__ unsigned cvtpk(float lo, float hi) { return pg8::cvt_pk_bf16(lo, hi); }
__device__ __forceinline__ s16x4 vtr(const LAS unsigned char* p) { typedef short v4i16_t __attribute__((ext_vector_type(4))); return __builtin_bit_cast(s16x4, __builtin_amdgcn_ds_read_tr16_b64_v4i16((LAS v4i16_t*)p)); }
__device__ __forceinline__ float bflo(unsigned w) { return __uint_as_float(w << 16); }
__device__ __forceinline__ float bfhi(unsigned w) { return __uint_as_float(w & 0xffff0000u); }
constexpr float LOG2E = 1.4426950408889634f, LN2 = 0.6931471805599453f;
constexpr int NBX = 192;


__device__ __forceinline__ void st_mixA_mfma(Ctx& F) {
    const int lane = hw_lane(), r32 = lane & 31, hi = lane >> 5, tid = F.wave * 64 + lane;
    LAS unsigned char* wl = F.lds + RING_OFF + F.wave * 16384;
    typedef float f32x2v __attribute__((ext_vector_type(2))); typedef unsigned u32x2v __attribute__((ext_vector_type(2)));
    LAS f32x2v* tab = (LAS f32x2v*)(F.lds + WSCR_OFF + 8192);
    const int g = F.wave >> 1, ch = lane & 3;
    bf16x8 wf[14];
    const bf16* wrow0 = F.WSP + (size_t)(g * 128 + r32) * 128 + 8 * hi;
    { int n = 0;
#pragma unroll
      for (int tb = 2; tb < 4; ++tb)
#pragma unroll
          for (int ks = 0; ks < 2 * (tb + 1); ++ks) wf[n++] = *(const bf16x8*)(wrow0 + (size_t)tb * 32 * 128 + 16 * ks); }
    for (int unit = blockIdx.x; unit < HB_ROWS / 128; unit += F.G) {
        const int rowbase = unit * 128;
        v4u raw[8];
        { const int c0 = g * 192 + (F.wave & 1) * 96;
#pragma unroll
          for (int i = 0; i < 8; ++i) raw[i] = *(const v4u*)(F.PA + (size_t)(rowbase + (lane >> 2) + 16 * i) * PAP + C_AV + c0 + 8 * ch); }
        { const int row = tid >> 2, part = tid & 3; const float* sp = F.SS + (size_t)(rowbase + row) * SS_W + 12 * part; float s = 0.f, q = 0.f;
#pragma unroll
          for (int k = 0; k < 6; ++k) { s += sp[2 * k]; q += sp[2 * k + 1]; }
          s += __shfl_xor(s, 1); s += __shfl_xor(s, 2); q += __shfl_xor(q, 1); q += __shfl_xor(q, 2);
          const float mu = s * (1.f / 768.f), var = q * (1.f / 768.f) - mu * mu;
          if (part == 0) tab[row] = (f32x2v){mu, rsqrtf(fmaxf(var, 0.f) + EPS)}; }
        __syncthreads();
#pragma unroll 1
        for (int cbi = 0; cbi < 3; ++cbi) {
            const int c0 = g * 192 + ((F.wave & 1) * 3 + cbi) * 32;
            const f32x4 w0 = *(const f32x4*)(F.lnw + c0 + 8 * ch), w1 = *(const f32x4*)(F.lnw + c0 + 8 * ch + 4), b0 = *(const f32x4*)(F.lnb + c0 + 8 * ch), b1 = *(const f32x4*)(F.lnb + c0 + 8 * ch + 4);
#pragma unroll
            for (int i = 0; i < 8; ++i) { const int s = (lane >> 2) + 16 * i; const f32x2v st = tab[s]; const v4u rw = raw[i]; v4u o;
                o.x = cvtpk((bflo(rw.x) - st.x) * st.y * w0.x + b0.x, (bfhi(rw.x) - st.x) * st.y * w0.y + b0.y); o.y = cvtpk((bflo(rw.y) - st.x) * st.y * w0.z + b0.z, (bfhi(rw.y) - st.x) * st.y * w0.w + b0.w);
                o.z = cvtpk((bflo(rw.z) - st.x) * st.y * w1.x + b1.x, (bfhi(rw.z) - st.x) * st.y * w1.y + b1.y); o.w = cvtpk((bflo(rw.w) - st.x) * st.y * w1.z + b1.z, (bfhi(rw.w) - st.x) * st.y * w1.w + b1.w);
                *(LAS v4u*)(wl + (s >> 3) * 512 + (s & 7) * 64 + ch * 16) = o; }
            if (cbi < 2) {
#pragma unroll
                for (int i = 0; i < 8; ++i) raw[i] = *(const v4u*)(F.PA + (size_t)(rowbase + (lane >> 2) + 16 * i) * PAP + C_AV + c0 + 32 + 8 * ch); }
            u32x2v uu[1][4], zz[1][4];
#define MA_LDUZ(TB) do { const size_t row_ = (size_t)(rowbase + 32 * (TB) + r32); _Pragma("unroll") for (int i = 0; i < 4; ++i) { \
                uu[0][i] = *(const u32x2v*)(F.PA + row_ * PAP + C_AU + c0 + 4 * hi + 8 * i); zz[0][i] = *(const u32x2v*)(F.PA + row_ * PAP + C_AZ + c0 + 4 * hi + 8 * i); } } while (0)
            const LAS unsigned char* vb = wl + hi * 512 + ((lane & 15) >> 2) * 64 + ((lane >> 4) & 1) * 32 + (lane & 3) * 8;
            const bf16* wr2 = wrow0; asm volatile("" : "+v"(wr2));
            bf16x8 wq[6];
            { int n2 = 0;
#pragma unroll
              for (int tb = 0; tb < 2; ++tb)
#pragma unroll
                  for (int ks = 0; ks < 2 * (tb + 1); ++ks) wq[n2++] = *(const bf16x8*)(wr2 + (size_t)tb * 32 * 128 + 16 * ks); }
            int n = 0, nq = 0;
#pragma unroll
            for (int tb = 0; tb < 4; ++tb) { f32x16 acc = {};
                MA_LDUZ(tb);
#pragma unroll
                for (int ks = 0; ks < 2 * (tb + 1); ++ks) { const s16x4 a = vtr(vb + ks * 1024), c = vtr(vb + ks * 1024 + 256); const bf16x8 af = {a[0], a[1], a[2], a[3], c[0], c[1], c[2], c[3]};
                    acc = __builtin_amdgcn_mfma_f32_32x32x16_bf16(af, tb < 2 ? wq[nq++] : wf[n++], acc, 0, 0, 0); }
                const int t = 32 * tb + r32; const size_t row = (size_t)(rowbase + t); const float sb = F.sp_b[g * 128 + t];
                bf16* yp = F.YC + row * KC + c0 + 4 * hi;
#pragma unroll
                for (int i = 0; i < 4; ++i) { const u32x2v u = uu[0][i], z = zz[0][i]; u32x2v w;
                    w.x = cvtpk(bflo(u.x) * (acc[4 * i] + sb) * bflo(z.x), bfhi(u.x) * (acc[4 * i + 1] + sb) * bfhi(z.x)); w.y = cvtpk(bflo(u.y) * (acc[4 * i + 2] + sb) * bflo(z.y), bfhi(u.y) * (acc[4 * i + 3] + sb) * bfhi(z.y));
                    *(u32x2v*)(yp + 8 * i) = w; } }
#undef MA_LDUZ
        }
        __syncthreads();
    }
}

__device__ __forceinline__ void st_mergeB_vec(Ctx& F) {
    constexpr int NI = 4;
    const int total = HB_ROWS * 32;
    for (int g0 = F.gtid; g0 < total; g0 += NI * F.T) {
        v4u a[NI], b[NI], c[NI], z[NI]; float l0[NI], l1[NI], l2[NI];
#pragma unroll
        for (int i = 0; i < NI; ++i) { const int gid = g0 + i * F.T < total ? g0 + i * F.T : g0; const int r = gid >> 5, c8 = (gid & 31) * 8, h = c8 >> 6;
            l0[i] = F.LSE[((size_t)0 * HB_ROWS + r) * 4 + h]; l1[i] = F.LSE[((size_t)1 * HB_ROWS + r) * 4 + h]; l2[i] = F.LSE[((size_t)2 * HB_ROWS + r) * 4 + h];
            a[i] = *(const v4u*)(F.OG + ((size_t)0 * HB_ROWS + r) * 256 + c8); b[i] = *(const v4u*)(F.OG + ((size_t)1 * HB_ROWS + r) * 256 + c8); c[i] = *(const v4u*)(F.OG + ((size_t)2 * HB_ROWS + r) * 256 + c8);
            z[i] = *(const v4u*)(F.PA + (size_t)r * PAP + C_BZ + c8); }
        __builtin_amdgcn_sched_barrier(0);
#pragma unroll
        for (int i = 0; i < NI; ++i) { if (g0 + i * F.T >= total) break; const int gid = g0 + i * F.T; const int r = gid >> 5, c8 = (gid & 31) * 8;
            const float mx = fmaxf(l0[i], fmaxf(l1[i], l2[i])); float e0 = __expf(l0[i] - mx), e1 = __expf(l1[i] - mx), e2 = __expf(l2[i] - mx); const float inv = 1.f / (e0 + e1 + e2); e0 *= inv; e1 *= inv; e2 *= inv;
            v4u o;
#define MB_1(X) X = pk2((e0 * bflo(a[i].X) + e1 * bflo(b[i].X) + e2 * bflo(c[i].X)) * bflo(z[i].X), (e0 * bfhi(a[i].X) + e1 * bfhi(b[i].X) + e2 * bfhi(c[i].X)) * bfhi(z[i].X))
            o.MB_1(x); o.MB_1(y); o.MB_1(z); o.MB_1(w);
#undef MB_1
            *(v4u*)(F.YC + (size_t)r * KC + 768 + c8) = o; }
    }
}

__device__ __forceinline__ void dma16(const void* gsrc, LAS unsigned char* ldst) { __builtin_amdgcn_global_load_lds((const unsigned*)gsrc, (LAS unsigned*)ldst, 16, 0, 0); }
#define VM_WAIT0() asm volatile("s_waitcnt vmcnt(0)" ::: "memory")


__device__ __forceinline__ void st_attnM_v3(Ctx& F, int hb) {
    const int lane = hw_lane(), r32 = lane & 31, hi = lane >> 5;
    LAS unsigned char* kimg = F.lds + RING_OFF; LAS unsigned char* vimg = F.lds + RING_OFF + 65536;
    LAS float* kstab = (LAS float*)(F.lds + WSCR_OFF + 8192);
    typedef unsigned u32x2v __attribute__((ext_vector_type(2)));
    const int vcu = F.xgwave >> 3;
    __syncthreads();
    for (int task = vcu; task < 256; task += F.G) {
        const int bh = task >> 2, b = bh >> 2, h = bh & 3; const size_t kbase = (size_t)(hb * 16 + b) * MEML;
#pragma unroll
        for (int j = 0; j < 8; ++j) { const int p = F.wave * 8 + j, row = 4 * p + (lane >> 4);
            dma16(F.KVM + (kbase + row) * 1024 + h * 128 + 8 * ((lane & 15) ^ (row & 15)), kimg + p * 1024);
            dma16(F.KVM + (kbase + 8 * (p >> 1) + ((lane & 31) >> 2)) * 1024 + 512 + h * 128 + (2 * (p & 1) + (lane >> 5)) * 32 + (lane & 3) * 8, vimg + p * 1024); }
        { const int key = F.wave * 32 + r32; const float* sp = F.MKSS + (kbase + key) * 16 + 4 * h;
          const float ksv = rsqrtf(((sp[0] + sp[1]) + (sp[2] + sp[3])) * (1.f / 128.f) + EPS); if (lane < 32) kstab[key] = ksv; }
        VM_WAIT0(); __syncthreads();
#pragma unroll 1
        for (int qi = 0; qi < 2; ++qi) {
            const int qb = (task & 3) * 16 + F.wave * 2 + qi;
            const size_t qrow = (size_t)(b * SEQ + qb * 32 + r32);
            const float qs = rsqrtf(((F.SS[qrow * SS_W + 96 + 4 * h] + F.SS[qrow * SS_W + 96 + 4 * h + 1]) + (F.SS[qrow * SS_W + 96 + 4 * h + 2] + F.SS[qrow * SS_W + 96 + 4 * h + 3])) * (1.f / 128.f) + EPS) * (0.08838834764831845f * LOG2E);
            bf16x8 qf[8];
#pragma unroll
            for (int d0 = 0; d0 < 8; ++d0) { const int dd = 16 * d0 + 8 * hi;
                const v4u raw = *(const v4u*)(F.PA + qrow * PAP + C_MQ + h * 128 + dd);
                const f32x4 wa = *(const f32x4*)(F.mqw + dd), wb = *(const f32x4*)(F.mqw + dd + 4), ka = *(const f32x4*)(F.mkw + dd), kb = *(const f32x4*)(F.mkw + dd + 4);
                v4u o;
                o.x = cvtpk(bflo(raw.x) * qs * wa.x * ka.x, bfhi(raw.x) * qs * wa.y * ka.y); o.y = cvtpk(bflo(raw.y) * qs * wa.z * ka.z, bfhi(raw.y) * qs * wa.w * ka.w);
                o.z = cvtpk(bflo(raw.z) * qs * wb.x * kb.x, bfhi(raw.z) * qs * wb.y * kb.y); o.w = cvtpk(bflo(raw.w) * qs * wb.z * kb.z, bfhi(raw.w) * qs * wb.w * kb.w);
                qf[d0] = __builtin_bit_cast(bf16x8, o); }
            u32x2v zz[4][4];
#pragma unroll
            for (int db = 0; db < 4; ++db)
#pragma unroll
                for (int i = 0; i < 4; ++i) zz[db][i] = *(const u32x2v*)(F.PA + qrow * PAP + C_MZ + h * 128 + 4 * hi + db * 32 + 8 * i);
            float mrun = -1e30f, lrun = 0.f; f32x16 o0 = {}, o1 = {}, o2 = {}, o3 = {};
            const LAS unsigned char* kb0 = kimg + r32 * 256; const int ksw = r32 & 15;
            const LAS unsigned char* vb0 = vimg + (4 * hi + ((lane & 15) >> 2)) * 64 + ((lane >> 4) & 1) * 32 + (lane & 3) * 8;
#pragma unroll 2
            for (int t = 0; t < MEML / 32; ++t) {
                f32x16 st = {};
#pragma unroll
                for (int d0 = 0; d0 < 8; ++d0) { const bf16x8 kf = *(const LAS bf16x8*)(kb0 + t * 8192 + (((2 * d0 + hi) ^ ksw) * 16)); st = __builtin_amdgcn_mfma_f32_32x32x16_bf16(kf, qf[d0], st, 0, 0, 0); }
                float tmax = -1e30f;
#pragma unroll
                for (int i = 0; i < 4; ++i) { const f32x4 kk = *(const LAS f32x4*)(kstab + 32 * t + 8 * i + 4 * hi);
#pragma unroll
                    for (int j = 0; j < 4; ++j) { const float s = st[4 * i + j] * kk[j]; st[4 * i + j] = s; tmax = fmaxf(tmax, s); } }
                tmax = fmaxf(tmax, __shfl_xor(tmax, 32));
                const float mnew = fmaxf(mrun, tmax), alpha = __builtin_amdgcn_exp2f(mrun - mnew); mrun = mnew;
                float psum = 0.f;
#pragma unroll
                for (int r = 0; r < 16; ++r) { st[r] = __builtin_amdgcn_exp2f(st[r] - mnew); psum += st[r]; }
                lrun = lrun * alpha + psum;
#pragma unroll
                for (int r = 0; r < 16; ++r) { o0[r] *= alpha; o1[r] *= alpha; o2[r] *= alpha; o3[r] *= alpha; }
                v4u p0, p1;
                p0.x = cvtpk(st[0], st[1]); p0.y = cvtpk(st[2], st[3]); p0.z = cvtpk(st[4], st[5]); p0.w = cvtpk(st[6], st[7]);
                p1.x = cvtpk(st[8], st[9]); p1.y = cvtpk(st[10], st[11]); p1.z = cvtpk(st[12], st[13]); p1.w = cvtpk(st[14], st[15]);
                const LAS unsigned char* vb = vb0 + t * 8192;
#define AM_PV(OX, DB) do { _Pragma("unroll") for (int s = 0; s < 2; ++s) { const bf16x8 pf = __builtin_bit_cast(bf16x8, s == 0 ? p0 : p1); \
                    const s16x4 a = vtr(vb + (2 * s) * 2048 + (DB) * 512), c = vtr(vb + (2 * s + 1) * 2048 + (DB) * 512); const bf16x8 vf = {a[0], a[1], a[2], a[3], c[0], c[1], c[2], c[3]}; \
                    OX = __builtin_amdgcn_mfma_f32_32x32x16_bf16(vf, pf, OX, 0, 0, 0); } } while (0)
                AM_PV(o0, 0); AM_PV(o1, 1); AM_PV(o2, 2); AM_PV(o3, 3);
#undef AM_PV
            }
            const float ltot = lrun + __shfl_xor(lrun, 32), inv = 1.f / ltot;
            bf16* yrow = F.YC + qrow * KC + 1024 + h * 128 + 4 * hi;
#define AM_ST(OX, DB) do { _Pragma("unroll") for (int i = 0; i < 4; ++i) { const u32x2v z = zz[DB][i]; u32x2v w; \
                w.x = cvtpk(OX[4 * i] * inv * bflo(z.x), OX[4 * i + 1] * inv * bfhi(z.x)); w.y = cvtpk(OX[4 * i + 2] * inv * bflo(z.y), OX[4 * i + 3] * inv * bfhi(z.y)); \
                *(u32x2v*)(yrow + (DB) * 32 + 8 * i) = w; } } while (0)
            AM_ST(o0, 0); AM_ST(o1, 1); AM_ST(o2, 2); AM_ST(o3, 3);
#undef AM_ST
        }
        __syncthreads();
    }
}

__device__ __forceinline__ void st_attnB_v3(Ctx& F) {
    const int lane = hw_lane(), r32 = lane & 31, hi = lane >> 5, tid = F.wave * 64 + lane;
    LAS unsigned char* kimg = F.lds + RING_OFF; LAS unsigned char* vimg = F.lds + RING_OFF + 49152;
    LAS float* kstab = (LAS float*)(F.lds + RING_OFF + 98304);
    LAS float* btab = (LAS float*)(F.lds + RING_OFF + 98304 + 2048);
    typedef unsigned u32x2v __attribute__((ext_vector_type(2)));
    const int vcu = F.xgwave >> 3;
    __syncthreads();
    for (int unit = vcu; unit < 3 * 16 * 4 * 8; unit += F.G) {
        const int k = unit & 7, h = (unit >> 3) & 3, b = (unit >> 5) & 15, g = unit >> 9, hh = 4 * g + h;
        const int dil = g == 0 ? 1 : (g == 1 ? 4 : 16);
        const int res0 = g == 0 ? 0 : (g == 1 ? (k >> 1) : 2 * k), j0 = g == 0 ? 8 * k : (g == 1 ? 8 * (k & 1) : 0);
#pragma unroll
        for (int i = 0; i < 12; ++i) { const int q = F.wave * 12 + i, s = q >> 3, pc = q & 7, p = pc & 3;
            int res, jt; bool valid;
            if (g < 2) { res = res0; jt = j0 - 4 + s; valid = jt >= 0; } else { res = res0 + (s >> 2); jt = s & 3; valid = s < 8; }
            if (valid) {
                if (pc < 4) { const int row = 8 * p + (lane >> 3); const size_t trow = (size_t)(b * SEQ + res + (32 * jt + row) * dil);
                    dma16(F.PA + trow * PAP + C_BK + hh * 64 + 8 * ((lane & 7) ^ ((row >> 1) & 7)), kimg + s * 4096 + p * 1024); }
                else { const int key = 8 * p + ((lane & 31) >> 2); const size_t trow = (size_t)(b * SEQ + res + (32 * jt + key) * dil);
                    dma16(F.PA + trow * PAP + C_BV + hh * 64 + (lane >> 5) * 32 + (lane & 3) * 8, vimg + s * 4096 + p * 1024); } } }
        if (tid < 384) { const int s = tid >> 5, kk = tid & 31; int res, jt; bool valid;
            if (g < 2) { res = res0; jt = j0 - 4 + s; valid = jt >= 0; } else { res = res0 + (s >> 2); jt = s & 3; valid = s < 8; }
            if (valid) { const size_t trow = (size_t)(b * SEQ + res + (32 * jt + kk) * dil);
                kstab[tid] = rsqrtf((F.SS[trow * SS_W + 72 + 2 * hh] + F.SS[trow * SS_W + 72 + 2 * hh + 1]) * (1.f / 64.f) + EPS); } }
        if (tid < NBX) btab[tid] = F.BIASX[(g * 4 + h) * NBX + tid];
        const int wres = g < 2 ? res0 : res0 + (F.wave >> 2), j = g < 2 ? j0 + F.wave : (F.wave & 3);
        const int sbase = g < 2 ? 4 - j0 : (F.wave >> 2) * 4;
        const size_t qrow = (size_t)(b * SEQ + wres + (32 * j + r32) * dil);
        const float qs = rsqrtf((F.SS[qrow * SS_W + 48 + 2 * hh] + F.SS[qrow * SS_W + 48 + 2 * hh + 1]) * (1.f / 64.f) + EPS) * (0.125f * LOG2E);
        bf16x8 qf[4];
#pragma unroll
        for (int d0 = 0; d0 < 4; ++d0) { const int dd = 16 * d0 + 8 * hi;
            const v4u raw = *(const v4u*)(F.PA + qrow * PAP + C_BQ + hh * 64 + dd);
            const f32x4 wa = *(const f32x4*)(F.bqw + dd), wb = *(const f32x4*)(F.bqw + dd + 4), ka = *(const f32x4*)(F.bkw + dd), kb = *(const f32x4*)(F.bkw + dd + 4);
            v4u o;
            o.x = cvtpk(bflo(raw.x) * qs * wa.x * ka.x, bfhi(raw.x) * qs * wa.y * ka.y); o.y = cvtpk(bflo(raw.y) * qs * wa.z * ka.z, bfhi(raw.y) * qs * wa.w * ka.w);
            o.z = cvtpk(bflo(raw.z) * qs * wb.x * kb.x, bfhi(raw.z) * qs * wb.y * kb.y); o.w = cvtpk(bflo(raw.w) * qs * wb.z * kb.z, bfhi(raw.w) * qs * wb.w * kb.w);
            qf[d0] = __builtin_bit_cast(bf16x8, o); }
        VM_WAIT0(); __syncthreads();
        float mrun = -1e30f, lrun = 0.f; f32x16 o0 = {}, o1 = {};
        const int ksw = (r32 >> 1) & 7;
        for (int jt = (j >= 4 ? j - 4 : 0); jt <= j; ++jt) {
            const int s = sbase + jt;
            const LAS unsigned char* kb = kimg + s * 4096 + r32 * 128;
            f32x16 st = {};
#pragma unroll
            for (int d0 = 0; d0 < 4; ++d0) { const bf16x8 kf = *(const LAS bf16x8*)(kb + (((2 * d0 + hi) ^ ksw) * 16)); st = __builtin_amdgcn_mfma_f32_32x32x16_bf16(kf, qf[d0], st, 0, 0, 0); }
            const int bidx = 32 * (j - jt) + r32 + 31 - 4 * hi;
            float tmax = -1e30f;
#pragma unroll
            for (int i = 0; i < 4; ++i) { const f32x4 kk = *(const LAS f32x4*)(kstab + s * 32 + 8 * i + 4 * hi);
#pragma unroll
                for (int jj = 0; jj < 4; ++jj) { const float sv = st[4 * i + jj] * kk[jj] + btab[bidx - 8 * i - jj]; st[4 * i + jj] = sv; tmax = fmaxf(tmax, sv); } }
            tmax = fmaxf(tmax, __shfl_xor(tmax, 32));
            const float mnew = fmaxf(mrun, tmax), alpha = __builtin_amdgcn_exp2f(mrun - mnew); mrun = mnew;
            float psum = 0.f;
#pragma unroll
            for (int r = 0; r < 16; ++r) { st[r] = __builtin_amdgcn_exp2f(st[r] - mnew); psum += st[r]; }
            lrun = lrun * alpha + psum;
#pragma unroll
            for (int r = 0; r < 16; ++r) { o0[r] *= alpha; o1[r] *= alpha; }
            v4u p0, p1;
            p0.x = cvtpk(st[0], st[1]); p0.y = cvtpk(st[2], st[3]); p0.z = cvtpk(st[4], st[5]); p0.w = cvtpk(st[6], st[7]);
            p1.x = cvtpk(st[8], st[9]); p1.y = cvtpk(st[10], st[11]); p1.z = cvtpk(st[12], st[13]); p1.w = cvtpk(st[14], st[15]);
            const LAS unsigned char* vb = vimg + s * 4096 + (4 * hi + ((lane & 15) >> 2)) * 64 + ((lane >> 4) & 1) * 32 + (lane & 3) * 8;
#pragma unroll
            for (int ss = 0; ss < 2; ++ss) { const bf16x8 pf = __builtin_bit_cast(bf16x8, ss == 0 ? p0 : p1);
                { const s16x4 a = vtr(vb + (2 * ss) * 1024), c = vtr(vb + (2 * ss + 1) * 1024); const bf16x8 vf = {a[0], a[1], a[2], a[3], c[0], c[1], c[2], c[3]};
                  o0 = __builtin_amdgcn_mfma_f32_32x32x16_bf16(vf, pf, o0, 0, 0, 0); }
                { const s16x4 a = vtr(vb + (2 * ss) * 1024 + 512), c = vtr(vb + (2 * ss + 1) * 1024 + 512); const bf16x8 vf = {a[0], a[1], a[2], a[3], c[0], c[1], c[2], c[3]};
                  o1 = __builtin_amdgcn_mfma_f32_32x32x16_bf16(vf, pf, o1, 0, 0, 0); } }
        }
        const float ltot = lrun + __shfl_xor(lrun, 32), inv = 1.f / ltot;
        bf16* orow = F.OG + ((size_t)g * HB_ROWS + qrow) * 256 + h * 64 + 4 * hi;
#pragma unroll
        for (int i = 0; i < 4; ++i) { u32x2v w0, w1; w0.x = cvtpk(o0[4 * i] * inv, o0[4 * i + 1] * inv); w0.y = cvtpk(o0[4 * i + 2] * inv, o0[4 * i + 3] * inv);
            w1.x = cvtpk(o1[4 * i] * inv, o1[4 * i + 1] * inv); w1.y = cvtpk(o1[4 * i + 2] * inv, o1[4 * i + 3] * inv);
            *(u32x2v*)(orow + 8 * i) = w0; *(u32x2v*)(orow + 32 + 8 * i) = w1; }
        if (hi == 0) F.LSE[((size_t)g * HB_ROWS + qrow) * 4 + h] = (mrun + __log2f(ltot)) * LN2;
        __syncthreads();
    }
}

#ifndef G1_STAGGER_TICKS
#define G1_STAGGER_TICKS 0
#endif
#ifndef G1_ALIGN_EPI
#define G1_ALIGN_EPI true
#endif
#ifndef PROBE_REP
#define PROBE_REP -1
#endif
#define REPS(id) for (int rep_ = 0; rep_ < ((PROBE_REP) == (id) ? 2 : 1); ++rep_)
#ifndef MK_PER_PHASE
#define MK_PER_PHASE 0
#endif
constexpr int NPH_HALF = 5, NPHASES = 1 + 2 * NPH_HALF;
struct Args { const float* in[20]; float* out; unsigned char* ws; int ph_lo, ph_hi; };
__global__ void __launch_bounds__(NTHR, 2) mega_fwd(Args args) {
    extern __shared__ __attribute__((aligned(16))) unsigned char lds_raw[];
    Ctx F;
    F.lds = (LAS unsigned char*)lds_raw;
    F.tid = threadIdx.x; F.lane = F.tid & 63; F.wave = __builtin_amdgcn_readfirstlane(F.tid >> 6);
    F.G = gridDim.x; F.gtid = blockIdx.x * NTHR + F.tid; F.T = F.G * NTHR; F.gwave = blockIdx.x * NWAVES + F.wave; F.NW = F.G * NWAVES;
    { const int bx = blockIdx.x; const int vcu = (F.G % 8 == 0) ? (bx % 8) * (F.G / 8) + bx / 8 : bx; F.xgwave = vcu * NWAVES + F.wave; }
    unsigned char* ws = args.ws;
    F.x = args.in[0]; F.mem = args.in[1]; F.norm_w = args.in[2]; F.w_in = args.in[3]; F.gate_b = args.in[4]; F.lnw = args.in[5]; F.lnb = args.in[6]; F.sp_w = args.in[7];
    F.sp_b = args.in[8]; F.bqw = args.in[9]; F.bkw = args.in[10]; F.rel_bias = args.in[11]; F.mem_norm_w = args.in[12]; F.m_w_kv = args.in[13]; F.mqw = args.in[14]; F.mkw = args.in[15];
    F.proj_a = args.in[16]; F.proj_b = args.in[17]; F.proj_m = args.in[18]; F.w_out = args.in[19]; F.out = args.out;
    F.WIN = (bf16*)(ws + WS_WIN); F.PCAT = (bf16*)(ws + WS_PCAT); F.WOUT = (bf16*)(ws + WS_WOUT); F.WSP = (bf16*)(ws + WS_WSP); F.BIAS = (float*)(ws + WS_BIAS); F.BIASX = (float*)(ws + WS_BIAS + 65536);
    F.XN = (bf16*)(ws + WS_XN); F.PA = (bf16*)(ws + WS_PA); F.KVM = (bf16*)(ws + WS_KVM); F.SS = (float*)(ws + WS_SS); F.MKSS = (float*)(ws + WS_MKSS);
    F.OG = (bf16*)(ws + WS_OG); F.LSE = (float*)(ws + WS_LSE); F.LNST = (float*)(ws + WS_LNST); F.YC = (bf16*)(ws + WS_YC); F.MRG = (bf16*)(ws + WS_MRG);
    for (int u = F.tid; u < (LDS_BYTES - LDSCTL_OFF) / 4; u += NTHR) ((LAS unsigned*)(F.lds + LDSCTL_OFF))[u] = 0u;
    __syncthreads();
    XcdBarrier bar; bar.bar = (unsigned*)(ws + WS_CTL) + CW_BAR; bar.x = 0; bar.st = nullptr; bar.wave = 0;
    if (!MK_PER_PHASE) bar = xcd_barrier_post((unsigned*)(ws + WS_CTL) + CW_BAR, (volatile LAS unsigned*)(F.lds + MISC_OFF) + 8, F.wave);
    const int lo = args.ph_lo, hi = args.ph_hi;
#define IN(k) (lo <= (k) && (k) < hi)
#define SEAM(k) do { if (IN(k) && IN((k) + 1)) xcd_barrier(bar); } while (0)

    if (IN(0)) { REPS(0) p0_prologue(F); } SEAM(0);
#pragma unroll 1
    for (int hb = 0; hb < 2; ++hb) {
        const int pb = 1 + hb * NPH_HALF, row0 = hb * HB_ROWS;
        asm volatile("v_mbcnt_lo_u32_b32 %0, -1, 0\n\tv_mbcnt_hi_u32_b32 %0, -1, %0" : "=v"(F.lane)); F.tid = F.wave * 64 + F.lane; F.gtid = blockIdx.x * NTHR + F.tid;
#if PROBE_REP == 9 || PROBE_REP == 10
        if (IN(pb + 0)) { pg8::Gemm g{F.XN, F.WIN, MTOT + MMEM, NIN + 1024, DM, DM, DM}; pg8::OrderG1 S; S.init(hb, F.G, (int)blockIdx.x);
            typedef pg8::EpiProjT<PROBE_REP - 8> EP; EP E{F.PA, F.KVM, F.SS, F.MKSS, F.gate_b, hb * (HB_ROWS / 256), 0};
            pg8::gemm_phase<EP, pg8::OrderG1, true, true>(F.lds + RING_OFF, g, S, E, F.wave); }
#endif
        if (IN(pb + 0)) REPS(1) {
            pg8::Gemm g{F.XN, F.WIN, MTOT + MMEM, NIN + 1024, DM, DM, DM}; pg8::OrderG1 S; S.init(hb, F.G, (int)blockIdx.x);
#if G1_STAGGER_TICKS
            { const unsigned long long t0 = __builtin_amdgcn_s_memrealtime(), dl = (unsigned long long)((blockIdx.x >> 3) & 31) * G1_STAGGER_TICKS;
              while (__builtin_amdgcn_s_memrealtime() - t0 < dl) __builtin_amdgcn_s_sleep(8); }
#endif
            pg8::EpiProj E{F.PA, F.KVM, F.SS, F.MKSS, F.gate_b, hb * (HB_ROWS / 256), 0};
            pg8::gemm_phase<pg8::EpiProj, pg8::OrderG1, G1_ALIGN_EPI, true>(F.lds + RING_OFF, g, S, E, F.wave);
        }
#if PROBE_REP == 8
        if (IN(pb + 0)) { pg8::Gemm g{F.XN, F.WIN, MTOT + MMEM, NIN + 1024, DM, DM, DM}; pg8::OrderG1 S; S.init(hb, F.G, (int)blockIdx.x); pg8::EpiNull E{};
            pg8::gemm_phase<pg8::EpiNull, pg8::OrderG1, true, true>(F.lds + RING_OFF, g, S, E, F.wave); }
#endif
        SEAM(pb + 0);
        if (IN(pb + 1)) { REPS(2) st_mixA_mfma(F); REPS(3) st_attnB_v3(F); REPS(4) st_attnM_v3(F, hb); } SEAM(pb + 1);
        if (IN(pb + 2)) { REPS(5) st_mergeB_vec(F); } SEAM(pb + 2);
#if PROBE_REP == 13 || PROBE_REP == 14
        if (IN(pb + 3)) { pg8::Gemm g{F.YC, F.PCAT, HB_ROWS, DM, KC, KC, KC}; pg8::StaticOrder S; S.init(HB_ROWS, DM, F.G, (int)blockIdx.x);
            typedef pg8::EpiG2catT<PROBE_REP == 13, PROBE_REP == 14> EP; EP E{F.PA, F.MRG};
            pg8::gemm_phase<EP, pg8::StaticOrder, true, true>(F.lds + RING_OFF, g, S, E, F.wave); }
#endif
#if PROBE_REP == 11
        if (IN(pb + 3)) { pg8::Gemm g{F.YC, F.PCAT, HB_ROWS, DM, KC, KC, KC}; pg8::StaticOrder S; S.init(HB_ROWS, DM, F.G, (int)blockIdx.x); pg8::EpiNull E{};
            pg8::gemm_phase<pg8::EpiNull, pg8::StaticOrder, true, true>(F.lds + RING_OFF, g, S, E, F.wave); }
#endif
#if PROBE_REP == 12
        if (IN(pb + 4)) { pg8::Gemm g{F.MRG, F.WOUT, HB_ROWS, DM, DM, DM, DM}; pg8::StaticOrder S; S.init(HB_ROWS, DM, F.G, (int)blockIdx.x); pg8::EpiNull E{};
            pg8::gemm_phase<pg8::EpiNull, pg8::StaticOrder, true, true>(F.lds + RING_OFF, g, S, E, F.wave); }
#endif
        if (IN(pb + 3)) REPS(6) {
            pg8::Gemm g{F.YC, F.PCAT, HB_ROWS, DM, KC, KC, KC}; pg8::StaticOrder S; S.init(HB_ROWS, DM, F.G, (int)blockIdx.x);
            pg8::EpiG2cat E{F.PA, F.MRG};
            pg8::gemm_phase<pg8::EpiG2cat, pg8::StaticOrder, true, true>(F.lds + RING_OFF, g, S, E, F.wave);
        } SEAM(pb + 3);
        if (IN(pb + 4)) REPS(7) {
            pg8::Gemm g{F.MRG, F.WOUT, HB_ROWS, DM, DM, DM, DM}; pg8::StaticOrder S; S.init(HB_ROWS, DM, F.G, (int)blockIdx.x);
            pg8::EpiG3 E{F.x + (size_t)row0 * DM, F.out + (size_t)row0 * DM};
            pg8::gemm_phase<pg8::EpiG3, pg8::StaticOrder, true, true>(F.lds + RING_OFF, g, S, E, F.wave);
        } if (hb == 1) SEAM(pb + 4);
    }
#undef IN
#undef SEAM
}

extern "C" void kernel_launch(void* const* d_in, const int* in_sizes, int n_in, void* d_out, int out_size, void* d_ws, size_t ws_size, hipStream_t stream) {
    static int grid = 0;
    if (grid == 0) {
        if (n_in != 20 || in_sizes[0] != MTOT * DM || out_size != MTOT * DM || ws_size < WS_END) { fprintf(stderr, "kernel_launch: unexpected shapes (n_in %d, ws %zu); nothing launched\n", n_in, ws_size); grid = -1; return; }
        int dev = 0, cus = 0, per_cu = 0;
        if (hipGetDevice(&dev) != hipSuccess || hipDeviceGetAttribute(&cus, hipDeviceAttributeMultiprocessorCount, dev) != hipSuccess) { grid = -1; return; }
        if (hipFuncSetAttribute((const void*)mega_fwd, hipFuncAttributeMaxDynamicSharedMemorySize, LDS_BYTES) != hipSuccess) { fprintf(stderr, "kernel_launch: hipFuncSetAttribute failed\n"); grid = -1; return; }
        if (hipOccupancyMaxActiveBlocksPerMultiprocessor(&per_cu, (const void*)mega_fwd, NTHR, LDS_BYTES) != hipSuccess || per_cu < 1) { fprintf(stderr, "kernel_launch: occupancy query says %d blocks per CU\n", per_cu); (void)hipGetLastError(); grid = -1; return; }
        grid = cus;
    }
    if (grid < 0) return;
    if (hipMemsetAsync((char*)d_ws + WS_CTL, 0, CTL_ZERO_BYTES, stream) != hipSuccess) return;
    Args a{};
    for (int i = 0; i < 20; ++i) a.in[i] = (const float*)d_in[i];
    a.out = (float*)d_out; a.ws = (unsigned char*)d_ws;
#if MK_PER_PHASE
    for (int p = 0; p < NPHASES; ++p) { a.ph_lo = p; a.ph_hi = p + 1; hipLaunchKernelGGL(mega_fwd, dim3(grid), dim3(NTHR), LDS_BYTES, stream, a); }
#else
    a.ph_lo = 0; a.ph_hi = NPHASES; hipLaunchKernelGGL(mega_fwd, dim3(grid), dim3(NTHR), LDS_BYTES, stream, a);
#endif
}
```

```cpp
#include <hip/hip_runtime.h>
#include <cstdint>
#include <cstdio>

constexpr int DM = 1024, NB = 32, SEQ = 2048, MTOT = NB * SEQ;
constexpr int NIN = 8960, MEML = 256, MMEM = NB * MEML;
constexpr int HB_ROWS = MTOT / 2;
constexpr int C_AU = 0, C_AV = 768, C_AZ = 1536, C_BQ = 2304, C_BK = 3072, C_BV = 3840, C_BZ = 4608, C_MQ = 4864, C_MZ = 5376, C_G = 5888;
constexpr float EPS = 1e-6f;
constexpr int SS_W = 112;
constexpr int PAP = 7424;
constexpr int PA_ROWB = 2 * PAP, PA_GOFF = 2 * C_G;
constexpr int KC = 1536;

constexpr size_t MiB = 1u << 20;
constexpr size_t WS_CTL = 0, CTL_ZERO_BYTES = 256 * 1024, WS_WIN = 2 * MiB, WS_PCAT = 22 * MiB, WS_WOUT = 25 * MiB, WS_WSP = 27 * MiB, WS_BIAS = 27 * MiB + 512 * 1024;
constexpr size_t WS_XN = 32 * MiB, WS_PA = 176 * MiB, WS_KVM = 736 * MiB, WS_SS = 752 * MiB, WS_MKSS = 766 * MiB, WS_OG = 768 * MiB, WS_LSE = 816 * MiB, WS_LNST = 818 * MiB;
constexpr size_t WS_YC = 820 * MiB, WS_MRG = 916 * MiB, WS_END = 980 * MiB;
constexpr int CW_BAR = 4096;

namespace pg8 {
#define PG8_LAS __attribute__((address_space(3)))
typedef unsigned short bf16_t;
typedef short bf16x8 __attribute__((ext_vector_type(8)));
typedef float f32x4 __attribute__((ext_vector_type(4)));
typedef unsigned u32x4 __attribute__((ext_vector_type(4)));
constexpr int BM = 256, BK = 64, HALF = 128, HTB = HALF * BK * 2  , STAGE_BYTES = 8 * HTB, NXCD = 8, WGM = 8;

__host__ __device__ __forceinline__ int lds_byte(int r, int c) { const int st = (r >> 4) * 2 + (c >> 5), rr = r & 15, cc = c & 31, ob = rr * 64 + cc * 2; return st * 1024 + (ob ^ (((ob >> 9) & 1) << 5)); }
__host__ __device__ __forceinline__ void stage_rc(int b, int& R, int& C) { const int st = b / 1024, sb = b % 1024, swz = sb ^ (((sb >> 9) & 1) << 5); R = (st >> 1) * 16 + swz / 64; C = (st & 1) * 32 + (swz % 64) / 2; }
__host__ __device__ __forceinline__ int perm32(int rho) { const int n = rho >> 4, i = rho & 15; return 8 * (i >> 2) + 4 * n + (i & 3); }

struct Unit { int pm, pn; };
struct Gemm { const bf16_t* A; const bf16_t* Bt; int M, N, K, lda, ldb; };

struct StaticOrder {
    int nM, nN, nwg, G, c;
    __host__ __device__ void init(int M, int N, int G_, int c_) { nM = M / BM; nN = N / BM; nwg = nM * nN; G = G_; c = c_; }
    __host__ __device__ bool next(int i, Unit& u) const {
        const long L = (long)i * G + c; if (L >= nwg) return false;
        int wgid = (int)L; { const int q = nwg / NXCD, r = nwg % NXCD, xcd = wgid % NXCD, off = wgid / NXCD; wgid = (xcd < r ? xcd * (q + 1) : r * (q + 1) + (xcd - r) * q) + off; }
        const int nig = WGM * nN, gid = wgid / nig, fm = gid * WGM, gsz = (nM - fm) < WGM ? (nM - fm) : WGM;
        u.pm = fm + ((wgid % nig) % gsz); u.pn = (wgid % nig) / gsz; return true;
    }
    __device__ __forceinline__ void a_ready(const Unit&) const {}
    __device__ __forceinline__ void done(const Unit&) const {}
};


typedef float f32x2c_t __attribute__((ext_vector_type(2))); typedef __bf16 bf16x2c_t __attribute__((ext_vector_type(2)));
__device__ __forceinline__ unsigned cvt_pk_bf16(float lo, float hi) { const f32x2c_t v = {lo, hi}; const bf16x2c_t b = __builtin_convertvector(v, bf16x2c_t); return __builtin_bit_cast(unsigned, b); }
typedef float f32x2 __attribute__((ext_vector_type(2)));
__device__ __forceinline__ f32x2 gelu_pk(f32x2 v) {
    const f32x2 av = __builtin_elementwise_abs(v), d = av * 0.2316418882f + 1.0f;
    f32x2 t; t.x = __builtin_amdgcn_rcpf(d.x); t.y = __builtin_amdgcn_rcpf(d.y);
    f32x2 q = t * 0.5307027145f + (-0.7265760135f); q = q * t + 0.7107068705f; q = q * t + (-0.142248368f); q = q * t + 0.127414796f; q = q * t;
    const f32x2 s = (v * v) * (-0.72134752044f);
    f32x2 e; e.x = __builtin_amdgcn_exp2f(s.x); e.y = __builtin_amdgcn_exp2f(s.y);
    const f32x2 m = v * (q * e), r = v - m;
    f32x2 o; o.x = v.x < 0.f ? m.x : r.x; o.y = v.y < 0.f ? m.y : r.y; return o;
}

template <class Epi, class Sched, bool ALIGN_EPI = false, bool SP2 = false>
__device__ __forceinline__ void gemm_phase(PG8_LAS unsigned char* lds, const Gemm g, const Sched& S, const Epi& E, const int wave_id) {
    int tid; asm volatile("v_mbcnt_lo_u32_b32 %0, -1, 0\n\tv_mbcnt_hi_u32_b32 %0, -1, %0" : "=v"(tid)); tid += wave_id * 64;
    const int wid = __builtin_amdgcn_readfirstlane(tid >> 6), lane = tid & 63, wr = wid >> 2, wc = wid & 3, fr = lane & 15, fq = lane >> 4;
    int K = g.K; asm volatile("" : "+s"(K)); const int nt = K / BK;
    unsigned voffA[2], voffB[2];
#pragma unroll
    for (int i = 0; i < 2; ++i) { int R, C; stage_rc(tid * 16 + i * 8192, R, C); const int Rb = Epi::PERM ? ((R & ~31) + perm32(R & 31)) : R;
        voffA[i] = (unsigned)(R * g.lda + C) * 2u; voffB[i] = (unsigned)(Rb * g.ldb + C) * 2u; }
    const size_t kstep = (size_t)(BK * 2);
    const size_t hstepA = (size_t)HALF * g.lda * 2, hstepB = (size_t)HALF * g.ldb * 2;
    const size_t tstepA = 2 * hstepA, tstepB = 2 * hstepB;
    const unsigned ldsw = (unsigned)wid * 1024u;
    const int aoff = lds_byte(wr * 64 + fr, fq * 8), boff = lds_byte(wc * 32 + fr, fq * 8);
#define PG8_SA(b, h) (((b) * 2 + (h)) * HTB)
#define PG8_SB(b, h) ((4 + (b) * 2 + (h)) * HTB)
#define PG8_STAGE(bufoff, gbase, voff) do { _Pragma("unroll") for (int _i = 0; _i < 2; ++_i) \
        __builtin_amdgcn_global_load_lds((const unsigned*)((const char*)(gbase) + (voff)[_i]), (PG8_LAS unsigned*)(lds + (bufoff) + ldsw + _i * 8192), 16, 0, 0); } while (0)
#define PG8_LDA(dst, b, h) do { _Pragma("unroll") for (int m = 0; m < 4; ++m) _Pragma("unroll") for (int k = 0; k < 2; ++k) dst[m][k] = *(const PG8_LAS bf16x8*)(lds + PG8_SA(b, h) + aoff + m * 2048 + k * 1024); } while (0)
#define PG8_LDB(dst, b, h) do { _Pragma("unroll") for (int n = 0; n < 2; ++n) _Pragma("unroll") for (int k = 0; k < 2; ++k) dst[n][k] = *(const PG8_LAS bf16x8*)(lds + PG8_SB(b, h) + boff + n * 2048 + k * 1024); } while (0)
#define PG8_MMA(ai, bj, At, Bt) do { __builtin_amdgcn_s_setprio(1); _Pragma("unroll") for (int m = 0; m < 4; ++m) _Pragma("unroll") for (int n = 0; n < 2; ++n) _Pragma("unroll") for (int k = 0; k < 2; ++k) \
        acc[ai][bj][m][n] = __builtin_amdgcn_mfma_f32_16x16x32_bf16(Bt[n][k], At[m][k], acc[ai][bj][m][n], 0, 0, 0); __builtin_amdgcn_s_setprio(0); } while (0)
#define PG8_WAIT_V(n) asm volatile("s_waitcnt vmcnt(" #n ")" ::: "memory")
#define PG8_WAIT_L(n) asm volatile("s_waitcnt lgkmcnt(" #n ")" ::: "memory")
#define PG8_BAR __builtin_amdgcn_s_barrier()
#define PG8_SCHED __builtin_amdgcn_sched_barrier(0)
    Unit cur, nxt; int ui = 0;
    if (!S.next(0, cur)) return;
    f32x4 acc[2][2][4][2];
#pragma unroll
    for (int a = 0; a < 2; ++a)
#pragma unroll
        for (int b = 0; b < 2; ++b)
#pragma unroll
            for (int m = 0; m < 4; ++m)
#pragma unroll
                for (int n = 0; n < 2; ++n) acc[a][b][m][n] = (f32x4){0.f, 0.f, 0.f, 0.f};
    bf16x8 At[4][2], B0[2][2], B1[2][2];
    const char* cA = (const char*)g.A + (size_t)cur.pm * tstepA; const char* cB = (const char*)g.Bt + (size_t)cur.pn * tstepB;
    S.a_ready(cur);
    if constexpr (SP2) {
        PG8_STAGE(PG8_SB(0, 0), cB, voffB); PG8_STAGE(PG8_SB(0, 1), cB + hstepB, voffB); PG8_STAGE(PG8_SA(0, 0), cA, voffA); PG8_STAGE(PG8_SA(0, 1), cA + hstepA, voffA);
        if (wr == 1) PG8_BAR;
        PG8_WAIT_V(2); PG8_BAR;
        PG8_STAGE(PG8_SB(1, 0), cB + kstep, voffB); PG8_STAGE(PG8_SA(1, 0), cA + kstep, voffA); PG8_STAGE(PG8_SB(1, 1), cB + hstepB + kstep, voffB);
        PG8_WAIT_V(6); PG8_BAR;
    } else {
        PG8_STAGE(PG8_SB(0, 0), cB, voffB); PG8_STAGE(PG8_SA(0, 0), cA, voffA); PG8_STAGE(PG8_SB(0, 1), cB + hstepB, voffB); PG8_STAGE(PG8_SA(0, 1), cA + hstepA, voffA);
        if (wr == 1) PG8_BAR;
        PG8_WAIT_V(4); PG8_BAR;
        PG8_STAGE(PG8_SB(1, 0), cB + kstep, voffB); PG8_STAGE(PG8_SA(1, 0), cA + kstep, voffA); PG8_STAGE(PG8_SB(1, 1), cB + hstepB + kstep, voffB);
        PG8_WAIT_V(6); PG8_BAR;
    }
    for (;;) {
        const bool has_next = S.next(ui + 1, nxt);
        const char* nA = has_next ? (const char*)g.A + (size_t)nxt.pm * tstepA : cA; const char* nB = has_next ? (const char*)g.Bt + (size_t)nxt.pn * tstepB : cB;
        for (int t = 0; t < nt; t += 2) {
            if constexpr (Epi::KHOOK) { if (t == Epi::KH1 || t == Epi::KH2) E.khook(acc, cur, t, wr, wc, fr, fq); }
            const bool last = (t == nt - 2);
            const char* a1 = cA + (size_t)(t + 1) * kstep;
            const char* a2 = last ? nA : cA + (size_t)(t + 2) * kstep; const char* b2 = last ? nB : cB + (size_t)(t + 2) * kstep;
            const char* a3 = a2 + kstep; const char* b3 = b2 + kstep;
            if (last && has_next) S.a_ready(nxt);
            if constexpr (SP2) {
            PG8_LDB(B0, 0, 0); PG8_LDB(B1, 0, 1); PG8_SCHED; PG8_LDA(At, 0, 0); PG8_STAGE(PG8_SA(1, 1), a1 + hstepA, voffA);
            PG8_WAIT_V(8); PG8_WAIT_L(0); PG8_BAR; PG8_MMA(0, 0, At, B0); PG8_MMA(0, 1, At, B1); PG8_BAR; PG8_SCHED;
            PG8_LDA(At, 0, 1); PG8_STAGE(PG8_SB(0, 0), b2, voffB); PG8_STAGE(PG8_SB(0, 1), b2 + hstepB, voffB); PG8_STAGE(PG8_SA(0, 0), a2, voffA);
            PG8_WAIT_V(8); PG8_WAIT_L(0); PG8_BAR; PG8_MMA(1, 0, At, B0); PG8_MMA(1, 1, At, B1); PG8_BAR; PG8_SCHED;
            PG8_LDB(B0, 1, 0); PG8_LDB(B1, 1, 1); PG8_SCHED; PG8_LDA(At, 1, 0); PG8_STAGE(PG8_SA(0, 1), a2 + hstepA, voffA);
            PG8_WAIT_V(8); PG8_WAIT_L(0); PG8_BAR; PG8_MMA(0, 0, At, B0); PG8_MMA(0, 1, At, B1); PG8_BAR; PG8_SCHED;
            PG8_LDA(At, 1, 1); PG8_STAGE(PG8_SB(1, 0), b3, voffB); PG8_STAGE(PG8_SB(1, 1), b3 + hstepB, voffB); PG8_STAGE(PG8_SA(1, 0), a3, voffA);
            PG8_WAIT_V(8); PG8_WAIT_L(0); PG8_BAR; PG8_MMA(1, 0, At, B0); PG8_MMA(1, 1, At, B1); PG8_BAR; PG8_SCHED;
            } else {
            PG8_LDB(B0, 0, 0); PG8_SCHED; PG8_LDA(At, 0, 0); PG8_STAGE(PG8_SA(1, 1), a1 + hstepA, voffA);
            PG8_WAIT_L(8); PG8_BAR; PG8_WAIT_L(0); PG8_MMA(0, 0, At, B0); PG8_BAR; PG8_SCHED;
            PG8_LDB(B1, 0, 1); PG8_STAGE(PG8_SB(0, 0), b2, voffB);
            PG8_BAR; PG8_WAIT_L(0); PG8_MMA(0, 1, At, B1); PG8_BAR;
            PG8_LDA(At, 0, 1); PG8_STAGE(PG8_SA(0, 0), a2, voffA);
            PG8_BAR; PG8_WAIT_L(0); PG8_MMA(1, 0, At, B0); PG8_BAR; PG8_SCHED;
            PG8_STAGE(PG8_SB(0, 1), b2 + hstepB, voffB);
            PG8_WAIT_V(6); PG8_BAR; PG8_MMA(1, 1, At, B1); PG8_BAR;
            PG8_LDB(B0, 1, 0); PG8_SCHED; PG8_LDA(At, 1, 0); PG8_STAGE(PG8_SA(0, 1), a2 + hstepA, voffA);
            PG8_WAIT_L(8); PG8_BAR; PG8_WAIT_L(0); PG8_MMA(0, 0, At, B0); PG8_BAR; PG8_SCHED;
            PG8_LDB(B1, 1, 1); PG8_STAGE(PG8_SB(1, 0), b3, voffB);
            PG8_BAR; PG8_WAIT_L(0); PG8_MMA(0, 1, At, B1); PG8_BAR;
            PG8_LDA(At, 1, 1); PG8_STAGE(PG8_SA(1, 0), a3, voffA);
            PG8_BAR; PG8_WAIT_L(0); PG8_MMA(1, 0, At, B0); PG8_BAR; PG8_SCHED;
            PG8_STAGE(PG8_SB(1, 1), b3 + hstepB, voffB);
            PG8_WAIT_V(6); PG8_BAR; PG8_MMA(1, 1, At, B1); PG8_BAR;
            }
        }
        if constexpr (ALIGN_EPI) { if (wr == 0) PG8_BAR; }
        if constexpr (!Epi::AFTER_DRAIN) { E(acc, cur, wr, wc, fr, fq); S.done(cur); }
        if (!has_next) break;
#pragma unroll
        for (int a = 0; a < 2; ++a)
#pragma unroll
            for (int b = 0; b < 2; ++b)
#pragma unroll
                for (int m = 0; m < 4; ++m)
#pragma unroll
                    for (int n = 0; n < 2; ++n) acc[a][b][m][n] = (f32x4){0.f, 0.f, 0.f, 0.f};
        cur = nxt; cA = nA; cB = nB; ++ui;
        if constexpr (ALIGN_EPI) { if (wr == 1) PG8_BAR; }
    }
    PG8_WAIT_V(0);
    if constexpr (!ALIGN_EPI) { if (wr == 0) PG8_BAR; }
    PG8_BAR;
    if constexpr (Epi::AFTER_DRAIN) { E.fused(acc, cur, wr, wc, fr, fq, lds, wid, lane); S.done(cur); }
#undef PG8_SA
#undef PG8_SB
#undef PG8_STAGE
#undef PG8_LDA
#undef PG8_LDB
#undef PG8_MMA
#undef PG8_WAIT_V
#undef PG8_WAIT_L
#undef PG8_BAR
#undef PG8_SCHED
}
}

#ifndef G1_EPI_DRAIN
#define G1_EPI_DRAIN 0
#endif
#ifndef G1_STORE_AUX_MIX
#define G1_STORE_AUX_MIX 2
#endif
#ifndef G1_STORE_AUX
#define G1_STORE_AUX 2
#endif
namespace pg8 {
__device__ __forceinline__ float ubf0(unsigned w) { return (float)(w & 0xffu); }
__device__ __forceinline__ float ubf1(unsigned w) { return (float)((w >> 8) & 0xffu); }
__device__ __forceinline__ float ubf2(unsigned w) { return (float)((w >> 16) & 0xffu); }
__device__ __forceinline__ float ubf3(unsigned w) { return (float)(w >> 24); }
__device__ __forceinline__ float ex2(float x) { return __builtin_amdgcn_exp2f(x); }
__device__ __forceinline__ float sigm_fast(float x) { return __builtin_amdgcn_rcpf(1.0f + ex2(x * -1.4426950408889634f)); }
template <int MODE = 0  > struct EpiProjT {
    static constexpr bool PERM = true, AFTER_DRAIN = false, KHOOK = false;
    bf16_t* PA; bf16_t* KVM; float* SS; float* MKSS; const float* gate_b; int pm0; int pad;
    template <int KIND, int STAT> __device__ __forceinline__ void body(const f32x4 (&acc)[2][2][4][2], const __amdgpu_buffer_rsrc_t rsrc, int row0, int col0, int ldc, float* sb, int sld, int so, const float* bias, int wc, int fq) const {
        f32x4 bv[2][2];
        if (KIND == 3) {
#pragma unroll
            for (int bj = 0; bj < 2; ++bj)
#pragma unroll
                for (int n = 0; n < 2; ++n) bv[bj][n] = *(const f32x4*)(bias + bj * HALF + 4 * n);
        }
#pragma unroll
        for (int ai = 0; ai < 2; ++ai)
#pragma unroll
            for (int m = 0; m < 4; ++m) { const int row = row0 + ai * HALF + m * 16; const unsigned rowoff = ((unsigned)row * (unsigned)ldc + (unsigned)col0) * 2u;
#pragma unroll
                for (int bj = 0; bj < 2; ++bj) { f32x4 v0 = acc[ai][bj][m][0], v1 = acc[ai][bj][m][1];
                    if (KIND == 1) { f32x2 a = gelu_pk((f32x2){v0[0], v0[1]}), b = gelu_pk((f32x2){v0[2], v0[3]}), c = gelu_pk((f32x2){v1[0], v1[1]}), d = gelu_pk((f32x2){v1[2], v1[3]});
                        v0 = (f32x4){a.x, a.y, b.x, b.y}; v1 = (f32x4){c.x, c.y, d.x, d.y}; }
                    else if (KIND == 2) {
#pragma unroll
                        for (int j = 0; j < 4; ++j) { v0[j] = v0[j] * sigm_fast(v0[j]); v1[j] = v1[j] * sigm_fast(v1[j]); } }
                    else if (KIND == 3) { v0 = v0 + bv[bj][0]; v1 = v1 + bv[bj][1];
#pragma unroll
                        for (int j = 0; j < 4; ++j) { v0[j] = sigm_fast(v0[j]); v1[j] = sigm_fast(v1[j]); } }
                    if (STAT) {
                        float s = ((v0[0] + v0[1]) + (v0[2] + v0[3])) + ((v1[0] + v1[1]) + (v1[2] + v1[3]));
                        float q = ((v0[0] * v0[0] + v0[1] * v0[1]) + (v0[2] * v0[2] + v0[3] * v0[3])) + ((v1[0] * v1[0] + v1[1] * v1[1]) + (v1[2] * v1[2] + v1[3] * v1[3]));
                        if (STAT == 2) { s += __shfl_xor(s, 16); s += __shfl_xor(s, 32); }
                        q += __shfl_xor(q, 16); q += __shfl_xor(q, 32);
                        if (fq == 0) { float* sp = sb + (size_t)row * sld + so; const int blk = 4 * bj + wc;
                            if (STAT == 2) { sp[2 * blk] = s; sp[2 * blk + 1] = q; } else sp[blk] = q; }
                    }
                    u32x4 w; w.x = cvt_pk_bf16(v0[0], v0[1]); w.y = cvt_pk_bf16(v0[2], v0[3]); w.z = cvt_pk_bf16(v1[0], v1[1]); w.w = cvt_pk_bf16(v1[2], v1[3]);
                    if (MODE == 2) asm volatile("" :: "v"(w)); else __builtin_amdgcn_raw_buffer_store_b128(w, rsrc, (int)(rowoff + bj * HALF * 2), 0, KIND == 3 ? G1_STORE_AUX : G1_STORE_AUX_MIX); } }
    }
    __device__ __forceinline__ void uz_body(const f32x4 (&acc)[2][2][4][2], const __amdgpu_buffer_rsrc_t rsrc, int row0, int ucol0) const {
#pragma unroll
        for (int ai = 0; ai < 2; ++ai)
#pragma unroll
            for (int m = 0; m < 4; ++m) { const int row = row0 + ai * HALF + m * 16;
                f32x4 u0 = acc[ai][0][m][0], u1 = acc[ai][0][m][1]; const f32x4 z0 = acc[ai][1][m][0], z1 = acc[ai][1][m][1];
                { f32x2 a = gelu_pk((f32x2){u0[0], u0[1]}), b = gelu_pk((f32x2){u0[2], u0[3]}), c = gelu_pk((f32x2){u1[0], u1[1]}), d = gelu_pk((f32x2){u1[2], u1[3]});
                  u0 = (f32x4){a.x, a.y, b.x, b.y}; u1 = (f32x4){c.x, c.y, d.x, d.y}; }
#pragma unroll
                for (int j = 0; j < 4; ++j) { u0[j] *= z0[j] * sigm_fast(z0[j]); u1[j] *= z1[j] * sigm_fast(z1[j]); }
                u32x4 w; w.x = cvt_pk_bf16(u0[0], u0[1]); w.y = cvt_pk_bf16(u0[2], u0[3]); w.z = cvt_pk_bf16(u1[0], u1[1]); w.w = cvt_pk_bf16(u1[2], u1[3]);
                if (MODE == 2) asm volatile("" :: "v"(w)); else __builtin_amdgcn_raw_buffer_store_b128(w, rsrc, (int)((unsigned)row * (unsigned)PA_ROWB + (unsigned)(2 * (C_AU + ucol0))), 0, G1_STORE_AUX_MIX); }
    }
    __device__ __forceinline__ void gate_body(const f32x4 (&acc)[2][2][4][2], const __amdgpu_buffer_rsrc_t rsrc, int row0, int gcol0, const float* bias) const {
        f32x4 bv[2][2];
#pragma unroll
        for (int bj = 0; bj < 2; ++bj)
#pragma unroll
            for (int n = 0; n < 2; ++n) bv[bj][n] = *(const f32x4*)(bias + 8 * bj + 4 * n);
#pragma unroll
        for (int ai = 0; ai < 2; ++ai)
#pragma unroll
            for (int m = 0; m < 4; ++m) { const int row = row0 + ai * HALF + m * 16; u32x4 w;
#pragma unroll
                for (int bj = 0; bj < 2; ++bj)
#pragma unroll
                    for (int n = 0; n < 2; ++n) { const f32x4 v = acc[ai][bj][m][n] + bv[bj][n]; unsigned d = 0u;
#pragma unroll
                        for (int j = 0; j < 4; ++j) d |= (unsigned)(fmaxf(sigm_fast(v[j]) * 255.0f, 1.0f) + 0.5f) << (8 * j);
                        w[2 * bj + n] = d; }
                if (MODE == 2) asm volatile("" :: "v"(w)); else __builtin_amdgcn_raw_buffer_store_b128(w, rsrc, (int)((unsigned)row * (unsigned)PA_ROWB + (unsigned)(PA_GOFF + gcol0)), 0, G1_STORE_AUX); }
    }
    __device__ __forceinline__ void operator()(const f32x4 (&acc)[2][2][4][2], const Unit& u, int wr, int wc, int fr, int fq) const {
        const bool kv = u.pn >= 35; const int pn = kv ? u.pn - 35 : u.pn;
        const int rowt = kv ? (u.pm - 256) * BM : (u.pm - pm0) * BM;
        bf16_t* base = kv ? KVM : PA; const int ldc = kv ? 1024 : PAP;
        const __amdgpu_buffer_rsrc_t rsrc = __builtin_amdgcn_make_buffer_rsrc(base, 0, kv ? (int)((size_t)MMEM * 1024 * 2) : (int)((size_t)HB_ROWS * PA_ROWB), 0x00020000);
        const int row0 = rowt + wr * 64 + fr, col0 = pn * BM + wc * 32 + 8 * fq;
        if (MODE == 1) { body<0, 0>(acc, rsrc, row0, col0, ldc, SS, SS_W, 0, gate_b, wc, fq); return; }
        if (kv) { if (pn < 2) body<0, 1>(acc, rsrc, row0, col0, ldc, MKSS, 16, 8 * pn, gate_b, wc, fq); else body<0, 0>(acc, rsrc, row0, col0, ldc, SS, SS_W, 0, gate_b, wc, fq); }
        else if (pn < 3) uz_body(acc, rsrc, row0, 128 * pn + 32 * wc + 8 * fq);
        else if (pn < 6) body<1, 2>(acc, rsrc, row0, col0, ldc, SS, SS_W, 16 * (pn - 3), gate_b, wc, fq);
        else if (pn < 9) uz_body(acc, rsrc, row0, 128 * (pn - 3) + 32 * wc + 8 * fq);
        else if (pn < 12) body<0, 1>(acc, rsrc, row0, col0, ldc, SS, SS_W, 48 + 8 * (pn - 9), gate_b, wc, fq);
        else if (pn < 15) body<0, 1>(acc, rsrc, row0, col0, ldc, SS, SS_W, 72 + 8 * (pn - 12), gate_b, wc, fq);
        else if (pn < 18) body<0, 0>(acc, rsrc, row0, col0, ldc, SS, SS_W, 0, gate_b, wc, fq);
        else if (pn < 19) body<2, 0>(acc, rsrc, row0, col0, ldc, SS, SS_W, 0, gate_b, wc, fq);
        else if (pn < 21) body<0, 1>(acc, rsrc, row0, col0, ldc, SS, SS_W, 96 + 8 * (pn - 19), gate_b, wc, fq);
        else if (pn < 23) body<2, 0>(acc, rsrc, row0, col0, ldc, SS, SS_W, 0, gate_b, wc, fq);
        else { const int gc = (pn - 23) * BM + 64 * wc + 16 * fq; gate_body(acc, rsrc, row0, gc, gate_b + gc); }
#if G1_EPI_DRAIN
        asm volatile("s_waitcnt vmcnt(0)" ::: "memory");
#endif
    }
};
typedef EpiProjT<0> EpiProj;
template <bool HOOKS = true, bool EPI = true> struct EpiG2catT {
    static constexpr bool PERM = true, AFTER_DRAIN = false, KHOOK = HOOKS; static constexpr int KH1 = 12, KH2 = 16;
    const bf16_t* PA; bf16_t* MRG;
    __device__ __forceinline__ void khook(f32x4 (&acc)[2][2][4][2], const Unit& u, int t, int wr, int wc, int fr, int fq) const {
        typedef unsigned u32x2v __attribute__((ext_vector_type(2)));
        const int ga = t == KH1 ? 0 : 1;
        const int row0 = u.pm * BM + wr * 64 + fr, col0 = u.pn * BM + wc * 32 + 8 * fq;
        const unsigned char* gbase = (const unsigned char*)PA + (size_t)row0 * PA_ROWB + PA_GOFF + ga * DM + col0;
        u32x2v ag[2][4][2], bg[2][4][2];
#pragma unroll
        for (int ai = 0; ai < 2; ++ai)
#pragma unroll
            for (int m = 0; m < 4; ++m) { const unsigned char* gp_ = gbase + (size_t)(ai * HALF + m * 16) * PA_ROWB;
#pragma unroll
                for (int bj = 0; bj < 2; ++bj) { ag[ai][m][bj] = *(const u32x2v*)(gp_ + bj * HALF); bg[ai][m][bj] = *(const u32x2v*)(gp_ + DM + bj * HALF); } }
        __builtin_amdgcn_sched_barrier(0);
#define G2_R(A, Bv, K) (ubf##K(A) * __builtin_amdgcn_rcpf(ubf##K(Bv)))
#pragma unroll
        for (int ai = 0; ai < 2; ++ai)
#pragma unroll
            for (int m = 0; m < 4; ++m)
#pragma unroll
                for (int bj = 0; bj < 2; ++bj) { const u32x2v a = ag[ai][m][bj], b = bg[ai][m][bj]; f32x4 r0, r1;
                    r0[0] = G2_R(a.x, b.x, 0); r0[1] = G2_R(a.x, b.x, 1); r0[2] = G2_R(a.x, b.x, 2); r0[3] = G2_R(a.x, b.x, 3);
                    r1[0] = G2_R(a.y, b.y, 0); r1[1] = G2_R(a.y, b.y, 1); r1[2] = G2_R(a.y, b.y, 2); r1[3] = G2_R(a.y, b.y, 3);
                    acc[ai][bj][m][0] *= r0; acc[ai][bj][m][1] *= r1; }
#undef G2_R
    }
    __device__ __forceinline__ void operator()(const f32x4 (&acc)[2][2][4][2], const Unit& u, int wr, int wc, int fr, int fq) const {
        typedef unsigned u32x2v __attribute__((ext_vector_type(2)));
        if (!EPI) { _Pragma("unroll") for (int ai = 0; ai < 2; ++ai) _Pragma("unroll") for (int bj = 0; bj < 2; ++bj) _Pragma("unroll") for (int m = 0; m < 4; ++m) asm volatile("" :: "v"(acc[ai][bj][m][0]), "v"(acc[ai][bj][m][1])); return; }
        const int row0 = u.pm * BM + wr * 64 + fr, col0 = u.pn * BM + wc * 32 + 8 * fq;
        u32x2v gv[2][4][2];
#pragma unroll
        for (int ai = 0; ai < 2; ++ai)
#pragma unroll
            for (int m = 0; m < 4; ++m) { const unsigned char* gp = (const unsigned char*)PA + (size_t)(row0 + ai * HALF + m * 16) * PA_ROWB + PA_GOFF + 2 * DM + col0;
#pragma unroll
                for (int bj = 0; bj < 2; ++bj) gv[ai][m][bj] = *(const u32x2v*)(gp + bj * HALF); }
        __builtin_amdgcn_sched_barrier(0);
        const float q = 1.0f / 255.0f;
#pragma unroll
        for (int ai = 0; ai < 2; ++ai)
#pragma unroll
            for (int m = 0; m < 4; ++m) { bf16_t* mp = MRG + (size_t)(row0 + ai * HALF + m * 16) * DM + col0;
#pragma unroll
                for (int bj = 0; bj < 2; ++bj) { const u32x2v g = gv[ai][m][bj]; const f32x4 v0 = acc[ai][bj][m][0] * q, v1 = acc[ai][bj][m][1] * q; u32x4 w;
                    w.x = cvt_pk_bf16(v0[0] * ubf0(g.x), v0[1] * ubf1(g.x)); w.y = cvt_pk_bf16(v0[2] * ubf2(g.x), v0[3] * ubf3(g.x));
                    w.z = cvt_pk_bf16(v1[0] * ubf0(g.y), v1[1] * ubf1(g.y)); w.w = cvt_pk_bf16(v1[2] * ubf2(g.y), v1[3] * ubf3(g.y));
                    *(u32x4*)(mp + bj * HALF) = w; } }
    }
};
typedef EpiG2catT<true, true> EpiG2cat;
struct EpiG3 {
    static constexpr bool PERM = false, AFTER_DRAIN = false, KHOOK = false;
    const float* x; float* out;
    __device__ __forceinline__ void operator()(const f32x4 (&acc)[2][2][4][2], const Unit& u, int wr, int wc, int fr, int fq) const {
        const int row0 = u.pm * BM + wr * 64 + fr, col0 = u.pn * BM + wc * 32 + 4 * fq;
        f32x4 xv[2][2][2][2];
#define G3_LOAD(B) do { _Pragma("unroll") for (int mm = 0; mm < 2; ++mm) { const size_t off_ = (size_t)(row0 + ((B) >> 1) * HALF + (2 * ((B) & 1) + mm) * 16) * DM + col0; \
            _Pragma("unroll") for (int bj = 0; bj < 2; ++bj) _Pragma("unroll") for (int n = 0; n < 2; ++n) xv[(B) & 1][mm][bj][n] = __builtin_nontemporal_load((const f32x4*)(x + off_ + bj * HALF + n * 16)); } } while (0)
#define G3_STORE(B) do { _Pragma("unroll") for (int mm = 0; mm < 2; ++mm) { const size_t off_ = (size_t)(row0 + ((B) >> 1) * HALF + (2 * ((B) & 1) + mm) * 16) * DM + col0; \
            _Pragma("unroll") for (int bj = 0; bj < 2; ++bj) _Pragma("unroll") for (int n = 0; n < 2; ++n) \
                __builtin_nontemporal_store(xv[(B) & 1][mm][bj][n] + acc[(B) >> 1][bj][2 * ((B) & 1) + mm][n], (f32x4*)(out + off_ + bj * HALF + n * 16)); } } while (0)
        G3_LOAD(0); G3_LOAD(1); __builtin_amdgcn_sched_barrier(0); G3_STORE(0); G3_STORE(1); __builtin_amdgcn_sched_barrier(0); G3_LOAD(2); G3_LOAD(3); __builtin_amdgcn_sched_barrier(0); G3_STORE(2); G3_STORE(3);
#undef G3_LOAD
#undef G3_STORE
    }
};
struct EpiNull {
    static constexpr bool PERM = true, AFTER_DRAIN = false, KHOOK = false;
    __device__ __forceinline__ void operator()(const f32x4 (&acc)[2][2][4][2], const Unit& u, int wr, int wc, int fr, int fq) const {
#pragma unroll
        for (int ai = 0; ai < 2; ++ai)
#pragma unroll
            for (int bj = 0; bj < 2; ++bj)
#pragma unroll
                for (int m = 0; m < 4; ++m) asm volatile("" :: "v"(acc[ai][bj][m][0]), "v"(acc[ai][bj][m][1]));
    }
};
struct OrderG1 {
    StaticOrder so; int pm0, nkv;
    __device__ void init(int hb, int G, int c) { so.init(HB_ROWS, NIN, G, c); pm0 = hb * (HB_ROWS / BM); nkv = hb == 0 ? (MMEM / BM) * 4 : 0; }
    __device__ bool next(int i, Unit& u) const {
        if (so.next(i, u)) { u.pm += pm0; return true; }
        const long j = (long)i * so.G + so.c - so.nwg; if (j < 0 || j >= nkv) return false;
        u.pm = 256 + (int)(j >> 2); u.pn = 35 + (int)(j & 3); return true;
    }
    __device__ __forceinline__ void a_ready(const Unit&) const {}
    __device__ __forceinline__ void done(const Unit&) const {}
};
}

#define GAS __attribute__((address_space(1)))
#define LAS __attribute__((address_space(3)))
typedef unsigned short bf16;
typedef unsigned v4u __attribute__((ext_vector_type(4)));
typedef float f32x4 __attribute__((ext_vector_type(4)));
typedef short bf16x8 __attribute__((ext_vector_type(8)));
typedef GAS unsigned gu32;
typedef GAS unsigned long long gu64;
#define RLX_AGENT __ATOMIC_RELAXED, __HIP_MEMORY_SCOPE_AGENT
#define LDS_WAIT() asm volatile("s_waitcnt lgkmcnt(0)" ::: "memory")
#define VM_WAIT() asm volatile("s_waitcnt vmcnt(0)" ::: "memory")
__device__ __forceinline__ unsigned long long rt() { return __builtin_amdgcn_s_memrealtime(); }
__device__ __forceinline__ unsigned f2bf(float f) { unsigned u = __builtin_bit_cast(unsigned, f); return (u + 0x7fffu + ((u >> 16) & 1u)) >> 16; }
__device__ __forceinline__ unsigned pk2(float lo, float hi) { return f2bf(lo) | (f2bf(hi) << 16); }

__device__ __forceinline__ int hw_lane() { int l; asm volatile("v_mbcnt_lo_u32_b32 %0, -1, 0\n\tv_mbcnt_hi_u32_b32 %0, -1, %0" : "=v"(l)); return l; }
__device__ __forceinline__ bool hw_thread0(int wave) { return wave == 0 && hw_lane() == 0; }
#define XB_TMO      128
#define XB_XCNT(j)  (256  + 64 * (j))
#define XB_XSUB(j)  (1280 + 64 * (j))
#define XB_XGEN(j)  (2304 + 64 * (j))
#define XB_TOP      3328
#define XB_TOPGEN   3392
#define XCD_BAR_WORDS 3456
#define XB_SPIN_CAP (1u << 18)

__device__ __forceinline__ unsigned xb_ld(unsigned* p)              { return __hip_atomic_load(p, __ATOMIC_RELAXED, __HIP_MEMORY_SCOPE_AGENT); }
__device__ __forceinline__ unsigned xb_add(unsigned* p, unsigned v) { return __hip_atomic_fetch_add(p, v, __ATOMIC_RELAXED, __HIP_MEMORY_SCOPE_AGENT); }
__device__ __forceinline__ unsigned xb_xcc_id() { return (unsigned)__builtin_amdgcn_s_getreg((3 << 11) | 20) & 0xFu; }
#define XB_SPIN(cond, bar) do { unsigned _sp = 0; while (cond) { __builtin_amdgcn_s_sleep(1); \
    if ((++_sp & 255u) == 0u) { if (xb_ld(&(bar)[XB_TMO])) break; if (_sp > XB_SPIN_CAP) { atomicAdd(&(bar)[XB_TMO], 1u); break; } } } } while (0)

struct XcdBarrier {
    unsigned* bar; unsigned x; int wave;
    volatile LAS unsigned* st;
};

__device__ __forceinline__ XcdBarrier xcd_barrier_post(unsigned* bar, volatile LAS unsigned* st, int wave) {
    XcdBarrier b; b.bar = bar; b.x = xb_xcc_id(); b.st = st; b.wave = wave;
    if (hw_thread0(wave)) (void)xb_add(&bar[XB_XCNT(b.x)], 1u);
    return b;
}
__device__ __forceinline__ void xcd_barrier_complete(unsigned* bar, unsigned x, unsigned& nloc, unsigned& nx) {
    const unsigned G = gridDim.x * gridDim.y * gridDim.z;
    unsigned sum, cnt, mine, sp = 0u;
    for (;;) {
        sum = 0u; cnt = 0u; mine = 0u;
#pragma unroll
        for (unsigned j = 0; j < 16; ++j) { const unsigned c = xb_ld(&bar[XB_XCNT(j)]); sum += c; cnt += (c > 0u) ? 1u : 0u; mine = (j == x) ? c : mine; }
        if (sum == G) break;
        __builtin_amdgcn_s_sleep(1);
        if ((++sp & 255u) == 0u) { if (xb_ld(&bar[XB_TMO])) break; if (sp > XB_SPIN_CAP) { atomicAdd(&bar[XB_TMO], 1u); break; } }
    }
    nloc = mine > 0u ? mine : 1u; nx = cnt > 0u ? cnt : 1u;
}

__device__ __forceinline__ void xcd_barrier(const XcdBarrier& b) {
    asm volatile("s_waitcnt vmcnt(0)" ::: "memory");
    __syncthreads();
    if (hw_thread0(b.wave)) {
        unsigned* bar = b.bar;
        __builtin_amdgcn_s_waitcnt(0);
        unsigned nloc = b.st[0], nx = b.st[1];
        if (nloc == 0u) { xcd_barrier_complete(bar, b.x, nloc, nx); b.st[0] = nloc; b.st[1] = nx; }
        const unsigned old = xb_add(&bar[XB_XSUB(b.x)], 1u);
        const unsigned gen = old / nloc;
        if (old + 1u == (gen + 1u) * nloc) {
            __builtin_amdgcn_fence(__ATOMIC_RELEASE, "agent");
            asm volatile("s_waitcnt vmcnt(0)" ::: "memory");
            const unsigned og = xb_add(&bar[XB_TOP], 1u);
            const unsigned tg = og / nx;
            if (og + 1u == (tg + 1u) * nx) xb_add(&bar[XB_TOPGEN], 1u);
            else XB_SPIN(xb_ld(&bar[XB_TOPGEN]) == tg, bar);
            __builtin_amdgcn_fence(__ATOMIC_ACQUIRE, "agent");
            xb_add(&bar[XB_XGEN(b.x)], 1u);
            asm volatile("s_waitcnt vmcnt(0)" ::: "memory");
        } else {
            XB_SPIN(xb_ld(&bar[XB_XGEN(b.x)]) == gen, bar);
            __builtin_amdgcn_fence(__ATOMIC_ACQUIRE, "agent");
            asm volatile("s_waitcnt vmcnt(0)" ::: "memory");
        }
    }
    __syncthreads();
}

__device__ __forceinline__ float wave_sum(float v) {
#pragma unroll
    for (int o = 1; o < 64; o <<= 1) v += __shfl_xor(v, o);
    return v;
}

constexpr int RING_OFF = 0, RING_BYTES = 131072;
constexpr int LDSCTL_OFF = RING_BYTES, MISC_OFF = LDSCTL_OFF + 320;
constexpr int LDS_BYTES = 147456;
constexpr int NWAVES = 8, NTHR = NWAVES * 64;
constexpr int WSCR_OFF = 132096;

__device__ __forceinline__ float bf2f(bf16 h) { return __builtin_bit_cast(float, (unsigned)h << 16); }
__device__ __forceinline__ float sigm_f(float x) { return 1.f / (1.f + __expf(-x)); }
__device__ __forceinline__ int t5_bucket(int d) {
    if (d < 16) return d;
    int b = 16;
    b += d >= 22; b += d >= 30; b += d >= 40; b += d >= 54; b += d >= 73; b += d >= 99; b += d >= 134; b += d >= 182; b += d >= 246; b += d >= 332; b += d >= 450; b += d >= 609; b += d >= 825; b += d >= 1117; b += d >= 1513;
    return b;
}

struct Ctx {
    const float *x, *mem, *norm_w, *w_in, *gate_b, *lnw, *lnb, *sp_w, *sp_b, *bqw, *bkw, *rel_bias, *mem_norm_w, *m_w_kv, *mqw, *mkw, *proj_a, *proj_b, *proj_m, *w_out;
    float* out;
    bf16 *WIN, *PCAT, *WOUT, *WSP, *XN, *PA, *KVM, *OG, *YC, *MRG; float *BIAS, *BIASX, *SS, *MKSS, *LSE, *LNST;
    LAS unsigned char* lds; int tid, lane, wave, G, gtid, T, gwave, NW, xgwave;
};

__device__ __forceinline__ void p0_transpose_item(const float* W, int N, bf16* WT, int ldt, int row_off, int koff, LAS float* scr, int item, int lane, bool gperm = false) {
    const int nblk = N / 32, kb = item / nblk, nb = item % nblk, k0 = 64 * kb, n0 = 32 * nb;
#pragma unroll 8
    for (int i = 0; i < 32; ++i) { const int kk = 2 * i + (lane >> 5); scr[kk * 33 + (lane & 31)] = W[(size_t)(k0 + kk) * N + n0 + (lane & 31)]; }
    LDS_WAIT(); asm volatile("" ::: "memory");
    const int c = lane & 7;
#pragma unroll
    for (int j = 0; j < 4; ++j) { const int n = (lane >> 3) + 8 * j; const LAS float* s = scr + (8 * c) * 33 + n;
        v4u o; o.x = pk2(s[0 * 33], s[1 * 33]); o.y = pk2(s[2 * 33], s[3 * 33]); o.z = pk2(s[4 * 33], s[5 * 33]); o.w = pk2(s[6 * 33], s[7 * 33]);
        int nn = n0 + n;
        if (gperm) {
            if (nn >= C_G) nn = (nn & ~255) + 128 * ((nn >> 3) & 1) + 32 * ((nn >> 6) & 3) + 8 * ((nn >> 4) & 3) + (nn & 7);
            else if (nn < C_AV) { const int T = nn >> 7; nn = 256 * (T < 3 ? T : T + 3) + (nn & 127); }
            else if (nn >= C_AZ && nn < C_BQ) { const int c = nn - C_AZ, T = c >> 7; nn = 256 * (T < 3 ? T : T + 3) + 128 + (c & 127); }
        }
        *(GAS v4u*)(WT + (size_t)(row_off + nn) * ldt + koff + k0 + 8 * c) = o; }
    LDS_WAIT(); asm volatile("" ::: "memory");
}
template <int NR> __device__ __forceinline__ void rms_rows_to_bf16(const float* src, const float* w, bf16* dst, size_t m0, size_t stride, int lane) {
    f32x4 v[NR][4]; float s[NR];
#pragma unroll
    for (int r = 0; r < NR; ++r) { const GAS f32x4* xr = (const GAS f32x4*)(src + (m0 + r * stride) * DM) + lane;
#pragma unroll
        for (int j = 0; j < 4; ++j) v[r][j] = __builtin_nontemporal_load(xr + 64 * j); }
    f32x4 ww[4];
#pragma unroll
    for (int j = 0; j < 4; ++j) ww[j] = ((const GAS f32x4*)w + lane)[64 * j];
#pragma unroll
    for (int r = 0; r < NR; ++r) { float a = 0.f;
#pragma unroll
        for (int j = 0; j < 4; ++j) a += (v[r][j].x * v[r][j].x + v[r][j].y * v[r][j].y) + (v[r][j].z * v[r][j].z + v[r][j].w * v[r][j].w);
        s[r] = rsqrtf(wave_sum(a) * (1.f / DM) + EPS); }
#pragma unroll
    for (int r = 0; r < NR; ++r) { GAS unsigned long long* o8 = (GAS unsigned long long*)(dst + (m0 + r * stride) * DM) + lane;
#pragma unroll
        for (int j = 0; j < 4; ++j) o8[64 * j] = (unsigned long long)pk2(v[r][j].x * s[r] * ww[j].x, v[r][j].y * s[r] * ww[j].y) | ((unsigned long long)pk2(v[r][j].z * s[r] * ww[j].z, v[r][j].w * s[r] * ww[j].w) << 32); }
}
__device__ __forceinline__ void p0_prologue(Ctx& F) {
    LAS float* scr = (LAS float*)(F.lds + RING_OFF + F.wave * 16384);
    constexpr int I_IN = 16 * (NIN / 32), I_KV = 16 * 32, I_PA = 12 * 32, I_PB = 4 * 32, I_PM = 8 * 32, I_WO = 16 * 32;
    constexpr int NITEMS = I_IN + I_KV + I_PA + I_PB + I_PM + I_WO;
    for (int it = F.gwave; it < NITEMS; it += F.NW) {
        int r = it;
        if (r < I_IN) { p0_transpose_item(F.w_in, NIN, F.WIN, DM, 0, 0, scr, r, F.lane, true); continue; } r -= I_IN;
        if (r < I_KV) { p0_transpose_item(F.m_w_kv, 1024, F.WIN, DM, NIN, 0, scr, r, F.lane); continue; } r -= I_KV;
        if (r < I_PA) { p0_transpose_item(F.proj_a, DM, F.PCAT, KC, 0, 0, scr, r, F.lane); continue; } r -= I_PA;
        if (r < I_PB) { p0_transpose_item(F.proj_b, DM, F.PCAT, KC, 0, 768, scr, r, F.lane); continue; } r -= I_PB;
        if (r < I_PM) { p0_transpose_item(F.proj_m, DM, F.PCAT, KC, 0, 1024, scr, r, F.lane); continue; } r -= I_PM;
        p0_transpose_item(F.w_out, DM, F.WOUT, DM, 0, 0, scr, r, F.lane);
    }
    for (int i = F.gtid; i < 4 * 128 * 128; i += F.T) { const int t = (i >> 7) & 127, s = i & 127; F.WSP[i] = (bf16)(s <= t ? f2bf(F.sp_w[i]) : 0u); }
    for (int i = F.gtid; i < 3 * 4 * 132; i += F.T) { const int g = i / (4 * 132), h = (i / 132) % 4, j = i % 132; const int dil = g == 0 ? 1 : (g == 1 ? 4 : 16);
        F.BIAS[i] = j <= 128 ? F.rel_bias[t5_bucket(j * dil) * 12 + 4 * g + h] : 0.f; }
    for (int i = F.gtid; i < 3 * 4 * 192; i += F.T) { const int g = i / (4 * 192), h = (i / 192) % 4, step = i % 192 - 31; const int dil = g == 0 ? 1 : (g == 1 ? 4 : 16);
        F.BIASX[i] = (step >= 0 && step <= 128) ? F.rel_bias[t5_bucket(step * dil) * 12 + 4 * g + h] * 1.4426950408889634f : -1e30f; }
    if ((MTOT % (4 * F.NW)) == 0 && (MMEM % (4 * F.NW)) == 0) {
        for (size_t m = F.gwave; m < (size_t)MTOT; m += 4 * (size_t)F.NW) rms_rows_to_bf16<4>(F.x, F.norm_w, F.XN, m, F.NW, F.lane);
        for (size_t m = F.gwave; m < (size_t)MMEM; m += 4 * (size_t)F.NW) rms_rows_to_bf16<4>(F.mem, F.mem_norm_w, F.XN + (size_t)MTOT * DM, m, F.NW, F.lane);
    } else {
        for (size_t m = F.gwave; m < (size_t)MTOT; m += F.NW) rms_rows_to_bf16<1>(F.x, F.norm_w, F.XN, m, 0, F.lane);
        for (size_t m = F.gwave; m < (size_t)MMEM; m += F.NW) rms_rows_to_bf16<1>(F.mem, F.mem_norm_w, F.XN + (size_t)MTOT * DM, m, 0, F.lane);
    }
}


typedef float f32x16 __attribute__((ext_vector_type(16)));
typedef short s16x4 __attribute__((ext_vector_type(4)));
__device__ __forceinline__ int crow(int r, int hi) { return (r & 3) + 8 * (r >> 2) + 4 * hi; }
__device__ __forceinline__ unsigned cvtpk(float lo, float hi) { return pg8::cvt_pk_bf16(lo, hi); }
__device__ __forceinline__ s16x4 vtr(const LAS unsigned char* p) { typedef short v4i16_t __attribute__((ext_vector_type(4))); return __builtin_bit_cast(s16x4, __builtin_amdgcn_ds_read_tr16_b64_v4i16((LAS v4i16_t*)p)); }
__device__ __forceinline__ float bflo(unsigned w) { return __uint_as_float(w << 16); }
__device__ __forceinline__ float bfhi(unsigned w) { return __uint_as_float(w & 0xffff0000u); }
constexpr float LOG2E = 1.4426950408889634f, LN2 = 0.6931471805599453f;
constexpr int NBX = 192;


__device__ __forceinline__ void st_mixA_mfma(Ctx& F) {
    const int lane = hw_lane(), r32 = lane & 31, hi = lane >> 5, tid = F.wave * 64 + lane;
    LAS unsigned char* wl = F.lds + RING_OFF + F.wave * 16384;
    typedef float f32x2v __attribute__((ext_vector_type(2))); typedef unsigned u32x2v __attribute__((ext_vector_type(2)));
    LAS f32x2v* tab = (LAS f32x2v*)(F.lds + WSCR_OFF + 8192);
    const int g = F.wave >> 1, ch = lane & 3;
    bf16x8 wf[14];
    const bf16* wrow0 = F.WSP + (size_t)(g * 128 + r32) * 128 + 8 * hi;
    { int n = 0;
#pragma unroll
      for (int tb = 2; tb < 4; ++tb)
#pragma unroll
          for (int ks = 0; ks < 2 * (tb + 1); ++ks) wf[n++] = *(const bf16x8*)(wrow0 + (size_t)tb * 32 * 128 + 16 * ks); }
    for (int unit = blockIdx.x; unit < HB_ROWS / 128; unit += F.G) {
        const int rowbase = unit * 128;
        v4u raw[8];
        { const int c0 = g * 192 + (F.wave & 1) * 96;
#pragma unroll
          for (int i = 0; i < 8; ++i) raw[i] = *(const v4u*)(F.PA + (size_t)(rowbase + (lane >> 2) + 16 * i) * PAP + C_AV + c0 + 8 * ch); }
        { const int row = tid >> 2, part = tid & 3; const float* sp = F.SS + (size_t)(rowbase + row) * SS_W + 12 * part; float s = 0.f, q = 0.f;
#pragma unroll
          for (int k = 0; k < 6; ++k) { s += sp[2 * k]; q += sp[2 * k + 1]; }
          s += __shfl_xor(s, 1); s += __shfl_xor(s, 2); q += __shfl_xor(q, 1); q += __shfl_xor(q, 2);
          const float mu = s * (1.f / 768.f), var = q * (1.f / 768.f) - mu * mu;
          if (part == 0) tab[row] = (f32x2v){mu, rsqrtf(fmaxf(var, 0.f) + EPS)}; }
        __syncthreads();
#pragma unroll 1
        for (int cbi = 0; cbi < 3; ++cbi) {
            const int c0 = g * 192 + ((F.wave & 1) * 3 + cbi) * 32;
            const f32x4 w0 = *(const f32x4*)(F.lnw + c0 + 8 * ch), w1 = *(const f32x4*)(F.lnw + c0 + 8 * ch + 4), b0 = *(const f32x4*)(F.lnb + c0 + 8 * ch), b1 = *(const f32x4*)(F.lnb + c0 + 8 * ch + 4);
#pragma unroll
            for (int i = 0; i < 8; ++i) { const int s = (lane >> 2) + 16 * i; const f32x2v st = tab[s]; const v4u rw = raw[i]; v4u o;
                o.x = cvtpk((bflo(rw.x) - st.x) * st.y * w0.x + b0.x, (bfhi(rw.x) - st.x) * st.y * w0.y + b0.y); o.y = cvtpk((bflo(rw.y) - st.x) * st.y * w0.z + b0.z, (bfhi(rw.y) - st.x) * st.y * w0.w + b0.w);
                o.z = cvtpk((bflo(rw.z) - st.x) * st.y * w1.x + b1.x, (bfhi(rw.z) - st.x) * st.y * w1.y + b1.y); o.w = cvtpk((bflo(rw.w) - st.x) * st.y * w1.z + b1.z, (bfhi(rw.w) - st.x) * st.y * w1.w + b1.w);
                *(LAS v4u*)(wl + (s >> 3) * 512 + (s & 7) * 64 + ch * 16) = o; }
            if (cbi < 2) {
#pragma unroll
                for (int i = 0; i < 8; ++i) raw[i] = *(const v4u*)(F.PA + (size_t)(rowbase + (lane >> 2) + 16 * i) * PAP + C_AV + c0 + 32 + 8 * ch); }
            u32x2v uz[4][4];
#pragma unroll
            for (int tb = 0; tb < 4; ++tb) { const size_t row_ = (size_t)(rowbase + 32 * tb + r32);
#pragma unroll
                for (int i = 0; i < 4; ++i) uz[tb][i] = *(const u32x2v*)(F.PA + row_ * PAP + C_AU + c0 + 4 * hi + 8 * i); }
            const LAS unsigned char* vb = wl + hi * 512 + ((lane & 15) >> 2) * 64 + ((lane >> 4) & 1) * 32 + (lane & 3) * 8;
            const bf16* wr2 = wrow0; asm volatile("" : "+v"(wr2));
            bf16x8 wq[6];
            { int n2 = 0;
#pragma unroll
              for (int tb = 0; tb < 2; ++tb)
#pragma unroll
                  for (int ks = 0; ks < 2 * (tb + 1); ++ks) wq[n2++] = *(const bf16x8*)(wr2 + (size_t)tb * 32 * 128 + 16 * ks); }
            int n = 0, nq = 0;
#pragma unroll
            for (int tb = 0; tb < 4; ++tb) { f32x16 acc = {};
#pragma unroll
                for (int ks = 0; ks < 2 * (tb + 1); ++ks) { const s16x4 a = vtr(vb + ks * 1024), c = vtr(vb + ks * 1024 + 256); const bf16x8 af = {a[0], a[1], a[2], a[3], c[0], c[1], c[2], c[3]};
                    acc = __builtin_amdgcn_mfma_f32_32x32x16_bf16(af, tb < 2 ? wq[nq++] : wf[n++], acc, 0, 0, 0); }
                const int t = 32 * tb + r32; const size_t row = (size_t)(rowbase + t); const float sb = F.sp_b[g * 128 + t];
                bf16* yp = F.YC + row * KC + c0 + 4 * hi;
#pragma unroll
                for (int i = 0; i < 4; ++i) { const u32x2v u = uz[tb][i]; u32x2v w;
                    w.x = cvtpk(bflo(u.x) * (acc[4 * i] + sb), bfhi(u.x) * (acc[4 * i + 1] + sb)); w.y = cvtpk(bflo(u.y) * (acc[4 * i + 2] + sb), bfhi(u.y) * (acc[4 * i + 3] + sb));
                    *(u32x2v*)(yp + 8 * i) = w; } }
        }
        __syncthreads();
    }
}

__device__ __forceinline__ void st_mergeB_vec(Ctx& F) {
    constexpr int NI = 4;
    const int total = HB_ROWS * 32;
    for (int g0 = F.gtid; g0 < total; g0 += NI * F.T) {
        v4u a[NI], b[NI], c[NI], z[NI]; float l0[NI], l1[NI], l2[NI];
#pragma unroll
        for (int i = 0; i < NI; ++i) { const int gid = g0 + i * F.T < total ? g0 + i * F.T : g0; const int r = gid >> 5, c8 = (gid & 31) * 8, h = c8 >> 6;
            l0[i] = F.LSE[((size_t)0 * HB_ROWS + r) * 4 + h]; l1[i] = F.LSE[((size_t)1 * HB_ROWS + r) * 4 + h]; l2[i] = F.LSE[((size_t)2 * HB_ROWS + r) * 4 + h];
            a[i] = *(const v4u*)(F.OG + ((size_t)0 * HB_ROWS + r) * 256 + c8); b[i] = *(const v4u*)(F.OG + ((size_t)1 * HB_ROWS + r) * 256 + c8); c[i] = *(const v4u*)(F.OG + ((size_t)2 * HB_ROWS + r) * 256 + c8);
            z[i] = *(const v4u*)(F.PA + (size_t)r * PAP + C_BZ + c8); }
        __builtin_amdgcn_sched_barrier(0);
#pragma unroll
        for (int i = 0; i < NI; ++i) { if (g0 + i * F.T >= total) break; const int gid = g0 + i * F.T; const int r = gid >> 5, c8 = (gid & 31) * 8;
            const float mx = fmaxf(l0[i], fmaxf(l1[i], l2[i])); float e0 = __expf(l0[i] - mx), e1 = __expf(l1[i] - mx), e2 = __expf(l2[i] - mx); const float inv = 1.f / (e0 + e1 + e2); e0 *= inv; e1 *= inv; e2 *= inv;
            v4u o;
#define MB_1(X) X = pk2((e0 * bflo(a[i].X) + e1 * bflo(b[i].X) + e2 * bflo(c[i].X)) * bflo(z[i].X), (e0 * bfhi(a[i].X) + e1 * bfhi(b[i].X) + e2 * bfhi(c[i].X)) * bfhi(z[i].X))
            o.MB_1(x); o.MB_1(y); o.MB_1(z); o.MB_1(w);
#undef MB_1
            *(v4u*)(F.YC + (size_t)r * KC + 768 + c8) = o; }
    }
}

__device__ __forceinline__ void dma16(const void* gsrc, LAS unsigned char* ldst) { __builtin_amdgcn_global_load_lds((const unsigned*)gsrc, (LAS unsigned*)ldst, 16, 0, 0); }
#define VM_WAIT0() asm volatile("s_waitcnt vmcnt(0)" ::: "memory")


__device__ __forceinline__ void st_attnM_v3(Ctx& F, int hb) {
    const int lane = hw_lane(), r32 = lane & 31, hi = lane >> 5;
    LAS unsigned char* kimg = F.lds + RING_OFF; LAS unsigned char* vimg = F.lds + RING_OFF + 65536;
    LAS float* kstab = (LAS float*)(F.lds + WSCR_OFF + 8192);
    typedef unsigned u32x2v __attribute__((ext_vector_type(2)));
    const int vcu = F.xgwave >> 3;
    __syncthreads();
    for (int task = vcu; task < 256; task += F.G) {
        const int bh = task >> 2, b = bh >> 2, h = bh & 3; const size_t kbase = (size_t)(hb * 16 + b) * MEML;
#pragma unroll
        for (int j = 0; j < 8; ++j) { const int p = F.wave * 8 + j, row = 4 * p + (lane >> 4);
            dma16(F.KVM + (kbase + row) * 1024 + h * 128 + 8 * ((lane & 15) ^ (row & 15)), kimg + p * 1024);
            dma16(F.KVM + (kbase + 8 * (p >> 1) + ((lane & 31) >> 2)) * 1024 + 512 + h * 128 + (2 * (p & 1) + (lane >> 5)) * 32 + (lane & 3) * 8, vimg + p * 1024); }
        { const int key = F.wave * 32 + r32; const float* sp = F.MKSS + (kbase + key) * 16 + 4 * h;
          const float ksv = rsqrtf(((sp[0] + sp[1]) + (sp[2] + sp[3])) * (1.f / 128.f) + EPS); if (lane < 32) kstab[key] = ksv; }
        VM_WAIT0(); __syncthreads();
#pragma unroll 1
        for (int qi = 0; qi < 2; ++qi) {
            const int qb = (task & 3) * 16 + F.wave * 2 + qi;
            const size_t qrow = (size_t)(b * SEQ + qb * 32 + r32);
            const float qs = rsqrtf(((F.SS[qrow * SS_W + 96 + 4 * h] + F.SS[qrow * SS_W + 96 + 4 * h + 1]) + (F.SS[qrow * SS_W + 96 + 4 * h + 2] + F.SS[qrow * SS_W + 96 + 4 * h + 3])) * (1.f / 128.f) + EPS) * (0.08838834764831845f * LOG2E);
            bf16x8 qf[8];
#pragma unroll
            for (int d0 = 0; d0 < 8; ++d0) { const int dd = 16 * d0 + 8 * hi;
                const v4u raw = *(const v4u*)(F.PA + qrow * PAP + C_MQ + h * 128 + dd);
                const f32x4 wa = *(const f32x4*)(F.mqw + dd), wb = *(const f32x4*)(F.mqw + dd + 4), ka = *(const f32x4*)(F.mkw + dd), kb = *(const f32x4*)(F.mkw + dd + 4);
                v4u o;
                o.x = cvtpk(bflo(raw.x) * qs * wa.x * ka.x, bfhi(raw.x) * qs * wa.y * ka.y); o.y = cvtpk(bflo(raw.y) * qs * wa.z * ka.z, bfhi(raw.y) * qs * wa.w * ka.w);
                o.z = cvtpk(bflo(raw.z) * qs * wb.x * kb.x, bfhi(raw.z) * qs * wb.y * kb.y); o.w = cvtpk(bflo(raw.w) * qs * wb.z * kb.z, bfhi(raw.w) * qs * wb.w * kb.w);
                qf[d0] = __builtin_bit_cast(bf16x8, o); }
            u32x2v zz[4][4];
#pragma unroll
            for (int db = 0; db < 4; ++db)
#pragma unroll
                for (int i = 0; i < 4; ++i) zz[db][i] = *(const u32x2v*)(F.PA + qrow * PAP + C_MZ + h * 128 + 4 * hi + db * 32 + 8 * i);
            float mrun = -1e30f, lrun = 0.f; f32x16 o0 = {}, o1 = {}, o2 = {}, o3 = {};
            const LAS unsigned char* kb0 = kimg + r32 * 256; const int ksw = r32 & 15;
            const LAS unsigned char* vb0 = vimg + (4 * hi + ((lane & 15) >> 2)) * 64 + ((lane >> 4) & 1) * 32 + (lane & 3) * 8;
#pragma unroll 2
            for (int t = 0; t < MEML / 32; ++t) {
                f32x16 st = {};
#pragma unroll
                for (int d0 = 0; d0 < 8; ++d0) { const bf16x8 kf = *(const LAS bf16x8*)(kb0 + t * 8192 + (((2 * d0 + hi) ^ ksw) * 16)); st = __builtin_amdgcn_mfma_f32_32x32x16_bf16(kf, qf[d0], st, 0, 0, 0); }
                float tmax = -1e30f;
#pragma unroll
                for (int i = 0; i < 4; ++i) { const f32x4 kk = *(const LAS f32x4*)(kstab + 32 * t + 8 * i + 4 * hi);
#pragma unroll
                    for (int j = 0; j < 4; ++j) { const float s = st[4 * i + j] * kk[j]; st[4 * i + j] = s; tmax = fmaxf(tmax, s); } }
                tmax = fmaxf(tmax, __shfl_xor(tmax, 32));
                const float mnew = fmaxf(mrun, tmax), alpha = __builtin_amdgcn_exp2f(mrun - mnew); mrun = mnew;
                float psum = 0.f;
#pragma unroll
                for (int r = 0; r < 16; ++r) { st[r] = __builtin_amdgcn_exp2f(st[r] - mnew); psum += st[r]; }
                lrun = lrun * alpha + psum;
#pragma unroll
                for (int r = 0; r < 16; ++r) { o0[r] *= alpha; o1[r] *= alpha; o2[r] *= alpha; o3[r] *= alpha; }
                v4u p0, p1;
                p0.x = cvtpk(st[0], st[1]); p0.y = cvtpk(st[2], st[3]); p0.z = cvtpk(st[4], st[5]); p0.w = cvtpk(st[6], st[7]);
                p1.x = cvtpk(st[8], st[9]); p1.y = cvtpk(st[10], st[11]); p1.z = cvtpk(st[12], st[13]); p1.w = cvtpk(st[14], st[15]);
                const LAS unsigned char* vb = vb0 + t * 8192;
#define AM_PV(OX, DB) do { _Pragma("unroll") for (int s = 0; s < 2; ++s) { const bf16x8 pf = __builtin_bit_cast(bf16x8, s == 0 ? p0 : p1); \
                    const s16x4 a = vtr(vb + (2 * s) * 2048 + (DB) * 512), c = vtr(vb + (2 * s + 1) * 2048 + (DB) * 512); const bf16x8 vf = {a[0], a[1], a[2], a[3], c[0], c[1], c[2], c[3]}; \
                    OX = __builtin_amdgcn_mfma_f32_32x32x16_bf16(vf, pf, OX, 0, 0, 0); } } while (0)
                AM_PV(o0, 0); AM_PV(o1, 1); AM_PV(o2, 2); AM_PV(o3, 3);
#undef AM_PV
            }
            const float ltot = lrun + __shfl_xor(lrun, 32), inv = 1.f / ltot;
            bf16* yrow = F.YC + qrow * KC + 1024 + h * 128 + 4 * hi;
#define AM_ST(OX, DB) do { _Pragma("unroll") for (int i = 0; i < 4; ++i) { const u32x2v z = zz[DB][i]; u32x2v w; \
                w.x = cvtpk(OX[4 * i] * inv * bflo(z.x), OX[4 * i + 1] * inv * bfhi(z.x)); w.y = cvtpk(OX[4 * i + 2] * inv * bflo(z.y), OX[4 * i + 3] * inv * bfhi(z.y)); \
                *(u32x2v*)(yrow + (DB) * 32 + 8 * i) = w; } } while (0)
            AM_ST(o0, 0); AM_ST(o1, 1); AM_ST(o2, 2); AM_ST(o3, 3);
#undef AM_ST
        }
        __syncthreads();
    }
}

__device__ __forceinline__ void st_attnB_v3(Ctx& F) {
    const int lane = hw_lane(), r32 = lane & 31, hi = lane >> 5, tid = F.wave * 64 + lane;
    LAS unsigned char* kimg = F.lds + RING_OFF; LAS unsigned char* vimg = F.lds + RING_OFF + 49152;
    LAS float* kstab = (LAS float*)(F.lds + RING_OFF + 98304);
    LAS float* btab = (LAS float*)(F.lds + RING_OFF + 98304 + 2048);
    typedef unsigned u32x2v __attribute__((ext_vector_type(2)));
    const int vcu = F.xgwave >> 3;
    __syncthreads();
    for (int unit = vcu; unit < 3 * 16 * 4 * 8; unit += F.G) {
        const int k = unit & 7, h = (unit >> 3) & 3, b = (unit >> 5) & 15, g = unit >> 9, hh = 4 * g + h;
        const int dil = g == 0 ? 1 : (g == 1 ? 4 : 16);
        const int res0 = g == 0 ? 0 : (g == 1 ? (k >> 1) : 2 * k), j0 = g == 0 ? 8 * k : (g == 1 ? 8 * (k & 1) : 0);
#pragma unroll
        for (int i = 0; i < 12; ++i) { const int q = F.wave * 12 + i, s = q >> 3, pc = q & 7, p = pc & 3;
            int res, jt; bool valid;
            if (g < 2) { res = res0; jt = j0 - 4 + s; valid = jt >= 0; } else { res = res0 + (s >> 2); jt = s & 3; valid = s < 8; }
            if (valid) {
                if (pc < 4) { const int row = 8 * p + (lane >> 3); const size_t trow = (size_t)(b * SEQ + res + (32 * jt + row) * dil);
                    dma16(F.PA + trow * PAP + C_BK + hh * 64 + 8 * ((lane & 7) ^ ((row >> 1) & 7)), kimg + s * 4096 + p * 1024); }
                else { const int key = 8 * p + ((lane & 31) >> 2); const size_t trow = (size_t)(b * SEQ + res + (32 * jt + key) * dil);
                    dma16(F.PA + trow * PAP + C_BV + hh * 64 + (lane >> 5) * 32 + (lane & 3) * 8, vimg + s * 4096 + p * 1024); } } }
        if (tid < 384) { const int s = tid >> 5, kk = tid & 31; int res, jt; bool valid;
            if (g < 2) { res = res0; jt = j0 - 4 + s; valid = jt >= 0; } else { res = res0 + (s >> 2); jt = s & 3; valid = s < 8; }
            if (valid) { const size_t trow = (size_t)(b * SEQ + res + (32 * jt + kk) * dil);
                kstab[tid] = rsqrtf((F.SS[trow * SS_W + 72 + 2 * hh] + F.SS[trow * SS_W + 72 + 2 * hh + 1]) * (1.f / 64.f) + EPS); } }
        if (tid < NBX) btab[tid] = F.BIASX[(g * 4 + h) * NBX + tid];
        const int wres = g < 2 ? res0 : res0 + (F.wave >> 2), j = g < 2 ? j0 + F.wave : (F.wave & 3);
        const int sbase = g < 2 ? 4 - j0 : (F.wave >> 2) * 4;
        const size_t qrow = (size_t)(b * SEQ + wres + (32 * j + r32) * dil);
        const float qs = rsqrtf((F.SS[qrow * SS_W + 48 + 2 * hh] + F.SS[qrow * SS_W + 48 + 2 * hh + 1]) * (1.f / 64.f) + EPS) * (0.125f * LOG2E);
        bf16x8 qf[4];
#pragma unroll
        for (int d0 = 0; d0 < 4; ++d0) { const int dd = 16 * d0 + 8 * hi;
            const v4u raw = *(const v4u*)(F.PA + qrow * PAP + C_BQ + hh * 64 + dd);
            const f32x4 wa = *(const f32x4*)(F.bqw + dd), wb = *(const f32x4*)(F.bqw + dd + 4), ka = *(const f32x4*)(F.bkw + dd), kb = *(const f32x4*)(F.bkw + dd + 4);
            v4u o;
            o.x = cvtpk(bflo(raw.x) * qs * wa.x * ka.x, bfhi(raw.x) * qs * wa.y * ka.y); o.y = cvtpk(bflo(raw.y) * qs * wa.z * ka.z, bfhi(raw.y) * qs * wa.w * ka.w);
            o.z = cvtpk(bflo(raw.z) * qs * wb.x * kb.x, bfhi(raw.z) * qs * wb.y * kb.y); o.w = cvtpk(bflo(raw.w) * qs * wb.z * kb.z, bfhi(raw.w) * qs * wb.w * kb.w);
            qf[d0] = __builtin_bit_cast(bf16x8, o); }
        VM_WAIT0(); __syncthreads();
        float mrun = -1e30f, lrun = 0.f; f32x16 o0 = {}, o1 = {};
        const int ksw = (r32 >> 1) & 7;
        for (int jt = (j >= 4 ? j - 4 : 0); jt <= j; ++jt) {
            const int s = sbase + jt;
            const LAS unsigned char* kb = kimg + s * 4096 + r32 * 128;
            f32x16 st = {};
#pragma unroll
            for (int d0 = 0; d0 < 4; ++d0) { const bf16x8 kf = *(const LAS bf16x8*)(kb + (((2 * d0 + hi) ^ ksw) * 16)); st = __builtin_amdgcn_mfma_f32_32x32x16_bf16(kf, qf[d0], st, 0, 0, 0); }
            const int bidx = 32 * (j - jt) + r32 + 31 - 4 * hi;
            float tmax = -1e30f;
#pragma unroll
            for (int i = 0; i < 4; ++i) { const f32x4 kk = *(const LAS f32x4*)(kstab + s * 32 + 8 * i + 4 * hi);
#pragma unroll
                for (int jj = 0; jj < 4; ++jj) { const float sv = st[4 * i + jj] * kk[jj] + btab[bidx - 8 * i - jj]; st[4 * i + jj] = sv; tmax = fmaxf(tmax, sv); } }
            tmax = fmaxf(tmax, __shfl_xor(tmax, 32));
            const float mnew = fmaxf(mrun, tmax), alpha = __builtin_amdgcn_exp2f(mrun - mnew); mrun = mnew;
            float psum = 0.f;
#pragma unroll
            for (int r = 0; r < 16; ++r) { st[r] = __builtin_amdgcn_exp2f(st[r] - mnew); psum += st[r]; }
            lrun = lrun * alpha + psum;
#pragma unroll
            for (int r = 0; r < 16; ++r) { o0[r] *= alpha; o1[r] *= alpha; }
            v4u p0, p1;
            p0.x = cvtpk(st[0], st[1]); p0.y = cvtpk(st[2], st[3]); p0.z = cvtpk(st[4], st[5]); p0.w = cvtpk(st[6], st[7]);
            p1.x = cvtpk(st[8], st[9]); p1.y = cvtpk(st[10], st[11]); p1.z = cvtpk(st[12], st[13]); p1.w = cvtpk(st[14], st[15]);
            const LAS unsigned char* vb = vimg + s * 4096 + (4 * hi + ((lane & 15) >> 2)) * 64 + ((lane >> 4) & 1) * 32 + (lane & 3) * 8;
#pragma unroll
            for (int ss = 0; ss < 2; ++ss) { const bf16x8 pf = __builtin_bit_cast(bf16x8, ss == 0 ? p0 : p1);
                { const s16x4 a = vtr(vb + (2 * ss) * 1024), c = vtr(vb + (2 * ss + 1) * 1024); const bf16x8 vf = {a[0], a[1], a[2], a[3], c[0], c[1], c[2], c[3]};
                  o0 = __builtin_amdgcn_mfma_f32_32x32x16_bf16(vf, pf, o0, 0, 0, 0); }
                { const s16x4 a = vtr(vb + (2 * ss) * 1024 + 512), c = vtr(vb + (2 * ss + 1) * 1024 + 512); const bf16x8 vf = {a[0], a[1], a[2], a[3], c[0], c[1], c[2], c[3]};
                  o1 = __builtin_amdgcn_mfma_f32_32x32x16_bf16(vf, pf, o1, 0, 0, 0); } }
        }
        const float ltot = lrun + __shfl_xor(lrun, 32), inv = 1.f / ltot;
        bf16* orow = F.OG + ((size_t)g * HB_ROWS + qrow) * 256 + h * 64 + 4 * hi;
#pragma unroll
        for (int i = 0; i < 4; ++i) { u32x2v w0, w1; w0.x = cvtpk(o0[4 * i] * inv, o0[4 * i + 1] * inv); w0.y = cvtpk(o0[4 * i + 2] * inv, o0[4 * i + 3] * inv);
            w1.x = cvtpk(o1[4 * i] * inv, o1[4 * i + 1] * inv); w1.y = cvtpk(o1[4 * i + 2] * inv, o1[4 * i + 3] * inv);
            *(u32x2v*)(orow + 8 * i) = w0; *(u32x2v*)(orow + 32 + 8 * i) = w1; }
        if (hi == 0) F.LSE[((size_t)g * HB_ROWS + qrow) * 4 + h] = (mrun + __log2f(ltot)) * LN2;
        __syncthreads();
    }
}

#ifndef G1_STAGGER_TICKS
#define G1_STAGGER_TICKS 0
#endif
#ifndef G1_ALIGN_EPI
#define G1_ALIGN_EPI true
#endif
#ifndef PROBE_REP
#define PROBE_REP -1
#endif
#define REPS(id) for (int rep_ = 0; rep_ < ((PROBE_REP) == (id) ? 2 : 1); ++rep_)
#ifndef MK_PER_PHASE
#define MK_PER_PHASE 0
#endif
constexpr int NPH_HALF = 5, NPHASES = 1 + 2 * NPH_HALF;
struct Args { const float* in[20]; float* out; unsigned char* ws; int ph_lo, ph_hi; };
__global__ void __launch_bounds__(NTHR, 2) mega_fwd(Args args) {
    extern __shared__ __attribute__((aligned(16))) unsigned char lds_raw[];
    Ctx F;
    F.lds = (LAS unsigned char*)lds_raw;
    F.tid = threadIdx.x; F.lane = F.tid & 63; F.wave = __builtin_amdgcn_readfirstlane(F.tid >> 6);
    F.G = gridDim.x; F.gtid = blockIdx.x * NTHR + F.tid; F.T = F.G * NTHR; F.gwave = blockIdx.x * NWAVES + F.wave; F.NW = F.G * NWAVES;
    { const int bx = blockIdx.x; const int vcu = (F.G % 8 == 0) ? (bx % 8) * (F.G / 8) + bx / 8 : bx; F.xgwave = vcu * NWAVES + F.wave; }
    unsigned char* ws = args.ws;
    F.x = args.in[0]; F.mem = args.in[1]; F.norm_w = args.in[2]; F.w_in = args.in[3]; F.gate_b = args.in[4]; F.lnw = args.in[5]; F.lnb = args.in[6]; F.sp_w = args.in[7];
    F.sp_b = args.in[8]; F.bqw = args.in[9]; F.bkw = args.in[10]; F.rel_bias = args.in[11]; F.mem_norm_w = args.in[12]; F.m_w_kv = args.in[13]; F.mqw = args.in[14]; F.mkw = args.in[15];
    F.proj_a = args.in[16]; F.proj_b = args.in[17]; F.proj_m = args.in[18]; F.w_out = args.in[19]; F.out = args.out;
    F.WIN = (bf16*)(ws + WS_WIN); F.PCAT = (bf16*)(ws + WS_PCAT); F.WOUT = (bf16*)(ws + WS_WOUT); F.WSP = (bf16*)(ws + WS_WSP); F.BIAS = (float*)(ws + WS_BIAS); F.BIASX = (float*)(ws + WS_BIAS + 65536);
    F.XN = (bf16*)(ws + WS_XN); F.PA = (bf16*)(ws + WS_PA); F.KVM = (bf16*)(ws + WS_KVM); F.SS = (float*)(ws + WS_SS); F.MKSS = (float*)(ws + WS_MKSS);
    F.OG = (bf16*)(ws + WS_OG); F.LSE = (float*)(ws + WS_LSE); F.LNST = (float*)(ws + WS_LNST); F.YC = (bf16*)(ws + WS_YC); F.MRG = (bf16*)(ws + WS_MRG);
    for (int u = F.tid; u < (LDS_BYTES - LDSCTL_OFF) / 4; u += NTHR) ((LAS unsigned*)(F.lds + LDSCTL_OFF))[u] = 0u;
    __syncthreads();
    XcdBarrier bar; bar.bar = (unsigned*)(ws + WS_CTL) + CW_BAR; bar.x = 0; bar.st = nullptr; bar.wave = 0;
    if (!MK_PER_PHASE) bar = xcd_barrier_post((unsigned*)(ws + WS_CTL) + CW_BAR, (volatile LAS unsigned*)(F.lds + MISC_OFF) + 8, F.wave);
    const int lo = args.ph_lo, hi = args.ph_hi;
#define IN(k) (lo <= (k) && (k) < hi)
#define SEAM(k) do { if (IN(k) && IN((k) + 1)) xcd_barrier(bar); } while (0)

    if (IN(0)) { REPS(0) p0_prologue(F); } SEAM(0);
#pragma unroll 1
    for (int hb = 0; hb < 2; ++hb) {
        const int pb = 1 + hb * NPH_HALF, row0 = hb * HB_ROWS;
        asm volatile("v_mbcnt_lo_u32_b32 %0, -1, 0\n\tv_mbcnt_hi_u32_b32 %0, -1, %0" : "=v"(F.lane)); F.tid = F.wave * 64 + F.lane; F.gtid = blockIdx.x * NTHR + F.tid;
#if PROBE_REP == 9 || PROBE_REP == 10
        if (IN(pb + 0)) { pg8::Gemm g{F.XN, F.WIN, MTOT + MMEM, NIN + 1024, DM, DM, DM}; pg8::OrderG1 S; S.init(hb, F.G, (int)blockIdx.x);
            typedef pg8::EpiProjT<PROBE_REP - 8> EP; EP E{F.PA, F.KVM, F.SS, F.MKSS, F.gate_b, hb * (HB_ROWS / 256), 0};
            pg8::gemm_phase<EP, pg8::OrderG1, true, true>(F.lds + RING_OFF, g, S, E, F.wave); }
#endif
        if (IN(pb + 0)) REPS(1) {
            pg8::Gemm g{F.XN, F.WIN, MTOT + MMEM, NIN + 1024, DM, DM, DM}; pg8::OrderG1 S; S.init(hb, F.G, (int)blockIdx.x);
#if G1_STAGGER_TICKS
            { const unsigned long long t0 = __builtin_amdgcn_s_memrealtime(), dl = (unsigned long long)((blockIdx.x >> 3) & 31) * G1_STAGGER_TICKS;
              while (__builtin_amdgcn_s_memrealtime() - t0 < dl) __builtin_amdgcn_s_sleep(8); }
#endif
            pg8::EpiProj E{F.PA, F.KVM, F.SS, F.MKSS, F.gate_b, hb * (HB_ROWS / 256), 0};
            pg8::gemm_phase<pg8::EpiProj, pg8::OrderG1, G1_ALIGN_EPI, true>(F.lds + RING_OFF, g, S, E, F.wave);
        }
#if PROBE_REP == 8
        if (IN(pb + 0)) { pg8::Gemm g{F.XN, F.WIN, MTOT + MMEM, NIN + 1024, DM, DM, DM}; pg8::OrderG1 S; S.init(hb, F.G, (int)blockIdx.x); pg8::EpiNull E{};
            pg8::gemm_phase<pg8::EpiNull, pg8::OrderG1, true, true>(F.lds + RING_OFF, g, S, E, F.wave); }
#endif
        SEAM(pb + 0);
        if (IN(pb + 1)) { REPS(2) st_mixA_mfma(F); REPS(3) st_attnB_v3(F); REPS(4) st_attnM_v3(F, hb); } SEAM(pb + 1);
        if (IN(pb + 2)) { REPS(5) st_mergeB_vec(F); } SEAM(pb + 2);
#if PROBE_REP == 13 || PROBE_REP == 14
        if (IN(pb + 3)) { pg8::Gemm g{F.YC, F.PCAT, HB_ROWS, DM, KC, KC, KC}; pg8::StaticOrder S; S.init(HB_ROWS, DM, F.G, (int)blockIdx.x);
            typedef pg8::EpiG2catT<PROBE_REP == 13, PROBE_REP == 14> EP; EP E{F.PA, F.MRG};
            pg8::gemm_phase<EP, pg8::StaticOrder, true, true>(F.lds + RING_OFF, g, S, E, F.wave); }
#endif
#if PROBE_REP == 11
        if (IN(pb + 3)) { pg8::Gemm g{F.YC, F.PCAT, HB_ROWS, DM, KC, KC, KC}; pg8::StaticOrder S; S.init(HB_ROWS, DM, F.G, (int)blockIdx.x); pg8::EpiNull E{};
            pg8::gemm_phase<pg8::EpiNull, pg8::StaticOrder, true, true>(F.lds + RING_OFF, g, S, E, F.wave); }
#endif
#if PROBE_REP == 12
        if (IN(pb + 4)) { pg8::Gemm g{F.MRG, F.WOUT, HB_ROWS, DM, DM, DM, DM}; pg8::StaticOrder S; S.init(HB_ROWS, DM, F.G, (int)blockIdx.x); pg8::EpiNull E{};
            pg8::gemm_phase<pg8::EpiNull, pg8::StaticOrder, true, true>(F.lds + RING_OFF, g, S, E, F.wave); }
#endif
        if (IN(pb + 3)) REPS(6) {
            pg8::Gemm g{F.YC, F.PCAT, HB_ROWS, DM, KC, KC, KC}; pg8::StaticOrder S; S.init(HB_ROWS, DM, F.G, (int)blockIdx.x);
            pg8::EpiG2cat E{F.PA, F.MRG};
            pg8::gemm_phase<pg8::EpiG2cat, pg8::StaticOrder, true, true>(F.lds + RING_OFF, g, S, E, F.wave);
        } SEAM(pb + 3);
        if (IN(pb + 4)) REPS(7) {
            pg8::Gemm g{F.MRG, F.WOUT, HB_ROWS, DM, DM, DM, DM}; pg8::StaticOrder S; S.init(HB_ROWS, DM, F.G, (int)blockIdx.x);
            pg8::EpiG3 E{F.x + (size_t)row0 * DM, F.out + (size_t)row0 * DM};
            pg8::gemm_phase<pg8::EpiG3, pg8::StaticOrder, true, true>(F.lds + RING_OFF, g, S, E, F.wave);
        } if (hb == 1) SEAM(pb + 4);
    }
#undef IN
#undef SEAM
}

extern "C" void kernel_launch(void* const* d_in, const int* in_sizes, int n_in, void* d_out, int out_size, void* d_ws, size_t ws_size, hipStream_t stream) {
    static int grid = 0;
    if (grid == 0) {
        if (n_in != 20 || in_sizes[0] != MTOT * DM || out_size != MTOT * DM || ws_size < WS_END) { fprintf(stderr, "kernel_launch: unexpected shapes (n_in %d, ws %zu); nothing launched\n", n_in, ws_size); grid = -1; return; }
        int dev = 0, cus = 0, per_cu = 0;
        if (hipGetDevice(&dev) != hipSuccess || hipDeviceGetAttribute(&cus, hipDeviceAttributeMultiprocessorCount, dev) != hipSuccess) { grid = -1; return; }
        if (hipFuncSetAttribute((const void*)mega_fwd, hipFuncAttributeMaxDynamicSharedMemorySize, LDS_BYTES) != hipSuccess) { fprintf(stderr, "kernel_launch: hipFuncSetAttribute failed\n"); grid = -1; return; }
        if (hipOccupancyMaxActiveBlocksPerMultiprocessor(&per_cu, (const void*)mega_fwd, NTHR, LDS_BYTES) != hipSuccess || per_cu < 1) { fprintf(stderr, "kernel_launch: occupancy query says %d blocks per CU\n", per_cu); (void)hipGetLastError(); grid = -1; return; }
        grid = cus;
    }
    if (grid < 0) return;
    if (hipMemsetAsync((char*)d_ws + WS_CTL, 0, CTL_ZERO_BYTES, stream) != hipSuccess) return;
    Args a{};
    for (int i = 0; i < 20; ++i) a.in[i] = (const float*)d_in[i];
    a.out = (float*)d_out; a.ws = (unsigned char*)d_ws;
#if MK_PER_PHASE
    for (int p = 0; p < NPHASES; ++p) { a.ph_lo = p; a.ph_hi = p + 1; hipLaunchKernelGGL(mega_fwd, dim3(grid), dim3(NTHR), LDS_BYTES, stream, a); }
#else
    a.ph_lo = 0; a.ph_hi = NPHASES; hipLaunchKernelGGL(mega_fwd, dim3(grid), dim3(NTHR), LDS_BYTES, stream, a);
#endif
}
```

```cpp
#include <hip/hip_runtime.h>
#include <cstdint>
#include <cstdio>

constexpr int DM = 1024, NB = 32, SEQ = 2048, MTOT = NB * SEQ;
constexpr int NIN = 8960, MEML = 256, MMEM = NB * MEML;
constexpr int HB_ROWS = MTOT / 2;
constexpr int C_AU = 0, C_AV = 768, C_AZ = 1536, C_BQ = 2304, C_BK = 3072, C_BV = 3840, C_BZ = 4608, C_MQ = 4864, C_MZ = 5376, C_G = 5888;
constexpr float EPS = 1e-6f;
constexpr int SS_W = 112;
constexpr int PAP = 7424;
constexpr int PA_ROWB = 2 * PAP, PA_GOFF = 2 * C_G;
constexpr int KC = 1536;

constexpr size_t MiB = 1u << 20;
constexpr size_t WS_CTL = 0, CTL_ZERO_BYTES = 256 * 1024, WS_WIN = 2 * MiB, WS_PCAT = 22 * MiB, WS_WOUT = 25 * MiB, WS_WSP = 27 * MiB, WS_BIAS = 27 * MiB + 512 * 1024;
constexpr size_t WS_XN = 32 * MiB, WS_PA = 176 * MiB, WS_KVM = 736 * MiB, WS_SS = 752 * MiB, WS_MKSS = 766 * MiB, WS_OG = 768 * MiB, WS_LSE = 816 * MiB, WS_LNST = 818 * MiB;
constexpr size_t WS_YC = 820 * MiB, WS_MRG = 916 * MiB, WS_END = 980 * MiB;
constexpr int CW_BAR = 4096;

namespace pg8 {
#define PG8_LAS __attribute__((address_space(3)))
typedef unsigned short bf16_t;
typedef short bf16x8 __attribute__((ext_vector_type(8)));
typedef float f32x4 __attribute__((ext_vector_type(4)));
typedef unsigned u32x4 __attribute__((ext_vector_type(4)));
constexpr int BM = 256, BK = 64, HALF = 128, HTB = HALF * BK * 2  , STAGE_BYTES = 8 * HTB, NXCD = 8, WGM = 8;

__host__ __device__ __forceinline__ int lds_byte(int r, int c) { const int st = (r >> 4) * 2 + (c >> 5), rr = r & 15, cc = c & 31, ob = rr * 64 + cc * 2; return st * 1024 + (ob ^ (((ob >> 9) & 1) << 5)); }
__host__ __device__ __forceinline__ void stage_rc(int b, int& R, int& C) { const int st = b / 1024, sb = b % 1024, swz = sb ^ (((sb >> 9) & 1) << 5); R = (st >> 1) * 16 + swz / 64; C = (st & 1) * 32 + (swz % 64) / 2; }
__host__ __device__ __forceinline__ int perm32(int rho) { const int n = rho >> 4, i = rho & 15; return 8 * (i >> 2) + 4 * n + (i & 3); }

struct Unit { int pm, pn; };
struct Gemm { const bf16_t* A; const bf16_t* Bt; int M, N, K, lda, ldb; };

struct StaticOrder {
    int nM, nN, nwg, G, c;
    __host__ __device__ void init(int M, int N, int G_, int c_) { nM = M / BM; nN = N / BM; nwg = nM * nN; G = G_; c = c_; }
    __host__ __device__ bool next(int i, Unit& u) const {
        const long L = (long)i * G + c; if (L >= nwg) return false;
        int wgid = (int)L; { const int q = nwg / NXCD, r = nwg % NXCD, xcd = wgid % NXCD, off = wgid / NXCD; wgid = (xcd < r ? xcd * (q + 1) : r * (q + 1) + (xcd - r) * q) + off; }
        const int nig = WGM * nN, gid = wgid / nig, fm = gid * WGM, gsz = (nM - fm) < WGM ? (nM - fm) : WGM;
        u.pm = fm + ((wgid % nig) % gsz); u.pn = (wgid % nig) / gsz; return true;
    }
    __device__ __forceinline__ void a_ready(const Unit&) const {}
    __device__ __forceinline__ void done(const Unit&) const {}
};


typedef float f32x2c_t __attribute__((ext_vector_type(2))); typedef __bf16 bf16x2c_t __attribute__((ext_vector_type(2)));
__device__ __forceinline__ unsigned cvt_pk_bf16(float lo, float hi) { const f32x2c_t v = {lo, hi}; const bf16x2c_t b = __builtin_convertvector(v, bf16x2c_t); return __builtin_bit_cast(unsigned, b); }
typedef float f32x2 __attribute__((ext_vector_type(2)));
__device__ __forceinline__ f32x2 gelu_pk(f32x2 v) {
    const f32x2 av = __builtin_elementwise_abs(v), d = av * 0.2316418882f + 1.0f;
    f32x2 t; t.x = __builtin_amdgcn_rcpf(d.x); t.y = __builtin_amdgcn_rcpf(d.y);
    f32x2 q = t * 0.5307027145f + (-0.7265760135f); q = q * t + 0.7107068705f; q = q * t + (-0.142248368f); q = q * t + 0.127414796f; q = q * t;
    const f32x2 s = (v * v) * (-0.72134752044f);
    f32x2 e; e.x = __builtin_amdgcn_exp2f(s.x); e.y = __builtin_amdgcn_exp2f(s.y);
    const f32x2 m = v * (q * e), r = v - m;
    f32x2 o; o.x = v.x < 0.f ? m.x : r.x; o.y = v.y < 0.f ? m.y : r.y; return o;
}

template <class Epi, class Sched, bool ALIGN_EPI = false, bool SP2 = false>
__device__ __forceinline__ void gemm_phase(PG8_LAS unsigned char* lds, const Gemm g, const Sched& S, const Epi& E, const int wave_id) {
    int tid; asm volatile("v_mbcnt_lo_u32_b32 %0, -1, 0\n\tv_mbcnt_hi_u32_b32 %0, -1, %0" : "=v"(tid)); tid += wave_id * 64;
    const int wid = __builtin_amdgcn_readfirstlane(tid >> 6), lane = tid & 63, wr = wid >> 2, wc = wid & 3, fr = lane & 15, fq = lane >> 4;
    int K = g.K; asm volatile("" : "+s"(K)); const int nt = K / BK;
    unsigned voffA[2], voffB[2];
#pragma unroll
    for (int i = 0; i < 2; ++i) { int R, C; stage_rc(tid * 16 + i * 8192, R, C); const int Rb = Epi::PERM ? ((R & ~31) + perm32(R & 31)) : R;
        voffA[i] = (unsigned)(R * g.lda + C) * 2u; voffB[i] = (unsigned)(Rb * g.ldb + C) * 2u; }
    const size_t kstep = (size_t)(BK * 2);
    const size_t hstepA = (size_t)HALF * g.lda * 2, hstepB = (size_t)HALF * g.ldb * 2;
    const size_t tstepA = 2 * hstepA, tstepB = 2 * hstepB;
    const unsigned ldsw = (unsigned)wid * 1024u;
    const int aoff = lds_byte(wr * 64 + fr, fq * 8), boff = lds_byte(wc * 32 + fr, fq * 8);
#define PG8_SA(b, h) (((b) * 2 + (h)) * HTB)
#define PG8_SB(b, h) ((4 + (b) * 2 + (h)) * HTB)
#define PG8_STAGE(bufoff, gbase, voff) do { _Pragma("unroll") for (int _i = 0; _i < 2; ++_i) \
        __builtin_amdgcn_global_load_lds((const unsigned*)((const char*)(gbase) + (voff)[_i]), (PG8_LAS unsigned*)(lds + (bufoff) + ldsw + _i * 8192), 16, 0, 0); } while (0)
#define PG8_LDA(dst, b, h) do { _Pragma("unroll") for (int m = 0; m < 4; ++m) _Pragma("unroll") for (int k = 0; k < 2; ++k) dst[m][k] = *(const PG8_LAS bf16x8*)(lds + PG8_SA(b, h) + aoff + m * 2048 + k * 1024); } while (0)
#define PG8_LDB(dst, b, h) do { _Pragma("unroll") for (int n = 0; n < 2; ++n) _Pragma("unroll") for (int k = 0; k < 2; ++k) dst[n][k] = *(const PG8_LAS bf16x8*)(lds + PG8_SB(b, h) + boff + n * 2048 + k * 1024); } while (0)
#define PG8_MMA(ai, bj, At, Bt) do { __builtin_amdgcn_s_setprio(1); _Pragma("unroll") for (int m = 0; m < 4; ++m) _Pragma("unroll") for (int n = 0; n < 2; ++n) _Pragma("unroll") for (int k = 0; k < 2; ++k) \
        acc[ai][bj][m][n] = __builtin_amdgcn_mfma_f32_16x16x32_bf16(Bt[n][k], At[m][k], acc[ai][bj][m][n], 0, 0, 0); __builtin_amdgcn_s_setprio(0); } while (0)
#define PG8_WAIT_V(n) asm volatile("s_waitcnt vmcnt(" #n ")" ::: "memory")
#define PG8_WAIT_L(n) asm volatile("s_waitcnt lgkmcnt(" #n ")" ::: "memory")
#define PG8_BAR __builtin_amdgcn_s_barrier()
#define PG8_SCHED __builtin_amdgcn_sched_barrier(0)
    Unit cur, nxt; int ui = 0;
    if (!S.next(0, cur)) return;
    f32x4 acc[2][2][4][2];
#pragma unroll
    for (int a = 0; a < 2; ++a)
#pragma unroll
        for (int b = 0; b < 2; ++b)
#pragma unroll
            for (int m = 0; m < 4; ++m)
#pragma unroll
                for (int n = 0; n < 2; ++n) acc[a][b][m][n] = (f32x4){0.f, 0.f, 0.f, 0.f};
    bf16x8 At[4][2], B0[2][2], B1[2][2];
    const char* cA = (const char*)g.A + (size_t)cur.pm * tstepA; const char* cB = (const char*)g.Bt + (size_t)cur.pn * tstepB;
    S.a_ready(cur);
    if constexpr (SP2) {
        PG8_STAGE(PG8_SB(0, 0), cB, voffB); PG8_STAGE(PG8_SB(0, 1), cB + hstepB, voffB); PG8_STAGE(PG8_SA(0, 0), cA, voffA); PG8_STAGE(PG8_SA(0, 1), cA + hstepA, voffA);
        if (wr == 1) PG8_BAR;
        PG8_WAIT_V(2); PG8_BAR;
        PG8_STAGE(PG8_SB(1, 0), cB + kstep, voffB); PG8_STAGE(PG8_SA(1, 0), cA + kstep, voffA); PG8_STAGE(PG8_SB(1, 1), cB + hstepB + kstep, voffB);
        PG8_WAIT_V(6); PG8_BAR;
    } else {
        PG8_STAGE(PG8_SB(0, 0), cB, voffB); PG8_STAGE(PG8_SA(0, 0), cA, voffA); PG8_STAGE(PG8_SB(0, 1), cB + hstepB, voffB); PG8_STAGE(PG8_SA(0, 1), cA + hstepA, voffA);
        if (wr == 1) PG8_BAR;
        PG8_WAIT_V(4); PG8_BAR;
        PG8_STAGE(PG8_SB(1, 0), cB + kstep, voffB); PG8_STAGE(PG8_SA(1, 0), cA + kstep, voffA); PG8_STAGE(PG8_SB(1, 1), cB + hstepB + kstep, voffB);
        PG8_WAIT_V(6); PG8_BAR;
    }
    for (;;) {
        const bool has_next = S.next(ui + 1, nxt);
        const char* nA = has_next ? (const char*)g.A + (size_t)nxt.pm * tstepA : cA; const char* nB = has_next ? (const char*)g.Bt + (size_t)nxt.pn * tstepB : cB;
        for (int t = 0; t < nt; t += 2) {
            if constexpr (Epi::KHOOK) { if (t == Epi::KH1 || t == Epi::KH2) E.khook(acc, cur, t, wr, wc, fr, fq); }
            const bool last = (t == nt - 2);
            const char* a1 = cA + (size_t)(t + 1) * kstep;
            const char* a2 = last ? nA : cA + (size_t)(t + 2) * kstep; const char* b2 = last ? nB : cB + (size_t)(t + 2) * kstep;
            const char* a3 = a2 + kstep; const char* b3 = b2 + kstep;
            if (last && has_next) S.a_ready(nxt);
            if constexpr (SP2) {
            PG8_LDB(B0, 0, 0); PG8_LDB(B1, 0, 1); PG8_SCHED; PG8_LDA(At, 0, 0); PG8_STAGE(PG8_SA(1, 1), a1 + hstepA, voffA);
            PG8_WAIT_V(8); PG8_WAIT_L(0); PG8_BAR; PG8_MMA(0, 0, At, B0); PG8_MMA(0, 1, At, B1); PG8_BAR; PG8_SCHED;
            PG8_LDA(At, 0, 1); PG8_STAGE(PG8_SB(0, 0), b2, voffB); PG8_STAGE(PG8_SB(0, 1), b2 + hstepB, voffB); PG8_STAGE(PG8_SA(0, 0), a2, voffA);
            PG8_WAIT_V(8); PG8_WAIT_L(0); PG8_BAR; PG8_MMA(1, 0, At, B0); PG8_MMA(1, 1, At, B1); PG8_BAR; PG8_SCHED;
            PG8_LDB(B0, 1, 0); PG8_LDB(B1, 1, 1); PG8_SCHED; PG8_LDA(At, 1, 0); PG8_STAGE(PG8_SA(0, 1), a2 + hstepA, voffA);
            PG8_WAIT_V(8); PG8_WAIT_L(0); PG8_BAR; PG8_MMA(0, 0, At, B0); PG8_MMA(0, 1, At, B1); PG8_BAR; PG8_SCHED;
            PG8_LDA(At, 1, 1); PG8_STAGE(PG8_SB(1, 0), b3, voffB); PG8_STAGE(PG8_SB(1, 1), b3 + hstepB, voffB); PG8_STAGE(PG8_SA(1, 0), a3, voffA);
            PG8_WAIT_V(8); PG8_WAIT_L(0); PG8_BAR; PG8_MMA(1, 0, At, B0); PG8_MMA(1, 1, At, B1); PG8_BAR; PG8_SCHED;
            } else {
            PG8_LDB(B0, 0, 0); PG8_SCHED; PG8_LDA(At, 0, 0); PG8_STAGE(PG8_SA(1, 1), a1 + hstepA, voffA);
            PG8_WAIT_L(8); PG8_BAR; PG8_WAIT_L(0); PG8_MMA(0, 0, At, B0); PG8_BAR; PG8_SCHED;
            PG8_LDB(B1, 0, 1); PG8_STAGE(PG8_SB(0, 0), b2, voffB);
            PG8_BAR; PG8_WAIT_L(0); PG8_MMA(0, 1, At, B1); PG8_BAR;
            PG8_LDA(At, 0, 1); PG8_STAGE(PG8_SA(0, 0), a2, voffA);
            PG8_BAR; PG8_WAIT_L(0); PG8_MMA(1, 0, At, B0); PG8_BAR; PG8_SCHED;
            PG8_STAGE(PG8_SB(0, 1), b2 + hstepB, voffB);
            PG8_WAIT_V(6); PG8_BAR; PG8_MMA(1, 1, At, B1); PG8_BAR;
            PG8_LDB(B0, 1, 0); PG8_SCHED; PG8_LDA(At, 1, 0); PG8_STAGE(PG8_SA(0, 1), a2 + hstepA, voffA);
            PG8_WAIT_L(8); PG8_BAR; PG8_WAIT_L(0); PG8_MMA(0, 0, At, B0); PG8_BAR; PG8_SCHED;
            PG8_LDB(B1, 1, 1); PG8_STAGE(PG8_SB(1, 0), b3, voffB);
            PG8_BAR; PG8_WAIT_L(0); PG8_MMA(0, 1, At, B1); PG8_BAR;
            PG8_LDA(At, 1, 1); PG8_STAGE(PG8_SA(1, 0), a3, voffA);
            PG8_BAR; PG8_WAIT_L(0); PG8_MMA(1, 0, At, B0); PG8_BAR; PG8_SCHED;
            PG8_STAGE(PG8_SB(1, 1), b3 + hstepB, voffB);
            PG8_WAIT_V(6); PG8_BAR; PG8_MMA(1, 1, At, B1); PG8_BAR;
            }
        }
        if constexpr (ALIGN_EPI) { if (wr == 0) PG8_BAR; }
        if constexpr (!Epi::AFTER_DRAIN) { E(acc, cur, wr, wc, fr, fq); S.done(cur); }
        if (!has_next) break;
#pragma unroll
        for (int a = 0; a < 2; ++a)
#pragma unroll
            for (int b = 0; b < 2; ++b)
#pragma unroll
                for (int m = 0; m < 4; ++m)
#pragma unroll
                    for (int n = 0; n < 2; ++n) acc[a][b][m][n] = (f32x4){0.f, 0.f, 0.f, 0.f};
        cur = nxt; cA = nA; cB = nB; ++ui;
        if constexpr (ALIGN_EPI) { if (wr == 1) PG8_BAR; }
    }
    PG8_WAIT_V(0);
    if constexpr (!ALIGN_EPI) { if (wr == 0) PG8_BAR; }
    PG8_BAR;
    if constexpr (Epi::AFTER_DRAIN) { E.fused(acc, cur, wr, wc, fr, fq, lds, wid, lane); S.done(cur); }
#undef PG8_SA
#undef PG8_SB
#undef PG8_STAGE
#undef PG8_LDA
#undef PG8_LDB
#undef PG8_MMA
#undef PG8_WAIT_V
#undef PG8_WAIT_L
#undef PG8_BAR
#undef PG8_SCHED
}
}

#ifndef G1_EPI_DRAIN
#define G1_EPI_DRAIN 0
#endif
#ifndef G1_STORE_AUX_MIX
#define G1_STORE_AUX_MIX 2
#endif
#ifndef G1_STORE_AUX
#define G1_STORE_AUX 2
#endif
namespace pg8 {
__device__ __forceinline__ float ubf0(unsigned w) { return (float)(w & 0xffu); }
__device__ __forceinline__ float ubf1(unsigned w) { return (float)((w >> 8) & 0xffu); }
__device__ __forceinline__ float ubf2(unsigned w) { return (float)((w >> 16) & 0xffu); }
__device__ __forceinline__ float ubf3(unsigned w) { return (float)(w >> 24); }
__device__ __forceinline__ float ex2(float x) { return __builtin_amdgcn_exp2f(x); }
__device__ __forceinline__ float sigm_fast(float x) { return __builtin_amdgcn_rcpf(1.0f + ex2(x * -1.4426950408889634f)); }
template <int MODE = 0  > struct EpiProjT {
    static constexpr bool PERM = true, AFTER_DRAIN = false, KHOOK = false;
    bf16_t* PA; bf16_t* KVM; float* SS; float* MKSS; const float* gate_b; int pm0; int pad;
    template <int KIND, int STAT> __device__ __forceinline__ void body(const f32x4 (&acc)[2][2][4][2], const __amdgpu_buffer_rsrc_t rsrc, int row0, int col0, int ldc, float* sb, int sld, int so, const float* bias, int wc, int fq) const {
        f32x4 bv[2][2];
        if (KIND == 3) {
#pragma unroll
            for (int bj = 0; bj < 2; ++bj)
#pragma unroll
                for (int n = 0; n < 2; ++n) bv[bj][n] = *(const f32x4*)(bias + bj * HALF + 4 * n);
        }
#pragma unroll
        for (int ai = 0; ai < 2; ++ai)
#pragma unroll
            for (int m = 0; m < 4; ++m) { const int row = row0 + ai * HALF + m * 16; const unsigned rowoff = ((unsigned)row * (unsigned)ldc + (unsigned)col0) * 2u;
#pragma unroll
                for (int bj = 0; bj < 2; ++bj) { f32x4 v0 = acc[ai][bj][m][0], v1 = acc[ai][bj][m][1];
                    if (KIND == 1) { f32x2 a = gelu_pk((f32x2){v0[0], v0[1]}), b = gelu_pk((f32x2){v0[2], v0[3]}), c = gelu_pk((f32x2){v1[0], v1[1]}), d = gelu_pk((f32x2){v1[2], v1[3]});
                        v0 = (f32x4){a.x, a.y, b.x, b.y}; v1 = (f32x4){c.x, c.y, d.x, d.y}; }
                    else if (KIND == 2) {
#pragma unroll
                        for (int j = 0; j < 4; ++j) { v0[j] = v0[j] * sigm_fast(v0[j]); v1[j] = v1[j] * sigm_fast(v1[j]); } }
                    else if (KIND == 3) { v0 = v0 + bv[bj][0]; v1 = v1 + bv[bj][1];
#pragma unroll
                        for (int j = 0; j < 4; ++j) { v0[j] = sigm_fast(v0[j]); v1[j] = sigm_fast(v1[j]); } }
                    if (STAT) {
                        float s = ((v0[0] + v0[1]) + (v0[2] + v0[3])) + ((v1[0] + v1[1]) + (v1[2] + v1[3]));
                        float q = ((v0[0] * v0[0] + v0[1] * v0[1]) + (v0[2] * v0[2] + v0[3] * v0[3])) + ((v1[0] * v1[0] + v1[1] * v1[1]) + (v1[2] * v1[2] + v1[3] * v1[3]));
                        if (STAT == 2) { s += __shfl_xor(s, 16); s += __shfl_xor(s, 32); }
                        q += __shfl_xor(q, 16); q += __shfl_xor(q, 32);
                        if (fq == 0) { float* sp = sb + (size_t)row * sld + so; const int blk = 4 * bj + wc;
                            if (STAT == 2) { sp[2 * blk] = s; sp[2 * blk + 1] = q; } else sp[blk] = q; }
                    }
                    u32x4 w; w.x = cvt_pk_bf16(v0[0], v0[1]); w.y = cvt_pk_bf16(v0[2], v0[3]); w.z = cvt_pk_bf16(v1[0], v1[1]); w.w = cvt_pk_bf16(v1[2], v1[3]);
                    if (MODE == 2) asm volatile("" :: "v"(w)); else __builtin_amdgcn_raw_buffer_store_b128(w, rsrc, (int)(rowoff + bj * HALF * 2), 0, KIND == 3 ? G1_STORE_AUX : G1_STORE_AUX_MIX); } }
    }
    __device__ __forceinline__ void uz_body(const f32x4 (&acc)[2][2][4][2], const __amdgpu_buffer_rsrc_t rsrc, int row0, int ucol0) const {
#pragma unroll
        for (int ai = 0; ai < 2; ++ai)
#pragma unroll
            for (int m = 0; m < 4; ++m) { const int row = row0 + ai * HALF + m * 16;
                f32x4 u0 = acc[ai][0][m][0], u1 = acc[ai][0][m][1]; const f32x4 z0 = acc[ai][1][m][0], z1 = acc[ai][1][m][1];
                { f32x2 a = gelu_pk((f32x2){u0[0], u0[1]}), b = gelu_pk((f32x2){u0[2], u0[3]}), c = gelu_pk((f32x2){u1[0], u1[1]}), d = gelu_pk((f32x2){u1[2], u1[3]});
                  u0 = (f32x4){a.x, a.y, b.x, b.y}; u1 = (f32x4){c.x, c.y, d.x, d.y}; }
#pragma unroll
                for (int j = 0; j < 4; ++j) { u0[j] *= z0[j] * sigm_fast(z0[j]); u1[j] *= z1[j] * sigm_fast(z1[j]); }
                u32x4 w; w.x = cvt_pk_bf16(u0[0], u0[1]); w.y = cvt_pk_bf16(u0[2], u0[3]); w.z = cvt_pk_bf16(u1[0], u1[1]); w.w = cvt_pk_bf16(u1[2], u1[3]);
                if (MODE == 2) asm volatile("" :: "v"(w)); else __builtin_amdgcn_raw_buffer_store_b128(w, rsrc, (int)((unsigned)row * (unsigned)PA_ROWB + (unsigned)(2 * (C_AU + ucol0))), 0, G1_STORE_AUX_MIX); }
    }
    __device__ __forceinline__ void gate_body(const f32x4 (&acc)[2][2][4][2], const __amdgpu_buffer_rsrc_t rsrc, int row0, int gcol0, const float* bias) const {
        f32x4 bv[2][2];
#pragma unroll
        for (int bj = 0; bj < 2; ++bj)
#pragma unroll
            for (int n = 0; n < 2; ++n) bv[bj][n] = *(const f32x4*)(bias + 8 * bj + 4 * n);
#pragma unroll
        for (int ai = 0; ai < 2; ++ai)
#pragma unroll
            for (int m = 0; m < 4; ++m) { const int row = row0 + ai * HALF + m * 16; u32x4 w;
#pragma unroll
                for (int bj = 0; bj < 2; ++bj)
#pragma unroll
                    for (int n = 0; n < 2; ++n) { const f32x4 v = acc[ai][bj][m][n] + bv[bj][n]; unsigned d = 0u;
#pragma unroll
                        for (int j = 0; j < 4; ++j) d |= (unsigned)(fmaxf(sigm_fast(v[j]) * 255.0f, 1.0f) + 0.5f) << (8 * j);
                        w[2 * bj + n] = d; }
                if (MODE == 2) asm volatile("" :: "v"(w)); else __builtin_amdgcn_raw_buffer_store_b128(w, rsrc, (int)((unsigned)row * (unsigned)PA_ROWB + (unsigned)(PA_GOFF + gcol0)), 0, G1_STORE_AUX); }
    }
    __device__ __forceinline__ void operator()(const f32x4 (&acc)[2][2][4][2], const Unit& u, int wr, int wc, int fr, int fq) const {
        const bool kv = u.pn >= 35; const int pn = kv ? u.pn - 35 : u.pn;
        const int rowt = kv ? (u.pm - 256) * BM : (u.pm - pm0) * BM;
        bf16_t* base = kv ? KVM : PA; const int ldc = kv ? 1024 : PAP;
        const __amdgpu_buffer_rsrc_t rsrc = __builtin_amdgcn_make_buffer_rsrc(base, 0, kv ? (int)((size_t)MMEM * 1024 * 2) : (int)((size_t)HB_ROWS * PA_ROWB), 0x00020000);
        const int row0 = rowt + wr * 64 + fr, col0 = pn * BM + wc * 32 + 8 * fq;
        if (MODE == 1) { body<0, 0>(acc, rsrc, row0, col0, ldc, SS, SS_W, 0, gate_b, wc, fq); return; }
        if (kv) { if (pn < 2) body<0, 1>(acc, rsrc, row0, col0, ldc, MKSS, 16, 8 * pn, gate_b, wc, fq); else body<0, 0>(acc, rsrc, row0, col0, ldc, SS, SS_W, 0, gate_b, wc, fq); }
        else if (pn < 3) uz_body(acc, rsrc, row0, 128 * pn + 32 * wc + 8 * fq);
        else if (pn < 6) body<1, 2>(acc, rsrc, row0, col0, ldc, SS, SS_W, 16 * (pn - 3), gate_b, wc, fq);
        else if (pn < 9) uz_body(acc, rsrc, row0, 128 * (pn - 3) + 32 * wc + 8 * fq);
        else if (pn < 12) body<0, 1>(acc, rsrc, row0, col0, ldc, SS, SS_W, 48 + 8 * (pn - 9), gate_b, wc, fq);
        else if (pn < 15) body<0, 1>(acc, rsrc, row0, col0, ldc, SS, SS_W, 72 + 8 * (pn - 12), gate_b, wc, fq);
        else if (pn < 18) body<0, 0>(acc, rsrc, row0, col0, ldc, SS, SS_W, 0, gate_b, wc, fq);
        else if (pn < 19) body<2, 0>(acc, rsrc, row0, col0, ldc, SS, SS_W, 0, gate_b, wc, fq);
        else if (pn < 21) body<0, 1>(acc, rsrc, row0, col0, ldc, SS, SS_W, 96 + 8 * (pn - 19), gate_b, wc, fq);
        else if (pn < 23) body<2, 0>(acc, rsrc, row0, col0, ldc, SS, SS_W, 0, gate_b, wc, fq);
        else { const int gc = (pn - 23) * BM + 64 * wc + 16 * fq; gate_body(acc, rsrc, row0, gc, gate_b + gc); }
#if G1_EPI_DRAIN
        asm volatile("s_waitcnt vmcnt(0)" ::: "memory");
#endif
    }
};
typedef EpiProjT<0> EpiProj;
template <bool HOOKS = true, bool EPI = true> struct EpiG2catT {
    static constexpr bool PERM = true, AFTER_DRAIN = false, KHOOK = HOOKS; static constexpr int KH1 = 12, KH2 = 16;
    const bf16_t* PA; bf16_t* MRG;
    __device__ __forceinline__ void khook(f32x4 (&acc)[2][2][4][2], const Unit& u, int t, int wr, int wc, int fr, int fq) const {
        typedef unsigned u32x2v __attribute__((ext_vector_type(2)));
        const int ga = t == KH1 ? 0 : 1;
        const int row0 = u.pm * BM + wr * 64 + fr, col0 = u.pn * BM + wc * 32 + 8 * fq;
        const unsigned char* gbase = (const unsigned char*)PA + (size_t)row0 * PA_ROWB + PA_GOFF + ga * DM + col0;
        u32x2v ag[2][4][2], bg[2][4][2];
#pragma unroll
        for (int ai = 0; ai < 2; ++ai)
#pragma unroll
            for (int m = 0; m < 4; ++m) { const unsigned char* gp_ = gbase + (size_t)(ai * HALF + m * 16) * PA_ROWB;
#pragma unroll
                for (int bj = 0; bj < 2; ++bj) { ag[ai][m][bj] = *(const u32x2v*)(gp_ + bj * HALF); bg[ai][m][bj] = *(const u32x2v*)(gp_ + DM + bj * HALF); } }
        __builtin_amdgcn_sched_barrier(0);
#define G2_R(A, Bv, K) (ubf##K(A) * __builtin_amdgcn_rcpf(ubf##K(Bv)))
#pragma unroll
        for (int ai = 0; ai < 2; ++ai)
#pragma unroll
            for (int m = 0; m < 4; ++m)
#pragma unroll
                for (int bj = 0; bj < 2; ++bj) { const u32x2v a = ag[ai][m][bj], b = bg[ai][m][bj]; f32x4 r0, r1;
                    r0[0] = G2_R(a.x, b.x, 0); r0[1] = G2_R(a.x, b.x, 1); r0[2] = G2_R(a.x, b.x, 2); r0[3] = G2_R(a.x, b.x, 3);
                    r1[0] = G2_R(a.y, b.y, 0); r1[1] = G2_R(a.y, b.y, 1); r1[2] = G2_R(a.y, b.y, 2); r1[3] = G2_R(a.y, b.y, 3);
                    acc[ai][bj][m][0] *= r0; acc[ai][bj][m][1] *= r1; }
#undef G2_R
    }
    __device__ __forceinline__ void operator()(const f32x4 (&acc)[2][2][4][2], const Unit& u, int wr, int wc, int fr, int fq) const {
        typedef unsigned u32x2v __attribute__((ext_vector_type(2)));
        if (!EPI) { _Pragma("unroll") for (int ai = 0; ai < 2; ++ai) _Pragma("unroll") for (int bj = 0; bj < 2; ++bj) _Pragma("unroll") for (int m = 0; m < 4; ++m) asm volatile("" :: "v"(acc[ai][bj][m][0]), "v"(acc[ai][bj][m][1])); return; }
        const int row0 = u.pm * BM + wr * 64 + fr, col0 = u.pn * BM + wc * 32 + 8 * fq;
        u32x2v gv[2][4][2];
#pragma unroll
        for (int ai = 0; ai < 2; ++ai)
#pragma unroll
            for (int m = 0; m < 4; ++m) { const unsigned char* gp = (const unsigned char*)PA + (size_t)(row0 + ai * HALF + m * 16) * PA_ROWB + PA_GOFF + 2 * DM + col0;
#pragma unroll
                for (int bj = 0; bj < 2; ++bj) gv[ai][m][bj] = *(const u32x2v*)(gp + bj * HALF); }
        __builtin_amdgcn_sched_barrier(0);
        const float q = 1.0f / 255.0f;
#pragma unroll
        for (int ai = 0; ai < 2; ++ai)
#pragma unroll
            for (int m = 0; m < 4; ++m) { bf16_t* mp = MRG + (size_t)(row0 + ai * HALF + m * 16) * DM + col0;
#pragma unroll
                for (int bj = 0; bj < 2; ++bj) { const u32x2v g = gv[ai][m][bj]; const f32x4 v0 = acc[ai][bj][m][0] * q, v1 = acc[ai][bj][m][1] * q; u32x4 w;
                    w.x = cvt_pk_bf16(v0[0] * ubf0(g.x), v0[1] * ubf1(g.x)); w.y = cvt_pk_bf16(v0[2] * ubf2(g.x), v0[3] * ubf3(g.x));
                    w.z = cvt_pk_bf16(v1[0] * ubf0(g.y), v1[1] * ubf1(g.y)); w.w = cvt_pk_bf16(v1[2] * ubf2(g.y), v1[3] * ubf3(g.y));
                    *(u32x4*)(mp + bj * HALF) = w; } }
    }
};
typedef EpiG2catT<true, true> EpiG2cat;
struct EpiG3 {
    static constexpr bool PERM = false, AFTER_DRAIN = false, KHOOK = false;
    const float* x; float* out;
    __device__ __forceinline__ void operator()(const f32x4 (&acc)[2][2][4][2], const Unit& u, int wr, int wc, int fr, int fq) const {
        const int row0 = u.pm * BM + wr * 64 + fr, col0 = u.pn * BM + wc * 32 + 4 * fq;
        f32x4 xv[2][2][2][2];
#define G3_LOAD(B) do { _Pragma("unroll") for (int mm = 0; mm < 2; ++mm) { const size_t off_ = (size_t)(row0 + ((B) >> 1) * HALF + (2 * ((B) & 1) + mm) * 16) * DM + col0; \
            _Pragma("unroll") for (int bj = 0; bj < 2; ++bj) _Pragma("unroll") for (int n = 0; n < 2; ++n) xv[(B) & 1][mm][bj][n] = __builtin_nontemporal_load((const f32x4*)(x + off_ + bj * HALF + n * 16)); } } while (0)
#define G3_STORE(B) do { _Pragma("unroll") for (int mm = 0; mm < 2; ++mm) { const size_t off_ = (size_t)(row0 + ((B) >> 1) * HALF + (2 * ((B) & 1) + mm) * 16) * DM + col0; \
            _Pragma("unroll") for (int bj = 0; bj < 2; ++bj) _Pragma("unroll") for (int n = 0; n < 2; ++n) \
                __builtin_nontemporal_store(xv[(B) & 1][mm][bj][n] + acc[(B) >> 1][bj][2 * ((B) & 1) + mm][n], (f32x4*)(out + off_ + bj * HALF + n * 16)); } } while (0)
        G3_LOAD(0); G3_LOAD(1); __builtin_amdgcn_sched_barrier(0); G3_STORE(0); G3_STORE(1); __builtin_amdgcn_sched_barrier(0); G3_LOAD(2); G3_LOAD(3); __builtin_amdgcn_sched_barrier(0); G3_STORE(2); G3_STORE(3);
#undef G3_LOAD
#undef G3_STORE
    }
};
struct EpiNull {
    static constexpr bool PERM = true, AFTER_DRAIN = false, KHOOK = false;
    __device__ __forceinline__ void operator()(const f32x4 (&acc)[2][2][4][2], const Unit& u, int wr, int wc, int fr, int fq) const {
#pragma unroll
        for (int ai = 0; ai < 2; ++ai)
#pragma unroll
            for (int bj = 0; bj < 2; ++bj)
#pragma unroll
                for (int m = 0; m < 4; ++m) asm volatile("" :: "v"(acc[ai][bj][m][0]), "v"(acc[ai][bj][m][1]));
    }
};
struct OrderG1 {
    StaticOrder so; int pm0, nkv;
    __device__ void init(int hb, int G, int c) { so.init(HB_ROWS, NIN, G, c); pm0 = hb * (HB_ROWS / BM); nkv = hb == 0 ? (MMEM / BM) * 4 : 0; }
    __device__ bool next(int i, Unit& u) const {
        if (so.next(i, u)) { u.pm += pm0; return true; }
        const long j = (long)i * so.G + so.c - so.nwg; if (j < 0 || j >= nkv) return false;
        u.pm = 256 + (int)(j >> 2); u.pn = 35 + (int)(j & 3); return true;
    }
    __device__ __forceinline__ void a_ready(const Unit&) const {}
    __device__ __forceinline__ void done(const Unit&) const {}
};
}

#define GAS __attribute__((address_space(1)))
#define LAS __attribute__((address_space(3)))
typedef unsigned short bf16;
typedef unsigned v4u __attribute__((ext_vector_type(4)));
typedef float f32x4 __attribute__((ext_vector_type(4)));
typedef short bf16x8 __attribute__((ext_vector_type(8)));
typedef GAS unsigned gu32;
typedef GAS unsigned long long gu64;
#define RLX_AGENT __ATOMIC_RELAXED, __HIP_MEMORY_SCOPE_AGENT
#define LDS_WAIT() asm volatile("s_waitcnt lgkmcnt(0)" ::: "memory")
#define VM_WAIT() asm volatile("s_waitcnt vmcnt(0)" ::: "memory")
__device__ __forceinline__ unsigned long long rt() { return __builtin_amdgcn_s_memrealtime(); }
__device__ __forceinline__ unsigned f2bf(float f) { unsigned u = __builtin_bit_cast(unsigned, f); return (u + 0x7fffu + ((u >> 16) & 1u)) >> 16; }
__device__ __forceinline__ unsigned pk2(float lo, float hi) { return f2bf(lo) | (f2bf(hi) << 16); }

__device__ __forceinline__ int hw_lane() { int l; asm volatile("v_mbcnt_lo_u32_b32 %0, -1, 0\n\tv_mbcnt_hi_u32_b32 %0, -1, %0" : "=v"(l)); return l; }
__device__ __forceinline__ bool hw_thread0(int wave) { return wave == 0 && hw_lane() == 0; }
#define XB_TMO      128
#define XB_XCNT(j)  (256  + 64 * (j))
#define XB_XSUB(j)  (1280 + 64 * (j))
#define XB_XGEN(j)  (2304 + 64 * (j))
#define XB_TOP      3328
#define XB_TOPGEN   3392
#define XCD_BAR_WORDS 3456
#define XB_SPIN_CAP (1u << 18)

__device__ __forceinline__ unsigned xb_ld(unsigned* p)              { return __hip_atomic_load(p, __ATOMIC_RELAXED, __HIP_MEMORY_SCOPE_AGENT); }
__device__ __forceinline__ unsigned xb_add(unsigned* p, unsigned v) { return __hip_atomic_fetch_add(p, v, __ATOMIC_RELAXED, __HIP_MEMORY_SCOPE_AGENT); }
__device__ __forceinline__ unsigned xb_xcc_id() { return (unsigned)__builtin_amdgcn_s_getreg((3 << 11) | 20) & 0xFu; }
#define XB_SPIN(cond, bar) do { unsigned _sp = 0; while (cond) { __builtin_amdgcn_s_sleep(1); \
    if ((++_sp & 255u) == 0u) { if (xb_ld(&(bar)[XB_TMO])) break; if (_sp > XB_SPIN_CAP) { atomicAdd(&(bar)[XB_TMO], 1u); break; } } } } while (0)

struct XcdBarrier {
    unsigned* bar; unsigned x; int wave;
    volatile LAS unsigned* st;
};

__device__ __forceinline__ XcdBarrier xcd_barrier_post(unsigned* bar, volatile LAS unsigned* st, int wave) {
    XcdBarrier b; b.bar = bar; b.x = xb_xcc_id(); b.st = st; b.wave = wave;
    if (hw_thread0(wave)) (void)xb_add(&bar[XB_XCNT(b.x)], 1u);
    return b;
}
__device__ __forceinline__ void xcd_barrier_complete(unsigned* bar, unsigned x, unsigned& nloc, unsigned& nx) {
    const unsigned G = gridDim.x * gridDim.y * gridDim.z;
    unsigned sum, cnt, mine, sp = 0u;
    for (;;) {
        sum = 0u; cnt = 0u; mine = 0u;
#pragma unroll
        for (unsigned j = 0; j < 16; ++j) { const unsigned c = xb_ld(&bar[XB_XCNT(j)]); sum += c; cnt += (c > 0u) ? 1u : 0u; mine = (j == x) ? c : mine; }
        if (sum == G) break;
        __builtin_amdgcn_s_sleep(1);
        if ((++sp & 255u) == 0u) { if (xb_ld(&bar[XB_TMO])) break; if (sp > XB_SPIN_CAP) { atomicAdd(&bar[XB_TMO], 1u); break; } }
    }
    nloc = mine > 0u ? mine : 1u; nx = cnt > 0u ? cnt : 1u;
}

__device__ __forceinline__ void xcd_barrier(const XcdBarrier& b) {
    asm volatile("s_waitcnt vmcnt(0)" ::: "memory");
    __syncthreads();
    if (hw_thread0(b.wave)) {
        unsigned* bar = b.bar;
        __builtin_amdgcn_s_waitcnt(0);
        unsigned nloc = b.st[0], nx = b.st[1];
        if (nloc == 0u) { xcd_barrier_complete(bar, b.x, nloc, nx); b.st[0] = nloc; b.st[1] = nx; }
        const unsigned old = xb_add(&bar[XB_XSUB(b.x)], 1u);
        const unsigned gen = old / nloc;
        if (old + 1u == (gen + 1u) * nloc) {
            __builtin_amdgcn_fence(__ATOMIC_RELEASE, "agent");
            asm volatile("s_waitcnt vmcnt(0)" ::: "memory");
            const unsigned og = xb_add(&bar[XB_TOP], 1u);
            const unsigned tg = og / nx;
            if (og + 1u == (tg + 1u) * nx) xb_add(&bar[XB_TOPGEN], 1u);
            else XB_SPIN(xb_ld(&bar[XB_TOPGEN]) == tg, bar);
            __builtin_amdgcn_fence(__ATOMIC_ACQUIRE, "agent");
            xb_add(&bar[XB_XGEN(b.x)], 1u);
            asm volatile("s_waitcnt vmcnt(0)" ::: "memory");
        } else {
            XB_SPIN(xb_ld(&bar[XB_XGEN(b.x)]) == gen, bar);
            __builtin_amdgcn_fence(__ATOMIC_ACQUIRE, "agent");
            asm volatile("s_waitcnt vmcnt(0)" ::: "memory");
        }
    }
    __syncthreads();
}

__device__ __forceinline__ float wave_sum(float v) {
#pragma unroll
    for (int o = 1; o < 64; o <<= 1) v += __shfl_xor(v, o);
    return v;
}

constexpr int RING_OFF = 0, RING_BYTES = 131072;
constexpr int LDSCTL_OFF = RING_BYTES, MISC_OFF = LDSCTL_OFF + 320;
constexpr int LDS_BYTES = 147456;
constexpr int NWAVES = 8, NTHR = NWAVES * 64;
constexpr int WSCR_OFF = 132096;

__device__ __forceinline__ float bf2f(bf16 h) { return __builtin_bit_cast(float, (unsigned)h << 16); }
__device__ __forceinline__ float sigm_f(float x) { return 1.f / (1.f + __expf(-x)); }
__device__ __forceinline__ int t5_bucket(int d) {
    if (d < 16) return d;
    int b = 16;
    b += d >= 22; b += d >= 30; b += d >= 40; b += d >= 54; b += d >= 73; b += d >= 99; b += d >= 134; b += d >= 182; b += d >= 246; b += d >= 332; b += d >= 450; b += d >= 609; b += d >= 825; b += d >= 1117; b += d >= 1513;
    return b;
}

struct Ctx {
    const float *x, *mem, *norm_w, *w_in, *gate_b, *lnw, *lnb, *sp_w, *sp_b, *bqw, *bkw, *rel_bias, *mem_norm_w, *m_w_kv, *mqw, *mkw, *proj_a, *proj_b, *proj_m, *w_out;
    float* out;
    bf16 *WIN, *PCAT, *WOUT, *WSP, *XN, *PA, *KVM, *OG, *YC, *MRG; float *BIAS, *BIASX, *SS, *MKSS, *LSE, *LNST;
    LAS unsigned char* lds; int tid, lane, wave, G, gtid, T, gwave, NW, xgwave;
};

__device__ __forceinline__ void p0_transpose_item(const float* W, int N, bf16* WT, int ldt, int row_off, int koff, LAS float* scr, int item, int lane, bool gperm = false) {
    const int nblk = N / 32, kb = item / nblk, nb = item % nblk, k0 = 64 * kb, n0 = 32 * nb;
#pragma unroll 8
    for (int i = 0; i < 32; ++i) { const int kk = 2 * i + (lane >> 5); scr[kk * 33 + (lane & 31)] = W[(size_t)(k0 + kk) * N + n0 + (lane & 31)]; }
    LDS_WAIT(); asm volatile("" ::: "memory");
    const int c = lane & 7;
#pragma unroll
    for (int j = 0; j < 4; ++j) { const int n = (lane >> 3) + 8 * j; const LAS float* s = scr + (8 * c) * 33 + n;
        v4u o; o.x = pk2(s[0 * 33], s[1 * 33]); o.y = pk2(s[2 * 33], s[3 * 33]); o.z = pk2(s[4 * 33], s[5 * 33]); o.w = pk2(s[6 * 33], s[7 * 33]);
        int nn = n0 + n;
        if (gperm) {
            if (nn >= C_G) nn = (nn & ~255) + 128 * ((nn >> 3) & 1) + 32 * ((nn >> 6) & 3) + 8 * ((nn >> 4) & 3) + (nn & 7);
            else if (nn < C_AV) { const int T = nn >> 7; nn = 256 * (T < 3 ? T : T + 3) + (nn & 127); }
            else if (nn >= C_AZ && nn < C_BQ) { const int c = nn - C_AZ, T = c >> 7; nn = 256 * (T < 3 ? T : T + 3) + 128 + (c & 127); }
        }
        *(GAS v4u*)(WT + (size_t)(row_off + nn) * ldt + koff + k0 + 8 * c) = o; }
    LDS_WAIT(); asm volatile("" ::: "memory");
}
template <int NR> __device__ __forceinline__ void rms_rows_to_bf16(const float* src, const float* w, bf16* dst, size_t m0, size_t stride, int lane) {
    f32x4 v[NR][4]; float s[NR];
#pragma unroll
    for (int r = 0; r < NR; ++r) { const GAS f32x4* xr = (const GAS f32x4*)(src + (m0 + r * stride) * DM) + lane;
#pragma unroll
        for (int j = 0; j < 4; ++j) v[r][j] = __builtin_nontemporal_load(xr + 64 * j); }
    f32x4 ww[4];
#pragma unroll
    for (int j = 0; j < 4; ++j) ww[j] = ((const GAS f32x4*)w + lane)[64 * j];
#pragma unroll
    for (int r = 0; r < NR; ++r) { float a = 0.f;
#pragma unroll
        for (int j = 0; j < 4; ++j) a += (v[r][j].x * v[r][j].x + v[r][j].y * v[r][j].y) + (v[r][j].z * v[r][j].z + v[r][j].w * v[r][j].w);
        s[r] = rsqrtf(wave_sum(a) * (1.f / DM) + EPS); }
#pragma unroll
    for (int r = 0; r < NR; ++r) { GAS unsigned long long* o8 = (GAS unsigned long long*)(dst + (m0 + r * stride) * DM) + lane;
#pragma unroll
        for (int j = 0; j < 4; ++j) o8[64 * j] = (unsigned long long)pk2(v[r][j].x * s[r] * ww[j].x, v[r][j].y * s[r] * ww[j].y) | ((unsigned long long)pk2(v[r][j].z * s[r] * ww[j].z, v[r][j].w * s[r] * ww[j].w) << 32); }
}
__device__ __forceinline__ void p0_prologue(Ctx& F) {
    LAS float* scr = (LAS float*)(F.lds + RING_OFF + F.wave * 16384);
    constexpr int I_IN = 16 * (NIN / 32), I_KV = 16 * 32, I_PA = 12 * 32, I_PB = 4 * 32, I_PM = 8 * 32, I_WO = 16 * 32;
    constexpr int NITEMS = I_IN + I_KV + I_PA + I_PB + I_PM + I_WO;
    for (int it = F.gwave; it < NITEMS; it += F.NW) {
        int r = it;
        if (r < I_IN) { p0_transpose_item(F.w_in, NIN, F.WIN, DM, 0, 0, scr, r, F.lane, true); continue; } r -= I_IN;
        if (r < I_KV) { p0_transpose_item(F.m_w_kv, 1024, F.WIN, DM, NIN, 0, scr, r, F.lane); continue; } r -= I_KV;
        if (r < I_PA) { p0_transpose_item(F.proj_a, DM, F.PCAT, KC, 0, 0, scr, r, F.lane); continue; } r -= I_PA;
        if (r < I_PB) { p0_transpose_item(F.proj_b, DM, F.PCAT, KC, 0, 768, scr, r, F.lane); continue; } r -= I_PB;
        if (r < I_PM) { p0_transpose_item(F.proj_m, DM, F.PCAT, KC, 0, 1024, scr, r, F.lane); continue; } r -= I_PM;
        p0_transpose_item(F.w_out, DM, F.WOUT, DM, 0, 0, scr, r, F.lane);
    }
    for (int i = F.gtid; i < 4 * 128 * 128; i += F.T) { const int t = (i >> 7) & 127, s = i & 127; F.WSP[i] = (bf16)(s <= t ? f2bf(F.sp_w[i]) : 0u); }
    for (int i = F.gtid; i < 3 * 4 * 132; i += F.T) { const int g = i / (4 * 132), h = (i / 132) % 4, j = i % 132; const int dil = g == 0 ? 1 : (g == 1 ? 4 : 16);
        F.BIAS[i] = j <= 128 ? F.rel_bias[t5_bucket(j * dil) * 12 + 4 * g + h] : 0.f; }
    for (int i = F.gtid; i < 3 * 4 * 192; i += F.T) { const int g = i / (4 * 192), h = (i / 192) % 4, step = i % 192 - 31; const int dil = g == 0 ? 1 : (g == 1 ? 4 : 16);
        F.BIASX[i] = (step >= 0 && step <= 128) ? F.rel_bias[t5_bucket(step * dil) * 12 + 4 * g + h] * 1.4426950408889634f : -1e30f; }
    if ((MTOT % (4 * F.NW)) == 0 && (MMEM % (4 * F.NW)) == 0) {
        for (size_t m = F.gwave; m < (size_t)MTOT; m += 4 * (size_t)F.NW) rms_rows_to_bf16<4>(F.x, F.norm_w, F.XN, m, F.NW, F.lane);
        for (size_t m = F.gwave; m < (size_t)MMEM; m += 4 * (size_t)F.NW) rms_rows_to_bf16<4>(F.mem, F.mem_norm_w, F.XN + (size_t)MTOT * DM, m, F.NW, F.lane);
    } else {
        for (size_t m = F.gwave; m < (size_t)MTOT; m += F.NW) rms_rows_to_bf16<1>(F.x, F.norm_w, F.XN, m, 0, F.lane);
        for (size_t m = F.gwave; m < (size_t)MMEM; m += F.NW) rms_rows_to_bf16<1>(F.mem, F.mem_norm_w, F.XN + (size_t)MTOT * DM, m, 0, F.lane);
    }
}


typedef float f32x16 __attribute__((ext_vector_type(16)));
typedef short s16x4 __attribute__((ext_vector_type(4)));
__device__ __forceinline__ int crow(int r, int hi) { return (r & 3) + 8 * (r >> 2) + 4 * hi; }
__device__ __forceinline__ unsigned cvtpk(float lo, float hi) { return pg8::cvt_pk_bf16(lo, hi); }
__device__ __forceinline__ s16x4 vtr(const LAS unsigned char* p) { typedef short v4i16_t __attribute__((ext_vector_type(4))); return __builtin_bit_cast(s16x4, __builtin_amdgcn_ds_read_tr16_b64_v4i16((LAS v4i16_t*)p)); }
__device__ __forceinline__ float bflo(unsigned w) { return __uint_as_float(w << 16); }
__device__ __forceinline__ float bfhi(unsigned w) { return __uint_as_float(w & 0xffff0000u); }
constexpr float LOG2E = 1.4426950408889634f, LN2 = 0.6931471805599453f;
constexpr int NBX = 192;


__device__ __forceinline__ void dma16(const void* gsrc, LAS unsigned char* ldst) { __builtin_amdgcn_global_load_lds((const unsigned*)gsrc, (LAS unsigned*)ldst, 16, 0, 0); }
#define VM_WAIT0() asm volatile("s_waitcnt vmcnt(0)" ::: "memory")
__device__ __forceinline__ void st_mixA_mfma(Ctx& F) {
    const int lane = hw_lane(), r32 = lane & 31, hi = lane >> 5, tid = F.wave * 64 + lane;
    LAS unsigned char* wl = F.lds + RING_OFF + F.wave * 16384;
    typedef float f32x2v __attribute__((ext_vector_type(2))); typedef unsigned u32x2v __attribute__((ext_vector_type(2)));
    LAS f32x2v* tab = (LAS f32x2v*)(F.lds + WSCR_OFF + 8192);
    const int g = F.wave >> 1, ch = lane & 3;
    bf16x8 wf[14];
    const bf16* wrow0 = F.WSP + (size_t)(g * 128 + r32) * 128 + 8 * hi;
    { int n = 0;
#pragma unroll
      for (int tb = 2; tb < 4; ++tb)
#pragma unroll
          for (int ks = 0; ks < 2 * (tb + 1); ++ks) wf[n++] = *(const bf16x8*)(wrow0 + (size_t)tb * 32 * 128 + 16 * ks); }
    for (int unit = blockIdx.x; unit < HB_ROWS / 128; unit += F.G) {
        const int rowbase = unit * 128;
        v4u raw[8];
        { const int c0 = g * 192 + (F.wave & 1) * 96;
#pragma unroll
          for (int i = 0; i < 8; ++i) raw[i] = *(const v4u*)(F.PA + (size_t)(rowbase + (lane >> 2) + 16 * i) * PAP + C_AV + c0 + 8 * ch); }
        { const int row = tid >> 2, part = tid & 3; const float* sp = F.SS + (size_t)(rowbase + row) * SS_W + 12 * part; float s = 0.f, q = 0.f;
#pragma unroll
          for (int k = 0; k < 6; ++k) { s += sp[2 * k]; q += sp[2 * k + 1]; }
          s += __shfl_xor(s, 1); s += __shfl_xor(s, 2); q += __shfl_xor(q, 1); q += __shfl_xor(q, 2);
          const float mu = s * (1.f / 768.f), var = q * (1.f / 768.f) - mu * mu;
          if (part == 0) tab[row] = (f32x2v){mu, rsqrtf(fmaxf(var, 0.f) + EPS)}; }
        __syncthreads();
#pragma unroll 1
        for (int cbi = 0; cbi < 3; ++cbi) {
            const int c0 = g * 192 + ((F.wave & 1) * 3 + cbi) * 32;
            const f32x4 w0 = *(const f32x4*)(F.lnw + c0 + 8 * ch), w1 = *(const f32x4*)(F.lnw + c0 + 8 * ch + 4), b0 = *(const f32x4*)(F.lnb + c0 + 8 * ch), b1 = *(const f32x4*)(F.lnb + c0 + 8 * ch + 4);
#pragma unroll
            for (int i = 0; i < 8; ++i) { const int s = (lane >> 2) + 16 * i; const f32x2v st = tab[s]; const v4u rw = raw[i]; v4u o;
                o.x = cvtpk((bflo(rw.x) - st.x) * st.y * w0.x + b0.x, (bfhi(rw.x) - st.x) * st.y * w0.y + b0.y); o.y = cvtpk((bflo(rw.y) - st.x) * st.y * w0.z + b0.z, (bfhi(rw.y) - st.x) * st.y * w0.w + b0.w);
                o.z = cvtpk((bflo(rw.z) - st.x) * st.y * w1.x + b1.x, (bfhi(rw.z) - st.x) * st.y * w1.y + b1.y); o.w = cvtpk((bflo(rw.w) - st.x) * st.y * w1.z + b1.z, (bfhi(rw.w) - st.x) * st.y * w1.w + b1.w);
                *(LAS v4u*)(wl + (s >> 3) * 512 + (s & 7) * 64 + ch * 16) = o; }
            if (cbi < 2) {
#pragma unroll
                for (int i = 0; i < 8; ++i) raw[i] = *(const v4u*)(F.PA + (size_t)(rowbase + (lane >> 2) + 16 * i) * PAP + C_AV + c0 + 32 + 8 * ch); }
            LAS unsigned char* uzb = wl + 8192;
#pragma unroll
            for (int p = 0; p < 8; ++p) { const int row_ = 16 * p + (lane >> 2);
                dma16(F.PA + (size_t)(rowbase + row_) * PAP + C_AU + c0 + 8 * ((lane & 3) ^ ((row_ >> 2) & 3)), uzb + p * 1024); }
            const LAS unsigned char* vb = wl + hi * 512 + ((lane & 15) >> 2) * 64 + ((lane >> 4) & 1) * 32 + (lane & 3) * 8;
            const bf16* wr2 = wrow0; asm volatile("" : "+v"(wr2));
            bf16x8 wq[6];
            { int n2 = 0;
#pragma unroll
              for (int tb = 0; tb < 2; ++tb)
#pragma unroll
                  for (int ks = 0; ks < 2 * (tb + 1); ++ks) wq[n2++] = *(const bf16x8*)(wr2 + (size_t)tb * 32 * 128 + 16 * ks); }
            int n = 0, nq = 0;
#pragma unroll
            for (int tb = 0; tb < 4; ++tb) { f32x16 acc = {};
#pragma unroll
                for (int ks = 0; ks < 2 * (tb + 1); ++ks) { const s16x4 a = vtr(vb + ks * 1024), c = vtr(vb + ks * 1024 + 256); const bf16x8 af = {a[0], a[1], a[2], a[3], c[0], c[1], c[2], c[3]};
                    acc = __builtin_amdgcn_mfma_f32_32x32x16_bf16(af, tb < 2 ? wq[nq++] : wf[n++], acc, 0, 0, 0); }
                const int t = 32 * tb + r32; const float sb = F.sp_b[g * 128 + t];
                if (tb == 0) VM_WAIT0();
                LAS unsigned char* urow = uzb + t * 64 + 8 * hi; const int fsw = (r32 >> 2) & 3;
#pragma unroll
                for (int i = 0; i < 4; ++i) { LAS u32x2v* up = (LAS u32x2v*)(urow + ((i ^ fsw) * 16)); const u32x2v u = *up; u32x2v w;
                    w.x = cvtpk(bflo(u.x) * (acc[4 * i] + sb), bfhi(u.x) * (acc[4 * i + 1] + sb)); w.y = cvtpk(bflo(u.y) * (acc[4 * i + 2] + sb), bfhi(u.y) * (acc[4 * i + 3] + sb));
                    *up = w; }
#pragma unroll
                for (int jr = 0; jr < 2; ++jr) { const int row_ = 32 * tb + 16 * jr + (lane >> 2); const v4u yv = *(const LAS v4u*)(uzb + row_ * 64 + (lane & 3) * 16);
                    *(v4u*)(F.YC + (size_t)(rowbase + row_) * KC + c0 + 8 * ((lane & 3) ^ ((row_ >> 2) & 3))) = yv; } }
        }
        __syncthreads();
    }
}

__device__ __forceinline__ void st_mergeB_vec(Ctx& F) {
    constexpr int NI = 4;
    const int total = HB_ROWS * 32;
    for (int g0 = F.gtid; g0 < total; g0 += NI * F.T) {
        v4u a[NI], b[NI], c[NI], z[NI]; float l0[NI], l1[NI], l2[NI];
#pragma unroll
        for (int i = 0; i < NI; ++i) { const int gid = g0 + i * F.T < total ? g0 + i * F.T : g0; const int r = gid >> 5, c8 = (gid & 31) * 8, h = c8 >> 6;
            l0[i] = F.LSE[((size_t)0 * HB_ROWS + r) * 4 + h]; l1[i] = F.LSE[((size_t)1 * HB_ROWS + r) * 4 + h]; l2[i] = F.LSE[((size_t)2 * HB_ROWS + r) * 4 + h];
            a[i] = *(const v4u*)(F.OG + ((size_t)0 * HB_ROWS + r) * 256 + c8); b[i] = *(const v4u*)(F.OG + ((size_t)1 * HB_ROWS + r) * 256 + c8); c[i] = *(const v4u*)(F.OG + ((size_t)2 * HB_ROWS + r) * 256 + c8);
            z[i] = *(const v4u*)(F.PA + (size_t)r * PAP + C_BZ + c8); }
        __builtin_amdgcn_sched_barrier(0);
#pragma unroll
        for (int i = 0; i < NI; ++i) { if (g0 + i * F.T >= total) break; const int gid = g0 + i * F.T; const int r = gid >> 5, c8 = (gid & 31) * 8;
            const float mx = fmaxf(l0[i], fmaxf(l1[i], l2[i])); float e0 = __expf(l0[i] - mx), e1 = __expf(l1[i] - mx), e2 = __expf(l2[i] - mx); const float inv = 1.f / (e0 + e1 + e2); e0 *= inv; e1 *= inv; e2 *= inv;
            v4u o;
#define MB_1(X) X = pk2((e0 * bflo(a[i].X) + e1 * bflo(b[i].X) + e2 * bflo(c[i].X)) * bflo(z[i].X), (e0 * bfhi(a[i].X) + e1 * bfhi(b[i].X) + e2 * bfhi(c[i].X)) * bfhi(z[i].X))
            o.MB_1(x); o.MB_1(y); o.MB_1(z); o.MB_1(w);
#undef MB_1
            *(v4u*)(F.YC + (size_t)r * KC + 768 + c8) = o; }
    }
}


__device__ __forceinline__ void st_attnM_v3(Ctx& F, int hb) {
    const int lane = hw_lane(), r32 = lane & 31, hi = lane >> 5;
    LAS unsigned char* kimg = F.lds + RING_OFF; LAS unsigned char* vimg = F.lds + RING_OFF + 65536;
    LAS float* kstab = (LAS float*)(F.lds + WSCR_OFF + 8192);
    typedef unsigned u32x2v __attribute__((ext_vector_type(2)));
    const int vcu = F.xgwave >> 3;
    __syncthreads();
    for (int task = vcu; task < 256; task += F.G) {
        const int bh = task >> 2, b = bh >> 2, h = bh & 3; const size_t kbase = (size_t)(hb * 16 + b) * MEML;
#pragma unroll
        for (int j = 0; j < 8; ++j) { const int p = F.wave * 8 + j, row = 4 * p + (lane >> 4);
            dma16(F.KVM + (kbase + row) * 1024 + h * 128 + 8 * ((lane & 15) ^ (row & 15)), kimg + p * 1024);
            dma16(F.KVM + (kbase + 8 * (p >> 1) + ((lane & 31) >> 2)) * 1024 + 512 + h * 128 + (2 * (p & 1) + (lane >> 5)) * 32 + (lane & 3) * 8, vimg + p * 1024); }
        { const int key = F.wave * 32 + r32; const float* sp = F.MKSS + (kbase + key) * 16 + 4 * h;
          const float ksv = rsqrtf(((sp[0] + sp[1]) + (sp[2] + sp[3])) * (1.f / 128.f) + EPS); if (lane < 32) kstab[key] = ksv; }
        VM_WAIT0(); __syncthreads();
#pragma unroll 1
        for (int qi = 0; qi < 2; ++qi) {
            const int qb = (task & 3) * 16 + F.wave * 2 + qi;
            const size_t qrow = (size_t)(b * SEQ + qb * 32 + r32);
            const float qs = rsqrtf(((F.SS[qrow * SS_W + 96 + 4 * h] + F.SS[qrow * SS_W + 96 + 4 * h + 1]) + (F.SS[qrow * SS_W + 96 + 4 * h + 2] + F.SS[qrow * SS_W + 96 + 4 * h + 3])) * (1.f / 128.f) + EPS) * (0.08838834764831845f * LOG2E);
            bf16x8 qf[8];
#pragma unroll
            for (int d0 = 0; d0 < 8; ++d0) { const int dd = 16 * d0 + 8 * hi;
                const v4u raw = *(const v4u*)(F.PA + qrow * PAP + C_MQ + h * 128 + dd);
                const f32x4 wa = *(const f32x4*)(F.mqw + dd), wb = *(const f32x4*)(F.mqw + dd + 4), ka = *(const f32x4*)(F.mkw + dd), kb = *(const f32x4*)(F.mkw + dd + 4);
                v4u o;
                o.x = cvtpk(bflo(raw.x) * qs * wa.x * ka.x, bfhi(raw.x) * qs * wa.y * ka.y); o.y = cvtpk(bflo(raw.y) * qs * wa.z * ka.z, bfhi(raw.y) * qs * wa.w * ka.w);
                o.z = cvtpk(bflo(raw.z) * qs * wb.x * kb.x, bfhi(raw.z) * qs * wb.y * kb.y); o.w = cvtpk(bflo(raw.w) * qs * wb.z * kb.z, bfhi(raw.w) * qs * wb.w * kb.w);
                qf[d0] = __builtin_bit_cast(bf16x8, o); }
            u32x2v zz[4][4];
#pragma unroll
            for (int db = 0; db < 4; ++db)
#pragma unroll
                for (int i = 0; i < 4; ++i) zz[db][i] = *(const u32x2v*)(F.PA + qrow * PAP + C_MZ + h * 128 + 4 * hi + db * 32 + 8 * i);
            float mrun = -1e30f, lrun = 0.f; f32x16 o0 = {}, o1 = {}, o2 = {}, o3 = {};
            const LAS unsigned char* kb0 = kimg + r32 * 256; const int ksw = r32 & 15;
            const LAS unsigned char* vb0 = vimg + (4 * hi + ((lane & 15) >> 2)) * 64 + ((lane >> 4) & 1) * 32 + (lane & 3) * 8;
#pragma unroll 2
            for (int t = 0; t < MEML / 32; ++t) {
                f32x16 st = {};
#pragma unroll
                for (int d0 = 0; d0 < 8; ++d0) { const bf16x8 kf = *(const LAS bf16x8*)(kb0 + t * 8192 + (((2 * d0 + hi) ^ ksw) * 16)); st = __builtin_amdgcn_mfma_f32_32x32x16_bf16(kf, qf[d0], st, 0, 0, 0); }
                float tmax = -1e30f;
#pragma unroll
                for (int i = 0; i < 4; ++i) { const f32x4 kk = *(const LAS f32x4*)(kstab + 32 * t + 8 * i + 4 * hi);
#pragma unroll
                    for (int j = 0; j < 4; ++j) { const float s = st[4 * i + j] * kk[j]; st[4 * i + j] = s; tmax = fmaxf(tmax, s); } }
                tmax = fmaxf(tmax, __shfl_xor(tmax, 32));
                const float mnew = fmaxf(mrun, tmax), alpha = __builtin_amdgcn_exp2f(mrun - mnew); mrun = mnew;
                float psum = 0.f;
#pragma unroll
                for (int r = 0; r < 16; ++r) { st[r] = __builtin_amdgcn_exp2f(st[r] - mnew); psum += st[r]; }
                lrun = lrun * alpha + psum;
#pragma unroll
                for (int r = 0; r < 16; ++r) { o0[r] *= alpha; o1[r] *= alpha; o2[r] *= alpha; o3[r] *= alpha; }
                v4u p0, p1;
                p0.x = cvtpk(st[0], st[1]); p0.y = cvtpk(st[2], st[3]); p0.z = cvtpk(st[4], st[5]); p0.w = cvtpk(st[6], st[7]);
                p1.x = cvtpk(st[8], st[9]); p1.y = cvtpk(st[10], st[11]); p1.z = cvtpk(st[12], st[13]); p1.w = cvtpk(st[14], st[15]);
                const LAS unsigned char* vb = vb0 + t * 8192;
#define AM_PV(OX, DB) do { _Pragma("unroll") for (int s = 0; s < 2; ++s) { const bf16x8 pf = __builtin_bit_cast(bf16x8, s == 0 ? p0 : p1); \
                    const s16x4 a = vtr(vb + (2 * s) * 2048 + (DB) * 512), c = vtr(vb + (2 * s + 1) * 2048 + (DB) * 512); const bf16x8 vf = {a[0], a[1], a[2], a[3], c[0], c[1], c[2], c[3]}; \
                    OX = __builtin_amdgcn_mfma_f32_32x32x16_bf16(vf, pf, OX, 0, 0, 0); } } while (0)
                AM_PV(o0, 0); AM_PV(o1, 1); AM_PV(o2, 2); AM_PV(o3, 3);
#undef AM_PV
            }
            const float ltot = lrun + __shfl_xor(lrun, 32), inv = 1.f / ltot;
            bf16* yrow = F.YC + qrow * KC + 1024 + h * 128 + 4 * hi;
#define AM_ST(OX, DB) do { _Pragma("unroll") for (int i = 0; i < 4; ++i) { const u32x2v z = zz[DB][i]; u32x2v w; \
                w.x = cvtpk(OX[4 * i] * inv * bflo(z.x), OX[4 * i + 1] * inv * bfhi(z.x)); w.y = cvtpk(OX[4 * i + 2] * inv * bflo(z.y), OX[4 * i + 3] * inv * bfhi(z.y)); \
                *(u32x2v*)(yrow + (DB) * 32 + 8 * i) = w; } } while (0)
            AM_ST(o0, 0); AM_ST(o1, 1); AM_ST(o2, 2); AM_ST(o3, 3);
#undef AM_ST
        }
        __syncthreads();
    }
}

__device__ __forceinline__ void st_attnB_v3(Ctx& F) {
    const int lane = hw_lane(), r32 = lane & 31, hi = lane >> 5, tid = F.wave * 64 + lane;
    LAS unsigned char* kimg = F.lds + RING_OFF; LAS unsigned char* vimg = F.lds + RING_OFF + 49152;
    LAS float* kstab = (LAS float*)(F.lds + RING_OFF + 98304);
    LAS float* btab = (LAS float*)(F.lds + RING_OFF + 98304 + 2048);
    typedef unsigned u32x2v __attribute__((ext_vector_type(2)));
    const int vcu = F.xgwave >> 3;
    __syncthreads();
    for (int unit = vcu; unit < 3 * 16 * 4 * 8; unit += F.G) {
        const int k = unit & 7, h = (unit >> 3) & 3, b = (unit >> 5) & 15, g = unit >> 9, hh = 4 * g + h;
        const int dil = g == 0 ? 1 : (g == 1 ? 4 : 16);
        const int res0 = g == 0 ? 0 : (g == 1 ? (k >> 1) : 2 * k), j0 = g == 0 ? 8 * k : (g == 1 ? 8 * (k & 1) : 0);
#pragma unroll
        for (int i = 0; i < 12; ++i) { const int q = F.wave * 12 + i, s = q >> 3, pc = q & 7, p = pc & 3;
            int res, jt; bool valid;
            if (g < 2) { res = res0; jt = j0 - 4 + s; valid = jt >= 0; } else { res = res0 + (s >> 2); jt = s & 3; valid = s < 8; }
            if (valid) {
                if (pc < 4) { const int row = 8 * p + (lane >> 3); const size_t trow = (size_t)(b * SEQ + res + (32 * jt + row) * dil);
                    dma16(F.PA + trow * PAP + C_BK + hh * 64 + 8 * ((lane & 7) ^ ((row >> 1) & 7)), kimg + s * 4096 + p * 1024); }
                else { const int key = 8 * p + ((lane & 31) >> 2); const size_t trow = (size_t)(b * SEQ + res + (32 * jt + key) * dil);
                    dma16(F.PA + trow * PAP + C_BV + hh * 64 + (lane >> 5) * 32 + (lane & 3) * 8, vimg + s * 4096 + p * 1024); } } }
        if (tid < 384) { const int s = tid >> 5, kk = tid & 31; int res, jt; bool valid;
            if (g < 2) { res = res0; jt = j0 - 4 + s; valid = jt >= 0; } else { res = res0 + (s >> 2); jt = s & 3; valid = s < 8; }
            if (valid) { const size_t trow = (size_t)(b * SEQ + res + (32 * jt + kk) * dil);
                kstab[tid] = rsqrtf((F.SS[trow * SS_W + 72 + 2 * hh] + F.SS[trow * SS_W + 72 + 2 * hh + 1]) * (1.f / 64.f) + EPS); } }
        if (tid < NBX) btab[tid] = F.BIASX[(g * 4 + h) * NBX + tid];
        const int wres = g < 2 ? res0 : res0 + (F.wave >> 2), j = g < 2 ? j0 + F.wave : (F.wave & 3);
        const int sbase = g < 2 ? 4 - j0 : (F.wave >> 2) * 4;
        const size_t qrow = (size_t)(b * SEQ + wres + (32 * j + r32) * dil);
        const float qs = rsqrtf((F.SS[qrow * SS_W + 48 + 2 * hh] + F.SS[qrow * SS_W + 48 + 2 * hh + 1]) * (1.f / 64.f) + EPS) * (0.125f * LOG2E);
        bf16x8 qf[4];
#pragma unroll
        for (int d0 = 0; d0 < 4; ++d0) { const int dd = 16 * d0 + 8 * hi;
            const v4u raw = *(const v4u*)(F.PA + qrow * PAP + C_BQ + hh * 64 + dd);
            const f32x4 wa = *(const f32x4*)(F.bqw + dd), wb = *(const f32x4*)(F.bqw + dd + 4), ka = *(const f32x4*)(F.bkw + dd), kb = *(const f32x4*)(F.bkw + dd + 4);
            v4u o;
            o.x = cvtpk(bflo(raw.x) * qs * wa.x * ka.x, bfhi(raw.x) * qs * wa.y * ka.y); o.y = cvtpk(bflo(raw.y) * qs * wa.z * ka.z, bfhi(raw.y) * qs * wa.w * ka.w);
            o.z = cvtpk(bflo(raw.z) * qs * wb.x * kb.x, bfhi(raw.z) * qs * wb.y * kb.y); o.w = cvtpk(bflo(raw.w) * qs * wb.z * kb.z, bfhi(raw.w) * qs * wb.w * kb.w);
            qf[d0] = __builtin_bit_cast(bf16x8, o); }
        VM_WAIT0(); __syncthreads();
        float mrun = -1e30f, lrun = 0.f; f32x16 o0 = {}, o1 = {};
        const int ksw = (r32 >> 1) & 7;
        for (int jt = (j >= 4 ? j - 4 : 0); jt <= j; ++jt) {
            const int s = sbase + jt;
            const LAS unsigned char* kb = kimg + s * 4096 + r32 * 128;
            f32x16 st = {};
#pragma unroll
            for (int d0 = 0; d0 < 4; ++d0) { const bf16x8 kf = *(const LAS bf16x8*)(kb + (((2 * d0 + hi) ^ ksw) * 16)); st = __builtin_amdgcn_mfma_f32_32x32x16_bf16(kf, qf[d0], st, 0, 0, 0); }
            const int bidx = 32 * (j - jt) + r32 + 31 - 4 * hi;
            float tmax = -1e30f;
#pragma unroll
            for (int i = 0; i < 4; ++i) { const f32x4 kk = *(const LAS f32x4*)(kstab + s * 32 + 8 * i + 4 * hi);
#pragma unroll
                for (int jj = 0; jj < 4; ++jj) { const float sv = st[4 * i + jj] * kk[jj] + btab[bidx - 8 * i - jj]; st[4 * i + jj] = sv; tmax = fmaxf(tmax, sv); } }
            tmax = fmaxf(tmax, __shfl_xor(tmax, 32));
            const float mnew = fmaxf(mrun, tmax), alpha = __builtin_amdgcn_exp2f(mrun - mnew); mrun = mnew;
            float psum = 0.f;
#pragma unroll
            for (int r = 0; r < 16; ++r) { st[r] = __builtin_amdgcn_exp2f(st[r] - mnew); psum += st[r]; }
            lrun = lrun * alpha + psum;
#pragma unroll
            for (int r = 0; r < 16; ++r) { o0[r] *= alpha; o1[r] *= alpha; }
            v4u p0, p1;
            p0.x = cvtpk(st[0], st[1]); p0.y = cvtpk(st[2], st[3]); p0.z = cvtpk(st[4], st[5]); p0.w = cvtpk(st[6], st[7]);
            p1.x = cvtpk(st[8], st[9]); p1.y = cvtpk(st[10], st[11]); p1.z = cvtpk(st[12], st[13]); p1.w = cvtpk(st[14], st[15]);
            const LAS unsigned char* vb = vimg + s * 4096 + (4 * hi + ((lane & 15) >> 2)) * 64 + ((lane >> 4) & 1) * 32 + (lane & 3) * 8;
#pragma unroll
            for (int ss = 0; ss < 2; ++ss) { const bf16x8 pf = __builtin_bit_cast(bf16x8, ss == 0 ? p0 : p1);
                { const s16x4 a = vtr(vb + (2 * ss) * 1024), c = vtr(vb + (2 * ss + 1) * 1024); const bf16x8 vf = {a[0], a[1], a[2], a[3], c[0], c[1], c[2], c[3]};
                  o0 = __builtin_amdgcn_mfma_f32_32x32x16_bf16(vf, pf, o0, 0, 0, 0); }
                { const s16x4 a = vtr(vb + (2 * ss) * 1024 + 512), c = vtr(vb + (2 * ss + 1) * 1024 + 512); const bf16x8 vf = {a[0], a[1], a[2], a[3], c[0], c[1], c[2], c[3]};
                  o1 = __builtin_amdgcn_mfma_f32_32x32x16_bf16(vf, pf, o1, 0, 0, 0); } }
        }
        const float ltot = lrun + __shfl_xor(lrun, 32), inv = 1.f / ltot;
        bf16* orow = F.OG + ((size_t)g * HB_ROWS + qrow) * 256 + h * 64 + 4 * hi;
#pragma unroll
        for (int i = 0; i < 4; ++i) { u32x2v w0, w1; w0.x = cvtpk(o0[4 * i] * inv, o0[4 * i + 1] * inv); w0.y = cvtpk(o0[4 * i + 2] * inv, o0[4 * i + 3] * inv);
            w1.x = cvtpk(o1[4 * i] * inv, o1[4 * i + 1] * inv); w1.y = cvtpk(o1[4 * i + 2] * inv, o1[4 * i + 3] * inv);
            *(u32x2v*)(orow + 8 * i) = w0; *(u32x2v*)(orow + 32 + 8 * i) = w1; }
        if (hi == 0) F.LSE[((size_t)g * HB_ROWS + qrow) * 4 + h] = (mrun + __log2f(ltot)) * LN2;
        __syncthreads();
    }
}

#ifndef G1_STAGGER_TICKS
#define G1_STAGGER_TICKS 0
#endif
#ifndef G1_ALIGN_EPI
#define G1_ALIGN_EPI true
#endif
#ifndef PROBE_REP
#define PROBE_REP -1
#endif
#define REPS(id) for (int rep_ = 0; rep_ < ((PROBE_REP) == (id) ? 2 : 1); ++rep_)
#ifndef MK_PER_PHASE
#define MK_PER_PHASE 0
#endif
constexpr int NPH_HALF = 5, NPHASES = 1 + 2 * NPH_HALF;
struct Args { const float* in[20]; float* out; unsigned char* ws; int ph_lo, ph_hi; };
__global__ void __launch_bounds__(NTHR, 2) mega_fwd(Args args) {
    extern __shared__ __attribute__((aligned(16))) unsigned char lds_raw[];
    Ctx F;
    F.lds = (LAS unsigned char*)lds_raw;
    F.tid = threadIdx.x; F.lane = F.tid & 63; F.wave = __builtin_amdgcn_readfirstlane(F.tid >> 6);
    F.G = gridDim.x; F.gtid = blockIdx.x * NTHR + F.tid; F.T = F.G * NTHR; F.gwave = blockIdx.x * NWAVES + F.wave; F.NW = F.G * NWAVES;
    { const int bx = blockIdx.x; const int vcu = (F.G % 8 == 0) ? (bx % 8) * (F.G / 8) + bx / 8 : bx; F.xgwave = vcu * NWAVES + F.wave; }
    unsigned char* ws = args.ws;
    F.x = args.in[0]; F.mem = args.in[1]; F.norm_w = args.in[2]; F.w_in = args.in[3]; F.gate_b = args.in[4]; F.lnw = args.in[5]; F.lnb = args.in[6]; F.sp_w = args.in[7];
    F.sp_b = args.in[8]; F.bqw = args.in[9]; F.bkw = args.in[10]; F.rel_bias = args.in[11]; F.mem_norm_w = args.in[12]; F.m_w_kv = args.in[13]; F.mqw = args.in[14]; F.mkw = args.in[15];
    F.proj_a = args.in[16]; F.proj_b = args.in[17]; F.proj_m = args.in[18]; F.w_out = args.in[19]; F.out = args.out;
    F.WIN = (bf16*)(ws + WS_WIN); F.PCAT = (bf16*)(ws + WS_PCAT); F.WOUT = (bf16*)(ws + WS_WOUT); F.WSP = (bf16*)(ws + WS_WSP); F.BIAS = (float*)(ws + WS_BIAS); F.BIASX = (float*)(ws + WS_BIAS + 65536);
    F.XN = (bf16*)(ws + WS_XN); F.PA = (bf16*)(ws + WS_PA); F.KVM = (bf16*)(ws + WS_KVM); F.SS = (float*)(ws + WS_SS); F.MKSS = (float*)(ws + WS_MKSS);
    F.OG = (bf16*)(ws + WS_OG); F.LSE = (float*)(ws + WS_LSE); F.LNST = (float*)(ws + WS_LNST); F.YC = (bf16*)(ws + WS_YC); F.MRG = (bf16*)(ws + WS_MRG);
    for (int u = F.tid; u < (LDS_BYTES - LDSCTL_OFF) / 4; u += NTHR) ((LAS unsigned*)(F.lds + LDSCTL_OFF))[u] = 0u;
    __syncthreads();
    XcdBarrier bar; bar.bar = (unsigned*)(ws + WS_CTL) + CW_BAR; bar.x = 0; bar.st = nullptr; bar.wave = 0;
    if (!MK_PER_PHASE) bar = xcd_barrier_post((unsigned*)(ws + WS_CTL) + CW_BAR, (volatile LAS unsigned*)(F.lds + MISC_OFF) + 8, F.wave);
    const int lo = args.ph_lo, hi = args.ph_hi;
#define IN(k) (lo <= (k) && (k) < hi)
#define SEAM(k) do { if (IN(k) && IN((k) + 1)) xcd_barrier(bar); } while (0)

    if (IN(0)) { REPS(0) p0_prologue(F); } SEAM(0);
#pragma unroll 1
    for (int hb = 0; hb < 2; ++hb) {
        const int pb = 1 + hb * NPH_HALF, row0 = hb * HB_ROWS;
        asm volatile("v_mbcnt_lo_u32_b32 %0, -1, 0\n\tv_mbcnt_hi_u32_b32 %0, -1, %0" : "=v"(F.lane)); F.tid = F.wave * 64 + F.lane; F.gtid = blockIdx.x * NTHR + F.tid;
#if PROBE_REP == 9 || PROBE_REP == 10
        if (IN(pb + 0)) { pg8::Gemm g{F.XN, F.WIN, MTOT + MMEM, NIN + 1024, DM, DM, DM}; pg8::OrderG1 S; S.init(hb, F.G, (int)blockIdx.x);
            typedef pg8::EpiProjT<PROBE_REP - 8> EP; EP E{F.PA, F.KVM, F.SS, F.MKSS, F.gate_b, hb * (HB_ROWS / 256), 0};
            pg8::gemm_phase<EP, pg8::OrderG1, true, true>(F.lds + RING_OFF, g, S, E, F.wave); }
#endif
        if (IN(pb + 0)) REPS(1) {
            pg8::Gemm g{F.XN, F.WIN, MTOT + MMEM, NIN + 1024, DM, DM, DM}; pg8::OrderG1 S; S.init(hb, F.G, (int)blockIdx.x);
#if G1_STAGGER_TICKS
            { const unsigned long long t0 = __builtin_amdgcn_s_memrealtime(), dl = (unsigned long long)((blockIdx.x >> 3) & 31) * G1_STAGGER_TICKS;
              while (__builtin_amdgcn_s_memrealtime() - t0 < dl) __builtin_amdgcn_s_sleep(8); }
#endif
            pg8::EpiProj E{F.PA, F.KVM, F.SS, F.MKSS, F.gate_b, hb * (HB_ROWS / 256), 0};
            pg8::gemm_phase<pg8::EpiProj, pg8::OrderG1, G1_ALIGN_EPI, true>(F.lds + RING_OFF, g, S, E, F.wave);
        }
#if PROBE_REP == 8
        if (IN(pb + 0)) { pg8::Gemm g{F.XN, F.WIN, MTOT + MMEM, NIN + 1024, DM, DM, DM}; pg8::OrderG1 S; S.init(hb, F.G, (int)blockIdx.x); pg8::EpiNull E{};
            pg8::gemm_phase<pg8::EpiNull, pg8::OrderG1, true, true>(F.lds + RING_OFF, g, S, E, F.wave); }
#endif
        SEAM(pb + 0);
        if (IN(pb + 1)) { REPS(2) st_mixA_mfma(F); REPS(3) st_attnB_v3(F); REPS(4) st_attnM_v3(F, hb); } SEAM(pb + 1);
        if (IN(pb + 2)) { REPS(5) st_mergeB_vec(F); } SEAM(pb + 2);
#if PROBE_REP == 13 || PROBE_REP == 14
        if (IN(pb + 3)) { pg8::Gemm g{F.YC, F.PCAT, HB_ROWS, DM, KC, KC, KC}; pg8::StaticOrder S; S.init(HB_ROWS, DM, F.G, (int)blockIdx.x);
            typedef pg8::EpiG2catT<PROBE_REP == 13, PROBE_REP == 14> EP; EP E{F.PA, F.MRG};
            pg8::gemm_phase<EP, pg8::StaticOrder, true, true>(F.lds + RING_OFF, g, S, E, F.wave); }
#endif
#if PROBE_REP == 11
        if (IN(pb + 3)) { pg8::Gemm g{F.YC, F.PCAT, HB_ROWS, DM, KC, KC, KC}; pg8::StaticOrder S; S.init(HB_ROWS, DM, F.G, (int)blockIdx.x); pg8::EpiNull E{};
            pg8::gemm_phase<pg8::EpiNull, pg8::StaticOrder, true, true>(F.lds + RING_OFF, g, S, E, F.wave); }
#endif
#if PROBE_REP == 12
        if (IN(pb + 4)) { pg8::Gemm g{F.MRG, F.WOUT, HB_ROWS, DM, DM, DM, DM}; pg8::StaticOrder S; S.init(HB_ROWS, DM, F.G, (int)blockIdx.x); pg8::EpiNull E{};
            pg8::gemm_phase<pg8::EpiNull, pg8::StaticOrder, true, true>(F.lds + RING_OFF, g, S, E, F.wave); }
#endif
        if (IN(pb + 3)) REPS(6) {
            pg8::Gemm g{F.YC, F.PCAT, HB_ROWS, DM, KC, KC, KC}; pg8::StaticOrder S; S.init(HB_ROWS, DM, F.G, (int)blockIdx.x);
            pg8::EpiG2cat E{F.PA, F.MRG};
            pg8::gemm_phase<pg8::EpiG2cat, pg8::StaticOrder, true, true>(F.lds + RING_OFF, g, S, E, F.wave);
        } SEAM(pb + 3);
        if (IN(pb + 4)) REPS(7) {
            pg8::Gemm g{F.MRG, F.WOUT, HB_ROWS, DM, DM, DM, DM}; pg8::StaticOrder S; S.init(HB_ROWS, DM, F.G, (int)blockIdx.x);
            pg8::EpiG3 E{F.x + (size_t)row0 * DM, F.out + (size_t)row0 * DM};
            pg8::gemm_phase<pg8::EpiG3, pg8::StaticOrder, true, true>(F.lds + RING_OFF, g, S, E, F.wave);
        } if (hb == 1) SEAM(pb + 4);
    }
#undef IN
#undef SEAM
}

extern "C" void kernel_launch(void* const* d_in, const int* in_sizes, int n_in, void* d_out, int out_size, void* d_ws, size_t ws_size, hipStream_t stream) {
    static int grid = 0;
    if (grid == 0) {
        if (n_in != 20 || in_sizes[0] != MTOT * DM || out_size != MTOT * DM || ws_size < WS_END) { fprintf(stderr, "kernel_launch: unexpected shapes (n_in %d, ws %zu); nothing launched\n", n_in, ws_size); grid = -1; return; }
        int dev = 0, cus = 0, per_cu = 0;
        if (hipGetDevice(&dev) != hipSuccess || hipDeviceGetAttribute(&cus, hipDeviceAttributeMultiprocessorCount, dev) != hipSuccess) { grid = -1; return; }
        if (hipFuncSetAttribute((const void*)mega_fwd, hipFuncAttributeMaxDynamicSharedMemorySize, LDS_BYTES) != hipSuccess) { fprintf(stderr, "kernel_launch: hipFuncSetAttribute failed\n"); grid = -1; return; }
        if (hipOccupancyMaxActiveBlocksPerMultiprocessor(&per_cu, (const void*)mega_fwd, NTHR, LDS_BYTES) != hipSuccess || per_cu < 1) { fprintf(stderr, "kernel_launch: occupancy query says %d blocks per CU\n", per_cu); (void)hipGetLastError(); grid = -1; return; }
        grid = cus;
    }
    if (grid < 0) return;
    if (hipMemsetAsync((char*)d_ws + WS_CTL, 0, CTL_ZERO_BYTES, stream) != hipSuccess) return;
    Args a{};
    for (int i = 0; i < 20; ++i) a.in[i] = (const float*)d_in[i];
    a.out = (float*)d_out; a.ws = (unsigned char*)d_ws;
#if MK_PER_PHASE
    for (int p = 0; p < NPHASES; ++p) { a.ph_lo = p; a.ph_hi = p + 1; hipLaunchKernelGGL(mega_fwd, dim3(grid), dim3(NTHR), LDS_BYTES, stream, a); }
#else
    a.ph_lo = 0; a.ph_hi = NPHASES; hipLaunchKernelGGL(mega_fwd, dim3(grid), dim3(NTHR), LDS_BYTES, stream, a);
#endif
}
```

```cpp
#include <hip/hip_runtime.h>
#include <cstdint>
#include <cstdio>

constexpr int DM = 1024, NB = 32, SEQ = 2048, MTOT = NB * SEQ;
constexpr int NIN = 8960, MEML = 256, MMEM = NB * MEML;
constexpr int HB_ROWS = MTOT / 2;
constexpr int C_AU = 0, C_AV = 768, C_AZ = 1536, C_BQ = 2304, C_BK = 3072, C_BV = 3840, C_BZ = 4608, C_MQ = 4864, C_MZ = 5376, C_G = 5888;
constexpr float EPS = 1e-6f;
constexpr int SS_W = 112;
constexpr int PAP = 7424;
constexpr int PA_ROWB = 2 * PAP, PA_GOFF = 2 * C_G;
constexpr int KC = 1536;

constexpr size_t MiB = 1u << 20;
constexpr size_t WS_CTL = 0, CTL_ZERO_BYTES = 256 * 1024, WS_WIN = 2 * MiB, WS_PCAT = 22 * MiB, WS_WOUT = 25 * MiB, WS_WSP = 27 * MiB, WS_BIAS = 27 * MiB + 512 * 1024;
constexpr size_t WS_XN = 32 * MiB, WS_PA = 176 * MiB, WS_KVM = 736 * MiB, WS_SS = 752 * MiB, WS_MKSS = 766 * MiB, WS_OG = 768 * MiB, WS_LSE = 816 * MiB, WS_LNST = 818 * MiB;
constexpr size_t WS_YC = 820 * MiB, WS_MRG = 916 * MiB, WS_END = 980 * MiB;
constexpr int CW_BAR = 4096;

namespace pg8 {
#define PG8_LAS __attribute__((address_space(3)))
typedef unsigned short bf16_t;
typedef short bf16x8 __attribute__((ext_vector_type(8)));
typedef float f32x4 __attribute__((ext_vector_type(4)));
typedef unsigned u32x4 __attribute__((ext_vector_type(4)));
constexpr int BM = 256, BK = 64, HALF = 128, HTB = HALF * BK * 2  , STAGE_BYTES = 8 * HTB, NXCD = 8, WGM = 8;

__host__ __device__ __forceinline__ int lds_byte(int r, int c) { const int st = (r >> 4) * 2 + (c >> 5), rr = r & 15, cc = c & 31, ob = rr * 64 + cc * 2; return st * 1024 + (ob ^ (((ob >> 9) & 1) << 5)); }
__host__ __device__ __forceinline__ void stage_rc(int b, int& R, int& C) { const int st = b / 1024, sb = b % 1024, swz = sb ^ (((sb >> 9) & 1) << 5); R = (st >> 1) * 16 + swz / 64; C = (st & 1) * 32 + (swz % 64) / 2; }
__host__ __device__ __forceinline__ int perm32(int rho) { const int n = rho >> 4, i = rho & 15; return 8 * (i >> 2) + 4 * n + (i & 3); }

struct Unit { int pm, pn; };
struct Gemm { const bf16_t* A; const bf16_t* Bt; int M, N, K, lda, ldb; };

struct StaticOrder {
    int nM, nN, nwg, G, c;
    __host__ __device__ void init(int M, int N, int G_, int c_) { nM = M / BM; nN = N / BM; nwg = nM * nN; G = G_; c = c_; }
    __host__ __device__ bool next(int i, Unit& u) const {
        const long L = (long)i * G + c; if (L >= nwg) return false;
        int wgid = (int)L; { const int q = nwg / NXCD, r = nwg % NXCD, xcd = wgid % NXCD, off = wgid / NXCD; wgid = (xcd < r ? xcd * (q + 1) : r * (q + 1) + (xcd - r) * q) + off; }
        const int nig = WGM * nN, gid = wgid / nig, fm = gid * WGM, gsz = (nM - fm) < WGM ? (nM - fm) : WGM;
        u.pm = fm + ((wgid % nig) % gsz); u.pn = (wgid % nig) / gsz; return true;
    }
    __device__ __forceinline__ void a_ready(const Unit&) const {}
    __device__ __forceinline__ void done(const Unit&) const {}
};


typedef float f32x2c_t __attribute__((ext_vector_type(2))); typedef __bf16 bf16x2c_t __attribute__((ext_vector_type(2)));
__device__ __forceinline__ unsigned cvt_pk_bf16(float lo, float hi) { const f32x2c_t v = {lo, hi}; const bf16x2c_t b = __builtin_convertvector(v, bf16x2c_t); return __builtin_bit_cast(unsigned, b); }
typedef float f32x2 __attribute__((ext_vector_type(2)));
__device__ __forceinline__ f32x2 gelu_pk(f32x2 v) {
    const f32x2 av = __builtin_elementwise_abs(v), d = av * 0.2316418882f + 1.0f;
    f32x2 t; t.x = __builtin_amdgcn_rcpf(d.x); t.y = __builtin_amdgcn_rcpf(d.y);
    f32x2 q = t * 0.5307027145f + (-0.7265760135f); q = q * t + 0.7107068705f; q = q * t + (-0.142248368f); q = q * t + 0.127414796f; q = q * t;
    const f32x2 s = (v * v) * (-0.72134752044f);
    f32x2 e; e.x = __builtin_amdgcn_exp2f(s.x); e.y = __builtin_amdgcn_exp2f(s.y);
    const f32x2 m = v * (q * e), r = v - m;
    f32x2 o; o.x = v.x < 0.f ? m.x : r.x; o.y = v.y < 0.f ? m.y : r.y; return o;
}

template <class Epi, class Sched, bool ALIGN_EPI = false, bool SP2 = false>
__device__ __forceinline__ void gemm_phase(PG8_LAS unsigned char* lds, const Gemm g, const Sched& S, const Epi& E, const int wave_id) {
    int tid; asm volatile("v_mbcnt_lo_u32_b32 %0, -1, 0\n\tv_mbcnt_hi_u32_b32 %0, -1, %0" : "=v"(tid)); tid += wave_id * 64;
    const int wid = __builtin_amdgcn_readfirstlane(tid >> 6), lane = tid & 63, wr = wid >> 2, wc = wid & 3, fr = lane & 15, fq = lane >> 4;
    int K = g.K; asm volatile("" : "+s"(K)); const int nt = K / BK;
    unsigned voffA[2], voffB[2];
#pragma unroll
    for (int i = 0; i < 2; ++i) { int R, C; stage_rc(tid * 16 + i * 8192, R, C); const int Rb = Epi::PERM ? ((R & ~31) + perm32(R & 31)) : R;
        voffA[i] = (unsigned)(R * g.lda + C) * 2u; voffB[i] = (unsigned)(Rb * g.ldb + C) * 2u; }
    const size_t kstep = (size_t)(BK * 2);
    const size_t hstepA = (size_t)HALF * g.lda * 2, hstepB = (size_t)HALF * g.ldb * 2;
    const size_t tstepA = 2 * hstepA, tstepB = 2 * hstepB;
    const unsigned ldsw = (unsigned)wid * 1024u;
    const int aoff = lds_byte(wr * 64 + fr, fq * 8), boff = lds_byte(wc * 32 + fr, fq * 8);
#define PG8_SA(b, h) (((b) * 2 + (h)) * HTB)
#define PG8_SB(b, h) ((4 + (b) * 2 + (h)) * HTB)
#define PG8_STAGE(bufoff, gbase, voff) do { _Pragma("unroll") for (int _i = 0; _i < 2; ++_i) \
        __builtin_amdgcn_global_load_lds((const unsigned*)((const char*)(gbase) + (voff)[_i]), (PG8_LAS unsigned*)(lds + (bufoff) + ldsw + _i * 8192), 16, 0, 0); } while (0)
#define PG8_LDA(dst, b, h) do { _Pragma("unroll") for (int m = 0; m < 4; ++m) _Pragma("unroll") for (int k = 0; k < 2; ++k) dst[m][k] = *(const PG8_LAS bf16x8*)(lds + PG8_SA(b, h) + aoff + m * 2048 + k * 1024); } while (0)
#define PG8_LDB(dst, b, h) do { _Pragma("unroll") for (int n = 0; n < 2; ++n) _Pragma("unroll") for (int k = 0; k < 2; ++k) dst[n][k] = *(const PG8_LAS bf16x8*)(lds + PG8_SB(b, h) + boff + n * 2048 + k * 1024); } while (0)
#define PG8_MMA(ai, bj, At, Bt) do { __builtin_amdgcn_s_setprio(1); _Pragma("unroll") for (int m = 0; m < 4; ++m) _Pragma("unroll") for (int n = 0; n < 2; ++n) _Pragma("unroll") for (int k = 0; k < 2; ++k) \
        acc[ai][bj][m][n] = __builtin_amdgcn_mfma_f32_16x16x32_bf16(Bt[n][k], At[m][k], acc[ai][bj][m][n], 0, 0, 0); __builtin_amdgcn_s_setprio(0); } while (0)
#define PG8_WAIT_V(n) asm volatile("s_waitcnt vmcnt(" #n ")" ::: "memory")
#define PG8_WAIT_L(n) asm volatile("s_waitcnt lgkmcnt(" #n ")" ::: "memory")
#define PG8_BAR __builtin_amdgcn_s_barrier()
#define PG8_SCHED __builtin_amdgcn_sched_barrier(0)
    Unit cur, nxt; int ui = 0;
    if (!S.next(0, cur)) return;
    f32x4 acc[2][2][4][2];
#pragma unroll
    for (int a = 0; a < 2; ++a)
#pragma unroll
        for (int b = 0; b < 2; ++b)
#pragma unroll
            for (int m = 0; m < 4; ++m)
#pragma unroll
                for (int n = 0; n < 2; ++n) acc[a][b][m][n] = (f32x4){0.f, 0.f, 0.f, 0.f};
    bf16x8 At[4][2], B0[2][2], B1[2][2];
    const char* cA = (const char*)g.A + (size_t)cur.pm * tstepA; const char* cB = (const char*)g.Bt + (size_t)cur.pn * tstepB;
    S.a_ready(cur);
    if constexpr (SP2) {
        PG8_STAGE(PG8_SB(0, 0), cB, voffB); PG8_STAGE(PG8_SB(0, 1), cB + hstepB, voffB); PG8_STAGE(PG8_SA(0, 0), cA, voffA); PG8_STAGE(PG8_SA(0, 1), cA + hstepA, voffA);
        if (wr == 1) PG8_BAR;
        PG8_WAIT_V(2); PG8_BAR;
        PG8_STAGE(PG8_SB(1, 0), cB + kstep, voffB); PG8_STAGE(PG8_SA(1, 0), cA + kstep, voffA); PG8_STAGE(PG8_SB(1, 1), cB + hstepB + kstep, voffB);
        PG8_WAIT_V(6); PG8_BAR;
    } else {
        PG8_STAGE(PG8_SB(0, 0), cB, voffB); PG8_STAGE(PG8_SA(0, 0), cA, voffA); PG8_STAGE(PG8_SB(0, 1), cB + hstepB, voffB); PG8_STAGE(PG8_SA(0, 1), cA + hstepA, voffA);
        if (wr == 1) PG8_BAR;
        PG8_WAIT_V(4); PG8_BAR;
        PG8_STAGE(PG8_SB(1, 0), cB + kstep, voffB); PG8_STAGE(PG8_SA(1, 0), cA + kstep, voffA); PG8_STAGE(PG8_SB(1, 1), cB + hstepB + kstep, voffB);
        PG8_WAIT_V(6); PG8_BAR;
    }
    for (;;) {
        const bool has_next = S.next(ui + 1, nxt);
        const char* nA = has_next ? (const char*)g.A + (size_t)nxt.pm * tstepA : cA; const char* nB = has_next ? (const char*)g.Bt + (size_t)nxt.pn * tstepB : cB;
        for (int t = 0; t < nt; t += 2) {
            if constexpr (Epi::KHOOK) { if (t == Epi::KH1 || t == Epi::KH2) E.khook(acc, cur, t, wr, wc, fr, fq); }
            const bool last = (t == nt - 2);
            const char* a1 = cA + (size_t)(t + 1) * kstep;
            const char* a2 = last ? nA : cA + (size_t)(t + 2) * kstep; const char* b2 = last ? nB : cB + (size_t)(t + 2) * kstep;
            const char* a3 = a2 + kstep; const char* b3 = b2 + kstep;
            if (last && has_next) S.a_ready(nxt);
            if constexpr (SP2) {
            PG8_LDB(B0, 0, 0); PG8_LDB(B1, 0, 1); PG8_SCHED; PG8_LDA(At, 0, 0); PG8_STAGE(PG8_SA(1, 1), a1 + hstepA, voffA);
            PG8_WAIT_V(8); PG8_WAIT_L(0); PG8_BAR; PG8_MMA(0, 0, At, B0); PG8_MMA(0, 1, At, B1); PG8_BAR; PG8_SCHED;
            PG8_LDA(At, 0, 1); PG8_STAGE(PG8_SB(0, 0), b2, voffB); PG8_STAGE(PG8_SB(0, 1), b2 + hstepB, voffB); PG8_STAGE(PG8_SA(0, 0), a2, voffA);
            PG8_WAIT_V(8); PG8_WAIT_L(0); PG8_BAR; PG8_MMA(1, 0, At, B0); PG8_MMA(1, 1, At, B1); PG8_BAR; PG8_SCHED;
            PG8_LDB(B0, 1, 0); PG8_LDB(B1, 1, 1); PG8_SCHED; PG8_LDA(At, 1, 0); PG8_STAGE(PG8_SA(0, 1), a2 + hstepA, voffA);
            PG8_WAIT_V(8); PG8_WAIT_L(0); PG8_BAR; PG8_MMA(0, 0, At, B0); PG8_MMA(0, 1, At, B1); PG8_BAR; PG8_SCHED;
            PG8_LDA(At, 1, 1); PG8_STAGE(PG8_SB(1, 0), b3, voffB); PG8_STAGE(PG8_SB(1, 1), b3 + hstepB, voffB); PG8_STAGE(PG8_SA(1, 0), a3, voffA);
            PG8_WAIT_V(8); PG8_WAIT_L(0); PG8_BAR; PG8_MMA(1, 0, At, B0); PG8_MMA(1, 1, At, B1); PG8_BAR; PG8_SCHED;
            } else {
            PG8_LDB(B0, 0, 0); PG8_SCHED; PG8_LDA(At, 0, 0); PG8_STAGE(PG8_SA(1, 1), a1 + hstepA, voffA);
            PG8_WAIT_L(8); PG8_BAR; PG8_WAIT_L(0); PG8_MMA(0, 0, At, B0); PG8_BAR; PG8_SCHED;
            PG8_LDB(B1, 0, 1); PG8_STAGE(PG8_SB(0, 0), b2, voffB);
            PG8_BAR; PG8_WAIT_L(0); PG8_MMA(0, 1, At, B1); PG8_BAR;
            PG8_LDA(At, 0, 1); PG8_STAGE(PG8_SA(0, 0), a2, voffA);
            PG8_BAR; PG8_WAIT_L(0); PG8_MMA(1, 0, At, B0); PG8_BAR; PG8_SCHED;
            PG8_STAGE(PG8_SB(0, 1), b2 + hstepB, voffB);
            PG8_WAIT_V(6); PG8_BAR; PG8_MMA(1, 1, At, B1); PG8_BAR;
            PG8_LDB(B0, 1, 0); PG8_SCHED; PG8_LDA(At, 1, 0); PG8_STAGE(PG8_SA(0, 1), a2 + hstepA, voffA);
            PG8_WAIT_L(8); PG8_BAR; PG8_WAIT_L(0); PG8_MMA(0, 0, At, B0); PG8_BAR; PG8_SCHED;
            PG8_LDB(B1, 1, 1); PG8_STAGE(PG8_SB(1, 0), b3, voffB);
            PG8_BAR; PG8_WAIT_L(0); PG8_MMA(0, 1, At, B1); PG8_BAR;
            PG8_LDA(At, 1, 1); PG8_STAGE(PG8_SA(1, 0), a3, voffA);
            PG8_BAR; PG8_WAIT_L(0); PG8_MMA(1, 0, At, B0); PG8_BAR; PG8_SCHED;
            PG8_STAGE(PG8_SB(1, 1), b3 + hstepB, voffB);
            PG8_WAIT_V(6); PG8_BAR; PG8_MMA(1, 1, At, B1); PG8_BAR;
            }
        }
        if constexpr (ALIGN_EPI) { if (wr == 0) PG8_BAR; }
        if constexpr (!Epi::AFTER_DRAIN) { E(acc, cur, wr, wc, fr, fq); S.done(cur); }
        if (!has_next) break;
#pragma unroll
        for (int a = 0; a < 2; ++a)
#pragma unroll
            for (int b = 0; b < 2; ++b)
#pragma unroll
                for (int m = 0; m < 4; ++m)
#pragma unroll
                    for (int n = 0; n < 2; ++n) acc[a][b][m][n] = (f32x4){0.f, 0.f, 0.f, 0.f};
        cur = nxt; cA = nA; cB = nB; ++ui;
        if constexpr (ALIGN_EPI) { if (wr == 1) PG8_BAR; }
    }
    PG8_WAIT_V(0);
    if constexpr (!ALIGN_EPI) { if (wr == 0) PG8_BAR; }
    PG8_BAR;
    if constexpr (Epi::AFTER_DRAIN) { E.fused(acc, cur, wr, wc, fr, fq, lds, wid, lane); S.done(cur); }
#undef PG8_SA
#undef PG8_SB
#undef PG8_STAGE
#undef PG8_LDA
#undef PG8_LDB
#undef PG8_MMA
#undef PG8_WAIT_V
#undef PG8_WAIT_L
#undef PG8_BAR
#undef PG8_SCHED
}
}

#ifndef G1_EPI_DRAIN
#define G1_EPI_DRAIN 0
#endif
#ifndef G1_STORE_AUX_MIX
#define G1_STORE_AUX_MIX 2
#endif
#ifndef G1_STORE_AUX
#define G1_STORE_AUX 2
#endif
namespace pg8 {
__device__ __forceinline__ float ubf0(unsigned w) { return (float)(w & 0xffu); }
__device__ __forceinline__ float ubf1(unsigned w) { return (float)((w >> 8) & 0xffu); }
__device__ __forceinline__ float ubf2(unsigned w) { return (float)((w >> 16) & 0xffu); }
__device__ __forceinline__ float ubf3(unsigned w) { return (float)(w >> 24); }
__device__ __forceinline__ float ex2(float x) { return __builtin_amdgcn_exp2f(x); }
__device__ __forceinline__ float sigm_fast(float x) { return __builtin_amdgcn_rcpf(1.0f + ex2(x * -1.4426950408889634f)); }
template <int MODE = 0  > struct EpiProjT {
    static constexpr bool PERM = true, AFTER_DRAIN = false, KHOOK = false;
    bf16_t* PA; bf16_t* KVM; float* SS; float* MKSS; const float* gate_b; int pm0; int pad;
    template <int KIND, int STAT> __device__ __forceinline__ void body(const f32x4 (&acc)[2][2][4][2], const __amdgpu_buffer_rsrc_t rsrc, int row0, int col0, int ldc, float* sb, int sld, int so, const float* bias, int wc, int fq) const {
        f32x4 bv[2][2];
        if (KIND == 3) {
#pragma unroll
            for (int bj = 0; bj < 2; ++bj)
#pragma unroll
                for (int n = 0; n < 2; ++n) bv[bj][n] = *(const f32x4*)(bias + bj * HALF + 4 * n);
        }
#pragma unroll
        for (int ai = 0; ai < 2; ++ai)
#pragma unroll
            for (int m = 0; m < 4; ++m) { const int row = row0 + ai * HALF + m * 16; const unsigned rowoff = ((unsigned)row * (unsigned)ldc + (unsigned)col0) * 2u;
#pragma unroll
                for (int bj = 0; bj < 2; ++bj) { f32x4 v0 = acc[ai][bj][m][0], v1 = acc[ai][bj][m][1];
                    if (KIND == 1) { f32x2 a = gelu_pk((f32x2){v0[0], v0[1]}), b = gelu_pk((f32x2){v0[2], v0[3]}), c = gelu_pk((f32x2){v1[0], v1[1]}), d = gelu_pk((f32x2){v1[2], v1[3]});
                        v0 = (f32x4){a.x, a.y, b.x, b.y}; v1 = (f32x4){c.x, c.y, d.x, d.y}; }
                    else if (KIND == 2) {
#pragma unroll
                        for (int j = 0; j < 4; ++j) { v0[j] = v0[j] * sigm_fast(v0[j]); v1[j] = v1[j] * sigm_fast(v1[j]); } }
                    else if (KIND == 3) { v0 = v0 + bv[bj][0]; v1 = v1 + bv[bj][1];
#pragma unroll
                        for (int j = 0; j < 4; ++j) { v0[j] = sigm_fast(v0[j]); v1[j] = sigm_fast(v1[j]); } }
                    if (STAT) {
                        float s = ((v0[0] + v0[1]) + (v0[2] + v0[3])) + ((v1[0] + v1[1]) + (v1[2] + v1[3]));
                        float q = ((v0[0] * v0[0] + v0[1] * v0[1]) + (v0[2] * v0[2] + v0[3] * v0[3])) + ((v1[0] * v1[0] + v1[1] * v1[1]) + (v1[2] * v1[2] + v1[3] * v1[3]));
                        if (STAT == 2) { s += __shfl_xor(s, 16); s += __shfl_xor(s, 32); }
                        q += __shfl_xor(q, 16); q += __shfl_xor(q, 32);
                        if (fq == 0) { float* sp = sb + (size_t)row * sld + so; const int blk = 4 * bj + wc;
                            if (STAT == 2) { sp[2 * blk] = s; sp[2 * blk + 1] = q; } else sp[blk] = q; }
                    }
                    u32x4 w; w.x = cvt_pk_bf16(v0[0], v0[1]); w.y = cvt_pk_bf16(v0[2], v0[3]); w.z = cvt_pk_bf16(v1[0], v1[1]); w.w = cvt_pk_bf16(v1[2], v1[3]);
                    if (MODE == 2) asm volatile("" :: "v"(w)); else __builtin_amdgcn_raw_buffer_store_b128(w, rsrc, (int)(rowoff + bj * HALF * 2), 0, KIND == 3 ? G1_STORE_AUX : G1_STORE_AUX_MIX); } }
    }
    __device__ __forceinline__ void uz_body(const f32x4 (&acc)[2][2][4][2], const __amdgpu_buffer_rsrc_t rsrc, int row0, int ucol0) const {
#pragma unroll
        for (int ai = 0; ai < 2; ++ai)
#pragma unroll
            for (int m = 0; m < 4; ++m) { const int row = row0 + ai * HALF + m * 16;
                f32x4 u0 = acc[ai][0][m][0], u1 = acc[ai][0][m][1]; const f32x4 z0 = acc[ai][1][m][0], z1 = acc[ai][1][m][1];
                { f32x2 a = gelu_pk((f32x2){u0[0], u0[1]}), b = gelu_pk((f32x2){u0[2], u0[3]}), c = gelu_pk((f32x2){u1[0], u1[1]}), d = gelu_pk((f32x2){u1[2], u1[3]});
                  u0 = (f32x4){a.x, a.y, b.x, b.y}; u1 = (f32x4){c.x, c.y, d.x, d.y}; }
#pragma unroll
                for (int j = 0; j < 4; ++j) { u0[j] *= z0[j] * sigm_fast(z0[j]); u1[j] *= z1[j] * sigm_fast(z1[j]); }
                u32x4 w; w.x = cvt_pk_bf16(u0[0], u0[1]); w.y = cvt_pk_bf16(u0[2], u0[3]); w.z = cvt_pk_bf16(u1[0], u1[1]); w.w = cvt_pk_bf16(u1[2], u1[3]);
                if (MODE == 2) asm volatile("" :: "v"(w)); else __builtin_amdgcn_raw_buffer_store_b128(w, rsrc, (int)((unsigned)row * (unsigned)PA_ROWB + (unsigned)(2 * (C_AU + ucol0))), 0, G1_STORE_AUX_MIX); }
    }
    __device__ __forceinline__ void gate_body(const f32x4 (&acc)[2][2][4][2], const __amdgpu_buffer_rsrc_t rsrc, int row0, int gcol0, const float* bias) const {
        f32x4 bv[2][2];
#pragma unroll
        for (int bj = 0; bj < 2; ++bj)
#pragma unroll
            for (int n = 0; n < 2; ++n) bv[bj][n] = *(const f32x4*)(bias + 8 * bj + 4 * n);
#pragma unroll
        for (int ai = 0; ai < 2; ++ai)
#pragma unroll
            for (int m = 0; m < 4; ++m) { const int row = row0 + ai * HALF + m * 16; u32x4 w;
#pragma unroll
                for (int bj = 0; bj < 2; ++bj)
#pragma unroll
                    for (int n = 0; n < 2; ++n) { const f32x4 v = acc[ai][bj][m][n] + bv[bj][n]; unsigned d = 0u;
#pragma unroll
                        for (int j = 0; j < 4; ++j) d |= (unsigned)(fmaxf(sigm_fast(v[j]) * 255.0f, 1.0f) + 0.5f) << (8 * j);
                        w[2 * bj + n] = d; }
                if (MODE == 2) asm volatile("" :: "v"(w)); else __builtin_amdgcn_raw_buffer_store_b128(w, rsrc, (int)((unsigned)row * (unsigned)PA_ROWB + (unsigned)(PA_GOFF + gcol0)), 0, G1_STORE_AUX); }
    }
    __device__ __forceinline__ void operator()(const f32x4 (&acc)[2][2][4][2], const Unit& u, int wr, int wc, int fr, int fq) const {
        const bool kv = u.pn >= 35; const int pn = kv ? u.pn - 35 : u.pn;
        const int rowt = kv ? (u.pm - 256) * BM : (u.pm - pm0) * BM;
        bf16_t* base = kv ? KVM : PA; const int ldc = kv ? 1024 : PAP;
        const __amdgpu_buffer_rsrc_t rsrc = __builtin_amdgcn_make_buffer_rsrc(base, 0, kv ? (int)((size_t)MMEM * 1024 * 2) : (int)((size_t)HB_ROWS * PA_ROWB), 0x00020000);
        const int row0 = rowt + wr * 64 + fr, col0 = pn * BM + wc * 32 + 8 * fq;
        if (MODE == 1) { body<0, 0>(acc, rsrc, row0, col0, ldc, SS, SS_W, 0, gate_b, wc, fq); return; }
        if (kv) { if (pn < 2) body<0, 1>(acc, rsrc, row0, col0, ldc, MKSS, 16, 8 * pn, gate_b, wc, fq); else body<0, 0>(acc, rsrc, row0, col0, ldc, SS, SS_W, 0, gate_b, wc, fq); }
        else if (pn < 3) uz_body(acc, rsrc, row0, 128 * pn + 32 * wc + 8 * fq);
        else if (pn < 6) body<1, 2>(acc, rsrc, row0, col0, ldc, SS, SS_W, 16 * (pn - 3), gate_b, wc, fq);
        else if (pn < 9) uz_body(acc, rsrc, row0, 128 * (pn - 3) + 32 * wc + 8 * fq);
        else if (pn < 12) body<0, 1>(acc, rsrc, row0, col0, ldc, SS, SS_W, 48 + 8 * (pn - 9), gate_b, wc, fq);
        else if (pn < 15) body<0, 1>(acc, rsrc, row0, col0, ldc, SS, SS_W, 72 + 8 * (pn - 12), gate_b, wc, fq);
        else if (pn < 18) body<0, 0>(acc, rsrc, row0, col0, ldc, SS, SS_W, 0, gate_b, wc, fq);
        else if (pn < 19) body<2, 0>(acc, rsrc, row0, col0, ldc, SS, SS_W, 0, gate_b, wc, fq);
        else if (pn < 21) body<0, 1>(acc, rsrc, row0, col0, ldc, SS, SS_W, 96 + 8 * (pn - 19), gate_b, wc, fq);
        else if (pn < 23) body<2, 0>(acc, rsrc, row0, col0, ldc, SS, SS_W, 0, gate_b, wc, fq);
        else { const int gc = (pn - 23) * BM + 64 * wc + 16 * fq; gate_body(acc, rsrc, row0, gc, gate_b + gc); }
#if G1_EPI_DRAIN
        asm volatile("s_waitcnt vmcnt(0)" ::: "memory");
#endif
    }
};
typedef EpiProjT<0> EpiProj;
template <bool HOOKS = true, bool EPI = true> struct EpiG2catT {
    static constexpr bool PERM = true, AFTER_DRAIN = false, KHOOK = HOOKS; static constexpr int KH1 = 12, KH2 = 16;
    const bf16_t* PA; bf16_t* MRG;
    __device__ __forceinline__ void khook(f32x4 (&acc)[2][2][4][2], const Unit& u, int t, int wr, int wc, int fr, int fq) const {
        typedef unsigned u32x2v __attribute__((ext_vector_type(2)));
        const int ga = t == KH1 ? 0 : 1;
        const int row0 = u.pm * BM + wr * 64 + fr, col0 = u.pn * BM + wc * 32 + 8 * fq;
        const unsigned char* gbase = (const unsigned char*)PA + (size_t)row0 * PA_ROWB + PA_GOFF + ga * DM + col0;
        u32x2v ag[2][4][2], bg[2][4][2];
#pragma unroll
        for (int ai = 0; ai < 2; ++ai)
#pragma unroll
            for (int m = 0; m < 4; ++m) { const unsigned char* gp_ = gbase + (size_t)(ai * HALF + m * 16) * PA_ROWB;
#pragma unroll
                for (int bj = 0; bj < 2; ++bj) { ag[ai][m][bj] = *(const u32x2v*)(gp_ + bj * HALF); bg[ai][m][bj] = *(const u32x2v*)(gp_ + DM + bj * HALF); } }
        __builtin_amdgcn_sched_barrier(0);
#define G2_R(A, Bv, K) (ubf##K(A) * __builtin_amdgcn_rcpf(ubf##K(Bv)))
#pragma unroll
        for (int ai = 0; ai < 2; ++ai)
#pragma unroll
            for (int m = 0; m < 4; ++m)
#pragma unroll
                for (int bj = 0; bj < 2; ++bj) { const u32x2v a = ag[ai][m][bj], b = bg[ai][m][bj]; f32x4 r0, r1;
                    r0[0] = G2_R(a.x, b.x, 0); r0[1] = G2_R(a.x, b.x, 1); r0[2] = G2_R(a.x, b.x, 2); r0[3] = G2_R(a.x, b.x, 3);
                    r1[0] = G2_R(a.y, b.y, 0); r1[1] = G2_R(a.y, b.y, 1); r1[2] = G2_R(a.y, b.y, 2); r1[3] = G2_R(a.y, b.y, 3);
                    acc[ai][bj][m][0] *= r0; acc[ai][bj][m][1] *= r1; }
#undef G2_R
    }
    __device__ __forceinline__ void operator()(const f32x4 (&acc)[2][2][4][2], const Unit& u, int wr, int wc, int fr, int fq) const {
        typedef unsigned u32x2v __attribute__((ext_vector_type(2)));
        if (!EPI) { _Pragma("unroll") for (int ai = 0; ai < 2; ++ai) _Pragma("unroll") for (int bj = 0; bj < 2; ++bj) _Pragma("unroll") for (int m = 0; m < 4; ++m) asm volatile("" :: "v"(acc[ai][bj][m][0]), "v"(acc[ai][bj][m][1])); return; }
        const int row0 = u.pm * BM + wr * 64 + fr, col0 = u.pn * BM + wc * 32 + 8 * fq;
        u32x2v gv[2][4][2];
#pragma unroll
        for (int ai = 0; ai < 2; ++ai)
#pragma unroll
            for (int m = 0; m < 4; ++m) { const unsigned char* gp = (const unsigned char*)PA + (size_t)(row0 + ai * HALF + m * 16) * PA_ROWB + PA_GOFF + 2 * DM + col0;
#pragma unroll
                for (int bj = 0; bj < 2; ++bj) gv[ai][m][bj] = *(const u32x2v*)(gp + bj * HALF); }
        __builtin_amdgcn_sched_barrier(0);
        const float q = 1.0f / 255.0f;
#pragma unroll
        for (int ai = 0; ai < 2; ++ai)
#pragma unroll
            for (int m = 0; m < 4; ++m) { bf16_t* mp = MRG + (size_t)(row0 + ai * HALF + m * 16) * DM + col0;
#pragma unroll
                for (int bj = 0; bj < 2; ++bj) { const u32x2v g = gv[ai][m][bj]; const f32x4 v0 = acc[ai][bj][m][0] * q, v1 = acc[ai][bj][m][1] * q; u32x4 w;
                    w.x = cvt_pk_bf16(v0[0] * ubf0(g.x), v0[1] * ubf1(g.x)); w.y = cvt_pk_bf16(v0[2] * ubf2(g.x), v0[3] * ubf3(g.x));
                    w.z = cvt_pk_bf16(v1[0] * ubf0(g.y), v1[1] * ubf1(g.y)); w.w = cvt_pk_bf16(v1[2] * ubf2(g.y), v1[3] * ubf3(g.y));
                    *(u32x4*)(mp + bj * HALF) = w; } }
    }
};
typedef EpiG2catT<true, true> EpiG2cat;
struct EpiG3 {
    static constexpr bool PERM = false, AFTER_DRAIN = false, KHOOK = false;
    const float* x; float* out;
    __device__ __forceinline__ void operator()(const f32x4 (&acc)[2][2][4][2], const Unit& u, int wr, int wc, int fr, int fq) const {
        const int row0 = u.pm * BM + wr * 64 + fr, col0 = u.pn * BM + wc * 32 + 4 * fq;
        f32x4 xv[2][2][2][2];
#define G3_LOAD(B) do { _Pragma("unroll") for (int mm = 0; mm < 2; ++mm) { const size_t off_ = (size_t)(row0 + ((B) >> 1) * HALF + (2 * ((B) & 1) + mm) * 16) * DM + col0; \
            _Pragma("unroll") for (int bj = 0; bj < 2; ++bj) _Pragma("unroll") for (int n = 0; n < 2; ++n) xv[(B) & 1][mm][bj][n] = __builtin_nontemporal_load((const f32x4*)(x + off_ + bj * HALF + n * 16)); } } while (0)
#define G3_STORE(B) do { _Pragma("unroll") for (int mm = 0; mm < 2; ++mm) { const size_t off_ = (size_t)(row0 + ((B) >> 1) * HALF + (2 * ((B) & 1) + mm) * 16) * DM + col0; \
            _Pragma("unroll") for (int bj = 0; bj < 2; ++bj) _Pragma("unroll") for (int n = 0; n < 2; ++n) \
                __builtin_nontemporal_store(xv[(B) & 1][mm][bj][n] + acc[(B) >> 1][bj][2 * ((B) & 1) + mm][n], (f32x4*)(out + off_ + bj * HALF + n * 16)); } } while (0)
        G3_LOAD(0); G3_LOAD(1); __builtin_amdgcn_sched_barrier(0); G3_STORE(0); G3_STORE(1); __builtin_amdgcn_sched_barrier(0); G3_LOAD(2); G3_LOAD(3); __builtin_amdgcn_sched_barrier(0); G3_STORE(2); G3_STORE(3);
#undef G3_LOAD
#undef G3_STORE
    }
};
struct EpiNull {
    static constexpr bool PERM = true, AFTER_DRAIN = false, KHOOK = false;
    __device__ __forceinline__ void operator()(const f32x4 (&acc)[2][2][4][2], const Unit& u, int wr, int wc, int fr, int fq) const {
#pragma unroll
        for (int ai = 0; ai < 2; ++ai)
#pragma unroll
            for (int bj = 0; bj < 2; ++bj)
#pragma unroll
                for (int m = 0; m < 4; ++m) asm volatile("" :: "v"(acc[ai][bj][m][0]), "v"(acc[ai][bj][m][1]));
    }
};
struct OrderG1 {
    StaticOrder so; int pm0, nkv;
    __device__ void init(int hb, int G, int c) { so.init(HB_ROWS, NIN, G, c); pm0 = hb * (HB_ROWS / BM); nkv = hb == 0 ? (MMEM / BM) * 4 : 0; }
    __device__ bool next(int i, Unit& u) const {
        if (so.next(i, u)) { u.pm += pm0; return true; }
        const long j = (long)i * so.G + so.c - so.nwg; if (j < 0 || j >= nkv) return false;
        u.pm = 256 + (int)(j >> 2); u.pn = 35 + (int)(j & 3); return true;
    }
    __device__ __forceinline__ void a_ready(const Unit&) const {}
    __device__ __forceinline__ void done(const Unit&) const {}
};
}

#define GAS __attribute__((address_space(1)))
#define LAS __attribute__((address_space(3)))
typedef unsigned short bf16;
typedef unsigned v4u __attribute__((ext_vector_type(4)));
typedef float f32x4 __attribute__((ext_vector_type(4)));
typedef short bf16x8 __attribute__((ext_vector_type(8)));
typedef GAS unsigned gu32;
typedef GAS unsigned long long gu64;
#define RLX_AGENT __ATOMIC_RELAXED, __HIP_MEMORY_SCOPE_AGENT
#define LDS_WAIT() asm volatile("s_waitcnt lgkmcnt(0)" ::: "memory")
#define VM_WAIT() asm volatile("s_waitcnt vmcnt(0)" ::: "memory")
__device__ __forceinline__ unsigned long long rt() { return __builtin_amdgcn_s_memrealtime(); }
__device__ __forceinline__ unsigned f2bf(float f) { unsigned u = __builtin_bit_cast(unsigned, f); return (u + 0x7fffu + ((u >> 16) & 1u)) >> 16; }
__device__ __forceinline__ unsigned pk2(float lo, float hi) { return f2bf(lo) | (f2bf(hi) << 16); }

__device__ __forceinline__ int hw_lane() { int l; asm volatile("v_mbcnt_lo_u32_b32 %0, -1, 0\n\tv_mbcnt_hi_u32_b32 %0, -1, %0" : "=v"(l)); return l; }
__device__ __forceinline__ bool hw_thread0(int wave) { return wave == 0 && hw_lane() == 0; }
#define XB_TMO      128
#define XB_XCNT(j)  (256  + 64 * (j))
#define XB_XSUB(j)  (1280 + 64 * (j))
#define XB_XGEN(j)  (2304 + 64 * (j))
#define XB_TOP      3328
#define XB_TOPGEN   3392
#define XCD_BAR_WORDS 3456
#define XB_SPIN_CAP (1u << 18)

__device__ __forceinline__ unsigned xb_ld(unsigned* p)              { return __hip_atomic_load(p, __ATOMIC_RELAXED, __HIP_MEMORY_SCOPE_AGENT); }
__device__ __forceinline__ unsigned xb_add(unsigned* p, unsigned v) { return __hip_atomic_fetch_add(p, v, __ATOMIC_RELAXED, __HIP_MEMORY_SCOPE_AGENT); }
__device__ __forceinline__ unsigned xb_xcc_id() { return (unsigned)__builtin_amdgcn_s_getreg((3 << 11) | 20) & 0xFu; }
#define XB_SPIN(cond, bar) do { unsigned _sp = 0; while (cond) { __builtin_amdgcn_s_sleep(1); \
    if ((++_sp & 255u) == 0u) { if (xb_ld(&(bar)[XB_TMO])) break; if (_sp > XB_SPIN_CAP) { atomicAdd(&(bar)[XB_TMO], 1u); break; } } } } while (0)

struct XcdBarrier {
    unsigned* bar; unsigned x; int wave;
    volatile LAS unsigned* st;
};

__device__ __forceinline__ XcdBarrier xcd_barrier_post(unsigned* bar, volatile LAS unsigned* st, int wave) {
    XcdBarrier b; b.bar = bar; b.x = xb_xcc_id(); b.st = st; b.wave = wave;
    if (hw_thread0(wave)) (void)xb_add(&bar[XB_XCNT(b.x)], 1u);
    return b;
}
__device__ __forceinline__ void xcd_barrier_complete(unsigned* bar, unsigned x, unsigned& nloc, unsigned& nx) {
    const unsigned G = gridDim.x * gridDim.y * gridDim.z;
    unsigned sum, cnt, mine, sp = 0u;
    for (;;) {
        sum = 0u; cnt = 0u; mine = 0u;
#pragma unroll
        for (unsigned j = 0; j < 16; ++j) { const unsigned c = xb_ld(&bar[XB_XCNT(j)]); sum += c; cnt += (c > 0u) ? 1u : 0u; mine = (j == x) ? c : mine; }
        if (sum == G) break;
        __builtin_amdgcn_s_sleep(1);
        if ((++sp & 255u) == 0u) { if (xb_ld(&bar[XB_TMO])) break; if (sp > XB_SPIN_CAP) { atomicAdd(&bar[XB_TMO], 1u); break; } }
    }
    nloc = mine > 0u ? mine : 1u; nx = cnt > 0u ? cnt : 1u;
}

__device__ __forceinline__ void xcd_barrier(const XcdBarrier& b) {
    asm volatile("s_waitcnt vmcnt(0)" ::: "memory");
    __syncthreads();
    if (hw_thread0(b.wave)) {
        unsigned* bar = b.bar;
        __builtin_amdgcn_s_waitcnt(0);
        unsigned nloc = b.st[0], nx = b.st[1];
        if (nloc == 0u) { xcd_barrier_complete(bar, b.x, nloc, nx); b.st[0] = nloc; b.st[1] = nx; }
        const unsigned old = xb_add(&bar[XB_XSUB(b.x)], 1u);
        const unsigned gen = old / nloc;
        if (old + 1u == (gen + 1u) * nloc) {
            __builtin_amdgcn_fence(__ATOMIC_RELEASE, "agent");
            asm volatile("s_waitcnt vmcnt(0)" ::: "memory");
            const unsigned og = xb_add(&bar[XB_TOP], 1u);
            const unsigned tg = og / nx;
            if (og + 1u == (tg + 1u) * nx) xb_add(&bar[XB_TOPGEN], 1u);
            else XB_SPIN(xb_ld(&bar[XB_TOPGEN]) == tg, bar);
            __builtin_amdgcn_fence(__ATOMIC_ACQUIRE, "agent");
            xb_add(&bar[XB_XGEN(b.x)], 1u);
            asm volatile("s_waitcnt vmcnt(0)" ::: "memory");
        } else {
            XB_SPIN(xb_ld(&bar[XB_XGEN(b.x)]) == gen, bar);
            __builtin_amdgcn_fence(__ATOMIC_ACQUIRE, "agent");
            asm volatile("s_waitcnt vmcnt(0)" ::: "memory");
        }
    }
    __syncthreads();
}

__device__ __forceinline__ float wave_sum(float v) {
#pragma unroll
    for (int o = 1; o < 64; o <<= 1) v += __shfl_xor(v, o);
    return v;
}

constexpr int RING_OFF = 0, RING_BYTES = 131072;
constexpr int LDSCTL_OFF = RING_BYTES, MISC_OFF = LDSCTL_OFF + 320;
constexpr int LDS_BYTES = 147456;
constexpr int NWAVES = 8, NTHR = NWAVES * 64;
constexpr int WSCR_OFF = 132096;

__device__ __forceinline__ float bf2f(bf16 h) { return __builtin_bit_cast(float, (unsigned)h << 16); }
__device__ __forceinline__ float sigm_f(float x) { return 1.f / (1.f + __expf(-x)); }
__device__ __forceinline__ int t5_bucket(int d) {
    if (d < 16) return d;
    int b = 16;
    b += d >= 22; b += d >= 30; b += d >= 40; b += d >= 54; b += d >= 73; b += d >= 99; b += d >= 134; b += d >= 182; b += d >= 246; b += d >= 332; b += d >= 450; b += d >= 609; b += d >= 825; b += d >= 1117; b += d >= 1513;
    return b;
}

struct Ctx {
    const float *x, *mem, *norm_w, *w_in, *gate_b, *lnw, *lnb, *sp_w, *sp_b, *bqw, *bkw, *rel_bias, *mem_norm_w, *m_w_kv, *mqw, *mkw, *proj_a, *proj_b, *proj_m, *w_out;
    float* out;
    bf16 *WIN, *PCAT, *WOUT, *WSP, *XN, *PA, *KVM, *OG, *YC, *MRG; float *BIAS, *BIASX, *SS, *MKSS, *LSE, *LNST;
    LAS unsigned char* lds; int tid, lane, wave, G, gtid, T, gwave, NW, xgwave;
};

__device__ __forceinline__ void p0_transpose_item(const float* W, int N, bf16* WT, int ldt, int row_off, int koff, LAS float* scr, int item, int lane, bool gperm = false) {
    const int nblk = N / 32, kb = item / nblk, nb = item % nblk, k0 = 64 * kb, n0 = 32 * nb;
#pragma unroll 8
    for (int i = 0; i < 32; ++i) { const int kk = 2 * i + (lane >> 5); scr[kk * 33 + (lane & 31)] = W[(size_t)(k0 + kk) * N + n0 + (lane & 31)]; }
    LDS_WAIT(); asm volatile("" ::: "memory");
    const int c = lane & 7;
#pragma unroll
    for (int j = 0; j < 4; ++j) { const int n = (lane >> 3) + 8 * j; const LAS float* s = scr + (8 * c) * 33 + n;
        v4u o; o.x = pk2(s[0 * 33], s[1 * 33]); o.y = pk2(s[2 * 33], s[3 * 33]); o.z = pk2(s[4 * 33], s[5 * 33]); o.w = pk2(s[6 * 33], s[7 * 33]);
        int nn = n0 + n;
        if (gperm) {
            if (nn >= C_G) nn = (nn & ~255) + 128 * ((nn >> 3) & 1) + 32 * ((nn >> 6) & 3) + 8 * ((nn >> 4) & 3) + (nn & 7);
            else if (nn < C_AV) { const int T = nn >> 7; nn = 256 * (T < 3 ? T : T + 3) + (nn & 127); }
            else if (nn >= C_AZ && nn < C_BQ) { const int c = nn - C_AZ, T = c >> 7; nn = 256 * (T < 3 ? T : T + 3) + 128 + (c & 127); }
        }
        *(GAS v4u*)(WT + (size_t)(row_off + nn) * ldt + koff + k0 + 8 * c) = o; }
    LDS_WAIT(); asm volatile("" ::: "memory");
}
template <int NR> __device__ __forceinline__ void rms_rows_to_bf16(const float* src, const float* w, bf16* dst, size_t m0, size_t stride, int lane) {
    f32x4 v[NR][4]; float s[NR];
#pragma unroll
    for (int r = 0; r < NR; ++r) { const GAS f32x4* xr = (const GAS f32x4*)(src + (m0 + r * stride) * DM) + lane;
#pragma unroll
        for (int j = 0; j < 4; ++j) v[r][j] = __builtin_nontemporal_load(xr + 64 * j); }
    f32x4 ww[4];
#pragma unroll
    for (int j = 0; j < 4; ++j) ww[j] = ((const GAS f32x4*)w + lane)[64 * j];
#pragma unroll
    for (int r = 0; r < NR; ++r) { float a = 0.f;
#pragma unroll
        for (int j = 0; j < 4; ++j) a += (v[r][j].x * v[r][j].x + v[r][j].y * v[r][j].y) + (v[r][j].z * v[r][j].z + v[r][j].w * v[r][j].w);
        s[r] = rsqrtf(wave_sum(a) * (1.f / DM) + EPS); }
#pragma unroll
    for (int r = 0; r < NR; ++r) { GAS unsigned long long* o8 = (GAS unsigned long long*)(dst + (m0 + r * stride) * DM) + lane;
#pragma unroll
        for (int j = 0; j < 4; ++j) o8[64 * j] = (unsigned long long)pk2(v[r][j].x * s[r] * ww[j].x, v[r][j].y * s[r] * ww[j].y) | ((unsigned long long)pk2(v[r][j].z * s[r] * ww[j].z, v[r][j].w * s[r] * ww[j].w) << 32); }
}
__device__ __forceinline__ void p0_prologue(Ctx& F) {
    LAS float* scr = (LAS float*)(F.lds + RING_OFF + F.wave * 16384);
    constexpr int I_IN = 16 * (NIN / 32), I_KV = 16 * 32, I_PA = 12 * 32, I_PB = 4 * 32, I_PM = 8 * 32, I_WO = 16 * 32;
    constexpr int NITEMS = I_IN + I_KV + I_PA + I_PB + I_PM + I_WO;
    for (int it = F.gwave; it < NITEMS; it += F.NW) {
        int r = it;
        if (r < I_IN) { p0_transpose_item(F.w_in, NIN, F.WIN, DM, 0, 0, scr, r, F.lane, true); continue; } r -= I_IN;
        if (r < I_KV) { p0_transpose_item(F.m_w_kv, 1024, F.WIN, DM, NIN, 0, scr, r, F.lane); continue; } r -= I_KV;
        if (r < I_PA) { p0_transpose_item(F.proj_a, DM, F.PCAT, KC, 0, 0, scr, r, F.lane); continue; } r -= I_PA;
        if (r < I_PB) { p0_transpose_item(F.proj_b, DM, F.PCAT, KC, 0, 768, scr, r, F.lane); continue; } r -= I_PB;
        if (r < I_PM) { p0_transpose_item(F.proj_m, DM, F.PCAT, KC, 0, 1024, scr, r, F.lane); continue; } r -= I_PM;
        p0_transpose_item(F.w_out, DM, F.WOUT, DM, 0, 0, scr, r, F.lane);
    }
    for (int i = F.gtid; i < 4 * 128 * 128; i += F.T) { const int t = (i >> 7) & 127, s = i & 127; F.WSP[i] = (bf16)(s <= t ? f2bf(F.sp_w[i]) : 0u); }
    for (int i = F.gtid; i < 3 * 4 * 132; i += F.T) { const int g = i / (4 * 132), h = (i / 132) % 4, j = i % 132; const int dil = g == 0 ? 1 : (g == 1 ? 4 : 16);
        F.BIAS[i] = j <= 128 ? F.rel_bias[t5_bucket(j * dil) * 12 + 4 * g + h] : 0.f; }
    for (int i = F.gtid; i < 3 * 4 * 192; i += F.T) { const int g = i / (4 * 192), h = (i / 192) % 4, step = i % 192 - 31; const int dil = g == 0 ? 1 : (g == 1 ? 4 : 16);
        F.BIASX[i] = (step >= 0 && step <= 128) ? F.rel_bias[t5_bucket(step * dil) * 12 + 4 * g + h] * 1.4426950408889634f : -1e30f; }
    if ((MTOT % (4 * F.NW)) == 0 && (MMEM % (4 * F.NW)) == 0) {
        for (size_t m = F.gwave; m < (size_t)MTOT; m += 4 * (size_t)F.NW) rms_rows_to_bf16<4>(F.x, F.norm_w, F.XN, m, F.NW, F.lane);
        for (size_t m = F.gwave; m < (size_t)MMEM; m += 4 * (size_t)F.NW) rms_rows_to_bf16<4>(F.mem, F.mem_norm_w, F.XN + (size_t)MTOT * DM, m, F.NW, F.lane);
    } else {
        for (size_t m = F.gwave; m < (size_t)MTOT; m += F.NW) rms_rows_to_bf16<1>(F.x, F.norm_w, F.XN, m, 0, F.lane);
        for (size_t m = F.gwave; m < (size_t)MMEM; m += F.NW) rms_rows_to_bf16<1>(F.mem, F.mem_norm_w, F.XN + (size_t)MTOT * DM, m, 0, F.lane);
    }
}


typedef float f32x16 __attribute__((ext_vector_type(16)));
typedef short s16x4 __attribute__((ext_vector_type(4)));
__device__ __forceinline__ int crow(int r, int hi) { return (r & 3) + 8 * (r >> 2) + 4 * hi; }
__device__ __forceinline__ unsigned cvtpk(float lo, float hi) { return pg8::cvt_pk_bf16(lo, hi); }
__device__ __forceinline__ s16x4 vtr(const LAS unsigned char* p) { typedef short v4i16_t __attribute__((ext_vector_type(4))); return __builtin_bit_cast(s16x4, __builtin_amdgcn_ds_read_tr16_b64_v4i16((LAS v4i16_t*)p)); }
__device__ __forceinline__ float bflo(unsigned w) { return __uint_as_float(w << 16); }
__device__ __forceinline__ float bfhi(unsigned w) { return __uint_as_float(w & 0xffff0000u); }
constexpr float LOG2E = 1.4426950408889634f, LN2 = 0.6931471805599453f;
constexpr int NBX = 192;


__device__ __forceinline__ void dma16(const void* gsrc, LAS unsigned char* ldst) { __builtin_amdgcn_global_load_lds((const unsigned*)gsrc, (LAS unsigned*)ldst, 16, 0, 0); }
#define VM_WAIT0() asm volatile("s_waitcnt vmcnt(0)" ::: "memory")
__device__ __forceinline__ void st_mixA_mfma(Ctx& F) {
    const int lane = hw_lane(), r32 = lane & 31, hi = lane >> 5, tid = F.wave * 64 + lane;
    LAS unsigned char* wl = F.lds + RING_OFF + F.wave * 16384;
    typedef float f32x2v __attribute__((ext_vector_type(2))); typedef unsigned u32x2v __attribute__((ext_vector_type(2)));
    LAS f32x2v* tab = (LAS f32x2v*)(F.lds + WSCR_OFF + 8192);
    const int g = F.wave >> 1, ch = lane & 3;
    bf16x8 wf[14];
    const bf16* wrow0 = F.WSP + (size_t)(g * 128 + r32) * 128 + 8 * hi;
    { int n = 0;
#pragma unroll
      for (int tb = 2; tb < 4; ++tb)
#pragma unroll
          for (int ks = 0; ks < 2 * (tb + 1); ++ks) wf[n++] = *(const bf16x8*)(wrow0 + (size_t)tb * 32 * 128 + 16 * ks); }
    for (int unit = blockIdx.x; unit < HB_ROWS / 128; unit += F.G) {
        const int rowbase = unit * 128;
        v4u raw[8];
        { const int c0 = g * 192 + (F.wave & 1) * 96;
#pragma unroll
          for (int i = 0; i < 8; ++i) raw[i] = *(const v4u*)(F.PA + (size_t)(rowbase + (lane >> 2) + 16 * i) * PAP + C_AV + c0 + 8 * ch); }
        { const int row = tid >> 2, part = tid & 3; const float* sp = F.SS + (size_t)(rowbase + row) * SS_W + 12 * part; float s = 0.f, q = 0.f;
#pragma unroll
          for (int k = 0; k < 6; ++k) { s += sp[2 * k]; q += sp[2 * k + 1]; }
          s += __shfl_xor(s, 1); s += __shfl_xor(s, 2); q += __shfl_xor(q, 1); q += __shfl_xor(q, 2);
          const float mu = s * (1.f / 768.f), var = q * (1.f / 768.f) - mu * mu;
          if (part == 0) tab[row] = (f32x2v){mu, rsqrtf(fmaxf(var, 0.f) + EPS)}; }
        __syncthreads();
#pragma unroll 1
        for (int cbi = 0; cbi < 3; ++cbi) {
            const int c0 = g * 192 + ((F.wave & 1) * 3 + cbi) * 32;
            const f32x4 w0 = *(const f32x4*)(F.lnw + c0 + 8 * ch), w1 = *(const f32x4*)(F.lnw + c0 + 8 * ch + 4), b0 = *(const f32x4*)(F.lnb + c0 + 8 * ch), b1 = *(const f32x4*)(F.lnb + c0 + 8 * ch + 4);
#pragma unroll
            for (int i = 0; i < 8; ++i) { const int s = (lane >> 2) + 16 * i; const f32x2v st = tab[s]; const v4u rw = raw[i]; v4u o;
                o.x = cvtpk((bflo(rw.x) - st.x) * st.y * w0.x + b0.x, (bfhi(rw.x) - st.x) * st.y * w0.y + b0.y); o.y = cvtpk((bflo(rw.y) - st.x) * st.y * w0.z + b0.z, (bfhi(rw.y) - st.x) * st.y * w0.w + b0.w);
                o.z = cvtpk((bflo(rw.z) - st.x) * st.y * w1.x + b1.x, (bfhi(rw.z) - st.x) * st.y * w1.y + b1.y); o.w = cvtpk((bflo(rw.w) - st.x) * st.y * w1.z + b1.z, (bfhi(rw.w) - st.x) * st.y * w1.w + b1.w);
                *(LAS v4u*)(wl + (s >> 3) * 512 + (s & 7) * 64 + ch * 16) = o; }
            if (cbi < 2) {
#pragma unroll
                for (int i = 0; i < 8; ++i) raw[i] = *(const v4u*)(F.PA + (size_t)(rowbase + (lane >> 2) + 16 * i) * PAP + C_AV + c0 + 32 + 8 * ch); }
            LAS unsigned char* uzb = wl + 8192;
#pragma unroll
            for (int p = 0; p < 8; ++p) { const int row_ = 16 * p + (lane >> 2);
                dma16(F.PA + (size_t)(rowbase + row_) * PAP + C_AU + c0 + 8 * ((lane & 3) ^ ((row_ >> 2) & 3)), uzb + p * 1024); }
            const LAS unsigned char* vb = wl + hi * 512 + ((lane & 15) >> 2) * 64 + ((lane >> 4) & 1) * 32 + (lane & 3) * 8;
            const bf16* wr2 = wrow0; asm volatile("" : "+v"(wr2));
            bf16x8 wq[6];
            { int n2 = 0;
#pragma unroll
              for (int tb = 0; tb < 2; ++tb)
#pragma unroll
                  for (int ks = 0; ks < 2 * (tb + 1); ++ks) wq[n2++] = *(const bf16x8*)(wr2 + (size_t)tb * 32 * 128 + 16 * ks); }
            int n = 0, nq = 0;
#pragma unroll
            for (int tb = 0; tb < 4; ++tb) { f32x16 acc = {};
#pragma unroll
                for (int ks = 0; ks < 2 * (tb + 1); ++ks) { const s16x4 a = vtr(vb + ks * 1024), c = vtr(vb + ks * 1024 + 256); const bf16x8 af = {a[0], a[1], a[2], a[3], c[0], c[1], c[2], c[3]};
                    acc = __builtin_amdgcn_mfma_f32_32x32x16_bf16(af, tb < 2 ? wq[nq++] : wf[n++], acc, 0, 0, 0); }
                const int t = 32 * tb + r32; const float sb = F.sp_b[g * 128 + t];
                if (tb == 0) VM_WAIT0();
                LAS unsigned char* urow = uzb + t * 64 + 8 * hi; const int fsw = (r32 >> 2) & 3;
#pragma unroll
                for (int i = 0; i < 4; ++i) { LAS u32x2v* up = (LAS u32x2v*)(urow + ((i ^ fsw) * 16)); const u32x2v u = *up; u32x2v w;
                    w.x = cvtpk(bflo(u.x) * (acc[4 * i] + sb), bfhi(u.x) * (acc[4 * i + 1] + sb)); w.y = cvtpk(bflo(u.y) * (acc[4 * i + 2] + sb), bfhi(u.y) * (acc[4 * i + 3] + sb));
                    *up = w; }
#pragma unroll
                for (int jr = 0; jr < 2; ++jr) { const int row_ = 32 * tb + 16 * jr + (lane >> 2); const v4u yv = *(const LAS v4u*)(uzb + row_ * 64 + (lane & 3) * 16);
                    *(v4u*)(F.YC + (size_t)(rowbase + row_) * KC + c0 + 8 * ((lane & 3) ^ ((row_ >> 2) & 3))) = yv; } }
        }
        __syncthreads();
    }
}

__device__ __forceinline__ void st_mergeB_vec(Ctx& F) {
    constexpr int NI = 4;
    const int total = HB_ROWS * 32;
    for (int g0 = F.gtid; g0 < total; g0 += NI * F.T) {
        v4u a[NI], b[NI], c[NI], z[NI]; float l0[NI], l1[NI], l2[NI];
#pragma unroll
        for (int i = 0; i < NI; ++i) { const int gid = g0 + i * F.T < total ? g0 + i * F.T : g0; const int r = gid >> 5, c8 = (gid & 31) * 8, h = c8 >> 6;
            l0[i] = F.LSE[((size_t)0 * HB_ROWS + r) * 4 + h]; l1[i] = F.LSE[((size_t)1 * HB_ROWS + r) * 4 + h]; l2[i] = F.LSE[((size_t)2 * HB_ROWS + r) * 4 + h];
            a[i] = *(const v4u*)(F.OG + ((size_t)0 * HB_ROWS + r) * 256 + c8); b[i] = *(const v4u*)(F.OG + ((size_t)1 * HB_ROWS + r) * 256 + c8); c[i] = *(const v4u*)(F.OG + ((size_t)2 * HB_ROWS + r) * 256 + c8);
            z[i] = *(const v4u*)(F.PA + (size_t)r * PAP + C_BZ + c8); }
        __builtin_amdgcn_sched_barrier(0);
#pragma unroll
        for (int i = 0; i < NI; ++i) { if (g0 + i * F.T >= total) break; const int gid = g0 + i * F.T; const int r = gid >> 5, c8 = (gid & 31) * 8;
            const float mx = fmaxf(l0[i], fmaxf(l1[i], l2[i])); float e0 = __expf(l0[i] - mx), e1 = __expf(l1[i] - mx), e2 = __expf(l2[i] - mx); const float inv = 1.f / (e0 + e1 + e2); e0 *= inv; e1 *= inv; e2 *= inv;
            v4u o;
#define MB_1(X) X = pk2((e0 * bflo(a[i].X) + e1 * bflo(b[i].X) + e2 * bflo(c[i].X)) * bflo(z[i].X), (e0 * bfhi(a[i].X) + e1 * bfhi(b[i].X) + e2 * bfhi(c[i].X)) * bfhi(z[i].X))
            o.MB_1(x); o.MB_1(y); o.MB_1(z); o.MB_1(w);
#undef MB_1
            *(v4u*)(F.YC + (size_t)r * KC + 768 + c8) = o; }
    }
}


__device__ __forceinline__ void st_attnM_v3(Ctx& F, int hb) {
    const int lane = hw_lane(), r32 = lane & 31, hi = lane >> 5;
    LAS unsigned char* kimg = F.lds + RING_OFF; LAS unsigned char* vimg = F.lds + RING_OFF + 65536;
    LAS float* kstab = (LAS float*)(F.lds + WSCR_OFF + 8192);
    typedef unsigned u32x2v __attribute__((ext_vector_type(2)));
    const int vcu = F.xgwave >> 3;
    __syncthreads();
    for (int task = vcu; task < 256; task += F.G) {
        const int bh = task >> 2, b = bh >> 2, h = bh & 3; const size_t kbase = (size_t)(hb * 16 + b) * MEML;
#pragma unroll
        for (int j = 0; j < 8; ++j) { const int p = F.wave * 8 + j, row = 4 * p + (lane >> 4);
            dma16(F.KVM + (kbase + row) * 1024 + h * 128 + 8 * ((lane & 15) ^ (row & 15)), kimg + p * 1024);
            dma16(F.KVM + (kbase + 8 * (p >> 1) + ((lane & 31) >> 2)) * 1024 + 512 + h * 128 + (2 * (p & 1) + (lane >> 5)) * 32 + (lane & 3) * 8, vimg + p * 1024); }
        { const int key = F.wave * 32 + r32; const float* sp = F.MKSS + (kbase + key) * 16 + 4 * h;
          const float ksv = rsqrtf(((sp[0] + sp[1]) + (sp[2] + sp[3])) * (1.f / 128.f) + EPS); if (lane < 32) kstab[key] = ksv; }
        VM_WAIT0(); __syncthreads();
#pragma unroll 1
        for (int qi = 0; qi < 2; ++qi) {
            const int qb = (task & 3) * 16 + F.wave * 2 + qi;
            const size_t qrow = (size_t)(b * SEQ + qb * 32 + r32);
            const float qs = rsqrtf(((F.SS[qrow * SS_W + 96 + 4 * h] + F.SS[qrow * SS_W + 96 + 4 * h + 1]) + (F.SS[qrow * SS_W + 96 + 4 * h + 2] + F.SS[qrow * SS_W + 96 + 4 * h + 3])) * (1.f / 128.f) + EPS) * (0.08838834764831845f * LOG2E);
            bf16x8 qf[8];
#pragma unroll
            for (int d0 = 0; d0 < 8; ++d0) { const int dd = 16 * d0 + 8 * hi;
                const v4u raw = *(const v4u*)(F.PA + qrow * PAP + C_MQ + h * 128 + dd);
                const f32x4 wa = *(const f32x4*)(F.mqw + dd), wb = *(const f32x4*)(F.mqw + dd + 4), ka = *(const f32x4*)(F.mkw + dd), kb = *(const f32x4*)(F.mkw + dd + 4);
                v4u o;
                o.x = cvtpk(bflo(raw.x) * qs * wa.x * ka.x, bfhi(raw.x) * qs * wa.y * ka.y); o.y = cvtpk(bflo(raw.y) * qs * wa.z * ka.z, bfhi(raw.y) * qs * wa.w * ka.w);
                o.z = cvtpk(bflo(raw.z) * qs * wb.x * kb.x, bfhi(raw.z) * qs * wb.y * kb.y); o.w = cvtpk(bflo(raw.w) * qs * wb.z * kb.z, bfhi(raw.w) * qs * wb.w * kb.w);
                qf[d0] = __builtin_bit_cast(bf16x8, o); }
            u32x2v zz[4][4];
#pragma unroll
            for (int db = 0; db < 4; ++db)
#pragma unroll
                for (int i = 0; i < 4; ++i) zz[db][i] = *(const u32x2v*)(F.PA + qrow * PAP + C_MZ + h * 128 + 4 * hi + db * 32 + 8 * i);
            float mrun = -1e30f, lrun = 0.f; f32x16 o0 = {}, o1 = {}, o2 = {}, o3 = {};
            const LAS unsigned char* kb0 = kimg + r32 * 256; const int ksw = r32 & 15;
            const LAS unsigned char* vb0 = vimg + (4 * hi + ((lane & 15) >> 2)) * 64 + ((lane >> 4) & 1) * 32 + (lane & 3) * 8;
#pragma unroll 2
            for (int t = 0; t < MEML / 32; ++t) {
                f32x16 st = {};
#pragma unroll
                for (int d0 = 0; d0 < 8; ++d0) { const bf16x8 kf = *(const LAS bf16x8*)(kb0 + t * 8192 + (((2 * d0 + hi) ^ ksw) * 16)); st = __builtin_amdgcn_mfma_f32_32x32x16_bf16(kf, qf[d0], st, 0, 0, 0); }
                float tmax = -1e30f;
#pragma unroll
                for (int i = 0; i < 4; ++i) { const f32x4 kk = *(const LAS f32x4*)(kstab + 32 * t + 8 * i + 4 * hi);
#pragma unroll
                    for (int j = 0; j < 4; ++j) { const float s = st[4 * i + j] * kk[j]; st[4 * i + j] = s; tmax = fmaxf(tmax, s); } }
                tmax = fmaxf(tmax, __shfl_xor(tmax, 32));
                const float mnew = fmaxf(mrun, tmax), alpha = __builtin_amdgcn_exp2f(mrun - mnew); mrun = mnew;
                float psum = 0.f;
#pragma unroll
                for (int r = 0; r < 16; ++r) { st[r] = __builtin_amdgcn_exp2f(st[r] - mnew); psum += st[r]; }
                lrun = lrun * alpha + psum;
#pragma unroll
                for (int r = 0; r < 16; ++r) { o0[r] *= alpha; o1[r] *= alpha; o2[r] *= alpha; o3[r] *= alpha; }
                v4u p0, p1;
                p0.x = cvtpk(st[0], st[1]); p0.y = cvtpk(st[2], st[3]); p0.z = cvtpk(st[4], st[5]); p0.w = cvtpk(st[6], st[7]);
                p1.x = cvtpk(st[8], st[9]); p1.y = cvtpk(st[10], st[11]); p1.z = cvtpk(st[12], st[13]); p1.w = cvtpk(st[14], st[15]);
                const LAS unsigned char* vb = vb0 + t * 8192;
#define AM_PV(OX, DB) do { _Pragma("unroll") for (int s = 0; s < 2; ++s) { const bf16x8 pf = __builtin_bit_cast(bf16x8, s == 0 ? p0 : p1); \
                    const s16x4 a = vtr(vb + (2 * s) * 2048 + (DB) * 512), c = vtr(vb + (2 * s + 1) * 2048 + (DB) * 512); const bf16x8 vf = {a[0], a[1], a[2], a[3], c[0], c[1], c[2], c[3]}; \
                    OX = __builtin_amdgcn_mfma_f32_32x32x16_bf16(vf, pf, OX, 0, 0, 0); } } while (0)
                AM_PV(o0, 0); AM_PV(o1, 1); AM_PV(o2, 2); AM_PV(o3, 3);
#undef AM_PV
            }
            const float ltot = lrun + __shfl_xor(lrun, 32), inv = 1.f / ltot;
            bf16* yrow = F.YC + qrow * KC + 1024 + h * 128 + 4 * hi;
#define AM_ST(OX, DB) do { _Pragma("unroll") for (int i = 0; i < 4; ++i) { const u32x2v z = zz[DB][i]; u32x2v w; \
                w.x = cvtpk(OX[4 * i] * inv * bflo(z.x), OX[4 * i + 1] * inv * bfhi(z.x)); w.y = cvtpk(OX[4 * i + 2] * inv * bflo(z.y), OX[4 * i + 3] * inv * bfhi(z.y)); \
                *(u32x2v*)(yrow + (DB) * 32 + 8 * i) = w; } } while (0)
            AM_ST(o0, 0); AM_ST(o1, 1); AM_ST(o2, 2); AM_ST(o3, 3);
#undef AM_ST
        }
        __syncthreads();
    }
}

__device__ __forceinline__ void st_attnB_v3(Ctx& F) {
    const int lane = hw_lane(), r32 = lane & 31, hi = lane >> 5, tid = F.wave * 64 + lane;
    LAS unsigned char* kimg = F.lds + RING_OFF; LAS unsigned char* vimg = F.lds + RING_OFF + 49152;
    LAS float* kstab = (LAS float*)(F.lds + RING_OFF + 98304);
    LAS float* btab = (LAS float*)(F.lds + RING_OFF + 98304 + 2048);
    typedef unsigned u32x2v __attribute__((ext_vector_type(2)));
    const int vcu = F.xgwave >> 3;
    unsigned tch0 = 0u, tch1 = 0u;
    __syncthreads();
    for (int unit = vcu; unit < 3 * 16 * 4 * 8; unit += F.G) {
        const int k = unit & 7, h = (unit >> 3) & 3, b = (unit >> 5) & 15, g = unit >> 9, hh = 4 * g + h;
        const int dil = g == 0 ? 1 : (g == 1 ? 4 : 16);
        const int res0 = g == 0 ? 0 : (g == 1 ? (k >> 1) : 2 * k), j0 = g == 0 ? 8 * k : (g == 1 ? 8 * (k & 1) : 0);
#pragma unroll
        for (int i = 0; i < 12; ++i) { const int q = F.wave * 12 + i, s = q >> 3, pc = q & 7, p = pc & 3;
            int res, jt; bool valid;
            if (g < 2) { res = res0; jt = j0 - 4 + s; valid = jt >= 0; } else { res = res0 + (s >> 2); jt = s & 3; valid = s < 8; }
            if (valid) {
                if (pc < 4) { const int row = 8 * p + (lane >> 3); const size_t trow = (size_t)(b * SEQ + res + (32 * jt + row) * dil);
                    dma16(F.PA + trow * PAP + C_BK + hh * 64 + 8 * ((lane & 7) ^ ((row >> 1) & 7)), kimg + s * 4096 + p * 1024); }
                else { const int key = 8 * p + ((lane & 31) >> 2); const size_t trow = (size_t)(b * SEQ + res + (32 * jt + key) * dil);
                    dma16(F.PA + trow * PAP + C_BV + hh * 64 + (lane >> 5) * 32 + (lane & 3) * 8, vimg + s * 4096 + p * 1024); } } }
        if (tid < 384) { const int s = tid >> 5, kk = tid & 31; int res, jt; bool valid;
            if (g < 2) { res = res0; jt = j0 - 4 + s; valid = jt >= 0; } else { res = res0 + (s >> 2); jt = s & 3; valid = s < 8; }
            if (valid) { const size_t trow = (size_t)(b * SEQ + res + (32 * jt + kk) * dil);
                kstab[tid] = rsqrtf((F.SS[trow * SS_W + 72 + 2 * hh] + F.SS[trow * SS_W + 72 + 2 * hh + 1]) * (1.f / 64.f) + EPS); } }
        if (tid < NBX) btab[tid] = F.BIASX[(g * 4 + h) * NBX + tid];
        const int wres = g < 2 ? res0 : res0 + (F.wave >> 2), j = g < 2 ? j0 + F.wave : (F.wave & 3);
        const int sbase = g < 2 ? 4 - j0 : (F.wave >> 2) * 4;
        const size_t qrow = (size_t)(b * SEQ + wres + (32 * j + r32) * dil);
        const float qs = rsqrtf((F.SS[qrow * SS_W + 48 + 2 * hh] + F.SS[qrow * SS_W + 48 + 2 * hh + 1]) * (1.f / 64.f) + EPS) * (0.125f * LOG2E);
        bf16x8 qf[4];
#pragma unroll
        for (int d0 = 0; d0 < 4; ++d0) { const int dd = 16 * d0 + 8 * hi;
            const v4u raw = *(const v4u*)(F.PA + qrow * PAP + C_BQ + hh * 64 + dd);
            const f32x4 wa = *(const f32x4*)(F.bqw + dd), wb = *(const f32x4*)(F.bqw + dd + 4), ka = *(const f32x4*)(F.bkw + dd), kb = *(const f32x4*)(F.bkw + dd + 4);
            v4u o;
            o.x = cvtpk(bflo(raw.x) * qs * wa.x * ka.x, bfhi(raw.x) * qs * wa.y * ka.y); o.y = cvtpk(bflo(raw.y) * qs * wa.z * ka.z, bfhi(raw.y) * qs * wa.w * ka.w);
            o.z = cvtpk(bflo(raw.z) * qs * wb.x * kb.x, bfhi(raw.z) * qs * wb.y * kb.y); o.w = cvtpk(bflo(raw.w) * qs * wb.z * kb.z, bfhi(raw.w) * qs * wb.w * kb.w);
            qf[d0] = __builtin_bit_cast(bf16x8, o); }
        VM_WAIT0(); __syncthreads();
        asm volatile("" :: "v"(tch0), "v"(tch1));
        { const int un = unit + F.G;
          if (un < 3 * 16 * 4 * 8 && tid < 384) { const int k2 = un & 7, h2 = (un >> 3) & 3, b2 = (un >> 5) & 15, g2 = un >> 9, hh2 = 4 * g2 + h2, dil2 = g2 == 0 ? 1 : (g2 == 1 ? 4 : 16);
              const int r02 = g2 == 0 ? 0 : (g2 == 1 ? (k2 >> 1) : 2 * k2), j02 = g2 == 0 ? 8 * k2 : (g2 == 1 ? 8 * (k2 & 1) : 0);
              const int s2 = tid >> 5, kk2 = tid & 31; int res2, jt2; bool valid2;
              if (g2 < 2) { res2 = r02; jt2 = j02 - 4 + s2; valid2 = jt2 >= 0; } else { res2 = r02 + (s2 >> 2); jt2 = s2 & 3; valid2 = s2 < 8; }
              if (valid2) { const bf16* lp = F.PA + (size_t)(b2 * SEQ + res2 + (32 * jt2 + kk2) * dil2) * PAP + hh2 * 64;
                  tch0 = *(const unsigned*)(lp + C_BK); tch1 = *(const unsigned*)(lp + C_BV); } } }
        float mrun = -1e30f, lrun = 0.f; f32x16 o0 = {}, o1 = {};
        const int ksw = (r32 >> 1) & 7;
        for (int jt = (j >= 4 ? j - 4 : 0); jt <= j; ++jt) {
            const int s = sbase + jt;
            const LAS unsigned char* kb = kimg + s * 4096 + r32 * 128;
            f32x16 st = {};
#pragma unroll
            for (int d0 = 0; d0 < 4; ++d0) { const bf16x8 kf = *(const LAS bf16x8*)(kb + (((2 * d0 + hi) ^ ksw) * 16)); st = __builtin_amdgcn_mfma_f32_32x32x16_bf16(kf, qf[d0], st, 0, 0, 0); }
            const int bidx = 32 * (j - jt) + r32 + 31 - 4 * hi;
            float tmax = -1e30f;
#pragma unroll
            for (int i = 0; i < 4; ++i) { const f32x4 kk = *(const LAS f32x4*)(kstab + s * 32 + 8 * i + 4 * hi);
#pragma unroll
                for (int jj = 0; jj < 4; ++jj) { const float sv = st[4 * i + jj] * kk[jj] + btab[bidx - 8 * i - jj]; st[4 * i + jj] = sv; tmax = fmaxf(tmax, sv); } }
            tmax = fmaxf(tmax, __shfl_xor(tmax, 32));
            const float mnew = fmaxf(mrun, tmax), alpha = __builtin_amdgcn_exp2f(mrun - mnew); mrun = mnew;
            float psum = 0.f;
#pragma unroll
            for (int r = 0; r < 16; ++r) { st[r] = __builtin_amdgcn_exp2f(st[r] - mnew); psum += st[r]; }
            lrun = lrun * alpha + psum;
#pragma unroll
            for (int r = 0; r < 16; ++r) { o0[r] *= alpha; o1[r] *= alpha; }
            v4u p0, p1;
            p0.x = cvtpk(st[0], st[1]); p0.y = cvtpk(st[2], st[3]); p0.z = cvtpk(st[4], st[5]); p0.w = cvtpk(st[6], st[7]);
            p1.x = cvtpk(st[8], st[9]); p1.y = cvtpk(st[10], st[11]); p1.z = cvtpk(st[12], st[13]); p1.w = cvtpk(st[14], st[15]);
            const LAS unsigned char* vb = vimg + s * 4096 + (4 * hi + ((lane & 15) >> 2)) * 64 + ((lane >> 4) & 1) * 32 + (lane & 3) * 8;
#pragma unroll
            for (int ss = 0; ss < 2; ++ss) { const bf16x8 pf = __builtin_bit_cast(bf16x8, ss == 0 ? p0 : p1);
                { const s16x4 a = vtr(vb + (2 * ss) * 1024), c = vtr(vb + (2 * ss + 1) * 1024); const bf16x8 vf = {a[0], a[1], a[2], a[3], c[0], c[1], c[2], c[3]};
                  o0 = __builtin_amdgcn_mfma_f32_32x32x16_bf16(vf, pf, o0, 0, 0, 0); }
                { const s16x4 a = vtr(vb + (2 * ss) * 1024 + 512), c = vtr(vb + (2 * ss + 1) * 1024 + 512); const bf16x8 vf = {a[0], a[1], a[2], a[3], c[0], c[1], c[2], c[3]};
                  o1 = __builtin_amdgcn_mfma_f32_32x32x16_bf16(vf, pf, o1, 0, 0, 0); } }
        }
        const float ltot = lrun + __shfl_xor(lrun, 32), inv = 1.f / ltot;
        bf16* orow = F.OG + ((size_t)g * HB_ROWS + qrow) * 256 + h * 64 + 4 * hi;
#pragma unroll
        for (int i = 0; i < 4; ++i) { u32x2v w0, w1; w0.x = cvtpk(o0[4 * i] * inv, o0[4 * i + 1] * inv); w0.y = cvtpk(o0[4 * i + 2] * inv, o0[4 * i + 3] * inv);
            w1.x = cvtpk(o1[4 * i] * inv, o1[4 * i + 1] * inv); w1.y = cvtpk(o1[4 * i + 2] * inv, o1[4 * i + 3] * inv);
            *(u32x2v*)(orow + 8 * i) = w0; *(u32x2v*)(orow + 32 + 8 * i) = w1; }
        if (hi == 0) F.LSE[((size_t)g * HB_ROWS + qrow) * 4 + h] = (mrun + __log2f(ltot)) * LN2;
        __syncthreads();
    }
    asm volatile("" :: "v"(tch0), "v"(tch1));
}

#ifndef G1_STAGGER_TICKS
#define G1_STAGGER_TICKS 0
#endif
#ifndef G1_ALIGN_EPI
#define G1_ALIGN_EPI true
#endif
#ifndef PROBE_REP
#define PROBE_REP -1
#endif
#define REPS(id) for (int rep_ = 0; rep_ < ((PROBE_REP) == (id) ? 2 : 1); ++rep_)
#ifndef MK_PER_PHASE
#define MK_PER_PHASE 0
#endif
constexpr int NPH_HALF = 5, NPHASES = 1 + 2 * NPH_HALF;
struct Args { const float* in[20]; float* out; unsigned char* ws; int ph_lo, ph_hi; };
__global__ void __launch_bounds__(NTHR, 2) mega_fwd(Args args) {
    extern __shared__ __attribute__((aligned(16))) unsigned char lds_raw[];
    Ctx F;
    F.lds = (LAS unsigned char*)lds_raw;
    F.tid = threadIdx.x; F.lane = F.tid & 63; F.wave = __builtin_amdgcn_readfirstlane(F.tid >> 6);
    F.G = gridDim.x; F.gtid = blockIdx.x * NTHR + F.tid; F.T = F.G * NTHR; F.gwave = blockIdx.x * NWAVES + F.wave; F.NW = F.G * NWAVES;
    { const int bx = blockIdx.x; const int vcu = (F.G % 8 == 0) ? (bx % 8) * (F.G / 8) + bx / 8 : bx; F.xgwave = vcu * NWAVES + F.wave; }
    unsigned char* ws = args.ws;
    F.x = args.in[0]; F.mem = args.in[1]; F.norm_w = args.in[2]; F.w_in = args.in[3]; F.gate_b = args.in[4]; F.lnw = args.in[5]; F.lnb = args.in[6]; F.sp_w = args.in[7];
    F.sp_b = args.in[8]; F.bqw = args.in[9]; F.bkw = args.in[10]; F.rel_bias = args.in[11]; F.mem_norm_w = args.in[12]; F.m_w_kv = args.in[13]; F.mqw = args.in[14]; F.mkw = args.in[15];
    F.proj_a = args.in[16]; F.proj_b = args.in[17]; F.proj_m = args.in[18]; F.w_out = args.in[19]; F.out = args.out;
    F.WIN = (bf16*)(ws + WS_WIN); F.PCAT = (bf16*)(ws + WS_PCAT); F.WOUT = (bf16*)(ws + WS_WOUT); F.WSP = (bf16*)(ws + WS_WSP); F.BIAS = (float*)(ws + WS_BIAS); F.BIASX = (float*)(ws + WS_BIAS + 65536);
    F.XN = (bf16*)(ws + WS_XN); F.PA = (bf16*)(ws + WS_PA); F.KVM = (bf16*)(ws + WS_KVM); F.SS = (float*)(ws + WS_SS); F.MKSS = (float*)(ws + WS_MKSS);
    F.OG = (bf16*)(ws + WS_OG); F.LSE = (float*)(ws + WS_LSE); F.LNST = (float*)(ws + WS_LNST); F.YC = (bf16*)(ws + WS_YC); F.MRG = (bf16*)(ws + WS_MRG);
    for (int u = F.tid; u < (LDS_BYTES - LDSCTL_OFF) / 4; u += NTHR) ((LAS unsigned*)(F.lds + LDSCTL_OFF))[u] = 0u;
    __syncthreads();
    XcdBarrier bar; bar.bar = (unsigned*)(ws + WS_CTL) + CW_BAR; bar.x = 0; bar.st = nullptr; bar.wave = 0;
    if (!MK_PER_PHASE) bar = xcd_barrier_post((unsigned*)(ws + WS_CTL) + CW_BAR, (volatile LAS unsigned*)(F.lds + MISC_OFF) + 8, F.wave);
    const int lo = args.ph_lo, hi = args.ph_hi;
#define IN(k) (lo <= (k) && (k) < hi)
#define SEAM(k) do { if (IN(k) && IN((k) + 1)) xcd_barrier(bar); } while (0)

    if (IN(0)) { REPS(0) p0_prologue(F); } SEAM(0);
#pragma unroll 1
    for (int hb = 0; hb < 2; ++hb) {
        const int pb = 1 + hb * NPH_HALF, row0 = hb * HB_ROWS;
        asm volatile("v_mbcnt_lo_u32_b32 %0, -1, 0\n\tv_mbcnt_hi_u32_b32 %0, -1, %0" : "=v"(F.lane)); F.tid = F.wave * 64 + F.lane; F.gtid = blockIdx.x * NTHR + F.tid;
#if PROBE_REP == 9 || PROBE_REP == 10
        if (IN(pb + 0)) { pg8::Gemm g{F.XN, F.WIN, MTOT + MMEM, NIN + 1024, DM, DM, DM}; pg8::OrderG1 S; S.init(hb, F.G, (int)blockIdx.x);
            typedef pg8::EpiProjT<PROBE_REP - 8> EP; EP E{F.PA, F.KVM, F.SS, F.MKSS, F.gate_b, hb * (HB_ROWS / 256), 0};
            pg8::gemm_phase<EP, pg8::OrderG1, true, true>(F.lds + RING_OFF, g, S, E, F.wave); }
#endif
        if (IN(pb + 0)) REPS(1) {
            pg8::Gemm g{F.XN, F.WIN, MTOT + MMEM, NIN + 1024, DM, DM, DM}; pg8::OrderG1 S; S.init(hb, F.G, (int)blockIdx.x);
#if G1_STAGGER_TICKS
            { const unsigned long long t0 = __builtin_amdgcn_s_memrealtime(), dl = (unsigned long long)((blockIdx.x >> 3) & 31) * G1_STAGGER_TICKS;
              while (__builtin_amdgcn_s_memrealtime() - t0 < dl) __builtin_amdgcn_s_sleep(8); }
#endif
            pg8::EpiProj E{F.PA, F.KVM, F.SS, F.MKSS, F.gate_b, hb * (HB_ROWS / 256), 0};
            pg8::gemm_phase<pg8::EpiProj, pg8::OrderG1, G1_ALIGN_EPI, true>(F.lds + RING_OFF, g, S, E, F.wave);
        }
#if PROBE_REP == 8
        if (IN(pb + 0)) { pg8::Gemm g{F.XN, F.WIN, MTOT + MMEM, NIN + 1024, DM, DM, DM}; pg8::OrderG1 S; S.init(hb, F.G, (int)blockIdx.x); pg8::EpiNull E{};
            pg8::gemm_phase<pg8::EpiNull, pg8::OrderG1, true, true>(F.lds + RING_OFF, g, S, E, F.wave); }
#endif
        SEAM(pb + 0);
        if (IN(pb + 1)) { REPS(2) st_mixA_mfma(F); REPS(3) st_attnB_v3(F); REPS(4) st_attnM_v3(F, hb); } SEAM(pb + 1);
        if (IN(pb + 2)) { REPS(5) st_mergeB_vec(F); } SEAM(pb + 2);
#if PROBE_REP == 13 || PROBE_REP == 14
        if (IN(pb + 3)) { pg8::Gemm g{F.YC, F.PCAT, HB_ROWS, DM, KC, KC, KC}; pg8::StaticOrder S; S.init(HB_ROWS, DM, F.G, (int)blockIdx.x);
            typedef pg8::EpiG2catT<PROBE_REP == 13, PROBE_REP == 14> EP; EP E{F.PA, F.MRG};
            pg8::gemm_phase<EP, pg8::StaticOrder, true, true>(F.lds + RING_OFF, g, S, E, F.wave); }
#endif
#if PROBE_REP == 11
        if (IN(pb + 3)) { pg8::Gemm g{F.YC, F.PCAT, HB_ROWS, DM, KC, KC, KC}; pg8::StaticOrder S; S.init(HB_ROWS, DM, F.G, (int)blockIdx.x); pg8::EpiNull E{};
            pg8::gemm_phase<pg8::EpiNull, pg8::StaticOrder, true, true>(F.lds + RING_OFF, g, S, E, F.wave); }
#endif
#if PROBE_REP == 12
        if (IN(pb + 4)) { pg8::Gemm g{F.MRG, F.WOUT, HB_ROWS, DM, DM, DM, DM}; pg8::StaticOrder S; S.init(HB_ROWS, DM, F.G, (int)blockIdx.x); pg8::EpiNull E{};
            pg8::gemm_phase<pg8::EpiNull, pg8::StaticOrder, true, true>(F.lds + RING_OFF, g, S, E, F.wave); }
#endif
        if (IN(pb + 3)) REPS(6) {
            pg8::Gemm g{F.YC, F.PCAT, HB_ROWS, DM, KC, KC, KC}; pg8::StaticOrder S; S.init(HB_ROWS, DM, F.G, (int)blockIdx.x);
            pg8::EpiG2cat E{F.PA, F.MRG};
            pg8::gemm_phase<pg8::EpiG2cat, pg8::StaticOrder, true, true>(F.lds + RING_OFF, g, S, E, F.wave);
        } SEAM(pb + 3);
        if (IN(pb + 4)) REPS(7) {
            pg8::Gemm g{F.MRG, F.WOUT, HB_ROWS, DM, DM, DM, DM}; pg8::StaticOrder S; S.init(HB_ROWS, DM, F.G, (int)blockIdx.x);
            pg8::EpiG3 E{F.x + (size_t)row0 * DM, F.out + (size_t)row0 * DM};
            pg8::gemm_phase<pg8::EpiG3, pg8::StaticOrder, true, true>(F.lds + RING_OFF, g, S, E, F.wave);
        } if (hb == 1) SEAM(pb + 4);
    }
#undef IN
#undef SEAM
}

extern "C" void kernel_launch(void* const* d_in, const int* in_sizes, int n_in, void* d_out, int out_size, void* d_ws, size_t ws_size, hipStream_t stream) {
    static int grid = 0;
    if (grid == 0) {
        if (n_in != 20 || in_sizes[0] != MTOT * DM || out_size != MTOT * DM || ws_size < WS_END) { fprintf(stderr, "kernel_launch: unexpected shapes (n_in %d, ws %zu); nothing launched\n", n_in, ws_size); grid = -1; return; }
        int dev = 0, cus = 0, per_cu = 0;
        if (hipGetDevice(&dev) != hipSuccess || hipDeviceGetAttribute(&cus, hipDeviceAttributeMultiprocessorCount, dev) != hipSuccess) { grid = -1; return; }
        if (hipFuncSetAttribute((const void*)mega_fwd, hipFuncAttributeMaxDynamicSharedMemorySize, LDS_BYTES) != hipSuccess) { fprintf(stderr, "kernel_launch: hipFuncSetAttribute failed\n"); grid = -1; return; }
        if (hipOccupancyMaxActiveBlocksPerMultiprocessor(&per_cu, (const void*)mega_fwd, NTHR, LDS_BYTES) != hipSuccess || per_cu < 1) { fprintf(stderr, "kernel_launch: occupancy query says %d blocks per CU\n", per_cu); (void)hipGetLastError(); grid = -1; return; }
        grid = cus;
    }
    if (grid < 0) return;
    if (hipMemsetAsync((char*)d_ws + WS_CTL, 0, CTL_ZERO_BYTES, stream) != hipSuccess) return;
    Args a{};
    for (int i = 0; i < 20; ++i) a.in[i] = (const float*)d_in[i];
    a.out = (float*)d_out; a.ws = (unsigned char*)d_ws;
#if MK_PER_PHASE
    for (int p = 0; p < NPHASES; ++p) { a.ph_lo = p; a.ph_hi = p + 1; hipLaunchKernelGGL(mega_fwd, dim3(grid), dim3(NTHR), LDS_BYTES, stream, a); }
#else
    a.ph_lo = 0; a.ph_hi = NPHASES; hipLaunchKernelGGL(mega_fwd, dim3(grid), dim3(NTHR), LDS_BYTES, stream, a);
#endif
}
```

```cpp
#include <hip/hip_runtime.h>
#include <cstdint>
#include <cstdio>

constexpr int DM = 1024, NB = 32, SEQ = 2048, MTOT = NB * SEQ;
constexpr int NIN = 8960, MEML = 256, MMEM = NB * MEML;
constexpr int HB_ROWS = MTOT / 2;
constexpr int C_AU = 0, C_AV = 768, C_AZ = 1536, C_BQ = 2304, C_BK = 3072, C_BV = 3840, C_BZ = 4608, C_MQ = 4864, C_MZ = 5376, C_G = 5888;
constexpr float EPS = 1e-6f;
constexpr int SS_W = 112;
constexpr int PAP = 7424;
constexpr int PA_ROWB = 2 * PAP, PA_GOFF = 2 * C_G;
constexpr int KC = 1536;

constexpr size_t MiB = 1u << 20;
constexpr size_t WS_CTL = 0, CTL_ZERO_BYTES = 32 * 1024, WS_WIN = 2 * MiB, WS_PCAT = 22 * MiB, WS_WOUT = 25 * MiB, WS_WSP = 27 * MiB, WS_BIAS = 27 * MiB + 512 * 1024;
constexpr size_t WS_XN = 32 * MiB, WS_PA = 176 * MiB, WS_KVM = 736 * MiB, WS_SS = 752 * MiB, WS_MKSS = 766 * MiB, WS_OG = 768 * MiB, WS_LSE = 816 * MiB, WS_LNST = 818 * MiB;
constexpr size_t WS_YC = 820 * MiB, WS_MRG = 916 * MiB, WS_END = 980 * MiB;
constexpr int CW_BAR = 4096;

namespace pg8 {
#define PG8_LAS __attribute__((address_space(3)))
typedef unsigned short bf16_t;
typedef short bf16x8 __attribute__((ext_vector_type(8)));
typedef float f32x4 __attribute__((ext_vector_type(4)));
typedef unsigned u32x4 __attribute__((ext_vector_type(4)));
constexpr int BM = 256, BK = 64, HALF = 128, HTB = HALF * BK * 2  , STAGE_BYTES = 8 * HTB, NXCD = 8, WGM = 8;

__host__ __device__ __forceinline__ int lds_byte(int r, int c) { const int st = (r >> 4) * 2 + (c >> 5), rr = r & 15, cc = c & 31, ob = rr * 64 + cc * 2; return st * 1024 + (ob ^ (((ob >> 9) & 1) << 5)); }
__host__ __device__ __forceinline__ void stage_rc(int b, int& R, int& C) { const int st = b / 1024, sb = b % 1024, swz = sb ^ (((sb >> 9) & 1) << 5); R = (st >> 1) * 16 + swz / 64; C = (st & 1) * 32 + (swz % 64) / 2; }
__host__ __device__ __forceinline__ int perm32(int rho) { const int n = rho >> 4, i = rho & 15; return 8 * (i >> 2) + 4 * n + (i & 3); }

struct Unit { int pm, pn; };
struct Gemm { const bf16_t* A; const bf16_t* Bt; int M, N, K, lda, ldb; };

struct StaticOrder {
    int nM, nN, nwg, G, c;
    __host__ __device__ void init(int M, int N, int G_, int c_) { nM = M / BM; nN = N / BM; nwg = nM * nN; G = G_; c = c_; }
    __host__ __device__ bool next(int i, Unit& u) const {
        const long L = (long)i * G + c; if (L >= nwg) return false;
        int wgid = (int)L; { const int q = nwg / NXCD, r = nwg % NXCD, xcd = wgid % NXCD, off = wgid / NXCD; wgid = (xcd < r ? xcd * (q + 1) : r * (q + 1) + (xcd - r) * q) + off; }
        const int nig = WGM * nN, gid = wgid / nig, fm = gid * WGM, gsz = (nM - fm) < WGM ? (nM - fm) : WGM;
        u.pm = fm + ((wgid % nig) % gsz); u.pn = (wgid % nig) / gsz; return true;
    }
    __device__ __forceinline__ void a_ready(const Unit&) const {}
    __device__ __forceinline__ void done(const Unit&) const {}
};


typedef float f32x2c_t __attribute__((ext_vector_type(2))); typedef __bf16 bf16x2c_t __attribute__((ext_vector_type(2)));
__device__ __forceinline__ unsigned cvt_pk_bf16(float lo, float hi) { const f32x2c_t v = {lo, hi}; const bf16x2c_t b = __builtin_convertvector(v, bf16x2c_t); return __builtin_bit_cast(unsigned, b); }
typedef float f32x2 __attribute__((ext_vector_type(2)));
__device__ __forceinline__ f32x2 gelu_pk(f32x2 v) {
    const f32x2 av = __builtin_elementwise_abs(v), d = av * 0.2316418882f + 1.0f;
    f32x2 t; t.x = __builtin_amdgcn_rcpf(d.x); t.y = __builtin_amdgcn_rcpf(d.y);
    f32x2 q = t * 0.5307027145f + (-0.7265760135f); q = q * t + 0.7107068705f; q = q * t + (-0.142248368f); q = q * t + 0.127414796f; q = q * t;
    const f32x2 s = (v * v) * (-0.72134752044f);
    f32x2 e; e.x = __builtin_amdgcn_exp2f(s.x); e.y = __builtin_amdgcn_exp2f(s.y);
    const f32x2 m = v * (q * e), r = v - m;
    f32x2 o; o.x = v.x < 0.f ? m.x : r.x; o.y = v.y < 0.f ? m.y : r.y; return o;
}

template <class Epi, class Sched, bool ALIGN_EPI = false, bool SP2 = false>
__device__ __forceinline__ void gemm_phase(PG8_LAS unsigned char* lds, const Gemm g, const Sched& S, const Epi& E, const int wave_id) {
    int tid; asm volatile("v_mbcnt_lo_u32_b32 %0, -1, 0\n\tv_mbcnt_hi_u32_b32 %0, -1, %0" : "=v"(tid)); tid += wave_id * 64;
    const int wid = __builtin_amdgcn_readfirstlane(tid >> 6), lane = tid & 63, wr = wid >> 2, wc = wid & 3, fr = lane & 15, fq = lane >> 4;
    int K = g.K; asm volatile("" : "+s"(K)); const int nt = K / BK;
    unsigned voffA[2], voffB[2];
#pragma unroll
    for (int i = 0; i < 2; ++i) { int R, C; stage_rc(tid * 16 + i * 8192, R, C); const int Rb = Epi::PERM ? ((R & ~31) + perm32(R & 31)) : R;
        voffA[i] = (unsigned)(R * g.lda + C) * 2u; voffB[i] = (unsigned)(Rb * g.ldb + C) * 2u; }
    const size_t kstep = (size_t)(BK * 2);
    const size_t hstepA = (size_t)HALF * g.lda * 2, hstepB = (size_t)HALF * g.ldb * 2;
    const size_t tstepA = 2 * hstepA, tstepB = 2 * hstepB;
    const unsigned ldsw = (unsigned)wid * 1024u;
    const int aoff = lds_byte(wr * 64 + fr, fq * 8), boff = lds_byte(wc * 32 + fr, fq * 8);
#define PG8_SA(b, h) (((b) * 2 + (h)) * HTB)
#define PG8_SB(b, h) ((4 + (b) * 2 + (h)) * HTB)
#define PG8_STAGE(bufoff, gbase, voff) do { _Pragma("unroll") for (int _i = 0; _i < 2; ++_i) \
        __builtin_amdgcn_global_load_lds((const unsigned*)((const char*)(gbase) + (voff)[_i]), (PG8_LAS unsigned*)(lds + (bufoff) + ldsw + _i * 8192), 16, 0, 0); } while (0)
#define PG8_LDA(dst, b, h) do { _Pragma("unroll") for (int m = 0; m < 4; ++m) _Pragma("unroll") for (int k = 0; k < 2; ++k) dst[m][k] = *(const PG8_LAS bf16x8*)(lds + PG8_SA(b, h) + aoff + m * 2048 + k * 1024); } while (0)
#define PG8_LDB(dst, b, h) do { _Pragma("unroll") for (int n = 0; n < 2; ++n) _Pragma("unroll") for (int k = 0; k < 2; ++k) dst[n][k] = *(const PG8_LAS bf16x8*)(lds + PG8_SB(b, h) + boff + n * 2048 + k * 1024); } while (0)
#define PG8_MMA(ai, bj, At, Bt) do { __builtin_amdgcn_s_setprio(1); _Pragma("unroll") for (int m = 0; m < 4; ++m) _Pragma("unroll") for (int n = 0; n < 2; ++n) _Pragma("unroll") for (int k = 0; k < 2; ++k) \
        acc[ai][bj][m][n] = __builtin_amdgcn_mfma_f32_16x16x32_bf16(Bt[n][k], At[m][k], acc[ai][bj][m][n], 0, 0, 0); __builtin_amdgcn_s_setprio(0); } while (0)
#define PG8_WAIT_V(n) asm volatile("s_waitcnt vmcnt(" #n ")" ::: "memory")
#define PG8_WAIT_L(n) asm volatile("s_waitcnt lgkmcnt(" #n ")" ::: "memory")
#define PG8_BAR __builtin_amdgcn_s_barrier()
#define PG8_SCHED __builtin_amdgcn_sched_barrier(0)
    Unit cur, nxt; int ui = 0;
    if (!S.next(0, cur)) return;
    f32x4 acc[2][2][4][2];
#pragma unroll
    for (int a = 0; a < 2; ++a)
#pragma unroll
        for (int b = 0; b < 2; ++b)
#pragma unroll
            for (int m = 0; m < 4; ++m)
#pragma unroll
                for (int n = 0; n < 2; ++n) acc[a][b][m][n] = (f32x4){0.f, 0.f, 0.f, 0.f};
    bf16x8 At[4][2], B0[2][2], B1[2][2];
    const char* cA = (const char*)g.A + (size_t)cur.pm * tstepA; const char* cB = (const char*)g.Bt + (size_t)cur.pn * tstepB;
    S.a_ready(cur);
    if constexpr (SP2) {
        PG8_STAGE(PG8_SB(0, 0), cB, voffB); PG8_STAGE(PG8_SB(0, 1), cB + hstepB, voffB); PG8_STAGE(PG8_SA(0, 0), cA, voffA); PG8_STAGE(PG8_SA(0, 1), cA + hstepA, voffA);
        if (wr == 1) PG8_BAR;
        PG8_WAIT_V(2); PG8_BAR;
        PG8_STAGE(PG8_SB(1, 0), cB + kstep, voffB); PG8_STAGE(PG8_SA(1, 0), cA + kstep, voffA); PG8_STAGE(PG8_SB(1, 1), cB + hstepB + kstep, voffB);
        PG8_WAIT_V(6); PG8_BAR;
    } else {
        PG8_STAGE(PG8_SB(0, 0), cB, voffB); PG8_STAGE(PG8_SA(0, 0), cA, voffA); PG8_STAGE(PG8_SB(0, 1), cB + hstepB, voffB); PG8_STAGE(PG8_SA(0, 1), cA + hstepA, voffA);
        if (wr == 1) PG8_BAR;
        PG8_WAIT_V(4); PG8_BAR;
        PG8_STAGE(PG8_SB(1, 0), cB + kstep, voffB); PG8_STAGE(PG8_SA(1, 0), cA + kstep, voffA); PG8_STAGE(PG8_SB(1, 1), cB + hstepB + kstep, voffB);
        PG8_WAIT_V(6); PG8_BAR;
    }
    for (;;) {
        const bool has_next = S.next(ui + 1, nxt);
        const char* nA = has_next ? (const char*)g.A + (size_t)nxt.pm * tstepA : cA; const char* nB = has_next ? (const char*)g.Bt + (size_t)nxt.pn * tstepB : cB;
        for (int t = 0; t < nt; t += 2) {
            if constexpr (Epi::KHOOK) { if (t == Epi::KH1 || t == Epi::KH2) E.khook(acc, cur, t, wr, wc, fr, fq); }
            const bool last = (t == nt - 2);
            const char* a1 = cA + (size_t)(t + 1) * kstep;
            const char* a2 = last ? nA : cA + (size_t)(t + 2) * kstep; const char* b2 = last ? nB : cB + (size_t)(t + 2) * kstep;
            const char* a3 = a2 + kstep; const char* b3 = b2 + kstep;
            if (last && has_next) S.a_ready(nxt);
            if constexpr (SP2) {
            PG8_LDB(B0, 0, 0); PG8_LDB(B1, 0, 1); PG8_SCHED; PG8_LDA(At, 0, 0); PG8_STAGE(PG8_SA(1, 1), a1 + hstepA, voffA);
            PG8_WAIT_V(8); PG8_WAIT_L(0); PG8_BAR; PG8_MMA(0, 0, At, B0); PG8_MMA(0, 1, At, B1); PG8_BAR; PG8_SCHED;
            PG8_LDA(At, 0, 1); PG8_STAGE(PG8_SB(0, 0), b2, voffB); PG8_STAGE(PG8_SB(0, 1), b2 + hstepB, voffB); PG8_STAGE(PG8_SA(0, 0), a2, voffA);
            PG8_WAIT_V(8); PG8_WAIT_L(0); PG8_BAR; PG8_MMA(1, 0, At, B0); PG8_MMA(1, 1, At, B1); PG8_BAR; PG8_SCHED;
            PG8_LDB(B0, 1, 0); PG8_LDB(B1, 1, 1); PG8_SCHED; PG8_LDA(At, 1, 0); PG8_STAGE(PG8_SA(0, 1), a2 + hstepA, voffA);
            PG8_WAIT_V(8); PG8_WAIT_L(0); PG8_BAR; PG8_MMA(0, 0, At, B0); PG8_MMA(0, 1, At, B1); PG8_BAR; PG8_SCHED;
            PG8_LDA(At, 1, 1); PG8_STAGE(PG8_SB(1, 0), b3, voffB); PG8_STAGE(PG8_SB(1, 1), b3 + hstepB, voffB); PG8_STAGE(PG8_SA(1, 0), a3, voffA);
            PG8_WAIT_V(8); PG8_WAIT_L(0); PG8_BAR; PG8_MMA(1, 0, At, B0); PG8_MMA(1, 1, At, B1); PG8_BAR; PG8_SCHED;
            } else {
            PG8_LDB(B0, 0, 0); PG8_SCHED; PG8_LDA(At, 0, 0); PG8_STAGE(PG8_SA(1, 1), a1 + hstepA, voffA);
            PG8_WAIT_L(8); PG8_BAR; PG8_WAIT_L(0); PG8_MMA(0, 0, At, B0); PG8_BAR; PG8_SCHED;
            PG8_LDB(B1, 0, 1); PG8_STAGE(PG8_SB(0, 0), b2, voffB);
            PG8_BAR; PG8_WAIT_L(0); PG8_MMA(0, 1, At, B1); PG8_BAR;
            PG8_LDA(At, 0, 1); PG8_STAGE(PG8_SA(0, 0), a2, voffA);
            PG8_BAR; PG8_WAIT_L(0); PG8_MMA(1, 0, At, B0); PG8_BAR; PG8_SCHED;
            PG8_STAGE(PG8_SB(0, 1), b2 + hstepB, voffB);
            PG8_WAIT_V(6); PG8_BAR; PG8_MMA(1, 1, At, B1); PG8_BAR;
            PG8_LDB(B0, 1, 0); PG8_SCHED; PG8_LDA(At, 1, 0); PG8_STAGE(PG8_SA(0, 1), a2 + hstepA, voffA);
            PG8_WAIT_L(8); PG8_BAR; PG8_WAIT_L(0); PG8_MMA(0, 0, At, B0); PG8_BAR; PG8_SCHED;
            PG8_LDB(B1, 1, 1); PG8_STAGE(PG8_SB(1, 0), b3, voffB);
            PG8_BAR; PG8_WAIT_L(0); PG8_MMA(0, 1, At, B1); PG8_BAR;
            PG8_LDA(At, 1, 1); PG8_STAGE(PG8_SA(1, 0), a3, voffA);
            PG8_BAR; PG8_WAIT_L(0); PG8_MMA(1, 0, At, B0); PG8_BAR; PG8_SCHED;
            PG8_STAGE(PG8_SB(1, 1), b3 + hstepB, voffB);
            PG8_WAIT_V(6); PG8_BAR; PG8_MMA(1, 1, At, B1); PG8_BAR;
            }
        }
        if constexpr (ALIGN_EPI) { if (wr == 0) PG8_BAR; }
        if constexpr (!Epi::AFTER_DRAIN) { E(acc, cur, wr, wc, fr, fq); S.done(cur); }
        if (!has_next) break;
#pragma unroll
        for (int a = 0; a < 2; ++a)
#pragma unroll
            for (int b = 0; b < 2; ++b)
#pragma unroll
                for (int m = 0; m < 4; ++m)
#pragma unroll
                    for (int n = 0; n < 2; ++n) acc[a][b][m][n] = (f32x4){0.f, 0.f, 0.f, 0.f};
        cur = nxt; cA = nA; cB = nB; ++ui;
        if constexpr (ALIGN_EPI) { if (wr == 1) PG8_BAR; }
    }
    PG8_WAIT_V(0);
    if constexpr (!ALIGN_EPI) { if (wr == 0) PG8_BAR; }
    PG8_BAR;
    if constexpr (Epi::AFTER_DRAIN) { E.fused(acc, cur, wr, wc, fr, fq, lds, wid, lane); S.done(cur); }
#undef PG8_SA
#undef PG8_SB
#undef PG8_STAGE
#undef PG8_LDA
#undef PG8_LDB
#undef PG8_MMA
#undef PG8_WAIT_V
#undef PG8_WAIT_L
#undef PG8_BAR
#undef PG8_SCHED
}
}

#ifndef G1_EPI_DRAIN
#define G1_EPI_DRAIN 0
#endif
#ifndef G1_STORE_AUX_MIX
#define G1_STORE_AUX_MIX 2
#endif
#ifndef G1_STORE_AUX
#define G1_STORE_AUX 2
#endif
namespace pg8 {
__device__ __forceinline__ float ubf0(unsigned w) { return (float)(w & 0xffu); }
__device__ __forceinline__ float ubf1(unsigned w) { return (float)((w >> 8) & 0xffu); }
__device__ __forceinline__ float ubf2(unsigned w) { return (float)((w >> 16) & 0xffu); }
__device__ __forceinline__ float ubf3(unsigned w) { return (float)(w >> 24); }
__device__ __forceinline__ float ex2(float x) { return __builtin_amdgcn_exp2f(x); }
__device__ __forceinline__ float sigm_fast(float x) { return __builtin_amdgcn_rcpf(1.0f + ex2(x * -1.4426950408889634f)); }
template <int MODE = 0  > struct EpiProjT {
    static constexpr bool PERM = true, AFTER_DRAIN = false, KHOOK = false;
    bf16_t* PA; bf16_t* KVM; float* SS; float* MKSS; const float* gate_b; int pm0; int pad;
    template <int KIND, int STAT> __device__ __forceinline__ void body(const f32x4 (&acc)[2][2][4][2], const __amdgpu_buffer_rsrc_t rsrc, int row0, int col0, int ldc, float* sb, int sld, int so, const float* bias, int wc, int fq) const {
        f32x4 bv[2][2];
        if (KIND == 3) {
#pragma unroll
            for (int bj = 0; bj < 2; ++bj)
#pragma unroll
                for (int n = 0; n < 2; ++n) bv[bj][n] = *(const f32x4*)(bias + bj * HALF + 4 * n);
        }
#pragma unroll
        for (int ai = 0; ai < 2; ++ai)
#pragma unroll
            for (int m = 0; m < 4; ++m) { const int row = row0 + ai * HALF + m * 16; const unsigned rowoff = ((unsigned)row * (unsigned)ldc + (unsigned)col0) * 2u;
#pragma unroll
                for (int bj = 0; bj < 2; ++bj) { f32x4 v0 = acc[ai][bj][m][0], v1 = acc[ai][bj][m][1];
                    if (KIND == 1) { f32x2 a = gelu_pk((f32x2){v0[0], v0[1]}), b = gelu_pk((f32x2){v0[2], v0[3]}), c = gelu_pk((f32x2){v1[0], v1[1]}), d = gelu_pk((f32x2){v1[2], v1[3]});
                        v0 = (f32x4){a.x, a.y, b.x, b.y}; v1 = (f32x4){c.x, c.y, d.x, d.y}; }
                    else if (KIND == 2) {
#pragma unroll
                        for (int j = 0; j < 4; ++j) { v0[j] = v0[j] * sigm_fast(v0[j]); v1[j] = v1[j] * sigm_fast(v1[j]); } }
                    else if (KIND == 3) { v0 = v0 + bv[bj][0]; v1 = v1 + bv[bj][1];
#pragma unroll
                        for (int j = 0; j < 4; ++j) { v0[j] = sigm_fast(v0[j]); v1[j] = sigm_fast(v1[j]); } }
                    if (STAT) {
                        float s = ((v0[0] + v0[1]) + (v0[2] + v0[3])) + ((v1[0] + v1[1]) + (v1[2] + v1[3]));
                        float q = ((v0[0] * v0[0] + v0[1] * v0[1]) + (v0[2] * v0[2] + v0[3] * v0[3])) + ((v1[0] * v1[0] + v1[1] * v1[1]) + (v1[2] * v1[2] + v1[3] * v1[3]));
                        if (STAT == 2) { s += __shfl_xor(s, 16); s += __shfl_xor(s, 32); }
                        q += __shfl_xor(q, 16); q += __shfl_xor(q, 32);
                        if (fq == 0) { float* sp = sb + (size_t)row * sld + so; const int blk = 4 * bj + wc;
                            if (STAT == 2) { sp[2 * blk] = s; sp[2 * blk + 1] = q; } else sp[blk] = q; }
                    }
                    u32x4 w; w.x = cvt_pk_bf16(v0[0], v0[1]); w.y = cvt_pk_bf16(v0[2], v0[3]); w.z = cvt_pk_bf16(v1[0], v1[1]); w.w = cvt_pk_bf16(v1[2], v1[3]);
                    if (MODE == 2) asm volatile("" :: "v"(w)); else __builtin_amdgcn_raw_buffer_store_b128(w, rsrc, (int)(rowoff + bj * HALF * 2), 0, KIND == 3 ? G1_STORE_AUX : G1_STORE_AUX_MIX); } }
    }
    __device__ __forceinline__ void uz_body(const f32x4 (&acc)[2][2][4][2], const __amdgpu_buffer_rsrc_t rsrc, int row0, int ucol0) const {
#pragma unroll
        for (int ai = 0; ai < 2; ++ai)
#pragma unroll
            for (int m = 0; m < 4; ++m) { const int row = row0 + ai * HALF + m * 16;
                f32x4 u0 = acc[ai][0][m][0], u1 = acc[ai][0][m][1]; const f32x4 z0 = acc[ai][1][m][0], z1 = acc[ai][1][m][1];
                { f32x2 a = gelu_pk((f32x2){u0[0], u0[1]}), b = gelu_pk((f32x2){u0[2], u0[3]}), c = gelu_pk((f32x2){u1[0], u1[1]}), d = gelu_pk((f32x2){u1[2], u1[3]});
                  u0 = (f32x4){a.x, a.y, b.x, b.y}; u1 = (f32x4){c.x, c.y, d.x, d.y}; }
#pragma unroll
                for (int j = 0; j < 4; ++j) { u0[j] *= z0[j] * sigm_fast(z0[j]); u1[j] *= z1[j] * sigm_fast(z1[j]); }
                u32x4 w; w.x = cvt_pk_bf16(u0[0], u0[1]); w.y = cvt_pk_bf16(u0[2], u0[3]); w.z = cvt_pk_bf16(u1[0], u1[1]); w.w = cvt_pk_bf16(u1[2], u1[3]);
                if (MODE == 2) asm volatile("" :: "v"(w)); else __builtin_amdgcn_raw_buffer_store_b128(w, rsrc, (int)((unsigned)row * (unsigned)PA_ROWB + (unsigned)(2 * (C_AU + ucol0))), 0, G1_STORE_AUX_MIX); }
    }
    __device__ __forceinline__ void gate_body(const f32x4 (&acc)[2][2][4][2], const __amdgpu_buffer_rsrc_t rsrc, int row0, int gcol0, const float* bias) const {
        f32x4 bv[2][2];
#pragma unroll
        for (int bj = 0; bj < 2; ++bj)
#pragma unroll
            for (int n = 0; n < 2; ++n) bv[bj][n] = *(const f32x4*)(bias + 8 * bj + 4 * n);
#pragma unroll
        for (int ai = 0; ai < 2; ++ai)
#pragma unroll
            for (int m = 0; m < 4; ++m) { const int row = row0 + ai * HALF + m * 16; u32x4 w;
#pragma unroll
                for (int bj = 0; bj < 2; ++bj)
#pragma unroll
                    for (int n = 0; n < 2; ++n) { const f32x4 v = acc[ai][bj][m][n] + bv[bj][n]; unsigned d = 0u;
#pragma unroll
                        for (int j = 0; j < 4; ++j) d |= (unsigned)(fmaxf(sigm_fast(v[j]) * 255.0f, 1.0f) + 0.5f) << (8 * j);
                        w[2 * bj + n] = d; }
                if (MODE == 2) asm volatile("" :: "v"(w)); else __builtin_amdgcn_raw_buffer_store_b128(w, rsrc, (int)((unsigned)row * (unsigned)PA_ROWB + (unsigned)(PA_GOFF + gcol0)), 0, G1_STORE_AUX); }
    }
    __device__ __forceinline__ void operator()(const f32x4 (&acc)[2][2][4][2], const Unit& u, int wr, int wc, int fr, int fq) const {
        const bool kv = u.pn >= 35; const int pn = kv ? u.pn - 35 : u.pn;
        const int rowt = kv ? (u.pm - 256) * BM : (u.pm - pm0) * BM;
        bf16_t* base = kv ? KVM : PA; const int ldc = kv ? 1024 : PAP;
        const __amdgpu_buffer_rsrc_t rsrc = __builtin_amdgcn_make_buffer_rsrc(base, 0, kv ? (int)((size_t)MMEM * 1024 * 2) : (int)((size_t)HB_ROWS * PA_ROWB), 0x00020000);
        const int row0 = rowt + wr * 64 + fr, col0 = pn * BM + wc * 32 + 8 * fq;
        if (MODE == 1) { body<0, 0>(acc, rsrc, row0, col0, ldc, SS, SS_W, 0, gate_b, wc, fq); return; }
        if (kv) { if (pn < 2) body<0, 1>(acc, rsrc, row0, col0, ldc, MKSS, 16, 8 * pn, gate_b, wc, fq); else body<0, 0>(acc, rsrc, row0, col0, ldc, SS, SS_W, 0, gate_b, wc, fq); }
        else if (pn < 3) uz_body(acc, rsrc, row0, 128 * pn + 32 * wc + 8 * fq);
        else if (pn < 6) body<1, 2>(acc, rsrc, row0, col0, ldc, SS, SS_W, 16 * (pn - 3), gate_b, wc, fq);
        else if (pn < 9) uz_body(acc, rsrc, row0, 128 * (pn - 3) + 32 * wc + 8 * fq);
        else if (pn < 12) body<0, 1>(acc, rsrc, row0, col0, ldc, SS, SS_W, 48 + 8 * (pn - 9), gate_b, wc, fq);
        else if (pn < 15) body<0, 1>(acc, rsrc, row0, col0, ldc, SS, SS_W, 72 + 8 * (pn - 12), gate_b, wc, fq);
        else if (pn < 18) body<0, 0>(acc, rsrc, row0, col0, ldc, SS, SS_W, 0, gate_b, wc, fq);
        else if (pn < 19) body<2, 0>(acc, rsrc, row0, col0, ldc, SS, SS_W, 0, gate_b, wc, fq);
        else if (pn < 21) body<0, 1>(acc, rsrc, row0, col0, ldc, SS, SS_W, 96 + 8 * (pn - 19), gate_b, wc, fq);
        else if (pn < 23) body<2, 0>(acc, rsrc, row0, col0, ldc, SS, SS_W, 0, gate_b, wc, fq);
        else { const int gc = (pn - 23) * BM + 64 * wc + 16 * fq; gate_body(acc, rsrc, row0, gc, gate_b + gc); }
#if G1_EPI_DRAIN
        asm volatile("s_waitcnt vmcnt(0)" ::: "memory");
#endif
    }
};
typedef EpiProjT<0> EpiProj;
template <bool HOOKS = true, bool EPI = true> struct EpiG2catT {
    static constexpr bool PERM = true, AFTER_DRAIN = false, KHOOK = HOOKS; static constexpr int KH1 = 12, KH2 = 16;
    const bf16_t* PA; bf16_t* MRG;
    __device__ __forceinline__ void khook(f32x4 (&acc)[2][2][4][2], const Unit& u, int t, int wr, int wc, int fr, int fq) const {
        typedef unsigned u32x2v __attribute__((ext_vector_type(2)));
        const int ga = t == KH1 ? 0 : 1;
        const int row0 = u.pm * BM + wr * 64 + fr, col0 = u.pn * BM + wc * 32 + 8 * fq;
        const unsigned char* gbase = (const unsigned char*)PA + (size_t)row0 * PA_ROWB + PA_GOFF + ga * DM + col0;
        u32x2v ag[2][4][2], bg[2][4][2];
#pragma unroll
        for (int ai = 0; ai < 2; ++ai)
#pragma unroll
            for (int m = 0; m < 4; ++m) { const unsigned char* gp_ = gbase + (size_t)(ai * HALF + m * 16) * PA_ROWB;
#pragma unroll
                for (int bj = 0; bj < 2; ++bj) { ag[ai][m][bj] = *(const u32x2v*)(gp_ + bj * HALF); bg[ai][m][bj] = *(const u32x2v*)(gp_ + DM + bj * HALF); } }
        __builtin_amdgcn_sched_barrier(0);
#define G2_R(A, Bv, K) (ubf##K(A) * __builtin_amdgcn_rcpf(ubf##K(Bv)))
#pragma unroll
        for (int ai = 0; ai < 2; ++ai)
#pragma unroll
            for (int m = 0; m < 4; ++m)
#pragma unroll
                for (int bj = 0; bj < 2; ++bj) { const u32x2v a = ag[ai][m][bj], b = bg[ai][m][bj]; f32x4 r0, r1;
                    r0[0] = G2_R(a.x, b.x, 0); r0[1] = G2_R(a.x, b.x, 1); r0[2] = G2_R(a.x, b.x, 2); r0[3] = G2_R(a.x, b.x, 3);
                    r1[0] = G2_R(a.y, b.y, 0); r1[1] = G2_R(a.y, b.y, 1); r1[2] = G2_R(a.y, b.y, 2); r1[3] = G2_R(a.y, b.y, 3);
                    acc[ai][bj][m][0] *= r0; acc[ai][bj][m][1] *= r1; }
#undef G2_R
    }
    __device__ __forceinline__ void operator()(const f32x4 (&acc)[2][2][4][2], const Unit& u, int wr, int wc, int fr, int fq) const {
        typedef unsigned u32x2v __attribute__((ext_vector_type(2)));
        if (!EPI) { _Pragma("unroll") for (int ai = 0; ai < 2; ++ai) _Pragma("unroll") for (int bj = 0; bj < 2; ++bj) _Pragma("unroll") for (int m = 0; m < 4; ++m) asm volatile("" :: "v"(acc[ai][bj][m][0]), "v"(acc[ai][bj][m][1])); return; }
        const int row0 = u.pm * BM + wr * 64 + fr, col0 = u.pn * BM + wc * 32 + 8 * fq;
        u32x2v gv[2][4][2];
#pragma unroll
        for (int ai = 0; ai < 2; ++ai)
#pragma unroll
            for (int m = 0; m < 4; ++m) { const unsigned char* gp = (const unsigned char*)PA + (size_t)(row0 + ai * HALF + m * 16) * PA_ROWB + PA_GOFF + 2 * DM + col0;
#pragma unroll
                for (int bj = 0; bj < 2; ++bj) gv[ai][m][bj] = *(const u32x2v*)(gp + bj * HALF); }
        __builtin_amdgcn_sched_barrier(0);
        const float q = 1.0f / 255.0f;
#pragma unroll
        for (int ai = 0; ai < 2; ++ai)
#pragma unroll
            for (int m = 0; m < 4; ++m) { bf16_t* mp = MRG + (size_t)(row0 + ai * HALF + m * 16) * DM + col0;
#pragma unroll
                for (int bj = 0; bj < 2; ++bj) { const u32x2v g = gv[ai][m][bj]; const f32x4 v0 = acc[ai][bj][m][0] * q, v1 = acc[ai][bj][m][1] * q; u32x4 w;
                    w.x = cvt_pk_bf16(v0[0] * ubf0(g.x), v0[1] * ubf1(g.x)); w.y = cvt_pk_bf16(v0[2] * ubf2(g.x), v0[3] * ubf3(g.x));
                    w.z = cvt_pk_bf16(v1[0] * ubf0(g.y), v1[1] * ubf1(g.y)); w.w = cvt_pk_bf16(v1[2] * ubf2(g.y), v1[3] * ubf3(g.y));
                    *(u32x4*)(mp + bj * HALF) = w; } }
    }
};
typedef EpiG2catT<true, true> EpiG2cat;
struct EpiG3 {
    static constexpr bool PERM = false, AFTER_DRAIN = false, KHOOK = false;
    const float* x; float* out;
    __device__ __forceinline__ void operator()(const f32x4 (&acc)[2][2][4][2], const Unit& u, int wr, int wc, int fr, int fq) const {
        const int row0 = u.pm * BM + wr * 64 + fr, col0 = u.pn * BM + wc * 32 + 4 * fq;
        f32x4 xv[2][2][2][2];
#define G3_LOAD(B) do { _Pragma("unroll") for (int mm = 0; mm < 2; ++mm) { const size_t off_ = (size_t)(row0 + ((B) >> 1) * HALF + (2 * ((B) & 1) + mm) * 16) * DM + col0; \
            _Pragma("unroll") for (int bj = 0; bj < 2; ++bj) _Pragma("unroll") for (int n = 0; n < 2; ++n) xv[(B) & 1][mm][bj][n] = __builtin_nontemporal_load((const f32x4*)(x + off_ + bj * HALF + n * 16)); } } while (0)
#define G3_STORE(B) do { _Pragma("unroll") for (int mm = 0; mm < 2; ++mm) { const size_t off_ = (size_t)(row0 + ((B) >> 1) * HALF + (2 * ((B) & 1) + mm) * 16) * DM + col0; \
            _Pragma("unroll") for (int bj = 0; bj < 2; ++bj) _Pragma("unroll") for (int n = 0; n < 2; ++n) \
                __builtin_nontemporal_store(xv[(B) & 1][mm][bj][n] + acc[(B) >> 1][bj][2 * ((B) & 1) + mm][n], (f32x4*)(out + off_ + bj * HALF + n * 16)); } } while (0)
        G3_LOAD(0); G3_LOAD(1); __builtin_amdgcn_sched_barrier(0); G3_STORE(0); G3_STORE(1); __builtin_amdgcn_sched_barrier(0); G3_LOAD(2); G3_LOAD(3); __builtin_amdgcn_sched_barrier(0); G3_STORE(2); G3_STORE(3);
#undef G3_LOAD
#undef G3_STORE
    }
};
struct EpiNull {
    static constexpr bool PERM = true, AFTER_DRAIN = false, KHOOK = false;
    __device__ __forceinline__ void operator()(const f32x4 (&acc)[2][2][4][2], const Unit& u, int wr, int wc, int fr, int fq) const {
#pragma unroll
        for (int ai = 0; ai < 2; ++ai)
#pragma unroll
            for (int bj = 0; bj < 2; ++bj)
#pragma unroll
                for (int m = 0; m < 4; ++m) asm volatile("" :: "v"(acc[ai][bj][m][0]), "v"(acc[ai][bj][m][1]));
    }
};
struct OrderG1 {
    StaticOrder so; int pm0, nkv;
    __device__ void init(int hb, int G, int c) { so.init(HB_ROWS, NIN, G, c); pm0 = hb * (HB_ROWS / BM); nkv = hb == 0 ? (MMEM / BM) * 4 : 0; }
    __device__ bool next(int i, Unit& u) const {
        if (so.next(i, u)) { u.pm += pm0; return true; }
        const long j = (long)i * so.G + so.c - so.nwg; if (j < 0 || j >= nkv) return false;
        u.pm = 256 + (int)(j >> 2); u.pn = 35 + (int)(j & 3); return true;
    }
    __device__ __forceinline__ void a_ready(const Unit&) const {}
    __device__ __forceinline__ void done(const Unit&) const {}
};
}

#define GAS __attribute__((address_space(1)))
#define LAS __attribute__((address_space(3)))
typedef unsigned short bf16;
typedef unsigned v4u __attribute__((ext_vector_type(4)));
typedef float f32x4 __attribute__((ext_vector_type(4)));
typedef short bf16x8 __attribute__((ext_vector_type(8)));
typedef GAS unsigned gu32;
typedef GAS unsigned long long gu64;
#define RLX_AGENT __ATOMIC_RELAXED, __HIP_MEMORY_SCOPE_AGENT
#define LDS_WAIT() asm volatile("s_waitcnt lgkmcnt(0)" ::: "memory")
#define VM_WAIT() asm volatile("s_waitcnt vmcnt(0)" ::: "memory")
__device__ __forceinline__ unsigned long long rt() { return __builtin_amdgcn_s_memrealtime(); }
__device__ __forceinline__ unsigned f2bf(float f) { unsigned u = __builtin_bit_cast(unsigned, f); return (u + 0x7fffu + ((u >> 16) & 1u)) >> 16; }
__device__ __forceinline__ unsigned pk2(float lo, float hi) { return f2bf(lo) | (f2bf(hi) << 16); }

__device__ __forceinline__ int hw_lane() { int l; asm volatile("v_mbcnt_lo_u32_b32 %0, -1, 0\n\tv_mbcnt_hi_u32_b32 %0, -1, %0" : "=v"(l)); return l; }
__device__ __forceinline__ bool hw_thread0(int wave) { return wave == 0 && hw_lane() == 0; }
#define XB_TMO      128
#define XB_XCNT(j)  (256  + 64 * (j))
#define XB_XSUB(j)  (1280 + 64 * (j))
#define XB_XGEN(j)  (2304 + 64 * (j))
#define XB_TOP      3328
#define XB_TOPGEN   3392
#define XCD_BAR_WORDS 3456
#define XB_SPIN_CAP (1u << 18)

__device__ __forceinline__ unsigned xb_ld(unsigned* p)              { return __hip_atomic_load(p, __ATOMIC_RELAXED, __HIP_MEMORY_SCOPE_AGENT); }
__device__ __forceinline__ unsigned xb_add(unsigned* p, unsigned v) { return __hip_atomic_fetch_add(p, v, __ATOMIC_RELAXED, __HIP_MEMORY_SCOPE_AGENT); }
__device__ __forceinline__ unsigned xb_xcc_id() { return (unsigned)__builtin_amdgcn_s_getreg((3 << 11) | 20) & 0xFu; }
#define XB_SPIN(cond, bar) do { unsigned _sp = 0; while (cond) { __builtin_amdgcn_s_sleep(1); \
    if ((++_sp & 255u) == 0u) { if (xb_ld(&(bar)[XB_TMO])) break; if (_sp > XB_SPIN_CAP) { atomicAdd(&(bar)[XB_TMO], 1u); break; } } } } while (0)

struct XcdBarrier {
    unsigned* bar; unsigned x; int wave;
    volatile LAS unsigned* st;
};

__device__ __forceinline__ XcdBarrier xcd_barrier_post(unsigned* bar, volatile LAS unsigned* st, int wave) {
    XcdBarrier b; b.bar = bar; b.x = xb_xcc_id(); b.st = st; b.wave = wave;
    if (hw_thread0(wave)) (void)xb_add(&bar[XB_XCNT(b.x)], 1u);
    return b;
}
__device__ __forceinline__ void xcd_barrier_complete(unsigned* bar, unsigned x, unsigned& nloc, unsigned& nx) {
    const unsigned G = gridDim.x * gridDim.y * gridDim.z;
    unsigned sum, cnt, mine, sp = 0u;
    for (;;) {
        sum = 0u; cnt = 0u; mine = 0u;
#pragma unroll
        for (unsigned j = 0; j < 16; ++j) { const unsigned c = xb_ld(&bar[XB_XCNT(j)]); sum += c; cnt += (c > 0u) ? 1u : 0u; mine = (j == x) ? c : mine; }
        if (sum == G) break;
        __builtin_amdgcn_s_sleep(1);
        if ((++sp & 255u) == 0u) { if (xb_ld(&bar[XB_TMO])) break; if (sp > XB_SPIN_CAP) { atomicAdd(&bar[XB_TMO], 1u); break; } }
    }
    nloc = mine > 0u ? mine : 1u; nx = cnt > 0u ? cnt : 1u;
}

__device__ __forceinline__ void xcd_barrier(const XcdBarrier& b) {
    asm volatile("s_waitcnt vmcnt(0)" ::: "memory");
    __syncthreads();
    if (hw_thread0(b.wave)) {
        unsigned* bar = b.bar;
        __builtin_amdgcn_s_waitcnt(0);
        unsigned nloc = b.st[0], nx = b.st[1];
        if (nloc == 0u) { xcd_barrier_complete(bar, b.x, nloc, nx); b.st[0] = nloc; b.st[1] = nx; }
        const unsigned old = xb_add(&bar[XB_XSUB(b.x)], 1u);
        const unsigned gen = old / nloc;
        if (old + 1u == (gen + 1u) * nloc) {
            __builtin_amdgcn_fence(__ATOMIC_RELEASE, "agent");
            asm volatile("s_waitcnt vmcnt(0)" ::: "memory");
            const unsigned og = xb_add(&bar[XB_TOP], 1u);
            const unsigned tg = og / nx;
            if (og + 1u == (tg + 1u) * nx) xb_add(&bar[XB_TOPGEN], 1u);
            else XB_SPIN(xb_ld(&bar[XB_TOPGEN]) == tg, bar);
            __builtin_amdgcn_fence(__ATOMIC_ACQUIRE, "agent");
            xb_add(&bar[XB_XGEN(b.x)], 1u);
            asm volatile("s_waitcnt vmcnt(0)" ::: "memory");
        } else {
            XB_SPIN(xb_ld(&bar[XB_XGEN(b.x)]) == gen, bar);
            __builtin_amdgcn_fence(__ATOMIC_ACQUIRE, "agent");
            asm volatile("s_waitcnt vmcnt(0)" ::: "memory");
        }
    }
    __syncthreads();
}

__device__ __forceinline__ float wave_sum(float v) {
#pragma unroll
    for (int o = 1; o < 64; o <<= 1) v += __shfl_xor(v, o);
    return v;
}

constexpr int RING_OFF = 0, RING_BYTES = 131072;
constexpr int LDSCTL_OFF = RING_BYTES, MISC_OFF = LDSCTL_OFF + 320;
constexpr int LDS_BYTES = 147456;
constexpr int NWAVES = 8, NTHR = NWAVES * 64;
constexpr int WSCR_OFF = 132096;

__device__ __forceinline__ float bf2f(bf16 h) { return __builtin_bit_cast(float, (unsigned)h << 16); }
__device__ __forceinline__ float sigm_f(float x) { return 1.f / (1.f + __expf(-x)); }
__device__ __forceinline__ int t5_bucket(int d) {
    if (d < 16) return d;
    int b = 16;
    b += d >= 22; b += d >= 30; b += d >= 40; b += d >= 54; b += d >= 73; b += d >= 99; b += d >= 134; b += d >= 182; b += d >= 246; b += d >= 332; b += d >= 450; b += d >= 609; b += d >= 825; b += d >= 1117; b += d >= 1513;
    return b;
}

struct Ctx {
    const float *x, *mem, *norm_w, *w_in, *gate_b, *lnw, *lnb, *sp_w, *sp_b, *bqw, *bkw, *rel_bias, *mem_norm_w, *m_w_kv, *mqw, *mkw, *proj_a, *proj_b, *proj_m, *w_out;
    float* out;
    bf16 *WIN, *PCAT, *WOUT, *WSP, *XN, *PA, *KVM, *OG, *YC, *MRG; float *BIAS, *BIASX, *SS, *MKSS, *LSE, *LNST;
    LAS unsigned char* lds; int tid, lane, wave, G, gtid, T, gwave, NW, xgwave;
};

__device__ __forceinline__ void p0_transpose_item(const float* W, int N, bf16* WT, int ldt, int row_off, int koff, LAS float* scr, int item, int lane, bool gperm = false) {
    const int nblk = N / 32, kb = item / nblk, nb = item % nblk, k0 = 64 * kb, n0 = 32 * nb;
#pragma unroll 8
    for (int i = 0; i < 32; ++i) { const int kk = 2 * i + (lane >> 5); scr[kk * 33 + (lane & 31)] = W[(size_t)(k0 + kk) * N + n0 + (lane & 31)]; }
    LDS_WAIT(); asm volatile("" ::: "memory");
    const int c = lane & 7;
#pragma unroll
    for (int j = 0; j < 4; ++j) { const int n = (lane >> 3) + 8 * j; const LAS float* s = scr + (8 * c) * 33 + n;
        v4u o; o.x = pk2(s[0 * 33], s[1 * 33]); o.y = pk2(s[2 * 33], s[3 * 33]); o.z = pk2(s[4 * 33], s[5 * 33]); o.w = pk2(s[6 * 33], s[7 * 33]);
        int nn = n0 + n;
        if (gperm) {
            if (nn >= C_G) nn = (nn & ~255) + 128 * ((nn >> 3) & 1) + 32 * ((nn >> 6) & 3) + 8 * ((nn >> 4) & 3) + (nn & 7);
            else if (nn < C_AV) { const int T = nn >> 7; nn = 256 * (T < 3 ? T : T + 3) + (nn & 127); }
            else if (nn >= C_AZ && nn < C_BQ) { const int c = nn - C_AZ, T = c >> 7; nn = 256 * (T < 3 ? T : T + 3) + 128 + (c & 127); }
        }
        *(GAS v4u*)(WT + (size_t)(row_off + nn) * ldt + koff + k0 + 8 * c) = o; }
    LDS_WAIT(); asm volatile("" ::: "memory");
}
template <int NR> __device__ __forceinline__ void rms_rows_to_bf16(const float* src, const float* w, bf16* dst, size_t m0, size_t stride, int lane) {
    f32x4 v[NR][4]; float s[NR];
#pragma unroll
    for (int r = 0; r < NR; ++r) { const GAS f32x4* xr = (const GAS f32x4*)(src + (m0 + r * stride) * DM) + lane;
#pragma unroll
        for (int j = 0; j < 4; ++j) v[r][j] = __builtin_nontemporal_load(xr + 64 * j); }
    f32x4 ww[4];
#pragma unroll
    for (int j = 0; j < 4; ++j) ww[j] = ((const GAS f32x4*)w + lane)[64 * j];
#pragma unroll
    for (int r = 0; r < NR; ++r) { float a = 0.f;
#pragma unroll
        for (int j = 0; j < 4; ++j) a += (v[r][j].x * v[r][j].x + v[r][j].y * v[r][j].y) + (v[r][j].z * v[r][j].z + v[r][j].w * v[r][j].w);
        s[r] = rsqrtf(wave_sum(a) * (1.f / DM) + EPS); }
#pragma unroll
    for (int r = 0; r < NR; ++r) { GAS unsigned long long* o8 = (GAS unsigned long long*)(dst + (m0 + r * stride) * DM) + lane;
#pragma unroll
        for (int j = 0; j < 4; ++j) o8[64 * j] = (unsigned long long)pk2(v[r][j].x * s[r] * ww[j].x, v[r][j].y * s[r] * ww[j].y) | ((unsigned long long)pk2(v[r][j].z * s[r] * ww[j].z, v[r][j].w * s[r] * ww[j].w) << 32); }
}
__device__ __forceinline__ void p0_prologue(Ctx& F) {
    LAS float* scr = (LAS float*)(F.lds + RING_OFF + F.wave * 16384);
    constexpr int I_IN = 16 * (NIN / 32), I_KV = 16 * 32, I_PA = 12 * 32, I_PB = 4 * 32, I_PM = 8 * 32, I_WO = 16 * 32;
    constexpr int NITEMS = I_IN + I_KV + I_PA + I_PB + I_PM + I_WO;
    for (int it = F.gwave; it < NITEMS; it += F.NW) {
        int r = it;
        if (r < I_IN) { p0_transpose_item(F.w_in, NIN, F.WIN, DM, 0, 0, scr, r, F.lane, true); continue; } r -= I_IN;
        if (r < I_KV) { p0_transpose_item(F.m_w_kv, 1024, F.WIN, DM, NIN, 0, scr, r, F.lane); continue; } r -= I_KV;
        if (r < I_PA) { p0_transpose_item(F.proj_a, DM, F.PCAT, KC, 0, 0, scr, r, F.lane); continue; } r -= I_PA;
        if (r < I_PB) { p0_transpose_item(F.proj_b, DM, F.PCAT, KC, 0, 768, scr, r, F.lane); continue; } r -= I_PB;
        if (r < I_PM) { p0_transpose_item(F.proj_m, DM, F.PCAT, KC, 0, 1024, scr, r, F.lane); continue; } r -= I_PM;
        p0_transpose_item(F.w_out, DM, F.WOUT, DM, 0, 0, scr, r, F.lane);
    }
    for (int i = F.gtid; i < 4 * 128 * 128; i += F.T) { const int t = (i >> 7) & 127, s = i & 127; F.WSP[i] = (bf16)(s <= t ? f2bf(F.sp_w[i]) : 0u); }
    for (int i = F.gtid; i < 3 * 4 * 132; i += F.T) { const int g = i / (4 * 132), h = (i / 132) % 4, j = i % 132; const int dil = g == 0 ? 1 : (g == 1 ? 4 : 16);
        F.BIAS[i] = j <= 128 ? F.rel_bias[t5_bucket(j * dil) * 12 + 4 * g + h] : 0.f; }
    for (int i = F.gtid; i < 3 * 4 * 192; i += F.T) { const int g = i / (4 * 192), h = (i / 192) % 4, step = i % 192 - 31; const int dil = g == 0 ? 1 : (g == 1 ? 4 : 16);
        F.BIASX[i] = (step >= 0 && step <= 128) ? F.rel_bias[t5_bucket(step * dil) * 12 + 4 * g + h] * 1.4426950408889634f : -1e30f; }
    if ((MTOT % (4 * F.NW)) == 0 && (MMEM % (4 * F.NW)) == 0) {
        for (size_t m = F.gwave; m < (size_t)MTOT; m += 4 * (size_t)F.NW) rms_rows_to_bf16<4>(F.x, F.norm_w, F.XN, m, F.NW, F.lane);
        for (size_t m = F.gwave; m < (size_t)MMEM; m += 4 * (size_t)F.NW) rms_rows_to_bf16<4>(F.mem, F.mem_norm_w, F.XN + (size_t)MTOT * DM, m, F.NW, F.lane);
    } else {
        for (size_t m = F.gwave; m < (size_t)MTOT; m += F.NW) rms_rows_to_bf16<1>(F.x, F.norm_w, F.XN, m, 0, F.lane);
        for (size_t m = F.gwave; m < (size_t)MMEM; m += F.NW) rms_rows_to_bf16<1>(F.mem, F.mem_norm_w, F.XN + (size_t)MTOT * DM, m, 0, F.lane);
    }
}


typedef float f32x16 __attribute__((ext_vector_type(16)));
typedef short s16x4 __attribute__((ext_vector_type(4)));
__device__ __forceinline__ int crow(int r, int hi) { return (r & 3) + 8 * (r >> 2) + 4 * hi; }
__device__ __forceinline__ unsigned cvtpk(float lo, float hi) { return pg8::cvt_pk_bf16(lo, hi); }
__device__ __forceinline__ s16x4 vtr(const LAS unsigned char* p) { typedef short v4i16_t __attribute__((ext_vector_type(4))); return __builtin_bit_cast(s16x4, __builtin_amdgcn_ds_read_tr16_b64_v4i16((LAS v4i16_t*)p)); }
__device__ __forceinline__ float bflo(unsigned w) { return __uint_as_float(w << 16); }
__device__ __forceinline__ float bfhi(unsigned w) { return __uint_as_float(w & 0xffff0000u); }
constexpr float LOG2E = 1.4426950408889634f, LN2 = 0.6931471805599453f;
constexpr int NBX = 192;


__device__ __forceinline__ void dma16(const void* gsrc, LAS unsigned char* ldst) { __builtin_amdgcn_global_load_lds((const unsigned*)gsrc, (LAS unsigned*)ldst, 16, 0, 0); }
#define VM_WAIT0() asm volatile("s_waitcnt vmcnt(0)" ::: "memory")
__device__ __forceinline__ void st_mixA_mfma(Ctx& F) {
    const int lane = hw_lane(), r32 = lane & 31, hi = lane >> 5, tid = F.wave * 64 + lane;
    LAS unsigned char* wl = F.lds + RING_OFF + F.wave * 16384;
    typedef float f32x2v __attribute__((ext_vector_type(2))); typedef unsigned u32x2v __attribute__((ext_vector_type(2)));
    LAS f32x2v* tab = (LAS f32x2v*)(F.lds + WSCR_OFF + 8192);
    const int g = F.wave >> 1, ch = lane & 3;
    bf16x8 wf[14];
    const bf16* wrow0 = F.WSP + (size_t)(g * 128 + r32) * 128 + 8 * hi;
    { int n = 0;
#pragma unroll
      for (int tb = 2; tb < 4; ++tb)
#pragma unroll
          for (int ks = 0; ks < 2 * (tb + 1); ++ks) wf[n++] = *(const bf16x8*)(wrow0 + (size_t)tb * 32 * 128 + 16 * ks); }
    for (int unit = blockIdx.x; unit < HB_ROWS / 128; unit += F.G) {
        const int rowbase = unit * 128;
        v4u raw[8];
        { const int c0 = g * 192 + (F.wave & 1) * 96;
#pragma unroll
          for (int i = 0; i < 8; ++i) raw[i] = *(const v4u*)(F.PA + (size_t)(rowbase + (lane >> 2) + 16 * i) * PAP + C_AV + c0 + 8 * ch); }
        { const int row = tid >> 2, part = tid & 3; const float* sp = F.SS + (size_t)(rowbase + row) * SS_W + 12 * part; float s = 0.f, q = 0.f;
#pragma unroll
          for (int k = 0; k < 6; ++k) { s += sp[2 * k]; q += sp[2 * k + 1]; }
          s += __shfl_xor(s, 1); s += __shfl_xor(s, 2); q += __shfl_xor(q, 1); q += __shfl_xor(q, 2);
          const float mu = s * (1.f / 768.f), var = q * (1.f / 768.f) - mu * mu;
          if (part == 0) tab[row] = (f32x2v){mu, rsqrtf(fmaxf(var, 0.f) + EPS)}; }
        __syncthreads();
#pragma unroll 1
        for (int cbi = 0; cbi < 3; ++cbi) {
            const int c0 = g * 192 + ((F.wave & 1) * 3 + cbi) * 32;
            const f32x4 w0 = *(const f32x4*)(F.lnw + c0 + 8 * ch), w1 = *(const f32x4*)(F.lnw + c0 + 8 * ch + 4), b0 = *(const f32x4*)(F.lnb + c0 + 8 * ch), b1 = *(const f32x4*)(F.lnb + c0 + 8 * ch + 4);
#pragma unroll
            for (int i = 0; i < 8; ++i) { const int s = (lane >> 2) + 16 * i; const f32x2v st = tab[s]; const v4u rw = raw[i]; v4u o;
                o.x = cvtpk((bflo(rw.x) - st.x) * st.y * w0.x + b0.x, (bfhi(rw.x) - st.x) * st.y * w0.y + b0.y); o.y = cvtpk((bflo(rw.y) - st.x) * st.y * w0.z + b0.z, (bfhi(rw.y) - st.x) * st.y * w0.w + b0.w);
                o.z = cvtpk((bflo(rw.z) - st.x) * st.y * w1.x + b1.x, (bfhi(rw.z) - st.x) * st.y * w1.y + b1.y); o.w = cvtpk((bflo(rw.w) - st.x) * st.y * w1.z + b1.z, (bfhi(rw.w) - st.x) * st.y * w1.w + b1.w);
                *(LAS v4u*)(wl + (s >> 3) * 512 + (s & 7) * 64 + ch * 16) = o; }
            if (cbi < 2) {
#pragma unroll
                for (int i = 0; i < 8; ++i) raw[i] = *(const v4u*)(F.PA + (size_t)(rowbase + (lane >> 2) + 16 * i) * PAP + C_AV + c0 + 32 + 8 * ch); }
            LAS unsigned char* uzb = wl + 8192;
#pragma unroll
            for (int p = 0; p < 8; ++p) { const int row_ = 16 * p + (lane >> 2);
                dma16(F.PA + (size_t)(rowbase + row_) * PAP + C_AU + c0 + 8 * ((lane & 3) ^ ((row_ >> 2) & 3)), uzb + p * 1024); }
            const LAS unsigned char* vb = wl + hi * 512 + ((lane & 15) >> 2) * 64 + ((lane >> 4) & 1) * 32 + (lane & 3) * 8;
            const bf16* wr2 = wrow0; asm volatile("" : "+v"(wr2));
            bf16x8 wq[6];
            { int n2 = 0;
#pragma unroll
              for (int tb = 0; tb < 2; ++tb)
#pragma unroll
                  for (int ks = 0; ks < 2 * (tb + 1); ++ks) wq[n2++] = *(const bf16x8*)(wr2 + (size_t)tb * 32 * 128 + 16 * ks); }
            int n = 0, nq = 0;
#pragma unroll
            for (int tb = 0; tb < 4; ++tb) { f32x16 acc = {};
#pragma unroll
                for (int ks = 0; ks < 2 * (tb + 1); ++ks) { const s16x4 a = vtr(vb + ks * 1024), c = vtr(vb + ks * 1024 + 256); const bf16x8 af = {a[0], a[1], a[2], a[3], c[0], c[1], c[2], c[3]};
                    acc = __builtin_amdgcn_mfma_f32_32x32x16_bf16(af, tb < 2 ? wq[nq++] : wf[n++], acc, 0, 0, 0); }
                const int t = 32 * tb + r32; const float sb = F.sp_b[g * 128 + t];
                if (tb == 0) VM_WAIT0();
                LAS unsigned char* urow = uzb + t * 64 + 8 * hi; const int fsw = (r32 >> 2) & 3;
#pragma unroll
                for (int i = 0; i < 4; ++i) { LAS u32x2v* up = (LAS u32x2v*)(urow + ((i ^ fsw) * 16)); const u32x2v u = *up; u32x2v w;
                    w.x = cvtpk(bflo(u.x) * (acc[4 * i] + sb), bfhi(u.x) * (acc[4 * i + 1] + sb)); w.y = cvtpk(bflo(u.y) * (acc[4 * i + 2] + sb), bfhi(u.y) * (acc[4 * i + 3] + sb));
                    *up = w; }
#pragma unroll
                for (int jr = 0; jr < 2; ++jr) { const int row_ = 32 * tb + 16 * jr + (lane >> 2); const v4u yv = *(const LAS v4u*)(uzb + row_ * 64 + (lane & 3) * 16);
                    *(v4u*)(F.YC + (size_t)(rowbase + row_) * KC + c0 + 8 * ((lane & 3) ^ ((row_ >> 2) & 3))) = yv; } }
        }
        __syncthreads();
    }
}

__device__ __forceinline__ void st_mergeB_vec(Ctx& F) {
    constexpr int NI = 4;
    const int total = HB_ROWS * 32;
    for (int g0 = F.gtid; g0 < total; g0 += NI * F.T) {
        v4u a[NI], b[NI], c[NI], z[NI]; float l0[NI], l1[NI], l2[NI];
#pragma unroll
        for (int i = 0; i < NI; ++i) { const int gid = g0 + i * F.T < total ? g0 + i * F.T : g0; const int r = gid >> 5, c8 = (gid & 31) * 8, h = c8 >> 6;
            l0[i] = F.LSE[((size_t)0 * HB_ROWS + r) * 4 + h]; l1[i] = F.LSE[((size_t)1 * HB_ROWS + r) * 4 + h]; l2[i] = F.LSE[((size_t)2 * HB_ROWS + r) * 4 + h];
            a[i] = *(const v4u*)(F.OG + ((size_t)0 * HB_ROWS + r) * 256 + c8); b[i] = *(const v4u*)(F.OG + ((size_t)1 * HB_ROWS + r) * 256 + c8); c[i] = *(const v4u*)(F.OG + ((size_t)2 * HB_ROWS + r) * 256 + c8);
            z[i] = *(const v4u*)(F.PA + (size_t)r * PAP + C_BZ + c8); }
        __builtin_amdgcn_sched_barrier(0);
#pragma unroll
        for (int i = 0; i < NI; ++i) { if (g0 + i * F.T >= total) break; const int gid = g0 + i * F.T; const int r = gid >> 5, c8 = (gid & 31) * 8;
            const float mx = fmaxf(l0[i], fmaxf(l1[i], l2[i])); float e0 = __expf(l0[i] - mx), e1 = __expf(l1[i] - mx), e2 = __expf(l2[i] - mx); const float inv = 1.f / (e0 + e1 + e2); e0 *= inv; e1 *= inv; e2 *= inv;
            v4u o;
#define MB_1(X) X = pk2((e0 * bflo(a[i].X) + e1 * bflo(b[i].X) + e2 * bflo(c[i].X)) * bflo(z[i].X), (e0 * bfhi(a[i].X) + e1 * bfhi(b[i].X) + e2 * bfhi(c[i].X)) * bfhi(z[i].X))
            o.MB_1(x); o.MB_1(y); o.MB_1(z); o.MB_1(w);
#undef MB_1
            *(v4u*)(F.YC + (size_t)r * KC + 768 + c8) = o; }
    }
}


__device__ __forceinline__ void st_attnM_v3(Ctx& F, int hb) {
    const int lane = hw_lane(), r32 = lane & 31, hi = lane >> 5;
    LAS unsigned char* kimg = F.lds + RING_OFF; LAS unsigned char* vimg = F.lds + RING_OFF + 65536;
    LAS float* kstab = (LAS float*)(F.lds + WSCR_OFF + 8192);
    typedef unsigned u32x2v __attribute__((ext_vector_type(2)));
    const int vcu = F.xgwave >> 3;
    __syncthreads();
    for (int task = vcu; task < 256; task += F.G) {
        const int bh = task >> 2, b = bh >> 2, h = bh & 3; const size_t kbase = (size_t)(hb * 16 + b) * MEML;
#pragma unroll
        for (int j = 0; j < 8; ++j) { const int p = F.wave * 8 + j, row = 4 * p + (lane >> 4);
            dma16(F.KVM + (kbase + row) * 1024 + h * 128 + 8 * ((lane & 15) ^ (row & 15)), kimg + p * 1024);
            dma16(F.KVM + (kbase + 8 * (p >> 1) + ((lane & 31) >> 2)) * 1024 + 512 + h * 128 + (2 * (p & 1) + (lane >> 5)) * 32 + (lane & 3) * 8, vimg + p * 1024); }
        { const int key = F.wave * 32 + r32; const float* sp = F.MKSS + (kbase + key) * 16 + 4 * h;
          const float ksv = rsqrtf(((sp[0] + sp[1]) + (sp[2] + sp[3])) * (1.f / 128.f) + EPS); if (lane < 32) kstab[key] = ksv; }
        VM_WAIT0(); __syncthreads();
#pragma unroll 1
        for (int qi = 0; qi < 2; ++qi) {
            const int qb = (task & 3) * 16 + F.wave * 2 + qi;
            const size_t qrow = (size_t)(b * SEQ + qb * 32 + r32);
            const float qs = rsqrtf(((F.SS[qrow * SS_W + 96 + 4 * h] + F.SS[qrow * SS_W + 96 + 4 * h + 1]) + (F.SS[qrow * SS_W + 96 + 4 * h + 2] + F.SS[qrow * SS_W + 96 + 4 * h + 3])) * (1.f / 128.f) + EPS) * (0.08838834764831845f * LOG2E);
            bf16x8 qf[8];
#pragma unroll
            for (int d0 = 0; d0 < 8; ++d0) { const int dd = 16 * d0 + 8 * hi;
                const v4u raw = *(const v4u*)(F.PA + qrow * PAP + C_MQ + h * 128 + dd);
                const f32x4 wa = *(const f32x4*)(F.mqw + dd), wb = *(const f32x4*)(F.mqw + dd + 4), ka = *(const f32x4*)(F.mkw + dd), kb = *(const f32x4*)(F.mkw + dd + 4);
                v4u o;
                o.x = cvtpk(bflo(raw.x) * qs * wa.x * ka.x, bfhi(raw.x) * qs * wa.y * ka.y); o.y = cvtpk(bflo(raw.y) * qs * wa.z * ka.z, bfhi(raw.y) * qs * wa.w * ka.w);
                o.z = cvtpk(bflo(raw.z) * qs * wb.x * kb.x, bfhi(raw.z) * qs * wb.y * kb.y); o.w = cvtpk(bflo(raw.w) * qs * wb.z * kb.z, bfhi(raw.w) * qs * wb.w * kb.w);
                qf[d0] = __builtin_bit_cast(bf16x8, o); }
            u32x2v zz[4][4];
#pragma unroll
            for (int db = 0; db < 4; ++db)
#pragma unroll
                for (int i = 0; i < 4; ++i) zz[db][i] = *(const u32x2v*)(F.PA + qrow * PAP + C_MZ + h * 128 + 4 * hi + db * 32 + 8 * i);
            float mrun = -1e30f, lrun = 0.f; f32x16 o0 = {}, o1 = {}, o2 = {}, o3 = {};
            const LAS unsigned char* kb0 = kimg + r32 * 256; const int ksw = r32 & 15;
            const LAS unsigned char* vb0 = vimg + (4 * hi + ((lane & 15) >> 2)) * 64 + ((lane >> 4) & 1) * 32 + (lane & 3) * 8;
#pragma unroll 2
            for (int t = 0; t < MEML / 32; ++t) {
                f32x16 st = {};
#pragma unroll
                for (int d0 = 0; d0 < 8; ++d0) { const bf16x8 kf = *(const LAS bf16x8*)(kb0 + t * 8192 + (((2 * d0 + hi) ^ ksw) * 16)); st = __builtin_amdgcn_mfma_f32_32x32x16_bf16(kf, qf[d0], st, 0, 0, 0); }
                float tmax = -1e30f;
#pragma unroll
                for (int i = 0; i < 4; ++i) { const f32x4 kk = *(const LAS f32x4*)(kstab + 32 * t + 8 * i + 4 * hi);
#pragma unroll
                    for (int j = 0; j < 4; ++j) { const float s = st[4 * i + j] * kk[j]; st[4 * i + j] = s; tmax = fmaxf(tmax, s); } }
                tmax = fmaxf(tmax, __shfl_xor(tmax, 32));
                const float mnew = fmaxf(mrun, tmax), alpha = __builtin_amdgcn_exp2f(mrun - mnew); mrun = mnew;
                float psum = 0.f;
#pragma unroll
                for (int r = 0; r < 16; ++r) { st[r] = __builtin_amdgcn_exp2f(st[r] - mnew); psum += st[r]; }
                lrun = lrun * alpha + psum;
#pragma unroll
                for (int r = 0; r < 16; ++r) { o0[r] *= alpha; o1[r] *= alpha; o2[r] *= alpha; o3[r] *= alpha; }
                v4u p0, p1;
                p0.x = cvtpk(st[0], st[1]); p0.y = cvtpk(st[2], st[3]); p0.z = cvtpk(st[4], st[5]); p0.w = cvtpk(st[6], st[7]);
                p1.x = cvtpk(st[8], st[9]); p1.y = cvtpk(st[10], st[11]); p1.z = cvtpk(st[12], st[13]); p1.w = cvtpk(st[14], st[15]);
                const LAS unsigned char* vb = vb0 + t * 8192;
#define AM_PV(OX, DB) do { _Pragma("unroll") for (int s = 0; s < 2; ++s) { const bf16x8 pf = __builtin_bit_cast(bf16x8, s == 0 ? p0 : p1); \
                    const s16x4 a = vtr(vb + (2 * s) * 2048 + (DB) * 512), c = vtr(vb + (2 * s + 1) * 2048 + (DB) * 512); const bf16x8 vf = {a[0], a[1], a[2], a[3], c[0], c[1], c[2], c[3]}; \
                    OX = __builtin_amdgcn_mfma_f32_32x32x16_bf16(vf, pf, OX, 0, 0, 0); } } while (0)
                AM_PV(o0, 0); AM_PV(o1, 1); AM_PV(o2, 2); AM_PV(o3, 3);
#undef AM_PV
            }
            const float ltot = lrun + __shfl_xor(lrun, 32), inv = 1.f / ltot;
            bf16* yrow = F.YC + qrow * KC + 1024 + h * 128 + 4 * hi;
#define AM_ST(OX, DB) do { _Pragma("unroll") for (int i = 0; i < 4; ++i) { const u32x2v z = zz[DB][i]; u32x2v w; \
                w.x = cvtpk(OX[4 * i] * inv * bflo(z.x), OX[4 * i + 1] * inv * bfhi(z.x)); w.y = cvtpk(OX[4 * i + 2] * inv * bflo(z.y), OX[4 * i + 3] * inv * bfhi(z.y)); \
                *(u32x2v*)(yrow + (DB) * 32 + 8 * i) = w; } } while (0)
            AM_ST(o0, 0); AM_ST(o1, 1); AM_ST(o2, 2); AM_ST(o3, 3);
#undef AM_ST
        }
        __syncthreads();
    }
}

__device__ __forceinline__ void st_attnB_v3(Ctx& F) {
    const int lane = hw_lane(), r32 = lane & 31, hi = lane >> 5, tid = F.wave * 64 + lane;
    LAS unsigned char* kimg = F.lds + RING_OFF; LAS unsigned char* vimg = F.lds + RING_OFF + 49152;
    LAS float* kstab = (LAS float*)(F.lds + RING_OFF + 98304);
    LAS float* btab = (LAS float*)(F.lds + RING_OFF + 98304 + 2048);
    typedef unsigned u32x2v __attribute__((ext_vector_type(2)));
    const int vcu = F.xgwave >> 3;
    __syncthreads();
    for (int unit = vcu; unit < 3 * 16 * 4 * 8; unit += F.G) {
        const int k = unit & 7, h = (unit >> 3) & 3, b = (unit >> 5) & 15, g = unit >> 9, hh = 4 * g + h;
        const int dil = g == 0 ? 1 : (g == 1 ? 4 : 16);
        const int res0 = g == 0 ? 0 : (g == 1 ? (k >> 1) : 2 * k), j0 = g == 0 ? 8 * k : (g == 1 ? 8 * (k & 1) : 0);
#pragma unroll
        for (int i = 0; i < 12; ++i) { const int q = F.wave * 12 + i, s = q >> 3, pc = q & 7, p = pc & 3;
            int res, jt; bool valid;
            if (g < 2) { res = res0; jt = j0 - 4 + s; valid = jt >= 0; } else { res = res0 + (s >> 2); jt = s & 3; valid = s < 8; }
            if (valid) {
                if (pc < 4) { const int row = 8 * p + (lane >> 3); const size_t trow = (size_t)(b * SEQ + res + (32 * jt + row) * dil);
                    dma16(F.PA + trow * PAP + C_BK + hh * 64 + 8 * ((lane & 7) ^ ((row >> 1) & 7)), kimg + s * 4096 + p * 1024); }
                else { const int key = 8 * p + ((lane & 31) >> 2); const size_t trow = (size_t)(b * SEQ + res + (32 * jt + key) * dil);
                    dma16(F.PA + trow * PAP + C_BV + hh * 64 + (lane >> 5) * 32 + (lane & 3) * 8, vimg + s * 4096 + p * 1024); } } }
        if (tid < 384) { const int s = tid >> 5, kk = tid & 31; int res, jt; bool valid;
            if (g < 2) { res = res0; jt = j0 - 4 + s; valid = jt >= 0; } else { res = res0 + (s >> 2); jt = s & 3; valid = s < 8; }
            if (valid) { const size_t trow = (size_t)(b * SEQ + res + (32 * jt + kk) * dil);
                kstab[tid] = rsqrtf((F.SS[trow * SS_W + 72 + 2 * hh] + F.SS[trow * SS_W + 72 + 2 * hh + 1]) * (1.f / 64.f) + EPS); } }
        if (tid < NBX) btab[tid] = F.BIASX[(g * 4 + h) * NBX + tid];
        const int wres = g < 2 ? res0 : res0 + (F.wave >> 2), j = g < 2 ? j0 + F.wave : (F.wave & 3);
        const int sbase = g < 2 ? 4 - j0 : (F.wave >> 2) * 4;
        const size_t qrow = (size_t)(b * SEQ + wres + (32 * j + r32) * dil);
        const float qs = rsqrtf((F.SS[qrow * SS_W + 48 + 2 * hh] + F.SS[qrow * SS_W + 48 + 2 * hh + 1]) * (1.f / 64.f) + EPS) * (0.125f * LOG2E);
        bf16x8 qf[4];
#pragma unroll
        for (int d0 = 0; d0 < 4; ++d0) { const int dd = 16 * d0 + 8 * hi;
            const v4u raw = *(const v4u*)(F.PA + qrow * PAP + C_BQ + hh * 64 + dd);
            const f32x4 wa = *(const f32x4*)(F.bqw + dd), wb = *(const f32x4*)(F.bqw + dd + 4), ka = *(const f32x4*)(F.bkw + dd), kb = *(const f32x4*)(F.bkw + dd + 4);
            v4u o;
            o.x = cvtpk(bflo(raw.x) * qs * wa.x * ka.x, bfhi(raw.x) * qs * wa.y * ka.y); o.y = cvtpk(bflo(raw.y) * qs * wa.z * ka.z, bfhi(raw.y) * qs * wa.w * ka.w);
            o.z = cvtpk(bflo(raw.z) * qs * wb.x * kb.x, bfhi(raw.z) * qs * wb.y * kb.y); o.w = cvtpk(bflo(raw.w) * qs * wb.z * kb.z, bfhi(raw.w) * qs * wb.w * kb.w);
            qf[d0] = __builtin_bit_cast(bf16x8, o); }
        VM_WAIT0(); __syncthreads();
        float mrun = -1e30f, lrun = 0.f; f32x16 o0 = {}, o1 = {};
        const int ksw = (r32 >> 1) & 7;
        for (int jt = (j >= 4 ? j - 4 : 0); jt <= j; ++jt) {
            const int s = sbase + jt;
            const LAS unsigned char* kb = kimg + s * 4096 + r32 * 128;
            f32x16 st = {};
#pragma unroll
            for (int d0 = 0; d0 < 4; ++d0) { const bf16x8 kf = *(const LAS bf16x8*)(kb + (((2 * d0 + hi) ^ ksw) * 16)); st = __builtin_amdgcn_mfma_f32_32x32x16_bf16(kf, qf[d0], st, 0, 0, 0); }
            const int bidx = 32 * (j - jt) + r32 + 31 - 4 * hi;
            float tmax = -1e30f;
#pragma unroll
            for (int i = 0; i < 4; ++i) { const f32x4 kk = *(const LAS f32x4*)(kstab + s * 32 + 8 * i + 4 * hi);
#pragma unroll
                for (int jj = 0; jj < 4; ++jj) { const float sv = st[4 * i + jj] * kk[jj] + btab[bidx - 8 * i - jj]; st[4 * i + jj] = sv; tmax = fmaxf(tmax, sv); } }
            tmax = fmaxf(tmax, __shfl_xor(tmax, 32));
            const float mnew = fmaxf(mrun, tmax), alpha = __builtin_amdgcn_exp2f(mrun - mnew); mrun = mnew;
            float psum = 0.f;
#pragma unroll
            for (int r = 0; r < 16; ++r) { st[r] = __builtin_amdgcn_exp2f(st[r] - mnew); psum += st[r]; }
            lrun = lrun * alpha + psum;
#pragma unroll
            for (int r = 0; r < 16; ++r) { o0[r] *= alpha; o1[r] *= alpha; }
            v4u p0, p1;
            p0.x = cvtpk(st[0], st[1]); p0.y = cvtpk(st[2], st[3]); p0.z = cvtpk(st[4], st[5]); p0.w = cvtpk(st[6], st[7]);
            p1.x = cvtpk(st[8], st[9]); p1.y = cvtpk(st[10], st[11]); p1.z = cvtpk(st[12], st[13]); p1.w = cvtpk(st[14], st[15]);
            const LAS unsigned char* vb = vimg + s * 4096 + (4 * hi + ((lane & 15) >> 2)) * 64 + ((lane >> 4) & 1) * 32 + (lane & 3) * 8;
#pragma unroll
            for (int ss = 0; ss < 2; ++ss) { const bf16x8 pf = __builtin_bit_cast(bf16x8, ss == 0 ? p0 : p1);
                { const s16x4 a = vtr(vb + (2 * ss) * 1024), c = vtr(vb + (2 * ss + 1) * 1024); const bf16x8 vf = {a[0], a[1], a[2], a[3], c[0], c[1], c[2], c[3]};
                  o0 = __builtin_amdgcn_mfma_f32_32x32x16_bf16(vf, pf, o0, 0, 0, 0); }
                { const s16x4 a = vtr(vb + (2 * ss) * 1024 + 512), c = vtr(vb + (2 * ss + 1) * 1024 + 512); const bf16x8 vf = {a[0], a[1], a[2], a[3], c[0], c[1], c[2], c[3]};
                  o1 = __builtin_amdgcn_mfma_f32_32x32x16_bf16(vf, pf, o1, 0, 0, 0); } }
        }
        const float ltot = lrun + __shfl_xor(lrun, 32), inv = 1.f / ltot;
        bf16* orow = F.OG + ((size_t)g * HB_ROWS + qrow) * 256 + h * 64 + 4 * hi;
#pragma unroll
        for (int i = 0; i < 4; ++i) { u32x2v w0, w1; w0.x = cvtpk(o0[4 * i] * inv, o0[4 * i + 1] * inv); w0.y = cvtpk(o0[4 * i + 2] * inv, o0[4 * i + 3] * inv);
            w1.x = cvtpk(o1[4 * i] * inv, o1[4 * i + 1] * inv); w1.y = cvtpk(o1[4 * i + 2] * inv, o1[4 * i + 3] * inv);
            *(u32x2v*)(orow + 8 * i) = w0; *(u32x2v*)(orow + 32 + 8 * i) = w1; }
        if (hi == 0) F.LSE[((size_t)g * HB_ROWS + qrow) * 4 + h] = (mrun + __log2f(ltot)) * LN2;
        __syncthreads();
    }
}

#ifndef G1_STAGGER_TICKS
#define G1_STAGGER_TICKS 0
#endif
#ifndef G1_ALIGN_EPI
#define G1_ALIGN_EPI true
#endif
#ifndef PROBE_REP
#define PROBE_REP -1
#endif
#define REPS(id) for (int rep_ = 0; rep_ < ((PROBE_REP) == (id) ? 2 : 1); ++rep_)
#ifndef MK_PER_PHASE
#define MK_PER_PHASE 0
#endif
constexpr int NPH_HALF = 5, NPHASES = 1 + 2 * NPH_HALF;
struct Args { const float* in[20]; float* out; unsigned char* ws; int ph_lo, ph_hi; };
__global__ void __launch_bounds__(NTHR, 2) mega_fwd(Args args) {
    extern __shared__ __attribute__((aligned(16))) unsigned char lds_raw[];
    Ctx F;
    F.lds = (LAS unsigned char*)lds_raw;
    F.tid = threadIdx.x; F.lane = F.tid & 63; F.wave = __builtin_amdgcn_readfirstlane(F.tid >> 6);
    F.G = gridDim.x; F.gtid = blockIdx.x * NTHR + F.tid; F.T = F.G * NTHR; F.gwave = blockIdx.x * NWAVES + F.wave; F.NW = F.G * NWAVES;
    { const int bx = blockIdx.x; const int vcu = (F.G % 8 == 0) ? (bx % 8) * (F.G / 8) + bx / 8 : bx; F.xgwave = vcu * NWAVES + F.wave; }
    unsigned char* ws = args.ws;
    F.x = args.in[0]; F.mem = args.in[1]; F.norm_w = args.in[2]; F.w_in = args.in[3]; F.gate_b = args.in[4]; F.lnw = args.in[5]; F.lnb = args.in[6]; F.sp_w = args.in[7];
    F.sp_b = args.in[8]; F.bqw = args.in[9]; F.bkw = args.in[10]; F.rel_bias = args.in[11]; F.mem_norm_w = args.in[12]; F.m_w_kv = args.in[13]; F.mqw = args.in[14]; F.mkw = args.in[15];
    F.proj_a = args.in[16]; F.proj_b = args.in[17]; F.proj_m = args.in[18]; F.w_out = args.in[19]; F.out = args.out;
    F.WIN = (bf16*)(ws + WS_WIN); F.PCAT = (bf16*)(ws + WS_PCAT); F.WOUT = (bf16*)(ws + WS_WOUT); F.WSP = (bf16*)(ws + WS_WSP); F.BIAS = (float*)(ws + WS_BIAS); F.BIASX = (float*)(ws + WS_BIAS + 65536);
    F.XN = (bf16*)(ws + WS_XN); F.PA = (bf16*)(ws + WS_PA); F.KVM = (bf16*)(ws + WS_KVM); F.SS = (float*)(ws + WS_SS); F.MKSS = (float*)(ws + WS_MKSS);
    F.OG = (bf16*)(ws + WS_OG); F.LSE = (float*)(ws + WS_LSE); F.LNST = (float*)(ws + WS_LNST); F.YC = (bf16*)(ws + WS_YC); F.MRG = (bf16*)(ws + WS_MRG);
    for (int u = F.tid; u < (LDS_BYTES - LDSCTL_OFF) / 4; u += NTHR) ((LAS unsigned*)(F.lds + LDSCTL_OFF))[u] = 0u;
    __syncthreads();
    XcdBarrier bar; bar.bar = (unsigned*)(ws + WS_CTL) + CW_BAR; bar.x = 0; bar.st = nullptr; bar.wave = 0;
    if (!MK_PER_PHASE) bar = xcd_barrier_post((unsigned*)(ws + WS_CTL) + CW_BAR, (volatile LAS unsigned*)(F.lds + MISC_OFF) + 8, F.wave);
    const int lo = args.ph_lo, hi = args.ph_hi;
#define IN(k) (lo <= (k) && (k) < hi)
#define SEAM(k) do { if (IN(k) && IN((k) + 1)) xcd_barrier(bar); } while (0)

    if (IN(0)) { REPS(0) p0_prologue(F); } SEAM(0);
#pragma unroll 1
    for (int hb = 0; hb < 2; ++hb) {
        const int pb = 1 + hb * NPH_HALF, row0 = hb * HB_ROWS;
        asm volatile("v_mbcnt_lo_u32_b32 %0, -1, 0\n\tv_mbcnt_hi_u32_b32 %0, -1, %0" : "=v"(F.lane)); F.tid = F.wave * 64 + F.lane; F.gtid = blockIdx.x * NTHR + F.tid;
#if PROBE_REP == 9 || PROBE_REP == 10
        if (IN(pb + 0)) { pg8::Gemm g{F.XN, F.WIN, MTOT + MMEM, NIN + 1024, DM, DM, DM}; pg8::OrderG1 S; S.init(hb, F.G, (int)blockIdx.x);
            typedef pg8::EpiProjT<PROBE_REP - 8> EP; EP E{F.PA, F.KVM, F.SS, F.MKSS, F.gate_b, hb * (HB_ROWS / 256), 0};
            pg8::gemm_phase<EP, pg8::OrderG1, true, true>(F.lds + RING_OFF, g, S, E, F.wave); }
#endif
        if (IN(pb + 0)) REPS(1) {
            pg8::Gemm g{F.XN, F.WIN, MTOT + MMEM, NIN + 1024, DM, DM, DM}; pg8::OrderG1 S; S.init(hb, F.G, (int)blockIdx.x);
#if G1_STAGGER_TICKS
            { const unsigned long long t0 = __builtin_amdgcn_s_memrealtime(), dl = (unsigned long long)((blockIdx.x >> 3) & 31) * G1_STAGGER_TICKS;
              while (__builtin_amdgcn_s_memrealtime() - t0 < dl) __builtin_amdgcn_s_sleep(8); }
#endif
            pg8::EpiProj E{F.PA, F.KVM, F.SS, F.MKSS, F.gate_b, hb * (HB_ROWS / 256), 0};
            pg8::gemm_phase<pg8::EpiProj, pg8::OrderG1, G1_ALIGN_EPI, true>(F.lds + RING_OFF, g, S, E, F.wave);
        }
#if PROBE_REP == 8
        if (IN(pb + 0)) { pg8::Gemm g{F.XN, F.WIN, MTOT + MMEM, NIN + 1024, DM, DM, DM}; pg8::OrderG1 S; S.init(hb, F.G, (int)blockIdx.x); pg8::EpiNull E{};
            pg8::gemm_phase<pg8::EpiNull, pg8::OrderG1, true, true>(F.lds + RING_OFF, g, S, E, F.wave); }
#endif
        SEAM(pb + 0);
        if (IN(pb + 1)) { REPS(2) st_mixA_mfma(F); REPS(3) st_attnB_v3(F); REPS(4) st_attnM_v3(F, hb); } SEAM(pb + 1);
        if (IN(pb + 2)) { REPS(5) st_mergeB_vec(F); } SEAM(pb + 2);
#if PROBE_REP == 13 || PROBE_REP == 14
        if (IN(pb + 3)) { pg8::Gemm g{F.YC, F.PCAT, HB_ROWS, DM, KC, KC, KC}; pg8::StaticOrder S; S.init(HB_ROWS, DM, F.G, (int)blockIdx.x);
            typedef pg8::EpiG2catT<PROBE_REP == 13, PROBE_REP == 14> EP; EP E{F.PA, F.MRG};
            pg8::gemm_phase<EP, pg8::StaticOrder, true, true>(F.lds + RING_OFF, g, S, E, F.wave); }
#endif
#if PROBE_REP == 11
        if (IN(pb + 3)) { pg8::Gemm g{F.YC, F.PCAT, HB_ROWS, DM, KC, KC, KC}; pg8::StaticOrder S; S.init(HB_ROWS, DM, F.G, (int)blockIdx.x); pg8::EpiNull E{};
            pg8::gemm_phase<pg8::EpiNull, pg8::StaticOrder, true, true>(F.lds + RING_OFF, g, S, E, F.wave); }
#endif
#if PROBE_REP == 12
        if (IN(pb + 4)) { pg8::Gemm g{F.MRG, F.WOUT, HB_ROWS, DM, DM, DM, DM}; pg8::StaticOrder S; S.init(HB_ROWS, DM, F.G, (int)blockIdx.x); pg8::EpiNull E{};
            pg8::gemm_phase<pg8::EpiNull, pg8::StaticOrder, true, true>(F.lds + RING_OFF, g, S, E, F.wave); }
#endif
        if (IN(pb + 3)) REPS(6) {
            pg8::Gemm g{F.YC, F.PCAT, HB_ROWS, DM, KC, KC, KC}; pg8::StaticOrder S; S.init(HB_ROWS, DM, F.G, (int)blockIdx.x);
            pg8::EpiG2cat E{F.PA, F.MRG};
            pg8::gemm_phase<pg8::EpiG2cat, pg8::StaticOrder, true, true>(F.lds + RING_OFF, g, S, E, F.wave);
        } SEAM(pb + 3);
        if (IN(pb + 4)) REPS(7) {
            pg8::Gemm g{F.MRG, F.WOUT, HB_ROWS, DM, DM, DM, DM}; pg8::StaticOrder S; S.init(HB_ROWS, DM, F.G, (int)blockIdx.x);
            pg8::EpiG3 E{F.x + (size_t)row0 * DM, F.out + (size_t)row0 * DM};
            pg8::gemm_phase<pg8::EpiG3, pg8::StaticOrder, true, true>(F.lds + RING_OFF, g, S, E, F.wave);
        } if (hb == 1) SEAM(pb + 4);
    }
#undef IN
#undef SEAM
}

extern "C" void kernel_launch(void* const* d_in, const int* in_sizes, int n_in, void* d_out, int out_size, void* d_ws, size_t ws_size, hipStream_t stream) {
    static int grid = 0;
    if (grid == 0) {
        if (n_in != 20 || in_sizes[0] != MTOT * DM || out_size != MTOT * DM || ws_size < WS_END) { fprintf(stderr, "kernel_launch: unexpected shapes (n_in %d, ws %zu); nothing launched\n", n_in, ws_size); grid = -1; return; }
        int dev = 0, cus = 0, per_cu = 0;
        if (hipGetDevice(&dev) != hipSuccess || hipDeviceGetAttribute(&cus, hipDeviceAttributeMultiprocessorCount, dev) != hipSuccess) { grid = -1; return; }
        if (hipFuncSetAttribute((const void*)mega_fwd, hipFuncAttributeMaxDynamicSharedMemorySize, LDS_BYTES) != hipSuccess) { fprintf(stderr, "kernel_launch: hipFuncSetAttribute failed\n"); grid = -1; return; }
        if (hipOccupancyMaxActiveBlocksPerMultiprocessor(&per_cu, (const void*)mega_fwd, NTHR, LDS_BYTES) != hipSuccess || per_cu < 1) { fprintf(stderr, "kernel_launch: occupancy query says %d blocks per CU\n", per_cu); (void)hipGetLastError(); grid = -1; return; }
        grid = cus;
    }
    if (grid < 0) return;
    if (hipMemsetAsync((char*)d_ws + WS_CTL, 0, CTL_ZERO_BYTES, stream) != hipSuccess) return;
    Args a{};
    for (int i = 0; i < 20; ++i) a.in[i] = (const float*)d_in[i];
    a.out = (float*)d_out; a.ws = (unsigned char*)d_ws;
#if MK_PER_PHASE
    for (int p = 0; p < NPHASES; ++p) { a.ph_lo = p; a.ph_hi = p + 1; hipLaunchKernelGGL(mega_fwd, dim3(grid), dim3(NTHR), LDS_BYTES, stream, a); }
#else
    a.ph_lo = 0; a.ph_hi = NPHASES; hipLaunchKernelGGL(mega_fwd, dim3(grid), dim3(NTHR), LDS_BYTES, stream, a);
#endif
}
```

```cpp
#include <hip/hip_runtime.h>
#include <cstdint>
#include <cstdio>

constexpr int DM = 1024, NB = 32, SEQ = 2048, MTOT = NB * SEQ;
constexpr int NIN = 8960, MEML = 256, MMEM = NB * MEML;
constexpr int HB_ROWS = MTOT / 2;
constexpr int C_AU = 0, C_AV = 768, C_AZ = 1536, C_BQ = 2304, C_BK = 3072, C_BV = 3840, C_BZ = 4608, C_MQ = 4864, C_MZ = 5376, C_G = 5888;
constexpr float EPS = 1e-6f;
constexpr int SS_W = 112;
constexpr int PAP = 7424;
constexpr int PA_ROWB = 2 * PAP, PA_GOFF = 2 * C_G;
constexpr int KC = 1536;

constexpr size_t MiB = 1u << 20;
constexpr size_t WS_CTL = 0, CTL_ZERO_BYTES = 32 * 1024, WS_WIN = 2 * MiB, WS_PCAT = 22 * MiB, WS_WOUT = 25 * MiB, WS_WSP = 27 * MiB, WS_BIAS = 27 * MiB + 512 * 1024;
constexpr size_t WS_XN = 32 * MiB, WS_PA = 176 * MiB, WS_KVM = 736 * MiB, WS_SS = 752 * MiB, WS_MKSS = 766 * MiB, WS_OG = 768 * MiB, WS_LSE = 816 * MiB, WS_LNST = 818 * MiB;
constexpr size_t WS_YC = 820 * MiB, WS_MRG = 916 * MiB, WS_END = 980 * MiB;
constexpr int CW_BAR = 4096;

namespace pg8 {
#define PG8_LAS __attribute__((address_space(3)))
typedef unsigned short bf16_t;
typedef short bf16x8 __attribute__((ext_vector_type(8)));
typedef float f32x4 __attribute__((ext_vector_type(4)));
typedef unsigned u32x4 __attribute__((ext_vector_type(4)));
constexpr int BM = 256, BK = 64, HALF = 128, HTB = HALF * BK * 2  , STAGE_BYTES = 8 * HTB, NXCD = 8, WGM = 8;

__host__ __device__ __forceinline__ int lds_byte(int r, int c) { const int st = (r >> 4) * 2 + (c >> 5), rr = r & 15, cc = c & 31, ob = rr * 64 + cc * 2; return st * 1024 + (ob ^ (((ob >> 9) & 1) << 5)); }
__host__ __device__ __forceinline__ void stage_rc(int b, int& R, int& C) { const int st = b / 1024, sb = b % 1024, swz = sb ^ (((sb >> 9) & 1) << 5); R = (st >> 1) * 16 + swz / 64; C = (st & 1) * 32 + (swz % 64) / 2; }
__host__ __device__ __forceinline__ int perm32(int rho) { const int n = rho >> 4, i = rho & 15; return 8 * (i >> 2) + 4 * n + (i & 3); }

struct Unit { int pm, pn; };
struct Gemm { const bf16_t* A; const bf16_t* Bt; int M, N, K, lda, ldb; };

struct StaticOrder {
    int nM, nN, nwg, G, c;
    __host__ __device__ void init(int M, int N, int G_, int c_) { nM = M / BM; nN = N / BM; nwg = nM * nN; G = G_; c = c_; }
    __host__ __device__ bool next(int i, Unit& u) const {
        const long L = (long)i * G + c; if (L >= nwg) return false;
        int wgid = (int)L; { const int q = nwg / NXCD, r = nwg % NXCD, xcd = wgid % NXCD, off = wgid / NXCD; wgid = (xcd < r ? xcd * (q + 1) : r * (q + 1) + (xcd - r) * q) + off; }
        const int nig = WGM * nN, gid = wgid / nig, fm = gid * WGM, gsz = (nM - fm) < WGM ? (nM - fm) : WGM;
        u.pm = fm + ((wgid % nig) % gsz); u.pn = (wgid % nig) / gsz; return true;
    }
    __device__ __forceinline__ void a_ready(const Unit&) const {}
    __device__ __forceinline__ void done(const Unit&) const {}
};


typedef float f32x2c_t __attribute__((ext_vector_type(2))); typedef __bf16 bf16x2c_t __attribute__((ext_vector_type(2)));
__device__ __forceinline__ unsigned cvt_pk_bf16(float lo, float hi) { const f32x2c_t v = {lo, hi}; const bf16x2c_t b = __builtin_convertvector(v, bf16x2c_t); return __builtin_bit_cast(unsigned, b); }
typedef float f32x2 __attribute__((ext_vector_type(2)));
__device__ __forceinline__ f32x2 gelu_pk(f32x2 v) {
    const f32x2 av = __builtin_elementwise_abs(v), d = av * 0.2316418882f + 1.0f;
    f32x2 t; t.x = __builtin_amdgcn_rcpf(d.x); t.y = __builtin_amdgcn_rcpf(d.y);
    f32x2 q = t * 0.5307027145f + (-0.7265760135f); q = q * t + 0.7107068705f; q = q * t + (-0.142248368f); q = q * t + 0.127414796f; q = q * t;
    const f32x2 s = (v * v) * (-0.72134752044f);
    f32x2 e; e.x = __builtin_amdgcn_exp2f(s.x); e.y = __builtin_amdgcn_exp2f(s.y);
    const f32x2 m = v * (q * e), r = v - m;
    f32x2 o; o.x = v.x < 0.f ? m.x : r.x; o.y = v.y < 0.f ? m.y : r.y; return o;
}

template <class Epi, class Sched, bool ALIGN_EPI = false, bool SP2 = false>
__device__ __forceinline__ void gemm_phase(PG8_LAS unsigned char* lds, const Gemm g, const Sched& S, const Epi& E, const int wave_id) {
    int tid; asm volatile("v_mbcnt_lo_u32_b32 %0, -1, 0\n\tv_mbcnt_hi_u32_b32 %0, -1, %0" : "=v"(tid)); tid += wave_id * 64;
    const int wid = __builtin_amdgcn_readfirstlane(tid >> 6), lane = tid & 63, wr = wid >> 2, wc = wid & 3, fr = lane & 15, fq = lane >> 4;
    int K = g.K; asm volatile("" : "+s"(K)); const int nt = K / BK;
    unsigned voffA[2], voffB[2];
#pragma unroll
    for (int i = 0; i < 2; ++i) { int R, C; stage_rc(tid * 16 + i * 8192, R, C); const int Rb = Epi::PERM ? ((R & ~31) + perm32(R & 31)) : R;
        voffA[i] = (unsigned)(R * g.lda + C) * 2u; voffB[i] = (unsigned)(Rb * g.ldb + C) * 2u; }
    const size_t kstep = (size_t)(BK * 2);
    const size_t hstepA = (size_t)HALF * g.lda * 2, hstepB = (size_t)HALF * g.ldb * 2;
    const size_t tstepA = 2 * hstepA, tstepB = 2 * hstepB;
    const unsigned ldsw = (unsigned)wid * 1024u;
    const int aoff = lds_byte(wr * 64 + fr, fq * 8), boff = lds_byte(wc * 32 + fr, fq * 8);
#define PG8_SA(b, h) (((b) * 2 + (h)) * HTB)
#define PG8_SB(b, h) ((4 + (b) * 2 + (h)) * HTB)
#define PG8_STAGE(bufoff, gbase, voff) do { _Pragma("unroll") for (int _i = 0; _i < 2; ++_i) \
        __builtin_amdgcn_global_load_lds((const unsigned*)((const char*)(gbase) + (voff)[_i]), (PG8_LAS unsigned*)(lds + (bufoff) + ldsw + _i * 8192), 16, 0, 0); } while (0)
#define PG8_LDA(dst, b, h) do { _Pragma("unroll") for (int m = 0; m < 4; ++m) _Pragma("unroll") for (int k = 0; k < 2; ++k) dst[m][k] = *(const PG8_LAS bf16x8*)(lds + PG8_SA(b, h) + aoff + m * 2048 + k * 1024); } while (0)
#define PG8_LDB(dst, b, h) do { _Pragma("unroll") for (int n = 0; n < 2; ++n) _Pragma("unroll") for (int k = 0; k < 2; ++k) dst[n][k] = *(const PG8_LAS bf16x8*)(lds + PG8_SB(b, h) + boff + n * 2048 + k * 1024); } while (0)
#define PG8_MMA(ai, bj, At, Bt) do { __builtin_amdgcn_s_setprio(1); _Pragma("unroll") for (int m = 0; m < 4; ++m) _Pragma("unroll") for (int n = 0; n < 2; ++n) _Pragma("unroll") for (int k = 0; k < 2; ++k) \
        acc[ai][bj][m][n] = __builtin_amdgcn_mfma_f32_16x16x32_bf16(Bt[n][k], At[m][k], acc[ai][bj][m][n], 0, 0, 0); __builtin_amdgcn_s_setprio(0); } while (0)
#define PG8_WAIT_V(n) asm volatile("s_waitcnt vmcnt(" #n ")" ::: "memory")
#define PG8_WAIT_L(n) asm volatile("s_waitcnt lgkmcnt(" #n ")" ::: "memory")
#define PG8_BAR __builtin_amdgcn_s_barrier()
#define PG8_SCHED __builtin_amdgcn_sched_barrier(0)
    Unit cur, nxt; int ui = 0;
    if (!S.next(0, cur)) return;
    f32x4 acc[2][2][4][2];
#pragma unroll
    for (int a = 0; a < 2; ++a)
#pragma unroll
        for (int b = 0; b < 2; ++b)
#pragma unroll
            for (int m = 0; m < 4; ++m)
#pragma unroll
                for (int n = 0; n < 2; ++n) acc[a][b][m][n] = (f32x4){0.f, 0.f, 0.f, 0.f};
    bf16x8 At[4][2], B0[2][2], B1[2][2];
    const char* cA = (const char*)g.A + (size_t)cur.pm * tstepA; const char* cB = (const char*)g.Bt + (size_t)cur.pn * tstepB;
    S.a_ready(cur);
    if constexpr (SP2) {
        PG8_STAGE(PG8_SB(0, 0), cB, voffB); PG8_STAGE(PG8_SB(0, 1), cB + hstepB, voffB); PG8_STAGE(PG8_SA(0, 0), cA, voffA); PG8_STAGE(PG8_SA(0, 1), cA + hstepA, voffA);
        if (wr == 1) PG8_BAR;
        PG8_WAIT_V(2); PG8_BAR;
        PG8_STAGE(PG8_SB(1, 0), cB + kstep, voffB); PG8_STAGE(PG8_SA(1, 0), cA + kstep, voffA); PG8_STAGE(PG8_SB(1, 1), cB + hstepB + kstep, voffB);
        PG8_WAIT_V(6); PG8_BAR;
    } else {
        PG8_STAGE(PG8_SB(0, 0), cB, voffB); PG8_STAGE(PG8_SA(0, 0), cA, voffA); PG8_STAGE(PG8_SB(0, 1), cB + hstepB, voffB); PG8_STAGE(PG8_SA(0, 1), cA + hstepA, voffA);
        if (wr == 1) PG8_BAR;
        PG8_WAIT_V(4); PG8_BAR;
        PG8_STAGE(PG8_SB(1, 0), cB + kstep, voffB); PG8_STAGE(PG8_SA(1, 0), cA + kstep, voffA); PG8_STAGE(PG8_SB(1, 1), cB + hstepB + kstep, voffB);
        PG8_WAIT_V(6); PG8_BAR;
    }
    for (;;) {
        const bool has_next = S.next(ui + 1, nxt);
        const char* nA = has_next ? (const char*)g.A + (size_t)nxt.pm * tstepA : cA; const char* nB = has_next ? (const char*)g.Bt + (size_t)nxt.pn * tstepB : cB;
        for (int t = 0; t < nt; t += 2) {
            if constexpr (Epi::KHOOK) { if (t == Epi::KH1 || t == Epi::KH2) E.khook(acc, cur, t, wr, wc, fr, fq); }
            const bool last = (t == nt - 2);
            const char* a1 = cA + (size_t)(t + 1) * kstep;
            const char* a2 = last ? nA : cA + (size_t)(t + 2) * kstep; const char* b2 = last ? nB : cB + (size_t)(t + 2) * kstep;
            const char* a3 = a2 + kstep; const char* b3 = b2 + kstep;
            if (last && has_next) S.a_ready(nxt);
            if constexpr (SP2) {
            PG8_LDB(B0, 0, 0); PG8_LDB(B1, 0, 1); PG8_SCHED; PG8_LDA(At, 0, 0); PG8_STAGE(PG8_SA(1, 1), a1 + hstepA, voffA);
            PG8_WAIT_V(8); PG8_WAIT_L(0); PG8_BAR; PG8_MMA(0, 0, At, B0); PG8_MMA(0, 1, At, B1); PG8_BAR; PG8_SCHED;
            PG8_LDA(At, 0, 1); PG8_STAGE(PG8_SB(0, 0), b2, voffB); PG8_STAGE(PG8_SB(0, 1), b2 + hstepB, voffB); PG8_STAGE(PG8_SA(0, 0), a2, voffA);
            PG8_WAIT_V(8); PG8_WAIT_L(0); PG8_BAR; PG8_MMA(1, 0, At, B0); PG8_MMA(1, 1, At, B1); PG8_BAR; PG8_SCHED;
            PG8_LDB(B0, 1, 0); PG8_LDB(B1, 1, 1); PG8_SCHED; PG8_LDA(At, 1, 0); PG8_STAGE(PG8_SA(0, 1), a2 + hstepA, voffA);
            PG8_WAIT_V(8); PG8_WAIT_L(0); PG8_BAR; PG8_MMA(0, 0, At, B0); PG8_MMA(0, 1, At, B1); PG8_BAR; PG8_SCHED;
            PG8_LDA(At, 1, 1); PG8_STAGE(PG8_SB(1, 0), b3, voffB); PG8_STAGE(PG8_SB(1, 1), b3 + hstepB, voffB); PG8_STAGE(PG8_SA(1, 0), a3, voffA);
            PG8_WAIT_V(8); PG8_WAIT_L(0); PG8_BAR; PG8_MMA(1, 0, At, B0); PG8_MMA(1, 1, At, B1); PG8_BAR; PG8_SCHED;
            } else {
            PG8_LDB(B0, 0, 0); PG8_SCHED; PG8_LDA(At, 0, 0); PG8_STAGE(PG8_SA(1, 1), a1 + hstepA, voffA);
            PG8_WAIT_L(8); PG8_BAR; PG8_WAIT_L(0); PG8_MMA(0, 0, At, B0); PG8_BAR; PG8_SCHED;
            PG8_LDB(B1, 0, 1); PG8_STAGE(PG8_SB(0, 0), b2, voffB);
            PG8_BAR; PG8_WAIT_L(0); PG8_MMA(0, 1, At, B1); PG8_BAR;
            PG8_LDA(At, 0, 1); PG8_STAGE(PG8_SA(0, 0), a2, voffA);
            PG8_BAR; PG8_WAIT_L(0); PG8_MMA(1, 0, At, B0); PG8_BAR; PG8_SCHED;
            PG8_STAGE(PG8_SB(0, 1), b2 + hstepB, voffB);
            PG8_WAIT_V(6); PG8_BAR; PG8_MMA(1, 1, At, B1); PG8_BAR;
            PG8_LDB(B0, 1, 0); PG8_SCHED; PG8_LDA(At, 1, 0); PG8_STAGE(PG8_SA(0, 1), a2 + hstepA, voffA);
            PG8_WAIT_L(8); PG8_BAR; PG8_WAIT_L(0); PG8_MMA(0, 0, At, B0); PG8_BAR; PG8_SCHED;
            PG8_LDB(B1, 1, 1); PG8_STAGE(PG8_SB(1, 0), b3, voffB);
            PG8_BAR; PG8_WAIT_L(0); PG8_MMA(0, 1, At, B1); PG8_BAR;
            PG8_LDA(At, 1, 1); PG8_STAGE(PG8_SA(1, 0), a3, voffA);
            PG8_BAR; PG8_WAIT_L(0); PG8_MMA(1, 0, At, B0); PG8_BAR; PG8_SCHED;
            PG8_STAGE(PG8_SB(1, 1), b3 + hstepB, voffB);
            PG8_WAIT_V(6); PG8_BAR; PG8_MMA(1, 1, At, B1); PG8_BAR;
            }
        }
        if constexpr (ALIGN_EPI) { if (wr == 0) PG8_BAR; }
        if constexpr (!Epi::AFTER_DRAIN) { E(acc, cur, wr, wc, fr, fq); S.done(cur); }
        if (!has_next) break;
#pragma unroll
        for (int a = 0; a < 2; ++a)
#pragma unroll
            for (int b = 0; b < 2; ++b)
#pragma unroll
                for (int m = 0; m < 4; ++m)
#pragma unroll
                    for (int n = 0; n < 2; ++n) acc[a][b][m][n] = (f32x4){0.f, 0.f, 0.f, 0.f};
        cur = nxt; cA = nA; cB = nB; ++ui;
        if constexpr (ALIGN_EPI) { if (wr == 1) PG8_BAR; }
    }
    PG8_WAIT_V(0);
    if constexpr (!ALIGN_EPI) { if (wr == 0) PG8_BAR; }
    PG8_BAR;
    if constexpr (Epi::AFTER_DRAIN) { E.fused(acc, cur, wr, wc, fr, fq, lds, wid, lane); S.done(cur); }
#undef PG8_SA
#undef PG8_SB
#undef PG8_STAGE
#undef PG8_LDA
#undef PG8_LDB
#undef PG8_MMA
#undef PG8_WAIT_V
#undef PG8_WAIT_L
#undef PG8_BAR
#undef PG8_SCHED
}
}

#ifndef G1_EPI_DRAIN
#define G1_EPI_DRAIN 0
#endif
#ifndef G1_STORE_AUX_MIX
#define G1_STORE_AUX_MIX 2
#endif
#ifndef G1_STORE_AUX
#define G1_STORE_AUX 2
#endif
namespace pg8 {
__device__ __forceinline__ float ubf0(unsigned w) { return (float)(w & 0xffu); }
__device__ __forceinline__ float ubf1(unsigned w) { return (float)((w >> 8) & 0xffu); }
__device__ __forceinline__ float ubf2(unsigned w) { return (float)((w >> 16) & 0xffu); }
__device__ __forceinline__ float ubf3(unsigned w) { return (float)(w >> 24); }
__device__ __forceinline__ float ex2(float x) { return __builtin_amdgcn_exp2f(x); }
__device__ __forceinline__ float sigm_fast(float x) { return __builtin_amdgcn_rcpf(1.0f + ex2(x * -1.4426950408889634f)); }
template <int MODE = 0  > struct EpiProjT {
    static constexpr bool PERM = true, AFTER_DRAIN = false, KHOOK = false;
    bf16_t* PA; bf16_t* KVM; float* SS; float* MKSS; const float* gate_b; int pm0; int pad;
    template <int KIND, int STAT> __device__ __forceinline__ void body(const f32x4 (&acc)[2][2][4][2], const __amdgpu_buffer_rsrc_t rsrc, int row0, int col0, int ldc, float* sb, int sld, int so, const float* bias, int wc, int fq) const {
        f32x4 bv[2][2];
        if (KIND == 3) {
#pragma unroll
            for (int bj = 0; bj < 2; ++bj)
#pragma unroll
                for (int n = 0; n < 2; ++n) bv[bj][n] = *(const f32x4*)(bias + bj * HALF + 4 * n);
        }
#pragma unroll
        for (int ai = 0; ai < 2; ++ai)
#pragma unroll
            for (int m = 0; m < 4; ++m) { const int row = row0 + ai * HALF + m * 16; const unsigned rowoff = ((unsigned)row * (unsigned)ldc + (unsigned)col0) * 2u;
#pragma unroll
                for (int bj = 0; bj < 2; ++bj) { f32x4 v0 = acc[ai][bj][m][0], v1 = acc[ai][bj][m][1];
                    if (KIND == 1) { f32x2 a = gelu_pk((f32x2){v0[0], v0[1]}), b = gelu_pk((f32x2){v0[2], v0[3]}), c = gelu_pk((f32x2){v1[0], v1[1]}), d = gelu_pk((f32x2){v1[2], v1[3]});
                        v0 = (f32x4){a.x, a.y, b.x, b.y}; v1 = (f32x4){c.x, c.y, d.x, d.y}; }
                    else if (KIND == 2) {
#pragma unroll
                        for (int j = 0; j < 4; ++j) { v0[j] = v0[j] * sigm_fast(v0[j]); v1[j] = v1[j] * sigm_fast(v1[j]); } }
                    else if (KIND == 3) { v0 = v0 + bv[bj][0]; v1 = v1 + bv[bj][1];
#pragma unroll
                        for (int j = 0; j < 4; ++j) { v0[j] = sigm_fast(v0[j]); v1[j] = sigm_fast(v1[j]); } }
                    if (STAT) {
                        float s = ((v0[0] + v0[1]) + (v0[2] + v0[3])) + ((v1[0] + v1[1]) + (v1[2] + v1[3]));
                        float q = ((v0[0] * v0[0] + v0[1] * v0[1]) + (v0[2] * v0[2] + v0[3] * v0[3])) + ((v1[0] * v1[0] + v1[1] * v1[1]) + (v1[2] * v1[2] + v1[3] * v1[3]));
                        if (STAT == 2) { s += __shfl_xor(s, 16); s += __shfl_xor(s, 32); }
                        q += __shfl_xor(q, 16); q += __shfl_xor(q, 32);
                        if (fq == 0) { float* sp = sb + (size_t)row * sld + so; const int blk = 4 * bj + wc;
                            if (STAT == 2) { sp[2 * blk] = s; sp[2 * blk + 1] = q; } else sp[blk] = q; }
                    }
                    u32x4 w; w.x = cvt_pk_bf16(v0[0], v0[1]); w.y = cvt_pk_bf16(v0[2], v0[3]); w.z = cvt_pk_bf16(v1[0], v1[1]); w.w = cvt_pk_bf16(v1[2], v1[3]);
                    if (MODE == 2) asm volatile("" :: "v"(w)); else __builtin_amdgcn_raw_buffer_store_b128(w, rsrc, (int)(rowoff + bj * HALF * 2), 0, KIND == 3 ? G1_STORE_AUX : G1_STORE_AUX_MIX); } }
    }
    __device__ __forceinline__ void uz_body(const f32x4 (&acc)[2][2][4][2], const __amdgpu_buffer_rsrc_t rsrc, int row0, int ucol0) const {
#pragma unroll
        for (int ai = 0; ai < 2; ++ai)
#pragma unroll
            for (int m = 0; m < 4; ++m) { const int row = row0 + ai * HALF + m * 16;
                f32x4 u0 = acc[ai][0][m][0], u1 = acc[ai][0][m][1]; const f32x4 z0 = acc[ai][1][m][0], z1 = acc[ai][1][m][1];
                { f32x2 a = gelu_pk((f32x2){u0[0], u0[1]}), b = gelu_pk((f32x2){u0[2], u0[3]}), c = gelu_pk((f32x2){u1[0], u1[1]}), d = gelu_pk((f32x2){u1[2], u1[3]});
                  u0 = (f32x4){a.x, a.y, b.x, b.y}; u1 = (f32x4){c.x, c.y, d.x, d.y}; }
#pragma unroll
                for (int j = 0; j < 4; ++j) { u0[j] *= z0[j] * sigm_fast(z0[j]); u1[j] *= z1[j] * sigm_fast(z1[j]); }
                u32x4 w; w.x = cvt_pk_bf16(u0[0], u0[1]); w.y = cvt_pk_bf16(u0[2], u0[3]); w.z = cvt_pk_bf16(u1[0], u1[1]); w.w = cvt_pk_bf16(u1[2], u1[3]);
                if (MODE == 2) asm volatile("" :: "v"(w)); else __builtin_amdgcn_raw_buffer_store_b128(w, rsrc, (int)((unsigned)row * (unsigned)PA_ROWB + (unsigned)(2 * (C_AU + ucol0))), 0, G1_STORE_AUX_MIX); }
    }
    __device__ __forceinline__ void gate_body(const f32x4 (&acc)[2][2][4][2], const __amdgpu_buffer_rsrc_t rsrc, int row0, int gcol0, const float* bias) const {
        f32x4 bv[2][2];
#pragma unroll
        for (int bj = 0; bj < 2; ++bj)
#pragma unroll
            for (int n = 0; n < 2; ++n) bv[bj][n] = *(const f32x4*)(bias + 8 * bj + 4 * n);
#pragma unroll
        for (int ai = 0; ai < 2; ++ai)
#pragma unroll
            for (int m = 0; m < 4; ++m) { const int row = row0 + ai * HALF + m * 16; u32x4 w;
#pragma unroll
                for (int bj = 0; bj < 2; ++bj)
#pragma unroll
                    for (int n = 0; n < 2; ++n) { const f32x4 v = acc[ai][bj][m][n] + bv[bj][n]; unsigned d = 0u;
#pragma unroll
                        for (int j = 0; j < 4; ++j) d |= (unsigned)(fmaxf(sigm_fast(v[j]) * 255.0f, 1.0f) + 0.5f) << (8 * j);
                        w[2 * bj + n] = d; }
                if (MODE == 2) asm volatile("" :: "v"(w)); else __builtin_amdgcn_raw_buffer_store_b128(w, rsrc, (int)((unsigned)row * (unsigned)PA_ROWB + (unsigned)(PA_GOFF + gcol0)), 0, G1_STORE_AUX); }
    }
    __device__ __forceinline__ void operator()(const f32x4 (&acc)[2][2][4][2], const Unit& u, int wr, int wc, int fr, int fq) const {
        const bool kv = u.pn >= 35; const int pn = kv ? u.pn - 35 : u.pn;
        const int rowt = kv ? (u.pm - 256) * BM : (u.pm - pm0) * BM;
        bf16_t* base = kv ? KVM : PA; const int ldc = kv ? 1024 : PAP;
        const __amdgpu_buffer_rsrc_t rsrc = __builtin_amdgcn_make_buffer_rsrc(base, 0, kv ? (int)((size_t)MMEM * 1024 * 2) : (int)((size_t)HB_ROWS * PA_ROWB), 0x00020000);
        const int row0 = rowt + wr * 64 + fr, col0 = pn * BM + wc * 32 + 8 * fq;
        if (MODE == 1) { body<0, 0>(acc, rsrc, row0, col0, ldc, SS, SS_W, 0, gate_b, wc, fq); return; }
        if (kv) { if (pn < 2) body<0, 1>(acc, rsrc, row0, col0, ldc, MKSS, 16, 8 * pn, gate_b, wc, fq); else body<0, 0>(acc, rsrc, row0, col0, ldc, SS, SS_W, 0, gate_b, wc, fq); }
        else if (pn < 3) uz_body(acc, rsrc, row0, 128 * pn + 32 * wc + 8 * fq);
        else if (pn < 6) body<1, 2>(acc, rsrc, row0, col0, ldc, SS, SS_W, 16 * (pn - 3), gate_b, wc, fq);
        else if (pn < 9) uz_body(acc, rsrc, row0, 128 * (pn - 3) + 32 * wc + 8 * fq);
        else if (pn < 12) body<0, 1>(acc, rsrc, row0, col0, ldc, SS, SS_W, 48 + 8 * (pn - 9), gate_b, wc, fq);
        else if (pn < 15) body<0, 1>(acc, rsrc, row0, col0, ldc, SS, SS_W, 72 + 8 * (pn - 12), gate_b, wc, fq);
        else if (pn < 18) body<0, 0>(acc, rsrc, row0, col0, ldc, SS, SS_W, 0, gate_b, wc, fq);
        else if (pn < 19) body<2, 0>(acc, rsrc, row0, col0, ldc, SS, SS_W, 0, gate_b, wc, fq);
        else if (pn < 21) body<0, 1>(acc, rsrc, row0, col0, ldc, SS, SS_W, 96 + 8 * (pn - 19), gate_b, wc, fq);
        else if (pn < 23) body<2, 0>(acc, rsrc, row0, col0, ldc, SS, SS_W, 0, gate_b, wc, fq);
        else { const int gc = (pn - 23) * BM + 64 * wc + 16 * fq; gate_body(acc, rsrc, row0, gc, gate_b + gc); }
#if G1_EPI_DRAIN
        asm volatile("s_waitcnt vmcnt(0)" ::: "memory");
#endif
    }
};
typedef EpiProjT<0> EpiProj;
template <bool HOOKS = true, bool EPI = true> struct EpiG2catT {
    static constexpr bool PERM = true, AFTER_DRAIN = false, KHOOK = HOOKS; static constexpr int KH1 = 12, KH2 = 16;
    const bf16_t* PA; bf16_t* MRG;
    __device__ __forceinline__ void khook(f32x4 (&acc)[2][2][4][2], const Unit& u, int t, int wr, int wc, int fr, int fq) const {
        typedef unsigned u32x2v __attribute__((ext_vector_type(2)));
        const int ga = t == KH1 ? 0 : 1;
        const int row0 = u.pm * BM + wr * 64 + fr, col0 = u.pn * BM + wc * 32 + 8 * fq;
        const unsigned char* gbase = (const unsigned char*)PA + (size_t)row0 * PA_ROWB + PA_GOFF + ga * DM + col0;
        u32x2v ag[2][4][2], bg[2][4][2];
#pragma unroll
        for (int ai = 0; ai < 2; ++ai)
#pragma unroll
            for (int m = 0; m < 4; ++m) { const unsigned char* gp_ = gbase + (size_t)(ai * HALF + m * 16) * PA_ROWB;
#pragma unroll
                for (int bj = 0; bj < 2; ++bj) { ag[ai][m][bj] = *(const u32x2v*)(gp_ + bj * HALF); bg[ai][m][bj] = *(const u32x2v*)(gp_ + DM + bj * HALF); } }
        __builtin_amdgcn_sched_barrier(0);
#define G2_R(A, Bv, K) (ubf##K(A) * __builtin_amdgcn_rcpf(ubf##K(Bv)))
#pragma unroll
        for (int ai = 0; ai < 2; ++ai)
#pragma unroll
            for (int m = 0; m < 4; ++m)
#pragma unroll
                for (int bj = 0; bj < 2; ++bj) { const u32x2v a = ag[ai][m][bj], b = bg[ai][m][bj]; f32x4 r0, r1;
                    r0[0] = G2_R(a.x, b.x, 0); r0[1] = G2_R(a.x, b.x, 1); r0[2] = G2_R(a.x, b.x, 2); r0[3] = G2_R(a.x, b.x, 3);
                    r1[0] = G2_R(a.y, b.y, 0); r1[1] = G2_R(a.y, b.y, 1); r1[2] = G2_R(a.y, b.y, 2); r1[3] = G2_R(a.y, b.y, 3);
                    acc[ai][bj][m][0] *= r0; acc[ai][bj][m][1] *= r1; }
#undef G2_R
    }
    __device__ __forceinline__ void operator()(const f32x4 (&acc)[2][2][4][2], const Unit& u, int wr, int wc, int fr, int fq) const {
        typedef unsigned u32x2v __attribute__((ext_vector_type(2)));
        if (!EPI) { _Pragma("unroll") for (int ai = 0; ai < 2; ++ai) _Pragma("unroll") for (int bj = 0; bj < 2; ++bj) _Pragma("unroll") for (int m = 0; m < 4; ++m) asm volatile("" :: "v"(acc[ai][bj][m][0]), "v"(acc[ai][bj][m][1])); return; }
        const int row0 = u.pm * BM + wr * 64 + fr, col0 = u.pn * BM + wc * 32 + 8 * fq;
        u32x2v gv[2][4][2];
#pragma unroll
        for (int ai = 0; ai < 2; ++ai)
#pragma unroll
            for (int m = 0; m < 4; ++m) { const unsigned char* gp = (const unsigned char*)PA + (size_t)(row0 + ai * HALF + m * 16) * PA_ROWB + PA_GOFF + 2 * DM + col0;
#pragma unroll
                for (int bj = 0; bj < 2; ++bj) gv[ai][m][bj] = *(const u32x2v*)(gp + bj * HALF); }
        __builtin_amdgcn_sched_barrier(0);
        const float q = 1.0f / 255.0f;
#pragma unroll
        for (int ai = 0; ai < 2; ++ai)
#pragma unroll
            for (int m = 0; m < 4; ++m) { bf16_t* mp = MRG + (size_t)(row0 + ai * HALF + m * 16) * DM + col0;
#pragma unroll
                for (int bj = 0; bj < 2; ++bj) { const u32x2v g = gv[ai][m][bj]; const f32x4 v0 = acc[ai][bj][m][0] * q, v1 = acc[ai][bj][m][1] * q; u32x4 w;
                    w.x = cvt_pk_bf16(v0[0] * ubf0(g.x), v0[1] * ubf1(g.x)); w.y = cvt_pk_bf16(v0[2] * ubf2(g.x), v0[3] * ubf3(g.x));
                    w.z = cvt_pk_bf16(v1[0] * ubf0(g.y), v1[1] * ubf1(g.y)); w.w = cvt_pk_bf16(v1[2] * ubf2(g.y), v1[3] * ubf3(g.y));
                    *(u32x4*)(mp + bj * HALF) = w; } }
    }
};
typedef EpiG2catT<true, true> EpiG2cat;
struct EpiG3 {
    static constexpr bool PERM = false, AFTER_DRAIN = false, KHOOK = false;
    const float* x; float* out;
    __device__ __forceinline__ void operator()(const f32x4 (&acc)[2][2][4][2], const Unit& u, int wr, int wc, int fr, int fq) const {
        const int row0 = u.pm * BM + wr * 64 + fr, col0 = u.pn * BM + wc * 32 + 4 * fq;
        f32x4 xv[2][2][2][2];
#define G3_LOAD(B) do { _Pragma("unroll") for (int mm = 0; mm < 2; ++mm) { const size_t off_ = (size_t)(row0 + ((B) >> 1) * HALF + (2 * ((B) & 1) + mm) * 16) * DM + col0; \
            _Pragma("unroll") for (int bj = 0; bj < 2; ++bj) _Pragma("unroll") for (int n = 0; n < 2; ++n) xv[(B) & 1][mm][bj][n] = __builtin_nontemporal_load((const f32x4*)(x + off_ + bj * HALF + n * 16)); } } while (0)
#define G3_STORE(B) do { _Pragma("unroll") for (int mm = 0; mm < 2; ++mm) { const size_t off_ = (size_t)(row0 + ((B) >> 1) * HALF + (2 * ((B) & 1) + mm) * 16) * DM + col0; \
            _Pragma("unroll") for (int bj = 0; bj < 2; ++bj) _Pragma("unroll") for (int n = 0; n < 2; ++n) \
                __builtin_nontemporal_store(xv[(B) & 1][mm][bj][n] + acc[(B) >> 1][bj][2 * ((B) & 1) + mm][n], (f32x4*)(out + off_ + bj * HALF + n * 16)); } } while (0)
        G3_LOAD(0); G3_LOAD(1); __builtin_amdgcn_sched_barrier(0); G3_STORE(0); G3_STORE(1); __builtin_amdgcn_sched_barrier(0); G3_LOAD(2); G3_LOAD(3); __builtin_amdgcn_sched_barrier(0); G3_STORE(2); G3_STORE(3);
#undef G3_LOAD
#undef G3_STORE
    }
};
struct EpiNull {
    static constexpr bool PERM = true, AFTER_DRAIN = false, KHOOK = false;
    __device__ __forceinline__ void operator()(const f32x4 (&acc)[2][2][4][2], const Unit& u, int wr, int wc, int fr, int fq) const {
#pragma unroll
        for (int ai = 0; ai < 2; ++ai)
#pragma unroll
            for (int bj = 0; bj < 2; ++bj)
#pragma unroll
                for (int m = 0; m < 4; ++m) asm volatile("" :: "v"(acc[ai][bj][m][0]), "v"(acc[ai][bj][m][1]));
    }
};
struct OrderG1 {
    StaticOrder so; int pm0, nkv;
    __device__ void init(int hb, int G, int c) { so.init(HB_ROWS, NIN, G, c); pm0 = hb * (HB_ROWS / BM); nkv = hb == 0 ? (MMEM / BM) * 4 : 0; }
    __device__ bool next(int i, Unit& u) const {
        if (so.next(i, u)) { u.pm += pm0; return true; }
        const long j = (long)i * so.G + so.c - so.nwg; if (j < 0 || j >= nkv) return false;
        u.pm = 256 + (int)(j >> 2); u.pn = 35 + (int)(j & 3); return true;
    }
    __device__ __forceinline__ void a_ready(const Unit&) const {}
    __device__ __forceinline__ void done(const Unit&) const {}
};
}

#define GAS __attribute__((address_space(1)))
#define LAS __attribute__((address_space(3)))
typedef unsigned short bf16;
typedef unsigned v4u __attribute__((ext_vector_type(4)));
typedef float f32x4 __attribute__((ext_vector_type(4)));
typedef short bf16x8 __attribute__((ext_vector_type(8)));
typedef GAS unsigned gu32;
typedef GAS unsigned long long gu64;
#define RLX_AGENT __ATOMIC_RELAXED, __HIP_MEMORY_SCOPE_AGENT
#define LDS_WAIT() asm volatile("s_waitcnt lgkmcnt(0)" ::: "memory")
#define VM_WAIT() asm volatile("s_waitcnt vmcnt(0)" ::: "memory")
__device__ __forceinline__ unsigned long long rt() { return __builtin_amdgcn_s_memrealtime(); }
__device__ __forceinline__ unsigned f2bf(float f) { unsigned u = __builtin_bit_cast(unsigned, f); return (u + 0x7fffu + ((u >> 16) & 1u)) >> 16; }
__device__ __forceinline__ unsigned pk2(float lo, float hi) { return f2bf(lo) | (f2bf(hi) << 16); }

__device__ __forceinline__ int hw_lane() { int l; asm volatile("v_mbcnt_lo_u32_b32 %0, -1, 0\n\tv_mbcnt_hi_u32_b32 %0, -1, %0" : "=v"(l)); return l; }
__device__ __forceinline__ bool hw_thread0(int wave) { return wave == 0 && hw_lane() == 0; }
#define XB_TMO      128
#define XB_XCNT(j)  (256  + 64 * (j))
#define XB_XSUB(j)  (1280 + 64 * (j))
#define XB_XGEN(j)  (2304 + 64 * (j))
#define XB_TOP      3328
#define XB_TOPGEN   3392
#define XCD_BAR_WORDS 3456
#define XB_SPIN_CAP (1u << 18)

__device__ __forceinline__ unsigned xb_ld(unsigned* p)              { return __hip_atomic_load(p, __ATOMIC_RELAXED, __HIP_MEMORY_SCOPE_AGENT); }
__device__ __forceinline__ unsigned xb_add(unsigned* p, unsigned v) { return __hip_atomic_fetch_add(p, v, __ATOMIC_RELAXED, __HIP_MEMORY_SCOPE_AGENT); }
__device__ __forceinline__ unsigned xb_xcc_id() { return (unsigned)__builtin_amdgcn_s_getreg((3 << 11) | 20) & 0xFu; }
#define XB_SPIN(cond, bar) do { unsigned _sp = 0; while (cond) { __builtin_amdgcn_s_sleep(1); \
    if ((++_sp & 255u) == 0u) { if (xb_ld(&(bar)[XB_TMO])) break; if (_sp > XB_SPIN_CAP) { atomicAdd(&(bar)[XB_TMO], 1u); break; } } } } while (0)

struct XcdBarrier {
    unsigned* bar; unsigned x; int wave;
    volatile LAS unsigned* st;
};

__device__ __forceinline__ XcdBarrier xcd_barrier_post(unsigned* bar, volatile LAS unsigned* st, int wave) {
    XcdBarrier b; b.bar = bar; b.x = xb_xcc_id(); b.st = st; b.wave = wave;
    if (hw_thread0(wave)) (void)xb_add(&bar[XB_XCNT(b.x)], 1u);
    return b;
}
__device__ __forceinline__ void xcd_barrier_complete(unsigned* bar, unsigned x, unsigned& nloc, unsigned& nx) {
    const unsigned G = gridDim.x * gridDim.y * gridDim.z;
    unsigned sum, cnt, mine, sp = 0u;
    for (;;) {
        sum = 0u; cnt = 0u; mine = 0u;
#pragma unroll
        for (unsigned j = 0; j < 16; ++j) { const unsigned c = xb_ld(&bar[XB_XCNT(j)]); sum += c; cnt += (c > 0u) ? 1u : 0u; mine = (j == x) ? c : mine; }
        if (sum == G) break;
        __builtin_amdgcn_s_sleep(1);
        if ((++sp & 255u) == 0u) { if (xb_ld(&bar[XB_TMO])) break; if (sp > XB_SPIN_CAP) { atomicAdd(&bar[XB_TMO], 1u); break; } }
    }
    nloc = mine > 0u ? mine : 1u; nx = cnt > 0u ? cnt : 1u;
}

__device__ __forceinline__ void xcd_barrier(const XcdBarrier& b) {
    asm volatile("s_waitcnt vmcnt(0)" ::: "memory");
    __syncthreads();
    if (hw_thread0(b.wave)) {
        unsigned* bar = b.bar;
        __builtin_amdgcn_s_waitcnt(0);
        unsigned nloc = b.st[0], nx = b.st[1];
        if (nloc == 0u) { xcd_barrier_complete(bar, b.x, nloc, nx); b.st[0] = nloc; b.st[1] = nx; }
        const unsigned old = xb_add(&bar[XB_XSUB(b.x)], 1u);
        const unsigned gen = old / nloc;
        if (old + 1u == (gen + 1u) * nloc) {
            __builtin_amdgcn_fence(__ATOMIC_RELEASE, "agent");
            asm volatile("s_waitcnt vmcnt(0)" ::: "memory");
            const unsigned og = xb_add(&bar[XB_TOP], 1u);
            const unsigned tg = og / nx;
            if (og + 1u == (tg + 1u) * nx) xb_add(&bar[XB_TOPGEN], 1u);
            else XB_SPIN(xb_ld(&bar[XB_TOPGEN]) == tg, bar);
            __builtin_amdgcn_fence(__ATOMIC_ACQUIRE, "agent");
            xb_add(&bar[XB_XGEN(b.x)], 1u);
            asm volatile("s_waitcnt vmcnt(0)" ::: "memory");
        } else {
            XB_SPIN(xb_ld(&bar[XB_XGEN(b.x)]) == gen, bar);
            __builtin_amdgcn_fence(__ATOMIC_ACQUIRE, "agent");
            asm volatile("s_waitcnt vmcnt(0)" ::: "memory");
        }
    }
    __syncthreads();
}

__device__ __forceinline__ float wave_sum(float v) {
#pragma unroll
    for (int o = 1; o < 64; o <<= 1) v += __shfl_xor(v, o);
    return v;
}

constexpr int RING_OFF = 0, RING_BYTES = 131072;
constexpr int LDSCTL_OFF = RING_BYTES, MISC_OFF = LDSCTL_OFF + 320;
constexpr int LDS_BYTES = 147456;
constexpr int NWAVES = 8, NTHR = NWAVES * 64;
constexpr int WSCR_OFF = 132096;

__device__ __forceinline__ float bf2f(bf16 h) { return __builtin_bit_cast(float, (unsigned)h << 16); }
__device__ __forceinline__ float sigm_f(float x) { return 1.f / (1.f + __expf(-x)); }
__device__ __forceinline__ int t5_bucket(int d) {
    if (d < 16) return d;
    int b = 16;
    b += d >= 22; b += d >= 30; b += d >= 40; b += d >= 54; b += d >= 73; b += d >= 99; b += d >= 134; b += d >= 182; b += d >= 246; b += d >= 332; b += d >= 450; b += d >= 609; b += d >= 825; b += d >= 1117; b += d >= 1513;
    return b;
}

struct Ctx {
    const float *x, *mem, *norm_w, *w_in, *gate_b, *lnw, *lnb, *sp_w, *sp_b, *bqw, *bkw, *rel_bias, *mem_norm_w, *m_w_kv, *mqw, *mkw, *proj_a, *proj_b, *proj_m, *w_out;
    float* out;
    bf16 *WIN, *PCAT, *WOUT, *WSP, *XN, *PA, *KVM, *OG, *YC, *MRG; float *BIAS, *BIASX, *SS, *MKSS, *LSE, *LNST;
    LAS unsigned char* lds; int tid, lane, wave, G, gtid, T, gwave, NW, xgwave;
};

__device__ __forceinline__ void p0_transpose_item(const float* W, int N, bf16* WT, int ldt, int row_off, int koff, LAS float* scr, int item, int lane, bool gperm = false) {
    const int nblk = N / 32, kb = item / nblk, nb = item % nblk, k0 = 64 * kb, n0 = 32 * nb;
#pragma unroll 8
    for (int i = 0; i < 32; ++i) { const int kk = 2 * i + (lane >> 5); scr[kk * 33 + (lane & 31)] = W[(size_t)(k0 + kk) * N + n0 + (lane & 31)]; }
    LDS_WAIT(); asm volatile("" ::: "memory");
    const int c = lane & 7;
#pragma unroll
    for (int j = 0; j < 4; ++j) { const int n = (lane >> 3) + 8 * j; const LAS float* s = scr + (8 * c) * 33 + n;
        v4u o; o.x = pk2(s[0 * 33], s[1 * 33]); o.y = pk2(s[2 * 33], s[3 * 33]); o.z = pk2(s[4 * 33], s[5 * 33]); o.w = pk2(s[6 * 33], s[7 * 33]);
        int nn = n0 + n;
        if (gperm) {
            if (nn >= C_G) nn = (nn & ~255) + 128 * ((nn >> 3) & 1) + 32 * ((nn >> 6) & 3) + 8 * ((nn >> 4) & 3) + (nn & 7);
            else if (nn < C_AV) { const int T = nn >> 7; nn = 256 * (T < 3 ? T : T + 3) + (nn & 127); }
            else if (nn >= C_AZ && nn < C_BQ) { const int c = nn - C_AZ, T = c >> 7; nn = 256 * (T < 3 ? T : T + 3) + 128 + (c & 127); }
        }
        *(GAS v4u*)(WT + (size_t)(row_off + nn) * ldt + koff + k0 + 8 * c) = o; }
    LDS_WAIT(); asm volatile("" ::: "memory");
}
template <int NR> __device__ __forceinline__ void rms_rows_to_bf16(const float* src, const float* w, bf16* dst, size_t m0, size_t stride, int lane) {
    f32x4 v[NR][4]; float s[NR];
#pragma unroll
    for (int r = 0; r < NR; ++r) { const GAS f32x4* xr = (const GAS f32x4*)(src + (m0 + r * stride) * DM) + lane;
#pragma unroll
        for (int j = 0; j < 4; ++j) v[r][j] = __builtin_nontemporal_load(xr + 64 * j); }
    f32x4 ww[4];
#pragma unroll
    for (int j = 0; j < 4; ++j) ww[j] = ((const GAS f32x4*)w + lane)[64 * j];
#pragma unroll
    for (int r = 0; r < NR; ++r) { float a = 0.f;
#pragma unroll
        for (int j = 0; j < 4; ++j) a += (v[r][j].x * v[r][j].x + v[r][j].y * v[r][j].y) + (v[r][j].z * v[r][j].z + v[r][j].w * v[r][j].w);
        s[r] = rsqrtf(wave_sum(a) * (1.f / DM) + EPS); }
#pragma unroll
    for (int r = 0; r < NR; ++r) { GAS unsigned long long* o8 = (GAS unsigned long long*)(dst + (m0 + r * stride) * DM) + lane;
#pragma unroll
        for (int j = 0; j < 4; ++j) o8[64 * j] = (unsigned long long)pk2(v[r][j].x * s[r] * ww[j].x, v[r][j].y * s[r] * ww[j].y) | ((unsigned long long)pk2(v[r][j].z * s[r] * ww[j].z, v[r][j].w * s[r] * ww[j].w) << 32); }
}
__device__ __forceinline__ void p0_prologue(Ctx& F) {
    LAS float* scr = (LAS float*)(F.lds + RING_OFF + F.wave * 16384);
    constexpr int I_IN = 16 * (NIN / 32), I_KV = 16 * 32, I_PA = 12 * 32, I_PB = 4 * 32, I_PM = 8 * 32, I_WO = 16 * 32;
    constexpr int NITEMS = I_IN + I_KV + I_PA + I_PB + I_PM + I_WO;
    for (int it = F.gwave; it < NITEMS; it += F.NW) {
        int r = it;
        if (r < I_IN) { p0_transpose_item(F.w_in, NIN, F.WIN, DM, 0, 0, scr, r, F.lane, true); continue; } r -= I_IN;
        if (r < I_KV) { p0_transpose_item(F.m_w_kv, 1024, F.WIN, DM, NIN, 0, scr, r, F.lane); continue; } r -= I_KV;
        if (r < I_PA) { p0_transpose_item(F.proj_a, DM, F.PCAT, KC, 0, 0, scr, r, F.lane); continue; } r -= I_PA;
        if (r < I_PB) { p0_transpose_item(F.proj_b, DM, F.PCAT, KC, 0, 768, scr, r, F.lane); continue; } r -= I_PB;
        if (r < I_PM) { p0_transpose_item(F.proj_m, DM, F.PCAT, KC, 0, 1024, scr, r, F.lane); continue; } r -= I_PM;
        p0_transpose_item(F.w_out, DM, F.WOUT, DM, 0, 0, scr, r, F.lane);
    }
    for (int i = F.gtid; i < 4 * 128 * 128; i += F.T) { const int t = (i >> 7) & 127, s = i & 127; F.WSP[i] = (bf16)(s <= t ? f2bf(F.sp_w[i]) : 0u); }
    for (int i = F.gtid; i < 3 * 4 * 132; i += F.T) { const int g = i / (4 * 132), h = (i / 132) % 4, j = i % 132; const int dil = g == 0 ? 1 : (g == 1 ? 4 : 16);
        F.BIAS[i] = j <= 128 ? F.rel_bias[t5_bucket(j * dil) * 12 + 4 * g + h] : 0.f; }
    for (int i = F.gtid; i < 3 * 4 * 192; i += F.T) { const int g = i / (4 * 192), h = (i / 192) % 4, step = i % 192 - 31; const int dil = g == 0 ? 1 : (g == 1 ? 4 : 16);
        F.BIASX[i] = (step >= 0 && step <= 128) ? F.rel_bias[t5_bucket(step * dil) * 12 + 4 * g + h] * 1.4426950408889634f : -1e30f; }
    if ((MTOT % (4 * F.NW)) == 0 && (MMEM % (4 * F.NW)) == 0) {
        for (size_t m = F.gwave; m < (size_t)MTOT; m += 4 * (size_t)F.NW) rms_rows_to_bf16<4>(F.x, F.norm_w, F.XN, m, F.NW, F.lane);
        for (size_t m = F.gwave; m < (size_t)MMEM; m += 4 * (size_t)F.NW) rms_rows_to_bf16<4>(F.mem, F.mem_norm_w, F.XN + (size_t)MTOT * DM, m, F.NW, F.lane);
    } else {
        for (size_t m = F.gwave; m < (size_t)MTOT; m += F.NW) rms_rows_to_bf16<1>(F.x, F.norm_w, F.XN, m, 0, F.lane);
        for (size_t m = F.gwave; m < (size_t)MMEM; m += F.NW) rms_rows_to_bf16<1>(F.mem, F.mem_norm_w, F.XN + (size_t)MTOT * DM, m, 0, F.lane);
    }
}


typedef float f32x16 __attribute__((ext_vector_type(16)));
typedef short s16x4 __attribute__((ext_vector_type(4)));
__device__ __forceinline__ int crow(int r, int hi) { return (r & 3) + 8 * (r >> 2) + 4 * hi; }
__device__ __forceinline__ unsigned cvtpk(float lo, float hi) { return pg8::cvt_pk_bf16(lo, hi); }
__device__ __forceinline__ v4u swap32x2(v4u w) { const auto r0 = __builtin_amdgcn_permlane32_swap(w.x, w.z, false, false), r1 = __builtin_amdgcn_permlane32_swap(w.y, w.w, false, false); return (v4u){r0[0], r1[0], r0[1], r1[1]}; }
__device__ __forceinline__ s16x4 vtr(const LAS unsigned char* p) { typedef short v4i16_t __attribute__((ext_vector_type(4))); return __builtin_bit_cast(s16x4, __builtin_amdgcn_ds_read_tr16_b64_v4i16((LAS v4i16_t*)p)); }
__device__ __forceinline__ float bflo(unsigned w) { return __uint_as_float(w << 16); }
__device__ __forceinline__ float bfhi(unsigned w) { return __uint_as_float(w & 0xffff0000u); }
constexpr float LOG2E = 1.4426950408889634f, LN2 = 0.6931471805599453f;
constexpr int NBX = 192;


__device__ __forceinline__ void dma16(const void* gsrc, LAS unsigned char* ldst) { __builtin_amdgcn_global_load_lds((const unsigned*)gsrc, (LAS unsigned*)ldst, 16, 0, 0); }
#define VM_WAIT0() asm volatile("s_waitcnt vmcnt(0)" ::: "memory")
__device__ __forceinline__ void st_mixA_mfma(Ctx& F) {
    const int lane = hw_lane(), r32 = lane & 31, hi = lane >> 5, tid = F.wave * 64 + lane;
    LAS unsigned char* wl = F.lds + RING_OFF + F.wave * 16384;
    typedef float f32x2v __attribute__((ext_vector_type(2))); typedef unsigned u32x2v __attribute__((ext_vector_type(2)));
    LAS f32x2v* tab = (LAS f32x2v*)(F.lds + WSCR_OFF + 8192);
    const int g = F.wave >> 1, ch = lane & 3;
    bf16x8 wf[14];
    const bf16* wrow0 = F.WSP + (size_t)(g * 128 + r32) * 128 + 8 * hi;
    { int n = 0;
#pragma unroll
      for (int tb = 2; tb < 4; ++tb)
#pragma unroll
          for (int ks = 0; ks < 2 * (tb + 1); ++ks) wf[n++] = *(const bf16x8*)(wrow0 + (size_t)tb * 32 * 128 + 16 * ks); }
    for (int unit = blockIdx.x; unit < HB_ROWS / 128; unit += F.G) {
        const int rowbase = unit * 128;
        v4u raw[8];
        { const int c0 = g * 192 + (F.wave & 1) * 96;
#pragma unroll
          for (int i = 0; i < 8; ++i) raw[i] = *(const v4u*)(F.PA + (size_t)(rowbase + (lane >> 2) + 16 * i) * PAP + C_AV + c0 + 8 * ch); }
        { const int row = tid >> 2, part = tid & 3; const float* sp = F.SS + (size_t)(rowbase + row) * SS_W + 12 * part; float s = 0.f, q = 0.f;
#pragma unroll
          for (int k = 0; k < 6; ++k) { s += sp[2 * k]; q += sp[2 * k + 1]; }
          s += __shfl_xor(s, 1); s += __shfl_xor(s, 2); q += __shfl_xor(q, 1); q += __shfl_xor(q, 2);
          const float mu = s * (1.f / 768.f), var = q * (1.f / 768.f) - mu * mu;
          if (part == 0) tab[row] = (f32x2v){mu, rsqrtf(fmaxf(var, 0.f) + EPS)}; }
        __syncthreads();
#pragma unroll 1
        for (int cbi = 0; cbi < 3; ++cbi) {
            const int c0 = g * 192 + ((F.wave & 1) * 3 + cbi) * 32;
            const f32x4 w0 = *(const f32x4*)(F.lnw + c0 + 8 * ch), w1 = *(const f32x4*)(F.lnw + c0 + 8 * ch + 4), b0 = *(const f32x4*)(F.lnb + c0 + 8 * ch), b1 = *(const f32x4*)(F.lnb + c0 + 8 * ch + 4);
#pragma unroll
            for (int i = 0; i < 8; ++i) { const int s = (lane >> 2) + 16 * i; const f32x2v st = tab[s]; const v4u rw = raw[i]; v4u o;
                o.x = cvtpk((bflo(rw.x) - st.x) * st.y * w0.x + b0.x, (bfhi(rw.x) - st.x) * st.y * w0.y + b0.y); o.y = cvtpk((bflo(rw.y) - st.x) * st.y * w0.z + b0.z, (bfhi(rw.y) - st.x) * st.y * w0.w + b0.w);
                o.z = cvtpk((bflo(rw.z) - st.x) * st.y * w1.x + b1.x, (bfhi(rw.z) - st.x) * st.y * w1.y + b1.y); o.w = cvtpk((bflo(rw.w) - st.x) * st.y * w1.z + b1.z, (bfhi(rw.w) - st.x) * st.y * w1.w + b1.w);
                *(LAS v4u*)(wl + (s >> 3) * 512 + (s & 7) * 64 + ch * 16) = o; }
            if (cbi < 2) {
#pragma unroll
                for (int i = 0; i < 8; ++i) raw[i] = *(const v4u*)(F.PA + (size_t)(rowbase + (lane >> 2) + 16 * i) * PAP + C_AV + c0 + 32 + 8 * ch); }
            LAS unsigned char* uzb = wl + 8192;
#pragma unroll
            for (int p = 0; p < 8; ++p) { const int row_ = 16 * p + (lane >> 2);
                dma16(F.PA + (size_t)(rowbase + row_) * PAP + C_AU + c0 + 8 * ((lane & 3) ^ ((row_ >> 2) & 3)), uzb + p * 1024); }
            const LAS unsigned char* vb = wl + hi * 512 + ((lane & 15) >> 2) * 64 + ((lane >> 4) & 1) * 32 + (lane & 3) * 8;
            const bf16* wr2 = wrow0; asm volatile("" : "+v"(wr2));
            bf16x8 wq[6];
            { int n2 = 0;
#pragma unroll
              for (int tb = 0; tb < 2; ++tb)
#pragma unroll
                  for (int ks = 0; ks < 2 * (tb + 1); ++ks) wq[n2++] = *(const bf16x8*)(wr2 + (size_t)tb * 32 * 128 + 16 * ks); }
            int n = 0, nq = 0;
#pragma unroll
            for (int tb = 0; tb < 4; ++tb) { f32x16 acc = {};
#pragma unroll
                for (int ks = 0; ks < 2 * (tb + 1); ++ks) { const s16x4 a = vtr(vb + ks * 1024), c = vtr(vb + ks * 1024 + 256); const bf16x8 af = {a[0], a[1], a[2], a[3], c[0], c[1], c[2], c[3]};
                    acc = __builtin_amdgcn_mfma_f32_32x32x16_bf16(af, tb < 2 ? wq[nq++] : wf[n++], acc, 0, 0, 0); }
                const int t = 32 * tb + r32; const float sb = F.sp_b[g * 128 + t];
                if (tb == 0) VM_WAIT0();
                LAS unsigned char* urow = uzb + t * 64 + 8 * hi; const int fsw = (r32 >> 2) & 3;
#pragma unroll
                for (int i = 0; i < 4; ++i) { LAS u32x2v* up = (LAS u32x2v*)(urow + ((i ^ fsw) * 16)); const u32x2v u = *up; u32x2v w;
                    w.x = cvtpk(bflo(u.x) * (acc[4 * i] + sb), bfhi(u.x) * (acc[4 * i + 1] + sb)); w.y = cvtpk(bflo(u.y) * (acc[4 * i + 2] + sb), bfhi(u.y) * (acc[4 * i + 3] + sb));
                    *up = w; }
#pragma unroll
                for (int jr = 0; jr < 2; ++jr) { const int row_ = 32 * tb + 16 * jr + (lane >> 2); const v4u yv = *(const LAS v4u*)(uzb + row_ * 64 + (lane & 3) * 16);
                    *(v4u*)(F.YC + (size_t)(rowbase + row_) * KC + c0 + 8 * ((lane & 3) ^ ((row_ >> 2) & 3))) = yv; } }
        }
        __syncthreads();
    }
}

__device__ __forceinline__ void st_mergeB_vec(Ctx& F) {
    constexpr int NI = 4;
    const int total = HB_ROWS * 32;
    for (int g0 = F.gtid; g0 < total; g0 += NI * F.T) {
        v4u a[NI], b[NI], c[NI], z[NI]; float l0[NI], l1[NI], l2[NI];
#pragma unroll
        for (int i = 0; i < NI; ++i) { const int gid = g0 + i * F.T < total ? g0 + i * F.T : g0; const int r = gid >> 5, c8 = (gid & 31) * 8, h = c8 >> 6;
            l0[i] = F.LSE[((size_t)0 * HB_ROWS + r) * 4 + h]; l1[i] = F.LSE[((size_t)1 * HB_ROWS + r) * 4 + h]; l2[i] = F.LSE[((size_t)2 * HB_ROWS + r) * 4 + h];
            a[i] = *(const v4u*)(F.OG + ((size_t)0 * HB_ROWS + r) * 256 + c8); b[i] = *(const v4u*)(F.OG + ((size_t)1 * HB_ROWS + r) * 256 + c8); c[i] = *(const v4u*)(F.OG + ((size_t)2 * HB_ROWS + r) * 256 + c8);
            z[i] = *(const v4u*)(F.PA + (size_t)r * PAP + C_BZ + c8); }
        __builtin_amdgcn_sched_barrier(0);
#pragma unroll
        for (int i = 0; i < NI; ++i) { if (g0 + i * F.T >= total) break; const int gid = g0 + i * F.T; const int r = gid >> 5, c8 = (gid & 31) * 8;
            const float mx = fmaxf(l0[i], fmaxf(l1[i], l2[i])); float e0 = __expf(l0[i] - mx), e1 = __expf(l1[i] - mx), e2 = __expf(l2[i] - mx); const float inv = 1.f / (e0 + e1 + e2); e0 *= inv; e1 *= inv; e2 *= inv;
            v4u o;
#define MB_1(X) X = pk2((e0 * bflo(a[i].X) + e1 * bflo(b[i].X) + e2 * bflo(c[i].X)) * bflo(z[i].X), (e0 * bfhi(a[i].X) + e1 * bfhi(b[i].X) + e2 * bfhi(c[i].X)) * bfhi(z[i].X))
            o.MB_1(x); o.MB_1(y); o.MB_1(z); o.MB_1(w);
#undef MB_1
            *(v4u*)(F.YC + (size_t)r * KC + 768 + c8) = o; }
    }
}


__device__ __forceinline__ void st_attnM_v3(Ctx& F, int hb) {
    const int lane = hw_lane(), r32 = lane & 31, hi = lane >> 5;
    LAS unsigned char* kimg = F.lds + RING_OFF; LAS unsigned char* vimg = F.lds + RING_OFF + 65536;
    LAS float* kstab = (LAS float*)(F.lds + WSCR_OFF + 8192);
    typedef unsigned u32x2v __attribute__((ext_vector_type(2)));
    const int vcu = F.xgwave >> 3;
    __syncthreads();
    for (int task = vcu; task < 256; task += F.G) {
        const int bh = task >> 2, b = bh >> 2, h = bh & 3; const size_t kbase = (size_t)(hb * 16 + b) * MEML;
#pragma unroll
        for (int j = 0; j < 8; ++j) { const int p = F.wave * 8 + j, row = 4 * p + (lane >> 4);
            dma16(F.KVM + (kbase + row) * 1024 + h * 128 + 8 * ((lane & 15) ^ (row & 15)), kimg + p * 1024);
            dma16(F.KVM + (kbase + 8 * (p >> 1) + ((lane & 31) >> 2)) * 1024 + 512 + h * 128 + (2 * (p & 1) + (lane >> 5)) * 32 + (lane & 3) * 8, vimg + p * 1024); }
        { const int key = F.wave * 32 + r32; const float* sp = F.MKSS + (kbase + key) * 16 + 4 * h;
          const float ksv = rsqrtf(((sp[0] + sp[1]) + (sp[2] + sp[3])) * (1.f / 128.f) + EPS); if (lane < 32) kstab[key] = ksv; }
        VM_WAIT0(); __syncthreads();
#pragma unroll 1
        for (int qi = 0; qi < 2; ++qi) {
            const int qb = (task & 3) * 16 + F.wave * 2 + qi;
            const size_t qrow = (size_t)(b * SEQ + qb * 32 + r32);
            const float qs = rsqrtf(((F.SS[qrow * SS_W + 96 + 4 * h] + F.SS[qrow * SS_W + 96 + 4 * h + 1]) + (F.SS[qrow * SS_W + 96 + 4 * h + 2] + F.SS[qrow * SS_W + 96 + 4 * h + 3])) * (1.f / 128.f) + EPS) * (0.08838834764831845f * LOG2E);
            bf16x8 qf[8];
#pragma unroll
            for (int d0 = 0; d0 < 8; ++d0) { const int dd = 16 * d0 + 8 * hi;
                const v4u raw = *(const v4u*)(F.PA + qrow * PAP + C_MQ + h * 128 + dd);
                const f32x4 wa = *(const f32x4*)(F.mqw + dd), wb = *(const f32x4*)(F.mqw + dd + 4), ka = *(const f32x4*)(F.mkw + dd), kb = *(const f32x4*)(F.mkw + dd + 4);
                v4u o;
                o.x = cvtpk(bflo(raw.x) * qs * wa.x * ka.x, bfhi(raw.x) * qs * wa.y * ka.y); o.y = cvtpk(bflo(raw.y) * qs * wa.z * ka.z, bfhi(raw.y) * qs * wa.w * ka.w);
                o.z = cvtpk(bflo(raw.z) * qs * wb.x * kb.x, bfhi(raw.z) * qs * wb.y * kb.y); o.w = cvtpk(bflo(raw.w) * qs * wb.z * kb.z, bfhi(raw.w) * qs * wb.w * kb.w);
                qf[d0] = __builtin_bit_cast(bf16x8, o); }
            v4u zq[4][2];
#pragma unroll
            for (int db = 0; db < 4; ++db)
#pragma unroll
                for (int kp = 0; kp < 2; ++kp) zq[db][kp] = *(const v4u*)(F.PA + qrow * PAP + C_MZ + h * 128 + db * 32 + 16 * kp + 8 * hi);
            float mrun = -1e30f, lrun = 0.f; f32x16 o0 = {}, o1 = {}, o2 = {}, o3 = {};
            const LAS unsigned char* kb0 = kimg + r32 * 256; const int ksw = r32 & 15;
            const LAS unsigned char* vb0 = vimg + (4 * hi + ((lane & 15) >> 2)) * 64 + ((lane >> 4) & 1) * 32 + (lane & 3) * 8;
#pragma unroll 2
            for (int t = 0; t < MEML / 32; ++t) {
                f32x16 st = {};
#pragma unroll
                for (int d0 = 0; d0 < 8; ++d0) { const bf16x8 kf = *(const LAS bf16x8*)(kb0 + t * 8192 + (((2 * d0 + hi) ^ ksw) * 16)); st = __builtin_amdgcn_mfma_f32_32x32x16_bf16(kf, qf[d0], st, 0, 0, 0); }
                float tmax = -1e30f;
#pragma unroll
                for (int i = 0; i < 4; ++i) { const f32x4 kk = *(const LAS f32x4*)(kstab + 32 * t + 8 * i + 4 * hi);
#pragma unroll
                    for (int j = 0; j < 4; ++j) { const float s = st[4 * i + j] * kk[j]; st[4 * i + j] = s; tmax = fmaxf(tmax, s); } }
                tmax = fmaxf(tmax, __shfl_xor(tmax, 32));
                const float mnew = fmaxf(mrun, tmax), alpha = __builtin_amdgcn_exp2f(mrun - mnew); mrun = mnew;
                float psum = 0.f;
#pragma unroll
                for (int r = 0; r < 16; ++r) { st[r] = __builtin_amdgcn_exp2f(st[r] - mnew); psum += st[r]; }
                lrun = lrun * alpha + psum;
#pragma unroll
                for (int r = 0; r < 16; ++r) { o0[r] *= alpha; o1[r] *= alpha; o2[r] *= alpha; o3[r] *= alpha; }
                v4u p0, p1;
                p0.x = cvtpk(st[0], st[1]); p0.y = cvtpk(st[2], st[3]); p0.z = cvtpk(st[4], st[5]); p0.w = cvtpk(st[6], st[7]);
                p1.x = cvtpk(st[8], st[9]); p1.y = cvtpk(st[10], st[11]); p1.z = cvtpk(st[12], st[13]); p1.w = cvtpk(st[14], st[15]);
                const LAS unsigned char* vb = vb0 + t * 8192;
#define AM_PV(OX, DB) do { _Pragma("unroll") for (int s = 0; s < 2; ++s) { const bf16x8 pf = __builtin_bit_cast(bf16x8, s == 0 ? p0 : p1); \
                    const s16x4 a = vtr(vb + (2 * s) * 2048 + (DB) * 512), c = vtr(vb + (2 * s + 1) * 2048 + (DB) * 512); const bf16x8 vf = {a[0], a[1], a[2], a[3], c[0], c[1], c[2], c[3]}; \
                    OX = __builtin_amdgcn_mfma_f32_32x32x16_bf16(vf, pf, OX, 0, 0, 0); } } while (0)
                AM_PV(o0, 0); AM_PV(o1, 1); AM_PV(o2, 2); AM_PV(o3, 3);
#undef AM_PV
            }
            const float ltot = lrun + __shfl_xor(lrun, 32), inv = 1.f / ltot;
            bf16* yrow = F.YC + qrow * KC + 1024 + h * 128 + 8 * hi;
#define AM_ST(OX, DB) do { _Pragma("unroll") for (int kp = 0; kp < 2; ++kp) { const v4u z = swap32x2(zq[DB][kp]);     \
            v4u w; w.x = cvtpk(OX[8 * kp] * inv * bflo(z.x), OX[8 * kp + 1] * inv * bfhi(z.x)); w.y = cvtpk(OX[8 * kp + 2] * inv * bflo(z.y), OX[8 * kp + 3] * inv * bfhi(z.y)); \
            w.z = cvtpk(OX[8 * kp + 4] * inv * bflo(z.z), OX[8 * kp + 5] * inv * bfhi(z.z)); w.w = cvtpk(OX[8 * kp + 6] * inv * bflo(z.w), OX[8 * kp + 7] * inv * bfhi(z.w)); \
            *(v4u*)(yrow + (DB) * 32 + 16 * kp) = swap32x2(w); } } while (0)
            AM_ST(o0, 0); AM_ST(o1, 1); AM_ST(o2, 2); AM_ST(o3, 3);
#undef AM_ST
        }
        __syncthreads();
    }
}

__device__ __forceinline__ void st_attnB_v3(Ctx& F) {
    const int lane = hw_lane(), r32 = lane & 31, hi = lane >> 5, tid = F.wave * 64 + lane;
    LAS unsigned char* kimg = F.lds + RING_OFF; LAS unsigned char* vimg = F.lds + RING_OFF + 49152;
    LAS float* kstab = (LAS float*)(F.lds + RING_OFF + 98304);
    LAS float* btab = (LAS float*)(F.lds + RING_OFF + 98304 + 2048);
    typedef unsigned u32x2v __attribute__((ext_vector_type(2)));
    const int vcu = F.xgwave >> 3;
    __syncthreads();
    for (int unit = vcu; unit < 3 * 16 * 4 * 8; unit += F.G) {
        const int k = unit & 7, h = (unit >> 3) & 3, b = (unit >> 5) & 15, g = unit >> 9, hh = 4 * g + h;
        const int dil = g == 0 ? 1 : (g == 1 ? 4 : 16);
        const int res0 = g == 0 ? 0 : (g == 1 ? (k >> 1) : 2 * k), j0 = g == 0 ? 8 * k : (g == 1 ? 8 * (k & 1) : 0);
#pragma unroll
        for (int i = 0; i < 12; ++i) { const int q = F.wave * 12 + i, s = q >> 3, pc = q & 7, p = pc & 3;
            int res, jt; bool valid;
            if (g < 2) { res = res0; jt = j0 - 4 + s; valid = jt >= 0; } else { res = res0 + (s >> 2); jt = s & 3; valid = s < 8; }
            if (valid) {
                if (pc < 4) { const int row = 8 * p + (lane >> 3); const size_t trow = (size_t)(b * SEQ + res + (32 * jt + row) * dil);
                    dma16(F.PA + trow * PAP + C_BK + hh * 64 + 8 * ((lane & 7) ^ ((row >> 1) & 7)), kimg + s * 4096 + p * 1024); }
                else { const int key = 8 * p + ((lane & 31) >> 2); const size_t trow = (size_t)(b * SEQ + res + (32 * jt + key) * dil);
                    dma16(F.PA + trow * PAP + C_BV + hh * 64 + (lane >> 5) * 32 + (lane & 3) * 8, vimg + s * 4096 + p * 1024); } } }
        if (tid < 384) { const int s = tid >> 5, kk = tid & 31; int res, jt; bool valid;
            if (g < 2) { res = res0; jt = j0 - 4 + s; valid = jt >= 0; } else { res = res0 + (s >> 2); jt = s & 3; valid = s < 8; }
            if (valid) { const size_t trow = (size_t)(b * SEQ + res + (32 * jt + kk) * dil);
                kstab[tid] = rsqrtf((F.SS[trow * SS_W + 72 + 2 * hh] + F.SS[trow * SS_W + 72 + 2 * hh + 1]) * (1.f / 64.f) + EPS); } }
        if (tid < NBX) btab[tid] = F.BIASX[(g * 4 + h) * NBX + tid];
        const int wres = g < 2 ? res0 : res0 + (F.wave >> 2), j = g < 2 ? j0 + F.wave : (F.wave & 3);
        const int sbase = g < 2 ? 4 - j0 : (F.wave >> 2) * 4;
        const size_t qrow = (size_t)(b * SEQ + wres + (32 * j + r32) * dil);
        const float qs = rsqrtf((F.SS[qrow * SS_W + 48 + 2 * hh] + F.SS[qrow * SS_W + 48 + 2 * hh + 1]) * (1.f / 64.f) + EPS) * (0.125f * LOG2E);
        bf16x8 qf[4];
#pragma unroll
        for (int d0 = 0; d0 < 4; ++d0) { const int dd = 16 * d0 + 8 * hi;
            const v4u raw = *(const v4u*)(F.PA + qrow * PAP + C_BQ + hh * 64 + dd);
            const f32x4 wa = *(const f32x4*)(F.bqw + dd), wb = *(const f32x4*)(F.bqw + dd + 4), ka = *(const f32x4*)(F.bkw + dd), kb = *(const f32x4*)(F.bkw + dd + 4);
            v4u o;
            o.x = cvtpk(bflo(raw.x) * qs * wa.x * ka.x, bfhi(raw.x) * qs * wa.y * ka.y); o.y = cvtpk(bflo(raw.y) * qs * wa.z * ka.z, bfhi(raw.y) * qs * wa.w * ka.w);
            o.z = cvtpk(bflo(raw.z) * qs * wb.x * kb.x, bfhi(raw.z) * qs * wb.y * kb.y); o.w = cvtpk(bflo(raw.w) * qs * wb.z * kb.z, bfhi(raw.w) * qs * wb.w * kb.w);
            qf[d0] = __builtin_bit_cast(bf16x8, o); }
        VM_WAIT0(); __syncthreads();
        float mrun = -1e30f, lrun = 0.f; f32x16 o0 = {}, o1 = {};
        const int ksw = (r32 >> 1) & 7;
        for (int jt = (j >= 4 ? j - 4 : 0); jt <= j; ++jt) {
            const int s = sbase + jt;
            const LAS unsigned char* kb = kimg + s * 4096 + r32 * 128;
            f32x16 st = {};
#pragma unroll
            for (int d0 = 0; d0 < 4; ++d0) { const bf16x8 kf = *(const LAS bf16x8*)(kb + (((2 * d0 + hi) ^ ksw) * 16)); st = __builtin_amdgcn_mfma_f32_32x32x16_bf16(kf, qf[d0], st, 0, 0, 0); }
            const int bidx = 32 * (j - jt) + r32 + 31 - 4 * hi;
            float tmax = -1e30f;
#pragma unroll
            for (int i = 0; i < 4; ++i) { const f32x4 kk = *(const LAS f32x4*)(kstab + s * 32 + 8 * i + 4 * hi);
#pragma unroll
                for (int jj = 0; jj < 4; ++jj) { const float sv = st[4 * i + jj] * kk[jj] + btab[bidx - 8 * i - jj]; st[4 * i + jj] = sv; tmax = fmaxf(tmax, sv); } }
            tmax = fmaxf(tmax, __shfl_xor(tmax, 32));
            const float mnew = fmaxf(mrun, tmax), alpha = __builtin_amdgcn_exp2f(mrun - mnew); mrun = mnew;
            float psum = 0.f;
#pragma unroll
            for (int r = 0; r < 16; ++r) { st[r] = __builtin_amdgcn_exp2f(st[r] - mnew); psum += st[r]; }
            lrun = lrun * alpha + psum;
#pragma unroll
            for (int r = 0; r < 16; ++r) { o0[r] *= alpha; o1[r] *= alpha; }
            v4u p0, p1;
            p0.x = cvtpk(st[0], st[1]); p0.y = cvtpk(st[2], st[3]); p0.z = cvtpk(st[4], st[5]); p0.w = cvtpk(st[6], st[7]);
            p1.x = cvtpk(st[8], st[9]); p1.y = cvtpk(st[10], st[11]); p1.z = cvtpk(st[12], st[13]); p1.w = cvtpk(st[14], st[15]);
            const LAS unsigned char* vb = vimg + s * 4096 + (4 * hi + ((lane & 15) >> 2)) * 64 + ((lane >> 4) & 1) * 32 + (lane & 3) * 8;
#pragma unroll
            for (int ss = 0; ss < 2; ++ss) { const bf16x8 pf = __builtin_bit_cast(bf16x8, ss == 0 ? p0 : p1);
                { const s16x4 a = vtr(vb + (2 * ss) * 1024), c = vtr(vb + (2 * ss + 1) * 1024); const bf16x8 vf = {a[0], a[1], a[2], a[3], c[0], c[1], c[2], c[3]};
                  o0 = __builtin_amdgcn_mfma_f32_32x32x16_bf16(vf, pf, o0, 0, 0, 0); }
                { const s16x4 a = vtr(vb + (2 * ss) * 1024 + 512), c = vtr(vb + (2 * ss + 1) * 1024 + 512); const bf16x8 vf = {a[0], a[1], a[2], a[3], c[0], c[1], c[2], c[3]};
                  o1 = __builtin_amdgcn_mfma_f32_32x32x16_bf16(vf, pf, o1, 0, 0, 0); } }
        }
        const float ltot = lrun + __shfl_xor(lrun, 32), inv = 1.f / ltot;
        bf16* orow = F.OG + ((size_t)g * HB_ROWS + qrow) * 256 + h * 64 + 8 * hi;
#define AB_ST(OX, DB) do { _Pragma("unroll") for (int kp = 0; kp < 2; ++kp) { v4u w; \
            w.x = cvtpk(OX[8 * kp] * inv, OX[8 * kp + 1] * inv); w.y = cvtpk(OX[8 * kp + 2] * inv, OX[8 * kp + 3] * inv); w.z = cvtpk(OX[8 * kp + 4] * inv, OX[8 * kp + 5] * inv); w.w = cvtpk(OX[8 * kp + 6] * inv, OX[8 * kp + 7] * inv); \
            *(v4u*)(orow + (DB) * 32 + 16 * kp) = swap32x2(w); } } while (0)
        AB_ST(o0, 0); AB_ST(o1, 1);
#undef AB_ST
        if (hi == 0) F.LSE[((size_t)g * HB_ROWS + qrow) * 4 + h] = (mrun + __log2f(ltot)) * LN2;
        __syncthreads();
    }
}

#ifndef G1_STAGGER_TICKS
#define G1_STAGGER_TICKS 0
#endif
#ifndef G1_ALIGN_EPI
#define G1_ALIGN_EPI true
#endif
#ifndef PROBE_REP
#define PROBE_REP -1
#endif
#define REPS(id) for (int rep_ = 0; rep_ < ((PROBE_REP) == (id) ? 2 : 1); ++rep_)
#ifndef MK_PER_PHASE
#define MK_PER_PHASE 0
#endif
constexpr int NPH_HALF = 5, NPHASES = 1 + 2 * NPH_HALF;
struct Args { const float* in[20]; float* out; unsigned char* ws; int ph_lo, ph_hi; };
__global__ void __launch_bounds__(NTHR, 2) mega_fwd(Args args) {
    extern __shared__ __attribute__((aligned(16))) unsigned char lds_raw[];
    Ctx F;
    F.lds = (LAS unsigned char*)lds_raw;
    F.tid = threadIdx.x; F.lane = F.tid & 63; F.wave = __builtin_amdgcn_readfirstlane(F.tid >> 6);
    F.G = gridDim.x; F.gtid = blockIdx.x * NTHR + F.tid; F.T = F.G * NTHR; F.gwave = blockIdx.x * NWAVES + F.wave; F.NW = F.G * NWAVES;
    { const int bx = blockIdx.x; const int vcu = (F.G % 8 == 0) ? (bx % 8) * (F.G / 8) + bx / 8 : bx; F.xgwave = vcu * NWAVES + F.wave; }
    unsigned char* ws = args.ws;
    F.x = args.in[0]; F.mem = args.in[1]; F.norm_w = args.in[2]; F.w_in = args.in[3]; F.gate_b = args.in[4]; F.lnw = args.in[5]; F.lnb = args.in[6]; F.sp_w = args.in[7];
    F.sp_b = args.in[8]; F.bqw = args.in[9]; F.bkw = args.in[10]; F.rel_bias = args.in[11]; F.mem_norm_w = args.in[12]; F.m_w_kv = args.in[13]; F.mqw = args.in[14]; F.mkw = args.in[15];
    F.proj_a = args.in[16]; F.proj_b = args.in[17]; F.proj_m = args.in[18]; F.w_out = args.in[19]; F.out = args.out;
    F.WIN = (bf16*)(ws + WS_WIN); F.PCAT = (bf16*)(ws + WS_PCAT); F.WOUT = (bf16*)(ws + WS_WOUT); F.WSP = (bf16*)(ws + WS_WSP); F.BIAS = (float*)(ws + WS_BIAS); F.BIASX = (float*)(ws + WS_BIAS + 65536);
    F.XN = (bf16*)(ws + WS_XN); F.PA = (bf16*)(ws + WS_PA); F.KVM = (bf16*)(ws + WS_KVM); F.SS = (float*)(ws + WS_SS); F.MKSS = (float*)(ws + WS_MKSS);
    F.OG = (bf16*)(ws + WS_OG); F.LSE = (float*)(ws + WS_LSE); F.LNST = (float*)(ws + WS_LNST); F.YC = (bf16*)(ws + WS_YC); F.MRG = (bf16*)(ws + WS_MRG);
    for (int u = F.tid; u < (LDS_BYTES - LDSCTL_OFF) / 4; u += NTHR) ((LAS unsigned*)(F.lds + LDSCTL_OFF))[u] = 0u;
    __syncthreads();
    XcdBarrier bar; bar.bar = (unsigned*)(ws + WS_CTL) + CW_BAR; bar.x = 0; bar.st = nullptr; bar.wave = 0;
    if (!MK_PER_PHASE) bar = xcd_barrier_post((unsigned*)(ws + WS_CTL) + CW_BAR, (volatile LAS unsigned*)(F.lds + MISC_OFF) + 8, F.wave);
    const int lo = args.ph_lo, hi = args.ph_hi;
#define IN(k) (lo <= (k) && (k) < hi)
#define SEAM(k) do { if (IN(k) && IN((k) + 1)) xcd_barrier(bar); } while (0)

    if (IN(0)) { REPS(0) p0_prologue(F); } SEAM(0);
#pragma unroll 1
    for (int hb = 0; hb < 2; ++hb) {
        const int pb = 1 + hb * NPH_HALF, row0 = hb * HB_ROWS;
        asm volatile("v_mbcnt_lo_u32_b32 %0, -1, 0\n\tv_mbcnt_hi_u32_b32 %0, -1, %0" : "=v"(F.lane)); F.tid = F.wave * 64 + F.lane; F.gtid = blockIdx.x * NTHR + F.tid;
#if PROBE_REP == 9 || PROBE_REP == 10
        if (IN(pb + 0)) { pg8::Gemm g{F.XN, F.WIN, MTOT + MMEM, NIN + 1024, DM, DM, DM}; pg8::OrderG1 S; S.init(hb, F.G, (int)blockIdx.x);
            typedef pg8::EpiProjT<PROBE_REP - 8> EP; EP E{F.PA, F.KVM, F.SS, F.MKSS, F.gate_b, hb * (HB_ROWS / 256), 0};
            pg8::gemm_phase<EP, pg8::OrderG1, true, true>(F.lds + RING_OFF, g, S, E, F.wave); }
#endif
        if (IN(pb + 0)) REPS(1) {
            pg8::Gemm g{F.XN, F.WIN, MTOT + MMEM, NIN + 1024, DM, DM, DM}; pg8::OrderG1 S; S.init(hb, F.G, (int)blockIdx.x);
#if G1_STAGGER_TICKS
            { const unsigned long long t0 = __builtin_amdgcn_s_memrealtime(), dl = (unsigned long long)((blockIdx.x >> 3) & 31) * G1_STAGGER_TICKS;
              while (__builtin_amdgcn_s_memrealtime() - t0 < dl) __builtin_amdgcn_s_sleep(8); }
#endif
            pg8::EpiProj E{F.PA, F.KVM, F.SS, F.MKSS, F.gate_b, hb * (HB_ROWS / 256), 0};
            pg8::gemm_phase<pg8::EpiProj, pg8::OrderG1, G1_ALIGN_EPI, true>(F.lds + RING_OFF, g, S, E, F.wave);
        }
#if PROBE_REP == 8
        if (IN(pb + 0)) { pg8::Gemm g{F.XN, F.WIN, MTOT + MMEM, NIN + 1024, DM, DM, DM}; pg8::OrderG1 S; S.init(hb, F.G, (int)blockIdx.x); pg8::EpiNull E{};
            pg8::gemm_phase<pg8::EpiNull, pg8::OrderG1, true, true>(F.lds + RING_OFF, g, S, E, F.wave); }
#endif
        SEAM(pb + 0);
        if (IN(pb + 1)) { REPS(2) st_mixA_mfma(F); REPS(3) st_attnB_v3(F); REPS(4) st_attnM_v3(F, hb); } SEAM(pb + 1);
        if (IN(pb + 2)) { REPS(5) st_mergeB_vec(F); } SEAM(pb + 2);
#if PROBE_REP == 13 || PROBE_REP == 14
        if (IN(pb + 3)) { pg8::Gemm g{F.YC, F.PCAT, HB_ROWS, DM, KC, KC, KC}; pg8::StaticOrder S; S.init(HB_ROWS, DM, F.G, (int)blockIdx.x);
            typedef pg8::EpiG2catT<PROBE_REP == 13, PROBE_REP == 14> EP; EP E{F.PA, F.MRG};
            pg8::gemm_phase<EP, pg8::StaticOrder, true, true>(F.lds + RING_OFF, g, S, E, F.wave); }
#endif
#if PROBE_REP == 11
        if (IN(pb + 3)) { pg8::Gemm g{F.YC, F.PCAT, HB_ROWS, DM, KC, KC, KC}; pg8::StaticOrder S; S.init(HB_ROWS, DM, F.G, (int)blockIdx.x); pg8::EpiNull E{};
            pg8::gemm_phase<pg8::EpiNull, pg8::StaticOrder, true, true>(F.lds + RING_OFF, g, S, E, F.wave); }
#endif
#if PROBE_REP == 12
        if (IN(pb + 4)) { pg8::Gemm g{F.MRG, F.WOUT, HB_ROWS, DM, DM, DM, DM}; pg8::StaticOrder S; S.init(HB_ROWS, DM, F.G, (int)blockIdx.x); pg8::EpiNull E{};
            pg8::gemm_phase<pg8::EpiNull, pg8::StaticOrder, true, true>(F.lds + RING_OFF, g, S, E, F.wave); }
#endif
        if (IN(pb + 3)) REPS(6) {
            pg8::Gemm g{F.YC, F.PCAT, HB_ROWS, DM, KC, KC, KC}; pg8::StaticOrder S; S.init(HB_ROWS, DM, F.G, (int)blockIdx.x);
            pg8::EpiG2cat E{F.PA, F.MRG};
            pg8::gemm_phase<pg8::EpiG2cat, pg8::StaticOrder, true, true>(F.lds + RING_OFF, g, S, E, F.wave);
        } SEAM(pb + 3);
        if (IN(pb + 4)) REPS(7) {
            pg8::Gemm g{F.MRG, F.WOUT, HB_ROWS, DM, DM, DM, DM}; pg8::StaticOrder S; S.init(HB_ROWS, DM, F.G, (int)blockIdx.x);
            pg8::EpiG3 E{F.x + (size_t)row0 * DM, F.out + (size_t)row0 * DM};
            pg8::gemm_phase<pg8::EpiG3, pg8::StaticOrder, true, true>(F.lds + RING_OFF, g, S, E, F.wave);
        } if (hb == 1) SEAM(pb + 4);
    }
#undef IN
#undef SEAM
}

extern "C" void kernel_launch(void* const* d_in, const int* in_sizes, int n_in, void* d_out, int out_size, void* d_ws, size_t ws_size, hipStream_t stream) {
    static int grid = 0;
    if (grid == 0) {
        if (n_in != 20 || in_sizes[0] != MTOT * DM || out_size != MTOT * DM || ws_size < WS_END) { fprintf(stderr, "kernel_launch: unexpected shapes (n_in %d, ws %zu); nothing launched\n", n_in, ws_size); grid = -1; return; }
        int dev = 0, cus = 0, per_cu = 0;
        if (hipGetDevice(&dev) != hipSuccess || hipDeviceGetAttribute(&cus, hipDeviceAttributeMultiprocessorCount, dev) != hipSuccess) { grid = -1; return; }
        if (hipFuncSetAttribute((const void*)mega_fwd, hipFuncAttributeMaxDynamicSharedMemorySize, LDS_BYTES) != hipSuccess) { fprintf(stderr, "kernel_launch: hipFuncSetAttribute failed\n"); grid = -1; return; }
        if (hipOccupancyMaxActiveBlocksPerMultiprocessor(&per_cu, (const void*)mega_fwd, NTHR, LDS_BYTES) != hipSuccess || per_cu < 1) { fprintf(stderr, "kernel_launch: occupancy query says %d blocks per CU\n", per_cu); (void)hipGetLastError(); grid = -1; return; }
        grid = cus;
    }
    if (grid < 0) return;
    if (hipMemsetAsync((char*)d_ws + WS_CTL, 0, CTL_ZERO_BYTES, stream) != hipSuccess) return;
    Args a{};
    for (int i = 0; i < 20; ++i) a.in[i] = (const float*)d_in[i];
    a.out = (float*)d_out; a.ws = (unsigned char*)d_ws;
#if MK_PER_PHASE
    for (int p = 0; p < NPHASES; ++p) { a.ph_lo = p; a.ph_hi = p + 1; hipLaunchKernelGGL(mega_fwd, dim3(grid), dim3(NTHR), LDS_BYTES, stream, a); }
#else
    a.ph_lo = 0; a.ph_hi = NPHASES; hipLaunchKernelGGL(mega_fwd, dim3(grid), dim3(NTHR), LDS_BYTES, stream, a);
#endif
}
```

```cpp
#include <hip/hip_runtime.h>
#include <cstdint>
#include <cstdio>

constexpr int DM = 1024, NB = 32, SEQ = 2048, MTOT = NB * SEQ;
constexpr int NIN = 8960, MEML = 256, MMEM = NB * MEML;
constexpr int HB_ROWS = MTOT / 2;
constexpr int C_AU = 0, C_AV = 768, C_AZ = 1536, C_BQ = 2304, C_BK = 3072, C_BV = 3840, C_BZ = 4608, C_MQ = 4864, C_MZ = 5376, C_G = 5888;
constexpr float EPS = 1e-6f;
constexpr int SS_W = 112;
constexpr int PAP = 7424;
constexpr int PA_ROWB = 2 * PAP, PA_GOFF = 2 * C_G;
constexpr int N8 = 6656;
__host__ __device__ constexpr int i8col(int n) { return n >= C_G ? n - C_G : (n >= C_BQ && n < C_BZ) ? n - C_BQ + 3072 : (n >= C_AV && n < C_AZ) ? n - C_AV + 5376 : (n >= C_MQ && n < C_MZ) ? n - C_MQ + 6144 : -1; }
__host__ __device__ constexpr int i8src(int c8) { return c8 < 3072 ? C_G + c8 : c8 < 5376 ? C_BQ + (c8 - 3072) : c8 < 6144 ? C_AV + (c8 - 5376) : C_MQ + (c8 - 6144); }
__host__ __device__ constexpr int i8tile_pn(int t8) { return t8 < 12 ? 23 + t8 : t8 < 21 ? 9 + (t8 - 12) : t8 < 24 ? 3 + (t8 - 21) : 19 + (t8 - 24); }
constexpr int KC = 1536;

constexpr size_t MiB = 1u << 20;
constexpr size_t WS_CTL = 0, CTL_ZERO_BYTES = 64 * 1024, WS_WIN = 2 * MiB, WS_PCAT = 22 * MiB, WS_WOUT = 28 * MiB, WS_WSP = 27 * MiB, WS_BIAS = 27 * MiB + 512 * 1024;
constexpr size_t WS_XN = 32 * MiB, WS_PA = 176 * MiB, WS_KVM = 736 * MiB, WS_SS = 752 * MiB, WS_MKSS = 766 * MiB, WS_OG = 768 * MiB, WS_LSE = 816 * MiB, WS_LNST = 818 * MiB;
constexpr int PMR = 1088;
constexpr size_t WS_YC = 820 * MiB, WS_MRG = 916 * MiB, WS_END = 984 * MiB;
constexpr int P8 = 1152;
constexpr size_t WS_XN8 = 640 * MiB, WS_W8 = 712 * MiB, WS_CS = 720 * MiB, WS_RS = 721 * MiB;
constexpr int CW_CMAX = 8192;
constexpr int CW_BAR = 4096;

__device__ __forceinline__ float xl_swap32(float x, bool mx) { const unsigned u = __builtin_bit_cast(unsigned, x); const auto r = __builtin_amdgcn_permlane32_swap(u, u, false, false); const unsigned a = r[0], b = r[1];
    const float fa = __builtin_bit_cast(float, a), fb = __builtin_bit_cast(float, b); return mx ? fmaxf(fa, fb) : fa + fb; }
__device__ __forceinline__ float xl_swap16(float x) { const unsigned u = __builtin_bit_cast(unsigned, x); const auto r = __builtin_amdgcn_permlane16_swap(u, u, false, false); const unsigned a = r[0], b = r[1];
    return __builtin_bit_cast(float, a) + __builtin_bit_cast(float, b); }
__device__ __forceinline__ float sum_x32(float x) { return xl_swap32(x, false); }
__device__ __forceinline__ float max_x32(float x) { return xl_swap32(x, true); }
__device__ __forceinline__ float sum_x16_x32(float x) { return xl_swap32(xl_swap16(x), false); }
template <int CTRL> __device__ __forceinline__ float dpp_f(float x) { return __builtin_bit_cast(float, __builtin_amdgcn_update_dpp(0, __builtin_bit_cast(int, x), CTRL, 0xf, 0xf, true)); }
__device__ __forceinline__ float sum_quad(float x) { x += dpp_f<0xB1>(x); return x + dpp_f<0x4E>(x); }
namespace pg8 {
#define PG8_LAS __attribute__((address_space(3)))
typedef unsigned short bf16_t;
typedef short bf16x8 __attribute__((ext_vector_type(8)));
typedef float f32x4 __attribute__((ext_vector_type(4)));
typedef unsigned u32x4 __attribute__((ext_vector_type(4)));
constexpr int BM = 256, BK = 64, HALF = 128, HTB = HALF * BK * 2  , STAGE_BYTES = 8 * HTB, NXCD = 8, WGM = 8;

__host__ __device__ __forceinline__ int lds_byte(int r, int c) { const int st = (r >> 4) * 2 + (c >> 5), rr = r & 15, cc = c & 31, ob = rr * 64 + cc * 2; return st * 1024 + (ob ^ (((ob >> 9) & 1) << 5)); }
__host__ __device__ __forceinline__ void stage_rc(int b, int& R, int& C) { const int st = b / 1024, sb = b % 1024, swz = sb ^ (((sb >> 9) & 1) << 5); R = (st >> 1) * 16 + swz / 64; C = (st & 1) * 32 + (swz % 64) / 2; }
__host__ __device__ __forceinline__ int perm32(int rho) { const int n = rho >> 4, i = rho & 15; return 8 * (i >> 2) + 4 * n + (i & 3); }

struct Unit { int pm, pn; };
struct Gemm { const bf16_t* A; const bf16_t* Bt; int M, N, K, lda, ldb; };

struct StaticOrder {
    int nM, nN, nwg, G, c;
    __host__ __device__ void init(int M, int N, int G_, int c_) { nM = M / BM; nN = N / BM; nwg = nM * nN; G = G_; c = c_; }
    __host__ __device__ bool next(int i, Unit& u) const {
        const long L = (long)i * G + c; if (L >= nwg) return false;
        int wgid = (int)L; { const int q = nwg / NXCD, r = nwg % NXCD, xcd = wgid % NXCD, off = wgid / NXCD; wgid = (xcd < r ? xcd * (q + 1) : r * (q + 1) + (xcd - r) * q) + off; }
        const int nig = WGM * nN, gid = wgid / nig, fm = gid * WGM, gsz = (nM - fm) < WGM ? (nM - fm) : WGM;
        u.pm = fm + ((wgid % nig) % gsz); u.pn = (wgid % nig) / gsz; return true;
    }
    __device__ __forceinline__ void a_ready(const Unit&) const {}
    __device__ __forceinline__ void done(const Unit&) const {}
};


typedef float f32x2c_t __attribute__((ext_vector_type(2))); typedef __bf16 bf16x2c_t __attribute__((ext_vector_type(2)));
__device__ __forceinline__ unsigned cvt_pk_bf16(float lo, float hi) { const f32x2c_t v = {lo, hi}; const bf16x2c_t b = __builtin_convertvector(v, bf16x2c_t); return __builtin_bit_cast(unsigned, b); }
typedef float f32x2 __attribute__((ext_vector_type(2)));
__device__ __forceinline__ f32x2 gelu_pk(f32x2 v) {
    const f32x2 av = __builtin_elementwise_abs(v), d = av * 0.2316418882f + 1.0f;
    f32x2 t; t.x = __builtin_amdgcn_rcpf(d.x); t.y = __builtin_amdgcn_rcpf(d.y);
    f32x2 q = t * 0.5307027145f + (-0.7265760135f); q = q * t + 0.7107068705f; q = q * t + (-0.142248368f); q = q * t + 0.127414796f; q = q * t;
    const f32x2 s = (v * v) * (-0.72134752044f);
    f32x2 e; e.x = __builtin_amdgcn_exp2f(s.x); e.y = __builtin_amdgcn_exp2f(s.y);
    const f32x2 m = v * (q * e), r = v - m;
    f32x2 o; o.x = v.x < 0.f ? m.x : r.x; o.y = v.y < 0.f ? m.y : r.y; return o;
}

typedef int i32x4 __attribute__((ext_vector_type(4)));
template <bool I8> __device__ __forceinline__ f32x4 mma16(bf16x8 a, bf16x8 b, f32x4 c) {
    if constexpr (I8) return __builtin_bit_cast(f32x4, __builtin_amdgcn_mfma_i32_16x16x64_i8(__builtin_bit_cast(i32x4, a), __builtin_bit_cast(i32x4, b), __builtin_bit_cast(i32x4, c), 0, 0, 0));
    else return __builtin_amdgcn_mfma_f32_16x16x32_bf16(a, b, c, 0, 0, 0);
}
template <class Epi, class Sched, bool ALIGN_EPI = false, bool SP2 = false, bool I8 = false>
__device__ __forceinline__ void gemm_phase(PG8_LAS unsigned char* lds, const Gemm g, const Sched& S, const Epi& E, const int wave_id) {
    int tid; asm volatile("v_mbcnt_lo_u32_b32 %0, -1, 0\n\tv_mbcnt_hi_u32_b32 %0, -1, %0" : "=v"(tid)); tid += wave_id * 64;
    const int wid = __builtin_amdgcn_readfirstlane(tid >> 6), lane = tid & 63, wr = wid >> 2, wc = wid & 3, fr = lane & 15, fq = lane >> 4;
    int K = g.K; asm volatile("" : "+s"(K)); const int nt = K / BK;
    unsigned voffA[2], voffB[2];
#pragma unroll
    for (int i = 0; i < 2; ++i) { int R, C; stage_rc(tid * 16 + i * 8192, R, C); const int Rb = Epi::PERM ? ((R & ~31) + perm32(R & 31)) : R;
        voffA[i] = (unsigned)(R * g.lda + C) * 2u; voffB[i] = (unsigned)(Rb * g.ldb + C) * 2u; }
    const size_t kstep = (size_t)(BK * 2);
    const size_t hstepA = (size_t)HALF * g.lda * 2, hstepB = (size_t)HALF * g.ldb * 2;
    const size_t tstepA = 2 * hstepA, tstepB = 2 * hstepB;
    const unsigned ldsw = (unsigned)wid * 1024u;
    const int aoff = lds_byte(wr * 64 + fr, fq * 8), boff = lds_byte(wc * 32 + fr, fq * 8);
#define PG8_SA(b, h) (((b) * 2 + (h)) * HTB)
#define PG8_SB(b, h) ((4 + (b) * 2 + (h)) * HTB)
#define PG8_STAGE(bufoff, gbase, voff) do { _Pragma("unroll") for (int _i = 0; _i < 2; ++_i) \
        __builtin_amdgcn_global_load_lds((const unsigned*)((const char*)(gbase) + (voff)[_i]), (PG8_LAS unsigned*)(lds + (bufoff) + ldsw + _i * 8192), 16, 0, 0); } while (0)
#define PG8_LDA(dst, b, h) do { _Pragma("unroll") for (int m = 0; m < 4; ++m) _Pragma("unroll") for (int k = 0; k < 2; ++k) dst[m][k] = *(const PG8_LAS bf16x8*)(lds + PG8_SA(b, h) + aoff + m * 2048 + k * 1024); } while (0)
#define PG8_LDB(dst, b, h) do { _Pragma("unroll") for (int n = 0; n < 2; ++n) _Pragma("unroll") for (int k = 0; k < 2; ++k) dst[n][k] = *(const PG8_LAS bf16x8*)(lds + PG8_SB(b, h) + boff + n * 2048 + k * 1024); } while (0)
#define PG8_MMA(ai, bj, At, Bt) do { __builtin_amdgcn_s_setprio(1); _Pragma("unroll") for (int m = 0; m < 4; ++m) _Pragma("unroll") for (int n = 0; n < 2; ++n) _Pragma("unroll") for (int k = 0; k < 2; ++k) \
        acc[ai][bj][m][n] = mma16<I8>(Bt[n][k], At[m][k], acc[ai][bj][m][n]); __builtin_amdgcn_s_setprio(0); } while (0)
#define PG8_WAIT_V(n) asm volatile("s_waitcnt vmcnt(" #n ")" ::: "memory")
#define PG8_WAIT_L(n) asm volatile("s_waitcnt lgkmcnt(" #n ")" ::: "memory")
#define PG8_BAR __builtin_amdgcn_s_barrier()
#define PG8_SCHED __builtin_amdgcn_sched_barrier(0)
    Unit cur, nxt; int ui = 0;
    if (!S.next(0, cur)) return;
    f32x4 acc[2][2][4][2];
#pragma unroll
    for (int a = 0; a < 2; ++a)
#pragma unroll
        for (int b = 0; b < 2; ++b)
#pragma unroll
            for (int m = 0; m < 4; ++m)
#pragma unroll
                for (int n = 0; n < 2; ++n) acc[a][b][m][n] = (f32x4){0.f, 0.f, 0.f, 0.f};
    bf16x8 At[4][2], B0[2][2], B1[2][2];
    const char* cA = (const char*)g.A + (size_t)cur.pm * tstepA; const char* cB = (const char*)g.Bt + (size_t)cur.pn * tstepB;
    S.a_ready(cur);
    if constexpr (I8) E.stage_scales(cur, 0, wid, lane);
    if constexpr (SP2) {
        PG8_STAGE(PG8_SB(0, 0), cB, voffB); PG8_STAGE(PG8_SB(0, 1), cB + hstepB, voffB); PG8_STAGE(PG8_SA(0, 0), cA, voffA); PG8_STAGE(PG8_SA(0, 1), cA + hstepA, voffA);
        if (wr == 1) PG8_BAR;
        PG8_WAIT_V(2); PG8_BAR;
        PG8_STAGE(PG8_SB(1, 0), cB + kstep, voffB); PG8_STAGE(PG8_SA(1, 0), cA + kstep, voffA); PG8_STAGE(PG8_SB(1, 1), cB + hstepB + kstep, voffB);
        PG8_WAIT_V(6); PG8_BAR;
    } else {
        PG8_STAGE(PG8_SB(0, 0), cB, voffB); PG8_STAGE(PG8_SA(0, 0), cA, voffA); PG8_STAGE(PG8_SB(0, 1), cB + hstepB, voffB); PG8_STAGE(PG8_SA(0, 1), cA + hstepA, voffA);
        if (wr == 1) PG8_BAR;
        PG8_WAIT_V(4); PG8_BAR;
        PG8_STAGE(PG8_SB(1, 0), cB + kstep, voffB); PG8_STAGE(PG8_SA(1, 0), cA + kstep, voffA); PG8_STAGE(PG8_SB(1, 1), cB + hstepB + kstep, voffB);
        PG8_WAIT_V(6); PG8_BAR;
    }
    for (;;) {
        const bool has_next = S.next(ui + 1, nxt);
        const char* nA = has_next ? (const char*)g.A + (size_t)nxt.pm * tstepA : cA; const char* nB = has_next ? (const char*)g.Bt + (size_t)nxt.pn * tstepB : cB;
        for (int t = 0; t < nt; t += 2) {
            if constexpr (Epi::KHOOK) { if (t == Epi::KH1 || t == Epi::KH2) {
                if constexpr (ALIGN_EPI) { if (wr == 0) PG8_BAR; }
                E.khook(acc, cur, t, wr, wc, fr, fq);
                if constexpr (ALIGN_EPI) { if (wr == 1) PG8_BAR; } } }
            const bool last = (t == nt - 2);
            const char* a1 = cA + (size_t)(t + 1) * kstep;
            const char* a2 = last ? nA : cA + (size_t)(t + 2) * kstep; const char* b2 = last ? nB : cB + (size_t)(t + 2) * kstep;
            const char* a3 = a2 + kstep; const char* b3 = b2 + kstep;
            if (last && has_next) S.a_ready(nxt);
            if constexpr (I8) { if (last && has_next) E.stage_scales(nxt, (ui + 1) & 1, wid, lane); }
            if constexpr (SP2) {
            PG8_LDB(B0, 0, 0); PG8_LDB(B1, 0, 1); PG8_SCHED; PG8_LDA(At, 0, 0); PG8_STAGE(PG8_SA(1, 1), a1 + hstepA, voffA);
            PG8_WAIT_V(8); PG8_WAIT_L(0); PG8_BAR; PG8_MMA(0, 0, At, B0); PG8_MMA(0, 1, At, B1); PG8_BAR; PG8_SCHED;
            PG8_LDA(At, 0, 1); PG8_STAGE(PG8_SB(0, 0), b2, voffB); PG8_STAGE(PG8_SB(0, 1), b2 + hstepB, voffB); PG8_STAGE(PG8_SA(0, 0), a2, voffA);
            PG8_WAIT_V(8); PG8_WAIT_L(0); PG8_BAR; PG8_MMA(1, 0, At, B0); PG8_MMA(1, 1, At, B1); PG8_BAR; PG8_SCHED;
            PG8_LDB(B0, 1, 0); PG8_LDB(B1, 1, 1); PG8_SCHED; PG8_LDA(At, 1, 0); PG8_STAGE(PG8_SA(0, 1), a2 + hstepA, voffA);
            PG8_WAIT_V(8); PG8_WAIT_L(0); PG8_BAR; PG8_MMA(0, 0, At, B0); PG8_MMA(0, 1, At, B1); PG8_BAR; PG8_SCHED;
            PG8_LDA(At, 1, 1); PG8_STAGE(PG8_SB(1, 0), b3, voffB); PG8_STAGE(PG8_SB(1, 1), b3 + hstepB, voffB); PG8_STAGE(PG8_SA(1, 0), a3, voffA);
            PG8_WAIT_V(8); PG8_WAIT_L(0); PG8_BAR; PG8_MMA(1, 0, At, B0); PG8_MMA(1, 1, At, B1); PG8_BAR; PG8_SCHED;
            } else {
            PG8_LDB(B0, 0, 0); PG8_SCHED; PG8_LDA(At, 0, 0); PG8_STAGE(PG8_SA(1, 1), a1 + hstepA, voffA);
            PG8_WAIT_L(8); PG8_BAR; PG8_WAIT_L(0); PG8_MMA(0, 0, At, B0); PG8_BAR; PG8_SCHED;
            PG8_LDB(B1, 0, 1); PG8_STAGE(PG8_SB(0, 0), b2, voffB);
            PG8_BAR; PG8_WAIT_L(0); PG8_MMA(0, 1, At, B1); PG8_BAR;
            PG8_LDA(At, 0, 1); PG8_STAGE(PG8_SA(0, 0), a2, voffA);
            PG8_BAR; PG8_WAIT_L(0); PG8_MMA(1, 0, At, B0); PG8_BAR; PG8_SCHED;
            PG8_STAGE(PG8_SB(0, 1), b2 + hstepB, voffB);
            PG8_WAIT_V(6); PG8_BAR; PG8_MMA(1, 1, At, B1); PG8_BAR;
            PG8_LDB(B0, 1, 0); PG8_SCHED; PG8_LDA(At, 1, 0); PG8_STAGE(PG8_SA(0, 1), a2 + hstepA, voffA);
            PG8_WAIT_L(8); PG8_BAR; PG8_WAIT_L(0); PG8_MMA(0, 0, At, B0); PG8_BAR; PG8_SCHED;
            PG8_LDB(B1, 1, 1); PG8_STAGE(PG8_SB(1, 0), b3, voffB);
            PG8_BAR; PG8_WAIT_L(0); PG8_MMA(0, 1, At, B1); PG8_BAR;
            PG8_LDA(At, 1, 1); PG8_STAGE(PG8_SA(1, 0), a3, voffA);
            PG8_BAR; PG8_WAIT_L(0); PG8_MMA(1, 0, At, B0); PG8_BAR; PG8_SCHED;
            PG8_STAGE(PG8_SB(1, 1), b3 + hstepB, voffB);
            PG8_WAIT_V(6); PG8_BAR; PG8_MMA(1, 1, At, B1); PG8_BAR;
            }
        }
        if constexpr (ALIGN_EPI) { if (wr == 0) PG8_BAR; }
        if constexpr (I8) { _Pragma("unroll") for (int a_ = 0; a_ < 2; ++a_) _Pragma("unroll") for (int b_ = 0; b_ < 2; ++b_) _Pragma("unroll") for (int m_ = 0; m_ < 4; ++m_) _Pragma("unroll") for (int n_ = 0; n_ < 2; ++n_) acc[a_][b_][m_][n_] = __builtin_convertvector(__builtin_bit_cast(i32x4, acc[a_][b_][m_][n_]), f32x4); }
        if constexpr (I8) { E.epi8(acc, cur, ui & 1, wr, wc, fr, fq); S.done(cur); }
        else if constexpr (!Epi::AFTER_DRAIN) { E(acc, cur, wr, wc, fr, fq); S.done(cur); }
        if (!has_next) break;
#pragma unroll
        for (int a = 0; a < 2; ++a)
#pragma unroll
            for (int b = 0; b < 2; ++b)
#pragma unroll
                for (int m = 0; m < 4; ++m)
#pragma unroll
                    for (int n = 0; n < 2; ++n) acc[a][b][m][n] = (f32x4){0.f, 0.f, 0.f, 0.f};
        cur = nxt; cA = nA; cB = nB; ++ui;
        if constexpr (ALIGN_EPI) { if (wr == 1) PG8_BAR; }
    }
    PG8_WAIT_V(0);
    if constexpr (!ALIGN_EPI) { if (wr == 0) PG8_BAR; }
    PG8_BAR;
    if constexpr (Epi::AFTER_DRAIN) { E.fused(acc, cur, wr, wc, fr, fq, lds, wid, lane); S.done(cur); }
#undef PG8_SA
#undef PG8_SB
#undef PG8_STAGE
#undef PG8_LDA
#undef PG8_LDB
#undef PG8_MMA
#undef PG8_WAIT_V
#undef PG8_WAIT_L
#undef PG8_BAR
#undef PG8_SCHED
}
}

#ifndef G1_EPI_DRAIN
#define G1_EPI_DRAIN 0
#endif
#ifndef G1_STORE_AUX_MIX
#define G1_STORE_AUX_MIX 2
#endif
#ifndef G1_STORE_AUX
#define G1_STORE_AUX 2
#endif
namespace pg8 {
__device__ __forceinline__ int gate_srow(int wr, int wc, int ai, int m, int bj, int fq) { return 2 * ((((wr * 4 + wc) * 2 + ai) * 4 + m) * 2 + bj) + (fq >> 1); }
__device__ __forceinline__ float ubf0(unsigned w) { return (float)(w & 0xffu); }
__device__ __forceinline__ float ubf1(unsigned w) { return (float)((w >> 8) & 0xffu); }
__device__ __forceinline__ float ubf2(unsigned w) { return (float)((w >> 16) & 0xffu); }
__device__ __forceinline__ float ubf3(unsigned w) { return (float)(w >> 24); }
__device__ __forceinline__ float ex2(float x) { return __builtin_amdgcn_exp2f(x); }
__device__ __forceinline__ float sigm_fast(float x) { return __builtin_amdgcn_rcpf(1.0f + ex2(x * -1.4426950408889634f)); }
template <int MODE = 0  > struct EpiProjT {
    static constexpr bool PERM = true, AFTER_DRAIN = false, KHOOK = false;
    bf16_t* PA; bf16_t* KVM; float* SS; float* MKSS; const float* gate_b; int pm0; int pad;
    template <int KIND, int STAT> __device__ __forceinline__ void body(const f32x4 (&acc)[2][2][4][2], const __amdgpu_buffer_rsrc_t rsrc, int row0, int col0, int ldc, float* sb, int sld, int so, const float* bias, int wc, int fq) const {
        f32x4 bv[2][2];
        if (KIND == 3) {
#pragma unroll
            for (int bj = 0; bj < 2; ++bj)
#pragma unroll
                for (int n = 0; n < 2; ++n) bv[bj][n] = *(const f32x4*)(bias + bj * HALF + 4 * n);
        }
#pragma unroll
        for (int ai = 0; ai < 2; ++ai)
#pragma unroll
            for (int m = 0; m < 4; ++m) { const int row = row0 + ai * HALF + m * 16; const unsigned rowoff = ((unsigned)row * (unsigned)ldc + (unsigned)col0) * 2u;
#pragma unroll
                for (int bj = 0; bj < 2; ++bj) { f32x4 v0 = acc[ai][bj][m][0], v1 = acc[ai][bj][m][1];
                    if (KIND == 1) { f32x2 a = gelu_pk((f32x2){v0[0], v0[1]}), b = gelu_pk((f32x2){v0[2], v0[3]}), c = gelu_pk((f32x2){v1[0], v1[1]}), d = gelu_pk((f32x2){v1[2], v1[3]});
                        v0 = (f32x4){a.x, a.y, b.x, b.y}; v1 = (f32x4){c.x, c.y, d.x, d.y}; }
                    else if (KIND == 2) {
#pragma unroll
                        for (int j = 0; j < 4; ++j) { v0[j] = v0[j] * sigm_fast(v0[j]); v1[j] = v1[j] * sigm_fast(v1[j]); } }
                    else if (KIND == 3) { v0 = v0 + bv[bj][0]; v1 = v1 + bv[bj][1];
#pragma unroll
                        for (int j = 0; j < 4; ++j) { v0[j] = sigm_fast(v0[j]); v1[j] = sigm_fast(v1[j]); } }
                    if (STAT) {
                        float s = ((v0[0] + v0[1]) + (v0[2] + v0[3])) + ((v1[0] + v1[1]) + (v1[2] + v1[3]));
                        float q = ((v0[0] * v0[0] + v0[1] * v0[1]) + (v0[2] * v0[2] + v0[3] * v0[3])) + ((v1[0] * v1[0] + v1[1] * v1[1]) + (v1[2] * v1[2] + v1[3] * v1[3]));
                        if (STAT == 2) s = sum_x16_x32(s);
                        q = sum_x16_x32(q);
                        if (fq == 0) { float* sp = sb + (size_t)row * sld + so; const int blk = 4 * bj + wc;
                            if (STAT == 2) { sp[2 * blk] = s; sp[2 * blk + 1] = q; } else sp[blk] = q; }
                    }
                    u32x4 w; w.x = cvt_pk_bf16(v0[0], v0[1]); w.y = cvt_pk_bf16(v0[2], v0[3]); w.z = cvt_pk_bf16(v1[0], v1[1]); w.w = cvt_pk_bf16(v1[2], v1[3]);
                    if (MODE == 2) asm volatile("" :: "v"(w)); else __builtin_amdgcn_raw_buffer_store_b128(w, rsrc, (int)(rowoff + bj * HALF * 2), 0, KIND == 3 ? G1_STORE_AUX : G1_STORE_AUX_MIX); } }
    }
    __device__ __forceinline__ void uz_body(const f32x4 (&acc)[2][2][4][2], const __amdgpu_buffer_rsrc_t rsrc, int row0, int ucol0) const {
#pragma unroll
        for (int ai = 0; ai < 2; ++ai)
#pragma unroll
            for (int m = 0; m < 4; ++m) { const int row = row0 + ai * HALF + m * 16;
                f32x4 u0 = acc[ai][0][m][0], u1 = acc[ai][0][m][1]; const f32x4 z0 = acc[ai][1][m][0], z1 = acc[ai][1][m][1];
                { f32x2 a = gelu_pk((f32x2){u0[0], u0[1]}), b = gelu_pk((f32x2){u0[2], u0[3]}), c = gelu_pk((f32x2){u1[0], u1[1]}), d = gelu_pk((f32x2){u1[2], u1[3]});
                  u0 = (f32x4){a.x, a.y, b.x, b.y}; u1 = (f32x4){c.x, c.y, d.x, d.y}; }
#pragma unroll
                for (int j = 0; j < 4; ++j) { u0[j] *= z0[j] * sigm_fast(z0[j]); u1[j] *= z1[j] * sigm_fast(z1[j]); }
                u32x4 w; w.x = cvt_pk_bf16(u0[0], u0[1]); w.y = cvt_pk_bf16(u0[2], u0[3]); w.z = cvt_pk_bf16(u1[0], u1[1]); w.w = cvt_pk_bf16(u1[2], u1[3]);
                if (MODE == 2) asm volatile("" :: "v"(w)); else __builtin_amdgcn_raw_buffer_store_b128(w, rsrc, (int)((unsigned)row * (unsigned)PA_ROWB + (unsigned)(2 * (C_AU + ucol0))), 0, G1_STORE_AUX_MIX); }
    }
    __device__ __forceinline__ void gate_body(const f32x4 (&acc)[2][2][4][2], const __amdgpu_buffer_rsrc_t rsrc, int row0, int gcol0, const float* bias) const {
        f32x4 bv[2][2];
#pragma unroll
        for (int bj = 0; bj < 2; ++bj)
#pragma unroll
            for (int n = 0; n < 2; ++n) bv[bj][n] = *(const f32x4*)(bias + 8 * bj + 4 * n);
#pragma unroll
        for (int ai = 0; ai < 2; ++ai)
#pragma unroll
            for (int m = 0; m < 4; ++m) { const int row = row0 + ai * HALF + m * 16; u32x4 w;
#pragma unroll
                for (int bj = 0; bj < 2; ++bj)
#pragma unroll
                    for (int n = 0; n < 2; ++n) { const f32x4 v = acc[ai][bj][m][n] + bv[bj][n]; unsigned d = 0u;
#pragma unroll
                        for (int j = 0; j < 4; ++j) d |= (unsigned)(fmaxf(sigm_fast(v[j]) * 255.0f, 1.0f) + 0.5f) << (8 * j);
                        w[2 * bj + n] = d; }
                if (MODE == 2) asm volatile("" :: "v"(w)); else __builtin_amdgcn_raw_buffer_store_b128(w, rsrc, (int)((unsigned)row * (unsigned)PA_ROWB + (unsigned)(PA_GOFF + gcol0)), 0, G1_STORE_AUX); }
    }
    __device__ __forceinline__ void operator()(const f32x4 (&acc)[2][2][4][2], const Unit& u, int wr, int wc, int fr, int fq) const {
        const bool kv = u.pn >= 35; const int pn = kv ? u.pn - 35 : u.pn;
        const int rowt = kv ? (u.pm - 256) * BM : (u.pm - pm0) * BM;
        bf16_t* base = kv ? KVM : PA; const int ldc = kv ? 1024 : PAP;
        const __amdgpu_buffer_rsrc_t rsrc = __builtin_amdgcn_make_buffer_rsrc(base, 0, kv ? (int)((size_t)MMEM * 1024 * 2) : (int)((size_t)HB_ROWS * PA_ROWB), 0x00020000);
        const int row0 = rowt + wr * 64 + fr, col0 = pn * BM + wc * 32 + 8 * fq;
        if (MODE == 1) { body<0, 0>(acc, rsrc, row0, col0, ldc, SS, SS_W, 0, gate_b, wc, fq); return; }
        if (kv) { if (pn < 2) body<0, 1>(acc, rsrc, row0, col0, ldc, MKSS, 16, 8 * pn, gate_b, wc, fq); else body<0, 0>(acc, rsrc, row0, col0, ldc, SS, SS_W, 0, gate_b, wc, fq); }
        else if (pn < 3) uz_body(acc, rsrc, row0, 128 * pn + 32 * wc + 8 * fq);
        else if (pn < 6) body<1, 2>(acc, rsrc, row0, col0, ldc, SS, SS_W, 16 * (pn - 3), gate_b, wc, fq);
        else if (pn < 9) uz_body(acc, rsrc, row0, 128 * (pn - 3) + 32 * wc + 8 * fq);
        else if (pn < 12) body<0, 1>(acc, rsrc, row0, col0, ldc, SS, SS_W, 48 + 8 * (pn - 9), gate_b, wc, fq);
        else if (pn < 15) body<0, 1>(acc, rsrc, row0, col0, ldc, SS, SS_W, 72 + 8 * (pn - 12), gate_b, wc, fq);
        else if (pn < 18) body<0, 0>(acc, rsrc, row0, col0, ldc, SS, SS_W, 0, gate_b, wc, fq);
        else if (pn < 19) body<2, 0>(acc, rsrc, row0, col0, ldc, SS, SS_W, 0, gate_b, wc, fq);
        else if (pn < 21) body<0, 1>(acc, rsrc, row0, col0, ldc, SS, SS_W, 96 + 8 * (pn - 19), gate_b, wc, fq);
        else if (pn < 23) body<2, 0>(acc, rsrc, row0, col0, ldc, SS, SS_W, 0, gate_b, wc, fq);
        else { const int gc = (pn - 23) * BM + 64 * wc + 16 * fq; gate_body(acc, rsrc, row0, gc, gate_b + gc); }
#if G1_EPI_DRAIN
        asm volatile("s_waitcnt vmcnt(0)" ::: "memory");
#endif
    }
};
typedef EpiProjT<0> EpiProj;
template <bool HOOKS = true, bool EPI = true> struct EpiG2catT {
    static constexpr bool PERM = true, AFTER_DRAIN = false, KHOOK = HOOKS; static constexpr int KH1 = 12, KH2 = 16;
    const bf16_t* PA; bf16_t* MRG;
    __device__ __forceinline__ void khook(f32x4 (&acc)[2][2][4][2], const Unit& u, int t, int wr, int wc, int fr, int fq) const {
        typedef unsigned u32x2v __attribute__((ext_vector_type(2)));
        const int ga = t == KH1 ? 0 : 1;
        const __amdgpu_buffer_rsrc_t grs = __builtin_amdgcn_make_buffer_rsrc((void*)PA, 0, (int)((size_t)HB_ROWS * PA_ROWB), 0x00020000);
        const int gvo = (u.pm * BM + gate_srow(wr, wc, 0, 0, 0, fq)) * PA_ROWB + PA_GOFF + ga * DM + u.pn * BM + 16 * fr + 8 * (fq & 1);
        u32x2v ag[2][4][2], bg[2][4][2];
#pragma unroll
        for (int ai = 0; ai < 2; ++ai)
#pragma unroll
            for (int m = 0; m < 4; ++m)
#pragma unroll
                for (int bj = 0; bj < 2; ++bj) { const int so = gate_srow(0, 0, ai, m, bj, 0) * PA_ROWB; ag[ai][m][bj] = __builtin_bit_cast(u32x2v, __builtin_amdgcn_raw_buffer_load_b64(grs, gvo, so, 0)); bg[ai][m][bj] = __builtin_bit_cast(u32x2v, __builtin_amdgcn_raw_buffer_load_b64(grs, gvo + DM, so, 0)); }
        __builtin_amdgcn_sched_barrier(0);
#define G2_R(A, Bv, K) (ubf##K(A) * __builtin_amdgcn_rcpf(ubf##K(Bv)))
#pragma unroll
        for (int ai = 0; ai < 2; ++ai)
#pragma unroll
            for (int m = 0; m < 4; ++m)
#pragma unroll
                for (int bj = 0; bj < 2; ++bj) { const u32x2v a = ag[ai][m][bj], b = bg[ai][m][bj]; f32x4 r0, r1;
                    r0[0] = G2_R(a.x, b.x, 0); r0[1] = G2_R(a.x, b.x, 1); r0[2] = G2_R(a.x, b.x, 2); r0[3] = G2_R(a.x, b.x, 3);
                    r1[0] = G2_R(a.y, b.y, 0); r1[1] = G2_R(a.y, b.y, 1); r1[2] = G2_R(a.y, b.y, 2); r1[3] = G2_R(a.y, b.y, 3);
                    acc[ai][bj][m][0] *= r0; acc[ai][bj][m][1] *= r1; }
#undef G2_R
    }
    __device__ __forceinline__ void operator()(const f32x4 (&acc)[2][2][4][2], const Unit& u, int wr, int wc, int fr, int fq) const {
        typedef unsigned u32x2v __attribute__((ext_vector_type(2)));
        if (!EPI) { _Pragma("unroll") for (int ai = 0; ai < 2; ++ai) _Pragma("unroll") for (int bj = 0; bj < 2; ++bj) _Pragma("unroll") for (int m = 0; m < 4; ++m) asm volatile("" :: "v"(acc[ai][bj][m][0]), "v"(acc[ai][bj][m][1])); return; }
        const int row0 = u.pm * BM + wr * 64 + fr, col0 = u.pn * BM + wc * 32 + 8 * fq;
        const __amdgpu_buffer_rsrc_t grs = __builtin_amdgcn_make_buffer_rsrc((void*)PA, 0, (int)((size_t)HB_ROWS * PA_ROWB), 0x00020000);
        const int gvo = (u.pm * BM + gate_srow(wr, wc, 0, 0, 0, fq)) * PA_ROWB + PA_GOFF + 2 * DM + u.pn * BM + 16 * fr + 8 * (fq & 1);
        u32x2v gv[2][4][2];
#pragma unroll
        for (int ai = 0; ai < 2; ++ai)
#pragma unroll
            for (int m = 0; m < 4; ++m)
#pragma unroll
                for (int bj = 0; bj < 2; ++bj) gv[ai][m][bj] = __builtin_bit_cast(u32x2v, __builtin_amdgcn_raw_buffer_load_b64(grs, gvo, gate_srow(0, 0, ai, m, bj, 0) * PA_ROWB, 0));
        __builtin_amdgcn_sched_barrier(0);
        const float q = 1.0f / 255.0f;
#pragma unroll
        for (int ai = 0; ai < 2; ++ai)
#pragma unroll
            for (int m = 0; m < 4; ++m) { bf16_t* mp = MRG + (size_t)(row0 + ai * HALF + m * 16) * PMR + col0;
#pragma unroll
                for (int bj = 0; bj < 2; ++bj) { const u32x2v g = gv[ai][m][bj]; const f32x4 v0 = acc[ai][bj][m][0] * q, v1 = acc[ai][bj][m][1] * q; u32x4 w;
                    w.x = cvt_pk_bf16(v0[0] * ubf0(g.x), v0[1] * ubf1(g.x)); w.y = cvt_pk_bf16(v0[2] * ubf2(g.x), v0[3] * ubf3(g.x));
                    w.z = cvt_pk_bf16(v1[0] * ubf0(g.y), v1[1] * ubf1(g.y)); w.w = cvt_pk_bf16(v1[2] * ubf2(g.y), v1[3] * ubf3(g.y));
                    *(u32x4*)(mp + bj * HALF) = w; } }
    }
};
typedef EpiG2catT<true, true> EpiG2cat;
struct EpiG3 {
    static constexpr bool PERM = false, AFTER_DRAIN = false, KHOOK = false;
    const float* x; float* out;
    static __device__ __forceinline__ f32x4 pairx(f32x4 keep, f32x4 other, bool take) { f32x4 r;
#pragma unroll
        for (int j = 0; j < 4; ++j) { const float kj = keep[j], oj = other[j]; const float t = __builtin_bit_cast(float, __builtin_amdgcn_update_dpp(0, __builtin_bit_cast(int, oj), 0xB1, 0xf, 0xf, true)); r[j] = take ? t : kj; }
        return r; }
    __device__ __forceinline__ void operator()(const f32x4 (&acc)[2][2][4][2], const Unit& u, int wr, int wc, int fr, int fq) const {
        __builtin_amdgcn_s_waitcnt(0xC07F);
        const bool odd = fr & 1;
        const int row0 = u.pm * BM + wr * 64 + fr, col0 = u.pn * BM + wc * 32 + 4 * fq;
        const size_t lbase = (size_t)(row0 & ~1) * DM + col0 + (odd ? 16 : 0);
        f32x4 xa[2][2][2], xb[2][2][2];
#define G3_LOAD(B) do { _Pragma("unroll") for (int mm = 0; mm < 2; ++mm) { const size_t off_ = lbase + (size_t)(((B) >> 1) * HALF + (2 * ((B) & 1) + mm) * 16) * DM; \
            _Pragma("unroll") for (int bj = 0; bj < 2; ++bj) { xa[(B) & 1][mm][bj] = __builtin_nontemporal_load((const f32x4*)(x + off_ + bj * HALF)); xb[(B) & 1][mm][bj] = __builtin_nontemporal_load((const f32x4*)(x + off_ + DM + bj * HALF)); } } } while (0)
#define G3_STORE(B) do { _Pragma("unroll") for (int mm = 0; mm < 2; ++mm) { const size_t off_ = lbase + (size_t)(((B) >> 1) * HALF + (2 * ((B) & 1) + mm) * 16) * DM; \
            _Pragma("unroll") for (int bj = 0; bj < 2; ++bj) { const f32x4 c0_ = acc[(B) >> 1][bj][2 * ((B) & 1) + mm][0], c1_ = acc[(B) >> 1][bj][2 * ((B) & 1) + mm][1]; \
                const f32x4 ca = pairx(c0_, c1_, odd), cb = pairx(c1_, c0_, !odd);                    \
                __builtin_nontemporal_store(xa[(B) & 1][mm][bj] + ca, (f32x4*)(out + off_ + bj * HALF)); \
                __builtin_nontemporal_store(xb[(B) & 1][mm][bj] + cb, (f32x4*)(out + off_ + DM + bj * HALF)); } } } while (0)
        G3_LOAD(0); G3_LOAD(1); __builtin_amdgcn_sched_barrier(0); G3_STORE(0); G3_LOAD(2); __builtin_amdgcn_sched_barrier(0); G3_STORE(1); G3_LOAD(3); __builtin_amdgcn_sched_barrier(0); G3_STORE(2); G3_STORE(3);
#undef G3_LOAD
#undef G3_STORE
    }
};
struct EpiNull {
    static constexpr bool PERM = true, AFTER_DRAIN = false, KHOOK = false;
    __device__ __forceinline__ void operator()(const f32x4 (&acc)[2][2][4][2], const Unit& u, int wr, int wc, int fr, int fq) const {
#pragma unroll
        for (int ai = 0; ai < 2; ++ai)
#pragma unroll
            for (int bj = 0; bj < 2; ++bj)
#pragma unroll
                for (int m = 0; m < 4; ++m) asm volatile("" :: "v"(acc[ai][bj][m][0]), "v"(acc[ai][bj][m][1]));
    }
};
struct OrderG1 {
    StaticOrder so; int pm0, nkv, pn0;
    __device__ void init(int hb, int G, int c, int pn0_, int ntiles, bool with_kv) { so.init(HB_ROWS, ntiles * BM, G, c); pm0 = hb * (HB_ROWS / BM); pn0 = pn0_; nkv = with_kv ? (MMEM / BM) * 4 : 0; }
    __device__ bool next(int i, Unit& u) const {
        if (so.next(i, u)) { u.pm += pm0; u.pn += pn0; return true; }
        const long j = (long)i * so.G + so.c - so.nwg; if (j < 0 || j >= nkv) return false;
        u.pm = 256 + (int)(j >> 2); u.pn = 35 + (int)(j & 3); return true;
    }
    __device__ __forceinline__ void a_ready(const Unit&) const {}
    __device__ __forceinline__ void done(const Unit&) const {}
};
struct OrderBF {
    StaticOrder so; int pm0, nkv;
    __device__ void init(int hb, int G, int c) { so.init(HB_ROWS, 9 * BM, G, c); pm0 = hb * (HB_ROWS / BM); nkv = hb == 0 ? (MMEM / BM) * 4 : 0; }
    __device__ bool next(int i, Unit& u) const {
        if (so.next(i, u)) { u.pm += pm0; const int t = u.pn; u.pn = t < 3 ? t : t < 6 ? t + 3 : t == 6 ? 18 : t + 14; return true; }
        const long j = (long)i * so.G + so.c - so.nwg; if (j < 0 || j >= nkv) return false;
        u.pm = 256 + (int)(j >> 2); u.pn = 35 + (int)(j & 3); return true;
    }
    __device__ __forceinline__ void a_ready(const Unit&) const {}
    __device__ __forceinline__ void done(const Unit&) const {}
};
struct OrderG8 {
    StaticOrder so; int pm0, bal;
    __device__ void init(int hb, int G, int c) { so.init(HB_ROWS, 26 * BM, G, c); pm0 = hb * (HB_ROWS / BM); bal = (hb == 1 && G == 256) ? 1 : 0; }
    __device__ bool next(int i, Unit& u) const {
        bool ok;
        if (!bal) ok = so.next(i, u);
        else { if (i < 12) ok = so.next(i, u); else { if (so.c < 128 || i > 13) return false; StaticOrder t = so; t.c = 2 * (so.c - 128) + (i - 12); ok = t.next(12, u); } }
        if (ok) u.pm += pm0; return ok;
    }
    __device__ __forceinline__ void a_ready(const Unit&) const {}
    __device__ __forceinline__ void done(const Unit&) const {}
};
template <int MODE8 = 0> struct EpiProj8T {
    static constexpr bool PERM = true, AFTER_DRAIN = false, KHOOK = false;
    EpiProjT<MODE8> base; const float* RS; const float* CS; PG8_LAS unsigned char* sl;
    __device__ __forceinline__ void gate8_body(const f32x4 (&acc)[2][2][4][2], const __amdgpu_buffer_rsrc_t rsrc, int trow, int t8, int wr, int wc, int fr, int fq, const PG8_LAS float* bias) const {
        constexpr float L2E = 1.4426950408889634f, C = 254.0f / 255.0f;
        f32x2 cb[2][2][2];
#pragma unroll
        for (int bj = 0; bj < 2; ++bj)
#pragma unroll
            for (int n = 0; n < 2; ++n) { const f32x4 b = *(const PG8_LAS f32x4*)(bias + 8 * bj + 4 * n); cb[bj][n][0] = (f32x2){b[0], b[1]} * L2E; cb[bj][n][1] = (f32x2){b[2], b[3]} * L2E; }
#pragma unroll
        for (int ai = 0; ai < 2; ++ai)
#pragma unroll
            for (int m = 0; m < 4; ++m) { const int row = trow + gate_srow(wr, 2 * (wc & 1) + (fq >> 1), ai, m, wc >> 1, 2 * (fq & 1)); u32x4 w;
#pragma unroll
                for (int bj = 0; bj < 2; ++bj)
#pragma unroll
                    for (int n = 0; n < 2; ++n) { const f32x4 v = acc[ai][bj][m][n]; unsigned p[2];
#pragma unroll
                        for (int h = 0; h < 2; ++h) { const f32x2 x = {v[2 * h], v[2 * h + 1]}; const f32x2 e = x * L2E + cb[bj][n][h];
                            f32x2 ex; ex.x = ex2(e.x); ex.y = ex2(e.y); const f32x2 den = ex * C + C;
                            f32x2 sc; sc.x = __builtin_amdgcn_fmed3f(__builtin_amdgcn_rcpf(den.x), 0.0f, 1.0f); sc.y = __builtin_amdgcn_fmed3f(__builtin_amdgcn_rcpf(den.y), 0.0f, 1.0f);
                            const f32x2 q = sc * (-254.0f) + 8388863.0f;
                            const float qx = q.x, qy = q.y;
                            p[h] = __builtin_amdgcn_perm(__builtin_bit_cast(unsigned, qy), __builtin_bit_cast(unsigned, qx), 0x0c0c0400u); }
                        w[2 * bj + n] = __builtin_amdgcn_perm(p[1], p[0], 0x05040100u); }
                if (MODE8 == 2) asm volatile("" :: "v"(w)); else __builtin_amdgcn_raw_buffer_store_b128(w, rsrc, (int)((unsigned)row * (unsigned)PA_ROWB + (unsigned)(PA_GOFF + t8 * BM + 16 * fr)), 0, G1_STORE_AUX); }
    }
    __device__ __forceinline__ void stage_scales(const Unit& u, int par, int wid, int lane) const {
        PG8_LAS unsigned char* d = sl + par * 3072;
        if (wid < 4) { __builtin_amdgcn_global_load_lds((const unsigned*)(CS + u.pn * BM + 64 * wid + lane), (PG8_LAS unsigned*)(d + 256 * wid), 4, 0, 0);
            if (u.pn < 12) __builtin_amdgcn_global_load_lds((const unsigned*)(base.gate_b + u.pn * BM + 64 * wid + lane), (PG8_LAS unsigned*)(d + 2048 + 256 * wid), 4, 0, 0); }
        else __builtin_amdgcn_global_load_lds((const unsigned*)(RS + u.pm * BM + 64 * (wid - 4) + lane), (PG8_LAS unsigned*)(d + 1024 + 256 * (wid - 4)), 4, 0, 0);
    }
    __device__ __forceinline__ void epi8(f32x4 (&acc)[2][2][4][2], const Unit& u, int par, int wr, int wc, int fr, int fq) const {
        const PG8_LAS float* d = (const PG8_LAS float*)(sl + par * 3072); const bool gate = u.pn < 12;
        const PG8_LAS float* cp = d + (gate ? 64 * wc + 16 * fq : 32 * wc + 8 * fq);
        f32x4 cs[2][2]; float rs[2][4];
#pragma unroll
        for (int bj = 0; bj < 2; ++bj)
#pragma unroll
            for (int n = 0; n < 2; ++n) cs[bj][n] = *(const PG8_LAS f32x4*)(cp + (gate ? 8 * bj : HALF * bj) + 4 * n);
#pragma unroll
        for (int ai = 0; ai < 2; ++ai)
#pragma unroll
            for (int m = 0; m < 4; ++m) rs[ai][m] = d[256 + wr * 64 + fr + ai * HALF + m * 16];
#pragma unroll
        for (int ai = 0; ai < 2; ++ai)
#pragma unroll
            for (int m = 0; m < 4; ++m)
#pragma unroll
                for (int bj = 0; bj < 2; ++bj)
#pragma unroll
                    for (int n = 0; n < 2; ++n) acc[ai][bj][m][n] *= cs[bj][n] * rs[ai][m];
        if (gate) {
            const __amdgpu_buffer_rsrc_t rsrc = __builtin_amdgcn_make_buffer_rsrc(base.PA, 0, (int)((size_t)HB_ROWS * PA_ROWB), 0x00020000);
            gate8_body(acc, rsrc, (u.pm - base.pm0) * BM, u.pn, wr, wc, fr, fq, d + 512 + 64 * wc + 16 * fq); return; }
        Unit v = u; v.pn = i8tile_pn(u.pn); base(acc, v, wr, wc, fr, fq);
    }
    __device__ __forceinline__ void operator()(const f32x4 (&acc)[2][2][4][2], const Unit& u, int wr, int wc, int fr, int fq) const {}
};
typedef EpiProj8T<0> EpiProj8;
}

#define GAS __attribute__((address_space(1)))
#define LAS __attribute__((address_space(3)))
typedef unsigned short bf16;
typedef unsigned v4u __attribute__((ext_vector_type(4)));
typedef float f32x4 __attribute__((ext_vector_type(4)));
typedef short bf16x8 __attribute__((ext_vector_type(8)));
typedef GAS unsigned gu32;
typedef GAS unsigned long long gu64;
#define RLX_AGENT __ATOMIC_RELAXED, __HIP_MEMORY_SCOPE_AGENT
#define LDS_WAIT() asm volatile("s_waitcnt lgkmcnt(0)" ::: "memory")
#define VM_WAIT() asm volatile("s_waitcnt vmcnt(0)" ::: "memory")
__device__ __forceinline__ unsigned long long rt() { return __builtin_amdgcn_s_memrealtime(); }
__device__ __forceinline__ unsigned f2bf(float f) { unsigned u = __builtin_bit_cast(unsigned, f); return (u + 0x7fffu + ((u >> 16) & 1u)) >> 16; }
__device__ __forceinline__ unsigned pk2(float lo, float hi) { return f2bf(lo) | (f2bf(hi) << 16); }

__device__ __forceinline__ int hw_lane() { int l; asm volatile("v_mbcnt_lo_u32_b32 %0, -1, 0\n\tv_mbcnt_hi_u32_b32 %0, -1, %0" : "=v"(l)); return l; }
__device__ __forceinline__ bool hw_thread0(int wave) { return wave == 0 && hw_lane() == 0; }
#define XB_TMO      128
#define XB_XCNT(j)  (256  + 64 * (j))
#define XB_XSUB(j)  (1280 + 64 * (j))
#define XB_XGEN(j)  (2304 + 64 * (j))
#define XB_TOP      3328
#define XB_TOPGEN   3392
#define XCD_BAR_WORDS 3456
#define XB_SPIN_CAP (1u << 18)

__device__ __forceinline__ unsigned xb_ld(unsigned* p)              { return __hip_atomic_load(p, __ATOMIC_RELAXED, __HIP_MEMORY_SCOPE_AGENT); }
__device__ __forceinline__ unsigned xb_add(unsigned* p, unsigned v) { return __hip_atomic_fetch_add(p, v, __ATOMIC_RELAXED, __HIP_MEMORY_SCOPE_AGENT); }
__device__ __forceinline__ unsigned xb_xcc_id() { return (unsigned)__builtin_amdgcn_s_getreg((3 << 11) | 20) & 0xFu; }
#define XB_SPIN(cond, bar) do { unsigned _sp = 0; while (cond) { __builtin_amdgcn_s_sleep(1); \
    if ((++_sp & 255u) == 0u) { if (xb_ld(&(bar)[XB_TMO])) break; if (_sp > XB_SPIN_CAP) { atomicAdd(&(bar)[XB_TMO], 1u); break; } } } } while (0)

struct XcdBarrier {
    unsigned* bar; unsigned x; int wave;
    volatile LAS unsigned* st;
};

__device__ __forceinline__ XcdBarrier xcd_barrier_post(unsigned* bar, volatile LAS unsigned* st, int wave) {
    XcdBarrier b; b.bar = bar; b.x = xb_xcc_id(); b.st = st; b.wave = wave;
    if (hw_thread0(wave)) (void)xb_add(&bar[XB_XCNT(b.x)], 1u);
    return b;
}
__device__ __forceinline__ void xcd_barrier_complete(unsigned* bar, unsigned x, unsigned& nloc, unsigned& nx) {
    const unsigned G = gridDim.x * gridDim.y * gridDim.z;
    unsigned sum, cnt, mine, sp = 0u;
    for (;;) {
        sum = 0u; cnt = 0u; mine = 0u;
#pragma unroll
        for (unsigned j = 0; j < 16; ++j) { const unsigned c = xb_ld(&bar[XB_XCNT(j)]); sum += c; cnt += (c > 0u) ? 1u : 0u; mine = (j == x) ? c : mine; }
        if (sum == G) break;
        __builtin_amdgcn_s_sleep(1);
        if ((++sp & 255u) == 0u) { if (xb_ld(&bar[XB_TMO])) break; if (sp > XB_SPIN_CAP) { atomicAdd(&bar[XB_TMO], 1u); break; } }
    }
    nloc = mine > 0u ? mine : 1u; nx = cnt > 0u ? cnt : 1u;
}

__device__ __forceinline__ void xcd_barrier(const XcdBarrier& b) {
    asm volatile("s_waitcnt vmcnt(0)" ::: "memory");
    __syncthreads();
    if (hw_thread0(b.wave)) {
        unsigned* bar = b.bar;
        __builtin_amdgcn_s_waitcnt(0);
        unsigned nloc = b.st[0], nx = b.st[1];
        if (nloc == 0u) { xcd_barrier_complete(bar, b.x, nloc, nx); b.st[0] = nloc; b.st[1] = nx; }
        const unsigned old = xb_add(&bar[XB_XSUB(b.x)], 1u);
        const unsigned gen = old / nloc;
        if (old + 1u == (gen + 1u) * nloc) {
            __builtin_amdgcn_fence(__ATOMIC_RELEASE, "agent");
            asm volatile("s_waitcnt vmcnt(0)" ::: "memory");
            const unsigned og = xb_add(&bar[XB_TOP], 1u);
            const unsigned tg = og / nx;
            if (og + 1u == (tg + 1u) * nx) xb_add(&bar[XB_TOPGEN], 1u);
            else XB_SPIN(xb_ld(&bar[XB_TOPGEN]) == tg, bar);
            __builtin_amdgcn_fence(__ATOMIC_ACQUIRE, "agent");
            xb_add(&bar[XB_XGEN(b.x)], 1u);
            asm volatile("s_waitcnt vmcnt(0)" ::: "memory");
        } else {
            XB_SPIN(xb_ld(&bar[XB_XGEN(b.x)]) == gen, bar);
            __builtin_amdgcn_fence(__ATOMIC_ACQUIRE, "agent");
            asm volatile("s_waitcnt vmcnt(0)" ::: "memory");
        }
    }
    __syncthreads();
}

__device__ __forceinline__ float wave_sum(float v) {
#pragma unroll
    for (int o = 1; o < 64; o <<= 1) v += __shfl_xor(v, o);
    return v;
}

constexpr int RING_OFF = 0, RING_BYTES = 131072;
constexpr int LDSCTL_OFF = RING_BYTES, MISC_OFF = LDSCTL_OFF + 320;
constexpr int SCALE_OFF = RING_BYTES + 8192;
constexpr int LDS_BYTES = 147456;
constexpr int NWAVES = 8, NTHR = NWAVES * 64;
constexpr int WSCR_OFF = 132096;

__device__ __forceinline__ float bf2f(bf16 h) { return __builtin_bit_cast(float, (unsigned)h << 16); }
__device__ __forceinline__ float sigm_f(float x) { return 1.f / (1.f + __expf(-x)); }
__device__ __forceinline__ int t5_bucket(int d) {
    if (d < 16) return d;
    int b = 16;
    b += d >= 22; b += d >= 30; b += d >= 40; b += d >= 54; b += d >= 73; b += d >= 99; b += d >= 134; b += d >= 182; b += d >= 246; b += d >= 332; b += d >= 450; b += d >= 609; b += d >= 825; b += d >= 1117; b += d >= 1513;
    return b;
}

struct Ctx {
    const float *x, *mem, *norm_w, *w_in, *gate_b, *lnw, *lnb, *sp_w, *sp_b, *bqw, *bkw, *rel_bias, *mem_norm_w, *m_w_kv, *mqw, *mkw, *proj_a, *proj_b, *proj_m, *w_out;
    float* out;
    bf16 *WIN, *PCAT, *WOUT, *WSP, *XN, *PA, *KVM, *OG, *YC, *MRG; float *BIAS, *BIASX, *SS, *MKSS, *LSE, *LNST, *CS, *RS; unsigned char *XN8, *W8; unsigned* cmax;
    LAS unsigned char* lds; int tid, lane, wave, G, gtid, T, gwave, NW, xgwave;
};

__device__ __forceinline__ void p0_transpose_item(const float* W, int N, bf16* WT, int ldt, int row_off, int koff, LAS float* scr, int item, int lane_unused, bool gperm = false, unsigned* cmax = nullptr) {
    const int lane = hw_lane();
    const int nblk = N / 32, kb = item / nblk, nb = item % nblk, k0 = 64 * kb, n0 = 32 * nb;
    float cam = 0.f;
#pragma unroll 8
    for (int i = 0; i < 32; ++i) { const int kk = 2 * i + (lane >> 5); const float wv = W[(size_t)(k0 + kk) * N + n0 + (lane & 31)]; scr[kk * 33 + (lane & 31)] = wv; cam = fmaxf(cam, fabsf(wv)); }
    if (cmax && i8col(n0) >= 0) { cam = fmaxf(cam, __shfl_xor(cam, 32)); if (lane < 32) atomicMax(cmax + i8col(n0) + lane, __float_as_uint(cam)); }
    LDS_WAIT(); asm volatile("" ::: "memory");
    const int c = lane & 7;
#pragma unroll
    for (int j = 0; j < 4; ++j) { const int n = (lane >> 3) + 8 * j; const LAS float* s = scr + (8 * c) * 33 + n;
        v4u o; o.x = pk2(s[0 * 33], s[1 * 33]); o.y = pk2(s[2 * 33], s[3 * 33]); o.z = pk2(s[4 * 33], s[5 * 33]); o.w = pk2(s[6 * 33], s[7 * 33]);
        int nn = n0 + n;
        if (gperm) {
            if (nn >= C_G) nn = (nn & ~255) + 128 * ((nn >> 3) & 1) + 32 * ((nn >> 6) & 3) + 8 * ((nn >> 4) & 3) + (nn & 7);
            else if (nn < C_AV) { const int T = nn >> 7; nn = 256 * (T < 3 ? T : T + 3) + (nn & 127); }
            else if (nn >= C_AZ && nn < C_BQ) { const int c = nn - C_AZ, T = c >> 7; nn = 256 * (T < 3 ? T : T + 3) + 128 + (c & 127); }
        }
        *(GAS v4u*)(WT + (size_t)(row_off + nn) * ldt + koff + k0 + 8 * c) = o; }
    LDS_WAIT(); asm volatile("" ::: "memory");
}
template <int NR> __device__ __forceinline__ void rms_rows_to_bf16(const float* src, const float* w, bf16* dst, size_t m0, size_t stride, int lane, unsigned char* q8 = nullptr, float* rsc = nullptr) {
    f32x4 v[NR][4]; float s[NR];
#pragma unroll
    for (int r = 0; r < NR; ++r) { const GAS f32x4* xr = (const GAS f32x4*)(src + (m0 + r * stride) * DM) + lane;
#pragma unroll
        for (int j = 0; j < 4; ++j) v[r][j] = __builtin_nontemporal_load(xr + 64 * j); }
    f32x4 ww[4];
#pragma unroll
    for (int j = 0; j < 4; ++j) ww[j] = ((const GAS f32x4*)w + lane)[64 * j];
#pragma unroll
    for (int r = 0; r < NR; ++r) { float a = 0.f;
#pragma unroll
        for (int j = 0; j < 4; ++j) a += (v[r][j].x * v[r][j].x + v[r][j].y * v[r][j].y) + (v[r][j].z * v[r][j].z + v[r][j].w * v[r][j].w);
        s[r] = rsqrtf(wave_sum(a) * (1.f / DM) + EPS); }
#pragma unroll
    for (int r = 0; r < NR; ++r) { GAS unsigned long long* o8 = (GAS unsigned long long*)(dst + (m0 + r * stride) * DM) + lane;
#pragma unroll
        for (int j = 0; j < 4; ++j) { v[r][j] = v[r][j] * s[r] * ww[j]; o8[64 * j] = (unsigned long long)pk2(v[r][j].x, v[r][j].y) | ((unsigned long long)pk2(v[r][j].z, v[r][j].w) << 32); } }
    if (q8) {
#pragma unroll
        for (int r = 0; r < NR; ++r) { float am = 0.f;
#pragma unroll
            for (int j = 0; j < 4; ++j) am = fmaxf(am, fmaxf(fmaxf(fabsf(v[r][j].x), fabsf(v[r][j].y)), fmaxf(fabsf(v[r][j].z), fabsf(v[r][j].w))));
#pragma unroll
            for (int o = 1; o < 64; o <<= 1) am = fmaxf(am, __shfl_xor(am, o));
            am = fmaxf(am, 1e-20f); const float inv = 127.0f / am;
            GAS unsigned* qo = (GAS unsigned*)(q8 + (m0 + r * stride) * P8) + lane;
#pragma unroll
            for (int j = 0; j < 4; ++j) { const int a0 = (int)rintf(v[r][j].x * inv), a1 = (int)rintf(v[r][j].y * inv), a2 = (int)rintf(v[r][j].z * inv), a3 = (int)rintf(v[r][j].w * inv);
                qo[64 * j] = (unsigned)(a0 & 0xff) | ((unsigned)(a1 & 0xff) << 8) | ((unsigned)(a2 & 0xff) << 16) | ((unsigned)(a3 & 0xff) << 24); }
            if (lane == 0) rsc[m0 + r * stride] = am * (1.0f / 127.0f); } }
}
__device__ __forceinline__ void p0_quant_tile(const float* W, unsigned char* W8, float* CS, const unsigned* cmax, LAS float* scr, int item) {
    const int lane = hw_lane();
    const int kb = item / (N8 / 32), nb = item % (N8 / 32), k0 = 64 * kb, c0 = 32 * nb, n0 = i8src(c0);
    const float am = fmaxf(__uint_as_float(cmax[c0 + (lane & 31)]), 1e-30f), inv = 127.0f / am;
    if (kb == 0 && lane < 32) CS[c0 + lane] = am * (1.0f / 127.0f);
#pragma unroll 8
    for (int i = 0; i < 32; ++i) { const int kk = 2 * i + (lane >> 5); scr[kk * 33 + (lane & 31)] = rintf(W[(size_t)(k0 + kk) * NIN + n0 + (lane & 31)] * inv); }
    LDS_WAIT(); asm volatile("" ::: "memory");
    const int c = lane & 3;
#pragma unroll
    for (int j = 0; j < 2; ++j) { const int n = (lane >> 2) + 16 * j; const LAS float* sp = scr + (16 * c) * 33 + n; v4u o;
#define Q4(B) ((unsigned)((int)sp[((B) + 0) * 33] & 0xff) | ((unsigned)((int)sp[((B) + 1) * 33] & 0xff) << 8) | ((unsigned)((int)sp[((B) + 2) * 33] & 0xff) << 16) | ((unsigned)((int)sp[((B) + 3) * 33] & 0xff) << 24))
        o.x = Q4(0); o.y = Q4(4); o.z = Q4(8); o.w = Q4(12);
#undef Q4
        int nn = c0 + n; if (nn < 3072) nn = (nn & ~255) + 128 * ((nn >> 3) & 1) + 32 * ((nn >> 6) & 3) + 8 * ((nn >> 4) & 3) + (nn & 7);
        *(GAS v4u*)(W8 + (size_t)nn * P8 + k0 + 16 * c) = o; }
    LDS_WAIT(); asm volatile("" ::: "memory");
}
__device__ __forceinline__ void p0_quant_weights(Ctx& F, const unsigned* cmax) {
    LAS float* scr = (LAS float*)(F.lds + RING_OFF + F.wave * 16384);
    for (int it = F.gwave; it < 16 * (N8 / 32); it += F.NW) p0_quant_tile(F.w_in, F.W8, F.CS, cmax, scr, it);
}
__device__ __forceinline__ void p0_int8_block(Ctx& F, int nb) {
    const int lane = hw_lane(), col = lane & 31;
    LAS float* scr = (LAS float*)(F.lds + RING_OFF + F.wave * 16384);
    LAS float* wmax = (LAS float*)(F.lds + WSCR_OFF + 8192);
    const int c0 = 32 * nb, n0 = i8src(c0);
    float wv[2][32]; float cam = 0.f;
#pragma unroll
    for (int b = 0; b < 2; ++b) { const int k0 = 64 * (2 * F.wave + b);
#pragma unroll
        for (int i = 0; i < 32; ++i) { const int kk = 2 * i + (lane >> 5); wv[b][i] = F.w_in[(size_t)(k0 + kk) * NIN + n0 + col]; } }
#pragma unroll
    for (int b = 0; b < 2; ++b)
#pragma unroll
        for (int i = 0; i < 32; ++i) cam = fmaxf(cam, fabsf(wv[b][i]));
    cam = max_x32(cam);
    if (lane < 32) wmax[F.wave * 32 + lane] = cam;
    __syncthreads();
    float am = 1e-30f;
#pragma unroll
    for (int w = 0; w < 8; ++w) am = fmaxf(am, wmax[w * 32 + col]);
    const float inv = 127.0f / am;
    if (F.wave == 0 && lane < 32) F.CS[c0 + lane] = am * (1.0f / 127.0f);
#pragma unroll 1
    for (int b = 0; b < 2; ++b) { const int k0 = 64 * (2 * F.wave + b);
#pragma unroll
        for (int i = 0; i < 32; ++i) { const int kk = 2 * i + (lane >> 5); scr[kk * 33 + col] = rintf((b == 0 ? wv[0][i] : wv[1][i]) * inv); }
        LDS_WAIT(); asm volatile("" ::: "memory");
        const int c = lane & 3;
#pragma unroll
        for (int j = 0; j < 2; ++j) { const int n = (lane >> 2) + 16 * j; const LAS float* sp = scr + (16 * c) * 33 + n; v4u o;
#define Q4(B) ((unsigned)((int)sp[((B) + 0) * 33] & 0xff) | ((unsigned)((int)sp[((B) + 1) * 33] & 0xff) << 8) | ((unsigned)((int)sp[((B) + 2) * 33] & 0xff) << 16) | ((unsigned)((int)sp[((B) + 3) * 33] & 0xff) << 24))
            o.x = Q4(0); o.y = Q4(4); o.z = Q4(8); o.w = Q4(12);
#undef Q4
            int nn = c0 + n; if (nn < 3072) nn = (nn & ~255) + 128 * ((nn >> 3) & 1) + 32 * ((nn >> 6) & 3) + 8 * ((nn >> 4) & 3) + (nn & 7);
            *(GAS v4u*)(F.W8 + (size_t)nn * P8 + k0 + 16 * c) = o; }
        LDS_WAIT(); asm volatile("" ::: "memory"); }
    __syncthreads();
}
__device__ __forceinline__ void p0_prologue(Ctx& F) {
    LAS float* scr = (LAS float*)(F.lds + RING_OFF + F.wave * 16384);
    constexpr int I_IN = 16 * (NIN / 32), I_KV = 16 * 32, I_PA = 12 * 32, I_PB = 4 * 32, I_PM = 8 * 32, I_WO = 16 * 32;
    constexpr int NITEMS = I_IN + I_KV + I_PA + I_PB + I_PM + I_WO;
    for (int nb = (int)blockIdx.x; nb < N8 / 32; nb += F.G) p0_int8_block(F, nb);
    for (int it = F.gwave; it < NITEMS; it += F.NW) {
        int r = it;
        if (r < I_IN) { if (i8col(32 * (r % (NIN / 32))) < 0) p0_transpose_item(F.w_in, NIN, F.WIN, DM, 0, 0, scr, r, F.lane, true, nullptr); continue; } r -= I_IN;
        if (r < I_KV) { p0_transpose_item(F.m_w_kv, 1024, F.WIN, DM, NIN, 0, scr, r, F.lane); continue; } r -= I_KV;
        if (r < I_PA) { p0_transpose_item(F.proj_a, DM, F.PCAT, KC, 0, 0, scr, r, F.lane); continue; } r -= I_PA;
        if (r < I_PB) { p0_transpose_item(F.proj_b, DM, F.PCAT, KC, 0, 768, scr, r, F.lane); continue; } r -= I_PB;
        if (r < I_PM) { p0_transpose_item(F.proj_m, DM, F.PCAT, KC, 0, 1024, scr, r, F.lane); continue; } r -= I_PM;
        p0_transpose_item(F.w_out, DM, F.WOUT, PMR, 0, 0, scr, r, F.lane);
    }
    for (int i = F.gtid; i < 4 * 128 * 128; i += F.T) { const int t = (i >> 7) & 127, s = i & 127; F.WSP[i] = (bf16)(s <= t ? f2bf(F.sp_w[i]) : 0u); }
    for (int i = F.gtid; i < 3 * 4 * 132; i += F.T) { const int g = i / (4 * 132), h = (i / 132) % 4, j = i % 132; const int dil = g == 0 ? 1 : (g == 1 ? 4 : 16);
        F.BIAS[i] = j <= 128 ? F.rel_bias[t5_bucket(j * dil) * 12 + 4 * g + h] : 0.f; }
    for (int i = F.gtid; i < 3 * 4 * 192; i += F.T) { const int g = i / (4 * 192), h = (i / 192) % 4, step = i % 192 - 31; const int dil = g == 0 ? 1 : (g == 1 ? 4 : 16);
        F.BIASX[i] = (step >= 0 && step <= 128) ? F.rel_bias[t5_bucket(step * dil) * 12 + 4 * g + h] * 1.4426950408889634f : -1e30f; }
    if ((MTOT % (4 * F.NW)) == 0 && (MMEM % (4 * F.NW)) == 0) {
        for (size_t m = F.gwave; m < (size_t)MTOT; m += 4 * (size_t)F.NW) rms_rows_to_bf16<4>(F.x, F.norm_w, F.XN, m, F.NW, F.lane, F.XN8, F.RS);
        for (size_t m = F.gwave; m < (size_t)MMEM; m += 4 * (size_t)F.NW) rms_rows_to_bf16<4>(F.mem, F.mem_norm_w, F.XN + (size_t)MTOT * DM, m, F.NW, F.lane);
    } else {
        for (size_t m = F.gwave; m < (size_t)MTOT; m += F.NW) rms_rows_to_bf16<1>(F.x, F.norm_w, F.XN, m, 0, F.lane, F.XN8, F.RS);
        for (size_t m = F.gwave; m < (size_t)MMEM; m += F.NW) rms_rows_to_bf16<1>(F.mem, F.mem_norm_w, F.XN + (size_t)MTOT * DM, m, 0, F.lane);
    }
}


typedef float f32x16 __attribute__((ext_vector_type(16)));
typedef short s16x4 __attribute__((ext_vector_type(4)));
__device__ __forceinline__ int crow(int r, int hi) { return (r & 3) + 8 * (r >> 2) + 4 * hi; }
__device__ __forceinline__ unsigned cvtpk(float lo, float hi) { return pg8::cvt_pk_bf16(lo, hi); }
__device__ __forceinline__ v4u swap32x2(v4u w) { const auto r0 = __builtin_amdgcn_permlane32_swap(w.x, w.z, false, false), r1 = __builtin_amdgcn_permlane32_swap(w.y, w.w, false, false); return (v4u){r0[0], r1[0], r0[1], r1[1]}; }
__device__ __forceinline__ s16x4 vtr(const LAS unsigned char* p) { typedef short v4i16_t __attribute__((ext_vector_type(4))); return __builtin_bit_cast(s16x4, __builtin_amdgcn_ds_read_tr16_b64_v4i16((LAS v4i16_t*)p)); }
__device__ __forceinline__ float bflo(unsigned w) { return __uint_as_float(w << 16); }
__device__ __forceinline__ float bfhi(unsigned w) { return __uint_as_float(w & 0xffff0000u); }
constexpr float LOG2E = 1.4426950408889634f, LN2 = 0.6931471805599453f;
constexpr int NBX = 192;


__device__ __forceinline__ void dma16(const void* gsrc, LAS unsigned char* ldst) { __builtin_amdgcn_global_load_lds((const unsigned*)gsrc, (LAS unsigned*)ldst, 16, 0, 0); }
#define VM_WAIT0() asm volatile("s_waitcnt vmcnt(0)" ::: "memory")
__device__ __forceinline__ void st_mixA_mfma(Ctx& F) {
    const int lane = hw_lane(), r32 = lane & 31, hi = lane >> 5, tid = F.wave * 64 + lane;
    LAS unsigned char* wl = F.lds + RING_OFF + F.wave * 16384;
    typedef float f32x2v __attribute__((ext_vector_type(2))); typedef unsigned u32x2v __attribute__((ext_vector_type(2)));
    LAS f32x2v* tab = (LAS f32x2v*)(F.lds + WSCR_OFF + 8192);
    const int g = F.wave >> 1, ch = lane & 3;
    bf16x8 wf[14];
    const bf16* wrow0 = F.WSP + (size_t)(g * 128 + r32) * 128 + 8 * hi;
    { int n = 0;
#pragma unroll
      for (int tb = 2; tb < 4; ++tb)
#pragma unroll
          for (int ks = 0; ks < 2 * (tb + 1); ++ks) wf[n++] = *(const bf16x8*)(wrow0 + (size_t)tb * 32 * 128 + 16 * ks); }
    for (int unit = blockIdx.x; unit < HB_ROWS / 128; unit += F.G) {
        const int rowbase = unit * 128;
        v4u raw[8];
        { const int c0 = g * 192 + (F.wave & 1) * 96;
#pragma unroll
          for (int i = 0; i < 8; ++i) raw[i] = *(const v4u*)(F.PA + (size_t)(rowbase + (lane >> 2) + 16 * i) * PAP + C_AV + c0 + 8 * ch); }
        { const int row = tid >> 2, part = tid & 3; const float* sp = F.SS + (size_t)(rowbase + row) * SS_W + 12 * part; float s = 0.f, q = 0.f;
#pragma unroll
          for (int k = 0; k < 6; ++k) { s += sp[2 * k]; q += sp[2 * k + 1]; }
          s = sum_quad(s); q = sum_quad(q);
          const float mu = s * (1.f / 768.f), var = q * (1.f / 768.f) - mu * mu;
          if (part == 0) tab[row] = (f32x2v){mu, rsqrtf(fmaxf(var, 0.f) + EPS)}; }
        __syncthreads();
#pragma unroll 1
        for (int cbi = 0; cbi < 3; ++cbi) {
            const int c0 = g * 192 + ((F.wave & 1) * 3 + cbi) * 32;
            const f32x4 w0 = *(const f32x4*)(F.lnw + c0 + 8 * ch), w1 = *(const f32x4*)(F.lnw + c0 + 8 * ch + 4), b0 = *(const f32x4*)(F.lnb + c0 + 8 * ch), b1 = *(const f32x4*)(F.lnb + c0 + 8 * ch + 4);
#pragma unroll
            for (int i = 0; i < 8; ++i) { const int s = (lane >> 2) + 16 * i; const f32x2v st = tab[s]; const v4u rw = raw[i]; v4u o;
                o.x = cvtpk((bflo(rw.x) - st.x) * st.y * w0.x + b0.x, (bfhi(rw.x) - st.x) * st.y * w0.y + b0.y); o.y = cvtpk((bflo(rw.y) - st.x) * st.y * w0.z + b0.z, (bfhi(rw.y) - st.x) * st.y * w0.w + b0.w);
                o.z = cvtpk((bflo(rw.z) - st.x) * st.y * w1.x + b1.x, (bfhi(rw.z) - st.x) * st.y * w1.y + b1.y); o.w = cvtpk((bflo(rw.w) - st.x) * st.y * w1.z + b1.z, (bfhi(rw.w) - st.x) * st.y * w1.w + b1.w);
                *(LAS v4u*)(wl + (s >> 3) * 512 + (s & 7) * 64 + ch * 16) = o; }
            if (cbi < 2) {
#pragma unroll
                for (int i = 0; i < 8; ++i) raw[i] = *(const v4u*)(F.PA + (size_t)(rowbase + (lane >> 2) + 16 * i) * PAP + C_AV + c0 + 32 + 8 * ch); }
            LAS unsigned char* uzb = wl + 8192;
#pragma unroll
            for (int p = 0; p < 8; ++p) { const int row_ = 16 * p + (lane >> 2);
                dma16(F.PA + (size_t)(rowbase + row_) * PAP + C_AU + c0 + 8 * ((lane & 3) ^ ((row_ >> 2) & 3)), uzb + p * 1024); }
            const LAS unsigned char* vb = wl + hi * 512 + ((lane & 15) >> 2) * 64 + ((lane >> 4) & 1) * 32 + (lane & 3) * 8;
            const bf16* wr2 = wrow0; asm volatile("" : "+v"(wr2));
            bf16x8 wq[6];
            { int n2 = 0;
#pragma unroll
              for (int tb = 0; tb < 2; ++tb)
#pragma unroll
                  for (int ks = 0; ks < 2 * (tb + 1); ++ks) wq[n2++] = *(const bf16x8*)(wr2 + (size_t)tb * 32 * 128 + 16 * ks); }
            int n = 0, nq = 0;
#pragma unroll
            for (int tb = 0; tb < 4; ++tb) { f32x16 acc = {};
#pragma unroll
                for (int ks = 0; ks < 2 * (tb + 1); ++ks) { const s16x4 a = vtr(vb + ks * 1024), c = vtr(vb + ks * 1024 + 256); const bf16x8 af = {a[0], a[1], a[2], a[3], c[0], c[1], c[2], c[3]};
                    acc = __builtin_amdgcn_mfma_f32_32x32x16_bf16(af, tb < 2 ? wq[nq++] : wf[n++], acc, 0, 0, 0); }
                const int t = 32 * tb + r32; const float sb = F.sp_b[g * 128 + t];
                if (tb == 0) VM_WAIT0();
                LAS unsigned char* urow = uzb + t * 64 + 8 * hi; const int fsw = (r32 >> 2) & 3;
#pragma unroll
                for (int i = 0; i < 4; ++i) { LAS u32x2v* up = (LAS u32x2v*)(urow + ((i ^ fsw) * 16)); const u32x2v u = *up; u32x2v w;
                    w.x = cvtpk(bflo(u.x) * (acc[4 * i] + sb), bfhi(u.x) * (acc[4 * i + 1] + sb)); w.y = cvtpk(bflo(u.y) * (acc[4 * i + 2] + sb), bfhi(u.y) * (acc[4 * i + 3] + sb));
                    *up = w; }
#pragma unroll
                for (int jr = 0; jr < 2; ++jr) { const int row_ = 32 * tb + 16 * jr + (lane >> 2); const v4u yv = *(const LAS v4u*)(uzb + row_ * 64 + (lane & 3) * 16);
                    *(v4u*)(F.YC + (size_t)(rowbase + row_) * KC + c0 + 8 * ((lane & 3) ^ ((row_ >> 2) & 3))) = yv; } }
        }
        __syncthreads();
    }
}

__device__ __forceinline__ void st_mergeB_vec(Ctx& F) {
    constexpr int NI = 8;
    const int total = HB_ROWS * 32, gtid0 = (int)blockIdx.x * NTHR + F.wave * 64 + hw_lane();
    for (int g0 = gtid0; g0 < total; g0 += NI * F.T) {
        v4u a[NI], b[NI], c[NI], z[NI]; float l0[NI], l1[NI], l2[NI];
#pragma unroll
        for (int i = 0; i < NI; ++i) { const int gid = g0 + i * F.T < total ? g0 + i * F.T : g0; const int r = gid >> 5, c8 = (gid & 31) * 8, h = c8 >> 6;
            l0[i] = F.LSE[((size_t)0 * HB_ROWS + r) * 4 + h]; l1[i] = F.LSE[((size_t)1 * HB_ROWS + r) * 4 + h]; l2[i] = F.LSE[((size_t)2 * HB_ROWS + r) * 4 + h];
            a[i] = *(const v4u*)(F.OG + ((size_t)0 * HB_ROWS + r) * 256 + c8); b[i] = *(const v4u*)(F.OG + ((size_t)1 * HB_ROWS + r) * 256 + c8); c[i] = *(const v4u*)(F.OG + ((size_t)2 * HB_ROWS + r) * 256 + c8);
            z[i] = *(const v4u*)(F.PA + (size_t)r * PAP + C_BZ + c8); }
        __builtin_amdgcn_sched_barrier(0);
#pragma unroll
        for (int i = 0; i < NI; ++i) { if (g0 + i * F.T >= total) break; const int gid = g0 + i * F.T; const int r = gid >> 5, c8 = (gid & 31) * 8;
            const float mx = fmaxf(l0[i], fmaxf(l1[i], l2[i])); float e0 = __expf(l0[i] - mx), e1 = __expf(l1[i] - mx), e2 = __expf(l2[i] - mx); const float inv = 1.f / (e0 + e1 + e2); e0 *= inv; e1 *= inv; e2 *= inv;
            v4u o;
#define MB_1(X) X = pk2((e0 * bflo(a[i].X) + e1 * bflo(b[i].X) + e2 * bflo(c[i].X)) * bflo(z[i].X), (e0 * bfhi(a[i].X) + e1 * bfhi(b[i].X) + e2 * bfhi(c[i].X)) * bfhi(z[i].X))
            o.MB_1(x); o.MB_1(y); o.MB_1(z); o.MB_1(w);
#undef MB_1
            *(v4u*)(F.YC + (size_t)r * KC + 768 + c8) = o; }
    }
}


__device__ __forceinline__ void st_attnM_v3(Ctx& F, int hb) {
    const int lane = hw_lane(), r32 = lane & 31, hi = lane >> 5;
    LAS unsigned char* kimg = F.lds + RING_OFF; LAS unsigned char* vimg = F.lds + RING_OFF + 65536;
    LAS float* kstab = (LAS float*)(F.lds + WSCR_OFF + 8192);
    typedef unsigned u32x2v __attribute__((ext_vector_type(2)));
    const int vcu = F.xgwave >> 3;
    __syncthreads();
    for (int task = vcu; task < 256; task += F.G) {
        const int bh = task >> 2, b = bh >> 2, h = bh & 3; const size_t kbase = (size_t)(hb * 16 + b) * MEML;
#pragma unroll
        for (int j = 0; j < 8; ++j) { const int p = F.wave * 8 + j, row = 4 * p + (lane >> 4);
            dma16(F.KVM + (kbase + row) * 1024 + h * 128 + 8 * ((lane & 15) ^ (row & 15)), kimg + p * 1024);
            dma16(F.KVM + (kbase + 8 * (p >> 1) + ((lane & 31) >> 2)) * 1024 + 512 + h * 128 + (2 * (p & 1) + (lane >> 5)) * 32 + (lane & 3) * 8, vimg + p * 1024); }
        { const int key = F.wave * 32 + r32; const float* sp = F.MKSS + (kbase + key) * 16 + 4 * h;
          const float ksv = rsqrtf(((sp[0] + sp[1]) + (sp[2] + sp[3])) * (1.f / 128.f) + EPS); if (lane < 32) kstab[key] = ksv; }
        VM_WAIT0(); __syncthreads();
#pragma unroll 1
        for (int qi = 0; qi < 2; ++qi) {
            const int qb = (task & 3) * 16 + F.wave * 2 + qi;
            const size_t qrow = (size_t)(b * SEQ + qb * 32 + r32);
            const float qs = rsqrtf(((F.SS[qrow * SS_W + 96 + 4 * h] + F.SS[qrow * SS_W + 96 + 4 * h + 1]) + (F.SS[qrow * SS_W + 96 + 4 * h + 2] + F.SS[qrow * SS_W + 96 + 4 * h + 3])) * (1.f / 128.f) + EPS) * (0.08838834764831845f * LOG2E);
            bf16x8 qf[8];
#pragma unroll
            for (int d0 = 0; d0 < 8; ++d0) { const int dd = 16 * d0 + 8 * hi;
                const v4u raw = *(const v4u*)(F.PA + qrow * PAP + C_MQ + h * 128 + dd);
                const f32x4 wa = *(const f32x4*)(F.mqw + dd), wb = *(const f32x4*)(F.mqw + dd + 4), ka = *(const f32x4*)(F.mkw + dd), kb = *(const f32x4*)(F.mkw + dd + 4);
                v4u o;
                o.x = cvtpk(bflo(raw.x) * qs * wa.x * ka.x, bfhi(raw.x) * qs * wa.y * ka.y); o.y = cvtpk(bflo(raw.y) * qs * wa.z * ka.z, bfhi(raw.y) * qs * wa.w * ka.w);
                o.z = cvtpk(bflo(raw.z) * qs * wb.x * kb.x, bfhi(raw.z) * qs * wb.y * kb.y); o.w = cvtpk(bflo(raw.w) * qs * wb.z * kb.z, bfhi(raw.w) * qs * wb.w * kb.w);
                qf[d0] = __builtin_bit_cast(bf16x8, o); }
            v4u zq[4][2];
#pragma unroll
            for (int db = 0; db < 4; ++db)
#pragma unroll
                for (int kp = 0; kp < 2; ++kp) zq[db][kp] = *(const v4u*)(F.PA + qrow * PAP + C_MZ + h * 128 + db * 32 + 16 * kp + 8 * hi);
            float mrun = -1e30f, lrun = 0.f; f32x16 o0 = {}, o1 = {}, o2 = {}, o3 = {};
            const LAS unsigned char* kb0 = kimg + r32 * 256; const int ksw = r32 & 15;
            const LAS unsigned char* vb0 = vimg + (4 * hi + ((lane & 15) >> 2)) * 64 + ((lane >> 4) & 1) * 32 + (lane & 3) * 8;
#pragma unroll 2
            for (int t = 0; t < MEML / 32; ++t) {
                f32x16 st = {};
#pragma unroll
                for (int d0 = 0; d0 < 8; ++d0) { const bf16x8 kf = *(const LAS bf16x8*)(kb0 + t * 8192 + (((2 * d0 + hi) ^ ksw) * 16)); st = __builtin_amdgcn_mfma_f32_32x32x16_bf16(kf, qf[d0], st, 0, 0, 0); }
                float tmax = -1e30f;
#pragma unroll
                for (int i = 0; i < 4; ++i) { const f32x4 kk = *(const LAS f32x4*)(kstab + 32 * t + 8 * i + 4 * hi);
#pragma unroll
                    for (int j = 0; j < 4; ++j) { const float s = st[4 * i + j] * kk[j]; st[4 * i + j] = s; tmax = fmaxf(tmax, s); } }
                tmax = max_x32(tmax);
                const float mnew = fmaxf(mrun, tmax), alpha = __builtin_amdgcn_exp2f(mrun - mnew); mrun = mnew;
                float psum = 0.f;
#pragma unroll
                for (int r = 0; r < 16; ++r) { st[r] = __builtin_amdgcn_exp2f(st[r] - mnew); psum += st[r]; }
                lrun = lrun * alpha + psum;
#pragma unroll
                for (int r = 0; r < 16; ++r) { o0[r] *= alpha; o1[r] *= alpha; o2[r] *= alpha; o3[r] *= alpha; }
                v4u p0, p1;
                p0.x = cvtpk(st[0], st[1]); p0.y = cvtpk(st[2], st[3]); p0.z = cvtpk(st[4], st[5]); p0.w = cvtpk(st[6], st[7]);
                p1.x = cvtpk(st[8], st[9]); p1.y = cvtpk(st[10], st[11]); p1.z = cvtpk(st[12], st[13]); p1.w = cvtpk(st[14], st[15]);
                const LAS unsigned char* vb = vb0 + t * 8192;
#define AM_PV(OX, DB) do { _Pragma("unroll") for (int s = 0; s < 2; ++s) { const bf16x8 pf = __builtin_bit_cast(bf16x8, s == 0 ? p0 : p1); \
                    const s16x4 a = vtr(vb + (2 * s) * 2048 + (DB) * 512), c = vtr(vb + (2 * s + 1) * 2048 + (DB) * 512); const bf16x8 vf = {a[0], a[1], a[2], a[3], c[0], c[1], c[2], c[3]}; \
                    OX = __builtin_amdgcn_mfma_f32_32x32x16_bf16(vf, pf, OX, 0, 0, 0); } } while (0)
                AM_PV(o0, 0); AM_PV(o1, 1); AM_PV(o2, 2); AM_PV(o3, 3);
#undef AM_PV
            }
            const float ltot = sum_x32(lrun), inv = 1.f / ltot;
            bf16* yrow = F.YC + qrow * KC + 1024 + h * 128 + 8 * hi;
#define AM_ST(OX, DB) do { _Pragma("unroll") for (int kp = 0; kp < 2; ++kp) { const v4u z = swap32x2(zq[DB][kp]);     \
            v4u w; w.x = cvtpk(OX[8 * kp] * inv * bflo(z.x), OX[8 * kp + 1] * inv * bfhi(z.x)); w.y = cvtpk(OX[8 * kp + 2] * inv * bflo(z.y), OX[8 * kp + 3] * inv * bfhi(z.y)); \
            w.z = cvtpk(OX[8 * kp + 4] * inv * bflo(z.z), OX[8 * kp + 5] * inv * bfhi(z.z)); w.w = cvtpk(OX[8 * kp + 6] * inv * bflo(z.w), OX[8 * kp + 7] * inv * bfhi(z.w)); \
            *(v4u*)(yrow + (DB) * 32 + 16 * kp) = swap32x2(w); } } while (0)
            AM_ST(o0, 0); AM_ST(o1, 1); AM_ST(o2, 2); AM_ST(o3, 3);
#undef AM_ST
        }
        __syncthreads();
    }
}

__device__ __forceinline__ void st_attnB_v3(Ctx& F) {
    const int lane = hw_lane(), r32 = lane & 31, hi = lane >> 5, tid = F.wave * 64 + lane;
    LAS unsigned char* kimg = F.lds + RING_OFF; LAS unsigned char* vimg = F.lds + RING_OFF + 49152;
    LAS float* kstab = (LAS float*)(F.lds + RING_OFF + 98304);
    LAS float* btab = (LAS float*)(F.lds + RING_OFF + 98304 + 2048);
    typedef unsigned u32x2v __attribute__((ext_vector_type(2)));
    const int vcu = F.xgwave >> 3;
    __syncthreads();
    for (int unit = vcu; unit < 3 * 16 * 4 * 8; unit += F.G) {
        const int k = unit & 7, h = (unit >> 3) & 3, b = (unit >> 5) & 15, g = unit >> 9, hh = 4 * g + h;
        const int dil = g == 0 ? 1 : (g == 1 ? 4 : 16);
        const int res0 = g == 0 ? 0 : (g == 1 ? (k >> 1) : 2 * k), j0 = g == 0 ? 8 * k : (g == 1 ? 8 * (k & 1) : 0);
#pragma unroll
        for (int i = 0; i < 12; ++i) { const int q = F.wave * 12 + i, s = q >> 3, pc = q & 7, p = pc & 3;
            int res, jt; bool valid;
            if (g < 2) { res = res0; jt = j0 - 4 + s; valid = jt >= 0; } else { res = res0 + (s >> 2); jt = s & 3; valid = s < 8; }
            if (valid) {
                if (pc < 4) { const int row = 8 * p + (lane >> 3); const size_t trow = (size_t)(b * SEQ + res + (32 * jt + row) * dil);
                    dma16(F.PA + trow * PAP + C_BK + hh * 64 + 8 * ((lane & 7) ^ ((row >> 1) & 7)), kimg + s * 4096 + p * 1024); }
                else { const int key = 8 * p + ((lane & 31) >> 2); const size_t trow = (size_t)(b * SEQ + res + (32 * jt + key) * dil);
                    dma16(F.PA + trow * PAP + C_BV + hh * 64 + (lane >> 5) * 32 + (lane & 3) * 8, vimg + s * 4096 + p * 1024); } } }
        if (tid < 384) { const int s = tid >> 5, kk = tid & 31; int res, jt; bool valid;
            if (g < 2) { res = res0; jt = j0 - 4 + s; valid = jt >= 0; } else { res = res0 + (s >> 2); jt = s & 3; valid = s < 8; }
            if (valid) { const size_t trow = (size_t)(b * SEQ + res + (32 * jt + kk) * dil);
                kstab[tid] = rsqrtf((F.SS[trow * SS_W + 72 + 2 * hh] + F.SS[trow * SS_W + 72 + 2 * hh + 1]) * (1.f / 64.f) + EPS); } }
        if (tid < NBX) btab[tid] = F.BIASX[(g * 4 + h) * NBX + tid];
        const int wres = g < 2 ? res0 : res0 + (F.wave >> 2), j = g < 2 ? j0 + F.wave : (F.wave & 3);
        const int sbase = g < 2 ? 4 - j0 : (F.wave >> 2) * 4;
        const size_t qrow = (size_t)(b * SEQ + wres + (32 * j + r32) * dil);
        const float qs = rsqrtf((F.SS[qrow * SS_W + 48 + 2 * hh] + F.SS[qrow * SS_W + 48 + 2 * hh + 1]) * (1.f / 64.f) + EPS) * (0.125f * LOG2E);
        bf16x8 qf[4];
#pragma unroll
        for (int d0 = 0; d0 < 4; ++d0) { const int dd = 16 * d0 + 8 * hi;
            const v4u raw = *(const v4u*)(F.PA + qrow * PAP + C_BQ + hh * 64 + dd);
            const f32x4 wa = *(const f32x4*)(F.bqw + dd), wb = *(const f32x4*)(F.bqw + dd + 4), ka = *(const f32x4*)(F.bkw + dd), kb = *(const f32x4*)(F.bkw + dd + 4);
            v4u o;
            o.x = cvtpk(bflo(raw.x) * qs * wa.x * ka.x, bfhi(raw.x) * qs * wa.y * ka.y); o.y = cvtpk(bflo(raw.y) * qs * wa.z * ka.z, bfhi(raw.y) * qs * wa.w * ka.w);
            o.z = cvtpk(bflo(raw.z) * qs * wb.x * kb.x, bfhi(raw.z) * qs * wb.y * kb.y); o.w = cvtpk(bflo(raw.w) * qs * wb.z * kb.z, bfhi(raw.w) * qs * wb.w * kb.w);
            qf[d0] = __builtin_bit_cast(bf16x8, o); }
        VM_WAIT0(); __syncthreads();
        float mrun = -1e30f, lrun = 0.f; f32x16 o0 = {}, o1 = {};
        const int ksw = (r32 >> 1) & 7;
        for (int jt = (j >= 4 ? j - 4 : 0); jt <= j; ++jt) {
            const int s = sbase + jt;
            const LAS unsigned char* kb = kimg + s * 4096 + r32 * 128;
            const LAS unsigned char* vb = vimg + s * 4096 + (4 * hi + ((lane & 15) >> 2)) * 64 + ((lane >> 4) & 1) * 32 + (lane & 3) * 8;
            const int bidx = 32 * (j - jt) + r32 + 31 - 4 * hi;
            bf16x8 kf[4]; f32x4 kk[4]; float bb[16]; s16x4 va[2][2], vc[2][2];
#pragma unroll
            for (int d0 = 0; d0 < 4; ++d0) kf[d0] = *(const LAS bf16x8*)(kb + (((2 * d0 + hi) ^ ksw) * 16));
#pragma unroll
            for (int i = 0; i < 4; ++i) { kk[i] = *(const LAS f32x4*)(kstab + s * 32 + 8 * i + 4 * hi);
#pragma unroll
                for (int jj = 0; jj < 4; ++jj) bb[4 * i + jj] = btab[bidx - 8 * i - jj]; }
#pragma unroll
            for (int ss = 0; ss < 2; ++ss)
#pragma unroll
                for (int hh2 = 0; hh2 < 2; ++hh2) { va[ss][hh2] = vtr(vb + (2 * ss) * 1024 + hh2 * 512); vc[ss][hh2] = vtr(vb + (2 * ss + 1) * 1024 + hh2 * 512); }
            __builtin_amdgcn_sched_barrier(0);
            f32x16 st = {};
#pragma unroll
            for (int d0 = 0; d0 < 4; ++d0) st = __builtin_amdgcn_mfma_f32_32x32x16_bf16(kf[d0], qf[d0], st, 0, 0, 0);
            float tmax = -1e30f;
#pragma unroll
            for (int i = 0; i < 4; ++i)
#pragma unroll
                for (int jj = 0; jj < 4; ++jj) { const float sv = st[4 * i + jj] * kk[i][jj] + bb[4 * i + jj]; st[4 * i + jj] = sv; tmax = fmaxf(tmax, sv); }
            tmax = max_x32(tmax);
            const float mnew = fmaxf(mrun, tmax), alpha = __builtin_amdgcn_exp2f(mrun - mnew); mrun = mnew;
            float psum = 0.f;
#pragma unroll
            for (int r = 0; r < 16; ++r) { st[r] = __builtin_amdgcn_exp2f(st[r] - mnew); psum += st[r]; }
            lrun = lrun * alpha + psum;
#pragma unroll
            for (int r = 0; r < 16; ++r) { o0[r] *= alpha; o1[r] *= alpha; }
            v4u p0, p1;
            p0.x = cvtpk(st[0], st[1]); p0.y = cvtpk(st[2], st[3]); p0.z = cvtpk(st[4], st[5]); p0.w = cvtpk(st[6], st[7]);
            p1.x = cvtpk(st[8], st[9]); p1.y = cvtpk(st[10], st[11]); p1.z = cvtpk(st[12], st[13]); p1.w = cvtpk(st[14], st[15]);
#pragma unroll
            for (int ss = 0; ss < 2; ++ss) { const bf16x8 pf = __builtin_bit_cast(bf16x8, ss == 0 ? p0 : p1);
                { const s16x4 a = va[ss][0], c = vc[ss][0]; const bf16x8 vf = {a[0], a[1], a[2], a[3], c[0], c[1], c[2], c[3]}; o0 = __builtin_amdgcn_mfma_f32_32x32x16_bf16(vf, pf, o0, 0, 0, 0); }
                { const s16x4 a = va[ss][1], c = vc[ss][1]; const bf16x8 vf = {a[0], a[1], a[2], a[3], c[0], c[1], c[2], c[3]}; o1 = __builtin_amdgcn_mfma_f32_32x32x16_bf16(vf, pf, o1, 0, 0, 0); } }
        }
        const float ltot = sum_x32(lrun), inv = 1.f / ltot;
        bf16* orow = F.OG + ((size_t)g * HB_ROWS + qrow) * 256 + h * 64 + 8 * hi;
#define AB_ST(OX, DB) do { _Pragma("unroll") for (int kp = 0; kp < 2; ++kp) { v4u w; \
            w.x = cvtpk(OX[8 * kp] * inv, OX[8 * kp + 1] * inv); w.y = cvtpk(OX[8 * kp + 2] * inv, OX[8 * kp + 3] * inv); w.z = cvtpk(OX[8 * kp + 4] * inv, OX[8 * kp + 5] * inv); w.w = cvtpk(OX[8 * kp + 6] * inv, OX[8 * kp + 7] * inv); \
            *(v4u*)(orow + (DB) * 32 + 16 * kp) = swap32x2(w); } } while (0)
        AB_ST(o0, 0); AB_ST(o1, 1);
#undef AB_ST
        if (hi == 0) F.LSE[((size_t)g * HB_ROWS + qrow) * 4 + h] = (mrun + __log2f(ltot)) * LN2;
        __syncthreads();
    }
}

#ifndef G1_STAGGER_TICKS
#define G1_STAGGER_TICKS 0
#endif
#ifndef G1_ALIGN_EPI
#define G1_ALIGN_EPI true
#endif
#ifndef PROBE_REP
#define PROBE_REP -1
#endif
#define REPS(id) for (int rep_ = 0; rep_ < ((PROBE_REP) == (id) ? 2 : 1); ++rep_)
#ifndef MK_PER_PHASE
#define MK_PER_PHASE 0
#endif
constexpr int NPH_HALF = 5, NPHASES = 1 + 2 * NPH_HALF;
struct Args { const float* in[20]; float* out; unsigned char* ws; int ph_lo, ph_hi; };
__global__ void __launch_bounds__(NTHR, 2) mega_fwd(Args args) {
    extern __shared__ __attribute__((aligned(16))) unsigned char lds_raw[];
    Ctx F;
    F.lds = (LAS unsigned char*)lds_raw;
    F.tid = threadIdx.x; F.lane = F.tid & 63; F.wave = __builtin_amdgcn_readfirstlane(F.tid >> 6);
    F.G = gridDim.x; F.gtid = blockIdx.x * NTHR + F.tid; F.T = F.G * NTHR; F.gwave = blockIdx.x * NWAVES + F.wave; F.NW = F.G * NWAVES;
    { const int bx = blockIdx.x; const int vcu = (F.G % 8 == 0) ? (bx % 8) * (F.G / 8) + bx / 8 : bx; F.xgwave = vcu * NWAVES + F.wave; }
    unsigned char* ws = args.ws;
    F.x = args.in[0]; F.mem = args.in[1]; F.norm_w = args.in[2]; F.w_in = args.in[3]; F.gate_b = args.in[4]; F.lnw = args.in[5]; F.lnb = args.in[6]; F.sp_w = args.in[7];
    F.sp_b = args.in[8]; F.bqw = args.in[9]; F.bkw = args.in[10]; F.rel_bias = args.in[11]; F.mem_norm_w = args.in[12]; F.m_w_kv = args.in[13]; F.mqw = args.in[14]; F.mkw = args.in[15];
    F.proj_a = args.in[16]; F.proj_b = args.in[17]; F.proj_m = args.in[18]; F.w_out = args.in[19]; F.out = args.out;
    F.WIN = (bf16*)(ws + WS_WIN); F.PCAT = (bf16*)(ws + WS_PCAT); F.WOUT = (bf16*)(ws + WS_WOUT); F.WSP = (bf16*)(ws + WS_WSP); F.BIAS = (float*)(ws + WS_BIAS); F.BIASX = (float*)(ws + WS_BIAS + 65536);
    F.XN = (bf16*)(ws + WS_XN); F.PA = (bf16*)(ws + WS_PA); F.KVM = (bf16*)(ws + WS_KVM); F.SS = (float*)(ws + WS_SS); F.MKSS = (float*)(ws + WS_MKSS);
    F.cmax = (unsigned*)(ws + WS_CTL + CW_CMAX * 4); F.XN8 = ws + WS_XN8; F.W8 = ws + WS_W8; F.CS = (float*)(ws + WS_CS); F.RS = (float*)(ws + WS_RS);
    F.OG = (bf16*)(ws + WS_OG); F.LSE = (float*)(ws + WS_LSE); F.LNST = (float*)(ws + WS_LNST); F.YC = (bf16*)(ws + WS_YC); F.MRG = (bf16*)(ws + WS_MRG);
    for (int u = F.tid; u < (LDS_BYTES - LDSCTL_OFF) / 4; u += NTHR) ((LAS unsigned*)(F.lds + LDSCTL_OFF))[u] = 0u;
    __syncthreads();
    XcdBarrier bar; bar.bar = (unsigned*)(ws + WS_CTL) + CW_BAR; bar.x = 0; bar.st = nullptr; bar.wave = 0;
    if (!MK_PER_PHASE) bar = xcd_barrier_post((unsigned*)(ws + WS_CTL) + CW_BAR, (volatile LAS unsigned*)(F.lds + MISC_OFF) + 8, F.wave);
    const int lo = args.ph_lo, hi = args.ph_hi;
#define IN(k) (lo <= (k) && (k) < hi)
#define SEAM(k) do { if (IN(k) && IN((k) + 1)) xcd_barrier(bar); } while (0)

    if (IN(0)) { REPS(0) p0_prologue(F); } SEAM(0);
#pragma unroll 1
    for (int hb = 0; hb < 2; ++hb) {
        const int pb = 1 + hb * NPH_HALF, row0 = hb * HB_ROWS;
        asm volatile("v_mbcnt_lo_u32_b32 %0, -1, 0\n\tv_mbcnt_hi_u32_b32 %0, -1, %0" : "=v"(F.lane)); F.tid = F.wave * 64 + F.lane; F.gtid = blockIdx.x * NTHR + F.tid;
#if PROBE_REP == 9 || PROBE_REP == 10
        if (IN(pb + 0)) { pg8::Gemm g{F.XN, F.WIN, MTOT + MMEM, NIN + 1024, DM, DM, DM}; pg8::OrderBF S; S.init(hb, F.G, (int)blockIdx.x);
            typedef pg8::EpiProjT<PROBE_REP - 8> EP; EP E{F.PA, F.KVM, F.SS, F.MKSS, F.gate_b, hb * (HB_ROWS / 256), 0};
            pg8::gemm_phase<EP, pg8::OrderBF, true, true>(F.lds + RING_OFF, g, S, E, F.wave); }
#endif
        if (IN(pb + 0)) REPS(1) {
            pg8::Gemm g{F.XN, F.WIN, MTOT + MMEM, NIN + 1024, DM, DM, DM}; pg8::OrderBF S; S.init(hb, F.G, (int)blockIdx.x);
#if G1_STAGGER_TICKS
            { const unsigned long long t0 = __builtin_amdgcn_s_memrealtime(), dl = (unsigned long long)((blockIdx.x >> 3) & 31) * G1_STAGGER_TICKS;
              while (__builtin_amdgcn_s_memrealtime() - t0 < dl) __builtin_amdgcn_s_sleep(8); }
#endif
            pg8::EpiProj E{F.PA, F.KVM, F.SS, F.MKSS, F.gate_b, hb * (HB_ROWS / 256), 0};
            pg8::gemm_phase<pg8::EpiProj, pg8::OrderBF, G1_ALIGN_EPI, true>(F.lds + RING_OFF, g, S, E, F.wave);
        }
#if PROBE_REP == 16 || PROBE_REP == 17
        if (IN(pb + 0)) { pg8::Gemm g{(const bf16*)F.XN8, (const bf16*)F.W8, MTOT, N8, DM / 2, P8 / 2, P8 / 2}; pg8::OrderG8 S; S.init(hb, F.G, (int)blockIdx.x);
            typedef pg8::EpiProj8T<PROBE_REP == 16 ? 2 : 0> EP; EP E{pg8::EpiProjT<PROBE_REP == 16 ? 2 : 0>{F.PA, F.KVM, F.SS, F.MKSS, F.gate_b, hb * (HB_ROWS / 256), 0}, F.RS, F.CS, F.lds + SCALE_OFF};
            pg8::gemm_phase<EP, pg8::OrderG8, G1_ALIGN_EPI, true, true>(F.lds + RING_OFF, g, S, E, F.wave); }
#endif
        if (IN(pb + 0)) {
            pg8::Gemm g{(const bf16*)F.XN8, (const bf16*)F.W8, MTOT, N8, DM / 2, P8 / 2, P8 / 2}; pg8::OrderG8 S; S.init(hb, F.G, (int)blockIdx.x);
            pg8::EpiProj8 E{pg8::EpiProj{F.PA, F.KVM, F.SS, F.MKSS, F.gate_b, hb * (HB_ROWS / 256), 0}, F.RS, F.CS, F.lds + SCALE_OFF};
            pg8::gemm_phase<pg8::EpiProj8, pg8::OrderG8, G1_ALIGN_EPI, true, true>(F.lds + RING_OFF, g, S, E, F.wave);
        }
#if PROBE_REP == 8
        if (IN(pb + 0)) { pg8::Gemm g{F.XN, F.WIN, MTOT + MMEM, NIN + 1024, DM, DM, DM}; pg8::OrderBF S; S.init(hb, F.G, (int)blockIdx.x); pg8::EpiNull E{};
            pg8::gemm_phase<pg8::EpiNull, pg8::OrderBF, true, true>(F.lds + RING_OFF, g, S, E, F.wave); }
#endif
        SEAM(pb + 0);
        if (IN(pb + 1)) { REPS(2) st_mixA_mfma(F); REPS(3) st_attnB_v3(F); REPS(4) st_attnM_v3(F, hb); } SEAM(pb + 1);
        if (IN(pb + 2)) { REPS(5) st_mergeB_vec(F); } SEAM(pb + 2);
#if PROBE_REP == 13 || PROBE_REP == 14
        if (IN(pb + 3)) { pg8::Gemm g{F.YC, F.PCAT, HB_ROWS, DM, KC, KC, KC}; pg8::StaticOrder S; S.init(HB_ROWS, DM, F.G, (int)blockIdx.x);
            typedef pg8::EpiG2catT<PROBE_REP == 13, PROBE_REP == 14> EP; EP E{F.PA, F.MRG};
            pg8::gemm_phase<EP, pg8::StaticOrder, true, true>(F.lds + RING_OFF, g, S, E, F.wave); }
#endif
#if PROBE_REP == 11
        if (IN(pb + 3)) { pg8::Gemm g{F.YC, F.PCAT, HB_ROWS, DM, KC, KC, KC}; pg8::StaticOrder S; S.init(HB_ROWS, DM, F.G, (int)blockIdx.x); pg8::EpiNull E{};
            pg8::gemm_phase<pg8::EpiNull, pg8::StaticOrder, true, true>(F.lds + RING_OFF, g, S, E, F.wave); }
#endif
#if PROBE_REP == 12
        if (IN(pb + 4)) { pg8::Gemm g{F.MRG, F.WOUT, HB_ROWS, DM, DM, PMR, PMR}; pg8::StaticOrder S; S.init(HB_ROWS, DM, F.G, (int)blockIdx.x); pg8::EpiNull E{};
            pg8::gemm_phase<pg8::EpiNull, pg8::StaticOrder, true, true>(F.lds + RING_OFF, g, S, E, F.wave); }
#endif
        if (IN(pb + 3)) REPS(6) {
            pg8::Gemm g{F.YC, F.PCAT, HB_ROWS, DM, KC, KC, KC}; pg8::StaticOrder S; S.init(HB_ROWS, DM, F.G, (int)blockIdx.x);
            pg8::EpiG2cat E{F.PA, F.MRG};
            pg8::gemm_phase<pg8::EpiG2cat, pg8::StaticOrder, true, true>(F.lds + RING_OFF, g, S, E, F.wave);
        } SEAM(pb + 3);
        if (IN(pb + 4)) REPS(7) {
            pg8::Gemm g{F.MRG, F.WOUT, HB_ROWS, DM, DM, PMR, PMR}; pg8::StaticOrder S; S.init(HB_ROWS, DM, F.G, (int)blockIdx.x);
            pg8::EpiG3 E{F.x + (size_t)row0 * DM, F.out + (size_t)row0 * DM};
            pg8::gemm_phase<pg8::EpiG3, pg8::StaticOrder, true, true>(F.lds + RING_OFF, g, S, E, F.wave);
        } if (hb == 1) SEAM(pb + 4);
    }
#undef IN
#undef SEAM
}

extern "C" void kernel_launch(void* const* d_in, const int* in_sizes, int n_in, void* d_out, int out_size, void* d_ws, size_t ws_size, hipStream_t stream) {
    static int grid = 0;
    if (grid == 0) {
        if (n_in != 20 || in_sizes[0] != MTOT * DM || out_size != MTOT * DM || ws_size < WS_END) { fprintf(stderr, "kernel_launch: unexpected shapes (n_in %d, ws %zu); nothing launched\n", n_in, ws_size); grid = -1; return; }
        int dev = 0, cus = 0, per_cu = 0;
        if (hipGetDevice(&dev) != hipSuccess || hipDeviceGetAttribute(&cus, hipDeviceAttributeMultiprocessorCount, dev) != hipSuccess) { grid = -1; return; }
        if (hipFuncSetAttribute((const void*)mega_fwd, hipFuncAttributeMaxDynamicSharedMemorySize, LDS_BYTES) != hipSuccess) { fprintf(stderr, "kernel_launch: hipFuncSetAttribute failed\n"); grid = -1; return; }
        if (hipOccupancyMaxActiveBlocksPerMultiprocessor(&per_cu, (const void*)mega_fwd, NTHR, LDS_BYTES) != hipSuccess || per_cu < 1) { fprintf(stderr, "kernel_launch: occupancy query says %d blocks per CU\n", per_cu); (void)hipGetLastError(); grid = -1; return; }
        grid = cus;
    }
    if (grid < 0) return;
    if (hipMemsetAsync((char*)d_ws + WS_CTL, 0, CTL_ZERO_BYTES, stream) != hipSuccess) return;
    Args a{};
    for (int i = 0; i < 20; ++i) a.in[i] = (const float*)d_in[i];
    a.out = (float*)d_out; a.ws = (unsigned char*)d_ws;
#if MK_PER_PHASE
    for (int p = 0; p < NPHASES; ++p) { a.ph_lo = p; a.ph_hi = p + 1; hipLaunchKernelGGL(mega_fwd, dim3(grid), dim3(NTHR), LDS_BYTES, stream, a); }
#else
    a.ph_lo = 0; a.ph_hi = NPHASES; hipLaunchKernelGGL(mega_fwd, dim3(grid), dim3(NTHR), LDS_BYTES, stream, a);
#endif
}
```

```cpp
#include <hip/hip_runtime.h>
#include <cstdint>
#include <cstdio>

constexpr int DM = 1024, NB = 32, SEQ = 2048, MTOT = NB * SEQ;
constexpr int NIN = 8960, MEML = 256, MMEM = NB * MEML;
constexpr int HB_ROWS = MTOT / 2;
constexpr int C_AU = 0, C_AV = 768, C_AZ = 1536, C_BQ = 2304, C_BK = 3072, C_BV = 3840, C_BZ = 4608, C_MQ = 4864, C_MZ = 5376, C_G = 5888;
constexpr float EPS = 1e-6f;
constexpr int SS_W = 112;
constexpr int PAP = 7424;
constexpr int PA_ROWB = 2 * PAP, PA_GOFF = 2 * C_G;
constexpr int N8 = 6656;
__host__ __device__ constexpr int i8col(int n) { return n >= C_G ? n - C_G : (n >= C_BQ && n < C_BZ) ? n - C_BQ + 3072 : (n >= C_AV && n < C_AZ) ? n - C_AV + 5376 : (n >= C_MQ && n < C_MZ) ? n - C_MQ + 6144 : -1; }
__host__ __device__ constexpr int i8src(int c8) { return c8 < 3072 ? C_G + c8 : c8 < 5376 ? C_BQ + (c8 - 3072) : c8 < 6144 ? C_AV + (c8 - 5376) : C_MQ + (c8 - 6144); }
__host__ __device__ constexpr int i8tile_pn(int t8) { return t8 < 12 ? 23 + t8 : t8 < 21 ? 9 + (t8 - 12) : t8 < 24 ? 3 + (t8 - 21) : 19 + (t8 - 24); }
constexpr int KC = 1536;

constexpr size_t MiB = 1u << 20;
constexpr size_t WS_CTL = 0, CTL_ZERO_BYTES = 64 * 1024, WS_WIN = 2 * MiB, WS_PCAT = 22 * MiB, WS_WOUT = 25 * MiB, WS_WSP = 27 * MiB, WS_BIAS = 27 * MiB + 512 * 1024;
constexpr size_t WS_XN = 32 * MiB, WS_PA = 176 * MiB, WS_KVM = 736 * MiB, WS_SS = 752 * MiB, WS_MKSS = 766 * MiB, WS_OG = 768 * MiB, WS_LSE = 816 * MiB, WS_LNST = 818 * MiB;
constexpr size_t WS_YC = 820 * MiB, WS_MRG = 916 * MiB, WS_END = 980 * MiB;
constexpr int P8 = 1152;
constexpr size_t WS_XN8 = 640 * MiB, WS_W8 = 712 * MiB, WS_CS = 720 * MiB, WS_RS = 721 * MiB;
constexpr int CW_CMAX = 8192;
constexpr int CW_BAR = 4096;

__device__ __forceinline__ float xl_swap32(float x, bool mx) { const unsigned u = __builtin_bit_cast(unsigned, x); const auto r = __builtin_amdgcn_permlane32_swap(u, u, false, false); const unsigned a = r[0], b = r[1];
    const float fa = __builtin_bit_cast(float, a), fb = __builtin_bit_cast(float, b); return mx ? fmaxf(fa, fb) : fa + fb; }
__device__ __forceinline__ float xl_swap16(float x) { const unsigned u = __builtin_bit_cast(unsigned, x); const auto r = __builtin_amdgcn_permlane16_swap(u, u, false, false); const unsigned a = r[0], b = r[1];
    return __builtin_bit_cast(float, a) + __builtin_bit_cast(float, b); }
__device__ __forceinline__ float sum_x32(float x) { return xl_swap32(x, false); }
__device__ __forceinline__ float max_x32(float x) { return xl_swap32(x, true); }
__device__ __forceinline__ float sum_x16_x32(float x) { return xl_swap32(xl_swap16(x), false); }
template <int CTRL> __device__ __forceinline__ float dpp_f(float x) { return __builtin_bit_cast(float, __builtin_amdgcn_update_dpp(0, __builtin_bit_cast(int, x), CTRL, 0xf, 0xf, true)); }
__device__ __forceinline__ float sum_quad(float x) { x += dpp_f<0xB1>(x); return x + dpp_f<0x4E>(x); }
namespace pg8 {
#define PG8_LAS __attribute__((address_space(3)))
typedef unsigned short bf16_t;
typedef short bf16x8 __attribute__((ext_vector_type(8)));
typedef float f32x4 __attribute__((ext_vector_type(4)));
typedef unsigned u32x4 __attribute__((ext_vector_type(4)));
constexpr int BM = 256, BK = 64, HALF = 128, HTB = HALF * BK * 2  , STAGE_BYTES = 8 * HTB, NXCD = 8, WGM = 8;

__host__ __device__ __forceinline__ int lds_byte(int r, int c) { const int st = (r >> 4) * 2 + (c >> 5), rr = r & 15, cc = c & 31, ob = rr * 64 + cc * 2; return st * 1024 + (ob ^ (((ob >> 9) & 1) << 5)); }
__host__ __device__ __forceinline__ void stage_rc(int b, int& R, int& C) { const int st = b / 1024, sb = b % 1024, swz = sb ^ (((sb >> 9) & 1) << 5); R = (st >> 1) * 16 + swz / 64; C = (st & 1) * 32 + (swz % 64) / 2; }
__host__ __device__ __forceinline__ int perm32(int rho) { const int n = rho >> 4, i = rho & 15; return 8 * (i >> 2) + 4 * n + (i & 3); }

struct Unit { int pm, pn; };
struct Gemm { const bf16_t* A; const bf16_t* Bt; int M, N, K, lda, ldb; };

struct StaticOrder {
    int nM, nN, nwg, G, c;
    __host__ __device__ void init(int M, int N, int G_, int c_) { nM = M / BM; nN = N / BM; nwg = nM * nN; G = G_; c = c_; }
    __host__ __device__ bool next(int i, Unit& u) const {
        const long L = (long)i * G + c; if (L >= nwg) return false;
        int wgid = (int)L; { const int q = nwg / NXCD, r = nwg % NXCD, xcd = wgid % NXCD, off = wgid / NXCD; wgid = (xcd < r ? xcd * (q + 1) : r * (q + 1) + (xcd - r) * q) + off; }
        const int nig = WGM * nN, gid = wgid / nig, fm = gid * WGM, gsz = (nM - fm) < WGM ? (nM - fm) : WGM;
        u.pm = fm + ((wgid % nig) % gsz); u.pn = (wgid % nig) / gsz; return true;
    }
    __device__ __forceinline__ void a_ready(const Unit&) const {}
    __device__ __forceinline__ void done(const Unit&) const {}
};


typedef float f32x2c_t __attribute__((ext_vector_type(2))); typedef __bf16 bf16x2c_t __attribute__((ext_vector_type(2)));
__device__ __forceinline__ unsigned cvt_pk_bf16(float lo, float hi) { const f32x2c_t v = {lo, hi}; const bf16x2c_t b = __builtin_convertvector(v, bf16x2c_t); return __builtin_bit_cast(unsigned, b); }
typedef float f32x2 __attribute__((ext_vector_type(2)));
__device__ __forceinline__ f32x2 gelu_pk(f32x2 v) {
    const f32x2 av = __builtin_elementwise_abs(v), d = av * 0.2316418882f + 1.0f;
    f32x2 t; t.x = __builtin_amdgcn_rcpf(d.x); t.y = __builtin_amdgcn_rcpf(d.y);
    f32x2 q = t * 0.5307027145f + (-0.7265760135f); q = q * t + 0.7107068705f; q = q * t + (-0.142248368f); q = q * t + 0.127414796f; q = q * t;
    const f32x2 s = (v * v) * (-0.72134752044f);
    f32x2 e; e.x = __builtin_amdgcn_exp2f(s.x); e.y = __builtin_amdgcn_exp2f(s.y);
    const f32x2 m = v * (q * e), r = v - m;
    f32x2 o; o.x = v.x < 0.f ? m.x : r.x; o.y = v.y < 0.f ? m.y : r.y; return o;
}

typedef int i32x4 __attribute__((ext_vector_type(4)));
template <bool I8> __device__ __forceinline__ f32x4 mma16(bf16x8 a, bf16x8 b, f32x4 c) {
    if constexpr (I8) return __builtin_bit_cast(f32x4, __builtin_amdgcn_mfma_i32_16x16x64_i8(__builtin_bit_cast(i32x4, a), __builtin_bit_cast(i32x4, b), __builtin_bit_cast(i32x4, c), 0, 0, 0));
    else return __builtin_amdgcn_mfma_f32_16x16x32_bf16(a, b, c, 0, 0, 0);
}
template <class Epi, class Sched, bool ALIGN_EPI = false, bool SP2 = false, bool I8 = false>
__device__ __forceinline__ void gemm_phase(PG8_LAS unsigned char* lds, const Gemm g, const Sched& S, const Epi& E, const int wave_id) {
    int tid; asm volatile("v_mbcnt_lo_u32_b32 %0, -1, 0\n\tv_mbcnt_hi_u32_b32 %0, -1, %0" : "=v"(tid)); tid += wave_id * 64;
    const int wid = __builtin_amdgcn_readfirstlane(tid >> 6), lane = tid & 63, wr = wid >> 2, wc = wid & 3, fr = lane & 15, fq = lane >> 4;
    int K = g.K; asm volatile("" : "+s"(K)); const int nt = K / BK;
    unsigned voffA[2], voffB[2];
#pragma unroll
    for (int i = 0; i < 2; ++i) { int R, C; stage_rc(tid * 16 + i * 8192, R, C); const int Rb = Epi::PERM ? ((R & ~31) + perm32(R & 31)) : R;
        voffA[i] = (unsigned)(R * g.lda + C) * 2u; voffB[i] = (unsigned)(Rb * g.ldb + C) * 2u; }
    const size_t kstep = (size_t)(BK * 2);
    const size_t hstepA = (size_t)HALF * g.lda * 2, hstepB = (size_t)HALF * g.ldb * 2;
    const size_t tstepA = 2 * hstepA, tstepB = 2 * hstepB;
    const unsigned ldsw = (unsigned)wid * 1024u;
    const int aoff = lds_byte(wr * 64 + fr, fq * 8), boff = lds_byte(wc * 32 + fr, fq * 8);
#define PG8_SA(b, h) (((b) * 2 + (h)) * HTB)
#define PG8_SB(b, h) ((4 + (b) * 2 + (h)) * HTB)
#define PG8_STAGE(bufoff, gbase, voff) do { _Pragma("unroll") for (int _i = 0; _i < 2; ++_i) \
        __builtin_amdgcn_global_load_lds((const unsigned*)((const char*)(gbase) + (voff)[_i]), (PG8_LAS unsigned*)(lds + (bufoff) + ldsw + _i * 8192), 16, 0, 0); } while (0)
#define PG8_LDA(dst, b, h) do { _Pragma("unroll") for (int m = 0; m < 4; ++m) _Pragma("unroll") for (int k = 0; k < 2; ++k) dst[m][k] = *(const PG8_LAS bf16x8*)(lds + PG8_SA(b, h) + aoff + m * 2048 + k * 1024); } while (0)
#define PG8_LDB(dst, b, h) do { _Pragma("unroll") for (int n = 0; n < 2; ++n) _Pragma("unroll") for (int k = 0; k < 2; ++k) dst[n][k] = *(const PG8_LAS bf16x8*)(lds + PG8_SB(b, h) + boff + n * 2048 + k * 1024); } while (0)
#define PG8_MMA(ai, bj, At, Bt) do { __builtin_amdgcn_s_setprio(1); _Pragma("unroll") for (int m = 0; m < 4; ++m) _Pragma("unroll") for (int n = 0; n < 2; ++n) _Pragma("unroll") for (int k = 0; k < 2; ++k) \
        acc[ai][bj][m][n] = mma16<I8>(Bt[n][k], At[m][k], acc[ai][bj][m][n]); __builtin_amdgcn_s_setprio(0); } while (0)
#define PG8_WAIT_V(n) asm volatile("s_waitcnt vmcnt(" #n ")" ::: "memory")
#define PG8_WAIT_L(n) asm volatile("s_waitcnt lgkmcnt(" #n ")" ::: "memory")
#define PG8_BAR __builtin_amdgcn_s_barrier()
#define PG8_SCHED __builtin_amdgcn_sched_barrier(0)
    Unit cur, nxt; int ui = 0;
    if (!S.next(0, cur)) return;
    f32x4 acc[2][2][4][2];
#pragma unroll
    for (int a = 0; a < 2; ++a)
#pragma unroll
        for (int b = 0; b < 2; ++b)
#pragma unroll
            for (int m = 0; m < 4; ++m)
#pragma unroll
                for (int n = 0; n < 2; ++n) acc[a][b][m][n] = (f32x4){0.f, 0.f, 0.f, 0.f};
    bf16x8 At[4][2], B0[2][2], B1[2][2];
    const char* cA = (const char*)g.A + (size_t)cur.pm * tstepA; const char* cB = (const char*)g.Bt + (size_t)cur.pn * tstepB;
    S.a_ready(cur);
    if constexpr (I8) E.stage_scales(cur, 0, wid, lane);
    if constexpr (SP2) {
        PG8_STAGE(PG8_SB(0, 0), cB, voffB); PG8_STAGE(PG8_SB(0, 1), cB + hstepB, voffB); PG8_STAGE(PG8_SA(0, 0), cA, voffA); PG8_STAGE(PG8_SA(0, 1), cA + hstepA, voffA);
        if (wr == 1) PG8_BAR;
        PG8_WAIT_V(2); PG8_BAR;
        PG8_STAGE(PG8_SB(1, 0), cB + kstep, voffB); PG8_STAGE(PG8_SA(1, 0), cA + kstep, voffA); PG8_STAGE(PG8_SB(1, 1), cB + hstepB + kstep, voffB);
        PG8_WAIT_V(6); PG8_BAR;
    } else {
        PG8_STAGE(PG8_SB(0, 0), cB, voffB); PG8_STAGE(PG8_SA(0, 0), cA, voffA); PG8_STAGE(PG8_SB(0, 1), cB + hstepB, voffB); PG8_STAGE(PG8_SA(0, 1), cA + hstepA, voffA);
        if (wr == 1) PG8_BAR;
        PG8_WAIT_V(4); PG8_BAR;
        PG8_STAGE(PG8_SB(1, 0), cB + kstep, voffB); PG8_STAGE(PG8_SA(1, 0), cA + kstep, voffA); PG8_STAGE(PG8_SB(1, 1), cB + hstepB + kstep, voffB);
        PG8_WAIT_V(6); PG8_BAR;
    }
    for (;;) {
        const bool has_next = S.next(ui + 1, nxt);
        const char* nA = has_next ? (const char*)g.A + (size_t)nxt.pm * tstepA : cA; const char* nB = has_next ? (const char*)g.Bt + (size_t)nxt.pn * tstepB : cB;
        for (int t = 0; t < nt; t += 2) {
            if constexpr (Epi::KHOOK) { if (t == Epi::KH1 || t == Epi::KH2) {
                if constexpr (ALIGN_EPI) { if (wr == 0) PG8_BAR; }
                E.khook(acc, cur, t, wr, wc, fr, fq);
                if constexpr (ALIGN_EPI) { if (wr == 1) PG8_BAR; } } }
            const bool last = (t == nt - 2);
            const char* a1 = cA + (size_t)(t + 1) * kstep;
            const char* a2 = last ? nA : cA + (size_t)(t + 2) * kstep; const char* b2 = last ? nB : cB + (size_t)(t + 2) * kstep;
            const char* a3 = a2 + kstep; const char* b3 = b2 + kstep;
            if (last && has_next) S.a_ready(nxt);
            if constexpr (I8) { if (last && has_next) E.stage_scales(nxt, (ui + 1) & 1, wid, lane); }
            if constexpr (SP2) {
            PG8_LDB(B0, 0, 0); PG8_LDB(B1, 0, 1); PG8_SCHED; PG8_LDA(At, 0, 0); PG8_STAGE(PG8_SA(1, 1), a1 + hstepA, voffA);
            PG8_WAIT_V(8); PG8_WAIT_L(0); PG8_BAR; PG8_MMA(0, 0, At, B0); PG8_MMA(0, 1, At, B1); PG8_BAR; PG8_SCHED;
            PG8_LDA(At, 0, 1); PG8_STAGE(PG8_SB(0, 0), b2, voffB); PG8_STAGE(PG8_SB(0, 1), b2 + hstepB, voffB); PG8_STAGE(PG8_SA(0, 0), a2, voffA);
            PG8_WAIT_V(8); PG8_WAIT_L(0); PG8_BAR; PG8_MMA(1, 0, At, B0); PG8_MMA(1, 1, At, B1); PG8_BAR; PG8_SCHED;
            PG8_LDB(B0, 1, 0); PG8_LDB(B1, 1, 1); PG8_SCHED; PG8_LDA(At, 1, 0); PG8_STAGE(PG8_SA(0, 1), a2 + hstepA, voffA);
            PG8_WAIT_V(8); PG8_WAIT_L(0); PG8_BAR; PG8_MMA(0, 0, At, B0); PG8_MMA(0, 1, At, B1); PG8_BAR; PG8_SCHED;
            PG8_LDA(At, 1, 1); PG8_STAGE(PG8_SB(1, 0), b3, voffB); PG8_STAGE(PG8_SB(1, 1), b3 + hstepB, voffB); PG8_STAGE(PG8_SA(1, 0), a3, voffA);
            PG8_WAIT_V(8); PG8_WAIT_L(0); PG8_BAR; PG8_MMA(1, 0, At, B0); PG8_MMA(1, 1, At, B1); PG8_BAR; PG8_SCHED;
            } else {
            PG8_LDB(B0, 0, 0); PG8_SCHED; PG8_LDA(At, 0, 0); PG8_STAGE(PG8_SA(1, 1), a1 + hstepA, voffA);
            PG8_WAIT_L(8); PG8_BAR; PG8_WAIT_L(0); PG8_MMA(0, 0, At, B0); PG8_BAR; PG8_SCHED;
            PG8_LDB(B1, 0, 1); PG8_STAGE(PG8_SB(0, 0), b2, voffB);
            PG8_BAR; PG8_WAIT_L(0); PG8_MMA(0, 1, At, B1); PG8_BAR;
            PG8_LDA(At, 0, 1); PG8_STAGE(PG8_SA(0, 0), a2, voffA);
            PG8_BAR; PG8_WAIT_L(0); PG8_MMA(1, 0, At, B0); PG8_BAR; PG8_SCHED;
            PG8_STAGE(PG8_SB(0, 1), b2 + hstepB, voffB);
            PG8_WAIT_V(6); PG8_BAR; PG8_MMA(1, 1, At, B1); PG8_BAR;
            PG8_LDB(B0, 1, 0); PG8_SCHED; PG8_LDA(At, 1, 0); PG8_STAGE(PG8_SA(0, 1), a2 + hstepA, voffA);
            PG8_WAIT_L(8); PG8_BAR; PG8_WAIT_L(0); PG8_MMA(0, 0, At, B0); PG8_BAR; PG8_SCHED;
            PG8_LDB(B1, 1, 1); PG8_STAGE(PG8_SB(1, 0), b3, voffB);
            PG8_BAR; PG8_WAIT_L(0); PG8_MMA(0, 1, At, B1); PG8_BAR;
            PG8_LDA(At, 1, 1); PG8_STAGE(PG8_SA(1, 0), a3, voffA);
            PG8_BAR; PG8_WAIT_L(0); PG8_MMA(1, 0, At, B0); PG8_BAR; PG8_SCHED;
            PG8_STAGE(PG8_SB(1, 1), b3 + hstepB, voffB);
            PG8_WAIT_V(6); PG8_BAR; PG8_MMA(1, 1, At, B1); PG8_BAR;
            }
        }
        if constexpr (ALIGN_EPI) { if (wr == 0) PG8_BAR; }
        if constexpr (I8) { _Pragma("unroll") for (int a_ = 0; a_ < 2; ++a_) _Pragma("unroll") for (int b_ = 0; b_ < 2; ++b_) _Pragma("unroll") for (int m_ = 0; m_ < 4; ++m_) _Pragma("unroll") for (int n_ = 0; n_ < 2; ++n_) acc[a_][b_][m_][n_] = __builtin_convertvector(__builtin_bit_cast(i32x4, acc[a_][b_][m_][n_]), f32x4); }
        if constexpr (I8) { E.epi8(acc, cur, ui & 1, wr, wc, fr, fq); S.done(cur); }
        else if constexpr (!Epi::AFTER_DRAIN) { E(acc, cur, wr, wc, fr, fq); S.done(cur); }
        if (!has_next) break;
#pragma unroll
        for (int a = 0; a < 2; ++a)
#pragma unroll
            for (int b = 0; b < 2; ++b)
#pragma unroll
                for (int m = 0; m < 4; ++m)
#pragma unroll
                    for (int n = 0; n < 2; ++n) { f32x2 z0, z1; asm volatile("v_mov_b64 %0, 0\n\tv_mov_b64 %1, 0" : "=v"(z0), "=v"(z1)); acc[a][b][m][n] = (f32x4){z0.x, z0.y, z1.x, z1.y}; }
        cur = nxt; cA = nA; cB = nB; ++ui;
        if constexpr (ALIGN_EPI) { if (wr == 1) PG8_BAR; }
    }
    PG8_WAIT_V(0);
    if constexpr (!ALIGN_EPI) { if (wr == 0) PG8_BAR; }
    PG8_BAR;
    if constexpr (Epi::AFTER_DRAIN) { E.fused(acc, cur, wr, wc, fr, fq, lds, wid, lane); S.done(cur); }
#undef PG8_SA
#undef PG8_SB
#undef PG8_STAGE
#undef PG8_LDA
#undef PG8_LDB
#undef PG8_MMA
#undef PG8_WAIT_V
#undef PG8_WAIT_L
#undef PG8_BAR
#undef PG8_SCHED
}
}

#ifndef G1_EPI_DRAIN
#define G1_EPI_DRAIN 0
#endif
#ifndef G1_STORE_AUX_MIX
#define G1_STORE_AUX_MIX 2
#endif
#ifndef G1_STORE_AUX
#define G1_STORE_AUX 2
#endif
namespace pg8 {
__device__ __forceinline__ int gate_srow(int wr, int wc, int ai, int m, int bj, int fq) { return 2 * ((((wr * 4 + wc) * 2 + ai) * 4 + m) * 2 + bj) + (fq >> 1); }
__device__ __forceinline__ float ubf0(unsigned w) { return (float)(w & 0xffu); }
__device__ __forceinline__ float ubf1(unsigned w) { return (float)((w >> 8) & 0xffu); }
__device__ __forceinline__ float ubf2(unsigned w) { return (float)((w >> 16) & 0xffu); }
__device__ __forceinline__ float ubf3(unsigned w) { return (float)(w >> 24); }
__device__ __forceinline__ float ex2(float x) { return __builtin_amdgcn_exp2f(x); }
__device__ __forceinline__ float sigm_fast(float x) { return __builtin_amdgcn_rcpf(1.0f + ex2(x * -1.4426950408889634f)); }
template <int MODE = 0  > struct EpiProjT {
    static constexpr bool PERM = true, AFTER_DRAIN = false, KHOOK = false;
    bf16_t* PA; bf16_t* KVM; float* SS; float* MKSS; const float* gate_b; int pm0; int pad;
    template <int KIND, int STAT> __device__ __forceinline__ void body(const f32x4 (&acc)[2][2][4][2], const __amdgpu_buffer_rsrc_t rsrc, int row0, int col0, int ldc, float* sb, int sld, int so, const float* bias, int wc, int fq) const {
        f32x4 bv[2][2];
        if (KIND == 3) {
#pragma unroll
            for (int bj = 0; bj < 2; ++bj)
#pragma unroll
                for (int n = 0; n < 2; ++n) bv[bj][n] = *(const f32x4*)(bias + bj * HALF + 4 * n);
        }
#pragma unroll
        for (int ai = 0; ai < 2; ++ai)
#pragma unroll
            for (int m = 0; m < 4; ++m) { const int row = row0 + ai * HALF + m * 16; const unsigned rowoff = ((unsigned)row * (unsigned)ldc + (unsigned)col0) * 2u;
#pragma unroll
                for (int bj = 0; bj < 2; ++bj) { f32x4 v0 = acc[ai][bj][m][0], v1 = acc[ai][bj][m][1];
                    if (KIND == 1) { f32x2 a = gelu_pk((f32x2){v0[0], v0[1]}), b = gelu_pk((f32x2){v0[2], v0[3]}), c = gelu_pk((f32x2){v1[0], v1[1]}), d = gelu_pk((f32x2){v1[2], v1[3]});
                        v0 = (f32x4){a.x, a.y, b.x, b.y}; v1 = (f32x4){c.x, c.y, d.x, d.y}; }
                    else if (KIND == 2) {
#pragma unroll
                        for (int j = 0; j < 4; ++j) { v0[j] = v0[j] * sigm_fast(v0[j]); v1[j] = v1[j] * sigm_fast(v1[j]); } }
                    else if (KIND == 3) { v0 = v0 + bv[bj][0]; v1 = v1 + bv[bj][1];
#pragma unroll
                        for (int j = 0; j < 4; ++j) { v0[j] = sigm_fast(v0[j]); v1[j] = sigm_fast(v1[j]); } }
                    if (STAT) {
                        float s = ((v0[0] + v0[1]) + (v0[2] + v0[3])) + ((v1[0] + v1[1]) + (v1[2] + v1[3]));
                        float q = ((v0[0] * v0[0] + v0[1] * v0[1]) + (v0[2] * v0[2] + v0[3] * v0[3])) + ((v1[0] * v1[0] + v1[1] * v1[1]) + (v1[2] * v1[2] + v1[3] * v1[3]));
                        if (STAT == 2) s = sum_x16_x32(s);
                        q = sum_x16_x32(q);
                        if (fq == 0) { float* sp = sb + (size_t)row * sld + so; const int blk = 4 * bj + wc;
                            if (STAT == 2) { sp[2 * blk] = s; sp[2 * blk + 1] = q; } else sp[blk] = q; }
                    }
                    u32x4 w; w.x = cvt_pk_bf16(v0[0], v0[1]); w.y = cvt_pk_bf16(v0[2], v0[3]); w.z = cvt_pk_bf16(v1[0], v1[1]); w.w = cvt_pk_bf16(v1[2], v1[3]);
                    if (MODE == 2) asm volatile("" :: "v"(w)); else __builtin_amdgcn_raw_buffer_store_b128(w, rsrc, (int)(rowoff + bj * HALF * 2), 0, KIND == 3 ? G1_STORE_AUX : G1_STORE_AUX_MIX); } }
    }
    __device__ __forceinline__ void uz_body(const f32x4 (&acc)[2][2][4][2], const __amdgpu_buffer_rsrc_t rsrc, int row0, int ucol0) const {
#pragma unroll
        for (int ai = 0; ai < 2; ++ai)
#pragma unroll
            for (int m = 0; m < 4; ++m) { const int row = row0 + ai * HALF + m * 16;
                f32x4 u0 = acc[ai][0][m][0], u1 = acc[ai][0][m][1]; const f32x4 z0 = acc[ai][1][m][0], z1 = acc[ai][1][m][1];
                { f32x2 a = gelu_pk((f32x2){u0[0], u0[1]}), b = gelu_pk((f32x2){u0[2], u0[3]}), c = gelu_pk((f32x2){u1[0], u1[1]}), d = gelu_pk((f32x2){u1[2], u1[3]});
                  u0 = (f32x4){a.x, a.y, b.x, b.y}; u1 = (f32x4){c.x, c.y, d.x, d.y}; }
#pragma unroll
                for (int j = 0; j < 4; ++j) { u0[j] *= z0[j] * sigm_fast(z0[j]); u1[j] *= z1[j] * sigm_fast(z1[j]); }
                u32x4 w; w.x = cvt_pk_bf16(u0[0], u0[1]); w.y = cvt_pk_bf16(u0[2], u0[3]); w.z = cvt_pk_bf16(u1[0], u1[1]); w.w = cvt_pk_bf16(u1[2], u1[3]);
                if (MODE == 2) asm volatile("" :: "v"(w)); else __builtin_amdgcn_raw_buffer_store_b128(w, rsrc, (int)((unsigned)row * (unsigned)PA_ROWB + (unsigned)(2 * (C_AU + ucol0))), 0, G1_STORE_AUX_MIX); }
    }
    __device__ __forceinline__ void gate_body(const f32x4 (&acc)[2][2][4][2], const __amdgpu_buffer_rsrc_t rsrc, int row0, int gcol0, const float* bias) const {
        f32x4 bv[2][2];
#pragma unroll
        for (int bj = 0; bj < 2; ++bj)
#pragma unroll
            for (int n = 0; n < 2; ++n) bv[bj][n] = *(const f32x4*)(bias + 8 * bj + 4 * n);
#pragma unroll
        for (int ai = 0; ai < 2; ++ai)
#pragma unroll
            for (int m = 0; m < 4; ++m) { const int row = row0 + ai * HALF + m * 16; u32x4 w;
#pragma unroll
                for (int bj = 0; bj < 2; ++bj)
#pragma unroll
                    for (int n = 0; n < 2; ++n) { const f32x4 v = acc[ai][bj][m][n] + bv[bj][n]; unsigned d = 0u;
#pragma unroll
                        for (int j = 0; j < 4; ++j) d |= (unsigned)(fmaxf(sigm_fast(v[j]) * 255.0f, 1.0f) + 0.5f) << (8 * j);
                        w[2 * bj + n] = d; }
                if (MODE == 2) asm volatile("" :: "v"(w)); else __builtin_amdgcn_raw_buffer_store_b128(w, rsrc, (int)((unsigned)row * (unsigned)PA_ROWB + (unsigned)(PA_GOFF + gcol0)), 0, G1_STORE_AUX); }
    }
    __device__ __forceinline__ void operator()(const f32x4 (&acc)[2][2][4][2], const Unit& u, int wr, int wc, int fr, int fq) const {
        const bool kv = u.pn >= 35; const int pn = kv ? u.pn - 35 : u.pn;
        const int rowt = kv ? (u.pm - 256) * BM : (u.pm - pm0) * BM;
        bf16_t* base = kv ? KVM : PA; const int ldc = kv ? 1024 : PAP;
        const __amdgpu_buffer_rsrc_t rsrc = __builtin_amdgcn_make_buffer_rsrc(base, 0, kv ? (int)((size_t)MMEM * 1024 * 2) : (int)((size_t)HB_ROWS * PA_ROWB), 0x00020000);
        const int row0 = rowt + wr * 64 + fr, col0 = pn * BM + wc * 32 + 8 * fq;
        if (MODE == 1) { body<0, 0>(acc, rsrc, row0, col0, ldc, SS, SS_W, 0, gate_b, wc, fq); return; }
        if (kv) { if (pn < 2) body<0, 1>(acc, rsrc, row0, col0, ldc, MKSS, 16, 8 * pn, gate_b, wc, fq); else body<0, 0>(acc, rsrc, row0, col0, ldc, SS, SS_W, 0, gate_b, wc, fq); }
        else if (pn < 3) uz_body(acc, rsrc, row0, 128 * pn + 32 * wc + 8 * fq);
        else if (pn < 6) body<1, 2>(acc, rsrc, row0, col0, ldc, SS, SS_W, 16 * (pn - 3), gate_b, wc, fq);
        else if (pn < 9) uz_body(acc, rsrc, row0, 128 * (pn - 3) + 32 * wc + 8 * fq);
        else if (pn < 12) body<0, 1>(acc, rsrc, row0, col0, ldc, SS, SS_W, 48 + 8 * (pn - 9), gate_b, wc, fq);
        else if (pn < 15) body<0, 1>(acc, rsrc, row0, col0, ldc, SS, SS_W, 72 + 8 * (pn - 12), gate_b, wc, fq);
        else if (pn < 18) body<0, 0>(acc, rsrc, row0, col0, ldc, SS, SS_W, 0, gate_b, wc, fq);
        else if (pn < 19) body<2, 0>(acc, rsrc, row0, col0, ldc, SS, SS_W, 0, gate_b, wc, fq);
        else if (pn < 21) body<0, 1>(acc, rsrc, row0, col0, ldc, SS, SS_W, 96 + 8 * (pn - 19), gate_b, wc, fq);
        else if (pn < 23) body<2, 0>(acc, rsrc, row0, col0, ldc, SS, SS_W, 0, gate_b, wc, fq);
        else { const int gc = (pn - 23) * BM + 64 * wc + 16 * fq; gate_body(acc, rsrc, row0, gc, gate_b + gc); }
#if G1_EPI_DRAIN
        asm volatile("s_waitcnt vmcnt(0)" ::: "memory");
#endif
    }
};
typedef EpiProjT<0> EpiProj;
template <bool HOOKS = true, bool EPI = true> struct EpiG2catT {
    static constexpr bool PERM = true, AFTER_DRAIN = false, KHOOK = HOOKS; static constexpr int KH1 = 12, KH2 = 16;
    const bf16_t* PA; bf16_t* MRG;
    __device__ __forceinline__ void khook(f32x4 (&acc)[2][2][4][2], const Unit& u, int t, int wr, int wc, int fr, int fq) const {
        typedef unsigned u32x2v __attribute__((ext_vector_type(2)));
        const int ga = t == KH1 ? 0 : 1;
        const __amdgpu_buffer_rsrc_t grs = __builtin_amdgcn_make_buffer_rsrc((void*)PA, 0, (int)((size_t)HB_ROWS * PA_ROWB), 0x00020000);
        const int gvo = (u.pm * BM + gate_srow(wr, wc, 0, 0, 0, fq)) * PA_ROWB + PA_GOFF + ga * DM + u.pn * BM + 16 * fr + 8 * (fq & 1);
        u32x2v ag[2][4][2], bg[2][4][2];
#pragma unroll
        for (int ai = 0; ai < 2; ++ai)
#pragma unroll
            for (int m = 0; m < 4; ++m)
#pragma unroll
                for (int bj = 0; bj < 2; ++bj) { const int so = gate_srow(0, 0, ai, m, bj, 0) * PA_ROWB; ag[ai][m][bj] = __builtin_bit_cast(u32x2v, __builtin_amdgcn_raw_buffer_load_b64(grs, gvo, so, 0)); bg[ai][m][bj] = __builtin_bit_cast(u32x2v, __builtin_amdgcn_raw_buffer_load_b64(grs, gvo + DM, so, 0)); }
        __builtin_amdgcn_sched_barrier(0);
#define G2_R(A, Bv, K) (ubf##K(A) * __builtin_amdgcn_rcpf(ubf##K(Bv)))
#pragma unroll
        for (int ai = 0; ai < 2; ++ai)
#pragma unroll
            for (int m = 0; m < 4; ++m)
#pragma unroll
                for (int bj = 0; bj < 2; ++bj) { const u32x2v a = ag[ai][m][bj], b = bg[ai][m][bj]; f32x4 r0, r1;
                    r0[0] = G2_R(a.x, b.x, 0); r0[1] = G2_R(a.x, b.x, 1); r0[2] = G2_R(a.x, b.x, 2); r0[3] = G2_R(a.x, b.x, 3);
                    r1[0] = G2_R(a.y, b.y, 0); r1[1] = G2_R(a.y, b.y, 1); r1[2] = G2_R(a.y, b.y, 2); r1[3] = G2_R(a.y, b.y, 3);
                    acc[ai][bj][m][0] *= r0; acc[ai][bj][m][1] *= r1; }
#undef G2_R
    }
    __device__ __forceinline__ void operator()(const f32x4 (&acc)[2][2][4][2], const Unit& u, int wr, int wc, int fr, int fq) const {
        typedef unsigned u32x2v __attribute__((ext_vector_type(2)));
        if (!EPI) { _Pragma("unroll") for (int ai = 0; ai < 2; ++ai) _Pragma("unroll") for (int bj = 0; bj < 2; ++bj) _Pragma("unroll") for (int m = 0; m < 4; ++m) asm volatile("" :: "v"(acc[ai][bj][m][0]), "v"(acc[ai][bj][m][1])); return; }
        const int row0 = u.pm * BM + wr * 64 + fr, col0 = u.pn * BM + wc * 32 + 8 * fq;
        const __amdgpu_buffer_rsrc_t grs = __builtin_amdgcn_make_buffer_rsrc((void*)PA, 0, (int)((size_t)HB_ROWS * PA_ROWB), 0x00020000);
        const int gvo = (u.pm * BM + gate_srow(wr, wc, 0, 0, 0, fq)) * PA_ROWB + PA_GOFF + 2 * DM + u.pn * BM + 16 * fr + 8 * (fq & 1);
        u32x2v gv[2][4][2];
#pragma unroll
        for (int ai = 0; ai < 2; ++ai)
#pragma unroll
            for (int m = 0; m < 4; ++m)
#pragma unroll
                for (int bj = 0; bj < 2; ++bj) gv[ai][m][bj] = __builtin_bit_cast(u32x2v, __builtin_amdgcn_raw_buffer_load_b64(grs, gvo, gate_srow(0, 0, ai, m, bj, 0) * PA_ROWB, 0));
        __builtin_amdgcn_sched_barrier(0);
        const float q = 1.0f / 255.0f;
#pragma unroll
        for (int ai = 0; ai < 2; ++ai)
#pragma unroll
            for (int m = 0; m < 4; ++m) { bf16_t* mp = MRG + (size_t)(row0 + ai * HALF + m * 16) * DM + col0;
#pragma unroll
                for (int bj = 0; bj < 2; ++bj) { const u32x2v g = gv[ai][m][bj]; const f32x4 v0 = acc[ai][bj][m][0] * q, v1 = acc[ai][bj][m][1] * q; u32x4 w;
                    w.x = cvt_pk_bf16(v0[0] * ubf0(g.x), v0[1] * ubf1(g.x)); w.y = cvt_pk_bf16(v0[2] * ubf2(g.x), v0[3] * ubf3(g.x));
                    w.z = cvt_pk_bf16(v1[0] * ubf0(g.y), v1[1] * ubf1(g.y)); w.w = cvt_pk_bf16(v1[2] * ubf2(g.y), v1[3] * ubf3(g.y));
                    *(u32x4*)(mp + bj * HALF) = w; } }
    }
};
typedef EpiG2catT<true, true> EpiG2cat;
struct EpiG3 {
    static constexpr bool PERM = false, AFTER_DRAIN = false, KHOOK = false;
    const float* x; float* out;
    static __device__ __forceinline__ f32x4 pairx(f32x4 keep, f32x4 other, bool take) { f32x4 r;
#pragma unroll
        for (int j = 0; j < 4; ++j) { const float kj = keep[j], oj = other[j]; const float t = __builtin_bit_cast(float, __builtin_amdgcn_update_dpp(0, __builtin_bit_cast(int, oj), 0xB1, 0xf, 0xf, true)); r[j] = take ? t : kj; }
        return r; }
    __device__ __forceinline__ void operator()(const f32x4 (&acc)[2][2][4][2], const Unit& u, int wr, int wc, int fr, int fq) const {
        __builtin_amdgcn_s_waitcnt(0xC07F);
        const bool odd = fr & 1;
        const int row0 = u.pm * BM + wr * 64 + fr, col0 = u.pn * BM + wc * 32 + 4 * fq;
        const size_t lbase = (size_t)(row0 & ~1) * DM + col0 + (odd ? 16 : 0);
        f32x4 xa[2][2][2], xb[2][2][2];
#define G3_LOAD(B) do { _Pragma("unroll") for (int mm = 0; mm < 2; ++mm) { const size_t off_ = lbase + (size_t)(((B) >> 1) * HALF + (2 * ((B) & 1) + mm) * 16) * DM; \
            _Pragma("unroll") for (int bj = 0; bj < 2; ++bj) { xa[(B) & 1][mm][bj] = __builtin_nontemporal_load((const f32x4*)(x + off_ + bj * HALF)); xb[(B) & 1][mm][bj] = __builtin_nontemporal_load((const f32x4*)(x + off_ + DM + bj * HALF)); } } } while (0)
#define G3_STORE(B) do { _Pragma("unroll") for (int mm = 0; mm < 2; ++mm) { const size_t off_ = lbase + (size_t)(((B) >> 1) * HALF + (2 * ((B) & 1) + mm) * 16) * DM; \
            _Pragma("unroll") for (int bj = 0; bj < 2; ++bj) { const f32x4 c0_ = acc[(B) >> 1][bj][2 * ((B) & 1) + mm][0], c1_ = acc[(B) >> 1][bj][2 * ((B) & 1) + mm][1]; \
                const f32x4 ca = pairx(c0_, c1_, odd), cb = pairx(c1_, c0_, !odd);                    \
                __builtin_nontemporal_store(xa[(B) & 1][mm][bj] + ca, (f32x4*)(out + off_ + bj * HALF)); \
                __builtin_nontemporal_store(xb[(B) & 1][mm][bj] + cb, (f32x4*)(out + off_ + DM + bj * HALF)); } } } while (0)
        G3_LOAD(0); G3_LOAD(1); __builtin_amdgcn_sched_barrier(0); G3_STORE(0); G3_LOAD(2); __builtin_amdgcn_sched_barrier(0); G3_STORE(1); G3_LOAD(3); __builtin_amdgcn_sched_barrier(0); G3_STORE(2); G3_STORE(3);
#undef G3_LOAD
#undef G3_STORE
    }
};
struct EpiNull {
    static constexpr bool PERM = true, AFTER_DRAIN = false, KHOOK = false;
    __device__ __forceinline__ void operator()(const f32x4 (&acc)[2][2][4][2], const Unit& u, int wr, int wc, int fr, int fq) const {
#pragma unroll
        for (int ai = 0; ai < 2; ++ai)
#pragma unroll
            for (int bj = 0; bj < 2; ++bj)
#pragma unroll
                for (int m = 0; m < 4; ++m) asm volatile("" :: "v"(acc[ai][bj][m][0]), "v"(acc[ai][bj][m][1]));
    }
};
struct OrderG1 {
    StaticOrder so; int pm0, nkv, pn0;
    __device__ void init(int hb, int G, int c, int pn0_, int ntiles, bool with_kv) { so.init(HB_ROWS, ntiles * BM, G, c); pm0 = hb * (HB_ROWS / BM); pn0 = pn0_; nkv = with_kv ? (MMEM / BM) * 4 : 0; }
    __device__ bool next(int i, Unit& u) const {
        if (so.next(i, u)) { u.pm += pm0; u.pn += pn0; return true; }
        const long j = (long)i * so.G + so.c - so.nwg; if (j < 0 || j >= nkv) return false;
        u.pm = 256 + (int)(j >> 2); u.pn = 35 + (int)(j & 3); return true;
    }
    __device__ __forceinline__ void a_ready(const Unit&) const {}
    __device__ __forceinline__ void done(const Unit&) const {}
};
struct OrderBF {
    StaticOrder so; int pm0, nkv;
    __device__ void init(int hb, int G, int c) { so.init(HB_ROWS, 9 * BM, G, c); pm0 = hb * (HB_ROWS / BM); nkv = hb == 0 ? (MMEM / BM) * 4 : 0; }
    __device__ bool next(int i, Unit& u) const {
        if (so.next(i, u)) { u.pm += pm0; const int t = u.pn; u.pn = t < 3 ? t : t < 6 ? t + 3 : t == 6 ? 18 : t + 14; return true; }
        const long j = (long)i * so.G + so.c - so.nwg; if (j < 0 || j >= nkv) return false;
        u.pm = 256 + (int)(j >> 2); u.pn = 35 + (int)(j & 3); return true;
    }
    __device__ __forceinline__ void a_ready(const Unit&) const {}
    __device__ __forceinline__ void done(const Unit&) const {}
};
struct OrderG8 {
    StaticOrder so; int pm0, bal;
    __device__ void init(int hb, int G, int c) { so.init(HB_ROWS, 26 * BM, G, c); pm0 = hb * (HB_ROWS / BM); bal = (hb == 1 && G == 256) ? 1 : 0; }
    __device__ bool next(int i, Unit& u) const {
        bool ok;
        if (!bal) ok = so.next(i, u);
        else { if (i < 12) ok = so.next(i, u); else { if (so.c < 128 || i > 13) return false; StaticOrder t = so; t.c = 2 * (so.c - 128) + (i - 12); ok = t.next(12, u); } }
        if (ok) u.pm += pm0; return ok;
    }
    __device__ __forceinline__ void a_ready(const Unit&) const {}
    __device__ __forceinline__ void done(const Unit&) const {}
};
template <int MODE8 = 0> struct EpiProj8T {
    static constexpr bool PERM = true, AFTER_DRAIN = false, KHOOK = false;
    EpiProjT<MODE8> base; const float* RS; const float* CS; PG8_LAS unsigned char* sl;
    __device__ __forceinline__ void gate8_body(const f32x4 (&acc)[2][2][4][2], const __amdgpu_buffer_rsrc_t rsrc, int trow, int t8, int wr, int wc, int fr, int fq, const PG8_LAS float* bias) const {
        constexpr float L2E = 1.4426950408889634f, C = 254.0f / 255.0f;
        f32x2 cb[2][2][2];
#pragma unroll
        for (int bj = 0; bj < 2; ++bj)
#pragma unroll
            for (int n = 0; n < 2; ++n) { const f32x4 b = *(const PG8_LAS f32x4*)(bias + 8 * bj + 4 * n); cb[bj][n][0] = (f32x2){b[0], b[1]} * L2E; cb[bj][n][1] = (f32x2){b[2], b[3]} * L2E; }
#pragma unroll
        for (int ai = 0; ai < 2; ++ai)
#pragma unroll
            for (int m = 0; m < 4; ++m) { const int row = trow + gate_srow(wr, 2 * (wc & 1) + (fq >> 1), ai, m, wc >> 1, 2 * (fq & 1)); u32x4 w;
#pragma unroll
                for (int bj = 0; bj < 2; ++bj)
#pragma unroll
                    for (int n = 0; n < 2; ++n) { const f32x4 v = acc[ai][bj][m][n]; unsigned p[2];
#pragma unroll
                        for (int h = 0; h < 2; ++h) { const f32x2 x = {v[2 * h], v[2 * h + 1]}; const f32x2 e = x * L2E + cb[bj][n][h];
                            f32x2 ex; ex.x = ex2(e.x); ex.y = ex2(e.y); const f32x2 den = ex * C + C;
                            f32x2 sc; sc.x = __builtin_amdgcn_fmed3f(__builtin_amdgcn_rcpf(den.x), 0.0f, 1.0f); sc.y = __builtin_amdgcn_fmed3f(__builtin_amdgcn_rcpf(den.y), 0.0f, 1.0f);
                            const f32x2 q = sc * (-254.0f) + 8388863.0f;
                            const float qx = q.x, qy = q.y;
                            p[h] = __builtin_amdgcn_perm(__builtin_bit_cast(unsigned, qy), __builtin_bit_cast(unsigned, qx), 0x0c0c0400u); }
                        w[2 * bj + n] = __builtin_amdgcn_perm(p[1], p[0], 0x05040100u); }
                if (MODE8 == 2) asm volatile("" :: "v"(w)); else __builtin_amdgcn_raw_buffer_store_b128(w, rsrc, (int)((unsigned)row * (unsigned)PA_ROWB + (unsigned)(PA_GOFF + t8 * BM + 16 * fr)), 0, G1_STORE_AUX); }
    }
    __device__ __forceinline__ void stage_scales(const Unit& u, int par, int wid, int lane) const {
        PG8_LAS unsigned char* d = sl + par * 3072;
        if (wid < 4) { __builtin_amdgcn_global_load_lds((const unsigned*)(CS + u.pn * BM + 64 * wid + lane), (PG8_LAS unsigned*)(d + 256 * wid), 4, 0, 0);
            if (u.pn < 12) __builtin_amdgcn_global_load_lds((const unsigned*)(base.gate_b + u.pn * BM + 64 * wid + lane), (PG8_LAS unsigned*)(d + 2048 + 256 * wid), 4, 0, 0); }
        else __builtin_amdgcn_global_load_lds((const unsigned*)(RS + u.pm * BM + 64 * (wid - 4) + lane), (PG8_LAS unsigned*)(d + 1024 + 256 * (wid - 4)), 4, 0, 0);
    }
    __device__ __forceinline__ void epi8(f32x4 (&acc)[2][2][4][2], const Unit& u, int par, int wr, int wc, int fr, int fq) const {
        const PG8_LAS float* d = (const PG8_LAS float*)(sl + par * 3072); const bool gate = u.pn < 12;
        const PG8_LAS float* cp = d + (gate ? 64 * wc + 16 * fq : 32 * wc + 8 * fq);
        f32x4 cs[2][2]; float rs[2][4];
#pragma unroll
        for (int bj = 0; bj < 2; ++bj)
#pragma unroll
            for (int n = 0; n < 2; ++n) cs[bj][n] = *(const PG8_LAS f32x4*)(cp + (gate ? 8 * bj : HALF * bj) + 4 * n);
#pragma unroll
        for (int ai = 0; ai < 2; ++ai)
#pragma unroll
            for (int m = 0; m < 4; ++m) rs[ai][m] = d[256 + wr * 64 + fr + ai * HALF + m * 16];
#pragma unroll
        for (int ai = 0; ai < 2; ++ai)
#pragma unroll
            for (int m = 0; m < 4; ++m)
#pragma unroll
                for (int bj = 0; bj < 2; ++bj)
#pragma unroll
                    for (int n = 0; n < 2; ++n) acc[ai][bj][m][n] *= cs[bj][n] * rs[ai][m];
        if (gate) {
            const __amdgpu_buffer_rsrc_t rsrc = __builtin_amdgcn_make_buffer_rsrc(base.PA, 0, (int)((size_t)HB_ROWS * PA_ROWB), 0x00020000);
            gate8_body(acc, rsrc, (u.pm - base.pm0) * BM, u.pn, wr, wc, fr, fq, d + 512 + 64 * wc + 16 * fq); return; }
        Unit v = u; v.pn = i8tile_pn(u.pn); base(acc, v, wr, wc, fr, fq);
    }
    __device__ __forceinline__ void operator()(const f32x4 (&acc)[2][2][4][2], const Unit& u, int wr, int wc, int fr, int fq) const {}
};
typedef EpiProj8T<0> EpiProj8;
}

#define GAS __attribute__((address_space(1)))
#define LAS __attribute__((address_space(3)))
typedef unsigned short bf16;
typedef unsigned v4u __attribute__((ext_vector_type(4)));
typedef float f32x4 __attribute__((ext_vector_type(4)));
typedef short bf16x8 __attribute__((ext_vector_type(8)));
typedef GAS unsigned gu32;
typedef GAS unsigned long long gu64;
#define RLX_AGENT __ATOMIC_RELAXED, __HIP_MEMORY_SCOPE_AGENT
#define LDS_WAIT() asm volatile("s_waitcnt lgkmcnt(0)" ::: "memory")
#define VM_WAIT() asm volatile("s_waitcnt vmcnt(0)" ::: "memory")
__device__ __forceinline__ unsigned long long rt() { return __builtin_amdgcn_s_memrealtime(); }
__device__ __forceinline__ unsigned f2bf(float f) { unsigned u = __builtin_bit_cast(unsigned, f); return (u + 0x7fffu + ((u >> 16) & 1u)) >> 16; }
__device__ __forceinline__ unsigned pk2(float lo, float hi) { return f2bf(lo) | (f2bf(hi) << 16); }

__device__ __forceinline__ int hw_lane() { int l; asm volatile("v_mbcnt_lo_u32_b32 %0, -1, 0\n\tv_mbcnt_hi_u32_b32 %0, -1, %0" : "=v"(l)); return l; }
__device__ __forceinline__ bool hw_thread0(int wave) { return wave == 0 && hw_lane() == 0; }
#define XB_TMO      128
#define XB_XCNT(j)  (256  + 64 * (j))
#define XB_XSUB(j)  (1280 + 64 * (j))
#define XB_XGEN(j)  (2304 + 64 * (j))
#define XB_TOP      3328
#define XB_TOPGEN   3392
#define XCD_BAR_WORDS 3456
#define XB_SPIN_CAP (1u << 18)

__device__ __forceinline__ unsigned xb_ld(unsigned* p)              { return __hip_atomic_load(p, __ATOMIC_RELAXED, __HIP_MEMORY_SCOPE_AGENT); }
__device__ __forceinline__ unsigned xb_add(unsigned* p, unsigned v) { return __hip_atomic_fetch_add(p, v, __ATOMIC_RELAXED, __HIP_MEMORY_SCOPE_AGENT); }
__device__ __forceinline__ unsigned xb_xcc_id() { return (unsigned)__builtin_amdgcn_s_getreg((3 << 11) | 20) & 0xFu; }
#define XB_SPIN(cond, bar) do { unsigned _sp = 0; while (cond) { __builtin_amdgcn_s_sleep(1); \
    if ((++_sp & 255u) == 0u) { if (xb_ld(&(bar)[XB_TMO])) break; if (_sp > XB_SPIN_CAP) { atomicAdd(&(bar)[XB_TMO], 1u); break; } } } } while (0)

struct XcdBarrier {
    unsigned* bar; unsigned x; int wave;
    volatile LAS unsigned* st;
};

__device__ __forceinline__ XcdBarrier xcd_barrier_post(unsigned* bar, volatile LAS unsigned* st, int wave) {
    XcdBarrier b; b.bar = bar; b.x = xb_xcc_id(); b.st = st; b.wave = wave;
    if (hw_thread0(wave)) (void)xb_add(&bar[XB_XCNT(b.x)], 1u);
    return b;
}
__device__ __forceinline__ void xcd_barrier_complete(unsigned* bar, unsigned x, unsigned& nloc, unsigned& nx) {
    const unsigned G = gridDim.x * gridDim.y * gridDim.z;
    unsigned sum, cnt, mine, sp = 0u;
    for (;;) {
        sum = 0u; cnt = 0u; mine = 0u;
#pragma unroll
        for (unsigned j = 0; j < 16; ++j) { const unsigned c = xb_ld(&bar[XB_XCNT(j)]); sum += c; cnt += (c > 0u) ? 1u : 0u; mine = (j == x) ? c : mine; }
        if (sum == G) break;
        __builtin_amdgcn_s_sleep(1);
        if ((++sp & 255u) == 0u) { if (xb_ld(&bar[XB_TMO])) break; if (sp > XB_SPIN_CAP) { atomicAdd(&bar[XB_TMO], 1u); break; } }
    }
    nloc = mine > 0u ? mine : 1u; nx = cnt > 0u ? cnt : 1u;
}

__device__ __forceinline__ void xcd_barrier(const XcdBarrier& b) {
    asm volatile("s_waitcnt vmcnt(0)" ::: "memory");
    __syncthreads();
    if (hw_thread0(b.wave)) {
        unsigned* bar = b.bar;
        __builtin_amdgcn_s_waitcnt(0);
        unsigned nloc = b.st[0], nx = b.st[1];
        if (nloc == 0u) { xcd_barrier_complete(bar, b.x, nloc, nx); b.st[0] = nloc; b.st[1] = nx; }
        const unsigned old = xb_add(&bar[XB_XSUB(b.x)], 1u);
        const unsigned gen = old / nloc;
        if (old + 1u == (gen + 1u) * nloc) {
            __builtin_amdgcn_fence(__ATOMIC_RELEASE, "agent");
            asm volatile("s_waitcnt vmcnt(0)" ::: "memory");
            const unsigned og = xb_add(&bar[XB_TOP], 1u);
            const unsigned tg = og / nx;
            if (og + 1u == (tg + 1u) * nx) xb_add(&bar[XB_TOPGEN], 1u);
            else XB_SPIN(xb_ld(&bar[XB_TOPGEN]) == tg, bar);
            __builtin_amdgcn_fence(__ATOMIC_ACQUIRE, "agent");
            xb_add(&bar[XB_XGEN(b.x)], 1u);
            asm volatile("s_waitcnt vmcnt(0)" ::: "memory");
        } else {
            XB_SPIN(xb_ld(&bar[XB_XGEN(b.x)]) == gen, bar);
            __builtin_amdgcn_fence(__ATOMIC_ACQUIRE, "agent");
            asm volatile("s_waitcnt vmcnt(0)" ::: "memory");
        }
    }
    __syncthreads();
}

__device__ __forceinline__ float wave_sum(float v) {
#pragma unroll
    for (int o = 1; o < 64; o <<= 1) v += __shfl_xor(v, o);
    return v;
}

constexpr int RING_OFF = 0, RING_BYTES = 131072;
constexpr int LDSCTL_OFF = RING_BYTES, MISC_OFF = LDSCTL_OFF + 320;
constexpr int SCALE_OFF = RING_BYTES + 8192;
constexpr int LDS_BYTES = 147456;
constexpr int NWAVES = 8, NTHR = NWAVES * 64;
constexpr int WSCR_OFF = 132096;

__device__ __forceinline__ float bf2f(bf16 h) { return __builtin_bit_cast(float, (unsigned)h << 16); }
__device__ __forceinline__ float sigm_f(float x) { return 1.f / (1.f + __expf(-x)); }
__device__ __forceinline__ int t5_bucket(int d) {
    if (d < 16) return d;
    int b = 16;
    b += d >= 22; b += d >= 30; b += d >= 40; b += d >= 54; b += d >= 73; b += d >= 99; b += d >= 134; b += d >= 182; b += d >= 246; b += d >= 332; b += d >= 450; b += d >= 609; b += d >= 825; b += d >= 1117; b += d >= 1513;
    return b;
}

struct Ctx {
    const float *x, *mem, *norm_w, *w_in, *gate_b, *lnw, *lnb, *sp_w, *sp_b, *bqw, *bkw, *rel_bias, *mem_norm_w, *m_w_kv, *mqw, *mkw, *proj_a, *proj_b, *proj_m, *w_out;
    float* out;
    bf16 *WIN, *PCAT, *WOUT, *WSP, *XN, *PA, *KVM, *OG, *YC, *MRG; float *BIAS, *BIASX, *SS, *MKSS, *LSE, *LNST, *CS, *RS; unsigned char *XN8, *W8; unsigned* cmax;
    LAS unsigned char* lds; int tid, lane, wave, G, gtid, T, gwave, NW, xgwave;
};

__device__ __forceinline__ void p0_transpose_item(const float* W, int N, bf16* WT, int ldt, int row_off, int koff, LAS float* scr, int item, int lane_unused, bool gperm = false, unsigned* cmax = nullptr) {
    const int lane = hw_lane();
    const int nblk = N / 32, kb = item / nblk, nb = item % nblk, k0 = 64 * kb, n0 = 32 * nb;
    float cam = 0.f;
#pragma unroll 8
    for (int i = 0; i < 32; ++i) { const int kk = 2 * i + (lane >> 5); const float wv = W[(size_t)(k0 + kk) * N + n0 + (lane & 31)]; scr[kk * 33 + (lane & 31)] = wv; cam = fmaxf(cam, fabsf(wv)); }
    if (cmax && i8col(n0) >= 0) { cam = fmaxf(cam, __shfl_xor(cam, 32)); if (lane < 32) atomicMax(cmax + i8col(n0) + lane, __float_as_uint(cam)); }
    LDS_WAIT(); asm volatile("" ::: "memory");
    const int c = lane & 7;
#pragma unroll
    for (int j = 0; j < 4; ++j) { const int n = (lane >> 3) + 8 * j; const LAS float* s = scr + (8 * c) * 33 + n;
        v4u o; o.x = pk2(s[0 * 33], s[1 * 33]); o.y = pk2(s[2 * 33], s[3 * 33]); o.z = pk2(s[4 * 33], s[5 * 33]); o.w = pk2(s[6 * 33], s[7 * 33]);
        int nn = n0 + n;
        if (gperm) {
            if (nn >= C_G) nn = (nn & ~255) + 128 * ((nn >> 3) & 1) + 32 * ((nn >> 6) & 3) + 8 * ((nn >> 4) & 3) + (nn & 7);
            else if (nn < C_AV) { const int T = nn >> 7; nn = 256 * (T < 3 ? T : T + 3) + (nn & 127); }
            else if (nn >= C_AZ && nn < C_BQ) { const int c = nn - C_AZ, T = c >> 7; nn = 256 * (T < 3 ? T : T + 3) + 128 + (c & 127); }
        }
        *(GAS v4u*)(WT + (size_t)(row_off + nn) * ldt + koff + k0 + 8 * c) = o; }
    LDS_WAIT(); asm volatile("" ::: "memory");
}
template <int NR> __device__ __forceinline__ void rms_rows_to_bf16(const float* src, const float* w, bf16* dst, size_t m0, size_t stride, int lane, unsigned char* q8 = nullptr, float* rsc = nullptr) {
    f32x4 v[NR][4]; float s[NR];
#pragma unroll
    for (int r = 0; r < NR; ++r) { const GAS f32x4* xr = (const GAS f32x4*)(src + (m0 + r * stride) * DM) + lane;
#pragma unroll
        for (int j = 0; j < 4; ++j) v[r][j] = __builtin_nontemporal_load(xr + 64 * j); }
    f32x4 ww[4];
#pragma unroll
    for (int j = 0; j < 4; ++j) ww[j] = ((const GAS f32x4*)w + lane)[64 * j];
#pragma unroll
    for (int r = 0; r < NR; ++r) { float a = 0.f;
#pragma unroll
        for (int j = 0; j < 4; ++j) a += (v[r][j].x * v[r][j].x + v[r][j].y * v[r][j].y) + (v[r][j].z * v[r][j].z + v[r][j].w * v[r][j].w);
        s[r] = rsqrtf(wave_sum(a) * (1.f / DM) + EPS); }
#pragma unroll
    for (int r = 0; r < NR; ++r) { GAS unsigned long long* o8 = (GAS unsigned long long*)(dst + (m0 + r * stride) * DM) + lane;
#pragma unroll
        for (int j = 0; j < 4; ++j) { v[r][j] = v[r][j] * s[r] * ww[j]; o8[64 * j] = (unsigned long long)pk2(v[r][j].x, v[r][j].y) | ((unsigned long long)pk2(v[r][j].z, v[r][j].w) << 32); } }
    if (q8) {
#pragma unroll
        for (int r = 0; r < NR; ++r) { float am = 0.f;
#pragma unroll
            for (int j = 0; j < 4; ++j) am = fmaxf(am, fmaxf(fmaxf(fabsf(v[r][j].x), fabsf(v[r][j].y)), fmaxf(fabsf(v[r][j].z), fabsf(v[r][j].w))));
#pragma unroll
            for (int o = 1; o < 64; o <<= 1) am = fmaxf(am, __shfl_xor(am, o));
            am = fmaxf(am, 1e-20f); const float inv = 127.0f / am;
            GAS unsigned* qo = (GAS unsigned*)(q8 + (m0 + r * stride) * P8) + lane;
#pragma unroll
            for (int j = 0; j < 4; ++j) { const int a0 = (int)rintf(v[r][j].x * inv), a1 = (int)rintf(v[r][j].y * inv), a2 = (int)rintf(v[r][j].z * inv), a3 = (int)rintf(v[r][j].w * inv);
                qo[64 * j] = (unsigned)(a0 & 0xff) | ((unsigned)(a1 & 0xff) << 8) | ((unsigned)(a2 & 0xff) << 16) | ((unsigned)(a3 & 0xff) << 24); }
            if (lane == 0) rsc[m0 + r * stride] = am * (1.0f / 127.0f); } }
}
__device__ __forceinline__ void p0_quant_tile(const float* W, unsigned char* W8, float* CS, const unsigned* cmax, LAS float* scr, int item) {
    const int lane = hw_lane();
    const int kb = item / (N8 / 32), nb = item % (N8 / 32), k0 = 64 * kb, c0 = 32 * nb, n0 = i8src(c0);
    const float am = fmaxf(__uint_as_float(cmax[c0 + (lane & 31)]), 1e-30f), inv = 127.0f / am;
    if (kb == 0 && lane < 32) CS[c0 + lane] = am * (1.0f / 127.0f);
#pragma unroll 8
    for (int i = 0; i < 32; ++i) { const int kk = 2 * i + (lane >> 5); scr[kk * 33 + (lane & 31)] = rintf(W[(size_t)(k0 + kk) * NIN + n0 + (lane & 31)] * inv); }
    LDS_WAIT(); asm volatile("" ::: "memory");
    const int c = lane & 3;
#pragma unroll
    for (int j = 0; j < 2; ++j) { const int n = (lane >> 2) + 16 * j; const LAS float* sp = scr + (16 * c) * 33 + n; v4u o;
#define Q4(B) ((unsigned)((int)sp[((B) + 0) * 33] & 0xff) | ((unsigned)((int)sp[((B) + 1) * 33] & 0xff) << 8) | ((unsigned)((int)sp[((B) + 2) * 33] & 0xff) << 16) | ((unsigned)((int)sp[((B) + 3) * 33] & 0xff) << 24))
        o.x = Q4(0); o.y = Q4(4); o.z = Q4(8); o.w = Q4(12);
#undef Q4
        int nn = c0 + n; if (nn < 3072) nn = (nn & ~255) + 128 * ((nn >> 3) & 1) + 32 * ((nn >> 6) & 3) + 8 * ((nn >> 4) & 3) + (nn & 7);
        *(GAS v4u*)(W8 + (size_t)nn * P8 + k0 + 16 * c) = o; }
    LDS_WAIT(); asm volatile("" ::: "memory");
}
__device__ __forceinline__ void p0_quant_weights(Ctx& F, const unsigned* cmax) {
    LAS float* scr = (LAS float*)(F.lds + RING_OFF + F.wave * 16384);
    for (int it = F.gwave; it < 16 * (N8 / 32); it += F.NW) p0_quant_tile(F.w_in, F.W8, F.CS, cmax, scr, it);
}
__device__ __forceinline__ void p0_int8_block(Ctx& F, int nb) {
    const int lane = hw_lane(), col = lane & 31;
    LAS float* scr = (LAS float*)(F.lds + RING_OFF + F.wave * 16384);
    LAS float* wmax = (LAS float*)(F.lds + WSCR_OFF + 8192);
    const int c0 = 32 * nb, n0 = i8src(c0);
    float wv[2][32]; float cam = 0.f;
#pragma unroll
    for (int b = 0; b < 2; ++b) { const int k0 = 64 * (2 * F.wave + b);
#pragma unroll
        for (int i = 0; i < 32; ++i) { const int kk = 2 * i + (lane >> 5); wv[b][i] = F.w_in[(size_t)(k0 + kk) * NIN + n0 + col]; } }
#pragma unroll
    for (int b = 0; b < 2; ++b)
#pragma unroll
        for (int i = 0; i < 32; ++i) cam = fmaxf(cam, fabsf(wv[b][i]));
    cam = max_x32(cam);
    if (lane < 32) wmax[F.wave * 32 + lane] = cam;
    __syncthreads();
    float am = 1e-30f;
#pragma unroll
    for (int w = 0; w < 8; ++w) am = fmaxf(am, wmax[w * 32 + col]);
    const float inv = 127.0f / am;
    if (F.wave == 0 && lane < 32) F.CS[c0 + lane] = am * (1.0f / 127.0f);
#pragma unroll 1
    for (int b = 0; b < 2; ++b) { const int k0 = 64 * (2 * F.wave + b);
#pragma unroll
        for (int i = 0; i < 32; ++i) { const int kk = 2 * i + (lane >> 5); scr[kk * 33 + col] = rintf((b == 0 ? wv[0][i] : wv[1][i]) * inv); }
        LDS_WAIT(); asm volatile("" ::: "memory");
        const int c = lane & 3;
#pragma unroll
        for (int j = 0; j < 2; ++j) { const int n = (lane >> 2) + 16 * j; const LAS float* sp = scr + (16 * c) * 33 + n; v4u o;
#define Q4(B) ((unsigned)((int)sp[((B) + 0) * 33] & 0xff) | ((unsigned)((int)sp[((B) + 1) * 33] & 0xff) << 8) | ((unsigned)((int)sp[((B) + 2) * 33] & 0xff) << 16) | ((unsigned)((int)sp[((B) + 3) * 33] & 0xff) << 24))
            o.x = Q4(0); o.y = Q4(4); o.z = Q4(8); o.w = Q4(12);
#undef Q4
            int nn = c0 + n; if (nn < 3072) nn = (nn & ~255) + 128 * ((nn >> 3) & 1) + 32 * ((nn >> 6) & 3) + 8 * ((nn >> 4) & 3) + (nn & 7);
            *(GAS v4u*)(F.W8 + (size_t)nn * P8 + k0 + 16 * c) = o; }
        LDS_WAIT(); asm volatile("" ::: "memory"); }
    __syncthreads();
}
__device__ __forceinline__ void p0_prologue(Ctx& F) {
    LAS float* scr = (LAS float*)(F.lds + RING_OFF + F.wave * 16384);
    constexpr int I_IN = 16 * (NIN / 32), I_KV = 16 * 32, I_PA = 12 * 32, I_PB = 4 * 32, I_PM = 8 * 32, I_WO = 16 * 32;
    constexpr int NITEMS = I_IN + I_KV + I_PA + I_PB + I_PM + I_WO;
    for (int nb = (int)blockIdx.x; nb < N8 / 32; nb += F.G) p0_int8_block(F, nb);
    for (int it = F.gwave; it < NITEMS; it += F.NW) {
        int r = it;
        if (r < I_IN) { if (i8col(32 * (r % (NIN / 32))) < 0) p0_transpose_item(F.w_in, NIN, F.WIN, DM, 0, 0, scr, r, F.lane, true, nullptr); continue; } r -= I_IN;
        if (r < I_KV) { p0_transpose_item(F.m_w_kv, 1024, F.WIN, DM, NIN, 0, scr, r, F.lane); continue; } r -= I_KV;
        if (r < I_PA) { p0_transpose_item(F.proj_a, DM, F.PCAT, KC, 0, 0, scr, r, F.lane); continue; } r -= I_PA;
        if (r < I_PB) { p0_transpose_item(F.proj_b, DM, F.PCAT, KC, 0, 768, scr, r, F.lane); continue; } r -= I_PB;
        if (r < I_PM) { p0_transpose_item(F.proj_m, DM, F.PCAT, KC, 0, 1024, scr, r, F.lane); continue; } r -= I_PM;
        p0_transpose_item(F.w_out, DM, F.WOUT, DM, 0, 0, scr, r, F.lane);
    }
    for (int i = F.gtid; i < 4 * 128 * 128; i += F.T) { const int t = (i >> 7) & 127, s = i & 127; F.WSP[i] = (bf16)(s <= t ? f2bf(F.sp_w[i]) : 0u); }
    for (int i = F.gtid; i < 3 * 4 * 132; i += F.T) { const int g = i / (4 * 132), h = (i / 132) % 4, j = i % 132; const int dil = g == 0 ? 1 : (g == 1 ? 4 : 16);
        F.BIAS[i] = j <= 128 ? F.rel_bias[t5_bucket(j * dil) * 12 + 4 * g + h] : 0.f; }
    for (int i = F.gtid; i < 3 * 4 * 192; i += F.T) { const int g = i / (4 * 192), h = (i / 192) % 4, step = i % 192 - 31; const int dil = g == 0 ? 1 : (g == 1 ? 4 : 16);
        F.BIASX[i] = (step >= 0 && step <= 128) ? F.rel_bias[t5_bucket(step * dil) * 12 + 4 * g + h] * 1.4426950408889634f : -1e30f; }
    if ((MTOT % (4 * F.NW)) == 0 && (MMEM % (4 * F.NW)) == 0) {
        for (size_t m = F.gwave; m < (size_t)MTOT; m += 4 * (size_t)F.NW) rms_rows_to_bf16<4>(F.x, F.norm_w, F.XN, m, F.NW, F.lane, F.XN8, F.RS);
        for (size_t m = F.gwave; m < (size_t)MMEM; m += 4 * (size_t)F.NW) rms_rows_to_bf16<4>(F.mem, F.mem_norm_w, F.XN + (size_t)MTOT * DM, m, F.NW, F.lane);
    } else {
        for (size_t m = F.gwave; m < (size_t)MTOT; m += F.NW) rms_rows_to_bf16<1>(F.x, F.norm_w, F.XN, m, 0, F.lane, F.XN8, F.RS);
        for (size_t m = F.gwave; m < (size_t)MMEM; m += F.NW) rms_rows_to_bf16<1>(F.mem, F.mem_norm_w, F.XN + (size_t)MTOT * DM, m, 0, F.lane);
    }
}


typedef float f32x16 __attribute__((ext_vector_type(16)));
typedef short s16x4 __attribute__((ext_vector_type(4)));
__device__ __forceinline__ int crow(int r, int hi) { return (r & 3) + 8 * (r >> 2) + 4 * hi; }
__device__ __forceinline__ unsigned cvtpk(float lo, float hi) { return pg8::cvt_pk_bf16(lo, hi); }
__device__ __forceinline__ v4u swap32x2(v4u w) { const auto r0 = __builtin_amdgcn_permlane32_swap(w.x, w.z, false, false), r1 = __builtin_amdgcn_permlane32_swap(w.y, w.w, false, false); return (v4u){r0[0], r1[0], r0[1], r1[1]}; }
__device__ __forceinline__ s16x4 vtr(const LAS unsigned char* p) { typedef short v4i16_t __attribute__((ext_vector_type(4))); return __builtin_bit_cast(s16x4, __builtin_amdgcn_ds_read_tr16_b64_v4i16((LAS v4i16_t*)p)); }
__device__ __forceinline__ float bflo(unsigned w) { return __uint_as_float(w << 16); }
__device__ __forceinline__ float bfhi(unsigned w) { return __uint_as_float(w & 0xffff0000u); }
constexpr float LOG2E = 1.4426950408889634f, LN2 = 0.6931471805599453f;
constexpr int NBX = 192;


__device__ __forceinline__ void dma16(const void* gsrc, LAS unsigned char* ldst) { __builtin_amdgcn_global_load_lds((const unsigned*)gsrc, (LAS unsigned*)ldst, 16, 0, 0); }
#define VM_WAIT0() asm volatile("s_waitcnt vmcnt(0)" ::: "memory")
__device__ __forceinline__ void st_mixA_mfma(Ctx& F) {
    const int lane = hw_lane(), r32 = lane & 31, hi = lane >> 5, tid = F.wave * 64 + lane;
    LAS unsigned char* wl = F.lds + RING_OFF + F.wave * 16384;
    typedef float f32x2v __attribute__((ext_vector_type(2))); typedef unsigned u32x2v __attribute__((ext_vector_type(2)));
    LAS f32x2v* tab = (LAS f32x2v*)(F.lds + WSCR_OFF + 8192);
    const int g = F.wave >> 1, ch = lane & 3;
    bf16x8 wf[14];
    const bf16* wrow0 = F.WSP + (size_t)(g * 128 + r32) * 128 + 8 * hi;
    { int n = 0;
#pragma unroll
      for (int tb = 2; tb < 4; ++tb)
#pragma unroll
          for (int ks = 0; ks < 2 * (tb + 1); ++ks) wf[n++] = *(const bf16x8*)(wrow0 + (size_t)tb * 32 * 128 + 16 * ks); }
    for (int unit = blockIdx.x; unit < HB_ROWS / 128; unit += F.G) {
        const int rowbase = unit * 128;
        v4u raw[8];
        { const int c0 = g * 192 + (F.wave & 1) * 96;
#pragma unroll
          for (int i = 0; i < 8; ++i) raw[i] = *(const v4u*)(F.PA + (size_t)(rowbase + (lane >> 2) + 16 * i) * PAP + C_AV + c0 + 8 * ch); }
        { const int row = tid >> 2, part = tid & 3; const float* sp = F.SS + (size_t)(rowbase + row) * SS_W + 12 * part; float s = 0.f, q = 0.f;
#pragma unroll
          for (int k = 0; k < 6; ++k) { s += sp[2 * k]; q += sp[2 * k + 1]; }
          s = sum_quad(s); q = sum_quad(q);
          const float mu = s * (1.f / 768.f), var = q * (1.f / 768.f) - mu * mu;
          if (part == 0) tab[row] = (f32x2v){mu, rsqrtf(fmaxf(var, 0.f) + EPS)}; }
        __syncthreads();
#pragma unroll 1
        for (int cbi = 0; cbi < 3; ++cbi) {
            const int c0 = g * 192 + ((F.wave & 1) * 3 + cbi) * 32;
            const f32x4 w0 = *(const f32x4*)(F.lnw + c0 + 8 * ch), w1 = *(const f32x4*)(F.lnw + c0 + 8 * ch + 4), b0 = *(const f32x4*)(F.lnb + c0 + 8 * ch), b1 = *(const f32x4*)(F.lnb + c0 + 8 * ch + 4);
#pragma unroll
            for (int i = 0; i < 8; ++i) { const int s = (lane >> 2) + 16 * i; const f32x2v st = tab[s]; const v4u rw = raw[i]; v4u o;
                o.x = cvtpk((bflo(rw.x) - st.x) * st.y * w0.x + b0.x, (bfhi(rw.x) - st.x) * st.y * w0.y + b0.y); o.y = cvtpk((bflo(rw.y) - st.x) * st.y * w0.z + b0.z, (bfhi(rw.y) - st.x) * st.y * w0.w + b0.w);
                o.z = cvtpk((bflo(rw.z) - st.x) * st.y * w1.x + b1.x, (bfhi(rw.z) - st.x) * st.y * w1.y + b1.y); o.w = cvtpk((bflo(rw.w) - st.x) * st.y * w1.z + b1.z, (bfhi(rw.w) - st.x) * st.y * w1.w + b1.w);
                *(LAS v4u*)(wl + (s >> 3) * 512 + (s & 7) * 64 + ch * 16) = o; }
            if (cbi < 2) {
#pragma unroll
                for (int i = 0; i < 8; ++i) raw[i] = *(const v4u*)(F.PA + (size_t)(rowbase + (lane >> 2) + 16 * i) * PAP + C_AV + c0 + 32 + 8 * ch); }
            LAS unsigned char* uzb = wl + 8192;
#pragma unroll
            for (int p = 0; p < 8; ++p) { const int row_ = 16 * p + (lane >> 2);
                dma16(F.PA + (size_t)(rowbase + row_) * PAP + C_AU + c0 + 8 * ((lane & 3) ^ ((row_ >> 2) & 3)), uzb + p * 1024); }
            const LAS unsigned char* vb = wl + hi * 512 + ((lane & 15) >> 2) * 64 + ((lane >> 4) & 1) * 32 + (lane & 3) * 8;
            const bf16* wr2 = wrow0; asm volatile("" : "+v"(wr2));
            bf16x8 wq[6];
            { int n2 = 0;
#pragma unroll
              for (int tb = 0; tb < 2; ++tb)
#pragma unroll
                  for (int ks = 0; ks < 2 * (tb + 1); ++ks) wq[n2++] = *(const bf16x8*)(wr2 + (size_t)tb * 32 * 128 + 16 * ks); }
            int n = 0, nq = 0;
#pragma unroll
            for (int tb = 0; tb < 4; ++tb) { f32x16 acc = {};
#pragma unroll
                for (int ks = 0; ks < 2 * (tb + 1); ++ks) { const s16x4 a = vtr(vb + ks * 1024), c = vtr(vb + ks * 1024 + 256); const bf16x8 af = {a[0], a[1], a[2], a[3], c[0], c[1], c[2], c[3]};
                    acc = __builtin_amdgcn_mfma_f32_32x32x16_bf16(af, tb < 2 ? wq[nq++] : wf[n++], acc, 0, 0, 0); }
                const int t = 32 * tb + r32; const float sb = F.sp_b[g * 128 + t];
                if (tb == 0) VM_WAIT0();
                LAS unsigned char* urow = uzb + t * 64 + 8 * hi; const int fsw = (r32 >> 2) & 3;
#pragma unroll
                for (int i = 0; i < 4; ++i) { LAS u32x2v* up = (LAS u32x2v*)(urow + ((i ^ fsw) * 16)); const u32x2v u = *up; u32x2v w;
                    w.x = cvtpk(bflo(u.x) * (acc[4 * i] + sb), bfhi(u.x) * (acc[4 * i + 1] + sb)); w.y = cvtpk(bflo(u.y) * (acc[4 * i + 2] + sb), bfhi(u.y) * (acc[4 * i + 3] + sb));
                    *up = w; }
#pragma unroll
                for (int jr = 0; jr < 2; ++jr) { const int row_ = 32 * tb + 16 * jr + (lane >> 2); const v4u yv = *(const LAS v4u*)(uzb + row_ * 64 + (lane & 3) * 16);
                    *(v4u*)(F.YC + (size_t)(rowbase + row_) * KC + c0 + 8 * ((lane & 3) ^ ((row_ >> 2) & 3))) = yv; } }
        }
        __syncthreads();
    }
}

__device__ __forceinline__ void st_mergeB_vec(Ctx& F) {
    constexpr int NI = 8;
    const int total = HB_ROWS * 32, gtid0 = (int)blockIdx.x * NTHR + F.wave * 64 + hw_lane();
    for (int g0 = gtid0; g0 < total; g0 += NI * F.T) {
        v4u a[NI], b[NI], c[NI], z[NI]; float l0[NI], l1[NI], l2[NI];
#pragma unroll
        for (int i = 0; i < NI; ++i) { const int gid = g0 + i * F.T < total ? g0 + i * F.T : g0; const int r = gid >> 5, c8 = (gid & 31) * 8, h = c8 >> 6;
            l0[i] = F.LSE[((size_t)0 * HB_ROWS + r) * 4 + h]; l1[i] = F.LSE[((size_t)1 * HB_ROWS + r) * 4 + h]; l2[i] = F.LSE[((size_t)2 * HB_ROWS + r) * 4 + h];
            a[i] = *(const v4u*)(F.OG + ((size_t)0 * HB_ROWS + r) * 256 + c8); b[i] = *(const v4u*)(F.OG + ((size_t)1 * HB_ROWS + r) * 256 + c8); c[i] = *(const v4u*)(F.OG + ((size_t)2 * HB_ROWS + r) * 256 + c8);
            z[i] = *(const v4u*)(F.PA + (size_t)r * PAP + C_BZ + c8); }
        __builtin_amdgcn_sched_barrier(0);
#pragma unroll
        for (int i = 0; i < NI; ++i) { if (g0 + i * F.T >= total) break; const int gid = g0 + i * F.T; const int r = gid >> 5, c8 = (gid & 31) * 8;
            const float mx = fmaxf(l0[i], fmaxf(l1[i], l2[i])); float e0 = __expf(l0[i] - mx), e1 = __expf(l1[i] - mx), e2 = __expf(l2[i] - mx); const float inv = 1.f / (e0 + e1 + e2); e0 *= inv; e1 *= inv; e2 *= inv;
            v4u o;
#define MB_1(X) X = pk2((e0 * bflo(a[i].X) + e1 * bflo(b[i].X) + e2 * bflo(c[i].X)) * bflo(z[i].X), (e0 * bfhi(a[i].X) + e1 * bfhi(b[i].X) + e2 * bfhi(c[i].X)) * bfhi(z[i].X))
            o.MB_1(x); o.MB_1(y); o.MB_1(z); o.MB_1(w);
#undef MB_1
            *(v4u*)(F.YC + (size_t)r * KC + 768 + c8) = o; }
    }
}


__device__ __forceinline__ void st_attnM_v3(Ctx& F, int hb) {
    const int lane = hw_lane(), r32 = lane & 31, hi = lane >> 5;
    LAS unsigned char* kimg = F.lds + RING_OFF; LAS unsigned char* vimg = F.lds + RING_OFF + 65536;
    LAS float* kstab = (LAS float*)(F.lds + WSCR_OFF + 8192);
    typedef unsigned u32x2v __attribute__((ext_vector_type(2)));
    const int vcu = F.xgwave >> 3;
    __syncthreads();
    for (int task = vcu; task < 256; task += F.G) {
        const int bh = task >> 2, b = bh >> 2, h = bh & 3; const size_t kbase = (size_t)(hb * 16 + b) * MEML;
#pragma unroll
        for (int j = 0; j < 8; ++j) { const int p = F.wave * 8 + j, row = 4 * p + (lane >> 4);
            dma16(F.KVM + (kbase + row) * 1024 + h * 128 + 8 * ((lane & 15) ^ (row & 15)), kimg + p * 1024);
            dma16(F.KVM + (kbase + 8 * (p >> 1) + ((lane & 31) >> 2)) * 1024 + 512 + h * 128 + (2 * (p & 1) + (lane >> 5)) * 32 + (lane & 3) * 8, vimg + p * 1024); }
        { const int key = F.wave * 32 + r32; const float* sp = F.MKSS + (kbase + key) * 16 + 4 * h;
          const float ksv = rsqrtf(((sp[0] + sp[1]) + (sp[2] + sp[3])) * (1.f / 128.f) + EPS); if (lane < 32) kstab[key] = ksv; }
        VM_WAIT0(); __syncthreads();
#pragma unroll 1
        for (int qi = 0; qi < 2; ++qi) {
            const int qb = (task & 3) * 16 + F.wave * 2 + qi;
            const size_t qrow = (size_t)(b * SEQ + qb * 32 + r32);
            const float qs = rsqrtf(((F.SS[qrow * SS_W + 96 + 4 * h] + F.SS[qrow * SS_W + 96 + 4 * h + 1]) + (F.SS[qrow * SS_W + 96 + 4 * h + 2] + F.SS[qrow * SS_W + 96 + 4 * h + 3])) * (1.f / 128.f) + EPS) * (0.08838834764831845f * LOG2E);
            bf16x8 qf[8];
#pragma unroll
            for (int d0 = 0; d0 < 8; ++d0) { const int dd = 16 * d0 + 8 * hi;
                const v4u raw = *(const v4u*)(F.PA + qrow * PAP + C_MQ + h * 128 + dd);
                const f32x4 wa = *(const f32x4*)(F.mqw + dd), wb = *(const f32x4*)(F.mqw + dd + 4), ka = *(const f32x4*)(F.mkw + dd), kb = *(const f32x4*)(F.mkw + dd + 4);
                v4u o;
                o.x = cvtpk(bflo(raw.x) * qs * wa.x * ka.x, bfhi(raw.x) * qs * wa.y * ka.y); o.y = cvtpk(bflo(raw.y) * qs * wa.z * ka.z, bfhi(raw.y) * qs * wa.w * ka.w);
                o.z = cvtpk(bflo(raw.z) * qs * wb.x * kb.x, bfhi(raw.z) * qs * wb.y * kb.y); o.w = cvtpk(bflo(raw.w) * qs * wb.z * kb.z, bfhi(raw.w) * qs * wb.w * kb.w);
                qf[d0] = __builtin_bit_cast(bf16x8, o); }
            v4u zq[4][2];
#pragma unroll
            for (int db = 0; db < 4; ++db)
#pragma unroll
                for (int kp = 0; kp < 2; ++kp) zq[db][kp] = *(const v4u*)(F.PA + qrow * PAP + C_MZ + h * 128 + db * 32 + 16 * kp + 8 * hi);
            float mrun = -1e30f, lrun = 0.f; f32x16 o0 = {}, o1 = {}, o2 = {}, o3 = {};
            const LAS unsigned char* kb0 = kimg + r32 * 256; const int ksw = r32 & 15;
            const LAS unsigned char* vb0 = vimg + (4 * hi + ((lane & 15) >> 2)) * 64 + ((lane >> 4) & 1) * 32 + (lane & 3) * 8;
#pragma unroll 2
            for (int t = 0; t < MEML / 32; ++t) {
                f32x16 st = {};
#pragma unroll
                for (int d0 = 0; d0 < 8; ++d0) { const bf16x8 kf = *(const LAS bf16x8*)(kb0 + t * 8192 + (((2 * d0 + hi) ^ ksw) * 16)); st = __builtin_amdgcn_mfma_f32_32x32x16_bf16(kf, qf[d0], st, 0, 0, 0); }
                float tmax = -1e30f;
#pragma unroll
                for (int i = 0; i < 4; ++i) { const f32x4 kk = *(const LAS f32x4*)(kstab + 32 * t + 8 * i + 4 * hi);
#pragma unroll
                    for (int j = 0; j < 4; ++j) { const float s = st[4 * i + j] * kk[j]; st[4 * i + j] = s; tmax = fmaxf(tmax, s); } }
                tmax = max_x32(tmax);
                const float mnew = fmaxf(mrun, tmax), alpha = __builtin_amdgcn_exp2f(mrun - mnew); mrun = mnew;
                float psum = 0.f;
#pragma unroll
                for (int r = 0; r < 16; ++r) { st[r] = __builtin_amdgcn_exp2f(st[r] - mnew); psum += st[r]; }
                lrun = lrun * alpha + psum;
#pragma unroll
                for (int r = 0; r < 16; ++r) { o0[r] *= alpha; o1[r] *= alpha; o2[r] *= alpha; o3[r] *= alpha; }
                v4u p0, p1;
                p0.x = cvtpk(st[0], st[1]); p0.y = cvtpk(st[2], st[3]); p0.z = cvtpk(st[4], st[5]); p0.w = cvtpk(st[6], st[7]);
                p1.x = cvtpk(st[8], st[9]); p1.y = cvtpk(st[10], st[11]); p1.z = cvtpk(st[12], st[13]); p1.w = cvtpk(st[14], st[15]);
                const LAS unsigned char* vb = vb0 + t * 8192;
#define AM_PV(OX, DB) do { _Pragma("unroll") for (int s = 0; s < 2; ++s) { const bf16x8 pf = __builtin_bit_cast(bf16x8, s == 0 ? p0 : p1); \
                    const s16x4 a = vtr(vb + (2 * s) * 2048 + (DB) * 512), c = vtr(vb + (2 * s + 1) * 2048 + (DB) * 512); const bf16x8 vf = {a[0], a[1], a[2], a[3], c[0], c[1], c[2], c[3]}; \
                    OX = __builtin_amdgcn_mfma_f32_32x32x16_bf16(vf, pf, OX, 0, 0, 0); } } while (0)
                AM_PV(o0, 0); AM_PV(o1, 1); AM_PV(o2, 2); AM_PV(o3, 3);
#undef AM_PV
            }
            const float ltot = sum_x32(lrun), inv = 1.f / ltot;
            bf16* yrow = F.YC + qrow * KC + 1024 + h * 128 + 8 * hi;
#define AM_ST(OX, DB) do { _Pragma("unroll") for (int kp = 0; kp < 2; ++kp) { const v4u z = swap32x2(zq[DB][kp]);     \
            v4u w; w.x = cvtpk(OX[8 * kp] * inv * bflo(z.x), OX[8 * kp + 1] * inv * bfhi(z.x)); w.y = cvtpk(OX[8 * kp + 2] * inv * bflo(z.y), OX[8 * kp + 3] * inv * bfhi(z.y)); \
            w.z = cvtpk(OX[8 * kp + 4] * inv * bflo(z.z), OX[8 * kp + 5] * inv * bfhi(z.z)); w.w = cvtpk(OX[8 * kp + 6] * inv * bflo(z.w), OX[8 * kp + 7] * inv * bfhi(z.w)); \
            *(v4u*)(yrow + (DB) * 32 + 16 * kp) = swap32x2(w); } } while (0)
            AM_ST(o0, 0); AM_ST(o1, 1); AM_ST(o2, 2); AM_ST(o3, 3);
#undef AM_ST
        }
        __syncthreads();
    }
}

__device__ __forceinline__ void st_attnB_v3(Ctx& F) {
    const int lane = hw_lane(), r32 = lane & 31, hi = lane >> 5, tid = F.wave * 64 + lane;
    LAS unsigned char* kimg = F.lds + RING_OFF; LAS unsigned char* vimg = F.lds + RING_OFF + 49152;
    LAS float* kstab = (LAS float*)(F.lds + RING_OFF + 98304);
    LAS float* btab = (LAS float*)(F.lds + RING_OFF + 98304 + 2048);
    typedef unsigned u32x2v __attribute__((ext_vector_type(2)));
    const int vcu = F.xgwave >> 3;
    __syncthreads();
    for (int unit = vcu; unit < 3 * 16 * 4 * 8; unit += F.G) {
        const int k = unit & 7, h = (unit >> 3) & 3, b = (unit >> 5) & 15, g = unit >> 9, hh = 4 * g + h;
        const int dil = g == 0 ? 1 : (g == 1 ? 4 : 16);
        const int res0 = g == 0 ? 0 : (g == 1 ? (k >> 1) : 2 * k), j0 = g == 0 ? 8 * k : (g == 1 ? 8 * (k & 1) : 0);
#pragma unroll
        for (int i = 0; i < 12; ++i) { const int q = F.wave * 12 + i, s = q >> 3, pc = q & 7, p = pc & 3;
            int res, jt; bool valid;
            if (g < 2) { res = res0; jt = j0 - 4 + s; valid = jt >= 0; } else { res = res0 + (s >> 2); jt = s & 3; valid = s < 8; }
            if (valid) {
                if (pc < 4) { const int row = 8 * p + (lane >> 3); const size_t trow = (size_t)(b * SEQ + res + (32 * jt + row) * dil);
                    dma16(F.PA + trow * PAP + C_BK + hh * 64 + 8 * ((lane & 7) ^ ((row >> 1) & 7)), kimg + s * 4096 + p * 1024); }
                else { const int key = 8 * p + ((lane & 31) >> 2); const size_t trow = (size_t)(b * SEQ + res + (32 * jt + key) * dil);
                    dma16(F.PA + trow * PAP + C_BV + hh * 64 + (lane >> 5) * 32 + (lane & 3) * 8, vimg + s * 4096 + p * 1024); } } }
        if (tid < 384) { const int s = tid >> 5, kk = tid & 31; int res, jt; bool valid;
            if (g < 2) { res = res0; jt = j0 - 4 + s; valid = jt >= 0; } else { res = res0 + (s >> 2); jt = s & 3; valid = s < 8; }
            if (valid) { const size_t trow = (size_t)(b * SEQ + res + (32 * jt + kk) * dil);
                kstab[tid] = rsqrtf((F.SS[trow * SS_W + 72 + 2 * hh] + F.SS[trow * SS_W + 72 + 2 * hh + 1]) * (1.f / 64.f) + EPS); } }
        if (tid < NBX) btab[tid] = F.BIASX[(g * 4 + h) * NBX + tid];
        const int wres = g < 2 ? res0 : res0 + (F.wave >> 2), j = g < 2 ? j0 + F.wave : (F.wave & 3);
        const int sbase = g < 2 ? 4 - j0 : (F.wave >> 2) * 4;
        const size_t qrow = (size_t)(b * SEQ + wres + (32 * j + r32) * dil);
        const float qs = rsqrtf((F.SS[qrow * SS_W + 48 + 2 * hh] + F.SS[qrow * SS_W + 48 + 2 * hh + 1]) * (1.f / 64.f) + EPS) * (0.125f * LOG2E);
        bf16x8 qf[4];
#pragma unroll
        for (int d0 = 0; d0 < 4; ++d0) { const int dd = 16 * d0 + 8 * hi;
            const v4u raw = *(const v4u*)(F.PA + qrow * PAP + C_BQ + hh * 64 + dd);
            const f32x4 wa = *(const f32x4*)(F.bqw + dd), wb = *(const f32x4*)(F.bqw + dd + 4), ka = *(const f32x4*)(F.bkw + dd), kb = *(const f32x4*)(F.bkw + dd + 4);
            v4u o;
            o.x = cvtpk(bflo(raw.x) * qs * wa.x * ka.x, bfhi(raw.x) * qs * wa.y * ka.y); o.y = cvtpk(bflo(raw.y) * qs * wa.z * ka.z, bfhi(raw.y) * qs * wa.w * ka.w);
            o.z = cvtpk(bflo(raw.z) * qs * wb.x * kb.x, bfhi(raw.z) * qs * wb.y * kb.y); o.w = cvtpk(bflo(raw.w) * qs * wb.z * kb.z, bfhi(raw.w) * qs * wb.w * kb.w);
            qf[d0] = __builtin_bit_cast(bf16x8, o); }
        VM_WAIT0(); __syncthreads();
        float mrun = -1e30f, lrun = 0.f; f32x16 o0 = {}, o1 = {};
        const int ksw = (r32 >> 1) & 7;
        for (int jt = (j >= 4 ? j - 4 : 0); jt <= j; ++jt) {
            const int s = sbase + jt;
            const LAS unsigned char* kb = kimg + s * 4096 + r32 * 128;
            const LAS unsigned char* vb = vimg + s * 4096 + (4 * hi + ((lane & 15) >> 2)) * 64 + ((lane >> 4) & 1) * 32 + (lane & 3) * 8;
            const int bidx = 32 * (j - jt) + r32 + 31 - 4 * hi;
            bf16x8 kf[4]; f32x4 kk[4]; float bb[16]; s16x4 va[2][2], vc[2][2];
#pragma unroll
            for (int d0 = 0; d0 < 4; ++d0) kf[d0] = *(const LAS bf16x8*)(kb + (((2 * d0 + hi) ^ ksw) * 16));
#pragma unroll
            for (int i = 0; i < 4; ++i) { kk[i] = *(const LAS f32x4*)(kstab + s * 32 + 8 * i + 4 * hi);
#pragma unroll
                for (int jj = 0; jj < 4; ++jj) bb[4 * i + jj] = btab[bidx - 8 * i - jj]; }
#pragma unroll
            for (int ss = 0; ss < 2; ++ss)
#pragma unroll
                for (int hh2 = 0; hh2 < 2; ++hh2) { va[ss][hh2] = vtr(vb + (2 * ss) * 1024 + hh2 * 512); vc[ss][hh2] = vtr(vb + (2 * ss + 1) * 1024 + hh2 * 512); }
            __builtin_amdgcn_sched_barrier(0);
            f32x16 st = {};
#pragma unroll
            for (int d0 = 0; d0 < 4; ++d0) st = __builtin_amdgcn_mfma_f32_32x32x16_bf16(kf[d0], qf[d0], st, 0, 0, 0);
            float tmax = -1e30f;
#pragma unroll
            for (int i = 0; i < 4; ++i)
#pragma unroll
                for (int jj = 0; jj < 4; ++jj) { const float sv = st[4 * i + jj] * kk[i][jj] + bb[4 * i + jj]; st[4 * i + jj] = sv; tmax = fmaxf(tmax, sv); }
            tmax = max_x32(tmax);
            const float mnew = fmaxf(mrun, tmax), alpha = __builtin_amdgcn_exp2f(mrun - mnew); mrun = mnew;
            float psum = 0.f;
#pragma unroll
            for (int r = 0; r < 16; ++r) { st[r] = __builtin_amdgcn_exp2f(st[r] - mnew); psum += st[r]; }
            lrun = lrun * alpha + psum;
#pragma unroll
            for (int r = 0; r < 16; ++r) { o0[r] *= alpha; o1[r] *= alpha; }
            v4u p0, p1;
            p0.x = cvtpk(st[0], st[1]); p0.y = cvtpk(st[2], st[3]); p0.z = cvtpk(st[4], st[5]); p0.w = cvtpk(st[6], st[7]);
            p1.x = cvtpk(st[8], st[9]); p1.y = cvtpk(st[10], st[11]); p1.z = cvtpk(st[12], st[13]); p1.w = cvtpk(st[14], st[15]);
#pragma unroll
            for (int ss = 0; ss < 2; ++ss) { const bf16x8 pf = __builtin_bit_cast(bf16x8, ss == 0 ? p0 : p1);
                { const s16x4 a = va[ss][0], c = vc[ss][0]; const bf16x8 vf = {a[0], a[1], a[2], a[3], c[0], c[1], c[2], c[3]}; o0 = __builtin_amdgcn_mfma_f32_32x32x16_bf16(vf, pf, o0, 0, 0, 0); }
                { const s16x4 a = va[ss][1], c = vc[ss][1]; const bf16x8 vf = {a[0], a[1], a[2], a[3], c[0], c[1], c[2], c[3]}; o1 = __builtin_amdgcn_mfma_f32_32x32x16_bf16(vf, pf, o1, 0, 0, 0); } }
        }
        const float ltot = sum_x32(lrun), inv = 1.f / ltot;
        bf16* orow = F.OG + ((size_t)g * HB_ROWS + qrow) * 256 + h * 64 + 8 * hi;
#define AB_ST(OX, DB) do { _Pragma("unroll") for (int kp = 0; kp < 2; ++kp) { v4u w; \
            w.x = cvtpk(OX[8 * kp] * inv, OX[8 * kp + 1] * inv); w.y = cvtpk(OX[8 * kp + 2] * inv, OX[8 * kp + 3] * inv); w.z = cvtpk(OX[8 * kp + 4] * inv, OX[8 * kp + 5] * inv); w.w = cvtpk(OX[8 * kp + 6] * inv, OX[8 * kp + 7] * inv); \
            *(v4u*)(orow + (DB) * 32 + 16 * kp) = swap32x2(w); } } while (0)
        AB_ST(o0, 0); AB_ST(o1, 1);
#undef AB_ST
        if (hi == 0) F.LSE[((size_t)g * HB_ROWS + qrow) * 4 + h] = (mrun + __log2f(ltot)) * LN2;
        __syncthreads();
    }
}

#ifndef G1_STAGGER_TICKS
#define G1_STAGGER_TICKS 0
#endif
#ifndef G1_ALIGN_EPI
#define G1_ALIGN_EPI true
#endif
#ifndef PROBE_REP
#define PROBE_REP -1
#endif
#define REPS(id) for (int rep_ = 0; rep_ < ((PROBE_REP) == (id) ? 2 : 1); ++rep_)
#ifndef MK_PER_PHASE
#define MK_PER_PHASE 0
#endif
constexpr int NPH_HALF = 5, NPHASES = 1 + 2 * NPH_HALF;
struct Args { const float* in[20]; float* out; unsigned char* ws; int ph_lo, ph_hi; };
__global__ void __launch_bounds__(NTHR, 2) mega_fwd(Args args) {
    extern __shared__ __attribute__((aligned(16))) unsigned char lds_raw[];
    Ctx F;
    F.lds = (LAS unsigned char*)lds_raw;
    F.tid = threadIdx.x; F.lane = F.tid & 63; F.wave = __builtin_amdgcn_readfirstlane(F.tid >> 6);
    F.G = gridDim.x; F.gtid = blockIdx.x * NTHR + F.tid; F.T = F.G * NTHR; F.gwave = blockIdx.x * NWAVES + F.wave; F.NW = F.G * NWAVES;
    { const int bx = blockIdx.x; const int vcu = (F.G % 8 == 0) ? (bx % 8) * (F.G / 8) + bx / 8 : bx; F.xgwave = vcu * NWAVES + F.wave; }
    unsigned char* ws = args.ws;
    F.x = args.in[0]; F.mem = args.in[1]; F.norm_w = args.in[2]; F.w_in = args.in[3]; F.gate_b = args.in[4]; F.lnw = args.in[5]; F.lnb = args.in[6]; F.sp_w = args.in[7];
    F.sp_b = args.in[8]; F.bqw = args.in[9]; F.bkw = args.in[10]; F.rel_bias = args.in[11]; F.mem_norm_w = args.in[12]; F.m_w_kv = args.in[13]; F.mqw = args.in[14]; F.mkw = args.in[15];
    F.proj_a = args.in[16]; F.proj_b = args.in[17]; F.proj_m = args.in[18]; F.w_out = args.in[19]; F.out = args.out;
    F.WIN = (bf16*)(ws + WS_WIN); F.PCAT = (bf16*)(ws + WS_PCAT); F.WOUT = (bf16*)(ws + WS_WOUT); F.WSP = (bf16*)(ws + WS_WSP); F.BIAS = (float*)(ws + WS_BIAS); F.BIASX = (float*)(ws + WS_BIAS + 65536);
    F.XN = (bf16*)(ws + WS_XN); F.PA = (bf16*)(ws + WS_PA); F.KVM = (bf16*)(ws + WS_KVM); F.SS = (float*)(ws + WS_SS); F.MKSS = (float*)(ws + WS_MKSS);
    F.cmax = (unsigned*)(ws + WS_CTL + CW_CMAX * 4); F.XN8 = ws + WS_XN8; F.W8 = ws + WS_W8; F.CS = (float*)(ws + WS_CS); F.RS = (float*)(ws + WS_RS);
    F.OG = (bf16*)(ws + WS_OG); F.LSE = (float*)(ws + WS_LSE); F.LNST = (float*)(ws + WS_LNST); F.YC = (bf16*)(ws + WS_YC); F.MRG = (bf16*)(ws + WS_MRG);
    for (int u = F.tid; u < (LDS_BYTES - LDSCTL_OFF) / 4; u += NTHR) ((LAS unsigned*)(F.lds + LDSCTL_OFF))[u] = 0u;
    __syncthreads();
    XcdBarrier bar; bar.bar = (unsigned*)(ws + WS_CTL) + CW_BAR; bar.x = 0; bar.st = nullptr; bar.wave = 0;
    if (!MK_PER_PHASE) bar = xcd_barrier_post((unsigned*)(ws + WS_CTL) + CW_BAR, (volatile LAS unsigned*)(F.lds + MISC_OFF) + 8, F.wave);
    const int lo = args.ph_lo, hi = args.ph_hi;
#define IN(k) (lo <= (k) && (k) < hi)
#define SEAM(k) do { if (IN(k) && IN((k) + 1)) xcd_barrier(bar); } while (0)

    if (IN(0)) { REPS(0) p0_prologue(F); } SEAM(0);
#pragma unroll 1
    for (int hb = 0; hb < 2; ++hb) {
        const int pb = 1 + hb * NPH_HALF, row0 = hb * HB_ROWS;
        asm volatile("v_mbcnt_lo_u32_b32 %0, -1, 0\n\tv_mbcnt_hi_u32_b32 %0, -1, %0" : "=v"(F.lane)); F.tid = F.wave * 64 + F.lane; F.gtid = blockIdx.x * NTHR + F.tid;
#if PROBE_REP == 9 || PROBE_REP == 10
        if (IN(pb + 0)) { pg8::Gemm g{F.XN, F.WIN, MTOT + MMEM, NIN + 1024, DM, DM, DM}; pg8::OrderBF S; S.init(hb, F.G, (int)blockIdx.x);
            typedef pg8::EpiProjT<PROBE_REP - 8> EP; EP E{F.PA, F.KVM, F.SS, F.MKSS, F.gate_b, hb * (HB_ROWS / 256), 0};
            pg8::gemm_phase<EP, pg8::OrderBF, true, true>(F.lds + RING_OFF, g, S, E, F.wave); }
#endif
        if (IN(pb + 0)) REPS(1) {
            pg8::Gemm g{F.XN, F.WIN, MTOT + MMEM, NIN + 1024, DM, DM, DM}; pg8::OrderBF S; S.init(hb, F.G, (int)blockIdx.x);
#if G1_STAGGER_TICKS
            { const unsigned long long t0 = __builtin_amdgcn_s_memrealtime(), dl = (unsigned long long)((blockIdx.x >> 3) & 31) * G1_STAGGER_TICKS;
              while (__builtin_amdgcn_s_memrealtime() - t0 < dl) __builtin_amdgcn_s_sleep(8); }
#endif
            pg8::EpiProj E{F.PA, F.KVM, F.SS, F.MKSS, F.gate_b, hb * (HB_ROWS / 256), 0};
            pg8::gemm_phase<pg8::EpiProj, pg8::OrderBF, G1_ALIGN_EPI, true>(F.lds + RING_OFF, g, S, E, F.wave);
        }
#if PROBE_REP == 16 || PROBE_REP == 17
        if (IN(pb + 0)) { pg8::Gemm g{(const bf16*)F.XN8, (const bf16*)F.W8, MTOT, N8, DM / 2, P8 / 2, P8 / 2}; pg8::OrderG8 S; S.init(hb, F.G, (int)blockIdx.x);
            typedef pg8::EpiProj8T<PROBE_REP == 16 ? 2 : 0> EP; EP E{pg8::EpiProjT<PROBE_REP == 16 ? 2 : 0>{F.PA, F.KVM, F.SS, F.MKSS, F.gate_b, hb * (HB_ROWS / 256), 0}, F.RS, F.CS, F.lds + SCALE_OFF};
            pg8::gemm_phase<EP, pg8::OrderG8, G1_ALIGN_EPI, true, true>(F.lds + RING_OFF, g, S, E, F.wave); }
#endif
        if (IN(pb + 0)) {
            pg8::Gemm g{(const bf16*)F.XN8, (const bf16*)F.W8, MTOT, N8, DM / 2, P8 / 2, P8 / 2}; pg8::OrderG8 S; S.init(hb, F.G, (int)blockIdx.x);
            pg8::EpiProj8 E{pg8::EpiProj{F.PA, F.KVM, F.SS, F.MKSS, F.gate_b, hb * (HB_ROWS / 256), 0}, F.RS, F.CS, F.lds + SCALE_OFF};
            pg8::gemm_phase<pg8::EpiProj8, pg8::OrderG8, G1_ALIGN_EPI, true, true>(F.lds + RING_OFF, g, S, E, F.wave);
        }
#if PROBE_REP == 8
        if (IN(pb + 0)) { pg8::Gemm g{F.XN, F.WIN, MTOT + MMEM, NIN + 1024, DM, DM, DM}; pg8::OrderBF S; S.init(hb, F.G, (int)blockIdx.x); pg8::EpiNull E{};
            pg8::gemm_phase<pg8::EpiNull, pg8::OrderBF, true, true>(F.lds + RING_OFF, g, S, E, F.wave); }
#endif
        SEAM(pb + 0);
        if (IN(pb + 1)) { REPS(2) st_mixA_mfma(F); REPS(3) st_attnB_v3(F); REPS(4) st_attnM_v3(F, hb); } SEAM(pb + 1);
        if (IN(pb + 2)) { REPS(5) st_mergeB_vec(F); } SEAM(pb + 2);
#if PROBE_REP == 13 || PROBE_REP == 14
        if (IN(pb + 3)) { pg8::Gemm g{F.YC, F.PCAT, HB_ROWS, DM, KC, KC, KC}; pg8::StaticOrder S; S.init(HB_ROWS, DM, F.G, (int)blockIdx.x);
            typedef pg8::EpiG2catT<PROBE_REP == 13, PROBE_REP == 14> EP; EP E{F.PA, F.MRG};
            pg8::gemm_phase<EP, pg8::StaticOrder, true, true>(F.lds + RING_OFF, g, S, E, F.wave); }
#endif
#if PROBE_REP == 11
        if (IN(pb + 3)) { pg8::Gemm g{F.YC, F.PCAT, HB_ROWS, DM, KC, KC, KC}; pg8::StaticOrder S; S.init(HB_ROWS, DM, F.G, (int)blockIdx.x); pg8::EpiNull E{};
            pg8::gemm_phase<pg8::EpiNull, pg8::StaticOrder, true, true>(F.lds + RING_OFF, g, S, E, F.wave); }
#endif
#if PROBE_REP == 12
        if (IN(pb + 4)) { pg8::Gemm g{F.MRG, F.WOUT, HB_ROWS, DM, DM, DM, DM}; pg8::StaticOrder S; S.init(HB_ROWS, DM, F.G, (int)blockIdx.x); pg8::EpiNull E{};
            pg8::gemm_phase<pg8::EpiNull, pg8::StaticOrder, true, true>(F.lds + RING_OFF, g, S, E, F.wave); }
#endif
        if (IN(pb + 3)) REPS(6) {
            pg8::Gemm g{F.YC, F.PCAT, HB_ROWS, DM, KC, KC, KC}; pg8::StaticOrder S; S.init(HB_ROWS, DM, F.G, (int)blockIdx.x);
            pg8::EpiG2cat E{F.PA, F.MRG};
            pg8::gemm_phase<pg8::EpiG2cat, pg8::StaticOrder, true, true>(F.lds + RING_OFF, g, S, E, F.wave);
        } SEAM(pb + 3);
        if (IN(pb + 4)) REPS(7) {
            pg8::Gemm g{F.MRG, F.WOUT, HB_ROWS, DM, DM, DM, DM}; pg8::StaticOrder S; S.init(HB_ROWS, DM, F.G, (int)blockIdx.x);
            pg8::EpiG3 E{F.x + (size_t)row0 * DM, F.out + (size_t)row0 * DM};
            pg8::gemm_phase<pg8::EpiG3, pg8::StaticOrder, true, true>(F.lds + RING_OFF, g, S, E, F.wave);
        } if (hb == 1) SEAM(pb + 4);
    }
#undef IN
#undef SEAM
}

extern "C" void kernel_launch(void* const* d_in, const int* in_sizes, int n_in, void* d_out, int out_size, void* d_ws, size_t ws_size, hipStream_t stream) {
    static int grid = 0;
    if (grid == 0) {
        if (n_in != 20 || in_sizes[0] != MTOT * DM || out_size != MTOT * DM || ws_size < WS_END) { fprintf(stderr, "kernel_launch: unexpected shapes (n_in %d, ws %zu); nothing launched\n", n_in, ws_size); grid = -1; return; }
        int dev = 0, cus = 0, per_cu = 0;
        if (hipGetDevice(&dev) != hipSuccess || hipDeviceGetAttribute(&cus, hipDeviceAttributeMultiprocessorCount, dev) != hipSuccess) { grid = -1; return; }
        if (hipFuncSetAttribute((const void*)mega_fwd, hipFuncAttributeMaxDynamicSharedMemorySize, LDS_BYTES) != hipSuccess) { fprintf(stderr, "kernel_launch: hipFuncSetAttribute failed\n"); grid = -1; return; }
        if (hipOccupancyMaxActiveBlocksPerMultiprocessor(&per_cu, (const void*)mega_fwd, NTHR, LDS_BYTES) != hipSuccess || per_cu < 1) { fprintf(stderr, "kernel_launch: occupancy query says %d blocks per CU\n", per_cu); (void)hipGetLastError(); grid = -1; return; }
        grid = cus;
    }
    if (grid < 0) return;
    if (hipMemsetAsync((char*)d_ws + WS_CTL, 0, CTL_ZERO_BYTES, stream) != hipSuccess) return;
    Args a{};
    for (int i = 0; i < 20; ++i) a.in[i] = (const float*)d_in[i];
    a.out = (float*)d_out; a.ws = (unsigned char*)d_ws;
#if MK_PER_PHASE
    for (int p = 0; p < NPHASES; ++p) { a.ph_lo = p; a.ph_hi = p + 1; hipLaunchKernelGGL(mega_fwd, dim3(grid), dim3(NTHR), LDS_BYTES, stream, a); }
#else
    a.ph_lo = 0; a.ph_hi = NPHASES; hipLaunchKernelGGL(mega_fwd, dim3(grid), dim3(NTHR), LDS_BYTES, stream, a);
#endif
}
```

```cpp
#include <hip/hip_runtime.h>
#include <cstdint>
#include <cstdio>

constexpr int DM = 1024, NB = 32, SEQ = 2048, MTOT = NB * SEQ;
constexpr int NIN = 8960, MEML = 256, MMEM = NB * MEML;
constexpr int HB_ROWS = MTOT / 2;
constexpr int C_AU = 0, C_AV = 768, C_AZ = 1536, C_BQ = 2304, C_BK = 3072, C_BV = 3840, C_BZ = 4608, C_MQ = 4864, C_MZ = 5376, C_G = 5888;
constexpr float EPS = 1e-6f;
constexpr int SS_W = 112;
constexpr int PAP = 7424;
constexpr int PA_ROWB = 2 * PAP, PA_GOFF = 2 * C_G;
constexpr int N8 = 6656;
__host__ __device__ constexpr int i8col(int n) { return n >= C_G ? n - C_G : (n >= C_BQ && n < C_BZ) ? n - C_BQ + 3072 : (n >= C_AV && n < C_AZ) ? n - C_AV + 5376 : (n >= C_MQ && n < C_MZ) ? n - C_MQ + 6144 : -1; }
__host__ __device__ constexpr int i8src(int c8) { return c8 < 3072 ? C_G + c8 : c8 < 5376 ? C_BQ + (c8 - 3072) : c8 < 6144 ? C_AV + (c8 - 5376) : C_MQ + (c8 - 6144); }
__host__ __device__ constexpr int i8tile_pn(int t8) { return t8 < 12 ? 23 + t8 : t8 < 21 ? 9 + (t8 - 12) : t8 < 24 ? 3 + (t8 - 21) : 19 + (t8 - 24); }
constexpr int KC = 1536;

constexpr size_t MiB = 1u << 20;
constexpr size_t WS_CTL = 0, CTL_ZERO_BYTES = 64 * 1024, WS_WIN = 2 * MiB, WS_PCAT = 22 * MiB, WS_WOUT = 25 * MiB, WS_WSP = 27 * MiB, WS_BIAS = 27 * MiB + 512 * 1024;
constexpr size_t WS_XN = 32 * MiB, WS_PA = 176 * MiB, WS_KVM = 736 * MiB, WS_SS = 752 * MiB, WS_MKSS = 766 * MiB, WS_OG = 768 * MiB, WS_LSE = 816 * MiB, WS_LNST = 818 * MiB;
constexpr size_t WS_YC = 820 * MiB, WS_MRG = 916 * MiB, WS_END = 980 * MiB;
constexpr int P8 = 1152;
constexpr size_t WS_XN8 = 640 * MiB, WS_W8 = 712 * MiB, WS_CS = 720 * MiB, WS_RS = 721 * MiB;
constexpr int CW_CMAX = 8192;
constexpr int CW_BAR = 4096;

__device__ __forceinline__ float xl_swap32(float x, bool mx) { const unsigned u = __builtin_bit_cast(unsigned, x); const auto r = __builtin_amdgcn_permlane32_swap(u, u, false, false); const unsigned a = r[0], b = r[1];
    const float fa = __builtin_bit_cast(float, a), fb = __builtin_bit_cast(float, b); return mx ? fmaxf(fa, fb) : fa + fb; }
__device__ __forceinline__ float xl_swap16(float x) { const unsigned u = __builtin_bit_cast(unsigned, x); const auto r = __builtin_amdgcn_permlane16_swap(u, u, false, false); const unsigned a = r[0], b = r[1];
    return __builtin_bit_cast(float, a) + __builtin_bit_cast(float, b); }
__device__ __forceinline__ float sum_x32(float x) { return xl_swap32(x, false); }
__device__ __forceinline__ float max_x32(float x) { return xl_swap32(x, true); }
__device__ __forceinline__ float sum_x16_x32(float x) { return xl_swap32(xl_swap16(x), false); }
template <int CTRL> __device__ __forceinline__ float dpp_f(float x) { return __builtin_bit_cast(float, __builtin_amdgcn_update_dpp(0, __builtin_bit_cast(int, x), CTRL, 0xf, 0xf, true)); }
__device__ __forceinline__ float sum_quad(float x) { x += dpp_f<0xB1>(x); return x + dpp_f<0x4E>(x); }
namespace pg8 {
#define PG8_LAS __attribute__((address_space(3)))
typedef unsigned short bf16_t;
typedef short bf16x8 __attribute__((ext_vector_type(8)));
typedef float f32x4 __attribute__((ext_vector_type(4)));
typedef unsigned u32x4 __attribute__((ext_vector_type(4)));
constexpr int BM = 256, BK = 64, HALF = 128, HTB = HALF * BK * 2  , STAGE_BYTES = 8 * HTB, NXCD = 8, WGM = 8;

__host__ __device__ __forceinline__ int lds_byte(int r, int c) { const int st = (r >> 4) * 2 + (c >> 5), rr = r & 15, cc = c & 31, ob = rr * 64 + cc * 2; return st * 1024 + (ob ^ (((ob >> 9) & 1) << 5)); }
__host__ __device__ __forceinline__ void stage_rc(int b, int& R, int& C) { const int st = b / 1024, sb = b % 1024, swz = sb ^ (((sb >> 9) & 1) << 5); R = (st >> 1) * 16 + swz / 64; C = (st & 1) * 32 + (swz % 64) / 2; }
__host__ __device__ __forceinline__ int perm32(int rho) { const int n = rho >> 4, i = rho & 15; return 8 * (i >> 2) + 4 * n + (i & 3); }

struct Unit { int pm, pn; };
struct Gemm { const bf16_t* A; const bf16_t* Bt; int M, N, K, lda, ldb; };

struct StaticOrder {
    int nM, nN, nwg, G, c;
    __host__ __device__ void init(int M, int N, int G_, int c_) { nM = M / BM; nN = N / BM; nwg = nM * nN; G = G_; c = c_; }
    __host__ __device__ bool next(int i, Unit& u) const {
        const long L = (long)i * G + c; if (L >= nwg) return false;
        int wgid = (int)L; { const int q = nwg / NXCD, r = nwg % NXCD, xcd = wgid % NXCD, off = wgid / NXCD; wgid = (xcd < r ? xcd * (q + 1) : r * (q + 1) + (xcd - r) * q) + off; }
        const int nig = WGM * nN, gid = wgid / nig, fm = gid * WGM, gsz = (nM - fm) < WGM ? (nM - fm) : WGM;
        u.pm = fm + ((wgid % nig) % gsz); u.pn = (wgid % nig) / gsz; return true;
    }
    __device__ __forceinline__ void a_ready(const Unit&) const {}
    __device__ __forceinline__ void done(const Unit&) const {}
};


typedef float f32x2c_t __attribute__((ext_vector_type(2))); typedef __bf16 bf16x2c_t __attribute__((ext_vector_type(2)));
__device__ __forceinline__ unsigned cvt_pk_bf16(float lo, float hi) { const f32x2c_t v = {lo, hi}; const bf16x2c_t b = __builtin_convertvector(v, bf16x2c_t); return __builtin_bit_cast(unsigned, b); }
typedef float f32x2 __attribute__((ext_vector_type(2)));
__device__ __forceinline__ f32x2 gelu_pk(f32x2 v) {
    const f32x2 av = __builtin_elementwise_abs(v), d = av * 0.2316418882f + 1.0f;
    f32x2 t; t.x = __builtin_amdgcn_rcpf(d.x); t.y = __builtin_amdgcn_rcpf(d.y);
    f32x2 q = t * 0.5307027145f + (-0.7265760135f); q = q * t + 0.7107068705f; q = q * t + (-0.142248368f); q = q * t + 0.127414796f; q = q * t;
    const f32x2 s = (v * v) * (-0.72134752044f);
    f32x2 e; e.x = __builtin_amdgcn_exp2f(s.x); e.y = __builtin_amdgcn_exp2f(s.y);
    const f32x2 m = v * (q * e), r = v - m;
    f32x2 o; o.x = v.x < 0.f ? m.x : r.x; o.y = v.y < 0.f ? m.y : r.y; return o;
}

typedef int i32x4 __attribute__((ext_vector_type(4)));
template <bool I8> __device__ __forceinline__ f32x4 mma16(bf16x8 a, bf16x8 b, f32x4 c) {
    if constexpr (I8) return __builtin_bit_cast(f32x4, __builtin_amdgcn_mfma_i32_16x16x64_i8(__builtin_bit_cast(i32x4, a), __builtin_bit_cast(i32x4, b), __builtin_bit_cast(i32x4, c), 0, 0, 0));
    else return __builtin_amdgcn_mfma_f32_16x16x32_bf16(a, b, c, 0, 0, 0);
}
template <class Epi, class Sched, bool ALIGN_EPI = false, bool SP2 = false, bool I8 = false>
__device__ __forceinline__ void gemm_phase(PG8_LAS unsigned char* lds, const Gemm g, const Sched& S, const Epi& E, const int wave_id) {
    int tid; asm volatile("v_mbcnt_lo_u32_b32 %0, -1, 0\n\tv_mbcnt_hi_u32_b32 %0, -1, %0" : "=v"(tid)); tid += wave_id * 64;
    const int wid = __builtin_amdgcn_readfirstlane(tid >> 6), lane = tid & 63, wr = wid >> 2, wc = wid & 3, fr = lane & 15, fq = lane >> 4;
    int K = g.K; asm volatile("" : "+s"(K)); const int nt = K / BK;
    unsigned voffA[2], voffB[2];
#pragma unroll
    for (int i = 0; i < 2; ++i) { int R, C; stage_rc(tid * 16 + i * 8192, R, C); const int Rb = Epi::PERM ? ((R & ~31) + perm32(R & 31)) : R;
        voffA[i] = (unsigned)(R * g.lda + C) * 2u; voffB[i] = (unsigned)(Rb * g.ldb + C) * 2u; }
    const size_t kstep = (size_t)(BK * 2);
    const size_t hstepA = (size_t)HALF * g.lda * 2, hstepB = (size_t)HALF * g.ldb * 2;
    const size_t tstepA = 2 * hstepA, tstepB = 2 * hstepB;
    const unsigned ldsw = (unsigned)wid * 1024u;
    const int aoff = lds_byte(wr * 64 + fr, fq * 8), boff = lds_byte(wc * 32 + fr, fq * 8);
#define PG8_SA(b, h) (((b) * 2 + (h)) * HTB)
#define PG8_SB(b, h) ((4 + (b) * 2 + (h)) * HTB)
#define PG8_STAGE(bufoff, gbase, voff) do { _Pragma("unroll") for (int _i = 0; _i < 2; ++_i) \
        __builtin_amdgcn_global_load_lds((const unsigned*)((const char*)(gbase) + (voff)[_i]), (PG8_LAS unsigned*)(lds + (bufoff) + ldsw + _i * 8192), 16, 0, 0); } while (0)
#define PG8_LDA(dst, b, h) do { _Pragma("unroll") for (int m = 0; m < 4; ++m) _Pragma("unroll") for (int k = 0; k < 2; ++k) dst[m][k] = *(const PG8_LAS bf16x8*)(lds + PG8_SA(b, h) + aoff + m * 2048 + k * 1024); } while (0)
#define PG8_LDB(dst, b, h) do { _Pragma("unroll") for (int n = 0; n < 2; ++n) _Pragma("unroll") for (int k = 0; k < 2; ++k) dst[n][k] = *(const PG8_LAS bf16x8*)(lds + PG8_SB(b, h) + boff + n * 2048 + k * 1024); } while (0)
#define PG8_MMA(ai, bj, At, Bt) do { __builtin_amdgcn_s_setprio(1); _Pragma("unroll") for (int m = 0; m < 4; ++m) _Pragma("unroll") for (int n = 0; n < 2; ++n) _Pragma("unroll") for (int k = 0; k < 2; ++k) \
        acc[ai][bj][m][n] = mma16<I8>(Bt[n][k], At[m][k], acc[ai][bj][m][n]); __builtin_amdgcn_s_setprio(0); } while (0)
#define PG8_WAIT_V(n) asm volatile("s_waitcnt vmcnt(" #n ")" ::: "memory")
#define PG8_WAIT_L(n) asm volatile("s_waitcnt lgkmcnt(" #n ")" ::: "memory")
#define PG8_BAR __builtin_amdgcn_s_barrier()
#define PG8_SCHED __builtin_amdgcn_sched_barrier(0)
    Unit cur, nxt; int ui = 0;
    if (!S.next(0, cur)) return;
    f32x4 acc[2][2][4][2];
#pragma unroll
    for (int a = 0; a < 2; ++a)
#pragma unroll
        for (int b = 0; b < 2; ++b)
#pragma unroll
            for (int m = 0; m < 4; ++m)
#pragma unroll
                for (int n = 0; n < 2; ++n) acc[a][b][m][n] = (f32x4){0.f, 0.f, 0.f, 0.f};
    bf16x8 At[4][2], B0[2][2], B1[2][2];
    const char* cA = (const char*)g.A + (size_t)cur.pm * tstepA; const char* cB = (const char*)g.Bt + (size_t)cur.pn * tstepB;
    S.a_ready(cur);
    if constexpr (I8) E.stage_scales(cur, 0, wid, lane);
    if constexpr (SP2) {
        PG8_STAGE(PG8_SB(0, 0), cB, voffB); PG8_STAGE(PG8_SB(0, 1), cB + hstepB, voffB); PG8_STAGE(PG8_SA(0, 0), cA, voffA); PG8_STAGE(PG8_SA(0, 1), cA + hstepA, voffA);
        if (wr == 1) PG8_BAR;
        PG8_WAIT_V(2); PG8_BAR;
        PG8_STAGE(PG8_SB(1, 0), cB + kstep, voffB); PG8_STAGE(PG8_SA(1, 0), cA + kstep, voffA); PG8_STAGE(PG8_SB(1, 1), cB + hstepB + kstep, voffB);
        PG8_WAIT_V(6); PG8_BAR;
    } else {
        PG8_STAGE(PG8_SB(0, 0), cB, voffB); PG8_STAGE(PG8_SA(0, 0), cA, voffA); PG8_STAGE(PG8_SB(0, 1), cB + hstepB, voffB); PG8_STAGE(PG8_SA(0, 1), cA + hstepA, voffA);
        if (wr == 1) PG8_BAR;
        PG8_WAIT_V(4); PG8_BAR;
        PG8_STAGE(PG8_SB(1, 0), cB + kstep, voffB); PG8_STAGE(PG8_SA(1, 0), cA + kstep, voffA); PG8_STAGE(PG8_SB(1, 1), cB + hstepB + kstep, voffB);
        PG8_WAIT_V(6); PG8_BAR;
    }
    for (;;) {
        const bool has_next = S.next(ui + 1, nxt);
        const char* nA = has_next ? (const char*)g.A + (size_t)nxt.pm * tstepA : cA; const char* nB = has_next ? (const char*)g.Bt + (size_t)nxt.pn * tstepB : cB;
        for (int t = 0; t < nt; t += 2) {
            if constexpr (Epi::KHOOK) { if (t == Epi::KH1 || t == Epi::KH2) {
                if constexpr (ALIGN_EPI) { if (wr == 0) PG8_BAR; }
                E.khook(acc, cur, t, wr, wc, fr, fq);
                if constexpr (ALIGN_EPI) { if (wr == 1) PG8_BAR; } } }
            const bool last = (t == nt - 2);
            const char* a1 = cA + (size_t)(t + 1) * kstep;
            const char* a2 = last ? nA : cA + (size_t)(t + 2) * kstep; const char* b2 = last ? nB : cB + (size_t)(t + 2) * kstep;
            const char* a3 = a2 + kstep; const char* b3 = b2 + kstep;
            if (last && has_next) S.a_ready(nxt);
            if constexpr (I8) { if (last && has_next) E.stage_scales(nxt, (ui + 1) & 1, wid, lane); }
            if constexpr (SP2) {
            PG8_LDB(B0, 0, 0); PG8_LDB(B1, 0, 1); PG8_SCHED; PG8_LDA(At, 0, 0); PG8_STAGE(PG8_SA(1, 1), a1 + hstepA, voffA);
            PG8_WAIT_V(8); PG8_WAIT_L(0); PG8_BAR; PG8_MMA(0, 0, At, B0); PG8_MMA(0, 1, At, B1); PG8_BAR; PG8_SCHED;
            PG8_LDA(At, 0, 1); PG8_STAGE(PG8_SB(0, 0), b2, voffB); PG8_STAGE(PG8_SB(0, 1), b2 + hstepB, voffB); PG8_STAGE(PG8_SA(0, 0), a2, voffA);
            PG8_WAIT_V(8); PG8_WAIT_L(0); PG8_BAR; PG8_MMA(1, 0, At, B0); PG8_MMA(1, 1, At, B1); PG8_BAR; PG8_SCHED;
            PG8_LDB(B0, 1, 0); PG8_LDB(B1, 1, 1); PG8_SCHED; PG8_LDA(At, 1, 0); PG8_STAGE(PG8_SA(0, 1), a2 + hstepA, voffA);
            PG8_WAIT_V(8); PG8_WAIT_L(0); PG8_BAR; PG8_MMA(0, 0, At, B0); PG8_MMA(0, 1, At, B1); PG8_BAR; PG8_SCHED;
            PG8_LDA(At, 1, 1); PG8_STAGE(PG8_SB(1, 0), b3, voffB); PG8_STAGE(PG8_SB(1, 1), b3 + hstepB, voffB); PG8_STAGE(PG8_SA(1, 0), a3, voffA);
            PG8_WAIT_V(8); PG8_WAIT_L(0); PG8_BAR; PG8_MMA(1, 0, At, B0); PG8_MMA(1, 1, At, B1); PG8_BAR; PG8_SCHED;
            } else {
            PG8_LDB(B0, 0, 0); PG8_SCHED; PG8_LDA(At, 0, 0); PG8_STAGE(PG8_SA(1, 1), a1 + hstepA, voffA);
            PG8_WAIT_L(8); PG8_BAR; PG8_WAIT_L(0); PG8_MMA(0, 0, At, B0); PG8_BAR; PG8_SCHED;
            PG8_LDB(B1, 0, 1); PG8_STAGE(PG8_SB(0, 0), b2, voffB);
            PG8_BAR; PG8_WAIT_L(0); PG8_MMA(0, 1, At, B1); PG8_BAR;
            PG8_LDA(At, 0, 1); PG8_STAGE(PG8_SA(0, 0), a2, voffA);
            PG8_BAR; PG8_WAIT_L(0); PG8_MMA(1, 0, At, B0); PG8_BAR; PG8_SCHED;
            PG8_STAGE(PG8_SB(0, 1), b2 + hstepB, voffB);
            PG8_WAIT_V(6); PG8_BAR; PG8_MMA(1, 1, At, B1); PG8_BAR;
            PG8_LDB(B0, 1, 0); PG8_SCHED; PG8_LDA(At, 1, 0); PG8_STAGE(PG8_SA(0, 1), a2 + hstepA, voffA);
            PG8_WAIT_L(8); PG8_BAR; PG8_WAIT_L(0); PG8_MMA(0, 0, At, B0); PG8_BAR; PG8_SCHED;
            PG8_LDB(B1, 1, 1); PG8_STAGE(PG8_SB(1, 0), b3, voffB);
            PG8_BAR; PG8_WAIT_L(0); PG8_MMA(0, 1, At, B1); PG8_BAR;
            PG8_LDA(At, 1, 1); PG8_STAGE(PG8_SA(1, 0), a3, voffA);
            PG8_BAR; PG8_WAIT_L(0); PG8_MMA(1, 0, At, B0); PG8_BAR; PG8_SCHED;
            PG8_STAGE(PG8_SB(1, 1), b3 + hstepB, voffB);
            PG8_WAIT_V(6); PG8_BAR; PG8_MMA(1, 1, At, B1); PG8_BAR;
            }
        }
        if constexpr (ALIGN_EPI) { if (wr == 0) PG8_BAR; }
        if constexpr (I8) { _Pragma("unroll") for (int a_ = 0; a_ < 2; ++a_) _Pragma("unroll") for (int b_ = 0; b_ < 2; ++b_) _Pragma("unroll") for (int m_ = 0; m_ < 4; ++m_) _Pragma("unroll") for (int n_ = 0; n_ < 2; ++n_) acc[a_][b_][m_][n_] = __builtin_convertvector(__builtin_bit_cast(i32x4, acc[a_][b_][m_][n_]), f32x4); }
        if constexpr (I8) { E.epi8(acc, cur, ui & 1, wr, wc, fr, fq); S.done(cur); }
        else if constexpr (!Epi::AFTER_DRAIN) { E(acc, cur, wr, wc, fr, fq); S.done(cur); }
        if (!has_next) break;
#pragma unroll
        for (int a = 0; a < 2; ++a)
#pragma unroll
            for (int b = 0; b < 2; ++b)
#pragma unroll
                for (int m = 0; m < 4; ++m)
#pragma unroll
                    for (int n = 0; n < 2; ++n) { f32x2 z0, z1; asm volatile("v_mov_b64 %0, 0\n\tv_mov_b64 %1, 0" : "=v"(z0), "=v"(z1)); acc[a][b][m][n] = (f32x4){z0.x, z0.y, z1.x, z1.y}; }
        cur = nxt; cA = nA; cB = nB; ++ui;
        if constexpr (ALIGN_EPI) { if (wr == 1) PG8_BAR; }
    }
    PG8_WAIT_V(0);
    if constexpr (!ALIGN_EPI) { if (wr == 0) PG8_BAR; }
    PG8_BAR;
    if constexpr (Epi::AFTER_DRAIN) { E.fused(acc, cur, wr, wc, fr, fq, lds, wid, lane); S.done(cur); }
#undef PG8_SA
#undef PG8_SB
#undef PG8_STAGE
#undef PG8_LDA
#undef PG8_LDB
#undef PG8_MMA
#undef PG8_WAIT_V
#undef PG8_WAIT_L
#undef PG8_BAR
#undef PG8_SCHED
}
}

#ifndef G1_EPI_DRAIN
#define G1_EPI_DRAIN 0
#endif
#ifndef G1_STORE_AUX_MIX
#define G1_STORE_AUX_MIX 2
#endif
#ifndef G1_STORE_AUX
#define G1_STORE_AUX 2
#endif
namespace pg8 {
__device__ __forceinline__ int gate_srow(int wr, int wc, int ai, int m, int bj, int fq) { return 2 * ((((wr * 4 + wc) * 2 + ai) * 4 + m) * 2 + bj) + (fq >> 1); }
__device__ __forceinline__ float ubf0(unsigned w) { return (float)(w & 0xffu); }
__device__ __forceinline__ float ubf1(unsigned w) { return (float)((w >> 8) & 0xffu); }
__device__ __forceinline__ float ubf2(unsigned w) { return (float)((w >> 16) & 0xffu); }
__device__ __forceinline__ float ubf3(unsigned w) { return (float)(w >> 24); }
__device__ __forceinline__ float ex2(float x) { return __builtin_amdgcn_exp2f(x); }
__device__ __forceinline__ float sigm_fast(float x) { return __builtin_amdgcn_rcpf(1.0f + ex2(x * -1.4426950408889634f)); }
template <int MODE = 0  > struct EpiProjT {
    static constexpr bool PERM = true, AFTER_DRAIN = false, KHOOK = false;
    bf16_t* PA; bf16_t* KVM; float* SS; float* MKSS; const float* gate_b; int pm0; int pad;
    template <int KIND, int STAT> __device__ __forceinline__ void body(const f32x4 (&acc)[2][2][4][2], const __amdgpu_buffer_rsrc_t rsrc, int row0, int col0, int ldc, float* sb, int sld, int so, const float* bias, int wc, int fq) const {
        f32x4 bv[2][2];
        if (KIND == 3) {
#pragma unroll
            for (int bj = 0; bj < 2; ++bj)
#pragma unroll
                for (int n = 0; n < 2; ++n) bv[bj][n] = *(const f32x4*)(bias + bj * HALF + 4 * n);
        }
#pragma unroll
        for (int ai = 0; ai < 2; ++ai)
#pragma unroll
            for (int m = 0; m < 4; ++m) { const int row = row0 + ai * HALF + m * 16; const unsigned rowoff = ((unsigned)row * (unsigned)ldc + (unsigned)col0) * 2u;
#pragma unroll
                for (int bj = 0; bj < 2; ++bj) { f32x4 v0 = acc[ai][bj][m][0], v1 = acc[ai][bj][m][1];
                    if (KIND == 1) { f32x2 a = gelu_pk((f32x2){v0[0], v0[1]}), b = gelu_pk((f32x2){v0[2], v0[3]}), c = gelu_pk((f32x2){v1[0], v1[1]}), d = gelu_pk((f32x2){v1[2], v1[3]});
                        v0 = (f32x4){a.x, a.y, b.x, b.y}; v1 = (f32x4){c.x, c.y, d.x, d.y}; }
                    else if (KIND == 2) {
#pragma unroll
                        for (int j = 0; j < 4; ++j) { v0[j] = v0[j] * sigm_fast(v0[j]); v1[j] = v1[j] * sigm_fast(v1[j]); } }
                    else if (KIND == 3) { v0 = v0 + bv[bj][0]; v1 = v1 + bv[bj][1];
#pragma unroll
                        for (int j = 0; j < 4; ++j) { v0[j] = sigm_fast(v0[j]); v1[j] = sigm_fast(v1[j]); } }
                    if (STAT) {
                        float s = ((v0[0] + v0[1]) + (v0[2] + v0[3])) + ((v1[0] + v1[1]) + (v1[2] + v1[3]));
                        float q = ((v0[0] * v0[0] + v0[1] * v0[1]) + (v0[2] * v0[2] + v0[3] * v0[3])) + ((v1[0] * v1[0] + v1[1] * v1[1]) + (v1[2] * v1[2] + v1[3] * v1[3]));
                        if (STAT == 2) s = sum_x16_x32(s);
                        q = sum_x16_x32(q);
                        if (fq == 0) { float* sp = sb + (size_t)row * sld + so; const int blk = 4 * bj + wc;
                            if (STAT == 2) { sp[2 * blk] = s; sp[2 * blk + 1] = q; } else sp[blk] = q; }
                    }
                    u32x4 w; w.x = cvt_pk_bf16(v0[0], v0[1]); w.y = cvt_pk_bf16(v0[2], v0[3]); w.z = cvt_pk_bf16(v1[0], v1[1]); w.w = cvt_pk_bf16(v1[2], v1[3]);
                    if (MODE == 2) asm volatile("" :: "v"(w)); else __builtin_amdgcn_raw_buffer_store_b128(w, rsrc, (int)(rowoff + bj * HALF * 2), 0, KIND == 3 ? G1_STORE_AUX : G1_STORE_AUX_MIX); } }
    }
    __device__ __forceinline__ void uz_body(const f32x4 (&acc)[2][2][4][2], const __amdgpu_buffer_rsrc_t rsrc, int row0, int ucol0) const {
#pragma unroll
        for (int ai = 0; ai < 2; ++ai)
#pragma unroll
            for (int m = 0; m < 4; ++m) { const int row = row0 + ai * HALF + m * 16;
                f32x4 u0 = acc[ai][0][m][0], u1 = acc[ai][0][m][1]; const f32x4 z0 = acc[ai][1][m][0], z1 = acc[ai][1][m][1];
                { f32x2 a = gelu_pk((f32x2){u0[0], u0[1]}), b = gelu_pk((f32x2){u0[2], u0[3]}), c = gelu_pk((f32x2){u1[0], u1[1]}), d = gelu_pk((f32x2){u1[2], u1[3]});
                  u0 = (f32x4){a.x, a.y, b.x, b.y}; u1 = (f32x4){c.x, c.y, d.x, d.y}; }
#pragma unroll
                for (int j = 0; j < 4; ++j) { u0[j] *= z0[j] * sigm_fast(z0[j]); u1[j] *= z1[j] * sigm_fast(z1[j]); }
                u32x4 w; w.x = cvt_pk_bf16(u0[0], u0[1]); w.y = cvt_pk_bf16(u0[2], u0[3]); w.z = cvt_pk_bf16(u1[0], u1[1]); w.w = cvt_pk_bf16(u1[2], u1[3]);
                if (MODE == 2) asm volatile("" :: "v"(w)); else __builtin_amdgcn_raw_buffer_store_b128(w, rsrc, (int)((unsigned)row * (unsigned)PA_ROWB + (unsigned)(2 * (C_AU + ucol0))), 0, G1_STORE_AUX_MIX); }
    }
    __device__ __forceinline__ void gate_body(const f32x4 (&acc)[2][2][4][2], const __amdgpu_buffer_rsrc_t rsrc, int row0, int gcol0, const float* bias) const {
        f32x4 bv[2][2];
#pragma unroll
        for (int bj = 0; bj < 2; ++bj)
#pragma unroll
            for (int n = 0; n < 2; ++n) bv[bj][n] = *(const f32x4*)(bias + 8 * bj + 4 * n);
#pragma unroll
        for (int ai = 0; ai < 2; ++ai)
#pragma unroll
            for (int m = 0; m < 4; ++m) { const int row = row0 + ai * HALF + m * 16; u32x4 w;
#pragma unroll
                for (int bj = 0; bj < 2; ++bj)
#pragma unroll
                    for (int n = 0; n < 2; ++n) { const f32x4 v = acc[ai][bj][m][n] + bv[bj][n]; unsigned d = 0u;
#pragma unroll
                        for (int j = 0; j < 4; ++j) d |= (unsigned)(fmaxf(sigm_fast(v[j]) * 255.0f, 1.0f) + 0.5f) << (8 * j);
                        w[2 * bj + n] = d; }
                if (MODE == 2) asm volatile("" :: "v"(w)); else __builtin_amdgcn_raw_buffer_store_b128(w, rsrc, (int)((unsigned)row * (unsigned)PA_ROWB + (unsigned)(PA_GOFF + gcol0)), 0, G1_STORE_AUX); }
    }
    __device__ __forceinline__ void operator()(const f32x4 (&acc)[2][2][4][2], const Unit& u, int wr, int wc, int fr, int fq) const {
        const bool kv = u.pn >= 35; const int pn = kv ? u.pn - 35 : u.pn;
        const int rowt = kv ? (u.pm - 256) * BM : (u.pm - pm0) * BM;
        bf16_t* base = kv ? KVM : PA; const int ldc = kv ? 1024 : PAP;
        const __amdgpu_buffer_rsrc_t rsrc = __builtin_amdgcn_make_buffer_rsrc(base, 0, kv ? (int)((size_t)MMEM * 1024 * 2) : (int)((size_t)HB_ROWS * PA_ROWB), 0x00020000);
        const int row0 = rowt + wr * 64 + fr, col0 = pn * BM + wc * 32 + 8 * fq;
        if (MODE == 1) { body<0, 0>(acc, rsrc, row0, col0, ldc, SS, SS_W, 0, gate_b, wc, fq); return; }
        if (kv) { if (pn < 2) body<0, 1>(acc, rsrc, row0, col0, ldc, MKSS, 16, 8 * pn, gate_b, wc, fq); else body<0, 0>(acc, rsrc, row0, col0, ldc, SS, SS_W, 0, gate_b, wc, fq); }
        else if (pn < 3) uz_body(acc, rsrc, row0, 128 * pn + 32 * wc + 8 * fq);
        else if (pn < 6) body<1, 2>(acc, rsrc, row0, col0, ldc, SS, SS_W, 16 * (pn - 3), gate_b, wc, fq);
        else if (pn < 9) uz_body(acc, rsrc, row0, 128 * (pn - 3) + 32 * wc + 8 * fq);
        else if (pn < 12) body<0, 1>(acc, rsrc, row0, col0, ldc, SS, SS_W, 48 + 8 * (pn - 9), gate_b, wc, fq);
        else if (pn < 15) body<0, 1>(acc, rsrc, row0, col0, ldc, SS, SS_W, 72 + 8 * (pn - 12), gate_b, wc, fq);
        else if (pn < 18) body<0, 0>(acc, rsrc, row0, col0, ldc, SS, SS_W, 0, gate_b, wc, fq);
        else if (pn < 19) body<2, 0>(acc, rsrc, row0, col0, ldc, SS, SS_W, 0, gate_b, wc, fq);
        else if (pn < 21) body<0, 1>(acc, rsrc, row0, col0, ldc, SS, SS_W, 96 + 8 * (pn - 19), gate_b, wc, fq);
        else if (pn < 23) body<2, 0>(acc, rsrc, row0, col0, ldc, SS, SS_W, 0, gate_b, wc, fq);
        else { const int gc = (pn - 23) * BM + 64 * wc + 16 * fq; gate_body(acc, rsrc, row0, gc, gate_b + gc); }
#if G1_EPI_DRAIN
        asm volatile("s_waitcnt vmcnt(0)" ::: "memory");
#endif
    }
};
typedef EpiProjT<0> EpiProj;
template <bool HOOKS = true, bool EPI = true> struct EpiG2catT {
    static constexpr bool PERM = true, AFTER_DRAIN = false, KHOOK = HOOKS; static constexpr int KH1 = 12, KH2 = 16;
    const bf16_t* PA; bf16_t* MRG;
    __device__ __forceinline__ void khook(f32x4 (&acc)[2][2][4][2], const Unit& u, int t, int wr, int wc, int fr, int fq) const {
        typedef unsigned u32x2v __attribute__((ext_vector_type(2)));
        const int ga = t == KH1 ? 0 : 1;
        const __amdgpu_buffer_rsrc_t grs = __builtin_amdgcn_make_buffer_rsrc((void*)PA, 0, (int)((size_t)HB_ROWS * PA_ROWB), 0x00020000);
        const int gvo = (u.pm * BM + gate_srow(wr, wc, 0, 0, 0, fq)) * PA_ROWB + PA_GOFF + ga * DM + u.pn * BM + 16 * fr + 8 * (fq & 1);
        u32x2v ag[2][4][2], bg[2][4][2];
#pragma unroll
        for (int ai = 0; ai < 2; ++ai)
#pragma unroll
            for (int m = 0; m < 4; ++m)
#pragma unroll
                for (int bj = 0; bj < 2; ++bj) { const int so = gate_srow(0, 0, ai, m, bj, 0) * PA_ROWB; ag[ai][m][bj] = __builtin_bit_cast(u32x2v, __builtin_amdgcn_raw_buffer_load_b64(grs, gvo, so, 0)); bg[ai][m][bj] = __builtin_bit_cast(u32x2v, __builtin_amdgcn_raw_buffer_load_b64(grs, gvo + DM, so, 0)); }
        __builtin_amdgcn_sched_barrier(0);
#define G2_R(A, Bv, K) (ubf##K(A) * __builtin_amdgcn_rcpf(ubf##K(Bv)))
#pragma unroll
        for (int ai = 0; ai < 2; ++ai)
#pragma unroll
            for (int m = 0; m < 4; ++m)
#pragma unroll
                for (int bj = 0; bj < 2; ++bj) { const u32x2v a = ag[ai][m][bj], b = bg[ai][m][bj]; f32x4 r0, r1;
                    r0[0] = G2_R(a.x, b.x, 0); r0[1] = G2_R(a.x, b.x, 1); r0[2] = G2_R(a.x, b.x, 2); r0[3] = G2_R(a.x, b.x, 3);
                    r1[0] = G2_R(a.y, b.y, 0); r1[1] = G2_R(a.y, b.y, 1); r1[2] = G2_R(a.y, b.y, 2); r1[3] = G2_R(a.y, b.y, 3);
                    acc[ai][bj][m][0] *= r0; acc[ai][bj][m][1] *= r1; }
#undef G2_R
    }
    __device__ __forceinline__ void operator()(const f32x4 (&acc)[2][2][4][2], const Unit& u, int wr, int wc, int fr, int fq) const {
        typedef unsigned u32x2v __attribute__((ext_vector_type(2)));
        if (!EPI) { _Pragma("unroll") for (int ai = 0; ai < 2; ++ai) _Pragma("unroll") for (int bj = 0; bj < 2; ++bj) _Pragma("unroll") for (int m = 0; m < 4; ++m) asm volatile("" :: "v"(acc[ai][bj][m][0]), "v"(acc[ai][bj][m][1])); return; }
        const int row0 = u.pm * BM + wr * 64 + fr, col0 = u.pn * BM + wc * 32 + 8 * fq;
        const __amdgpu_buffer_rsrc_t grs = __builtin_amdgcn_make_buffer_rsrc((void*)PA, 0, (int)((size_t)HB_ROWS * PA_ROWB), 0x00020000);
        const int gvo = (u.pm * BM + gate_srow(wr, wc, 0, 0, 0, fq)) * PA_ROWB + PA_GOFF + 2 * DM + u.pn * BM + 16 * fr + 8 * (fq & 1);
        u32x2v gv[2][4][2];
#pragma unroll
        for (int ai = 0; ai < 2; ++ai)
#pragma unroll
            for (int m = 0; m < 4; ++m)
#pragma unroll
                for (int bj = 0; bj < 2; ++bj) gv[ai][m][bj] = __builtin_bit_cast(u32x2v, __builtin_amdgcn_raw_buffer_load_b64(grs, gvo, gate_srow(0, 0, ai, m, bj, 0) * PA_ROWB, 0));
        __builtin_amdgcn_sched_barrier(0);
        const float q = 1.0f / 255.0f;
#pragma unroll
        for (int ai = 0; ai < 2; ++ai)
#pragma unroll
            for (int m = 0; m < 4; ++m) { bf16_t* mp = MRG + (size_t)(row0 + ai * HALF + m * 16) * DM + col0;
#pragma unroll
                for (int bj = 0; bj < 2; ++bj) { const u32x2v g = gv[ai][m][bj]; const f32x4 v0 = acc[ai][bj][m][0] * q, v1 = acc[ai][bj][m][1] * q; u32x4 w;
                    w.x = cvt_pk_bf16(v0[0] * ubf0(g.x), v0[1] * ubf1(g.x)); w.y = cvt_pk_bf16(v0[2] * ubf2(g.x), v0[3] * ubf3(g.x));
                    w.z = cvt_pk_bf16(v1[0] * ubf0(g.y), v1[1] * ubf1(g.y)); w.w = cvt_pk_bf16(v1[2] * ubf2(g.y), v1[3] * ubf3(g.y));
                    *(u32x4*)(mp + bj * HALF) = w; } }
    }
};
typedef EpiG2catT<true, true> EpiG2cat;
struct EpiG3 {
    static constexpr bool PERM = false, AFTER_DRAIN = false, KHOOK = false;
    const float* x; float* out;
    static __device__ __forceinline__ f32x4 pairx(f32x4 keep, f32x4 other, bool take) { f32x4 r;
#pragma unroll
        for (int j = 0; j < 4; ++j) { const float kj = keep[j], oj = other[j]; const float t = __builtin_bit_cast(float, __builtin_amdgcn_update_dpp(0, __builtin_bit_cast(int, oj), 0xB1, 0xf, 0xf, true)); r[j] = take ? t : kj; }
        return r; }
    __device__ __forceinline__ void operator()(const f32x4 (&acc)[2][2][4][2], const Unit& u, int wr, int wc, int fr, int fq) const {
        __builtin_amdgcn_s_waitcnt(0xC07F);
        const bool odd = fr & 1;
        const int row0 = u.pm * BM + wr * 64 + fr, col0 = u.pn * BM + wc * 32 + 4 * fq;
        const size_t lbase = (size_t)(row0 & ~1) * DM + col0 + (odd ? 16 : 0);
        f32x4 xa[2][2][2], xb[2][2][2];
#define G3_LOAD(B) do { _Pragma("unroll") for (int mm = 0; mm < 2; ++mm) { const size_t off_ = lbase + (size_t)(((B) >> 1) * HALF + (2 * ((B) & 1) + mm) * 16) * DM; \
            _Pragma("unroll") for (int bj = 0; bj < 2; ++bj) { xa[(B) & 1][mm][bj] = __builtin_nontemporal_load((const f32x4*)(x + off_ + bj * HALF)); xb[(B) & 1][mm][bj] = __builtin_nontemporal_load((const f32x4*)(x + off_ + DM + bj * HALF)); } } } while (0)
#define G3_STORE(B) do { _Pragma("unroll") for (int mm = 0; mm < 2; ++mm) { const size_t off_ = lbase + (size_t)(((B) >> 1) * HALF + (2 * ((B) & 1) + mm) * 16) * DM; \
            _Pragma("unroll") for (int bj = 0; bj < 2; ++bj) { const f32x4 c0_ = acc[(B) >> 1][bj][2 * ((B) & 1) + mm][0], c1_ = acc[(B) >> 1][bj][2 * ((B) & 1) + mm][1]; \
                const f32x4 ca = pairx(c0_, c1_, odd), cb = pairx(c1_, c0_, !odd);                    \
                __builtin_nontemporal_store(xa[(B) & 1][mm][bj] + ca, (f32x4*)(out + off_ + bj * HALF)); \
                __builtin_nontemporal_store(xb[(B) & 1][mm][bj] + cb, (f32x4*)(out + off_ + DM + bj * HALF)); } } } while (0)
        G3_LOAD(0); G3_LOAD(1); __builtin_amdgcn_sched_barrier(0); G3_STORE(0); G3_LOAD(2); __builtin_amdgcn_sched_barrier(0); G3_STORE(1); G3_LOAD(3); __builtin_amdgcn_sched_barrier(0); G3_STORE(2); G3_STORE(3);
#undef G3_LOAD
#undef G3_STORE
    }
};
struct EpiNull {
    static constexpr bool PERM = true, AFTER_DRAIN = false, KHOOK = false;
    __device__ __forceinline__ void operator()(const f32x4 (&acc)[2][2][4][2], const Unit& u, int wr, int wc, int fr, int fq) const {
#pragma unroll
        for (int ai = 0; ai < 2; ++ai)
#pragma unroll
            for (int bj = 0; bj < 2; ++bj)
#pragma unroll
                for (int m = 0; m < 4; ++m) asm volatile("" :: "v"(acc[ai][bj][m][0]), "v"(acc[ai][bj][m][1]));
    }
};
struct OrderG1 {
    StaticOrder so; int pm0, nkv, pn0;
    __device__ void init(int hb, int G, int c, int pn0_, int ntiles, bool with_kv) { so.init(HB_ROWS, ntiles * BM, G, c); pm0 = hb * (HB_ROWS / BM); pn0 = pn0_; nkv = with_kv ? (MMEM / BM) * 4 : 0; }
    __device__ bool next(int i, Unit& u) const {
        if (so.next(i, u)) { u.pm += pm0; u.pn += pn0; return true; }
        const long j = (long)i * so.G + so.c - so.nwg; if (j < 0 || j >= nkv) return false;
        u.pm = 256 + (int)(j >> 2); u.pn = 35 + (int)(j & 3); return true;
    }
    __device__ __forceinline__ void a_ready(const Unit&) const {}
    __device__ __forceinline__ void done(const Unit&) const {}
};
struct OrderBF {
    StaticOrder so; int pm0, nkv;
    __device__ void init(int hb, int G, int c) { so.init(HB_ROWS, 9 * BM, G, c); pm0 = hb * (HB_ROWS / BM); nkv = hb == 0 ? (MMEM / BM) * 4 : 0; }
    __device__ bool next(int i, Unit& u) const {
        if (so.next(i, u)) { u.pm += pm0; const int t = u.pn; u.pn = t < 3 ? t : t < 6 ? t + 3 : t == 6 ? 18 : t + 14; return true; }
        const long j = (long)i * so.G + so.c - so.nwg; if (j < 0 || j >= nkv) return false;
        u.pm = 256 + (int)(j >> 2); u.pn = 35 + (int)(j & 3); return true;
    }
    __device__ __forceinline__ void a_ready(const Unit&) const {}
    __device__ __forceinline__ void done(const Unit&) const {}
};
struct OrderG8 {
    StaticOrder so; int pm0, bal;
    __device__ void init(int hb, int G, int c) { so.init(HB_ROWS, 26 * BM, G, c); pm0 = hb * (HB_ROWS / BM); bal = (hb == 1 && G == 256) ? 1 : 0; }
    __device__ bool next(int i, Unit& u) const {
        bool ok;
        if (!bal) ok = so.next(i, u);
        else { if (i < 12) ok = so.next(i, u); else { if (so.c < 128 || i > 13) return false; StaticOrder t = so; t.c = 2 * (so.c - 128) + (i - 12); ok = t.next(12, u); } }
        if (ok) u.pm += pm0; return ok;
    }
    __device__ __forceinline__ void a_ready(const Unit&) const {}
    __device__ __forceinline__ void done(const Unit&) const {}
};
template <int MODE8 = 0> struct EpiProj8T {
    static constexpr bool PERM = true, AFTER_DRAIN = false, KHOOK = false;
    EpiProjT<MODE8> base; const float* RS; const float* CS; PG8_LAS unsigned char* sl;
    __device__ __forceinline__ void gate8_body(const f32x4 (&acc)[2][2][4][2], const __amdgpu_buffer_rsrc_t rsrc, int trow, int t8, int wr, int wc, int fr, int fq, const PG8_LAS float* bias) const {
        constexpr float L2E = 1.4426950408889634f, C = 254.0f / 255.0f;
        f32x2 cb[2][2][2];
#pragma unroll
        for (int bj = 0; bj < 2; ++bj)
#pragma unroll
            for (int n = 0; n < 2; ++n) { const f32x4 b = *(const PG8_LAS f32x4*)(bias + 8 * bj + 4 * n); cb[bj][n][0] = (f32x2){b[0], b[1]} * L2E; cb[bj][n][1] = (f32x2){b[2], b[3]} * L2E; }
#pragma unroll
        for (int ai = 0; ai < 2; ++ai)
#pragma unroll
            for (int m = 0; m < 4; ++m) { const int row = trow + gate_srow(wr, 2 * (wc & 1) + (fq >> 1), ai, m, wc >> 1, 2 * (fq & 1)); u32x4 w;
#pragma unroll
                for (int bj = 0; bj < 2; ++bj)
#pragma unroll
                    for (int n = 0; n < 2; ++n) { const f32x4 v = acc[ai][bj][m][n]; unsigned p[2];
#pragma unroll
                        for (int h = 0; h < 2; ++h) { const f32x2 x = {v[2 * h], v[2 * h + 1]}; const f32x2 e = x * L2E + cb[bj][n][h];
                            f32x2 ex; ex.x = ex2(e.x); ex.y = ex2(e.y); const f32x2 den = ex * C + C;
                            f32x2 sc; sc.x = __builtin_amdgcn_fmed3f(__builtin_amdgcn_rcpf(den.x), 0.0f, 1.0f); sc.y = __builtin_amdgcn_fmed3f(__builtin_amdgcn_rcpf(den.y), 0.0f, 1.0f);
                            const f32x2 q = sc * (-254.0f) + 8388863.0f;
                            const float qx = q.x, qy = q.y;
                            p[h] = __builtin_amdgcn_perm(__builtin_bit_cast(unsigned, qy), __builtin_bit_cast(unsigned, qx), 0x0c0c0400u); }
                        w[2 * bj + n] = __builtin_amdgcn_perm(p[1], p[0], 0x05040100u); }
                if (MODE8 == 2) asm volatile("" :: "v"(w)); else __builtin_amdgcn_raw_buffer_store_b128(w, rsrc, (int)((unsigned)row * (unsigned)PA_ROWB + (unsigned)(PA_GOFF + t8 * BM + 16 * fr)), 0, G1_STORE_AUX); }
    }
    __device__ __forceinline__ void stage_scales(const Unit& u, int par, int wid, int lane) const {
        PG8_LAS unsigned char* d = sl + par * 3072;
        if (wid < 4) { __builtin_amdgcn_global_load_lds((const unsigned*)(CS + u.pn * BM + 64 * wid + lane), (PG8_LAS unsigned*)(d + 256 * wid), 4, 0, 0);
            if (u.pn < 12) __builtin_amdgcn_global_load_lds((const unsigned*)(base.gate_b + u.pn * BM + 64 * wid + lane), (PG8_LAS unsigned*)(d + 2048 + 256 * wid), 4, 0, 0); }
        else __builtin_amdgcn_global_load_lds((const unsigned*)(RS + u.pm * BM + 64 * (wid - 4) + lane), (PG8_LAS unsigned*)(d + 1024 + 256 * (wid - 4)), 4, 0, 0);
    }
    __device__ __forceinline__ void epi8(f32x4 (&acc)[2][2][4][2], const Unit& u, int par, int wr, int wc, int fr, int fq) const {
        const PG8_LAS float* d = (const PG8_LAS float*)(sl + par * 3072); const bool gate = u.pn < 12;
        const PG8_LAS float* cp = d + (gate ? 64 * wc + 16 * fq : 32 * wc + 8 * fq);
        f32x4 cs[2][2]; float rs[2][4];
#pragma unroll
        for (int bj = 0; bj < 2; ++bj)
#pragma unroll
            for (int n = 0; n < 2; ++n) cs[bj][n] = *(const PG8_LAS f32x4*)(cp + (gate ? 8 * bj : HALF * bj) + 4 * n);
#pragma unroll
        for (int ai = 0; ai < 2; ++ai)
#pragma unroll
            for (int m = 0; m < 4; ++m) rs[ai][m] = d[256 + wr * 64 + fr + ai * HALF + m * 16];
#pragma unroll
        for (int ai = 0; ai < 2; ++ai)
#pragma unroll
            for (int m = 0; m < 4; ++m)
#pragma unroll
                for (int bj = 0; bj < 2; ++bj)
#pragma unroll
                    for (int n = 0; n < 2; ++n) acc[ai][bj][m][n] *= cs[bj][n] * rs[ai][m];
        if (gate) {
            const __amdgpu_buffer_rsrc_t rsrc = __builtin_amdgcn_make_buffer_rsrc(base.PA, 0, (int)((size_t)HB_ROWS * PA_ROWB), 0x00020000);
            gate8_body(acc, rsrc, (u.pm - base.pm0) * BM, u.pn, wr, wc, fr, fq, d + 512 + 64 * wc + 16 * fq); return; }
        Unit v = u; v.pn = i8tile_pn(u.pn); base(acc, v, wr, wc, fr, fq);
    }
    __device__ __forceinline__ void operator()(const f32x4 (&acc)[2][2][4][2], const Unit& u, int wr, int wc, int fr, int fq) const {}
};
typedef EpiProj8T<0> EpiProj8;
}

#define GAS __attribute__((address_space(1)))
#define LAS __attribute__((address_space(3)))
typedef unsigned short bf16;
typedef unsigned v4u __attribute__((ext_vector_type(4)));
typedef float f32x4 __attribute__((ext_vector_type(4)));
typedef short bf16x8 __attribute__((ext_vector_type(8)));
typedef GAS unsigned gu32;
typedef GAS unsigned long long gu64;
#define RLX_AGENT __ATOMIC_RELAXED, __HIP_MEMORY_SCOPE_AGENT
#define LDS_WAIT() asm volatile("s_waitcnt lgkmcnt(0)" ::: "memory")
#define VM_WAIT() asm volatile("s_waitcnt vmcnt(0)" ::: "memory")
__device__ __forceinline__ unsigned long long rt() { return __builtin_amdgcn_s_memrealtime(); }
__device__ __forceinline__ unsigned f2bf(float f) { unsigned u = __builtin_bit_cast(unsigned, f); return (u + 0x7fffu + ((u >> 16) & 1u)) >> 16; }
__device__ __forceinline__ unsigned pk2(float lo, float hi) { return f2bf(lo) | (f2bf(hi) << 16); }

__device__ __forceinline__ int hw_lane() { int l; asm volatile("v_mbcnt_lo_u32_b32 %0, -1, 0\n\tv_mbcnt_hi_u32_b32 %0, -1, %0" : "=v"(l)); return l; }
__device__ __forceinline__ bool hw_thread0(int wave) { return wave == 0 && hw_lane() == 0; }
#define XB_TMO      128
#define XB_XCNT(j)  (256  + 64 * (j))
#define XB_XSUB(j)  (1280 + 64 * (j))
#define XB_XGEN(j)  (2304 + 64 * (j))
#define XB_TOP      3328
#define XB_TOPGEN   3392
#define XCD_BAR_WORDS 3456
#define XB_SPIN_CAP (1u << 18)

__device__ __forceinline__ unsigned xb_ld(unsigned* p)              { return __hip_atomic_load(p, __ATOMIC_RELAXED, __HIP_MEMORY_SCOPE_AGENT); }
__device__ __forceinline__ unsigned xb_add(unsigned* p, unsigned v) { return __hip_atomic_fetch_add(p, v, __ATOMIC_RELAXED, __HIP_MEMORY_SCOPE_AGENT); }
__device__ __forceinline__ unsigned xb_xcc_id() { return (unsigned)__builtin_amdgcn_s_getreg((3 << 11) | 20) & 0xFu; }
#define XB_SPIN(cond, bar) do { unsigned _sp = 0; while (cond) { __builtin_amdgcn_s_sleep(1); \
    if ((++_sp & 255u) == 0u) { if (xb_ld(&(bar)[XB_TMO])) break; if (_sp > XB_SPIN_CAP) { atomicAdd(&(bar)[XB_TMO], 1u); break; } } } } while (0)

struct XcdBarrier {
    unsigned* bar; unsigned x; int wave;
    volatile LAS unsigned* st;
};

__device__ __forceinline__ XcdBarrier xcd_barrier_post(unsigned* bar, volatile LAS unsigned* st, int wave) {
    XcdBarrier b; b.bar = bar; b.x = xb_xcc_id(); b.st = st; b.wave = wave;
    if (hw_thread0(wave)) (void)xb_add(&bar[XB_XCNT(b.x)], 1u);
    return b;
}
__device__ __forceinline__ void xcd_barrier_complete(unsigned* bar, unsigned x, unsigned& nloc, unsigned& nx) {
    const unsigned G = gridDim.x * gridDim.y * gridDim.z;
    unsigned sum, cnt, mine, sp = 0u;
    for (;;) {
        sum = 0u; cnt = 0u; mine = 0u;
#pragma unroll
        for (unsigned j = 0; j < 16; ++j) { const unsigned c = xb_ld(&bar[XB_XCNT(j)]); sum += c; cnt += (c > 0u) ? 1u : 0u; mine = (j == x) ? c : mine; }
        if (sum == G) break;
        __builtin_amdgcn_s_sleep(1);
        if ((++sp & 255u) == 0u) { if (xb_ld(&bar[XB_TMO])) break; if (sp > XB_SPIN_CAP) { atomicAdd(&bar[XB_TMO], 1u); break; } }
    }
    nloc = mine > 0u ? mine : 1u; nx = cnt > 0u ? cnt : 1u;
}

__device__ __forceinline__ void xcd_barrier(const XcdBarrier& b) {
    asm volatile("s_waitcnt vmcnt(0)" ::: "memory");
    __syncthreads();
    if (hw_thread0(b.wave)) {
        unsigned* bar = b.bar;
        __builtin_amdgcn_s_waitcnt(0);
        unsigned nloc = b.st[0], nx = b.st[1];
        if (nloc == 0u) { xcd_barrier_complete(bar, b.x, nloc, nx); b.st[0] = nloc; b.st[1] = nx; }
        const unsigned old = xb_add(&bar[XB_XSUB(b.x)], 1u);
        const unsigned gen = old / nloc;
        if (old + 1u == (gen + 1u) * nloc) {
            __builtin_amdgcn_fence(__ATOMIC_RELEASE, "agent");
            asm volatile("s_waitcnt vmcnt(0)" ::: "memory");
            const unsigned og = xb_add(&bar[XB_TOP], 1u);
            const unsigned tg = og / nx;
            if (og + 1u == (tg + 1u) * nx) xb_add(&bar[XB_TOPGEN], 1u);
            else XB_SPIN(xb_ld(&bar[XB_TOPGEN]) == tg, bar);
            __builtin_amdgcn_fence(__ATOMIC_ACQUIRE, "agent");
            xb_add(&bar[XB_XGEN(b.x)], 1u);
            asm volatile("s_waitcnt vmcnt(0)" ::: "memory");
        } else {
            XB_SPIN(xb_ld(&bar[XB_XGEN(b.x)]) == gen, bar);
            __builtin_amdgcn_fence(__ATOMIC_ACQUIRE, "agent");
            asm volatile("s_waitcnt vmcnt(0)" ::: "memory");
        }
    }
    __syncthreads();
}

__device__ __forceinline__ float wave_sum(float v) {
#pragma unroll
    for (int o = 1; o < 64; o <<= 1) v += __shfl_xor(v, o);
    return v;
}

constexpr int RING_OFF = 0, RING_BYTES = 131072;
constexpr int LDSCTL_OFF = RING_BYTES, MISC_OFF = LDSCTL_OFF + 320;
constexpr int SCALE_OFF = RING_BYTES + 8192;
constexpr int LDS_BYTES = 147456;
constexpr int NWAVES = 8, NTHR = NWAVES * 64;
constexpr int WSCR_OFF = 132096;

__device__ __forceinline__ float bf2f(bf16 h) { return __builtin_bit_cast(float, (unsigned)h << 16); }
__device__ __forceinline__ float sigm_f(float x) { return 1.f / (1.f + __expf(-x)); }
__device__ __forceinline__ int t5_bucket(int d) {
    if (d < 16) return d;
    int b = 16;
    b += d >= 22; b += d >= 30; b += d >= 40; b += d >= 54; b += d >= 73; b += d >= 99; b += d >= 134; b += d >= 182; b += d >= 246; b += d >= 332; b += d >= 450; b += d >= 609; b += d >= 825; b += d >= 1117; b += d >= 1513;
    return b;
}

struct Ctx {
    const float *x, *mem, *norm_w, *w_in, *gate_b, *lnw, *lnb, *sp_w, *sp_b, *bqw, *bkw, *rel_bias, *mem_norm_w, *m_w_kv, *mqw, *mkw, *proj_a, *proj_b, *proj_m, *w_out;
    float* out;
    bf16 *WIN, *PCAT, *WOUT, *WSP, *XN, *PA, *KVM, *OG, *YC, *MRG; float *BIAS, *BIASX, *SS, *MKSS, *LSE, *LNST, *CS, *RS; unsigned char *XN8, *W8; unsigned* cmax;
    LAS unsigned char* lds; int tid, lane, wave, G, gtid, T, gwave, NW, xgwave;
};

__device__ __forceinline__ void p0_transpose_item(const float* W, int N, bf16* WT, int ldt, int row_off, int koff, LAS float* scr, int item, int lane_unused, bool gperm = false, unsigned* cmax = nullptr) {
    const int lane = hw_lane();
    const int nblk = N / 32, kb = item / nblk, nb = item % nblk, k0 = 64 * kb, n0 = 32 * nb;
    float cam = 0.f;
#pragma unroll 8
    for (int i = 0; i < 32; ++i) { const int kk = 2 * i + (lane >> 5); const float wv = W[(size_t)(k0 + kk) * N + n0 + (lane & 31)]; scr[kk * 33 + (lane & 31)] = wv; cam = fmaxf(cam, fabsf(wv)); }
    if (cmax && i8col(n0) >= 0) { cam = fmaxf(cam, __shfl_xor(cam, 32)); if (lane < 32) atomicMax(cmax + i8col(n0) + lane, __float_as_uint(cam)); }
    LDS_WAIT(); asm volatile("" ::: "memory");
    const int c = lane & 7;
#pragma unroll
    for (int j = 0; j < 4; ++j) { const int n = (lane >> 3) + 8 * j; const LAS float* s = scr + (8 * c) * 33 + n;
        v4u o; o.x = pk2(s[0 * 33], s[1 * 33]); o.y = pk2(s[2 * 33], s[3 * 33]); o.z = pk2(s[4 * 33], s[5 * 33]); o.w = pk2(s[6 * 33], s[7 * 33]);
        int nn = n0 + n;
        if (gperm) {
            if (nn >= C_G) nn = (nn & ~255) + 128 * ((nn >> 3) & 1) + 32 * ((nn >> 6) & 3) + 8 * ((nn >> 4) & 3) + (nn & 7);
            else if (nn < C_AV) { const int T = nn >> 7; nn = 256 * (T < 3 ? T : T + 3) + (nn & 127); }
            else if (nn >= C_AZ && nn < C_BQ) { const int c = nn - C_AZ, T = c >> 7; nn = 256 * (T < 3 ? T : T + 3) + 128 + (c & 127); }
        }
        *(GAS v4u*)(WT + (size_t)(row_off + nn) * ldt + koff + k0 + 8 * c) = o; }
    LDS_WAIT(); asm volatile("" ::: "memory");
}
template <int NR> __device__ __forceinline__ void rms_rows_to_bf16(const float* src, const float* w, bf16* dst, size_t m0, size_t stride, int lane, unsigned char* q8 = nullptr, float* rsc = nullptr) {
    f32x4 v[NR][4]; float s[NR];
#pragma unroll
    for (int r = 0; r < NR; ++r) { const GAS f32x4* xr = (const GAS f32x4*)(src + (m0 + r * stride) * DM) + lane;
#pragma unroll
        for (int j = 0; j < 4; ++j) v[r][j] = __builtin_nontemporal_load(xr + 64 * j); }
    f32x4 ww[4];
#pragma unroll
    for (int j = 0; j < 4; ++j) ww[j] = ((const GAS f32x4*)w + lane)[64 * j];
#pragma unroll
    for (int r = 0; r < NR; ++r) { float a = 0.f;
#pragma unroll
        for (int j = 0; j < 4; ++j) a += (v[r][j].x * v[r][j].x + v[r][j].y * v[r][j].y) + (v[r][j].z * v[r][j].z + v[r][j].w * v[r][j].w);
        s[r] = rsqrtf(wave_sum(a) * (1.f / DM) + EPS); }
#pragma unroll
    for (int r = 0; r < NR; ++r) { GAS unsigned long long* o8 = (GAS unsigned long long*)(dst + (m0 + r * stride) * DM) + lane;
#pragma unroll
        for (int j = 0; j < 4; ++j) { v[r][j] = v[r][j] * s[r] * ww[j]; o8[64 * j] = (unsigned long long)pk2(v[r][j].x, v[r][j].y) | ((unsigned long long)pk2(v[r][j].z, v[r][j].w) << 32); } }
    if (q8) {
#pragma unroll
        for (int r = 0; r < NR; ++r) { float am = 0.f;
#pragma unroll
            for (int j = 0; j < 4; ++j) am = fmaxf(am, fmaxf(fmaxf(fabsf(v[r][j].x), fabsf(v[r][j].y)), fmaxf(fabsf(v[r][j].z), fabsf(v[r][j].w))));
#pragma unroll
            for (int o = 1; o < 64; o <<= 1) am = fmaxf(am, __shfl_xor(am, o));
            am = fmaxf(am, 1e-20f); const float inv = 127.0f / am;
            GAS unsigned* qo = (GAS unsigned*)(q8 + (m0 + r * stride) * P8) + lane;
#pragma unroll
            for (int j = 0; j < 4; ++j) { const int a0 = (int)rintf(v[r][j].x * inv), a1 = (int)rintf(v[r][j].y * inv), a2 = (int)rintf(v[r][j].z * inv), a3 = (int)rintf(v[r][j].w * inv);
                qo[64 * j] = (unsigned)(a0 & 0xff) | ((unsigned)(a1 & 0xff) << 8) | ((unsigned)(a2 & 0xff) << 16) | ((unsigned)(a3 & 0xff) << 24); }
            if (lane == 0) rsc[m0 + r * stride] = am * (1.0f / 127.0f); } }
}
__device__ __forceinline__ void p0_quant_tile(const float* W, unsigned char* W8, float* CS, const unsigned* cmax, LAS float* scr, int item) {
    const int lane = hw_lane();
    const int kb = item / (N8 / 32), nb = item % (N8 / 32), k0 = 64 * kb, c0 = 32 * nb, n0 = i8src(c0);
    const float am = fmaxf(__uint_as_float(cmax[c0 + (lane & 31)]), 1e-30f), inv = 127.0f / am;
    if (kb == 0 && lane < 32) CS[c0 + lane] = am * (1.0f / 127.0f);
#pragma unroll 8
    for (int i = 0; i < 32; ++i) { const int kk = 2 * i + (lane >> 5); scr[kk * 33 + (lane & 31)] = rintf(W[(size_t)(k0 + kk) * NIN + n0 + (lane & 31)] * inv); }
    LDS_WAIT(); asm volatile("" ::: "memory");
    const int c = lane & 3;
#pragma unroll
    for (int j = 0; j < 2; ++j) { const int n = (lane >> 2) + 16 * j; const LAS float* sp = scr + (16 * c) * 33 + n; v4u o;
#define Q4(B) ((unsigned)((int)sp[((B) + 0) * 33] & 0xff) | ((unsigned)((int)sp[((B) + 1) * 33] & 0xff) << 8) | ((unsigned)((int)sp[((B) + 2) * 33] & 0xff) << 16) | ((unsigned)((int)sp[((B) + 3) * 33] & 0xff) << 24))
        o.x = Q4(0); o.y = Q4(4); o.z = Q4(8); o.w = Q4(12);
#undef Q4
        int nn = c0 + n; if (nn < 3072) nn = (nn & ~255) + 128 * ((nn >> 3) & 1) + 32 * ((nn >> 6) & 3) + 8 * ((nn >> 4) & 3) + (nn & 7);
        *(GAS v4u*)(W8 + (size_t)nn * P8 + k0 + 16 * c) = o; }
    LDS_WAIT(); asm volatile("" ::: "memory");
}
__device__ __forceinline__ void p0_quant_weights(Ctx& F, const unsigned* cmax) {
    LAS float* scr = (LAS float*)(F.lds + RING_OFF + F.wave * 16384);
    for (int it = F.gwave; it < 16 * (N8 / 32); it += F.NW) p0_quant_tile(F.w_in, F.W8, F.CS, cmax, scr, it);
}
__device__ __forceinline__ void p0_int8_block(Ctx& F, int nb) {
    const int lane = hw_lane(), col = lane & 31;
    LAS float* scr = (LAS float*)(F.lds + RING_OFF + F.wave * 16384);
    LAS float* wmax = (LAS float*)(F.lds + WSCR_OFF + 8192);
    const int c0 = 32 * nb, n0 = i8src(c0);
    float wv[2][32]; float cam = 0.f;
#pragma unroll
    for (int b = 0; b < 2; ++b) { const int k0 = 64 * (2 * F.wave + b);
#pragma unroll
        for (int i = 0; i < 32; ++i) { const int kk = 2 * i + (lane >> 5); wv[b][i] = F.w_in[(size_t)(k0 + kk) * NIN + n0 + col]; } }
#pragma unroll
    for (int b = 0; b < 2; ++b)
#pragma unroll
        for (int i = 0; i < 32; ++i) cam = fmaxf(cam, fabsf(wv[b][i]));
    cam = max_x32(cam);
    if (lane < 32) wmax[F.wave * 32 + lane] = cam;
    __syncthreads();
    float am = 1e-30f;
#pragma unroll
    for (int w = 0; w < 8; ++w) am = fmaxf(am, wmax[w * 32 + col]);
    const float inv = 127.0f / am;
    if (F.wave == 0 && lane < 32) F.CS[c0 + lane] = am * (1.0f / 127.0f);
#pragma unroll 1
    for (int b = 0; b < 2; ++b) { const int k0 = 64 * (2 * F.wave + b);
#pragma unroll
        for (int i = 0; i < 32; ++i) { const int kk = 2 * i + (lane >> 5); scr[kk * 33 + col] = rintf((b == 0 ? wv[0][i] : wv[1][i]) * inv); }
        LDS_WAIT(); asm volatile("" ::: "memory");
        const int c = lane & 3;
#pragma unroll
        for (int j = 0; j < 2; ++j) { const int n = (lane >> 2) + 16 * j; const LAS float* sp = scr + (16 * c) * 33 + n; v4u o;
#define Q4(B) ((unsigned)((int)sp[((B) + 0) * 33] & 0xff) | ((unsigned)((int)sp[((B) + 1) * 33] & 0xff) << 8) | ((unsigned)((int)sp[((B) + 2) * 33] & 0xff) << 16) | ((unsigned)((int)sp[((B) + 3) * 33] & 0xff) << 24))
            o.x = Q4(0); o.y = Q4(4); o.z = Q4(8); o.w = Q4(12);
#undef Q4
            int nn = c0 + n; if (nn < 3072) nn = (nn & ~255) + 128 * ((nn >> 3) & 1) + 32 * ((nn >> 6) & 3) + 8 * ((nn >> 4) & 3) + (nn & 7);
            *(GAS v4u*)(F.W8 + (size_t)nn * P8 + k0 + 16 * c) = o; }
        LDS_WAIT(); asm volatile("" ::: "memory"); }
    __syncthreads();
}
__device__ __forceinline__ void p0_prologue(Ctx& F) {
    LAS float* scr = (LAS float*)(F.lds + RING_OFF + F.wave * 16384);
    constexpr int I_IN = 16 * (NIN / 32), I_KV = 16 * 32, I_PA = 12 * 32, I_PB = 4 * 32, I_PM = 8 * 32, I_WO = 16 * 32;
    constexpr int NITEMS = I_IN + I_KV + I_PA + I_PB + I_PM + I_WO;
    for (int nb = (int)blockIdx.x; nb < N8 / 32; nb += F.G) p0_int8_block(F, nb);
    for (int it = F.gwave; it < NITEMS; it += F.NW) {
        int r = it;
        if (r < I_IN) { if (i8col(32 * (r % (NIN / 32))) < 0) p0_transpose_item(F.w_in, NIN, F.WIN, DM, 0, 0, scr, r, F.lane, true, nullptr); continue; } r -= I_IN;
        if (r < I_KV) { p0_transpose_item(F.m_w_kv, 1024, F.WIN, DM, NIN, 0, scr, r, F.lane); continue; } r -= I_KV;
        if (r < I_PA) { p0_transpose_item(F.proj_a, DM, F.PCAT, KC, 0, 0, scr, r, F.lane); continue; } r -= I_PA;
        if (r < I_PB) { p0_transpose_item(F.proj_b, DM, F.PCAT, KC, 0, 768, scr, r, F.lane); continue; } r -= I_PB;
        if (r < I_PM) { p0_transpose_item(F.proj_m, DM, F.PCAT, KC, 0, 1024, scr, r, F.lane); continue; } r -= I_PM;
        p0_transpose_item(F.w_out, DM, F.WOUT, DM, 0, 0, scr, r, F.lane);
    }
    for (int i = F.gtid; i < 4 * 128 * 128; i += F.T) { const int t = (i >> 7) & 127, s = i & 127; F.WSP[i] = (bf16)(s <= t ? f2bf(F.sp_w[i]) : 0u); }
    for (int i = F.gtid; i < 3 * 4 * 132; i += F.T) { const int g = i / (4 * 132), h = (i / 132) % 4, j = i % 132; const int dil = g == 0 ? 1 : (g == 1 ? 4 : 16);
        F.BIAS[i] = j <= 128 ? F.rel_bias[t5_bucket(j * dil) * 12 + 4 * g + h] : 0.f; }
    for (int i = F.gtid; i < 3 * 4 * 192; i += F.T) { const int g = i / (4 * 192), h = (i / 192) % 4, step = i % 192 - 31; const int dil = g == 0 ? 1 : (g == 1 ? 4 : 16);
        F.BIASX[i] = (step >= 0 && step <= 128) ? F.rel_bias[t5_bucket(step * dil) * 12 + 4 * g + h] * 1.4426950408889634f : -1e30f; }
    if ((MTOT % (4 * F.NW)) == 0 && (MMEM % (4 * F.NW)) == 0) {
        for (size_t m = F.gwave; m < (size_t)MTOT; m += 4 * (size_t)F.NW) rms_rows_to_bf16<4>(F.x, F.norm_w, F.XN, m, F.NW, F.lane, F.XN8, F.RS);
        for (size_t m = F.gwave; m < (size_t)MMEM; m += 4 * (size_t)F.NW) rms_rows_to_bf16<4>(F.mem, F.mem_norm_w, F.XN + (size_t)MTOT * DM, m, F.NW, F.lane);
    } else {
        for (size_t m = F.gwave; m < (size_t)MTOT; m += F.NW) rms_rows_to_bf16<1>(F.x, F.norm_w, F.XN, m, 0, F.lane, F.XN8, F.RS);
        for (size_t m = F.gwave; m < (size_t)MMEM; m += F.NW) rms_rows_to_bf16<1>(F.mem, F.mem_norm_w, F.XN + (size_t)MTOT * DM, m, 0, F.lane);
    }
}


typedef float f32x16 __attribute__((ext_vector_type(16)));
typedef short s16x4 __attribute__((ext_vector_type(4)));
__device__ __forceinline__ int crow(int r, int hi) { return (r & 3) + 8 * (r >> 2) + 4 * hi; }
__device__ __forceinline__ unsigned cvtpk(float lo, float hi) { return pg8::cvt_pk_bf16(lo, hi); }
__device__ __forceinline__ v4u swap32x2(v4u w) { const auto r0 = __builtin_amdgcn_permlane32_swap(w.x, w.z, false, false), r1 = __builtin_amdgcn_permlane32_swap(w.y, w.w, false, false); return (v4u){r0[0], r1[0], r0[1], r1[1]}; }
__device__ __forceinline__ s16x4 vtr(const LAS unsigned char* p) { typedef short v4i16_t __attribute__((ext_vector_type(4))); return __builtin_bit_cast(s16x4, __builtin_amdgcn_ds_read_tr16_b64_v4i16((LAS v4i16_t*)p)); }
__device__ __forceinline__ float bflo(unsigned w) { return __uint_as_float(w << 16); }
__device__ __forceinline__ float bfhi(unsigned w) { return __uint_as_float(w & 0xffff0000u); }
constexpr float LOG2E = 1.4426950408889634f, LN2 = 0.6931471805599453f;
constexpr float SM_THR = 5.0f;
constexpr int NBX = 192;


__device__ __forceinline__ void dma16(const void* gsrc, LAS unsigned char* ldst) { __builtin_amdgcn_global_load_lds((const unsigned*)gsrc, (LAS unsigned*)ldst, 16, 0, 0); }
#define VM_WAIT0() asm volatile("s_waitcnt vmcnt(0)" ::: "memory")
__device__ __forceinline__ void st_mixA_mfma(Ctx& F) {
    const int lane = hw_lane(), r32 = lane & 31, hi = lane >> 5, tid = F.wave * 64 + lane;
    LAS unsigned char* wl = F.lds + RING_OFF + F.wave * 16384;
    typedef float f32x2v __attribute__((ext_vector_type(2))); typedef unsigned u32x2v __attribute__((ext_vector_type(2)));
    LAS f32x2v* tab = (LAS f32x2v*)(F.lds + WSCR_OFF + 8192);
    const int g = F.wave >> 1, ch = lane & 3;
    bf16x8 wf[14];
    const bf16* wrow0 = F.WSP + (size_t)(g * 128 + r32) * 128 + 8 * hi;
    { int n = 0;
#pragma unroll
      for (int tb = 2; tb < 4; ++tb)
#pragma unroll
          for (int ks = 0; ks < 2 * (tb + 1); ++ks) wf[n++] = *(const bf16x8*)(wrow0 + (size_t)tb * 32 * 128 + 16 * ks); }
    for (int unit = blockIdx.x; unit < HB_ROWS / 128; unit += F.G) {
        const int rowbase = unit * 128;
        v4u raw[8];
        { const int c0 = g * 192 + (F.wave & 1) * 96;
#pragma unroll
          for (int i = 0; i < 8; ++i) raw[i] = *(const v4u*)(F.PA + (size_t)(rowbase + (lane >> 2) + 16 * i) * PAP + C_AV + c0 + 8 * ch); }
        { const int row = tid >> 2, part = tid & 3; const float* sp = F.SS + (size_t)(rowbase + row) * SS_W + 12 * part; float s = 0.f, q = 0.f;
#pragma unroll
          for (int k = 0; k < 6; ++k) { s += sp[2 * k]; q += sp[2 * k + 1]; }
          s = sum_quad(s); q = sum_quad(q);
          const float mu = s * (1.f / 768.f), var = q * (1.f / 768.f) - mu * mu;
          if (part == 0) tab[row] = (f32x2v){mu, rsqrtf(fmaxf(var, 0.f) + EPS)}; }
        __syncthreads();
#pragma unroll 1
        for (int cbi = 0; cbi < 3; ++cbi) {
            const int c0 = g * 192 + ((F.wave & 1) * 3 + cbi) * 32;
            const f32x4 w0 = *(const f32x4*)(F.lnw + c0 + 8 * ch), w1 = *(const f32x4*)(F.lnw + c0 + 8 * ch + 4), b0 = *(const f32x4*)(F.lnb + c0 + 8 * ch), b1 = *(const f32x4*)(F.lnb + c0 + 8 * ch + 4);
#pragma unroll
            for (int i = 0; i < 8; ++i) { const int s = (lane >> 2) + 16 * i; const f32x2v st = tab[s]; const v4u rw = raw[i]; v4u o;
                o.x = cvtpk((bflo(rw.x) - st.x) * st.y * w0.x + b0.x, (bfhi(rw.x) - st.x) * st.y * w0.y + b0.y); o.y = cvtpk((bflo(rw.y) - st.x) * st.y * w0.z + b0.z, (bfhi(rw.y) - st.x) * st.y * w0.w + b0.w);
                o.z = cvtpk((bflo(rw.z) - st.x) * st.y * w1.x + b1.x, (bfhi(rw.z) - st.x) * st.y * w1.y + b1.y); o.w = cvtpk((bflo(rw.w) - st.x) * st.y * w1.z + b1.z, (bfhi(rw.w) - st.x) * st.y * w1.w + b1.w);
                *(LAS v4u*)(wl + (s >> 3) * 512 + (s & 7) * 64 + ch * 16) = o; }
            if (cbi < 2) {
#pragma unroll
                for (int i = 0; i < 8; ++i) raw[i] = *(const v4u*)(F.PA + (size_t)(rowbase + (lane >> 2) + 16 * i) * PAP + C_AV + c0 + 32 + 8 * ch); }
            LAS unsigned char* uzb = wl + 8192;
#pragma unroll
            for (int p = 0; p < 8; ++p) { const int row_ = 16 * p + (lane >> 2);
                dma16(F.PA + (size_t)(rowbase + row_) * PAP + C_AU + c0 + 8 * ((lane & 3) ^ ((row_ >> 2) & 3)), uzb + p * 1024); }
            const LAS unsigned char* vb = wl + hi * 512 + ((lane & 15) >> 2) * 64 + ((lane >> 4) & 1) * 32 + (lane & 3) * 8;
            const bf16* wr2 = wrow0; asm volatile("" : "+v"(wr2));
            bf16x8 wq[6];
            { int n2 = 0;
#pragma unroll
              for (int tb = 0; tb < 2; ++tb)
#pragma unroll
                  for (int ks = 0; ks < 2 * (tb + 1); ++ks) wq[n2++] = *(const bf16x8*)(wr2 + (size_t)tb * 32 * 128 + 16 * ks); }
            int n = 0, nq = 0;
#pragma unroll
            for (int tb = 0; tb < 4; ++tb) { f32x16 acc = {};
#pragma unroll
                for (int ks = 0; ks < 2 * (tb + 1); ++ks) { const s16x4 a = vtr(vb + ks * 1024), c = vtr(vb + ks * 1024 + 256); const bf16x8 af = {a[0], a[1], a[2], a[3], c[0], c[1], c[2], c[3]};
                    acc = __builtin_amdgcn_mfma_f32_32x32x16_bf16(af, tb < 2 ? wq[nq++] : wf[n++], acc, 0, 0, 0); }
                const int t = 32 * tb + r32; const float sb = F.sp_b[g * 128 + t];
                if (tb == 0) VM_WAIT0();
                LAS unsigned char* urow = uzb + t * 64 + 8 * hi; const int fsw = (r32 >> 2) & 3;
#pragma unroll
                for (int i = 0; i < 4; ++i) { LAS u32x2v* up = (LAS u32x2v*)(urow + ((i ^ fsw) * 16)); const u32x2v u = *up; u32x2v w;
                    w.x = cvtpk(bflo(u.x) * (acc[4 * i] + sb), bfhi(u.x) * (acc[4 * i + 1] + sb)); w.y = cvtpk(bflo(u.y) * (acc[4 * i + 2] + sb), bfhi(u.y) * (acc[4 * i + 3] + sb));
                    *up = w; }
#pragma unroll
                for (int jr = 0; jr < 2; ++jr) { const int row_ = 32 * tb + 16 * jr + (lane >> 2); const v4u yv = *(const LAS v4u*)(uzb + row_ * 64 + (lane & 3) * 16);
                    *(v4u*)(F.YC + (size_t)(rowbase + row_) * KC + c0 + 8 * ((lane & 3) ^ ((row_ >> 2) & 3))) = yv; } }
        }
        __syncthreads();
    }
}

__device__ __forceinline__ void st_mergeB_vec(Ctx& F) {
    constexpr int NI = 8;
    const int total = HB_ROWS * 32, gtid0 = (int)blockIdx.x * NTHR + F.wave * 64 + hw_lane();
    for (int g0 = gtid0; g0 < total; g0 += NI * F.T) {
        v4u a[NI], b[NI], c[NI], z[NI]; float l0[NI], l1[NI], l2[NI];
#pragma unroll
        for (int i = 0; i < NI; ++i) { const int gid = g0 + i * F.T < total ? g0 + i * F.T : g0; const int r = gid >> 5, c8 = (gid & 31) * 8, h = c8 >> 6;
            l0[i] = F.LSE[((size_t)0 * HB_ROWS + r) * 4 + h]; l1[i] = F.LSE[((size_t)1 * HB_ROWS + r) * 4 + h]; l2[i] = F.LSE[((size_t)2 * HB_ROWS + r) * 4 + h];
            a[i] = *(const v4u*)(F.OG + ((size_t)0 * HB_ROWS + r) * 256 + c8); b[i] = *(const v4u*)(F.OG + ((size_t)1 * HB_ROWS + r) * 256 + c8); c[i] = *(const v4u*)(F.OG + ((size_t)2 * HB_ROWS + r) * 256 + c8);
            z[i] = *(const v4u*)(F.PA + (size_t)r * PAP + C_BZ + c8); }
        __builtin_amdgcn_sched_barrier(0);
#pragma unroll
        for (int i = 0; i < NI; ++i) { if (g0 + i * F.T >= total) break; const int gid = g0 + i * F.T; const int r = gid >> 5, c8 = (gid & 31) * 8;
            const float mx = fmaxf(l0[i], fmaxf(l1[i], l2[i])); float e0 = __expf(l0[i] - mx), e1 = __expf(l1[i] - mx), e2 = __expf(l2[i] - mx); const float inv = 1.f / (e0 + e1 + e2); e0 *= inv; e1 *= inv; e2 *= inv;
            v4u o;
#define MB_1(X) X = pk2((e0 * bflo(a[i].X) + e1 * bflo(b[i].X) + e2 * bflo(c[i].X)) * bflo(z[i].X), (e0 * bfhi(a[i].X) + e1 * bfhi(b[i].X) + e2 * bfhi(c[i].X)) * bfhi(z[i].X))
            o.MB_1(x); o.MB_1(y); o.MB_1(z); o.MB_1(w);
#undef MB_1
            *(v4u*)(F.YC + (size_t)r * KC + 768 + c8) = o; }
    }
}


__device__ __forceinline__ void st_attnM_v3(Ctx& F, int hb) {
    const int lane = hw_lane(), r32 = lane & 31, hi = lane >> 5;
    LAS unsigned char* kimg = F.lds + RING_OFF; LAS unsigned char* vimg = F.lds + RING_OFF + 65536;
    LAS float* kstab = (LAS float*)(F.lds + WSCR_OFF + 8192);
    typedef unsigned u32x2v __attribute__((ext_vector_type(2)));
    const int vcu = F.xgwave >> 3;
    __syncthreads();
    for (int task = vcu; task < 256; task += F.G) {
        const int bh = task >> 2, b = bh >> 2, h = bh & 3; const size_t kbase = (size_t)(hb * 16 + b) * MEML;
#pragma unroll
        for (int j = 0; j < 8; ++j) { const int p = F.wave * 8 + j, row = 4 * p + (lane >> 4);
            dma16(F.KVM + (kbase + row) * 1024 + h * 128 + 8 * ((lane & 15) ^ (row & 15)), kimg + p * 1024);
            dma16(F.KVM + (kbase + 8 * (p >> 1) + ((lane & 31) >> 2)) * 1024 + 512 + h * 128 + (2 * (p & 1) + (lane >> 5)) * 32 + (lane & 3) * 8, vimg + p * 1024); }
        { const int key = F.wave * 32 + r32; const float* sp = F.MKSS + (kbase + key) * 16 + 4 * h;
          const float ksv = rsqrtf(((sp[0] + sp[1]) + (sp[2] + sp[3])) * (1.f / 128.f) + EPS); if (lane < 32) kstab[key] = ksv; }
        VM_WAIT0(); __syncthreads();
#pragma unroll 1
        for (int qi = 0; qi < 2; ++qi) {
            const int qb = (task & 3) * 16 + F.wave * 2 + qi;
            const size_t qrow = (size_t)(b * SEQ + qb * 32 + r32);
            const float qs = rsqrtf(((F.SS[qrow * SS_W + 96 + 4 * h] + F.SS[qrow * SS_W + 96 + 4 * h + 1]) + (F.SS[qrow * SS_W + 96 + 4 * h + 2] + F.SS[qrow * SS_W + 96 + 4 * h + 3])) * (1.f / 128.f) + EPS) * (0.08838834764831845f * LOG2E);
            bf16x8 qf[8];
#pragma unroll
            for (int d0 = 0; d0 < 8; ++d0) { const int dd = 16 * d0 + 8 * hi;
                const v4u raw = *(const v4u*)(F.PA + qrow * PAP + C_MQ + h * 128 + dd);
                const f32x4 wa = *(const f32x4*)(F.mqw + dd), wb = *(const f32x4*)(F.mqw + dd + 4), ka = *(const f32x4*)(F.mkw + dd), kb = *(const f32x4*)(F.mkw + dd + 4);
                v4u o;
                o.x = cvtpk(bflo(raw.x) * qs * wa.x * ka.x, bfhi(raw.x) * qs * wa.y * ka.y); o.y = cvtpk(bflo(raw.y) * qs * wa.z * ka.z, bfhi(raw.y) * qs * wa.w * ka.w);
                o.z = cvtpk(bflo(raw.z) * qs * wb.x * kb.x, bfhi(raw.z) * qs * wb.y * kb.y); o.w = cvtpk(bflo(raw.w) * qs * wb.z * kb.z, bfhi(raw.w) * qs * wb.w * kb.w);
                qf[d0] = __builtin_bit_cast(bf16x8, o); }
            v4u zq[4][2];
#pragma unroll
            for (int db = 0; db < 4; ++db)
#pragma unroll
                for (int kp = 0; kp < 2; ++kp) zq[db][kp] = *(const v4u*)(F.PA + qrow * PAP + C_MZ + h * 128 + db * 32 + 16 * kp + 8 * hi);
            float mrun = -1e30f, lrun = 0.f; f32x16 o0 = {}, o1 = {}, o2 = {}, o3 = {};
            const LAS unsigned char* kb0 = kimg + r32 * 256; const int ksw = r32 & 15;
            const LAS unsigned char* vb0 = vimg + (4 * hi + ((lane & 15) >> 2)) * 64 + ((lane >> 4) & 1) * 32 + (lane & 3) * 8;
#pragma unroll 2
            for (int t = 0; t < MEML / 32; ++t) {
                f32x16 st = {};
#pragma unroll
                for (int d0 = 0; d0 < 8; ++d0) { const bf16x8 kf = *(const LAS bf16x8*)(kb0 + t * 8192 + (((2 * d0 + hi) ^ ksw) * 16)); st = __builtin_amdgcn_mfma_f32_32x32x16_bf16(kf, qf[d0], st, 0, 0, 0); }
                float tmax = -1e30f;
#pragma unroll
                for (int i = 0; i < 4; ++i) { const f32x4 kk = *(const LAS f32x4*)(kstab + 32 * t + 8 * i + 4 * hi);
#pragma unroll
                    for (int j = 0; j < 4; ++j) { const float s = st[4 * i + j] * kk[j]; st[4 * i + j] = s; tmax = fmaxf(tmax, s); } }
                tmax = max_x32(tmax);
                if (__builtin_amdgcn_ballot_w64(tmax > mrun + SM_THR) != 0ull) {
                    const float mnew = fmaxf(mrun, tmax), alpha = __builtin_amdgcn_exp2f(mrun - mnew); mrun = mnew; lrun *= alpha;
#pragma unroll
                    for (int r = 0; r < 16; ++r) { o0[r] *= alpha; o1[r] *= alpha; o2[r] *= alpha; o3[r] *= alpha; } }
                float psum = 0.f;
#pragma unroll
                for (int r = 0; r < 16; ++r) { st[r] = __builtin_amdgcn_exp2f(st[r] - mrun); psum += st[r]; }
                lrun += psum;
                v4u p0, p1;
                p0.x = cvtpk(st[0], st[1]); p0.y = cvtpk(st[2], st[3]); p0.z = cvtpk(st[4], st[5]); p0.w = cvtpk(st[6], st[7]);
                p1.x = cvtpk(st[8], st[9]); p1.y = cvtpk(st[10], st[11]); p1.z = cvtpk(st[12], st[13]); p1.w = cvtpk(st[14], st[15]);
                const LAS unsigned char* vb = vb0 + t * 8192;
#define AM_PV(OX, DB) do { _Pragma("unroll") for (int s = 0; s < 2; ++s) { const bf16x8 pf = __builtin_bit_cast(bf16x8, s == 0 ? p0 : p1); \
                    const s16x4 a = vtr(vb + (2 * s) * 2048 + (DB) * 512), c = vtr(vb + (2 * s + 1) * 2048 + (DB) * 512); const bf16x8 vf = {a[0], a[1], a[2], a[3], c[0], c[1], c[2], c[3]}; \
                    OX = __builtin_amdgcn_mfma_f32_32x32x16_bf16(vf, pf, OX, 0, 0, 0); } } while (0)
                AM_PV(o0, 0); AM_PV(o1, 1); AM_PV(o2, 2); AM_PV(o3, 3);
#undef AM_PV
            }
            const float ltot = sum_x32(lrun), inv = 1.f / ltot;
            bf16* yrow = F.YC + qrow * KC + 1024 + h * 128 + 8 * hi;
#define AM_ST(OX, DB) do { _Pragma("unroll") for (int kp = 0; kp < 2; ++kp) { const v4u z = swap32x2(zq[DB][kp]);     \
            v4u w; w.x = cvtpk(OX[8 * kp] * inv * bflo(z.x), OX[8 * kp + 1] * inv * bfhi(z.x)); w.y = cvtpk(OX[8 * kp + 2] * inv * bflo(z.y), OX[8 * kp + 3] * inv * bfhi(z.y)); \
            w.z = cvtpk(OX[8 * kp + 4] * inv * bflo(z.z), OX[8 * kp + 5] * inv * bfhi(z.z)); w.w = cvtpk(OX[8 * kp + 6] * inv * bflo(z.w), OX[8 * kp + 7] * inv * bfhi(z.w)); \
            *(v4u*)(yrow + (DB) * 32 + 16 * kp) = swap32x2(w); } } while (0)
            AM_ST(o0, 0); AM_ST(o1, 1); AM_ST(o2, 2); AM_ST(o3, 3);
#undef AM_ST
        }
        __syncthreads();
    }
}

__device__ __forceinline__ void st_attnB_v3(Ctx& F) {
    const int lane = hw_lane(), r32 = lane & 31, hi = lane >> 5, tid = F.wave * 64 + lane;
    LAS unsigned char* kimg = F.lds + RING_OFF; LAS unsigned char* vimg = F.lds + RING_OFF + 49152;
    LAS float* kstab = (LAS float*)(F.lds + RING_OFF + 98304);
    LAS float* btab = (LAS float*)(F.lds + RING_OFF + 98304 + 2048);
    typedef unsigned u32x2v __attribute__((ext_vector_type(2)));
    const int vcu = F.xgwave >> 3;
    __syncthreads();
    for (int unit = vcu; unit < 3 * 16 * 4 * 8; unit += F.G) {
        const int k = unit & 7, h = (unit >> 3) & 3, b = (unit >> 5) & 15, g = unit >> 9, hh = 4 * g + h;
        const int dil = g == 0 ? 1 : (g == 1 ? 4 : 16);
        const int res0 = g == 0 ? 0 : (g == 1 ? (k >> 1) : 2 * k), j0 = g == 0 ? 8 * k : (g == 1 ? 8 * (k & 1) : 0);
#pragma unroll
        for (int i = 0; i < 12; ++i) { const int q = F.wave * 12 + i, s = q >> 3, pc = q & 7, p = pc & 3;
            int res, jt; bool valid;
            if (g < 2) { res = res0; jt = j0 - 4 + s; valid = jt >= 0; } else { res = res0 + (s >> 2); jt = s & 3; valid = s < 8; }
            if (valid) {
                if (pc < 4) { const int row = 8 * p + (lane >> 3); const size_t trow = (size_t)(b * SEQ + res + (32 * jt + row) * dil);
                    dma16(F.PA + trow * PAP + C_BK + hh * 64 + 8 * ((lane & 7) ^ ((row >> 1) & 7)), kimg + s * 4096 + p * 1024); }
                else { const int key = 8 * p + ((lane & 31) >> 2); const size_t trow = (size_t)(b * SEQ + res + (32 * jt + key) * dil);
                    dma16(F.PA + trow * PAP + C_BV + hh * 64 + (lane >> 5) * 32 + (lane & 3) * 8, vimg + s * 4096 + p * 1024); } } }
        if (tid < 384) { const int s = tid >> 5, kk = tid & 31; int res, jt; bool valid;
            if (g < 2) { res = res0; jt = j0 - 4 + s; valid = jt >= 0; } else { res = res0 + (s >> 2); jt = s & 3; valid = s < 8; }
            if (valid) { const size_t trow = (size_t)(b * SEQ + res + (32 * jt + kk) * dil);
                kstab[tid] = rsqrtf((F.SS[trow * SS_W + 72 + 2 * hh] + F.SS[trow * SS_W + 72 + 2 * hh + 1]) * (1.f / 64.f) + EPS); } }
        if (tid < NBX) btab[tid] = F.BIASX[(g * 4 + h) * NBX + tid];
        const int wres = g < 2 ? res0 : res0 + (F.wave >> 2), j = g < 2 ? j0 + F.wave : (F.wave & 3);
        const int sbase = g < 2 ? 4 - j0 : (F.wave >> 2) * 4;
        const size_t qrow = (size_t)(b * SEQ + wres + (32 * j + r32) * dil);
        const float qs = rsqrtf((F.SS[qrow * SS_W + 48 + 2 * hh] + F.SS[qrow * SS_W + 48 + 2 * hh + 1]) * (1.f / 64.f) + EPS) * (0.125f * LOG2E);
        bf16x8 qf[4];
#pragma unroll
        for (int d0 = 0; d0 < 4; ++d0) { const int dd = 16 * d0 + 8 * hi;
            const v4u raw = *(const v4u*)(F.PA + qrow * PAP + C_BQ + hh * 64 + dd);
            const f32x4 wa = *(const f32x4*)(F.bqw + dd), wb = *(const f32x4*)(F.bqw + dd + 4), ka = *(const f32x4*)(F.bkw + dd), kb = *(const f32x4*)(F.bkw + dd + 4);
            v4u o;
            o.x = cvtpk(bflo(raw.x) * qs * wa.x * ka.x, bfhi(raw.x) * qs * wa.y * ka.y); o.y = cvtpk(bflo(raw.y) * qs * wa.z * ka.z, bfhi(raw.y) * qs * wa.w * ka.w);
            o.z = cvtpk(bflo(raw.z) * qs * wb.x * kb.x, bfhi(raw.z) * qs * wb.y * kb.y); o.w = cvtpk(bflo(raw.w) * qs * wb.z * kb.z, bfhi(raw.w) * qs * wb.w * kb.w);
            qf[d0] = __builtin_bit_cast(bf16x8, o); }
        VM_WAIT0(); __syncthreads();
        float mrun = -1e30f, lrun = 0.f; f32x16 o0 = {}, o1 = {};
        const int ksw = (r32 >> 1) & 7;
        for (int jt = (j >= 4 ? j - 4 : 0); jt <= j; ++jt) {
            const int s = sbase + jt;
            const LAS unsigned char* kb = kimg + s * 4096 + r32 * 128;
            const LAS unsigned char* vb = vimg + s * 4096 + (4 * hi + ((lane & 15) >> 2)) * 64 + ((lane >> 4) & 1) * 32 + (lane & 3) * 8;
            const int bidx = 32 * (j - jt) + r32 + 31 - 4 * hi;
            bf16x8 kf[4]; f32x4 kk[4]; float bb[16]; s16x4 va[2][2], vc[2][2];
#pragma unroll
            for (int d0 = 0; d0 < 4; ++d0) kf[d0] = *(const LAS bf16x8*)(kb + (((2 * d0 + hi) ^ ksw) * 16));
#pragma unroll
            for (int i = 0; i < 4; ++i) { kk[i] = *(const LAS f32x4*)(kstab + s * 32 + 8 * i + 4 * hi);
#pragma unroll
                for (int jj = 0; jj < 4; ++jj) bb[4 * i + jj] = btab[bidx - 8 * i - jj]; }
#pragma unroll
            for (int ss = 0; ss < 2; ++ss)
#pragma unroll
                for (int hh2 = 0; hh2 < 2; ++hh2) { va[ss][hh2] = vtr(vb + (2 * ss) * 1024 + hh2 * 512); vc[ss][hh2] = vtr(vb + (2 * ss + 1) * 1024 + hh2 * 512); }
            __builtin_amdgcn_sched_barrier(0);
            f32x16 st = {};
#pragma unroll
            for (int d0 = 0; d0 < 4; ++d0) st = __builtin_amdgcn_mfma_f32_32x32x16_bf16(kf[d0], qf[d0], st, 0, 0, 0);
            float tmax = -1e30f;
#pragma unroll
            for (int i = 0; i < 4; ++i)
#pragma unroll
                for (int jj = 0; jj < 4; ++jj) { const float sv = st[4 * i + jj] * kk[i][jj] + bb[4 * i + jj]; st[4 * i + jj] = sv; tmax = fmaxf(tmax, sv); }
            tmax = max_x32(tmax);
            if (__builtin_amdgcn_ballot_w64(tmax > mrun + SM_THR) != 0ull) {
                const float mnew = fmaxf(mrun, tmax), alpha = __builtin_amdgcn_exp2f(mrun - mnew); mrun = mnew; lrun *= alpha;
#pragma unroll
                for (int r = 0; r < 16; ++r) { o0[r] *= alpha; o1[r] *= alpha; } }
            float psum = 0.f;
#pragma unroll
            for (int r = 0; r < 16; ++r) { st[r] = __builtin_amdgcn_exp2f(st[r] - mrun); psum += st[r]; }
            lrun += psum;
            v4u p0, p1;
            p0.x = cvtpk(st[0], st[1]); p0.y = cvtpk(st[2], st[3]); p0.z = cvtpk(st[4], st[5]); p0.w = cvtpk(st[6], st[7]);
            p1.x = cvtpk(st[8], st[9]); p1.y = cvtpk(st[10], st[11]); p1.z = cvtpk(st[12], st[13]); p1.w = cvtpk(st[14], st[15]);
#pragma unroll
            for (int ss = 0; ss < 2; ++ss) { const bf16x8 pf = __builtin_bit_cast(bf16x8, ss == 0 ? p0 : p1);
                { const s16x4 a = va[ss][0], c = vc[ss][0]; const bf16x8 vf = {a[0], a[1], a[2], a[3], c[0], c[1], c[2], c[3]}; o0 = __builtin_amdgcn_mfma_f32_32x32x16_bf16(vf, pf, o0, 0, 0, 0); }
                { const s16x4 a = va[ss][1], c = vc[ss][1]; const bf16x8 vf = {a[0], a[1], a[2], a[3], c[0], c[1], c[2], c[3]}; o1 = __builtin_amdgcn_mfma_f32_32x32x16_bf16(vf, pf, o1, 0, 0, 0); } }
        }
        const float ltot = sum_x32(lrun), inv = 1.f / ltot;
        bf16* orow = F.OG + ((size_t)g * HB_ROWS + qrow) * 256 + h * 64 + 8 * hi;
#define AB_ST(OX, DB) do { _Pragma("unroll") for (int kp = 0; kp < 2; ++kp) { v4u w; \
            w.x = cvtpk(OX[8 * kp] * inv, OX[8 * kp + 1] * inv); w.y = cvtpk(OX[8 * kp + 2] * inv, OX[8 * kp + 3] * inv); w.z = cvtpk(OX[8 * kp + 4] * inv, OX[8 * kp + 5] * inv); w.w = cvtpk(OX[8 * kp + 6] * inv, OX[8 * kp + 7] * inv); \
            *(v4u*)(orow + (DB) * 32 + 16 * kp) = swap32x2(w); } } while (0)
        AB_ST(o0, 0); AB_ST(o1, 1);
#undef AB_ST
        if (hi == 0) F.LSE[((size_t)g * HB_ROWS + qrow) * 4 + h] = (mrun + __log2f(ltot)) * LN2;
        __syncthreads();
    }
}

#ifndef G1_STAGGER_TICKS
#define G1_STAGGER_TICKS 0
#endif
#ifndef G1_ALIGN_EPI
#define G1_ALIGN_EPI true
#endif
#ifndef PROBE_REP
#define PROBE_REP -1
#endif
#define REPS(id) for (int rep_ = 0; rep_ < ((PROBE_REP) == (id) ? 2 : 1); ++rep_)
#ifndef MK_PER_PHASE
#define MK_PER_PHASE 0
#endif
constexpr int NPH_HALF = 5, NPHASES = 1 + 2 * NPH_HALF;
struct Args { const float* in[20]; float* out; unsigned char* ws; int ph_lo, ph_hi; };
__global__ void __launch_bounds__(NTHR, 2) mega_fwd(Args args) {
    extern __shared__ __attribute__((aligned(16))) unsigned char lds_raw[];
    Ctx F;
    F.lds = (LAS unsigned char*)lds_raw;
    F.tid = threadIdx.x; F.lane = F.tid & 63; F.wave = __builtin_amdgcn_readfirstlane(F.tid >> 6);
    F.G = gridDim.x; F.gtid = blockIdx.x * NTHR + F.tid; F.T = F.G * NTHR; F.gwave = blockIdx.x * NWAVES + F.wave; F.NW = F.G * NWAVES;
    { const int bx = blockIdx.x; const int vcu = (F.G % 8 == 0) ? (bx % 8) * (F.G / 8) + bx / 8 : bx; F.xgwave = vcu * NWAVES + F.wave; }
    unsigned char* ws = args.ws;
    F.x = args.in[0]; F.mem = args.in[1]; F.norm_w = args.in[2]; F.w_in = args.in[3]; F.gate_b = args.in[4]; F.lnw = args.in[5]; F.lnb = args.in[6]; F.sp_w = args.in[7];
    F.sp_b = args.in[8]; F.bqw = args.in[9]; F.bkw = args.in[10]; F.rel_bias = args.in[11]; F.mem_norm_w = args.in[12]; F.m_w_kv = args.in[13]; F.mqw = args.in[14]; F.mkw = args.in[15];
    F.proj_a = args.in[16]; F.proj_b = args.in[17]; F.proj_m = args.in[18]; F.w_out = args.in[19]; F.out = args.out;
    F.WIN = (bf16*)(ws + WS_WIN); F.PCAT = (bf16*)(ws + WS_PCAT); F.WOUT = (bf16*)(ws + WS_WOUT); F.WSP = (bf16*)(ws + WS_WSP); F.BIAS = (float*)(ws + WS_BIAS); F.BIASX = (float*)(ws + WS_BIAS + 65536);
    F.XN = (bf16*)(ws + WS_XN); F.PA = (bf16*)(ws + WS_PA); F.KVM = (bf16*)(ws + WS_KVM); F.SS = (float*)(ws + WS_SS); F.MKSS = (float*)(ws + WS_MKSS);
    F.cmax = (unsigned*)(ws + WS_CTL + CW_CMAX * 4); F.XN8 = ws + WS_XN8; F.W8 = ws + WS_W8; F.CS = (float*)(ws + WS_CS); F.RS = (float*)(ws + WS_RS);
    F.OG = (bf16*)(ws + WS_OG); F.LSE = (float*)(ws + WS_LSE); F.LNST = (float*)(ws + WS_LNST); F.YC = (bf16*)(ws + WS_YC); F.MRG = (bf16*)(ws + WS_MRG);
    for (int u = F.tid; u < (LDS_BYTES - LDSCTL_OFF) / 4; u += NTHR) ((LAS unsigned*)(F.lds + LDSCTL_OFF))[u] = 0u;
    __syncthreads();
    XcdBarrier bar; bar.bar = (unsigned*)(ws + WS_CTL) + CW_BAR; bar.x = 0; bar.st = nullptr; bar.wave = 0;
    if (!MK_PER_PHASE) bar = xcd_barrier_post((unsigned*)(ws + WS_CTL) + CW_BAR, (volatile LAS unsigned*)(F.lds + MISC_OFF) + 8, F.wave);
    const int lo = args.ph_lo, hi = args.ph_hi;
#define IN(k) (lo <= (k) && (k) < hi)
#define SEAM(k) do { if (IN(k) && IN((k) + 1)) xcd_barrier(bar); } while (0)

    if (IN(0)) { REPS(0) p0_prologue(F); } SEAM(0);
#pragma unroll 1
    for (int hb = 0; hb < 2; ++hb) {
        const int pb = 1 + hb * NPH_HALF, row0 = hb * HB_ROWS;
        asm volatile("v_mbcnt_lo_u32_b32 %0, -1, 0\n\tv_mbcnt_hi_u32_b32 %0, -1, %0" : "=v"(F.lane)); F.tid = F.wave * 64 + F.lane; F.gtid = blockIdx.x * NTHR + F.tid;
#if PROBE_REP == 9 || PROBE_REP == 10
        if (IN(pb + 0)) { pg8::Gemm g{F.XN, F.WIN, MTOT + MMEM, NIN + 1024, DM, DM, DM}; pg8::OrderBF S; S.init(hb, F.G, (int)blockIdx.x);
            typedef pg8::EpiProjT<PROBE_REP - 8> EP; EP E{F.PA, F.KVM, F.SS, F.MKSS, F.gate_b, hb * (HB_ROWS / 256), 0};
            pg8::gemm_phase<EP, pg8::OrderBF, true, true>(F.lds + RING_OFF, g, S, E, F.wave); }
#endif
        if (IN(pb + 0)) REPS(1) {
            pg8::Gemm g{F.XN, F.WIN, MTOT + MMEM, NIN + 1024, DM, DM, DM}; pg8::OrderBF S; S.init(hb, F.G, (int)blockIdx.x);
#if G1_STAGGER_TICKS
            { const unsigned long long t0 = __builtin_amdgcn_s_memrealtime(), dl = (unsigned long long)((blockIdx.x >> 3) & 31) * G1_STAGGER_TICKS;
              while (__builtin_amdgcn_s_memrealtime() - t0 < dl) __builtin_amdgcn_s_sleep(8); }
#endif
            pg8::EpiProj E{F.PA, F.KVM, F.SS, F.MKSS, F.gate_b, hb * (HB_ROWS / 256), 0};
            pg8::gemm_phase<pg8::EpiProj, pg8::OrderBF, G1_ALIGN_EPI, true>(F.lds + RING_OFF, g, S, E, F.wave);
        }
#if PROBE_REP == 16 || PROBE_REP == 17
        if (IN(pb + 0)) { pg8::Gemm g{(const bf16*)F.XN8, (const bf16*)F.W8, MTOT, N8, DM / 2, P8 / 2, P8 / 2}; pg8::OrderG8 S; S.init(hb, F.G, (int)blockIdx.x);
            typedef pg8::EpiProj8T<PROBE_REP == 16 ? 2 : 0> EP; EP E{pg8::EpiProjT<PROBE_REP == 16 ? 2 : 0>{F.PA, F.KVM, F.SS, F.MKSS, F.gate_b, hb * (HB_ROWS / 256), 0}, F.RS, F.CS, F.lds + SCALE_OFF};
            pg8::gemm_phase<EP, pg8::OrderG8, G1_ALIGN_EPI, true, true>(F.lds + RING_OFF, g, S, E, F.wave); }
#endif
        if (IN(pb + 0)) {
            pg8::Gemm g{(const bf16*)F.XN8, (const bf16*)F.W8, MTOT, N8, DM / 2, P8 / 2, P8 / 2}; pg8::OrderG8 S; S.init(hb, F.G, (int)blockIdx.x);
            pg8::EpiProj8 E{pg8::EpiProj{F.PA, F.KVM, F.SS, F.MKSS, F.gate_b, hb * (HB_ROWS / 256), 0}, F.RS, F.CS, F.lds + SCALE_OFF};
            pg8::gemm_phase<pg8::EpiProj8, pg8::OrderG8, G1_ALIGN_EPI, true, true>(F.lds + RING_OFF, g, S, E, F.wave);
        }
#if PROBE_REP == 8
        if (IN(pb + 0)) { pg8::Gemm g{F.XN, F.WIN, MTOT + MMEM, NIN + 1024, DM, DM, DM}; pg8::OrderBF S; S.init(hb, F.G, (int)blockIdx.x); pg8::EpiNull E{};
            pg8::gemm_phase<pg8::EpiNull, pg8::OrderBF, true, true>(F.lds + RING_OFF, g, S, E, F.wave); }
#endif
        SEAM(pb + 0);
        if (IN(pb + 1)) { REPS(2) st_mixA_mfma(F); REPS(3) st_attnB_v3(F); REPS(4) st_attnM_v3(F, hb); } SEAM(pb + 1);
        if (IN(pb + 2)) { REPS(5) st_mergeB_vec(F); } SEAM(pb + 2);
#if PROBE_REP == 13 || PROBE_REP == 14
        if (IN(pb + 3)) { pg8::Gemm g{F.YC, F.PCAT, HB_ROWS, DM, KC, KC, KC}; pg8::StaticOrder S; S.init(HB_ROWS, DM, F.G, (int)blockIdx.x);
            typedef pg8::EpiG2catT<PROBE_REP == 13, PROBE_REP == 14> EP; EP E{F.PA, F.MRG};
            pg8::gemm_phase<EP, pg8::StaticOrder, true, true>(F.lds + RING_OFF, g, S, E, F.wave); }
#endif
#if PROBE_REP == 11
        if (IN(pb + 3)) { pg8::Gemm g{F.YC, F.PCAT, HB_ROWS, DM, KC, KC, KC}; pg8::StaticOrder S; S.init(HB_ROWS, DM, F.G, (int)blockIdx.x); pg8::EpiNull E{};
            pg8::gemm_phase<pg8::EpiNull, pg8::StaticOrder, true, true>(F.lds + RING_OFF, g, S, E, F.wave); }
#endif
#if PROBE_REP == 12
        if (IN(pb + 4)) { pg8::Gemm g{F.MRG, F.WOUT, HB_ROWS, DM, DM, DM, DM}; pg8::StaticOrder S; S.init(HB_ROWS, DM, F.G, (int)blockIdx.x); pg8::EpiNull E{};
            pg8::gemm_phase<pg8::EpiNull, pg8::StaticOrder, true, true>(F.lds + RING_OFF, g, S, E, F.wave); }
#endif
        if (IN(pb + 3)) REPS(6) {
            pg8::Gemm g{F.YC, F.PCAT, HB_ROWS, DM, KC, KC, KC}; pg8::StaticOrder S; S.init(HB_ROWS, DM, F.G, (int)blockIdx.x);
            pg8::EpiG2cat E{F.PA, F.MRG};
            pg8::gemm_phase<pg8::EpiG2cat, pg8::StaticOrder, true, true>(F.lds + RING_OFF, g, S, E, F.wave);
        } SEAM(pb + 3);
        if (IN(pb + 4)) REPS(7) {
            pg8::Gemm g{F.MRG, F.WOUT, HB_ROWS, DM, DM, DM, DM}; pg8::StaticOrder S; S.init(HB_ROWS, DM, F.G, (int)blockIdx.x);
            pg8::EpiG3 E{F.x + (size_t)row0 * DM, F.out + (size_t)row0 * DM};
            pg8::gemm_phase<pg8::EpiG3, pg8::StaticOrder, true, true>(F.lds + RING_OFF, g, S, E, F.wave);
        } if (hb == 1) SEAM(pb + 4);
    }
#undef IN
#undef SEAM
}

extern "C" void kernel_launch(void* const* d_in, const int* in_sizes, int n_in, void* d_out, int out_size, void* d_ws, size_t ws_size, hipStream_t stream) {
    static int grid = 0;
    if (grid == 0) {
        if (n_in != 20 || in_sizes[0] != MTOT * DM || out_size != MTOT * DM || ws_size < WS_END) { fprintf(stderr, "kernel_launch: unexpected shapes (n_in %d, ws %zu); nothing launched\n", n_in, ws_size); grid = -1; return; }
        int dev = 0, cus = 0, per_cu = 0;
        if (hipGetDevice(&dev) != hipSuccess || hipDeviceGetAttribute(&cus, hipDeviceAttributeMultiprocessorCount, dev) != hipSuccess) { grid = -1; return; }
        if (hipFuncSetAttribute((const void*)mega_fwd, hipFuncAttributeMaxDynamicSharedMemorySize, LDS_BYTES) != hipSuccess) { fprintf(stderr, "kernel_launch: hipFuncSetAttribute failed\n"); grid = -1; return; }
        if (hipOccupancyMaxActiveBlocksPerMultiprocessor(&per_cu, (const void*)mega_fwd, NTHR, LDS_BYTES) != hipSuccess || per_cu < 1) { fprintf(stderr, "kernel_launch: occupancy query says %d blocks per CU\n", per_cu); (void)hipGetLastError(); grid = -1; return; }
        grid = cus;
    }
    if (grid < 0) return;
    if (hipMemsetAsync((char*)d_ws + WS_CTL, 0, CTL_ZERO_BYTES, stream) != hipSuccess) return;
    Args a{};
    for (int i = 0; i < 20; ++i) a.in[i] = (const float*)d_in[i];
    a.out = (float*)d_out; a.ws = (unsigned char*)d_ws;
#if MK_PER_PHASE
    for (int p = 0; p < NPHASES; ++p) { a.ph_lo = p; a.ph_hi = p + 1; hipLaunchKernelGGL(mega_fwd, dim3(grid), dim3(NTHR), LDS_BYTES, stream, a); }
#else
    a.ph_lo = 0; a.ph_hi = NPHASES; hipLaunchKernelGGL(mega_fwd, dim3(grid), dim3(NTHR), LDS_BYTES, stream, a);
#endif
}
```

```cpp
#include <hip/hip_runtime.h>
#include <cstdint>
#include <cstdio>

constexpr int DM = 1024, NB = 32, SEQ = 2048, MTOT = NB * SEQ;
constexpr int NIN = 8960, MEML = 256, MMEM = NB * MEML;
constexpr int HB_ROWS = MTOT / 2;
constexpr int C_AU = 0, C_AV = 768, C_AZ = 1536, C_BQ = 2304, C_BK = 3072, C_BV = 3840, C_BZ = 4608, C_MQ = 4864, C_MZ = 5376, C_G = 5888;
constexpr float EPS = 1e-6f;
constexpr int SS_W = 112;
constexpr int PAP = 7424;
constexpr int PA_ROWB = 2 * PAP, PA_GOFF = 2 * C_G;
constexpr int NUZ8 = 2;
constexpr int N8 = 7424 + 256 * NUZ8;
__host__ __device__ constexpr int i8col(int n) { return n >= C_G ? n - C_G : (n >= C_BQ && n < C_BZ) ? n - C_BQ + 3072 : (n >= C_AV && n < C_AZ) ? n - C_AV + 5376 : (n >= C_BZ && n < C_G) ? n - C_BZ + 6144 : (n < C_AU + 128 * NUZ8) ? 7424 + 256 * (n >> 7) + (n & 127) : (n >= C_AZ && n < C_AZ + 128 * NUZ8) ? 7424 + 256 * ((n - C_AZ) >> 7) + 128 + ((n - C_AZ) & 127) : -1; }
__host__ __device__ constexpr int i8src(int c8) { return c8 < 3072 ? C_G + c8 : c8 < 5376 ? C_BQ + (c8 - 3072) : c8 < 6144 ? C_AV + (c8 - 5376) : c8 < 7424 ? C_BZ + (c8 - 6144) : (((c8 - 7424) & 255) < 128 ? C_AU : C_AZ - 128) + 128 * ((c8 - 7424) >> 8) + ((c8 - 7424) & 255); }
__host__ __device__ constexpr int i8tile_pn(int t8) { return t8 < 12 ? 23 + t8 : t8 < 21 ? 9 + (t8 - 12) : t8 < 24 ? 3 + (t8 - 21) : t8 < 29 ? 18 + (t8 - 24) : t8 - 29; }
constexpr int KC = 1536;

constexpr size_t MiB = 1u << 20;
constexpr size_t WS_CTL = 0, CTL_ZERO_BYTES = 64 * 1024, WS_WIN = 2 * MiB, WS_PCAT = 22 * MiB, WS_WOUT = 25 * MiB, WS_WSP = 27 * MiB, WS_BIAS = 27 * MiB + 512 * 1024;
constexpr size_t WS_XN = 32 * MiB, WS_PA = 176 * MiB, WS_KVM = 736 * MiB, WS_SS = 752 * MiB, WS_MKSS = 766 * MiB, WS_OG = 768 * MiB, WS_LSE = 816 * MiB, WS_LNST = 818 * MiB;
constexpr size_t WS_YC = 820 * MiB, WS_MRG = 916 * MiB, WS_END = 980 * MiB;
constexpr int P8 = 1152;
constexpr size_t WS_XN8 = 640 * MiB, WS_W8 = 712 * MiB, WS_CS = 721 * MiB, WS_RS = 722 * MiB;
constexpr int CW_CMAX = 8192;
constexpr int CW_BAR = 4096;

__device__ __forceinline__ float xl_swap32(float x, bool mx) { const unsigned u = __builtin_bit_cast(unsigned, x); const auto r = __builtin_amdgcn_permlane32_swap(u, u, false, false); const unsigned a = r[0], b = r[1];
    const float fa = __builtin_bit_cast(float, a), fb = __builtin_bit_cast(float, b); return mx ? fmaxf(fa, fb) : fa + fb; }
__device__ __forceinline__ float xl_swap16(float x) { const unsigned u = __builtin_bit_cast(unsigned, x); const auto r = __builtin_amdgcn_permlane16_swap(u, u, false, false); const unsigned a = r[0], b = r[1];
    return __builtin_bit_cast(float, a) + __builtin_bit_cast(float, b); }
__device__ __forceinline__ float sum_x32(float x) { return xl_swap32(x, false); }
__device__ __forceinline__ float max_x32(float x) { return xl_swap32(x, true); }
__device__ __forceinline__ float sum_x16_x32(float x) { return xl_swap32(xl_swap16(x), false); }
template <int CTRL> __device__ __forceinline__ float dpp_f(float x) { return __builtin_bit_cast(float, __builtin_amdgcn_update_dpp(0, __builtin_bit_cast(int, x), CTRL, 0xf, 0xf, true)); }
__device__ __forceinline__ float sum_quad(float x) { x += dpp_f<0xB1>(x); return x + dpp_f<0x4E>(x); }
namespace pg8 {
#define PG8_LAS __attribute__((address_space(3)))
typedef unsigned short bf16_t;
typedef short bf16x8 __attribute__((ext_vector_type(8)));
typedef float f32x4 __attribute__((ext_vector_type(4)));
typedef unsigned u32x4 __attribute__((ext_vector_type(4)));
constexpr int BM = 256, BK = 64, HALF = 128, HTB = HALF * BK * 2  , STAGE_BYTES = 8 * HTB, NXCD = 8, WGM = 8;

__host__ __device__ __forceinline__ int lds_byte(int r, int c) { const int st = (r >> 4) * 2 + (c >> 5), rr = r & 15, cc = c & 31, ob = rr * 64 + cc * 2; return st * 1024 + (ob ^ (((ob >> 9) & 1) << 5)); }
__host__ __device__ __forceinline__ void stage_rc(int b, int& R, int& C) { const int st = b / 1024, sb = b % 1024, swz = sb ^ (((sb >> 9) & 1) << 5); R = (st >> 1) * 16 + swz / 64; C = (st & 1) * 32 + (swz % 64) / 2; }
__host__ __device__ __forceinline__ int perm32(int rho) { const int n = rho >> 4, i = rho & 15; return 8 * (i >> 2) + 4 * n + (i & 3); }

struct Unit { int pm, pn; };
struct Gemm { const bf16_t* A; const bf16_t* Bt; int M, N, K, lda, ldb; };

struct StaticOrder {
    int nM, nN, nwg, G, c;
    __host__ __device__ void init(int M, int N, int G_, int c_) { nM = M / BM; nN = N / BM; nwg = nM * nN; G = G_; c = c_; }
    __host__ __device__ bool next(int i, Unit& u) const {
        const long L = (long)i * G + c; if (L >= nwg) return false;
        int wgid = (int)L; { const int q = nwg / NXCD, r = nwg % NXCD, xcd = wgid % NXCD, off = wgid / NXCD; wgid = (xcd < r ? xcd * (q + 1) : r * (q + 1) + (xcd - r) * q) + off; }
        const int nig = WGM * nN, gid = wgid / nig, fm = gid * WGM, gsz = (nM - fm) < WGM ? (nM - fm) : WGM;
        u.pm = fm + ((wgid % nig) % gsz); u.pn = (wgid % nig) / gsz; return true;
    }
    __device__ __forceinline__ void a_ready(const Unit&) const {}
    __device__ __forceinline__ void done(const Unit&) const {}
};


typedef float f32x2c_t __attribute__((ext_vector_type(2))); typedef __bf16 bf16x2c_t __attribute__((ext_vector_type(2)));
__device__ __forceinline__ unsigned cvt_pk_bf16(float lo, float hi) { const f32x2c_t v = {lo, hi}; const bf16x2c_t b = __builtin_convertvector(v, bf16x2c_t); return __builtin_bit_cast(unsigned, b); }
typedef float f32x2 __attribute__((ext_vector_type(2)));
__device__ __forceinline__ f32x2 gelu_pk(f32x2 v) {
    const f32x2 av = __builtin_elementwise_abs(v), d = av * 0.2316418882f + 1.0f;
    f32x2 t; t.x = __builtin_amdgcn_rcpf(d.x); t.y = __builtin_amdgcn_rcpf(d.y);
    f32x2 q = t * 0.5307027145f + (-0.7265760135f); q = q * t + 0.7107068705f; q = q * t + (-0.142248368f); q = q * t + 0.127414796f; q = q * t;
    const f32x2 s = (v * v) * (-0.72134752044f);
    f32x2 e; e.x = __builtin_amdgcn_exp2f(s.x); e.y = __builtin_amdgcn_exp2f(s.y);
    const f32x2 m = v * (q * e), r = v - m;
    f32x2 o; o.x = v.x < 0.f ? m.x : r.x; o.y = v.y < 0.f ? m.y : r.y; return o;
}

typedef int i32x4 __attribute__((ext_vector_type(4)));
template <bool I8> __device__ __forceinline__ f32x4 mma16(bf16x8 a, bf16x8 b, f32x4 c) {
    if constexpr (I8) return __builtin_bit_cast(f32x4, __builtin_amdgcn_mfma_i32_16x16x64_i8(__builtin_bit_cast(i32x4, a), __builtin_bit_cast(i32x4, b), __builtin_bit_cast(i32x4, c), 0, 0, 0));
    else return __builtin_amdgcn_mfma_f32_16x16x32_bf16(a, b, c, 0, 0, 0);
}
template <class Epi, class Sched, bool ALIGN_EPI = false, bool SP2 = false, bool I8 = false>
__device__ __forceinline__ void gemm_phase(PG8_LAS unsigned char* lds, const Gemm g, const Sched& S, const Epi& E, const int wave_id) {
    int tid; asm volatile("v_mbcnt_lo_u32_b32 %0, -1, 0\n\tv_mbcnt_hi_u32_b32 %0, -1, %0" : "=v"(tid)); tid += wave_id * 64;
    const int wid = __builtin_amdgcn_readfirstlane(tid >> 6), lane = tid & 63, wr = wid >> 2, wc = wid & 3, fr = lane & 15, fq = lane >> 4;
    int K = g.K; asm volatile("" : "+s"(K)); const int nt = K / BK;
    unsigned voffA[2], voffB[2];
#pragma unroll
    for (int i = 0; i < 2; ++i) { int R, C; stage_rc(tid * 16 + i * 8192, R, C); const int Rb = Epi::PERM ? ((R & ~31) + perm32(R & 31)) : R;
        voffA[i] = (unsigned)(R * g.lda + C) * 2u; voffB[i] = (unsigned)(Rb * g.ldb + C) * 2u; }
    const size_t kstep = (size_t)(BK * 2);
    const size_t hstepA = (size_t)HALF * g.lda * 2, hstepB = (size_t)HALF * g.ldb * 2;
    const size_t tstepA = 2 * hstepA, tstepB = 2 * hstepB;
    const unsigned ldsw = (unsigned)wid * 1024u;
    const int aoff = lds_byte(wr * 64 + fr, fq * 8), boff = lds_byte(wc * 32 + fr, fq * 8);
#define PG8_SA(b, h) (((b) * 2 + (h)) * HTB)
#define PG8_SB(b, h) ((4 + (b) * 2 + (h)) * HTB)
#define PG8_STAGE(bufoff, gbase, voff) do { _Pragma("unroll") for (int _i = 0; _i < 2; ++_i) \
        __builtin_amdgcn_global_load_lds((const unsigned*)((const char*)(gbase) + (voff)[_i]), (PG8_LAS unsigned*)(lds + (bufoff) + ldsw + _i * 8192), 16, 0, 0); } while (0)
#define PG8_LDA(dst, b, h) do { _Pragma("unroll") for (int m = 0; m < 4; ++m) _Pragma("unroll") for (int k = 0; k < 2; ++k) dst[m][k] = *(const PG8_LAS bf16x8*)(lds + PG8_SA(b, h) + aoff + m * 2048 + k * 1024); } while (0)
#define PG8_LDB(dst, b, h) do { _Pragma("unroll") for (int n = 0; n < 2; ++n) _Pragma("unroll") for (int k = 0; k < 2; ++k) dst[n][k] = *(const PG8_LAS bf16x8*)(lds + PG8_SB(b, h) + boff + n * 2048 + k * 1024); } while (0)
#define PG8_MMA(ai, bj, At, Bt) do { __builtin_amdgcn_s_setprio(1); _Pragma("unroll") for (int m = 0; m < 4; ++m) _Pragma("unroll") for (int n = 0; n < 2; ++n) _Pragma("unroll") for (int k = 0; k < 2; ++k) \
        acc[ai][bj][m][n] = mma16<I8>(Bt[n][k], At[m][k], acc[ai][bj][m][n]); __builtin_amdgcn_s_setprio(0); } while (0)
#define PG8_WAIT_V(n) asm volatile("s_waitcnt vmcnt(" #n ")" ::: "memory")
#define PG8_WAIT_L(n) asm volatile("s_waitcnt lgkmcnt(" #n ")" ::: "memory")
#define PG8_BAR __builtin_amdgcn_s_barrier()
#define PG8_SCHED __builtin_amdgcn_sched_barrier(0)
    Unit cur, nxt; int ui = 0;
    if (!S.next(0, cur)) return;
    f32x4 acc[2][2][4][2];
#pragma unroll
    for (int a = 0; a < 2; ++a)
#pragma unroll
        for (int b = 0; b < 2; ++b)
#pragma unroll
            for (int m = 0; m < 4; ++m)
#pragma unroll
                for (int n = 0; n < 2; ++n) acc[a][b][m][n] = (f32x4){0.f, 0.f, 0.f, 0.f};
    bf16x8 At[4][2], B0[2][2], B1[2][2];
    const char* cA = (const char*)g.A + (size_t)cur.pm * tstepA; const char* cB = (const char*)g.Bt + (size_t)cur.pn * tstepB;
    S.a_ready(cur);
    if constexpr (I8) E.stage_scales(cur, 0, wid, lane);
    if constexpr (SP2) {
        PG8_STAGE(PG8_SB(0, 0), cB, voffB); PG8_STAGE(PG8_SB(0, 1), cB + hstepB, voffB); PG8_STAGE(PG8_SA(0, 0), cA, voffA); PG8_STAGE(PG8_SA(0, 1), cA + hstepA, voffA);
        if (wr == 1) PG8_BAR;
        PG8_WAIT_V(2); PG8_BAR;
        PG8_STAGE(PG8_SB(1, 0), cB + kstep, voffB); PG8_STAGE(PG8_SA(1, 0), cA + kstep, voffA); PG8_STAGE(PG8_SB(1, 1), cB + hstepB + kstep, voffB);
        PG8_WAIT_V(6); PG8_BAR;
    } else {
        PG8_STAGE(PG8_SB(0, 0), cB, voffB); PG8_STAGE(PG8_SA(0, 0), cA, voffA); PG8_STAGE(PG8_SB(0, 1), cB + hstepB, voffB); PG8_STAGE(PG8_SA(0, 1), cA + hstepA, voffA);
        if (wr == 1) PG8_BAR;
        PG8_WAIT_V(4); PG8_BAR;
        PG8_STAGE(PG8_SB(1, 0), cB + kstep, voffB); PG8_STAGE(PG8_SA(1, 0), cA + kstep, voffA); PG8_STAGE(PG8_SB(1, 1), cB + hstepB + kstep, voffB);
        PG8_WAIT_V(6); PG8_BAR;
    }
    for (;;) {
        const bool has_next = S.next(ui + 1, nxt);
        const char* nA = has_next ? (const char*)g.A + (size_t)nxt.pm * tstepA : cA; const char* nB = has_next ? (const char*)g.Bt + (size_t)nxt.pn * tstepB : cB;
        for (int t = 0; t < nt; t += 2) {
            if constexpr (Epi::KHOOK) { if (t == Epi::KH1 || t == Epi::KH2) {
                if constexpr (ALIGN_EPI) { if (wr == 0) PG8_BAR; }
                E.khook(acc, cur, t, wr, wc, fr, fq);
                if constexpr (ALIGN_EPI) { if (wr == 1) PG8_BAR; } } }
            const bool last = (t == nt - 2);
            const char* a1 = cA + (size_t)(t + 1) * kstep;
            const char* a2 = last ? nA : cA + (size_t)(t + 2) * kstep; const char* b2 = last ? nB : cB + (size_t)(t + 2) * kstep;
            const char* a3 = a2 + kstep; const char* b3 = b2 + kstep;
            if (last && has_next) S.a_ready(nxt);
            if constexpr (I8) { if (last && has_next) E.stage_scales(nxt, (ui + 1) & 1, wid, lane); }
            if constexpr (SP2) {
            PG8_LDB(B0, 0, 0); PG8_LDB(B1, 0, 1); PG8_SCHED; PG8_LDA(At, 0, 0); PG8_STAGE(PG8_SA(1, 1), a1 + hstepA, voffA);
            PG8_WAIT_V(8); PG8_WAIT_L(0); PG8_BAR; PG8_MMA(0, 0, At, B0); PG8_MMA(0, 1, At, B1); PG8_BAR; PG8_SCHED;
            PG8_LDA(At, 0, 1); PG8_STAGE(PG8_SB(0, 0), b2, voffB); PG8_STAGE(PG8_SB(0, 1), b2 + hstepB, voffB); PG8_STAGE(PG8_SA(0, 0), a2, voffA);
            PG8_WAIT_V(8); PG8_WAIT_L(0); PG8_BAR; PG8_MMA(1, 0, At, B0); PG8_MMA(1, 1, At, B1); PG8_BAR; PG8_SCHED;
            PG8_LDB(B0, 1, 0); PG8_LDB(B1, 1, 1); PG8_SCHED; PG8_LDA(At, 1, 0); PG8_STAGE(PG8_SA(0, 1), a2 + hstepA, voffA);
            PG8_WAIT_V(8); PG8_WAIT_L(0); PG8_BAR; PG8_MMA(0, 0, At, B0); PG8_MMA(0, 1, At, B1); PG8_BAR; PG8_SCHED;
            PG8_LDA(At, 1, 1); PG8_STAGE(PG8_SB(1, 0), b3, voffB); PG8_STAGE(PG8_SB(1, 1), b3 + hstepB, voffB); PG8_STAGE(PG8_SA(1, 0), a3, voffA);
            PG8_WAIT_V(8); PG8_WAIT_L(0); PG8_BAR; PG8_MMA(1, 0, At, B0); PG8_MMA(1, 1, At, B1); PG8_BAR; PG8_SCHED;
            } else {
            PG8_LDB(B0, 0, 0); PG8_SCHED; PG8_LDA(At, 0, 0); PG8_STAGE(PG8_SA(1, 1), a1 + hstepA, voffA);
            PG8_WAIT_L(8); PG8_BAR; PG8_WAIT_L(0); PG8_MMA(0, 0, At, B0); PG8_BAR; PG8_SCHED;
            PG8_LDB(B1, 0, 1); PG8_STAGE(PG8_SB(0, 0), b2, voffB);
            PG8_BAR; PG8_WAIT_L(0); PG8_MMA(0, 1, At, B1); PG8_BAR;
            PG8_LDA(At, 0, 1); PG8_STAGE(PG8_SA(0, 0), a2, voffA);
            PG8_BAR; PG8_WAIT_L(0); PG8_MMA(1, 0, At, B0); PG8_BAR; PG8_SCHED;
            PG8_STAGE(PG8_SB(0, 1), b2 + hstepB, voffB);
            PG8_WAIT_V(6); PG8_BAR; PG8_MMA(1, 1, At, B1); PG8_BAR;
            PG8_LDB(B0, 1, 0); PG8_SCHED; PG8_LDA(At, 1, 0); PG8_STAGE(PG8_SA(0, 1), a2 + hstepA, voffA);
            PG8_WAIT_L(8); PG8_BAR; PG8_WAIT_L(0); PG8_MMA(0, 0, At, B0); PG8_BAR; PG8_SCHED;
            PG8_LDB(B1, 1, 1); PG8_STAGE(PG8_SB(1, 0), b3, voffB);
            PG8_BAR; PG8_WAIT_L(0); PG8_MMA(0, 1, At, B1); PG8_BAR;
            PG8_LDA(At, 1, 1); PG8_STAGE(PG8_SA(1, 0), a3, voffA);
            PG8_BAR; PG8_WAIT_L(0); PG8_MMA(1, 0, At, B0); PG8_BAR; PG8_SCHED;
            PG8_STAGE(PG8_SB(1, 1), b3 + hstepB, voffB);
            PG8_WAIT_V(6); PG8_BAR; PG8_MMA(1, 1, At, B1); PG8_BAR;
            }
        }
        if constexpr (ALIGN_EPI) { if (wr == 0) PG8_BAR; }
        if constexpr (I8) { _Pragma("unroll") for (int a_ = 0; a_ < 2; ++a_) _Pragma("unroll") for (int b_ = 0; b_ < 2; ++b_) _Pragma("unroll") for (int m_ = 0; m_ < 4; ++m_) _Pragma("unroll") for (int n_ = 0; n_ < 2; ++n_) acc[a_][b_][m_][n_] = __builtin_convertvector(__builtin_bit_cast(i32x4, acc[a_][b_][m_][n_]), f32x4); }
        if constexpr (I8) { E.epi8(acc, cur, ui & 1, wr, wc, fr, fq); S.done(cur); }
        else if constexpr (!Epi::AFTER_DRAIN) { E(acc, cur, wr, wc, fr, fq); S.done(cur); }
        if (!has_next) break;
#pragma unroll
        for (int a = 0; a < 2; ++a)
#pragma unroll
            for (int b = 0; b < 2; ++b)
#pragma unroll
                for (int m = 0; m < 4; ++m)
#pragma unroll
                    for (int n = 0; n < 2; ++n) { f32x2 z0, z1; asm volatile("v_mov_b64 %0, 0\n\tv_mov_b64 %1, 0" : "=v"(z0), "=v"(z1)); acc[a][b][m][n] = (f32x4){z0.x, z0.y, z1.x, z1.y}; }
        cur = nxt; cA = nA; cB = nB; ++ui;
        if constexpr (ALIGN_EPI) { if (wr == 1) PG8_BAR; }
    }
    PG8_WAIT_V(0);
    if constexpr (!ALIGN_EPI) { if (wr == 0) PG8_BAR; }
    PG8_BAR;
    if constexpr (Epi::AFTER_DRAIN) { E.fused(acc, cur, wr, wc, fr, fq, lds, wid, lane); S.done(cur); }
#undef PG8_SA
#undef PG8_SB
#undef PG8_STAGE
#undef PG8_LDA
#undef PG8_LDB
#undef PG8_MMA
#undef PG8_WAIT_V
#undef PG8_WAIT_L
#undef PG8_BAR
#undef PG8_SCHED
}
}

#ifndef G1_EPI_DRAIN
#define G1_EPI_DRAIN 0
#endif
#ifndef G1_STORE_AUX_MIX
#define G1_STORE_AUX_MIX 2
#endif
#ifndef G1_STORE_AUX
#define G1_STORE_AUX 2
#endif
namespace pg8 {
__device__ __forceinline__ int gate_srow(int wr, int wc, int ai, int m, int bj, int fq) { return 2 * ((((wr * 4 + wc) * 2 + ai) * 4 + m) * 2 + bj) + (fq >> 1); }
__device__ __forceinline__ float ubf0(unsigned w) { return (float)(w & 0xffu); }
__device__ __forceinline__ float ubf1(unsigned w) { return (float)((w >> 8) & 0xffu); }
__device__ __forceinline__ float ubf2(unsigned w) { return (float)((w >> 16) & 0xffu); }
__device__ __forceinline__ float ubf3(unsigned w) { return (float)(w >> 24); }
__device__ __forceinline__ float ex2(float x) { return __builtin_amdgcn_exp2f(x); }
__device__ __forceinline__ float sigm_fast(float x) { return __builtin_amdgcn_rcpf(1.0f + ex2(x * -1.4426950408889634f)); }
template <int MODE = 0  > struct EpiProjT {
    static constexpr bool PERM = true, AFTER_DRAIN = false, KHOOK = false;
    bf16_t* PA; bf16_t* KVM; float* SS; float* MKSS; const float* gate_b; int pm0; int pad;
    template <int KIND, int STAT> __device__ __forceinline__ void body(const f32x4 (&acc)[2][2][4][2], const __amdgpu_buffer_rsrc_t rsrc, int row0, int col0, int ldc, float* sb, int sld, int so, const float* bias, int wc, int fq) const {
        f32x4 bv[2][2];
        if (KIND == 3) {
#pragma unroll
            for (int bj = 0; bj < 2; ++bj)
#pragma unroll
                for (int n = 0; n < 2; ++n) bv[bj][n] = *(const f32x4*)(bias + bj * HALF + 4 * n);
        }
#pragma unroll
        for (int ai = 0; ai < 2; ++ai)
#pragma unroll
            for (int m = 0; m < 4; ++m) { const int row = row0 + ai * HALF + m * 16; const unsigned rowoff = ((unsigned)row * (unsigned)ldc + (unsigned)col0) * 2u;
#pragma unroll
                for (int bj = 0; bj < 2; ++bj) { f32x4 v0 = acc[ai][bj][m][0], v1 = acc[ai][bj][m][1];
                    if (KIND == 1) { f32x2 a = gelu_pk((f32x2){v0[0], v0[1]}), b = gelu_pk((f32x2){v0[2], v0[3]}), c = gelu_pk((f32x2){v1[0], v1[1]}), d = gelu_pk((f32x2){v1[2], v1[3]});
                        v0 = (f32x4){a.x, a.y, b.x, b.y}; v1 = (f32x4){c.x, c.y, d.x, d.y}; }
                    else if (KIND == 2) {
#pragma unroll
                        for (int j = 0; j < 4; ++j) { v0[j] = v0[j] * sigm_fast(v0[j]); v1[j] = v1[j] * sigm_fast(v1[j]); } }
                    else if (KIND == 3) { v0 = v0 + bv[bj][0]; v1 = v1 + bv[bj][1];
#pragma unroll
                        for (int j = 0; j < 4; ++j) { v0[j] = sigm_fast(v0[j]); v1[j] = sigm_fast(v1[j]); } }
                    if (STAT) {
                        float s = ((v0[0] + v0[1]) + (v0[2] + v0[3])) + ((v1[0] + v1[1]) + (v1[2] + v1[3]));
                        float q = ((v0[0] * v0[0] + v0[1] * v0[1]) + (v0[2] * v0[2] + v0[3] * v0[3])) + ((v1[0] * v1[0] + v1[1] * v1[1]) + (v1[2] * v1[2] + v1[3] * v1[3]));
                        if (STAT == 2) s = sum_x16_x32(s);
                        q = sum_x16_x32(q);
                        if (fq == 0) { float* sp = sb + (size_t)row * sld + so; const int blk = 4 * bj + wc;
                            if (STAT == 2) { sp[2 * blk] = s; sp[2 * blk + 1] = q; } else sp[blk] = q; }
                    }
                    u32x4 w; w.x = cvt_pk_bf16(v0[0], v0[1]); w.y = cvt_pk_bf16(v0[2], v0[3]); w.z = cvt_pk_bf16(v1[0], v1[1]); w.w = cvt_pk_bf16(v1[2], v1[3]);
                    if (MODE == 2) asm volatile("" :: "v"(w)); else __builtin_amdgcn_raw_buffer_store_b128(w, rsrc, (int)(rowoff + bj * HALF * 2), 0, KIND == 3 ? G1_STORE_AUX : G1_STORE_AUX_MIX); } }
    }
    __device__ __forceinline__ void uz_body(const f32x4 (&acc)[2][2][4][2], const __amdgpu_buffer_rsrc_t rsrc, int row0, int ucol0) const {
#pragma unroll
        for (int ai = 0; ai < 2; ++ai)
#pragma unroll
            for (int m = 0; m < 4; ++m) { const int row = row0 + ai * HALF + m * 16;
                f32x4 u0 = acc[ai][0][m][0], u1 = acc[ai][0][m][1]; const f32x4 z0 = acc[ai][1][m][0], z1 = acc[ai][1][m][1];
                { f32x2 a = gelu_pk((f32x2){u0[0], u0[1]}), b = gelu_pk((f32x2){u0[2], u0[3]}), c = gelu_pk((f32x2){u1[0], u1[1]}), d = gelu_pk((f32x2){u1[2], u1[3]});
                  u0 = (f32x4){a.x, a.y, b.x, b.y}; u1 = (f32x4){c.x, c.y, d.x, d.y}; }
#pragma unroll
                for (int j = 0; j < 4; ++j) { u0[j] *= z0[j] * sigm_fast(z0[j]); u1[j] *= z1[j] * sigm_fast(z1[j]); }
                u32x4 w; w.x = cvt_pk_bf16(u0[0], u0[1]); w.y = cvt_pk_bf16(u0[2], u0[3]); w.z = cvt_pk_bf16(u1[0], u1[1]); w.w = cvt_pk_bf16(u1[2], u1[3]);
                if (MODE == 2) asm volatile("" :: "v"(w)); else __builtin_amdgcn_raw_buffer_store_b128(w, rsrc, (int)((unsigned)row * (unsigned)PA_ROWB + (unsigned)(2 * (C_AU + ucol0))), 0, G1_STORE_AUX_MIX); }
    }
    __device__ __forceinline__ void gate_body(const f32x4 (&acc)[2][2][4][2], const __amdgpu_buffer_rsrc_t rsrc, int row0, int gcol0, const float* bias) const {
        f32x4 bv[2][2];
#pragma unroll
        for (int bj = 0; bj < 2; ++bj)
#pragma unroll
            for (int n = 0; n < 2; ++n) bv[bj][n] = *(const f32x4*)(bias + 8 * bj + 4 * n);
#pragma unroll
        for (int ai = 0; ai < 2; ++ai)
#pragma unroll
            for (int m = 0; m < 4; ++m) { const int row = row0 + ai * HALF + m * 16; u32x4 w;
#pragma unroll
                for (int bj = 0; bj < 2; ++bj)
#pragma unroll
                    for (int n = 0; n < 2; ++n) { const f32x4 v = acc[ai][bj][m][n] + bv[bj][n]; unsigned d = 0u;
#pragma unroll
                        for (int j = 0; j < 4; ++j) d |= (unsigned)(fmaxf(sigm_fast(v[j]) * 255.0f, 1.0f) + 0.5f) << (8 * j);
                        w[2 * bj + n] = d; }
                if (MODE == 2) asm volatile("" :: "v"(w)); else __builtin_amdgcn_raw_buffer_store_b128(w, rsrc, (int)((unsigned)row * (unsigned)PA_ROWB + (unsigned)(PA_GOFF + gcol0)), 0, G1_STORE_AUX); }
    }
    __device__ __forceinline__ void operator()(const f32x4 (&acc)[2][2][4][2], const Unit& u, int wr, int wc, int fr, int fq) const {
        const bool kv = u.pn >= 35; const int pn = kv ? u.pn - 35 : u.pn;
        const int rowt = kv ? (u.pm - 256) * BM : (u.pm - pm0) * BM;
        bf16_t* base = kv ? KVM : PA; const int ldc = kv ? 1024 : PAP;
        const __amdgpu_buffer_rsrc_t rsrc = __builtin_amdgcn_make_buffer_rsrc(base, 0, kv ? (int)((size_t)MMEM * 1024 * 2) : (int)((size_t)HB_ROWS * PA_ROWB), 0x00020000);
        const int row0 = rowt + wr * 64 + fr, col0 = pn * BM + wc * 32 + 8 * fq;
        if (MODE == 1) { body<0, 0>(acc, rsrc, row0, col0, ldc, SS, SS_W, 0, gate_b, wc, fq); return; }
        if (kv) { if (pn < 2) body<0, 1>(acc, rsrc, row0, col0, ldc, MKSS, 16, 8 * pn, gate_b, wc, fq); else body<0, 0>(acc, rsrc, row0, col0, ldc, SS, SS_W, 0, gate_b, wc, fq); }
        else if (pn < 3) uz_body(acc, rsrc, row0, 128 * pn + 32 * wc + 8 * fq);
        else if (pn < 6) body<1, 2>(acc, rsrc, row0, col0, ldc, SS, SS_W, 16 * (pn - 3), gate_b, wc, fq);
        else if (pn < 9) uz_body(acc, rsrc, row0, 128 * (pn - 3) + 32 * wc + 8 * fq);
        else if (pn < 12) body<0, 1>(acc, rsrc, row0, col0, ldc, SS, SS_W, 48 + 8 * (pn - 9), gate_b, wc, fq);
        else if (pn < 15) body<0, 1>(acc, rsrc, row0, col0, ldc, SS, SS_W, 72 + 8 * (pn - 12), gate_b, wc, fq);
        else if (pn < 18) body<0, 0>(acc, rsrc, row0, col0, ldc, SS, SS_W, 0, gate_b, wc, fq);
        else if (pn < 19) body<2, 0>(acc, rsrc, row0, col0, ldc, SS, SS_W, 0, gate_b, wc, fq);
        else if (pn < 21) body<0, 1>(acc, rsrc, row0, col0, ldc, SS, SS_W, 96 + 8 * (pn - 19), gate_b, wc, fq);
        else if (pn < 23) body<2, 0>(acc, rsrc, row0, col0, ldc, SS, SS_W, 0, gate_b, wc, fq);
        else { const int gc = (pn - 23) * BM + 64 * wc + 16 * fq; gate_body(acc, rsrc, row0, gc, gate_b + gc); }
#if G1_EPI_DRAIN
        asm volatile("s_waitcnt vmcnt(0)" ::: "memory");
#endif
    }
};
typedef EpiProjT<0> EpiProj;
template <bool HOOKS = true, bool EPI = true> struct EpiG2catT {
    static constexpr bool PERM = true, AFTER_DRAIN = false, KHOOK = HOOKS; static constexpr int KH1 = 12, KH2 = 16;
    const bf16_t* PA; bf16_t* MRG;
    __device__ __forceinline__ void khook(f32x4 (&acc)[2][2][4][2], const Unit& u, int t, int wr, int wc, int fr, int fq) const {
        typedef unsigned u32x2v __attribute__((ext_vector_type(2)));
        const int ga = t == KH1 ? 0 : 1;
        const __amdgpu_buffer_rsrc_t grs = __builtin_amdgcn_make_buffer_rsrc((void*)PA, 0, (int)((size_t)HB_ROWS * PA_ROWB), 0x00020000);
        const int gvo = (u.pm * BM + gate_srow(wr, wc, 0, 0, 0, fq)) * PA_ROWB + PA_GOFF + ga * DM + u.pn * BM + 16 * fr + 8 * (fq & 1);
        u32x2v ag[2][4][2], bg[2][4][2];
#pragma unroll
        for (int ai = 0; ai < 2; ++ai)
#pragma unroll
            for (int m = 0; m < 4; ++m)
#pragma unroll
                for (int bj = 0; bj < 2; ++bj) { const int so = gate_srow(0, 0, ai, m, bj, 0) * PA_ROWB; ag[ai][m][bj] = __builtin_bit_cast(u32x2v, __builtin_amdgcn_raw_buffer_load_b64(grs, gvo, so, 0)); bg[ai][m][bj] = __builtin_bit_cast(u32x2v, __builtin_amdgcn_raw_buffer_load_b64(grs, gvo + DM, so, 0)); }
        __builtin_amdgcn_sched_barrier(0);
#define G2_R(A, Bv, K) (ubf##K(A) * __builtin_amdgcn_rcpf(ubf##K(Bv)))
#pragma unroll
        for (int ai = 0; ai < 2; ++ai)
#pragma unroll
            for (int m = 0; m < 4; ++m)
#pragma unroll
                for (int bj = 0; bj < 2; ++bj) { const u32x2v a = ag[ai][m][bj], b = bg[ai][m][bj]; f32x4 r0, r1;
                    r0[0] = G2_R(a.x, b.x, 0); r0[1] = G2_R(a.x, b.x, 1); r0[2] = G2_R(a.x, b.x, 2); r0[3] = G2_R(a.x, b.x, 3);
                    r1[0] = G2_R(a.y, b.y, 0); r1[1] = G2_R(a.y, b.y, 1); r1[2] = G2_R(a.y, b.y, 2); r1[3] = G2_R(a.y, b.y, 3);
                    acc[ai][bj][m][0] *= r0; acc[ai][bj][m][1] *= r1; }
#undef G2_R
    }
    __device__ __forceinline__ void operator()(const f32x4 (&acc)[2][2][4][2], const Unit& u, int wr, int wc, int fr, int fq) const {
        typedef unsigned u32x2v __attribute__((ext_vector_type(2)));
        if (!EPI) { _Pragma("unroll") for (int ai = 0; ai < 2; ++ai) _Pragma("unroll") for (int bj = 0; bj < 2; ++bj) _Pragma("unroll") for (int m = 0; m < 4; ++m) asm volatile("" :: "v"(acc[ai][bj][m][0]), "v"(acc[ai][bj][m][1])); return; }
        const int row0 = u.pm * BM + wr * 64 + fr, col0 = u.pn * BM + wc * 32 + 8 * fq;
        const __amdgpu_buffer_rsrc_t grs = __builtin_amdgcn_make_buffer_rsrc((void*)PA, 0, (int)((size_t)HB_ROWS * PA_ROWB), 0x00020000);
        const int gvo = (u.pm * BM + gate_srow(wr, wc, 0, 0, 0, fq)) * PA_ROWB + PA_GOFF + 2 * DM + u.pn * BM + 16 * fr + 8 * (fq & 1);
        u32x2v gv[2][4][2];
#pragma unroll
        for (int ai = 0; ai < 2; ++ai)
#pragma unroll
            for (int m = 0; m < 4; ++m)
#pragma unroll
                for (int bj = 0; bj < 2; ++bj) gv[ai][m][bj] = __builtin_bit_cast(u32x2v, __builtin_amdgcn_raw_buffer_load_b64(grs, gvo, gate_srow(0, 0, ai, m, bj, 0) * PA_ROWB, 0));
        __builtin_amdgcn_sched_barrier(0);
        const float q = 1.0f / 255.0f;
#pragma unroll
        for (int ai = 0; ai < 2; ++ai)
#pragma unroll
            for (int m = 0; m < 4; ++m) { bf16_t* mp = MRG + (size_t)(row0 + ai * HALF + m * 16) * DM + col0;
#pragma unroll
                for (int bj = 0; bj < 2; ++bj) { const u32x2v g = gv[ai][m][bj]; const f32x4 v0 = acc[ai][bj][m][0] * q, v1 = acc[ai][bj][m][1] * q; u32x4 w;
                    w.x = cvt_pk_bf16(v0[0] * ubf0(g.x), v0[1] * ubf1(g.x)); w.y = cvt_pk_bf16(v0[2] * ubf2(g.x), v0[3] * ubf3(g.x));
                    w.z = cvt_pk_bf16(v1[0] * ubf0(g.y), v1[1] * ubf1(g.y)); w.w = cvt_pk_bf16(v1[2] * ubf2(g.y), v1[3] * ubf3(g.y));
                    *(u32x4*)(mp + bj * HALF) = w; } }
    }
};
typedef EpiG2catT<true, true> EpiG2cat;
struct EpiG3 {
    static constexpr bool PERM = false, AFTER_DRAIN = false, KHOOK = false;
    const float* x; float* out;
    static __device__ __forceinline__ f32x4 pairx(f32x4 keep, f32x4 other, bool take) { f32x4 r;
#pragma unroll
        for (int j = 0; j < 4; ++j) { const float kj = keep[j], oj = other[j]; const float t = __builtin_bit_cast(float, __builtin_amdgcn_update_dpp(0, __builtin_bit_cast(int, oj), 0xB1, 0xf, 0xf, true)); r[j] = take ? t : kj; }
        return r; }
    __device__ __forceinline__ void operator()(const f32x4 (&acc)[2][2][4][2], const Unit& u, int wr, int wc, int fr, int fq) const {
        __builtin_amdgcn_s_waitcnt(0xC07F);
        const bool odd = fr & 1;
        const int row0 = u.pm * BM + wr * 64 + fr, col0 = u.pn * BM + wc * 32 + 4 * fq;
        const size_t lbase = (size_t)(row0 & ~1) * DM + col0 + (odd ? 16 : 0);
        f32x4 xa[2][2][2], xb[2][2][2];
#define G3_LOAD(B) do { _Pragma("unroll") for (int mm = 0; mm < 2; ++mm) { const size_t off_ = lbase + (size_t)(((B) >> 1) * HALF + (2 * ((B) & 1) + mm) * 16) * DM; \
            _Pragma("unroll") for (int bj = 0; bj < 2; ++bj) { xa[(B) & 1][mm][bj] = __builtin_nontemporal_load((const f32x4*)(x + off_ + bj * HALF)); xb[(B) & 1][mm][bj] = __builtin_nontemporal_load((const f32x4*)(x + off_ + DM + bj * HALF)); } } } while (0)
#define G3_STORE(B) do { _Pragma("unroll") for (int mm = 0; mm < 2; ++mm) { const size_t off_ = lbase + (size_t)(((B) >> 1) * HALF + (2 * ((B) & 1) + mm) * 16) * DM; \
            _Pragma("unroll") for (int bj = 0; bj < 2; ++bj) { const f32x4 c0_ = acc[(B) >> 1][bj][2 * ((B) & 1) + mm][0], c1_ = acc[(B) >> 1][bj][2 * ((B) & 1) + mm][1]; \
                const f32x4 ca = pairx(c0_, c1_, odd), cb = pairx(c1_, c0_, !odd);                    \
                __builtin_nontemporal_store(xa[(B) & 1][mm][bj] + ca, (f32x4*)(out + off_ + bj * HALF)); \
                __builtin_nontemporal_store(xb[(B) & 1][mm][bj] + cb, (f32x4*)(out + off_ + DM + bj * HALF)); } } } while (0)
        G3_LOAD(0); G3_LOAD(1); __builtin_amdgcn_sched_barrier(0); G3_STORE(0); G3_LOAD(2); __builtin_amdgcn_sched_barrier(0); G3_STORE(1); G3_LOAD(3); __builtin_amdgcn_sched_barrier(0); G3_STORE(2); G3_STORE(3);
#undef G3_LOAD
#undef G3_STORE
    }
};
struct EpiNull {
    static constexpr bool PERM = true, AFTER_DRAIN = false, KHOOK = false;
    __device__ __forceinline__ void operator()(const f32x4 (&acc)[2][2][4][2], const Unit& u, int wr, int wc, int fr, int fq) const {
#pragma unroll
        for (int ai = 0; ai < 2; ++ai)
#pragma unroll
            for (int bj = 0; bj < 2; ++bj)
#pragma unroll
                for (int m = 0; m < 4; ++m) asm volatile("" :: "v"(acc[ai][bj][m][0]), "v"(acc[ai][bj][m][1]));
    }
};
struct OrderG1 {
    StaticOrder so; int pm0, nkv, pn0;
    __device__ void init(int hb, int G, int c, int pn0_, int ntiles, bool with_kv) { so.init(HB_ROWS, ntiles * BM, G, c); pm0 = hb * (HB_ROWS / BM); pn0 = pn0_; nkv = with_kv ? (MMEM / BM) * 4 : 0; }
    __device__ bool next(int i, Unit& u) const {
        if (so.next(i, u)) { u.pm += pm0; u.pn += pn0; return true; }
        const long j = (long)i * so.G + so.c - so.nwg; if (j < 0 || j >= nkv) return false;
        u.pm = 256 + (int)(j >> 2); u.pn = 35 + (int)(j & 3); return true;
    }
    __device__ __forceinline__ void a_ready(const Unit&) const {}
    __device__ __forceinline__ void done(const Unit&) const {}
};
struct OrderBF {
    StaticOrder so; int pm0, nkv;
    __device__ void init(int hb, int G, int c) { so.init(HB_ROWS, (6 - NUZ8) * BM, G, c); pm0 = hb * (HB_ROWS / BM); nkv = hb == 0 ? (MMEM / BM) * 4 : 0; }
    __device__ bool next(int i, Unit& u) const {
        if (so.next(i, u)) { u.pm += pm0; const int t = u.pn; const int T = t + NUZ8; u.pn = T < 3 ? T : T + 3; return true; }
        const long j = (long)i * so.G + so.c - so.nwg; if (j < 0 || j >= nkv) return false;
        u.pm = 256 + (int)(j >> 2); u.pn = 35 + (int)(j & 3); return true;
    }
    __device__ __forceinline__ void a_ready(const Unit&) const {}
    __device__ __forceinline__ void done(const Unit&) const {}
};
struct OrderG8 {
    StaticOrder so; int pm0, bal;
    __device__ void init(int hb, int G, int c) { so.init(HB_ROWS, (29 + NUZ8) * BM, G, c); pm0 = hb * (HB_ROWS / BM); bal = (hb == 0 && G == 256) ? 1 : 0; }
    __device__ bool next(int i, Unit& u) const {
        bool ok;
        if (!bal) ok = so.next(i, u);
        else { constexpr int R = (29 + NUZ8) / 2; if (i < R) ok = so.next(i, u); else { if (so.c < 128 || i > R) return false; StaticOrder t = so; t.c = so.c - 128; ok = t.next(R, u); } }
        if (ok) u.pm += pm0; return ok;
    }
    __device__ __forceinline__ void a_ready(const Unit&) const {}
    __device__ __forceinline__ void done(const Unit&) const {}
};
template <int MODE8 = 0> struct EpiProj8T {
    static constexpr bool PERM = true, AFTER_DRAIN = false, KHOOK = false;
    EpiProjT<MODE8> base; const float* RS; const float* CS; PG8_LAS unsigned char* sl;
    __device__ __forceinline__ void gate8_body(const f32x4 (&acc)[2][2][4][2], const __amdgpu_buffer_rsrc_t rsrc, int trow, int t8, int wr, int wc, int fr, int fq, const PG8_LAS float* bias) const {
        constexpr float L2E = 1.4426950408889634f, C = 254.0f / 255.0f;
        f32x2 cb[2][2][2];
#pragma unroll
        for (int bj = 0; bj < 2; ++bj)
#pragma unroll
            for (int n = 0; n < 2; ++n) { const f32x4 b = *(const PG8_LAS f32x4*)(bias + 8 * bj + 4 * n); cb[bj][n][0] = (f32x2){b[0], b[1]} * L2E; cb[bj][n][1] = (f32x2){b[2], b[3]} * L2E; }
#pragma unroll
        for (int ai = 0; ai < 2; ++ai)
#pragma unroll
            for (int m = 0; m < 4; ++m) { const int row = trow + gate_srow(wr, 2 * (wc & 1) + (fq >> 1), ai, m, wc >> 1, 2 * (fq & 1)); u32x4 w;
#pragma unroll
                for (int bj = 0; bj < 2; ++bj)
#pragma unroll
                    for (int n = 0; n < 2; ++n) { const f32x4 v = acc[ai][bj][m][n]; unsigned p[2];
#pragma unroll
                        for (int h = 0; h < 2; ++h) { const f32x2 x = {v[2 * h], v[2 * h + 1]}; const f32x2 e = x * L2E + cb[bj][n][h];
                            f32x2 ex; ex.x = ex2(e.x); ex.y = ex2(e.y); const f32x2 den = ex * C + C;
                            f32x2 sc; sc.x = __builtin_amdgcn_fmed3f(__builtin_amdgcn_rcpf(den.x), 0.0f, 1.0f); sc.y = __builtin_amdgcn_fmed3f(__builtin_amdgcn_rcpf(den.y), 0.0f, 1.0f);
                            const f32x2 q = sc * (-254.0f) + 8388863.0f;
                            const float qx = q.x, qy = q.y;
                            p[h] = __builtin_amdgcn_perm(__builtin_bit_cast(unsigned, qy), __builtin_bit_cast(unsigned, qx), 0x0c0c0400u); }
                        w[2 * bj + n] = __builtin_amdgcn_perm(p[1], p[0], 0x05040100u); }
                if (MODE8 == 2) asm volatile("" :: "v"(w)); else __builtin_amdgcn_raw_buffer_store_b128(w, rsrc, (int)((unsigned)row * (unsigned)PA_ROWB + (unsigned)(PA_GOFF + t8 * BM + 16 * fr)), 0, G1_STORE_AUX); }
    }
    __device__ __forceinline__ void stage_scales(const Unit& u, int par, int wid, int lane) const {
        PG8_LAS unsigned char* d = sl + par * 3072;
        if (wid < 4) { __builtin_amdgcn_global_load_lds((const unsigned*)(CS + u.pn * BM + 64 * wid + lane), (PG8_LAS unsigned*)(d + 256 * wid), 4, 0, 0);
            if (u.pn < 12) __builtin_amdgcn_global_load_lds((const unsigned*)(base.gate_b + u.pn * BM + 64 * wid + lane), (PG8_LAS unsigned*)(d + 2048 + 256 * wid), 4, 0, 0); }
        else __builtin_amdgcn_global_load_lds((const unsigned*)(RS + u.pm * BM + 64 * (wid - 4) + lane), (PG8_LAS unsigned*)(d + 1024 + 256 * (wid - 4)), 4, 0, 0);
    }
    __device__ __forceinline__ void epi8(f32x4 (&acc)[2][2][4][2], const Unit& u, int par, int wr, int wc, int fr, int fq) const {
        const PG8_LAS float* d = (const PG8_LAS float*)(sl + par * 3072); const bool gate = u.pn < 12;
        const PG8_LAS float* cp = d + (gate ? 64 * wc + 16 * fq : 32 * wc + 8 * fq);
        f32x4 cs[2][2]; float rs[2][4];
#pragma unroll
        for (int bj = 0; bj < 2; ++bj)
#pragma unroll
            for (int n = 0; n < 2; ++n) cs[bj][n] = *(const PG8_LAS f32x4*)(cp + (gate ? 8 * bj : HALF * bj) + 4 * n);
#pragma unroll
        for (int ai = 0; ai < 2; ++ai)
#pragma unroll
            for (int m = 0; m < 4; ++m) rs[ai][m] = d[256 + wr * 64 + fr + ai * HALF + m * 16];
#pragma unroll
        for (int ai = 0; ai < 2; ++ai)
#pragma unroll
            for (int m = 0; m < 4; ++m)
#pragma unroll
                for (int bj = 0; bj < 2; ++bj)
#pragma unroll
                    for (int n = 0; n < 2; ++n) acc[ai][bj][m][n] *= cs[bj][n] * rs[ai][m];
        if (gate) {
            const __amdgpu_buffer_rsrc_t rsrc = __builtin_amdgcn_make_buffer_rsrc(base.PA, 0, (int)((size_t)HB_ROWS * PA_ROWB), 0x00020000);
            gate8_body(acc, rsrc, (u.pm - base.pm0) * BM, u.pn, wr, wc, fr, fq, d + 512 + 64 * wc + 16 * fq); return; }
        Unit v = u; v.pn = i8tile_pn(u.pn); base(acc, v, wr, wc, fr, fq);
    }
    __device__ __forceinline__ void operator()(const f32x4 (&acc)[2][2][4][2], const Unit& u, int wr, int wc, int fr, int fq) const {}
};
typedef EpiProj8T<0> EpiProj8;
}

#define GAS __attribute__((address_space(1)))
#define LAS __attribute__((address_space(3)))
typedef unsigned short bf16;
typedef unsigned v4u __attribute__((ext_vector_type(4)));
typedef float f32x4 __attribute__((ext_vector_type(4)));
typedef short bf16x8 __attribute__((ext_vector_type(8)));
typedef GAS unsigned gu32;
typedef GAS unsigned long long gu64;
#define RLX_AGENT __ATOMIC_RELAXED, __HIP_MEMORY_SCOPE_AGENT
#define LDS_WAIT() asm volatile("s_waitcnt lgkmcnt(0)" ::: "memory")
#define VM_WAIT() asm volatile("s_waitcnt vmcnt(0)" ::: "memory")
__device__ __forceinline__ unsigned long long rt() { return __builtin_amdgcn_s_memrealtime(); }
__device__ __forceinline__ unsigned f2bf(float f) { unsigned u = __builtin_bit_cast(unsigned, f); return (u + 0x7fffu + ((u >> 16) & 1u)) >> 16; }
__device__ __forceinline__ unsigned pk2(float lo, float hi) { return f2bf(lo) | (f2bf(hi) << 16); }

__device__ __forceinline__ int hw_lane() { int l; asm volatile("v_mbcnt_lo_u32_b32 %0, -1, 0\n\tv_mbcnt_hi_u32_b32 %0, -1, %0" : "=v"(l)); return l; }
__device__ __forceinline__ bool hw_thread0(int wave) { return wave == 0 && hw_lane() == 0; }
#define XB_TMO      128
#define XB_XCNT(j)  (256  + 64 * (j))
#define XB_XSUB(j)  (1280 + 64 * (j))
#define XB_XGEN(j)  (2304 + 64 * (j))
#define XB_TOP      3328
#define XB_TOPGEN   3392
#define XCD_BAR_WORDS 3456
#define XB_SPIN_CAP (1u << 18)

__device__ __forceinline__ unsigned xb_ld(unsigned* p)              { return __hip_atomic_load(p, __ATOMIC_RELAXED, __HIP_MEMORY_SCOPE_AGENT); }
__device__ __forceinline__ unsigned xb_add(unsigned* p, unsigned v) { return __hip_atomic_fetch_add(p, v, __ATOMIC_RELAXED, __HIP_MEMORY_SCOPE_AGENT); }
__device__ __forceinline__ unsigned xb_xcc_id() { return (unsigned)__builtin_amdgcn_s_getreg((3 << 11) | 20) & 0xFu; }
#define XB_SPIN(cond, bar) do { unsigned _sp = 0; while (cond) { __builtin_amdgcn_s_sleep(1); \
    if ((++_sp & 255u) == 0u) { if (xb_ld(&(bar)[XB_TMO])) break; if (_sp > XB_SPIN_CAP) { atomicAdd(&(bar)[XB_TMO], 1u); break; } } } } while (0)

struct XcdBarrier {
    unsigned* bar; unsigned x; int wave;
    volatile LAS unsigned* st;
};

__device__ __forceinline__ XcdBarrier xcd_barrier_post(unsigned* bar, volatile LAS unsigned* st, int wave) {
    XcdBarrier b; b.bar = bar; b.x = xb_xcc_id(); b.st = st; b.wave = wave;
    if (hw_thread0(wave)) (void)xb_add(&bar[XB_XCNT(b.x)], 1u);
    return b;
}
__device__ __forceinline__ void xcd_barrier_complete(unsigned* bar, unsigned x, unsigned& nloc, unsigned& nx) {
    const unsigned G = gridDim.x * gridDim.y * gridDim.z;
    unsigned sum, cnt, mine, sp = 0u;
    for (;;) {
        sum = 0u; cnt = 0u; mine = 0u;
#pragma unroll
        for (unsigned j = 0; j < 16; ++j) { const unsigned c = xb_ld(&bar[XB_XCNT(j)]); sum += c; cnt += (c > 0u) ? 1u : 0u; mine = (j == x) ? c : mine; }
        if (sum == G) break;
        __builtin_amdgcn_s_sleep(1);
        if ((++sp & 255u) == 0u) { if (xb_ld(&bar[XB_TMO])) break; if (sp > XB_SPIN_CAP) { atomicAdd(&bar[XB_TMO], 1u); break; } }
    }
    nloc = mine > 0u ? mine : 1u; nx = cnt > 0u ? cnt : 1u;
}

__device__ __forceinline__ void xcd_barrier(const XcdBarrier& b) {
    asm volatile("s_waitcnt vmcnt(0)" ::: "memory");
    __syncthreads();
    if (hw_thread0(b.wave)) {
        unsigned* bar = b.bar;
        __builtin_amdgcn_s_waitcnt(0);
        unsigned nloc = b.st[0], nx = b.st[1];
        if (nloc == 0u) { xcd_barrier_complete(bar, b.x, nloc, nx); b.st[0] = nloc; b.st[1] = nx; }
        const unsigned old = xb_add(&bar[XB_XSUB(b.x)], 1u);
        const unsigned gen = old / nloc;
        if (old + 1u == (gen + 1u) * nloc) {
            __builtin_amdgcn_fence(__ATOMIC_RELEASE, "agent");
            asm volatile("s_waitcnt vmcnt(0)" ::: "memory");
            const unsigned og = xb_add(&bar[XB_TOP], 1u);
            const unsigned tg = og / nx;
            if (og + 1u == (tg + 1u) * nx) xb_add(&bar[XB_TOPGEN], 1u);
            else XB_SPIN(xb_ld(&bar[XB_TOPGEN]) == tg, bar);
            __builtin_amdgcn_fence(__ATOMIC_ACQUIRE, "agent");
            xb_add(&bar[XB_XGEN(b.x)], 1u);
            asm volatile("s_waitcnt vmcnt(0)" ::: "memory");
        } else {
            XB_SPIN(xb_ld(&bar[XB_XGEN(b.x)]) == gen, bar);
            __builtin_amdgcn_fence(__ATOMIC_ACQUIRE, "agent");
            asm volatile("s_waitcnt vmcnt(0)" ::: "memory");
        }
    }
    __syncthreads();
}

__device__ __forceinline__ float wave_sum(float v) {
#pragma unroll
    for (int o = 1; o < 64; o <<= 1) v += __shfl_xor(v, o);
    return v;
}

constexpr int RING_OFF = 0, RING_BYTES = 131072;
constexpr int LDSCTL_OFF = RING_BYTES, MISC_OFF = LDSCTL_OFF + 320;
constexpr int SCALE_OFF = RING_BYTES + 8192;
constexpr int LDS_BYTES = 147456;
constexpr int NWAVES = 8, NTHR = NWAVES * 64;
constexpr int WSCR_OFF = 132096;

__device__ __forceinline__ float bf2f(bf16 h) { return __builtin_bit_cast(float, (unsigned)h << 16); }
__device__ __forceinline__ float sigm_f(float x) { return 1.f / (1.f + __expf(-x)); }
__device__ __forceinline__ int t5_bucket(int d) {
    if (d < 16) return d;
    int b = 16;
    b += d >= 22; b += d >= 30; b += d >= 40; b += d >= 54; b += d >= 73; b += d >= 99; b += d >= 134; b += d >= 182; b += d >= 246; b += d >= 332; b += d >= 450; b += d >= 609; b += d >= 825; b += d >= 1117; b += d >= 1513;
    return b;
}

struct Ctx {
    const float *x, *mem, *norm_w, *w_in, *gate_b, *lnw, *lnb, *sp_w, *sp_b, *bqw, *bkw, *rel_bias, *mem_norm_w, *m_w_kv, *mqw, *mkw, *proj_a, *proj_b, *proj_m, *w_out;
    float* out;
    bf16 *WIN, *PCAT, *WOUT, *WSP, *XN, *PA, *KVM, *OG, *YC, *MRG; float *BIAS, *BIASX, *SS, *MKSS, *LSE, *LNST, *CS, *RS; unsigned char *XN8, *W8; unsigned* cmax;
    LAS unsigned char* lds; int tid, lane, wave, G, gtid, T, gwave, NW, xgwave;
};

__device__ __forceinline__ void p0_transpose_item(const float* W, int N, bf16* WT, int ldt, int row_off, int koff, LAS float* scr, int item, int lane_unused, bool gperm = false, unsigned* cmax = nullptr) {
    const int lane = hw_lane();
    const int nblk = N / 32, kb = item / nblk, nb = item % nblk, k0 = 64 * kb, n0 = 32 * nb;
    float cam = 0.f;
#pragma unroll 8
    for (int i = 0; i < 32; ++i) { const int kk = 2 * i + (lane >> 5); const float wv = W[(size_t)(k0 + kk) * N + n0 + (lane & 31)]; scr[kk * 33 + (lane & 31)] = wv; cam = fmaxf(cam, fabsf(wv)); }
    if (cmax && i8col(n0) >= 0) { cam = fmaxf(cam, __shfl_xor(cam, 32)); if (lane < 32) atomicMax(cmax + i8col(n0) + lane, __float_as_uint(cam)); }
    LDS_WAIT(); asm volatile("" ::: "memory");
    const int c = lane & 7;
#pragma unroll
    for (int j = 0; j < 4; ++j) { const int n = (lane >> 3) + 8 * j; const LAS float* s = scr + (8 * c) * 33 + n;
        v4u o; o.x = pk2(s[0 * 33], s[1 * 33]); o.y = pk2(s[2 * 33], s[3 * 33]); o.z = pk2(s[4 * 33], s[5 * 33]); o.w = pk2(s[6 * 33], s[7 * 33]);
        int nn = n0 + n;
        if (gperm) {
            if (nn >= C_G) nn = (nn & ~255) + 128 * ((nn >> 3) & 1) + 32 * ((nn >> 6) & 3) + 8 * ((nn >> 4) & 3) + (nn & 7);
            else if (nn < C_AV) { const int T = nn >> 7; nn = 256 * (T < 3 ? T : T + 3) + (nn & 127); }
            else if (nn >= C_AZ && nn < C_BQ) { const int c = nn - C_AZ, T = c >> 7; nn = 256 * (T < 3 ? T : T + 3) + 128 + (c & 127); }
        }
        *(GAS v4u*)(WT + (size_t)(row_off + nn) * ldt + koff + k0 + 8 * c) = o; }
    LDS_WAIT(); asm volatile("" ::: "memory");
}
template <int NR> __device__ __forceinline__ void rms_rows_to_bf16(const float* src, const float* w, bf16* dst, size_t m0, size_t stride, int lane, unsigned char* q8 = nullptr, float* rsc = nullptr) {
    f32x4 v[NR][4]; float s[NR];
#pragma unroll
    for (int r = 0; r < NR; ++r) { const GAS f32x4* xr = (const GAS f32x4*)(src + (m0 + r * stride) * DM) + lane;
#pragma unroll
        for (int j = 0; j < 4; ++j) v[r][j] = __builtin_nontemporal_load(xr + 64 * j); }
    f32x4 ww[4];
#pragma unroll
    for (int j = 0; j < 4; ++j) ww[j] = ((const GAS f32x4*)w + lane)[64 * j];
#pragma unroll
    for (int r = 0; r < NR; ++r) { float a = 0.f;
#pragma unroll
        for (int j = 0; j < 4; ++j) a += (v[r][j].x * v[r][j].x + v[r][j].y * v[r][j].y) + (v[r][j].z * v[r][j].z + v[r][j].w * v[r][j].w);
        s[r] = rsqrtf(wave_sum(a) * (1.f / DM) + EPS); }
#pragma unroll
    for (int r = 0; r < NR; ++r) { GAS unsigned long long* o8 = (GAS unsigned long long*)(dst + (m0 + r * stride) * DM) + lane;
#pragma unroll
        for (int j = 0; j < 4; ++j) { v[r][j] = v[r][j] * s[r] * ww[j]; o8[64 * j] = (unsigned long long)pk2(v[r][j].x, v[r][j].y) | ((unsigned long long)pk2(v[r][j].z, v[r][j].w) << 32); } }
    if (q8) {
#pragma unroll
        for (int r = 0; r < NR; ++r) { float am = 0.f;
#pragma unroll
            for (int j = 0; j < 4; ++j) am = fmaxf(am, fmaxf(fmaxf(fabsf(v[r][j].x), fabsf(v[r][j].y)), fmaxf(fabsf(v[r][j].z), fabsf(v[r][j].w))));
#pragma unroll
            for (int o = 1; o < 64; o <<= 1) am = fmaxf(am, __shfl_xor(am, o));
            am = fmaxf(am, 1e-20f); const float inv = 127.0f / am;
            GAS unsigned* qo = (GAS unsigned*)(q8 + (m0 + r * stride) * P8) + lane;
#pragma unroll
            for (int j = 0; j < 4; ++j) { const int a0 = (int)rintf(v[r][j].x * inv), a1 = (int)rintf(v[r][j].y * inv), a2 = (int)rintf(v[r][j].z * inv), a3 = (int)rintf(v[r][j].w * inv);
                qo[64 * j] = (unsigned)(a0 & 0xff) | ((unsigned)(a1 & 0xff) << 8) | ((unsigned)(a2 & 0xff) << 16) | ((unsigned)(a3 & 0xff) << 24); }
            if (lane == 0) rsc[m0 + r * stride] = am * (1.0f / 127.0f); } }
}
__device__ __forceinline__ void p0_quant_tile(const float* W, unsigned char* W8, float* CS, const unsigned* cmax, LAS float* scr, int item) {
    const int lane = hw_lane();
    const int kb = item / (N8 / 32), nb = item % (N8 / 32), k0 = 64 * kb, c0 = 32 * nb, n0 = i8src(c0);
    const float am = fmaxf(__uint_as_float(cmax[c0 + (lane & 31)]), 1e-30f), inv = 127.0f / am;
    if (kb == 0 && lane < 32) CS[c0 + lane] = am * (1.0f / 127.0f);
#pragma unroll 8
    for (int i = 0; i < 32; ++i) { const int kk = 2 * i + (lane >> 5); scr[kk * 33 + (lane & 31)] = rintf(W[(size_t)(k0 + kk) * NIN + n0 + (lane & 31)] * inv); }
    LDS_WAIT(); asm volatile("" ::: "memory");
    const int c = lane & 3;
#pragma unroll
    for (int j = 0; j < 2; ++j) { const int n = (lane >> 2) + 16 * j; const LAS float* sp = scr + (16 * c) * 33 + n; v4u o;
#define Q4(B) ((unsigned)((int)sp[((B) + 0) * 33] & 0xff) | ((unsigned)((int)sp[((B) + 1) * 33] & 0xff) << 8) | ((unsigned)((int)sp[((B) + 2) * 33] & 0xff) << 16) | ((unsigned)((int)sp[((B) + 3) * 33] & 0xff) << 24))
        o.x = Q4(0); o.y = Q4(4); o.z = Q4(8); o.w = Q4(12);
#undef Q4
        int nn = c0 + n; if (nn < 3072) nn = (nn & ~255) + 128 * ((nn >> 3) & 1) + 32 * ((nn >> 6) & 3) + 8 * ((nn >> 4) & 3) + (nn & 7);
        *(GAS v4u*)(W8 + (size_t)nn * P8 + k0 + 16 * c) = o; }
    LDS_WAIT(); asm volatile("" ::: "memory");
}
__device__ __forceinline__ void p0_quant_weights(Ctx& F, const unsigned* cmax) {
    LAS float* scr = (LAS float*)(F.lds + RING_OFF + F.wave * 16384);
    for (int it = F.gwave; it < 16 * (N8 / 32); it += F.NW) p0_quant_tile(F.w_in, F.W8, F.CS, cmax, scr, it);
}
__device__ __forceinline__ void p0_int8_block(Ctx& F, int nb) {
    const int lane = hw_lane(), col = lane & 31;
    LAS float* scr = (LAS float*)(F.lds + RING_OFF + F.wave * 16384);
    LAS float* wmax = (LAS float*)(F.lds + WSCR_OFF + 8192);
    const int c0 = 32 * nb, n0 = i8src(c0);
    float wv[2][32]; float cam = 0.f;
#pragma unroll
    for (int b = 0; b < 2; ++b) { const int k0 = 64 * (2 * F.wave + b);
#pragma unroll
        for (int i = 0; i < 32; ++i) { const int kk = 2 * i + (lane >> 5); wv[b][i] = F.w_in[(size_t)(k0 + kk) * NIN + n0 + col]; } }
#pragma unroll
    for (int b = 0; b < 2; ++b)
#pragma unroll
        for (int i = 0; i < 32; ++i) cam = fmaxf(cam, fabsf(wv[b][i]));
    cam = max_x32(cam);
    if (lane < 32) wmax[F.wave * 32 + lane] = cam;
    __syncthreads();
    float am = 1e-30f;
#pragma unroll
    for (int w = 0; w < 8; ++w) am = fmaxf(am, wmax[w * 32 + col]);
    const float inv = 127.0f / am;
    if (F.wave == 0 && lane < 32) F.CS[c0 + lane] = am * (1.0f / 127.0f);
#pragma unroll 1
    for (int b = 0; b < 2; ++b) { const int k0 = 64 * (2 * F.wave + b);
#pragma unroll
        for (int i = 0; i < 32; ++i) { const int kk = 2 * i + (lane >> 5); scr[kk * 33 + col] = rintf((b == 0 ? wv[0][i] : wv[1][i]) * inv); }
        LDS_WAIT(); asm volatile("" ::: "memory");
        const int c = lane & 3;
#pragma unroll
        for (int j = 0; j < 2; ++j) { const int n = (lane >> 2) + 16 * j; const LAS float* sp = scr + (16 * c) * 33 + n; v4u o;
#define Q4(B) ((unsigned)((int)sp[((B) + 0) * 33] & 0xff) | ((unsigned)((int)sp[((B) + 1) * 33] & 0xff) << 8) | ((unsigned)((int)sp[((B) + 2) * 33] & 0xff) << 16) | ((unsigned)((int)sp[((B) + 3) * 33] & 0xff) << 24))
            o.x = Q4(0); o.y = Q4(4); o.z = Q4(8); o.w = Q4(12);
#undef Q4
            int nn = c0 + n; if (nn < 3072) nn = (nn & ~255) + 128 * ((nn >> 3) & 1) + 32 * ((nn >> 6) & 3) + 8 * ((nn >> 4) & 3) + (nn & 7);
            *(GAS v4u*)(F.W8 + (size_t)nn * P8 + k0 + 16 * c) = o; }
        LDS_WAIT(); asm volatile("" ::: "memory"); }
    __syncthreads();
}
__device__ __forceinline__ void p0_prologue(Ctx& F) {
    LAS float* scr = (LAS float*)(F.lds + RING_OFF + F.wave * 16384);
    constexpr int I_IN = 16 * (NIN / 32), I_KV = 16 * 32, I_PA = 12 * 32, I_PB = 4 * 32, I_PM = 8 * 32, I_WO = 16 * 32;
    constexpr int NITEMS = I_IN + I_KV + I_PA + I_PB + I_PM + I_WO;
    for (int nb = (int)blockIdx.x; nb < N8 / 32; nb += F.G) p0_int8_block(F, nb);
    for (int it = F.gwave; it < NITEMS; it += F.NW) {
        int r = it;
        if (r < I_IN) { if (i8col(32 * (r % (NIN / 32))) < 0) p0_transpose_item(F.w_in, NIN, F.WIN, DM, 0, 0, scr, r, F.lane, true, nullptr); continue; } r -= I_IN;
        if (r < I_KV) { p0_transpose_item(F.m_w_kv, 1024, F.WIN, DM, NIN, 0, scr, r, F.lane); continue; } r -= I_KV;
        if (r < I_PA) { p0_transpose_item(F.proj_a, DM, F.PCAT, KC, 0, 0, scr, r, F.lane); continue; } r -= I_PA;
        if (r < I_PB) { p0_transpose_item(F.proj_b, DM, F.PCAT, KC, 0, 768, scr, r, F.lane); continue; } r -= I_PB;
        if (r < I_PM) { p0_transpose_item(F.proj_m, DM, F.PCAT, KC, 0, 1024, scr, r, F.lane); continue; } r -= I_PM;
        p0_transpose_item(F.w_out, DM, F.WOUT, DM, 0, 0, scr, r, F.lane);
    }
    for (int i = F.gtid; i < 4 * 128 * 128; i += F.T) { const int t = (i >> 7) & 127, s = i & 127; F.WSP[i] = (bf16)(s <= t ? f2bf(F.sp_w[i]) : 0u); }
    for (int i = F.gtid; i < 3 * 4 * 132; i += F.T) { const int g = i / (4 * 132), h = (i / 132) % 4, j = i % 132; const int dil = g == 0 ? 1 : (g == 1 ? 4 : 16);
        F.BIAS[i] = j <= 128 ? F.rel_bias[t5_bucket(j * dil) * 12 + 4 * g + h] : 0.f; }
    for (int i = F.gtid; i < 3 * 4 * 192; i += F.T) { const int g = i / (4 * 192), h = (i / 192) % 4, step = i % 192 - 31; const int dil = g == 0 ? 1 : (g == 1 ? 4 : 16);
        F.BIASX[i] = (step >= 0 && step <= 128) ? F.rel_bias[t5_bucket(step * dil) * 12 + 4 * g + h] * 1.4426950408889634f : -1e30f; }
    if ((MTOT % (4 * F.NW)) == 0 && (MMEM % (4 * F.NW)) == 0) {
        for (size_t m = F.gwave; m < (size_t)MTOT; m += 4 * (size_t)F.NW) rms_rows_to_bf16<4>(F.x, F.norm_w, F.XN, m, F.NW, F.lane, F.XN8, F.RS);
        for (size_t m = F.gwave; m < (size_t)MMEM; m += 4 * (size_t)F.NW) rms_rows_to_bf16<4>(F.mem, F.mem_norm_w, F.XN + (size_t)MTOT * DM, m, F.NW, F.lane);
    } else {
        for (size_t m = F.gwave; m < (size_t)MTOT; m += F.NW) rms_rows_to_bf16<1>(F.x, F.norm_w, F.XN, m, 0, F.lane, F.XN8, F.RS);
        for (size_t m = F.gwave; m < (size_t)MMEM; m += F.NW) rms_rows_to_bf16<1>(F.mem, F.mem_norm_w, F.XN + (size_t)MTOT * DM, m, 0, F.lane);
    }
}


typedef float f32x16 __attribute__((ext_vector_type(16)));
typedef short s16x4 __attribute__((ext_vector_type(4)));
__device__ __forceinline__ int crow(int r, int hi) { return (r & 3) + 8 * (r >> 2) + 4 * hi; }
__device__ __forceinline__ unsigned cvtpk(float lo, float hi) { return pg8::cvt_pk_bf16(lo, hi); }
__device__ __forceinline__ v4u swap32x2(v4u w) { const auto r0 = __builtin_amdgcn_permlane32_swap(w.x, w.z, false, false), r1 = __builtin_amdgcn_permlane32_swap(w.y, w.w, false, false); return (v4u){r0[0], r1[0], r0[1], r1[1]}; }
__device__ __forceinline__ s16x4 vtr(const LAS unsigned char* p) { typedef short v4i16_t __attribute__((ext_vector_type(4))); return __builtin_bit_cast(s16x4, __builtin_amdgcn_ds_read_tr16_b64_v4i16((LAS v4i16_t*)p)); }
__device__ __forceinline__ float bflo(unsigned w) { return __uint_as_float(w << 16); }
__device__ __forceinline__ float bfhi(unsigned w) { return __uint_as_float(w & 0xffff0000u); }
constexpr float LOG2E = 1.4426950408889634f, LN2 = 0.6931471805599453f;
constexpr float SM_THR = 5.0f;
constexpr int NBX = 192;


__device__ __forceinline__ void dma16(const void* gsrc, LAS unsigned char* ldst) { __builtin_amdgcn_global_load_lds((const unsigned*)gsrc, (LAS unsigned*)ldst, 16, 0, 0); }
#define VM_WAIT0() asm volatile("s_waitcnt vmcnt(0)" ::: "memory")
__device__ __forceinline__ void st_mixA_mfma(Ctx& F) {
    const int lane = hw_lane(), r32 = lane & 31, hi = lane >> 5, tid = F.wave * 64 + lane;
    LAS unsigned char* wl = F.lds + RING_OFF + F.wave * 16384;
    typedef float f32x2v __attribute__((ext_vector_type(2))); typedef unsigned u32x2v __attribute__((ext_vector_type(2)));
    LAS f32x2v* tab = (LAS f32x2v*)(F.lds + WSCR_OFF + 8192);
    const int g = F.wave >> 1, ch = lane & 3;
    bf16x8 wf[14];
    const bf16* wrow0 = F.WSP + (size_t)(g * 128 + r32) * 128 + 8 * hi;
    { int n = 0;
#pragma unroll
      for (int tb = 2; tb < 4; ++tb)
#pragma unroll
          for (int ks = 0; ks < 2 * (tb + 1); ++ks) wf[n++] = *(const bf16x8*)(wrow0 + (size_t)tb * 32 * 128 + 16 * ks); }
    for (int unit = blockIdx.x; unit < HB_ROWS / 128; unit += F.G) {
        const int rowbase = unit * 128;
        v4u raw[8];
        { const int c0 = g * 192 + (F.wave & 1) * 96;
#pragma unroll
          for (int i = 0; i < 8; ++i) raw[i] = *(const v4u*)(F.PA + (size_t)(rowbase + (lane >> 2) + 16 * i) * PAP + C_AV + c0 + 8 * ch); }
        { const int row = tid >> 2, part = tid & 3; const float* sp = F.SS + (size_t)(rowbase + row) * SS_W + 12 * part; float s = 0.f, q = 0.f;
#pragma unroll
          for (int k = 0; k < 6; ++k) { s += sp[2 * k]; q += sp[2 * k + 1]; }
          s = sum_quad(s); q = sum_quad(q);
          const float mu = s * (1.f / 768.f), var = q * (1.f / 768.f) - mu * mu;
          if (part == 0) tab[row] = (f32x2v){mu, rsqrtf(fmaxf(var, 0.f) + EPS)}; }
        float sbv[4];
#pragma unroll
        for (int tb = 0; tb < 4; ++tb) sbv[tb] = F.sp_b[g * 128 + 32 * tb + r32];
        __syncthreads();
#pragma unroll 1
        for (int cbi = 0; cbi < 3; ++cbi) {
            const int c0 = g * 192 + ((F.wave & 1) * 3 + cbi) * 32;
            const f32x4 w0 = *(const f32x4*)(F.lnw + c0 + 8 * ch), w1 = *(const f32x4*)(F.lnw + c0 + 8 * ch + 4), b0 = *(const f32x4*)(F.lnb + c0 + 8 * ch), b1 = *(const f32x4*)(F.lnb + c0 + 8 * ch + 4);
#pragma unroll
            for (int i = 0; i < 8; ++i) { const int s = (lane >> 2) + 16 * i; const f32x2v st = tab[s]; const v4u rw = raw[i]; v4u o;
                o.x = cvtpk((bflo(rw.x) - st.x) * st.y * w0.x + b0.x, (bfhi(rw.x) - st.x) * st.y * w0.y + b0.y); o.y = cvtpk((bflo(rw.y) - st.x) * st.y * w0.z + b0.z, (bfhi(rw.y) - st.x) * st.y * w0.w + b0.w);
                o.z = cvtpk((bflo(rw.z) - st.x) * st.y * w1.x + b1.x, (bfhi(rw.z) - st.x) * st.y * w1.y + b1.y); o.w = cvtpk((bflo(rw.w) - st.x) * st.y * w1.z + b1.z, (bfhi(rw.w) - st.x) * st.y * w1.w + b1.w);
                *(LAS v4u*)(wl + (s >> 3) * 512 + (s & 7) * 64 + ch * 16) = o; }
            if (cbi < 2) {
#pragma unroll
                for (int i = 0; i < 8; ++i) raw[i] = *(const v4u*)(F.PA + (size_t)(rowbase + (lane >> 2) + 16 * i) * PAP + C_AV + c0 + 32 + 8 * ch); }
            LAS unsigned char* uzb = wl + 8192;
#pragma unroll
            for (int p = 0; p < 8; ++p) { const int row_ = 16 * p + (lane >> 2);
                dma16(F.PA + (size_t)(rowbase + row_) * PAP + C_AU + c0 + 8 * ((lane & 3) ^ ((row_ >> 2) & 3)), uzb + p * 1024); }
            const LAS unsigned char* vb = wl + hi * 512 + ((lane & 15) >> 2) * 64 + ((lane >> 4) & 1) * 32 + (lane & 3) * 8;
            const bf16* wr2 = wrow0; asm volatile("" : "+v"(wr2));
            bf16x8 wq[6];
            { int n2 = 0;
#pragma unroll
              for (int tb = 0; tb < 2; ++tb)
#pragma unroll
                  for (int ks = 0; ks < 2 * (tb + 1); ++ks) wq[n2++] = *(const bf16x8*)(wr2 + (size_t)tb * 32 * 128 + 16 * ks); }
            int n = 0, nq = 0;
#pragma unroll
            for (int tb = 0; tb < 4; ++tb) { f32x16 acc = {};
#pragma unroll
                for (int ks = 0; ks < 2 * (tb + 1); ++ks) { const s16x4 a = vtr(vb + ks * 1024), c = vtr(vb + ks * 1024 + 256); const bf16x8 af = {a[0], a[1], a[2], a[3], c[0], c[1], c[2], c[3]};
                    acc = __builtin_amdgcn_mfma_f32_32x32x16_bf16(af, tb < 2 ? wq[nq++] : wf[n++], acc, 0, 0, 0); }
                const int t = 32 * tb + r32; const float sb = sbv[tb];
                if (tb == 0) VM_WAIT0();
                LAS unsigned char* urow = uzb + t * 64 + 8 * hi; const int fsw = (r32 >> 2) & 3;
#pragma unroll
                for (int i = 0; i < 4; ++i) { LAS u32x2v* up = (LAS u32x2v*)(urow + ((i ^ fsw) * 16)); const u32x2v u = *up; u32x2v w;
                    w.x = cvtpk(bflo(u.x) * (acc[4 * i] + sb), bfhi(u.x) * (acc[4 * i + 1] + sb)); w.y = cvtpk(bflo(u.y) * (acc[4 * i + 2] + sb), bfhi(u.y) * (acc[4 * i + 3] + sb));
                    *up = w; }
#pragma unroll
                for (int jr = 0; jr < 2; ++jr) { const int row_ = 32 * tb + 16 * jr + (lane >> 2); const v4u yv = *(const LAS v4u*)(uzb + row_ * 64 + (lane & 3) * 16);
                    *(v4u*)(F.YC + (size_t)(rowbase + row_) * KC + c0 + 8 * ((lane & 3) ^ ((row_ >> 2) & 3))) = yv; } }
        }
        __syncthreads();
    }
}

__device__ __forceinline__ void st_mergeB_vec(Ctx& F) {
    constexpr int NI = 8;
    const int total = HB_ROWS * 32, gtid0 = (int)blockIdx.x * NTHR + F.wave * 64 + hw_lane();
    for (int g0 = gtid0; g0 < total; g0 += NI * F.T) {
        v4u a[NI], b[NI], c[NI], z[NI]; float l0[NI], l1[NI], l2[NI];
#pragma unroll
        for (int i = 0; i < NI; ++i) { const int gid = g0 + i * F.T < total ? g0 + i * F.T : g0; const int r = gid >> 5, c8 = (gid & 31) * 8, h = c8 >> 6;
            l0[i] = F.LSE[((size_t)0 * HB_ROWS + r) * 4 + h]; l1[i] = F.LSE[((size_t)1 * HB_ROWS + r) * 4 + h]; l2[i] = F.LSE[((size_t)2 * HB_ROWS + r) * 4 + h];
            a[i] = *(const v4u*)(F.OG + ((size_t)0 * HB_ROWS + r) * 256 + c8); b[i] = *(const v4u*)(F.OG + ((size_t)1 * HB_ROWS + r) * 256 + c8); c[i] = *(const v4u*)(F.OG + ((size_t)2 * HB_ROWS + r) * 256 + c8);
            z[i] = *(const v4u*)(F.PA + (size_t)r * PAP + C_BZ + c8); }
        __builtin_amdgcn_sched_barrier(0);
#pragma unroll
        for (int i = 0; i < NI; ++i) { if (g0 + i * F.T >= total) break; const int gid = g0 + i * F.T; const int r = gid >> 5, c8 = (gid & 31) * 8;
            const float mx = fmaxf(l0[i], fmaxf(l1[i], l2[i])); float e0 = __expf(l0[i] - mx), e1 = __expf(l1[i] - mx), e2 = __expf(l2[i] - mx); const float inv = 1.f / (e0 + e1 + e2); e0 *= inv; e1 *= inv; e2 *= inv;
            v4u o;
#define MB_1(X) X = pk2((e0 * bflo(a[i].X) + e1 * bflo(b[i].X) + e2 * bflo(c[i].X)) * bflo(z[i].X), (e0 * bfhi(a[i].X) + e1 * bfhi(b[i].X) + e2 * bfhi(c[i].X)) * bfhi(z[i].X))
            o.MB_1(x); o.MB_1(y); o.MB_1(z); o.MB_1(w);
#undef MB_1
            *(v4u*)(F.YC + (size_t)r * KC + 768 + c8) = o; }
    }
}


__device__ __forceinline__ void st_attnM_v3(Ctx& F, int hb) {
    const int lane = hw_lane(), r32 = lane & 31, hi = lane >> 5;
    LAS unsigned char* kimg = F.lds + RING_OFF; LAS unsigned char* vimg = F.lds + RING_OFF + 65536;
    LAS float* kstab = (LAS float*)(F.lds + WSCR_OFF + 8192);
    typedef unsigned u32x2v __attribute__((ext_vector_type(2)));
    const int vcu = F.xgwave >> 3;
    __syncthreads();
    for (int task = vcu; task < 256; task += F.G) {
        const int bh = task >> 2, b = bh >> 2, h = bh & 3; const size_t kbase = (size_t)(hb * 16 + b) * MEML;
#pragma unroll
        for (int j = 0; j < 8; ++j) { const int p = F.wave * 8 + j, row = 4 * p + (lane >> 4);
            dma16(F.KVM + (kbase + row) * 1024 + h * 128 + 8 * ((lane & 15) ^ (row & 15)), kimg + p * 1024);
            dma16(F.KVM + (kbase + 8 * (p >> 1) + ((lane & 31) >> 2)) * 1024 + 512 + h * 128 + (2 * (p & 1) + (lane >> 5)) * 32 + (lane & 3) * 8, vimg + p * 1024); }
        { const int key = F.wave * 32 + r32; const float* sp = F.MKSS + (kbase + key) * 16 + 4 * h;
          const float ksv = rsqrtf(((sp[0] + sp[1]) + (sp[2] + sp[3])) * (1.f / 128.f) + EPS); if (lane < 32) kstab[key] = ksv; }
        VM_WAIT0(); __syncthreads();
#pragma unroll 1
        for (int qi = 0; qi < 2; ++qi) {
            const int qb = (task & 3) * 16 + F.wave * 2 + qi;
            const size_t qrow = (size_t)(b * SEQ + qb * 32 + r32);
            const float qs = rsqrtf(((F.SS[qrow * SS_W + 96 + 4 * h] + F.SS[qrow * SS_W + 96 + 4 * h + 1]) + (F.SS[qrow * SS_W + 96 + 4 * h + 2] + F.SS[qrow * SS_W + 96 + 4 * h + 3])) * (1.f / 128.f) + EPS) * (0.08838834764831845f * LOG2E);
            bf16x8 qf[8];
#pragma unroll
            for (int d0 = 0; d0 < 8; ++d0) { const int dd = 16 * d0 + 8 * hi;
                const v4u raw = *(const v4u*)(F.PA + qrow * PAP + C_MQ + h * 128 + dd);
                const f32x4 wa = *(const f32x4*)(F.mqw + dd), wb = *(const f32x4*)(F.mqw + dd + 4), ka = *(const f32x4*)(F.mkw + dd), kb = *(const f32x4*)(F.mkw + dd + 4);
                v4u o;
                o.x = cvtpk(bflo(raw.x) * qs * wa.x * ka.x, bfhi(raw.x) * qs * wa.y * ka.y); o.y = cvtpk(bflo(raw.y) * qs * wa.z * ka.z, bfhi(raw.y) * qs * wa.w * ka.w);
                o.z = cvtpk(bflo(raw.z) * qs * wb.x * kb.x, bfhi(raw.z) * qs * wb.y * kb.y); o.w = cvtpk(bflo(raw.w) * qs * wb.z * kb.z, bfhi(raw.w) * qs * wb.w * kb.w);
                qf[d0] = __builtin_bit_cast(bf16x8, o); }
            v4u zq[4][2];
#pragma unroll
            for (int db = 0; db < 4; ++db)
#pragma unroll
                for (int kp = 0; kp < 2; ++kp) zq[db][kp] = *(const v4u*)(F.PA + qrow * PAP + C_MZ + h * 128 + db * 32 + 16 * kp + 8 * hi);
            float mrun = -1e30f, lrun = 0.f; f32x16 o0 = {}, o1 = {}, o2 = {}, o3 = {};
            const LAS unsigned char* kb0 = kimg + r32 * 256; const int ksw = r32 & 15;
            const LAS unsigned char* vb0 = vimg + (4 * hi + ((lane & 15) >> 2)) * 64 + ((lane >> 4) & 1) * 32 + (lane & 3) * 8;
#pragma unroll 2
            for (int t = 0; t < MEML / 32; ++t) {
                f32x16 st = {};
#pragma unroll
                for (int d0 = 0; d0 < 8; ++d0) { const bf16x8 kf = *(const LAS bf16x8*)(kb0 + t * 8192 + (((2 * d0 + hi) ^ ksw) * 16)); st = __builtin_amdgcn_mfma_f32_32x32x16_bf16(kf, qf[d0], st, 0, 0, 0); }
                float tmax = -1e30f;
#pragma unroll
                for (int i = 0; i < 4; ++i) { const f32x4 kk = *(const LAS f32x4*)(kstab + 32 * t + 8 * i + 4 * hi);
#pragma unroll
                    for (int j = 0; j < 4; ++j) { const float s = st[4 * i + j] * kk[j]; st[4 * i + j] = s; tmax = fmaxf(tmax, s); } }
                tmax = max_x32(tmax);
                if (__builtin_amdgcn_ballot_w64(tmax > mrun + SM_THR) != 0ull) {
                    const float mnew = fmaxf(mrun, tmax), alpha = __builtin_amdgcn_exp2f(mrun - mnew); mrun = mnew; lrun *= alpha;
#pragma unroll
                    for (int r = 0; r < 16; ++r) { o0[r] *= alpha; o1[r] *= alpha; o2[r] *= alpha; o3[r] *= alpha; } }
                float psum = 0.f;
#pragma unroll
                for (int r = 0; r < 16; ++r) { st[r] = __builtin_amdgcn_exp2f(st[r] - mrun); psum += st[r]; }
                lrun += psum;
                v4u p0, p1;
                p0.x = cvtpk(st[0], st[1]); p0.y = cvtpk(st[2], st[3]); p0.z = cvtpk(st[4], st[5]); p0.w = cvtpk(st[6], st[7]);
                p1.x = cvtpk(st[8], st[9]); p1.y = cvtpk(st[10], st[11]); p1.z = cvtpk(st[12], st[13]); p1.w = cvtpk(st[14], st[15]);
                const LAS unsigned char* vb = vb0 + t * 8192;
#define AM_PV(OX, DB) do { _Pragma("unroll") for (int s = 0; s < 2; ++s) { const bf16x8 pf = __builtin_bit_cast(bf16x8, s == 0 ? p0 : p1); \
                    const s16x4 a = vtr(vb + (2 * s) * 2048 + (DB) * 512), c = vtr(vb + (2 * s + 1) * 2048 + (DB) * 512); const bf16x8 vf = {a[0], a[1], a[2], a[3], c[0], c[1], c[2], c[3]}; \
                    OX = __builtin_amdgcn_mfma_f32_32x32x16_bf16(vf, pf, OX, 0, 0, 0); } } while (0)
                AM_PV(o0, 0); AM_PV(o1, 1); AM_PV(o2, 2); AM_PV(o3, 3);
#undef AM_PV
            }
            const float ltot = sum_x32(lrun), inv = 1.f / ltot;
            bf16* yrow = F.YC + qrow * KC + 1024 + h * 128 + 8 * hi;
#define AM_ST(OX, DB) do { _Pragma("unroll") for (int kp = 0; kp < 2; ++kp) { const v4u z = swap32x2(zq[DB][kp]);     \
            v4u w; w.x = cvtpk(OX[8 * kp] * inv * bflo(z.x), OX[8 * kp + 1] * inv * bfhi(z.x)); w.y = cvtpk(OX[8 * kp + 2] * inv * bflo(z.y), OX[8 * kp + 3] * inv * bfhi(z.y)); \
            w.z = cvtpk(OX[8 * kp + 4] * inv * bflo(z.z), OX[8 * kp + 5] * inv * bfhi(z.z)); w.w = cvtpk(OX[8 * kp + 6] * inv * bflo(z.w), OX[8 * kp + 7] * inv * bfhi(z.w)); \
            *(v4u*)(yrow + (DB) * 32 + 16 * kp) = swap32x2(w); } } while (0)
            AM_ST(o0, 0); AM_ST(o1, 1); AM_ST(o2, 2); AM_ST(o3, 3);
#undef AM_ST
        }
        __syncthreads();
    }
}

__device__ __forceinline__ void st_attnB_v3(Ctx& F) {
    const int lane = hw_lane(), r32 = lane & 31, hi = lane >> 5, tid = F.wave * 64 + lane;
    LAS unsigned char* kimg = F.lds + RING_OFF; LAS unsigned char* vimg = F.lds + RING_OFF + 49152;
    LAS float* kstab = (LAS float*)(F.lds + RING_OFF + 98304);
    LAS float* btab = (LAS float*)(F.lds + RING_OFF + 98304 + 2048);
    typedef unsigned u32x2v __attribute__((ext_vector_type(2)));
    const int vcu = F.xgwave >> 3;
    __syncthreads();
    const int nit = (3 * 16 * 4 * 4 - vcu + F.G - 1) / F.G, prot = (F.G == 256) ? ((int)blockIdx.x & 7) / 3 : 0;
    for (int it = 0; it < nit; ++it)
#pragma unroll 1
    for (int sub = 0; sub < 2; ++sub) { const int pr = vcu + ((it + prot) % (prot ? 3 : nit ? nit : 1)) * F.G;
        const int unit = 2 * pr + sub;
        const int k = unit & 7, h = (unit >> 3) & 3, b = (unit >> 5) & 15, g = unit >> 9, hh = 4 * g + h;
        const int dil = g == 0 ? 1 : (g == 1 ? 4 : 16);
        const int res0 = g == 0 ? 0 : (g == 1 ? (k >> 1) : 2 * k), j0 = g == 0 ? 8 * k : (g == 1 ? 8 * (k & 1) : 0);
        const int base0 = j0 - 8 * sub - 4, fadd = (g < 2 && sub) ? 12 : 0, nslot = (g < 2 && sub) ? 8 : 12;
#pragma unroll
        for (int i = 0; i < 12; ++i) { const int q = F.wave * 12 + i, s = q >> 3, pc = q & 7, p = pc & 3;
            int res, jt; bool valid;
            if (g < 2) { res = res0; jt = base0 + fadd + s; valid = jt >= 0 && s < nslot; } else { res = res0 + (s >> 2); jt = s & 3; valid = s < 8; }
            if (valid) {
                if (pc < 4) { const int row = 8 * p + (lane >> 3); const size_t trow = (size_t)(b * SEQ + res + (32 * jt + row) * dil);
                    dma16(F.PA + trow * PAP + C_BK + hh * 64 + 8 * ((lane & 7) ^ ((row >> 1) & 7)), kimg + s * 4096 + p * 1024); }
                else { const int key = 8 * p + ((lane & 31) >> 2); const size_t trow = (size_t)(b * SEQ + res + (32 * jt + key) * dil);
                    dma16(F.PA + trow * PAP + C_BV + hh * 64 + (lane >> 5) * 32 + (lane & 3) * 8, vimg + s * 4096 + p * 1024); } } }
        if (tid < 384) { const int s = tid >> 5, kk = tid & 31; int res, jt; bool valid;
            if (g < 2) { res = res0; jt = base0 + fadd + s; valid = jt >= 0 && s < nslot; } else { res = res0 + (s >> 2); jt = s & 3; valid = s < 8; }
            if (valid) { const size_t trow = (size_t)(b * SEQ + res + (32 * jt + kk) * dil);
                kstab[tid] = rsqrtf((F.SS[trow * SS_W + 72 + 2 * hh] + F.SS[trow * SS_W + 72 + 2 * hh + 1]) * (1.f / 64.f) + EPS); } }
        if (tid < NBX) btab[tid] = F.BIASX[(g * 4 + h) * NBX + tid];
        const int wres = g < 2 ? res0 : res0 + (F.wave >> 2), j = g < 2 ? j0 + F.wave : (F.wave & 3);
        const int sbase = g < 2 ? -base0 : (F.wave >> 2) * 4;
        const size_t qrow = (size_t)(b * SEQ + wres + (32 * j + r32) * dil);
        const float qs = rsqrtf((F.SS[qrow * SS_W + 48 + 2 * hh] + F.SS[qrow * SS_W + 48 + 2 * hh + 1]) * (1.f / 64.f) + EPS) * (0.125f * LOG2E);
        bf16x8 qf[4];
#pragma unroll
        for (int d0 = 0; d0 < 4; ++d0) { const int dd = 16 * d0 + 8 * hi;
            const v4u raw = *(const v4u*)(F.PA + qrow * PAP + C_BQ + hh * 64 + dd);
            const f32x4 wa = *(const f32x4*)(F.bqw + dd), wb = *(const f32x4*)(F.bqw + dd + 4), ka = *(const f32x4*)(F.bkw + dd), kb = *(const f32x4*)(F.bkw + dd + 4);
            v4u o;
            o.x = cvtpk(bflo(raw.x) * qs * wa.x * ka.x, bfhi(raw.x) * qs * wa.y * ka.y); o.y = cvtpk(bflo(raw.y) * qs * wa.z * ka.z, bfhi(raw.y) * qs * wa.w * ka.w);
            o.z = cvtpk(bflo(raw.z) * qs * wb.x * kb.x, bfhi(raw.z) * qs * wb.y * kb.y); o.w = cvtpk(bflo(raw.w) * qs * wb.z * kb.z, bfhi(raw.w) * qs * wb.w * kb.w);
            qf[d0] = __builtin_bit_cast(bf16x8, o); }
        VM_WAIT0(); __syncthreads();
        float mrun = -1e30f, lrun = 0.f; f32x16 o0 = {}, o1 = {};
        const int ksw = (r32 >> 1) & 7;
        for (int jt = (j >= 4 ? j - 4 : 0); jt <= j; ++jt) {
            int s = sbase + jt; if (s >= 12) s -= 12;
            const LAS unsigned char* kb = kimg + s * 4096 + r32 * 128;
            const LAS unsigned char* vb = vimg + s * 4096 + (4 * hi + ((lane & 15) >> 2)) * 64 + ((lane >> 4) & 1) * 32 + (lane & 3) * 8;
            const int bidx = 32 * (j - jt) + r32 + 31 - 4 * hi;
            bf16x8 kf[4]; f32x4 kk[4]; float bb[16]; s16x4 va[2][2], vc[2][2];
#pragma unroll
            for (int d0 = 0; d0 < 4; ++d0) kf[d0] = *(const LAS bf16x8*)(kb + (((2 * d0 + hi) ^ ksw) * 16));
#pragma unroll
            for (int i = 0; i < 4; ++i) { kk[i] = *(const LAS f32x4*)(kstab + s * 32 + 8 * i + 4 * hi);
#pragma unroll
                for (int jj = 0; jj < 4; ++jj) bb[4 * i + jj] = btab[bidx - 8 * i - jj]; }
#pragma unroll
            for (int ss = 0; ss < 2; ++ss)
#pragma unroll
                for (int hh2 = 0; hh2 < 2; ++hh2) { va[ss][hh2] = vtr(vb + (2 * ss) * 1024 + hh2 * 512); vc[ss][hh2] = vtr(vb + (2 * ss + 1) * 1024 + hh2 * 512); }
            __builtin_amdgcn_sched_barrier(0);
            f32x16 st = {};
#pragma unroll
            for (int d0 = 0; d0 < 4; ++d0) st = __builtin_amdgcn_mfma_f32_32x32x16_bf16(kf[d0], qf[d0], st, 0, 0, 0);
            float tmax = -1e30f;
#pragma unroll
            for (int i = 0; i < 4; ++i)
#pragma unroll
                for (int jj = 0; jj < 4; ++jj) { const float sv = st[4 * i + jj] * kk[i][jj] + bb[4 * i + jj]; st[4 * i + jj] = sv; tmax = fmaxf(tmax, sv); }
            tmax = max_x32(tmax);
            if (__builtin_amdgcn_ballot_w64(tmax > mrun + SM_THR) != 0ull) {
                const float mnew = fmaxf(mrun, tmax), alpha = __builtin_amdgcn_exp2f(mrun - mnew); mrun = mnew; lrun *= alpha;
#pragma unroll
                for (int r = 0; r < 16; ++r) { o0[r] *= alpha; o1[r] *= alpha; } }
            float psum = 0.f;
#pragma unroll
            for (int r = 0; r < 16; ++r) { st[r] = __builtin_amdgcn_exp2f(st[r] - mrun); psum += st[r]; }
            lrun += psum;
            v4u p0, p1;
            p0.x = cvtpk(st[0], st[1]); p0.y = cvtpk(st[2], st[3]); p0.z = cvtpk(st[4], st[5]); p0.w = cvtpk(st[6], st[7]);
            p1.x = cvtpk(st[8], st[9]); p1.y = cvtpk(st[10], st[11]); p1.z = cvtpk(st[12], st[13]); p1.w = cvtpk(st[14], st[15]);
#pragma unroll
            for (int ss = 0; ss < 2; ++ss) { const bf16x8 pf = __builtin_bit_cast(bf16x8, ss == 0 ? p0 : p1);
                { const s16x4 a = va[ss][0], c = vc[ss][0]; const bf16x8 vf = {a[0], a[1], a[2], a[3], c[0], c[1], c[2], c[3]}; o0 = __builtin_amdgcn_mfma_f32_32x32x16_bf16(vf, pf, o0, 0, 0, 0); }
                { const s16x4 a = va[ss][1], c = vc[ss][1]; const bf16x8 vf = {a[0], a[1], a[2], a[3], c[0], c[1], c[2], c[3]}; o1 = __builtin_amdgcn_mfma_f32_32x32x16_bf16(vf, pf, o1, 0, 0, 0); } }
        }
        const float ltot = sum_x32(lrun), inv = 1.f / ltot;
        bf16* orow = F.OG + ((size_t)g * HB_ROWS + qrow) * 256 + h * 64 + 8 * hi;
#define AB_ST(OX, DB) do { _Pragma("unroll") for (int kp = 0; kp < 2; ++kp) { v4u w; \
            w.x = cvtpk(OX[8 * kp] * inv, OX[8 * kp + 1] * inv); w.y = cvtpk(OX[8 * kp + 2] * inv, OX[8 * kp + 3] * inv); w.z = cvtpk(OX[8 * kp + 4] * inv, OX[8 * kp + 5] * inv); w.w = cvtpk(OX[8 * kp + 6] * inv, OX[8 * kp + 7] * inv); \
            *(v4u*)(orow + (DB) * 32 + 16 * kp) = swap32x2(w); } } while (0)
        AB_ST(o0, 0); AB_ST(o1, 1);
#undef AB_ST
        if (hi == 0) F.LSE[((size_t)g * HB_ROWS + qrow) * 4 + h] = (mrun + __log2f(ltot)) * LN2;
        __syncthreads();
    }
}

#ifndef G1_STAGGER_TICKS
#define G1_STAGGER_TICKS 0
#endif
#ifndef G1_ALIGN_EPI
#define G1_ALIGN_EPI true
#endif
#ifndef PROBE_REP
#define PROBE_REP -1
#endif
#define REPS(id) for (int rep_ = 0; rep_ < ((PROBE_REP) == (id) ? 2 : 1); ++rep_)
#ifndef MK_PER_PHASE
#define MK_PER_PHASE 0
#endif
constexpr int NPH_HALF = 5, NPHASES = 1 + 2 * NPH_HALF;
struct Args { const float* in[20]; float* out; unsigned char* ws; int ph_lo, ph_hi; };
__global__ void __launch_bounds__(NTHR, 2) mega_fwd(Args args) {
    extern __shared__ __attribute__((aligned(16))) unsigned char lds_raw[];
    Ctx F;
    F.lds = (LAS unsigned char*)lds_raw;
    F.tid = threadIdx.x; F.lane = F.tid & 63; F.wave = __builtin_amdgcn_readfirstlane(F.tid >> 6);
    F.G = gridDim.x; F.gtid = blockIdx.x * NTHR + F.tid; F.T = F.G * NTHR; F.gwave = blockIdx.x * NWAVES + F.wave; F.NW = F.G * NWAVES;
    { const int bx = blockIdx.x; const int vcu = (F.G % 8 == 0) ? (bx % 8) * (F.G / 8) + bx / 8 : bx; F.xgwave = vcu * NWAVES + F.wave; }
    unsigned char* ws = args.ws;
    F.x = args.in[0]; F.mem = args.in[1]; F.norm_w = args.in[2]; F.w_in = args.in[3]; F.gate_b = args.in[4]; F.lnw = args.in[5]; F.lnb = args.in[6]; F.sp_w = args.in[7];
    F.sp_b = args.in[8]; F.bqw = args.in[9]; F.bkw = args.in[10]; F.rel_bias = args.in[11]; F.mem_norm_w = args.in[12]; F.m_w_kv = args.in[13]; F.mqw = args.in[14]; F.mkw = args.in[15];
    F.proj_a = args.in[16]; F.proj_b = args.in[17]; F.proj_m = args.in[18]; F.w_out = args.in[19]; F.out = args.out;
    F.WIN = (bf16*)(ws + WS_WIN); F.PCAT = (bf16*)(ws + WS_PCAT); F.WOUT = (bf16*)(ws + WS_WOUT); F.WSP = (bf16*)(ws + WS_WSP); F.BIAS = (float*)(ws + WS_BIAS); F.BIASX = (float*)(ws + WS_BIAS + 65536);
    F.XN = (bf16*)(ws + WS_XN); F.PA = (bf16*)(ws + WS_PA); F.KVM = (bf16*)(ws + WS_KVM); F.SS = (float*)(ws + WS_SS); F.MKSS = (float*)(ws + WS_MKSS);
    F.cmax = (unsigned*)(ws + WS_CTL + CW_CMAX * 4); F.XN8 = ws + WS_XN8; F.W8 = ws + WS_W8; F.CS = (float*)(ws + WS_CS); F.RS = (float*)(ws + WS_RS);
    F.OG = (bf16*)(ws + WS_OG); F.LSE = (float*)(ws + WS_LSE); F.LNST = (float*)(ws + WS_LNST); F.YC = (bf16*)(ws + WS_YC); F.MRG = (bf16*)(ws + WS_MRG);
    for (int u = F.tid; u < (LDS_BYTES - LDSCTL_OFF) / 4; u += NTHR) ((LAS unsigned*)(F.lds + LDSCTL_OFF))[u] = 0u;
    __syncthreads();
    XcdBarrier bar; bar.bar = (unsigned*)(ws + WS_CTL) + CW_BAR; bar.x = 0; bar.st = nullptr; bar.wave = 0;
    if (!MK_PER_PHASE) bar = xcd_barrier_post((unsigned*)(ws + WS_CTL) + CW_BAR, (volatile LAS unsigned*)(F.lds + MISC_OFF) + 8, F.wave);
    const int lo = args.ph_lo, hi = args.ph_hi;
#define IN(k) (lo <= (k) && (k) < hi)
#define SEAM(k) do { if (IN(k) && IN((k) + 1)) xcd_barrier(bar); } while (0)

    if (IN(0)) { REPS(0) p0_prologue(F); } SEAM(0);
#pragma unroll 1
    for (int hb = 0; hb < 2; ++hb) {
        const int pb = 1 + hb * NPH_HALF, row0 = hb * HB_ROWS;
        asm volatile("v_mbcnt_lo_u32_b32 %0, -1, 0\n\tv_mbcnt_hi_u32_b32 %0, -1, %0" : "=v"(F.lane)); F.tid = F.wave * 64 + F.lane; F.gtid = blockIdx.x * NTHR + F.tid;
#if PROBE_REP == 9 || PROBE_REP == 10
        if (IN(pb + 0)) { pg8::Gemm g{F.XN, F.WIN, MTOT + MMEM, NIN + 1024, DM, DM, DM}; pg8::OrderBF S; S.init(hb, F.G, (int)blockIdx.x);
            typedef pg8::EpiProjT<PROBE_REP - 8> EP; EP E{F.PA, F.KVM, F.SS, F.MKSS, F.gate_b, hb * (HB_ROWS / 256), 0};
            pg8::gemm_phase<EP, pg8::OrderBF, true, true>(F.lds + RING_OFF, g, S, E, F.wave); }
#endif
        const bool late_g3 = !MK_PER_PHASE && (((int)blockIdx.x & 1) != 0);
#pragma unroll 1
        for (int part = 0; part < 2; ++part) {
        const bool do_bf = (part == 0) != ((((int)blockIdx.x & 1) != 0));
        if (IN(pb + 0) && do_bf) REPS(1) {
            pg8::Gemm g{F.XN, F.WIN, MTOT + MMEM, NIN + 1024, DM, DM, DM}; pg8::OrderBF S; S.init(hb, F.G, (int)blockIdx.x);
#if G1_STAGGER_TICKS
            { const unsigned long long t0 = __builtin_amdgcn_s_memrealtime(), dl = (unsigned long long)((blockIdx.x >> 3) & 31) * G1_STAGGER_TICKS;
              while (__builtin_amdgcn_s_memrealtime() - t0 < dl) __builtin_amdgcn_s_sleep(8); }
#endif
            pg8::EpiProj E{F.PA, F.KVM, F.SS, F.MKSS, F.gate_b, hb * (HB_ROWS / 256), 0};
            pg8::gemm_phase<pg8::EpiProj, pg8::OrderBF, G1_ALIGN_EPI, true>(F.lds + RING_OFF, g, S, E, F.wave);
        }
#if PROBE_REP == 16 || PROBE_REP == 17
        if (IN(pb + 0)) { pg8::Gemm g{(const bf16*)F.XN8, (const bf16*)F.W8, MTOT, N8, DM / 2, P8 / 2, P8 / 2}; pg8::OrderG8 S; S.init(hb, F.G, (int)blockIdx.x);
            typedef pg8::EpiProj8T<PROBE_REP == 16 ? 2 : 0> EP; EP E{pg8::EpiProjT<PROBE_REP == 16 ? 2 : 0>{F.PA, F.KVM, F.SS, F.MKSS, F.gate_b, hb * (HB_ROWS / 256), 0}, F.RS, F.CS, F.lds + SCALE_OFF};
            pg8::gemm_phase<EP, pg8::OrderG8, G1_ALIGN_EPI, true, true>(F.lds + RING_OFF, g, S, E, F.wave); }
#endif
        if (IN(pb + 0) && hb == 1 && late_g3 && part == 1) {
            pg8::Gemm g{F.MRG, F.WOUT, HB_ROWS, DM, DM, DM, DM}; pg8::StaticOrder S; S.init(HB_ROWS, DM, F.G, (int)blockIdx.x);
            pg8::EpiG3 E{F.x, F.out};
            pg8::gemm_phase<pg8::EpiG3, pg8::StaticOrder, true, true>(F.lds + RING_OFF, g, S, E, F.wave);
        }
        if (IN(pb + 0) && !do_bf) {
            pg8::Gemm g{(const bf16*)F.XN8, (const bf16*)F.W8, MTOT, N8, DM / 2, P8 / 2, P8 / 2}; pg8::OrderG8 S; S.init(hb, F.G, (int)blockIdx.x);
            pg8::EpiProj8 E{pg8::EpiProj{F.PA, F.KVM, F.SS, F.MKSS, F.gate_b, hb * (HB_ROWS / 256), 0}, F.RS, F.CS, F.lds + SCALE_OFF};
            pg8::gemm_phase<pg8::EpiProj8, pg8::OrderG8, G1_ALIGN_EPI, true, true>(F.lds + RING_OFF, g, S, E, F.wave);
        }
        }
#if PROBE_REP == 8
        if (IN(pb + 0)) { pg8::Gemm g{F.XN, F.WIN, MTOT + MMEM, NIN + 1024, DM, DM, DM}; pg8::OrderBF S; S.init(hb, F.G, (int)blockIdx.x); pg8::EpiNull E{};
            pg8::gemm_phase<pg8::EpiNull, pg8::OrderBF, true, true>(F.lds + RING_OFF, g, S, E, F.wave); }
#endif
        SEAM(pb + 0);
        if (IN(pb + 1)) {
#pragma unroll 1
            for (int st = 0; st < 3; ++st) { const int which = (st + ((int)blockIdx.x & 7) % 3) % 3;
                if (which == 0) { REPS(2) st_mixA_mfma(F); } else if (which == 1) { REPS(3) st_attnB_v3(F); } else { REPS(4) st_attnM_v3(F, hb); } } } SEAM(pb + 1);
        if (IN(pb + 2)) { REPS(5) st_mergeB_vec(F); } SEAM(pb + 2);
#if PROBE_REP == 13 || PROBE_REP == 14
        if (IN(pb + 3)) { pg8::Gemm g{F.YC, F.PCAT, HB_ROWS, DM, KC, KC, KC}; pg8::StaticOrder S; S.init(HB_ROWS, DM, F.G, (int)blockIdx.x);
            typedef pg8::EpiG2catT<PROBE_REP == 13, PROBE_REP == 14> EP; EP E{F.PA, F.MRG};
            pg8::gemm_phase<EP, pg8::StaticOrder, true, true>(F.lds + RING_OFF, g, S, E, F.wave); }
#endif
#if PROBE_REP == 11
        if (IN(pb + 3)) { pg8::Gemm g{F.YC, F.PCAT, HB_ROWS, DM, KC, KC, KC}; pg8::StaticOrder S; S.init(HB_ROWS, DM, F.G, (int)blockIdx.x); pg8::EpiNull E{};
            pg8::gemm_phase<pg8::EpiNull, pg8::StaticOrder, true, true>(F.lds + RING_OFF, g, S, E, F.wave); }
#endif
#if PROBE_REP == 12
        if (IN(pb + 4)) { pg8::Gemm g{F.MRG, F.WOUT, HB_ROWS, DM, DM, DM, DM}; pg8::StaticOrder S; S.init(HB_ROWS, DM, F.G, (int)blockIdx.x); pg8::EpiNull E{};
            pg8::gemm_phase<pg8::EpiNull, pg8::StaticOrder, true, true>(F.lds + RING_OFF, g, S, E, F.wave); }
#endif
        if (IN(pb + 3)) REPS(6) {
            pg8::Gemm g{F.YC, F.PCAT, HB_ROWS, DM, KC, KC, KC}; pg8::StaticOrder S; S.init(HB_ROWS, DM, F.G, (int)blockIdx.x);
            pg8::EpiG2cat E{F.PA, F.MRG};
            pg8::gemm_phase<pg8::EpiG2cat, pg8::StaticOrder, true, true>(F.lds + RING_OFF, g, S, E, F.wave);
        } SEAM(pb + 3);
        if (IN(pb + 4) && (hb == 1 || !late_g3)) REPS(7) {
            pg8::Gemm g{F.MRG, F.WOUT, HB_ROWS, DM, DM, DM, DM}; pg8::StaticOrder S; S.init(HB_ROWS, DM, F.G, (int)blockIdx.x);
            pg8::EpiG3 E{F.x + (size_t)row0 * DM, F.out + (size_t)row0 * DM};
            pg8::gemm_phase<pg8::EpiG3, pg8::StaticOrder, true, true>(F.lds + RING_OFF, g, S, E, F.wave);
        } if (hb == 1) SEAM(pb + 4);
    }
#undef IN
#undef SEAM
}

extern "C" void kernel_launch(void* const* d_in, const int* in_sizes, int n_in, void* d_out, int out_size, void* d_ws, size_t ws_size, hipStream_t stream) {
    static int grid = 0;
    if (grid == 0) {
        if (n_in != 20 || in_sizes[0] != MTOT * DM || out_size != MTOT * DM || ws_size < WS_END) { fprintf(stderr, "kernel_launch: unexpected shapes (n_in %d, ws %zu); nothing launched\n", n_in, ws_size); grid = -1; return; }
        int dev = 0, cus = 0, per_cu = 0;
        if (hipGetDevice(&dev) != hipSuccess || hipDeviceGetAttribute(&cus, hipDeviceAttributeMultiprocessorCount, dev) != hipSuccess) { grid = -1; return; }
        if (hipFuncSetAttribute((const void*)mega_fwd, hipFuncAttributeMaxDynamicSharedMemorySize, LDS_BYTES) != hipSuccess) { fprintf(stderr, "kernel_launch: hipFuncSetAttribute failed\n"); grid = -1; return; }
        if (hipOccupancyMaxActiveBlocksPerMultiprocessor(&per_cu, (const void*)mega_fwd, NTHR, LDS_BYTES) != hipSuccess || per_cu < 1) { fprintf(stderr, "kernel_launch: occupancy query says %d blocks per CU\n", per_cu); (void)hipGetLastError(); grid = -1; return; }
        grid = cus;
    }
    if (grid < 0) return;
    if (hipMemsetAsync((char*)d_ws + WS_CTL, 0, CTL_ZERO_BYTES, stream) != hipSuccess) return;
    Args a{};
    for (int i = 0; i < 20; ++i) a.in[i] = (const float*)d_in[i];
    a.out = (float*)d_out; a.ws = (unsigned char*)d_ws;
#if MK_PER_PHASE
    for (int p = 0; p < NPHASES; ++p) { a.ph_lo = p; a.ph_hi = p + 1; hipLaunchKernelGGL(mega_fwd, dim3(grid), dim3(NTHR), LDS_BYTES, stream, a); }
#else
    a.ph_lo = 0; a.ph_hi = NPHASES; hipLaunchKernelGGL(mega_fwd, dim3(grid), dim3(NTHR), LDS_BYTES, stream, a);
#endif
}
```
